# Optimizing an MI355X kernel written in HIP

```python
import jax
import jax.numpy as jnp
from jax import lax
import numpy as np

D_MODEL = 2048
BATCH = 2
SEQ = 4096
DEPTH = 1

HEAD_DIM = 128
HA = 8
HA_KV = 2
H_IDX = 16
D_IDX = 64
TOPK_MAX = 256
HB = 8
ROPE_THETA = 500000.0
ROT_A = HEAD_DIM // 4
ROT_IDX = D_IDX // 4
Q_BLOCK = 128
D_FF = -(-8 * D_MODEL // (3 * 256)) * 256
D_PLE = 256
EPS = 1e-6
NEG_INF = float('-inf')

SPLIT_SIZES = (
    HA * HEAD_DIM,
    HA_KV * HEAD_DIM,
    HA_KV * HEAD_DIM,
    H_IDX * D_IDX,
    D_IDX,
    H_IDX,
    HB * HEAD_DIM,
    HB * HEAD_DIM,
    HB * HEAD_DIM,
    HB,
    D_MODEL,
    D_MODEL,
)
N_IN = sum(SPLIT_SIZES)

kernel_name = 'hybrid_dsa_fox_gated_block'


def rmsnorm(x, g):
    xf = x.astype(jnp.float32)
    xf = xf * lax.rsqrt(jnp.mean(xf * xf, axis=-1, keepdims=True) + EPS)
    return (xf * g.astype(jnp.float32)).astype(x.dtype)


def partial_rope(x, pos, rot):
    half = rot // 2
    inv_freq = ROPE_THETA ** (-jnp.arange(half, dtype=jnp.float32) / half)
    ang = pos.astype(jnp.float32)[:, :, None] * inv_freq
    cos = jnp.cos(ang)[:, :, None, :]
    sin = jnp.sin(ang)[:, :, None, :]
    x1 = x[..., :half].astype(jnp.float32)
    x2 = x[..., half:rot].astype(jnp.float32)
    rotated = jnp.concatenate([x1 * cos - x2 * sin, x2 * cos + x1 * sin], axis=-1).astype(x.dtype)
    return jnp.concatenate([rotated, x[..., rot:]], axis=-1)


def to_blocks(a):
    b, t = a.shape[:2]
    return jnp.moveaxis(a.reshape(b, t // Q_BLOCK, Q_BLOCK, *a.shape[2:]), 1, 0)


def from_blocks(a):
    a = jnp.moveaxis(a, 0, 1)
    return a.reshape(a.shape[0], a.shape[1] * a.shape[2], *a.shape[3:])


def dsa_sparse_attention(q, k, v, q_idx, k_idx, w_idx, top_k):
    t_len = q.shape[1]
    group = HA // HA_KV
    scale = HEAD_DIM ** -0.5
    key_pos = jnp.arange(t_len)
    t_blocks = key_pos.reshape(t_len // Q_BLOCK, Q_BLOCK)
    gather = jax.vmap(lambda table, idx: table[idx])

    def block(args):
        qb, qib, wib, tb = args
        nb = qb.shape[0]
        dots = jnp.einsum('bqhd,bsd->bqhs', qib, k_idx).astype(jnp.float32)
        score = jnp.einsum('bqh,bqhs->bqs', wib.astype(jnp.float32), jax.nn.relu(dots))
        causal = key_pos[None, :] <= tb[:, None]
        score = jnp.where(causal[None], score, NEG_INF)
        _, sel = lax.top_k(score, top_k)
        valid = sel <= tb[None, :, None]
        k_sel = gather(k, sel)
        v_sel = gather(v, sel)
        qg = qb.reshape(nb, Q_BLOCK, HA_KV, group, HEAD_DIM)
        logits = jnp.einsum('bqngd,bqsnd->bqngs', qg, k_sel).astype(jnp.float32) * scale
        logits = jnp.where(valid[:, :, None, None, :], logits, NEG_INF)
        prob = jax.nn.softmax(logits, axis=-1).astype(v.dtype)
        out = jnp.einsum('bqngs,bqsnd->bqngd', prob, v_sel)
        return out.reshape(nb, Q_BLOCK, HA * HEAD_DIM)

    out = lax.map(block, (to_blocks(q), to_blocks(q_idx), to_blocks(w_idx), t_blocks))
    return from_blocks(out)


def forgetting_attention(q, k, v, log_fcum):
    t_len = q.shape[1]
    scale = HEAD_DIM ** -0.5
    key_pos = jnp.arange(t_len)
    t_blocks = key_pos.reshape(t_len // Q_BLOCK, Q_BLOCK)
    c_keys = jnp.swapaxes(log_fcum, 1, 2)

    def block(args):
        qb, cb, tb = args
        nb = qb.shape[0]
        logits = jnp.einsum('bqhd,bshd->bhqs', qb, k).astype(jnp.float32) * scale
        logits = logits + jnp.swapaxes(cb, 1, 2)[..., None] - c_keys[:, :, None, :]
        causal = key_pos[None, :] <= tb[:, None]
        logits = jnp.where(causal[None, None], logits, NEG_INF)
        prob = jax.nn.softmax(logits, axis=-1).astype(v.dtype)
        out = jnp.einsum('bhqs,bshd->bqhd', prob, v)
        return out.reshape(nb, Q_BLOCK, HB * HEAD_DIM)

    out = lax.map(block, (to_blocks(q), to_blocks(log_fcum), t_blocks))
    return from_blocks(out)


def setup_inputs(seed: int = 0) -> dict:
    key = jax.random.key(seed)
    ks = jax.random.split(key, 17)
    f32 = jnp.float32

    def normal(k, shape, fan_in):
        return jax.random.normal(k, shape, f32) * fan_in ** -0.5

    def gain(k, shape):
        return 1.0 + 0.05 * jax.random.normal(k, shape, f32)

    wa = HA * HEAD_DIM
    wb = HB * HEAD_DIM
    return {
        'x': jax.random.normal(ks[0], (BATCH, SEQ, D_MODEL), f32),
        'p': jax.random.normal(ks[1], (DEPTH, BATCH, SEQ, D_PLE), f32),
        'positions': jnp.broadcast_to(jnp.arange(SEQ, dtype=jnp.int32), (BATCH, SEQ)),
        'g_mix': gain(ks[2], (DEPTH, D_MODEL)),
        'w_in': normal(ks[3], (DEPTH, D_MODEL, N_IN), D_MODEL),
        'b_f': 1.0 + 0.5 * jax.random.normal(ks[4], (DEPTH, HB), f32),
        'w_o_a': normal(ks[5], (DEPTH, wa, D_MODEL), wa),
        'w_o_b': normal(ks[6], (DEPTH, wb, D_MODEL), wb),
        'w_out': normal(ks[7], (DEPTH, D_MODEL, D_MODEL), D_MODEL),
        'g_ffn': gain(ks[8], (DEPTH, D_MODEL)),
        'w_ffn_gate': normal(ks[9], (DEPTH, D_MODEL, D_FF), D_MODEL),
        'w_ffn_up': normal(ks[10], (DEPTH, D_MODEL, D_FF), D_MODEL),
        'w_ffn_down': normal(ks[11], (DEPTH, D_FF, D_MODEL), D_FF),
        'g_ple': gain(ks[12], (DEPTH, D_MODEL)),
        'w_ple_gate': normal(ks[13], (DEPTH, D_MODEL, D_MODEL), D_MODEL),
        'w_ple_proj': normal(ks[14], (DEPTH, D_PLE, D_MODEL), D_PLE),
        'g_final': gain(ks[15], (D_MODEL,)),
    }


def reference(x, p, positions, g_mix, w_in, b_f, w_o_a, w_o_b, w_out, g_ffn,
              w_ffn_gate, w_ffn_up, w_ffn_down, g_ple, w_ple_gate, w_ple_proj, g_final):
    b, t_len, _ = x.shape
    top_k = min(TOPK_MAX, t_len // 4)
    split_at = [int(s) for s in np.cumsum(SPLIT_SIZES)[:-1]]
    for i in range(DEPTH):
        h = rmsnorm(x, g_mix[i])
        proj = h @ w_in[i]
        (q_a, k_a, v_a, q_i, k_i, w_i, q_b, k_b, v_b, f_b, gate_a, gate_b) = jnp.split(proj, split_at, axis=-1)

        q_a = partial_rope(q_a.reshape(b, t_len, HA, HEAD_DIM), positions, ROT_A)
        k_a = partial_rope(k_a.reshape(b, t_len, HA_KV, HEAD_DIM), positions, ROT_A)
        v_a = v_a.reshape(b, t_len, HA_KV, HEAD_DIM)
        q_i = partial_rope(q_i.reshape(b, t_len, H_IDX, D_IDX), positions, ROT_IDX)
        k_i = partial_rope(k_i[:, :, None, :], positions, ROT_IDX)[:, :, 0, :]
        w_i = w_i * (H_IDX ** -0.5 * D_IDX ** -0.5)
        out_a = dsa_sparse_attention(q_a, k_a, v_a, q_i, k_i, w_i, top_k)

        log_f = jax.nn.log_sigmoid(f_b.astype(jnp.float32) + b_f[i].astype(jnp.float32))
        log_fcum = jnp.cumsum(log_f, axis=1)
        out_b = forgetting_attention(q_b.reshape(b, t_len, HB, HEAD_DIM),
                                     k_b.reshape(b, t_len, HB, HEAD_DIM),
                                     v_b.reshape(b, t_len, HB, HEAD_DIM), log_fcum)

        y_a = out_a @ w_o_a[i]
        y_b = out_b @ w_o_b[i]
        mixed = jax.nn.sigmoid(gate_a) * y_a + jax.nn.sigmoid(gate_b) * y_b
        x = x + mixed @ w_out[i]

        h = rmsnorm(x, g_ffn[i])
        x = x + (jax.nn.silu(h @ w_ffn_gate[i]) * (h @ w_ffn_up[i])) @ w_ffn_down[i]

        h = rmsnorm(x, g_ple[i])
        x = x + jax.nn.sigmoid(h @ w_ple_gate[i]) * (p[i] @ w_ple_proj[i])
    return rmsnorm(x, g_final)
```

```cpp
#include <hip/hip_runtime.h>
#include <stdint.h>
#include <cstdio>

#define LAS __attribute__((address_space(3)))
typedef _Float16 h16;
typedef _Float16 h16x8 __attribute__((ext_vector_type(8)));
typedef _Float16 h16x4 __attribute__((ext_vector_type(4)));
typedef _Float16 h16x2 __attribute__((ext_vector_type(2)));
typedef float f32x4 __attribute__((ext_vector_type(4)));
typedef float f32x2 __attribute__((ext_vector_type(2)));
typedef unsigned u32x4 __attribute__((ext_vector_type(4)));
typedef unsigned u32x2 __attribute__((ext_vector_type(2)));
typedef unsigned long long u64;

constexpr int NBATCH = 2, T = 4096, MTOK = NBATCH * T, DM = 2048;
constexpr int HA = 8, HAKV = 2, HIDX = 16, DIDX = 64, HB = 8, HD = 128;
constexpr int N_IN = 9816, N_INP = 9984, DFF = 5632, DPLE = 256, TOPK = 256;
constexpr float EPS = 1e-6f;
constexpr float ATT_SCALE = 0.08838834764831845f;

constexpr size_t MiB = 1u << 20;
constexpr size_t WS_CTL = 0;
constexpr size_t WS_ROPE = 1 * MiB;
constexpr size_t WS_CB = 3 * MiB;
constexpr size_t WS_LOGF = 3 * MiB + 512 * 1024;
constexpr size_t WS_MASK = 4 * MiB;
constexpr size_t WS_WIN = 8 * MiB;
constexpr size_t WS_OUTA = 8 * MiB, WS_OUTB = 24 * MiB, WS_P16 = 40 * MiB;
constexpr size_t WS_WOA = 47 * MiB, WS_WOB = 51 * MiB, WS_WOUT = 55 * MiB, WS_WGU = 63 * MiB, WS_WDN = 107 * MiB, WS_WPG = 129 * MiB, WS_WPP = 137 * MiB;
constexpr size_t WS_QA = 138 * MiB, WS_KA = 154 * MiB, WS_VA = 158 * MiB, WS_QI = 162 * MiB, WS_KI = 178 * MiB, WS_WI = 179 * MiB;
constexpr size_t WS_QB = 180 * MiB, WS_KB = 196 * MiB, WS_VB = 212 * MiB, WS_SIGA = 228 * MiB, WS_SIGB = 260 * MiB, WS_END = 292 * MiB;
constexpr size_t WS_MIXED = WS_QB;
constexpr size_t WS_H2 = WS_QA;
constexpr size_t WS_ACT = WS_QB;
constexpr size_t WS_PP = WS_QB;

namespace pg8 {
constexpr int BM = 256, BK = 64, HALF = 128, HTB = HALF * BK * 2, STAGE_BYTES = 8 * HTB, NXCD = 8, WGM = 8;
__host__ __device__ __forceinline__ int lds_byte(int r, int c) { const int st = (r >> 4) * 2 + (c >> 5), rr = r & 15, cc = c & 31, ob = rr * 64 + cc * 2; return st * 1024 + (ob ^ (((ob >> 9) & 1) << 5)); }
__host__ __device__ __forceinline__ void stage_rc(int b, int& R, int& C) { const int st = b / 1024, sb = b % 1024, swz = sb ^ (((sb >> 9) & 1) << 5); R = (st >> 1) * 16 + swz / 64; C = (st & 1) * 32 + (swz % 64) / 2; }
struct Unit { int pm, pn; };
struct Gemm { const h16* A; const h16* Bt; int M, N, K; };
struct StaticOrder {
    int nM, nN, nwg, G, c;
    __host__ __device__ void init(int M, int N, int G_, int c_) { nM = M / BM; nN = N / BM; nwg = nM * nN; G = G_; c = c_; }
    __host__ __device__ bool next(int i, Unit& u) const {
        const long L = (long)i * G + c; if (L >= nwg) return false;
        int wgid = (int)L; { const int q = nwg / NXCD, r = nwg % NXCD, xcd = wgid % NXCD, off = wgid / NXCD; wgid = (xcd < r ? xcd * (q + 1) : r * (q + 1) + (xcd - r) * q) + off; }
        const int nig = WGM * nN, gid = wgid / nig, fm = gid * WGM, gsz = (nM - fm) < WGM ? (nM - fm) : WGM;
        u.pm = fm + ((wgid % nig) % gsz); u.pn = (wgid % nig) / gsz; return true;
    }
};
template <class Epi>
__device__ __forceinline__ void gemm_phase(LAS unsigned char* lds, const Gemm g, const StaticOrder& S, const Epi& E) {
    const int tid = threadIdx.x, wid = __builtin_amdgcn_readfirstlane(tid >> 6), lane = tid & 63, wr = wid >> 2, wc = wid & 3, fr = lane & 15, fq = lane >> 4;
    const int K = g.K, nt = K / BK;
    unsigned voffA[2];
#pragma unroll
    for (int i = 0; i < 2; ++i) { int R, C; stage_rc(tid * 16 + i * 8192, R, C); voffA[i] = (unsigned)(R * K + C) * 2u; }
    const size_t kstep = (size_t)(BK * 2);
    const size_t hstep = (size_t)HALF * K * 2;
    const size_t tstep = 2 * hstep;
    const unsigned ldsw = (unsigned)wid * 1024u;
    const int aoff = lds_byte(wr * 64 + fr, fq * 8), boff = lds_byte(wc * 32 + fr, fq * 8);
#define PG8_SA(b, h) (((b) * 2 + (h)) * HTB)
#define PG8_SB(b, h) ((4 + (b) * 2 + (h)) * HTB)
#define PG8_STAGE(bufoff, gbase) do { _Pragma("unroll") for (int _i = 0; _i < 2; ++_i) \
        __builtin_amdgcn_global_load_lds((const unsigned*)((const char*)(gbase) + voffA[_i]), (LAS unsigned*)(lds + (bufoff) + ldsw + _i * 8192), 16, 0, 0); } while (0)
#define PG8_LDA(dst, b, h) do { _Pragma("unroll") for (int m = 0; m < 4; ++m) _Pragma("unroll") for (int k = 0; k < 2; ++k) dst[m][k] = *(const LAS h16x8*)(lds + PG8_SA(b, h) + aoff + m * 2048 + k * 1024); } while (0)
#define PG8_LDB(dst, b, h) do { _Pragma("unroll") for (int n = 0; n < 2; ++n) _Pragma("unroll") for (int k = 0; k < 2; ++k) dst[n][k] = *(const LAS h16x8*)(lds + PG8_SB(b, h) + boff + n * 2048 + k * 1024); } while (0)
#define PG8_MMA(ai, bj, At, Bt) do { __builtin_amdgcn_s_setprio(1); _Pragma("unroll") for (int m = 0; m < 4; ++m) _Pragma("unroll") for (int n = 0; n < 2; ++n) _Pragma("unroll") for (int k = 0; k < 2; ++k) \
        acc[ai][bj][m][n] = __builtin_amdgcn_mfma_f32_16x16x32_f16(Bt[n][k], At[m][k], acc[ai][bj][m][n], 0, 0, 0); __builtin_amdgcn_s_setprio(0); } while (0)
#define PG8_WAIT_V(n) asm volatile("s_waitcnt vmcnt(" #n ")" ::: "memory")
#define PG8_WAIT_L(n) asm volatile("s_waitcnt lgkmcnt(" #n ")" ::: "memory")
#define PG8_BAR __builtin_amdgcn_s_barrier()
#define PG8_SCHED __builtin_amdgcn_sched_barrier(0)
    Unit cur, nxt; int ui = 0;
    if (!S.next(0, cur)) return;
    f32x4 acc[2][2][4][2];
#pragma unroll
    for (int a = 0; a < 2; ++a)
#pragma unroll
        for (int b = 0; b < 2; ++b)
#pragma unroll
            for (int m = 0; m < 4; ++m)
#pragma unroll
                for (int n = 0; n < 2; ++n) acc[a][b][m][n] = (f32x4){0.f, 0.f, 0.f, 0.f};
    h16x8 At[4][2], B0[2][2], B1[2][2];
    const char* cA = (const char*)g.A + (size_t)cur.pm * tstep; const char* cB = (const char*)g.Bt + (size_t)cur.pn * tstep;
    PG8_STAGE(PG8_SB(0, 0), cB); PG8_STAGE(PG8_SA(0, 0), cA); PG8_STAGE(PG8_SB(0, 1), cB + hstep); PG8_STAGE(PG8_SA(0, 1), cA + hstep);
    if (wr == 1) PG8_BAR;
    PG8_WAIT_V(4); PG8_BAR;
    PG8_STAGE(PG8_SB(1, 0), cB + kstep); PG8_STAGE(PG8_SA(1, 0), cA + kstep); PG8_STAGE(PG8_SB(1, 1), cB + hstep + kstep);
    PG8_WAIT_V(6); PG8_BAR;
    for (;;) {
        const bool has_next = S.next(ui + 1, nxt);
        const char* nA = has_next ? (const char*)g.A + (size_t)nxt.pm * tstep : cA; const char* nB = has_next ? (const char*)g.Bt + (size_t)nxt.pn * tstep : cB;
        for (int t = 0; t < nt; t += 2) {
            const bool last = (t == nt - 2);
            const char* a1 = cA + (size_t)(t + 1) * kstep;
            const char* a2 = last ? nA : cA + (size_t)(t + 2) * kstep; const char* b2 = last ? nB : cB + (size_t)(t + 2) * kstep;
            const char* a3 = a2 + kstep; const char* b3 = b2 + kstep;
            PG8_LDB(B0, 0, 0); PG8_SCHED; PG8_LDA(At, 0, 0); PG8_STAGE(PG8_SA(1, 1), a1 + hstep);
            PG8_WAIT_L(8); PG8_BAR; PG8_WAIT_L(0); PG8_MMA(0, 0, At, B0); PG8_BAR; PG8_SCHED;
            PG8_LDB(B1, 0, 1); PG8_STAGE(PG8_SB(0, 0), b2);
            PG8_BAR; PG8_WAIT_L(0); PG8_MMA(0, 1, At, B1); PG8_BAR;
            PG8_LDA(At, 0, 1); PG8_STAGE(PG8_SA(0, 0), a2);
            PG8_BAR; PG8_WAIT_L(0); PG8_MMA(1, 0, At, B0); PG8_BAR; PG8_SCHED;
            PG8_STAGE(PG8_SB(0, 1), b2 + hstep);
            PG8_WAIT_V(6); PG8_BAR; PG8_MMA(1, 1, At, B1); PG8_BAR;
            PG8_LDB(B0, 1, 0); PG8_SCHED; PG8_LDA(At, 1, 0); PG8_STAGE(PG8_SA(0, 1), a2 + hstep);
            PG8_WAIT_L(8); PG8_BAR; PG8_WAIT_L(0); PG8_MMA(0, 0, At, B0); PG8_BAR; PG8_SCHED;
            PG8_LDB(B1, 1, 1); PG8_STAGE(PG8_SB(1, 0), b3);
            PG8_BAR; PG8_WAIT_L(0); PG8_MMA(0, 1, At, B1); PG8_BAR;
            PG8_LDA(At, 1, 1); PG8_STAGE(PG8_SA(1, 0), a3);
            PG8_BAR; PG8_WAIT_L(0); PG8_MMA(1, 0, At, B0); PG8_BAR; PG8_SCHED;
            PG8_STAGE(PG8_SB(1, 1), b3 + hstep);
            PG8_WAIT_V(6); PG8_BAR; PG8_MMA(1, 1, At, B1); PG8_BAR;
        }
        E(acc, cur, wr, wc, fr, fq);
        if (!has_next) break;
#pragma unroll
        for (int a = 0; a < 2; ++a)
#pragma unroll
            for (int b = 0; b < 2; ++b)
#pragma unroll
                for (int m = 0; m < 4; ++m)
#pragma unroll
                    for (int n = 0; n < 2; ++n) acc[a][b][m][n] = (f32x4){0.f, 0.f, 0.f, 0.f};
        cur = nxt; cA = nA; cB = nB; ++ui;
    }
    PG8_WAIT_V(0);
    if (wr == 0) PG8_BAR;
    PG8_BAR;
#undef PG8_SA
#undef PG8_SB
#undef PG8_STAGE
#undef PG8_LDA
#undef PG8_LDB
#undef PG8_MMA
#undef PG8_WAIT_V
#undef PG8_WAIT_L
#undef PG8_BAR
#undef PG8_SCHED
}
}
using pg8::Unit;
typedef f32x4 Acc[2][2][4][2];

__device__ __forceinline__ void st4h(h16* p, f32x4 v) { h16x4 o; o[0] = (h16)v[0]; o[1] = (h16)v[1]; o[2] = (h16)v[2]; o[3] = (h16)v[3]; *(h16x4*)p = o; }
__device__ __forceinline__ f32x4 ld4h(const h16* p) { const h16x4 o = *(const h16x4*)p; return (f32x4){(float)o[0], (float)o[1], (float)o[2], (float)o[3]}; }
__device__ __forceinline__ float sigmoidf_(float x) { return 1.0f / (1.0f + __expf(-x)); }
__device__ __forceinline__ float logsigmoidf_(float z) { return fminf(z, 0.f) - __logf(1.0f + __expf(-fabsf(z))); }
__device__ __forceinline__ float wave_sum(float v) {
#pragma unroll
    for (int o = 1; o < 64; o <<= 1) v += __shfl_xor(v, o);
    return v;
}

struct EpiInProj {
    h16 *QA, *KA, *VA, *QI, *KI, *QB, *KB, *VB, *SIGA, *SIGB; float *WI, *LOGF; const float* ROPE; const float* b_f;
    __device__ __forceinline__ void operator()(const Acc& acc, const Unit& u, int wr, int wc, int fr, int fq) const {
        const int pn = u.pn, row0 = u.pm * 256 + wr * 64 + fr;
#pragma unroll
        for (int ai = 0; ai < 2; ++ai)
#pragma unroll
            for (int m = 0; m < 4; ++m) {
                const int row = row0 + ai * 128 + m * 16, b = row >> 12, t = row & 4095;
                const float* rp = ROPE + (size_t)row * 48;
#pragma unroll
                for (int bj = 0; bj < 2; ++bj) {
                    f32x4 v0 = acc[ai][bj][m][0], v1 = acc[ai][bj][m][1];
                    const int d0 = 32 * wc + 4 * fq;
                    if (pn < 6) {
                        h16* dst; int head;
                        if (pn < 4) { head = pn * 2 + bj; dst = QA + ((size_t)(b * HA + head) * T + t) * HD; }
                        else if (pn == 4) { head = bj; dst = KA + ((size_t)(b * HAKV + head) * T + t) * HD; }
                        else { head = bj; dst = VA + ((size_t)(b * HAKV + head) * T + t) * HD; }
                        if (pn < 5 && wc == 0) {
                            const f32x4 c = *(const f32x4*)(rp + 4 * fq), s = *(const f32x4*)(rp + 16 + 4 * fq);
                            const f32x4 y0 = v0 * c - v1 * s, y1 = v1 * c + v0 * s; v0 = y0; v1 = y1;
                        }
                        st4h(dst + d0, v0); st4h(dst + d0 + 16, v1);
                    } else if (pn < 11) {
                        const bool is_q = pn < 10;
                        if (is_q || bj == 0) {
                            if (is_q || wc < 2) {
                                const int dd = 32 * (wc & 1) + 4 * fq;
                                h16* dst = is_q ? QI + (size_t)row * 1024 + ((pn - 6) * 4 + 2 * bj + (wc >> 1)) * 64 : KI + (size_t)row * 64;
                                if ((wc & 1) == 0) {
                                    f32x4 pr;
#pragma unroll
                                    for (int j = 0; j < 4; ++j) pr[j] = __shfl_xor(v0[j], 32);
                                    const f32x4 c = *(const f32x4*)(rp + 32 + 4 * (fq & 1)), s = *(const f32x4*)(rp + 40 + 4 * (fq & 1));
                                    v0 = (fq < 2) ? (v0 * c - pr * s) : (v0 * c + pr * s);
                                }
                                st4h(dst + dd, v0); st4h(dst + dd + 16, v1);
                            } else if (wc == 2) {
                                *(f32x4*)(WI + (size_t)row * 16 + 4 * fq) = v0 * 0.03125f;
                                if (fq < 2) { const f32x4 bf = *(const f32x4*)(b_f + 4 * fq); f32x4 o;
#pragma unroll
                                    for (int j = 0; j < 4; ++j) o[j] = logsigmoidf_(v1[j] + bf[j]);
                                    *(f32x4*)(LOGF + (size_t)row * 8 + 4 * fq) = o; }
                            }
                        }
                    } else if (pn < 23) {
                        const int q = pn - 11, which = q >> 2, head = (q & 3) * 2 + bj;
                        h16* base = which == 0 ? QB : (which == 1 ? KB : VB);
                        h16* dst = base + ((size_t)(b * HB + head) * T + t) * HD;
                        st4h(dst + d0, v0); st4h(dst + d0 + 16, v1);
                    } else {
                        const int q = pn - 23; h16* base = q < 8 ? SIGA : SIGB; const int col = (q & 7) * 256 + 128 * bj + d0;
#pragma unroll
                        for (int j = 0; j < 4; ++j) { v0[j] = sigmoidf_(v0[j]); v1[j] = sigmoidf_(v1[j]); }
                        st4h(base + (size_t)row * DM + col, v0); st4h(base + (size_t)row * DM + col + 16, v1);
                    }
                }
            }
    }
};
template <bool FIRST> struct EpiGate {
    const h16* SIG; h16* MIXED;
    __device__ __forceinline__ void operator()(const Acc& acc, const Unit& u, int wr, int wc, int fr, int fq) const {
        const int row0 = u.pm * 256 + wr * 64 + fr, col0 = u.pn * 256 + 32 * wc + 4 * fq;
#pragma unroll
        for (int ai = 0; ai < 2; ++ai)
#pragma unroll
            for (int m = 0; m < 4; ++m)
#pragma unroll
                for (int bj = 0; bj < 2; ++bj)
#pragma unroll
                    for (int n = 0; n < 2; ++n) { const size_t off = (size_t)(row0 + ai * 128 + m * 16) * DM + col0 + bj * 128 + n * 16;
                        f32x4 v = ld4h(SIG + off) * acc[ai][bj][m][n]; if (!FIRST) v += ld4h(MIXED + off); st4h(MIXED + off, v); }
    }
};
struct EpiResid {
    const float* BASE; float* OUT;
    __device__ __forceinline__ void operator()(const Acc& acc, const Unit& u, int wr, int wc, int fr, int fq) const {
        const int row0 = u.pm * 256 + wr * 64 + fr, col0 = u.pn * 256 + 32 * wc + 4 * fq;
#pragma unroll
        for (int ai = 0; ai < 2; ++ai)
#pragma unroll
            for (int m = 0; m < 4; ++m)
#pragma unroll
                for (int bj = 0; bj < 2; ++bj)
#pragma unroll
                    for (int n = 0; n < 2; ++n) { const size_t off = (size_t)(row0 + ai * 128 + m * 16) * DM + col0 + bj * 128 + n * 16;
                        *(f32x4*)(OUT + off) = *(const f32x4*)(BASE + off) + acc[ai][bj][m][n]; }
    }
};
struct EpiSwiGLU {
    h16* ACT;
    __device__ __forceinline__ void operator()(const Acc& acc, const Unit& u, int wr, int wc, int fr, int fq) const {
        const int row0 = u.pm * 256 + wr * 64 + fr;
#pragma unroll
        for (int ai = 0; ai < 2; ++ai)
#pragma unroll
            for (int m = 0; m < 4; ++m)
#pragma unroll
                for (int bj = 0; bj < 2; ++bj) { const f32x4 g = acc[ai][bj][m][0], uu = acc[ai][bj][m][1]; f32x4 o;
#pragma unroll
                    for (int j = 0; j < 4; ++j) o[j] = g[j] * sigmoidf_(g[j]) * uu[j];
                    st4h(ACT + (size_t)(row0 + ai * 128 + m * 16) * DFF + 16 * (u.pn * 8 + bj * 4 + wc) + 4 * fq, o); }
    }
};
struct EpiStoreH {
    h16* O; int ldc;
    __device__ __forceinline__ void operator()(const Acc& acc, const Unit& u, int wr, int wc, int fr, int fq) const {
        const int row0 = u.pm * 256 + wr * 64 + fr, col0 = u.pn * 256 + 32 * wc + 4 * fq;
#pragma unroll
        for (int ai = 0; ai < 2; ++ai)
#pragma unroll
            for (int m = 0; m < 4; ++m)
#pragma unroll
                for (int bj = 0; bj < 2; ++bj)
#pragma unroll
                    for (int n = 0; n < 2; ++n) st4h(O + (size_t)(row0 + ai * 128 + m * 16) * ldc + col0 + bj * 128 + n * 16, acc[ai][bj][m][n]);
    }
};
struct EpiPLE {
    const h16* PP; float* X;
    __device__ __forceinline__ void operator()(const Acc& acc, const Unit& u, int wr, int wc, int fr, int fq) const {
        const int row0 = u.pm * 256 + wr * 64 + fr, col0 = u.pn * 256 + 32 * wc + 4 * fq;
#pragma unroll
        for (int ai = 0; ai < 2; ++ai)
#pragma unroll
            for (int m = 0; m < 4; ++m)
#pragma unroll
                for (int bj = 0; bj < 2; ++bj)
#pragma unroll
                    for (int n = 0; n < 2; ++n) { const size_t off = (size_t)(row0 + ai * 128 + m * 16) * DM + col0 + bj * 128 + n * 16;
                        const f32x4 a = acc[ai][bj][m][n], pp = ld4h(PP + off); f32x4 x = *(const f32x4*)(X + off);
#pragma unroll
                        for (int j = 0; j < 4; ++j) x[j] += sigmoidf_(a[j]) * pp[j];
                        *(f32x4*)(X + off) = x; }
    }
};

template <class Epi>
__global__ void __launch_bounds__(512, 2) k_gemm(pg8::Gemm g, Epi e) {
    extern __shared__ __attribute__((aligned(16))) unsigned char lds[];
    pg8::StaticOrder S; S.init(g.M, g.N, (int)gridDim.x, (int)blockIdx.x);
    pg8::gemm_phase<Epi>((LAS unsigned char*)lds, g, S, e);
}

__device__ __forceinline__ int map_in(int p) {
    if (p < 2560) return p;
    if (p < 2816) { const int c = p - 2560; if (c < 64) return 2560 + c; if (c < 80) return 2624 + (c - 64); if (c < 88) return 5712 + (c - 80); return -1; }
    const int q = p - 2816; if (q < 3072) return 2640 + q; return 5720 + (q - 3072);
}
template <int MODE>
__global__ void __launch_bounds__(256) k_transpose(const float* W0, const float* W1, int K, int Nsrc, h16* WT, int Nphys) {
    __shared__ float scr_all[4][64 * 33];
    const int lane = threadIdx.x & 63, wave = threadIdx.x >> 6;
    float* scr = scr_all[wave];
    const int nblk = Nphys / 32, nitems = (K / 64) * nblk;
    for (int item = blockIdx.x * 4 + wave; item < nitems; item += gridDim.x * 4) {
        const int kb = item / nblk, nb = item % nblk, k0 = 64 * kb, n0 = 32 * nb;
        const int n = n0 + (lane & 31);
        const float* src = nullptr;
        if (MODE == 0) { if (n < Nsrc) src = W0 + n; }
        else if (MODE == 1) { const int c = map_in(n); if (c >= 0) src = W0 + c; }
        else { src = (((n >> 4) & 1) ? W1 : W0) + 16 * (n >> 5) + (n & 15); }
#pragma unroll 8
        for (int i = 0; i < 32; ++i) { const int kk = 2 * i + (lane >> 5); scr[kk * 33 + (lane & 31)] = src ? src[(size_t)(k0 + kk) * Nsrc] : 0.f; }
        __builtin_amdgcn_wave_barrier(); asm volatile("s_waitcnt lgkmcnt(0)" ::: "memory");
        const int c = lane & 7;
#pragma unroll
        for (int j = 0; j < 4; ++j) { const int nn = (lane >> 3) + 8 * j; const float* s = scr + (8 * c) * 33 + nn;
            h16x8 o;
#pragma unroll
            for (int e = 0; e < 8; ++e) o[e] = (h16)s[e * 33];
            *(h16x8*)(WT + (size_t)(n0 + nn) * K + k0 + 8 * c) = o; }
        __builtin_amdgcn_wave_barrier(); asm volatile("s_waitcnt lgkmcnt(0)" ::: "memory");
    }
}
__device__ __forceinline__ void sincos_f32arg(float ang, float& sn, float& cs) {
    const double a = (double)ang;
    const double rev = a * 0.15915494309189535;
    const double fr = rev - __builtin_rint(rev);
    const double q4 = fr * 4.0; const double qi = __builtin_rint(q4); const int qq = ((int)qi) & 3;
    const double r = (q4 - qi) * 1.5707963267948966;
    const double r2 = r * r;
    const double s = r * (1.0 + r2 * (-1.0 / 6 + r2 * (1.0 / 120 + r2 * (-1.0 / 5040 + r2 * (1.0 / 362880 + r2 * (-1.0 / 39916800))))));
    const double c = 1.0 + r2 * (-0.5 + r2 * (1.0 / 24 + r2 * (-1.0 / 720 + r2 * (1.0 / 40320 + r2 * (-1.0 / 3628800 + r2 * (1.0 / 479001600))))));
    double so, co;
    if (qq == 0) { so = s; co = c; } else if (qq == 1) { so = c; co = -s; } else if (qq == 2) { so = -s; co = -c; } else { so = -c; co = s; }
    sn = (float)so; cs = (float)co;
}
__global__ void k_rope(const int* pos, float* ROPE) {
    const int idx = blockIdx.x * blockDim.x + threadIdx.x; if (idx >= MTOK * 24) return;
    const int tok = idx / 24, i = idx % 24, k = i < 16 ? i : 2 * (i - 16);
    float f = 0x1.000000p+0f;
    f = k == 1 ? 0x1.c2ef76p-2f : f; f = k == 2 ? 0x1.8d275ep-3f : f; f = k == 3 ? 0x1.5dc95ap-4f : f; f = k == 4 ? 0x1.341190p-5f : f; f = k == 5 ? 0x1.0f5384p-6f : f;
    f = k == 6 ? 0x1.ddee9cp-8f : f; f = k == 7 ? 0x1.a4ee3ep-9f : f; f = k == 8 ? 0x1.72ba44p-10f : f; f = k == 9 ? 0x1.468318p-11f : f; f = k == 10 ? 0x1.1f91f0p-12f : f;
    f = k == 11 ? 0x1.fa8b84p-14f : f; f = k == 12 ? 0x1.be218ap-15f : f; f = k == 13 ? 0x1.88ec22p-16f : f; f = k == 14 ? 0x1.5a0f50p-17f : f; f = k == 15 ? 0x1.30c94ep-18f : f;
    const float ang = (float)pos[tok] * f;
    float sn, cs; sincos_f32arg(ang, sn, cs);
    float* rp = ROPE + (size_t)tok * 48;
    if (i < 16) { rp[i] = cs; rp[16 + i] = sn; } else { rp[32 + (i - 16)] = cs; rp[40 + (i - 16)] = sn; }
}
template <bool TO_F32>
__global__ void __launch_bounds__(256) k_rmsnorm(const float* X, const float* g, h16* OUTH, float* OUTF) {
    const int lane = threadIdx.x & 63, row = blockIdx.x * 4 + (threadIdx.x >> 6); if (row >= MTOK) return;
    const f32x4* xr = (const f32x4*)(X + (size_t)row * DM) + lane;
    f32x4 v[8]; float s = 0.f;
#pragma unroll
    for (int j = 0; j < 8; ++j) { v[j] = xr[64 * j]; s += (v[j][0] * v[j][0] + v[j][1] * v[j][1]) + (v[j][2] * v[j][2] + v[j][3] * v[j][3]); }
    const float r = 1.0f / sqrtf(wave_sum(s) * (1.0f / DM) + EPS);
#pragma unroll
    for (int j = 0; j < 8; ++j) { const f32x4 gg = *((const f32x4*)g + lane + 64 * j); const f32x4 o = v[j] * r * gg;
        if (TO_F32) *((f32x4*)(OUTF + (size_t)row * DM) + lane + 64 * j) = o; else st4h(OUTH + (size_t)row * DM + 4 * (lane + 64 * j), o); }
}
__global__ void k_cvt(const float* P, h16* O, int n4) { const int i = blockIdx.x * blockDim.x + threadIdx.x; if (i < n4) st4h(O + 4 * (size_t)i, *((const f32x4*)P + i)); }
__global__ void __launch_bounds__(64) k_cumsum(const float* LOGF, float* CB) {
    const int bh = blockIdx.x, b = bh >> 3, h = bh & 7, lane = threadIdx.x;
    float loc[64]; float s = 0.f;
#pragma unroll
    for (int i = 0; i < 64; ++i) { s += LOGF[(size_t)(b * T + lane * 64 + i) * 8 + h]; loc[i] = s; }
    float inc = s;
#pragma unroll
    for (int o = 1; o < 64; o <<= 1) { const float nb = __shfl_up(inc, o); if (lane >= o) inc += nb; }
    const float base = inc - s;
#pragma unroll
    for (int i = 0; i < 64; ++i) CB[(size_t)bh * T + lane * 64 + i] = base + loc[i];
}

__device__ __forceinline__ unsigned fkey(float f) { const unsigned u = __float_as_uint(f + 0.0f); return (u & 0x80000000u) ? ~u : (u | 0x80000000u); }
__device__ __forceinline__ unsigned count_ge(const unsigned (&key)[64], unsigned th) {
    unsigned c = 0;
#pragma unroll
    for (int j = 0; j < 64; ++j) c += (unsigned)__builtin_popcountll(__ballot(key[j] >= th));
    return c;
}
__device__ __forceinline__ u64 topk_select(const unsigned (&key)[64], int nvalid, int lane) {
    u64 myword = 0;
    if (nvalid <= TOPK) {
#pragma unroll
        for (int j = 0; j < 64; ++j) { const u64 bal = __ballot(key[j] != 0u); if (lane == j) myword = bal; }
    } else {
        unsigned th = 0u; bool exact = false;
        for (int bit = 31; bit >= 0; --bit) { const unsigned tc = th | (1u << bit); const unsigned c = count_ge(key, tc); if (c >= (unsigned)TOPK) th = tc; if (c == (unsigned)TOPK) { exact = true; break; } }
        if (exact) {
#pragma unroll
            for (int j = 0; j < 64; ++j) { const u64 bal = __ballot(key[j] >= th); if (lane == j) myword = bal; }
        } else {
            unsigned cgt = 0;
#pragma unroll
            for (int j = 0; j < 64; ++j) cgt += (unsigned)__builtin_popcountll(__ballot(key[j] > th));
            int need = TOPK - (int)cgt;
#pragma unroll
            for (int j = 0; j < 64; ++j) { u64 eq = __ballot(key[j] == th); const u64 gt = __ballot(key[j] > th);
                int pc = __builtin_popcountll(eq);
                while (pc > need) { eq &= ~(1ull << (63 - __builtin_clzll(eq))); --pc; }
                need -= pc; if (lane == j) myword = gt | eq; }
        }
    }
    return myword;
}
__global__ void __launch_bounds__(256) k_topk_naive(const h16* QI, const h16* KI, const float* WI, u64* MASK) {
    __shared__ float qs_all[4][16 * 64 + 16];
    __shared__ unsigned ks_all[4][4096];
    const int lane = threadIdx.x & 63, wave = threadIdx.x >> 6, row = blockIdx.x * 4 + wave;
    const int b = row >> 12, t = row & 4095;
    float* qs = qs_all[wave]; unsigned* ks = ks_all[wave];
    { const h16* qp = QI + (size_t)row * 1024 + lane * 16;
#pragma unroll
      for (int i = 0; i < 16; ++i) qs[lane * 16 + i] = (float)qp[i]; }
    if (lane < 16) qs[1024 + lane] = WI[(size_t)row * 16 + lane];
    __builtin_amdgcn_wave_barrier(); asm volatile("s_waitcnt lgkmcnt(0)" ::: "memory");
#pragma unroll 1
    for (int j = 0; j < 64; ++j) {
        unsigned kk = 0u;
        const int s = 64 * j + lane;
        if (s <= t) {
            float kf[64];
            const h16x8* kp = (const h16x8*)(KI + (size_t)(b * T + s) * 64);
#pragma unroll
            for (int c = 0; c < 8; ++c) { const h16x8 kv = kp[c];
#pragma unroll
                for (int e = 0; e < 8; ++e) kf[c * 8 + e] = (float)kv[e]; }
            float sc = 0.f;
#pragma unroll 1
            for (int h = 0; h < 16; ++h) { float d = 0.f;
#pragma unroll
                for (int e = 0; e < 64; ++e) d = fmaf(qs[h * 64 + e], kf[e], d);
                sc = fmaf(qs[1024 + h], fmaxf(d, 0.f), sc); }
            kk = fkey(sc);
        }
        ks[j * 64 + lane] = kk;
    }
    __builtin_amdgcn_wave_barrier(); asm volatile("s_waitcnt lgkmcnt(0)" ::: "memory");
    unsigned key[64];
#pragma unroll
    for (int j = 0; j < 64; ++j) key[j] = ks[j * 64 + lane];
    MASK[(size_t)row * 64 + lane] = topk_select(key, t + 1, lane);
}

__global__ void __launch_bounds__(64) k_attn_a_naive(const h16* QA, const h16* KA, const h16* VA, const u64* MASK, h16* OUT) {
    const int idx = blockIdx.x * 64 + threadIdx.x;
    const int t = idx & 4095, h = (idx >> 12) & 7, b = idx >> 15, g = h >> 2;
    h16x2 q[64];
    { const h16x2* qp = (const h16x2*)(QA + ((size_t)(b * HA + h) * T + t) * HD);
#pragma unroll
      for (int i = 0; i < 64; ++i) q[i] = qp[i]; }
    float o[128];
#pragma unroll
    for (int i = 0; i < 128; ++i) o[i] = 0.f;
    float mrun = -1e30f, l = 0.f;
    const h16* kb = KA + (size_t)(b * HAKV + g) * T * HD; const h16* vb = VA + (size_t)(b * HAKV + g) * T * HD;
    const u64* mp = MASK + (size_t)(b * T + t) * 64;
    for (int wj = 0; wj < 64; ++wj) {
        u64 wbits = mp[wj];
        while (wbits) {
            const int s = wj * 64 + __builtin_ctzll(wbits); wbits &= wbits - 1;
            if (s > t) continue;
            const h16x2* kp = (const h16x2*)(kb + (size_t)s * HD);
            float d = 0.f;
#pragma unroll
            for (int i = 0; i < 64; ++i) { const h16x2 kk = kp[i]; d = fmaf((float)q[i][0], (float)kk[0], d); d = fmaf((float)q[i][1], (float)kk[1], d); }
            d *= ATT_SCALE;
            const float mn = fmaxf(mrun, d), al = __expf(mrun - mn), p = __expf(d - mn);
            l = l * al + p; mrun = mn;
            const h16x2* vp = (const h16x2*)(vb + (size_t)s * HD);
#pragma unroll
            for (int i = 0; i < 64; ++i) { const h16x2 vv = vp[i]; o[2 * i] = o[2 * i] * al + p * (float)vv[0]; o[2 * i + 1] = o[2 * i + 1] * al + p * (float)vv[1]; }
        }
    }
    const float rl = 1.0f / l;
    h16* op = OUT + (size_t)(b * T + t) * 1024 + h * HD;
#pragma unroll
    for (int i = 0; i < 32; ++i) { f32x4 v = {o[4 * i] * rl, o[4 * i + 1] * rl, o[4 * i + 2] * rl, o[4 * i + 3] * rl}; st4h(op + 4 * i, v); }
}
__global__ void __launch_bounds__(64) k_attn_b_naive(const h16* QB, const h16* KB, const h16* VB, const float* CB, h16* OUT) {
    const int idx = blockIdx.x * 64 + threadIdx.x;
    const int t = idx & 4095, h = (idx >> 12) & 7, b = idx >> 15;
    const int tmax = __builtin_amdgcn_readfirstlane(t | 63);
    h16x2 q[64];
    { const h16x2* qp = (const h16x2*)(QB + ((size_t)(b * HB + h) * T + t) * HD);
#pragma unroll
      for (int i = 0; i < 64; ++i) q[i] = qp[i]; }
    float o[128];
#pragma unroll
    for (int i = 0; i < 128; ++i) o[i] = 0.f;
    float mrun = -1e30f, l = 0.f;
    const h16* kb = KB + (size_t)(b * HB + h) * T * HD; const h16* vb = VB + (size_t)(b * HB + h) * T * HD;
    const float* cb = CB + (size_t)(b * HB + h) * T; const float ct = cb[t];
    for (int s = 0; s <= tmax; ++s) {
        const h16x2* kp = (const h16x2*)(kb + (size_t)s * HD);
        float d = 0.f;
#pragma unroll
        for (int i = 0; i < 64; ++i) { const h16x2 kk = kp[i]; d = fmaf((float)q[i][0], (float)kk[0], d); d = fmaf((float)q[i][1], (float)kk[1], d); }
        d = d * ATT_SCALE + (ct - cb[s]);
        if (s > t) d = -__builtin_inff();
        const float mn = fmaxf(mrun, d), al = __expf(mrun - mn), p = __expf(d - mn);
        l = l * al + p; mrun = mn;
        const h16x2* vp = (const h16x2*)(vb + (size_t)s * HD);
#pragma unroll
        for (int i = 0; i < 64; ++i) { const h16x2 vv = vp[i]; o[2 * i] = o[2 * i] * al + p * (float)vv[0]; o[2 * i + 1] = o[2 * i + 1] * al + p * (float)vv[1]; }
    }
    const float rl = 1.0f / l;
    h16* op = OUT + (size_t)(b * T + t) * 1024 + h * HD;
#pragma unroll
    for (int i = 0; i < 32; ++i) { f32x4 v = {o[4 * i] * rl, o[4 * i + 1] * rl, o[4 * i + 2] * rl, o[4 * i + 3] * rl}; st4h(op + 4 * i, v); }
}

template <class Epi> static void launch_gemm(const h16* A, const h16* Bt, int M, int N, int K, const Epi& e, hipStream_t st) {
    static bool attr = false;
    if (!attr) { attr = true; (void)hipFuncSetAttribute((const void*)k_gemm<Epi>, hipFuncAttributeMaxDynamicSharedMemorySize, pg8::STAGE_BYTES); }
    pg8::Gemm g{A, Bt, M, N, K};
    hipLaunchKernelGGL(k_gemm<Epi>, dim3(256), dim3(512), pg8::STAGE_BYTES, st, g, e);
}

extern "C" void kernel_launch(void* const* d_in, const int* in_sizes, int n_in, void* d_out, int out_size, void* d_ws, size_t ws_size, hipStream_t stream) {
    if (n_in != 17 || out_size != MTOK * DM || ws_size < WS_END) { fprintf(stderr, "kernel_launch: unexpected shapes / workspace (%d inputs, out %d, ws %zu)\n", n_in, out_size, ws_size); return; }
    const float* x = (const float*)d_in[0]; const float* p = (const float*)d_in[1]; const int* pos = (const int*)d_in[2];
    const float* g_mix = (const float*)d_in[3]; const float* w_in = (const float*)d_in[4]; const float* b_f = (const float*)d_in[5];
    const float* w_o_a = (const float*)d_in[6]; const float* w_o_b = (const float*)d_in[7]; const float* w_out = (const float*)d_in[8];
    const float* g_ffn = (const float*)d_in[9]; const float* w_g = (const float*)d_in[10]; const float* w_u = (const float*)d_in[11]; const float* w_d = (const float*)d_in[12];
    const float* g_ple = (const float*)d_in[13]; const float* w_pg = (const float*)d_in[14]; const float* w_pp = (const float*)d_in[15]; const float* g_final = (const float*)d_in[16];
    unsigned char* ws = (unsigned char*)d_ws; float* out = (float*)d_out;
    float* ROPE = (float*)(ws + WS_ROPE); float* CB = (float*)(ws + WS_CB); float* LOGF = (float*)(ws + WS_LOGF); u64* MASK = (u64*)(ws + WS_MASK);
    h16* WIN = (h16*)(ws + WS_WIN); h16* WOA = (h16*)(ws + WS_WOA); h16* WOB = (h16*)(ws + WS_WOB); h16* WOUT = (h16*)(ws + WS_WOUT);
    h16* WGU = (h16*)(ws + WS_WGU); h16* WDN = (h16*)(ws + WS_WDN); h16* WPG = (h16*)(ws + WS_WPG); h16* WPP = (h16*)(ws + WS_WPP);
    h16* QA = (h16*)(ws + WS_QA); h16* KA = (h16*)(ws + WS_KA); h16* VA = (h16*)(ws + WS_VA); h16* QI = (h16*)(ws + WS_QI); h16* KI = (h16*)(ws + WS_KI); float* WI = (float*)(ws + WS_WI);
    h16* QB = (h16*)(ws + WS_QB); h16* KB = (h16*)(ws + WS_KB); h16* VB = (h16*)(ws + WS_VB); h16* SIGA = (h16*)(ws + WS_SIGA); h16* SIGB = (h16*)(ws + WS_SIGB);
    h16* OUTA = (h16*)(ws + WS_OUTA); h16* OUTB = (h16*)(ws + WS_OUTB); h16* P16 = (h16*)(ws + WS_P16);
    h16* MIXED = (h16*)(ws + WS_MIXED); h16* H2 = (h16*)(ws + WS_H2); h16* ACT = (h16*)(ws + WS_ACT); h16* PP = (h16*)(ws + WS_PP);
    h16* H1 = (h16*)d_out;

    hipLaunchKernelGGL(k_transpose<1>, dim3(2048), dim3(256), 0, stream, w_in, (const float*)nullptr, DM, N_IN, WIN, N_INP);
    hipLaunchKernelGGL(k_transpose<0>, dim3(1024), dim3(256), 0, stream, w_o_a, (const float*)nullptr, 1024, DM, WOA, DM);
    hipLaunchKernelGGL(k_transpose<0>, dim3(1024), dim3(256), 0, stream, w_o_b, (const float*)nullptr, 1024, DM, WOB, DM);
    hipLaunchKernelGGL(k_transpose<0>, dim3(1024), dim3(256), 0, stream, w_out, (const float*)nullptr, DM, DM, WOUT, DM);
    hipLaunchKernelGGL(k_transpose<2>, dim3(2048), dim3(256), 0, stream, w_g, w_u, DM, DFF, WGU, 2 * DFF);
    hipLaunchKernelGGL(k_transpose<0>, dim3(2048), dim3(256), 0, stream, w_d, (const float*)nullptr, DFF, DM, WDN, DM);
    hipLaunchKernelGGL(k_transpose<0>, dim3(1024), dim3(256), 0, stream, w_pg, (const float*)nullptr, DM, DM, WPG, DM);
    hipLaunchKernelGGL(k_transpose<0>, dim3(256), dim3(256), 0, stream, w_pp, (const float*)nullptr, DPLE, DM, WPP, DM);
    hipLaunchKernelGGL(k_rope, dim3((MTOK * 24 + 255) / 256), dim3(256), 0, stream, pos, ROPE);
    hipLaunchKernelGGL(k_rmsnorm<false>, dim3(MTOK / 4), dim3(256), 0, stream, x, g_mix, H1, (float*)nullptr);
    { EpiInProj e{QA, KA, VA, QI, KI, QB, KB, VB, SIGA, SIGB, WI, LOGF, ROPE, b_f}; launch_gemm(H1, WIN, MTOK, N_INP, DM, e, stream); }
    hipLaunchKernelGGL(k_cumsum, dim3(16), dim3(64), 0, stream, LOGF, CB);
    hipLaunchKernelGGL(k_topk_naive, dim3(MTOK / 4), dim3(256), 0, stream, QI, KI, WI, MASK);
    hipLaunchKernelGGL(k_attn_a_naive, dim3(NBATCH * HA * T / 64), dim3(64), 0, stream, QA, KA, VA, MASK, OUTA);
    hipLaunchKernelGGL(k_attn_b_naive, dim3(NBATCH * HB * T / 64), dim3(64), 0, stream, QB, KB, VB, CB, OUTB);
    { EpiGate<true> e{SIGA, MIXED}; launch_gemm(OUTA, WOA, MTOK, DM, 1024, e, stream); }
    { EpiGate<false> e{SIGB, MIXED}; launch_gemm(OUTB, WOB, MTOK, DM, 1024, e, stream); }
    { EpiResid e{x, out}; launch_gemm(MIXED, WOUT, MTOK, DM, DM, e, stream); }
    hipLaunchKernelGGL(k_rmsnorm<false>, dim3(MTOK / 4), dim3(256), 0, stream, out, g_ffn, H2, (float*)nullptr);
    { EpiSwiGLU e{ACT}; launch_gemm(H2, WGU, MTOK, 2 * DFF, DM, e, stream); }
    { EpiResid e{out, out}; launch_gemm(ACT, WDN, MTOK, DM, DFF, e, stream); }
    hipLaunchKernelGGL(k_rmsnorm<false>, dim3(MTOK / 4), dim3(256), 0, stream, out, g_ple, H2, (float*)nullptr);
    hipLaunchKernelGGL(k_cvt, dim3((MTOK * DPLE / 4 + 255) / 256), dim3(256), 0, stream, p, P16, MTOK * DPLE / 4);
    { EpiStoreH e{PP, DM}; launch_gemm(P16, WPP, MTOK, DM, DPLE, e, stream); }
    { EpiPLE e{PP, out}; launch_gemm(H2, WPG, MTOK, DM, DM, e, stream); }
    hipLaunchKernelGGL(k_rmsnorm<true>, dim3(MTOK / 4), dim3(256), 0, stream, out, g_final, (h16*)nullptr, out);
}
```

```cpp
#include <hip/hip_runtime.h>
#include <hip/hip_cooperative_groups.h>
#include <stdint.h>
#include <cstdio>

#define LAS __attribute__((address_space(3)))
typedef _Float16 h16;
typedef _Float16 h16x8 __attribute__((ext_vector_type(8)));
typedef _Float16 h16x4 __attribute__((ext_vector_type(4)));
typedef _Float16 h16x2 __attribute__((ext_vector_type(2)));
typedef float f32x4 __attribute__((ext_vector_type(4)));
typedef float f32x2 __attribute__((ext_vector_type(2)));
typedef unsigned u32x4 __attribute__((ext_vector_type(4)));
typedef unsigned u32x2 __attribute__((ext_vector_type(2)));
typedef unsigned long long u64;

constexpr int NBATCH = 2, T = 4096, MTOK = NBATCH * T, DM = 2048;
constexpr int HA = 8, HAKV = 2, HIDX = 16, DIDX = 64, HB = 8, HD = 128;
constexpr int N_IN = 9816, N_INP = 9984, DFF = 5632, DPLE = 256, TOPK = 256;
constexpr float EPS = 1e-6f;
constexpr float ATT_SCALE = 0.08838834764831845f;

constexpr size_t MiB = 1u << 20;
constexpr size_t WS_CTL = 0;
constexpr size_t WS_ROPE = 1 * MiB;
constexpr size_t WS_CB = 3 * MiB;
constexpr size_t WS_LOGF = 3 * MiB + 512 * 1024;
constexpr size_t WS_MASK = 4 * MiB;
constexpr size_t WS_WIN = 8 * MiB;
constexpr size_t WS_OUTA = 8 * MiB, WS_OUTB = 24 * MiB, WS_P16 = 40 * MiB;
constexpr size_t WS_WOA = 47 * MiB, WS_WOB = 51 * MiB, WS_WOUT = 55 * MiB, WS_WGU = 63 * MiB, WS_WDN = 107 * MiB, WS_WPG = 129 * MiB, WS_WPP = 137 * MiB;
constexpr size_t WS_QA = 138 * MiB, WS_KA = 154 * MiB, WS_VA = 158 * MiB, WS_QI = 162 * MiB, WS_KI = 178 * MiB, WS_WI = 179 * MiB;
constexpr size_t WS_QB = 180 * MiB, WS_KB = 196 * MiB, WS_VB = 212 * MiB, WS_SIGA = 228 * MiB, WS_SIGB = 260 * MiB, WS_END = 292 * MiB;
constexpr size_t WS_MIXED = WS_QB;
constexpr size_t WS_H2 = WS_QA;
constexpr size_t WS_ACT = WS_QB;
constexpr size_t WS_PP = WS_QB;

namespace pg8 {
constexpr int BM = 256, BK = 64, HALF = 128, HTB = HALF * BK * 2, STAGE_BYTES = 8 * HTB, NXCD = 8, WGM = 8;
__host__ __device__ __forceinline__ int lds_byte(int r, int c) { const int st = (r >> 4) * 2 + (c >> 5), rr = r & 15, cc = c & 31, ob = rr * 64 + cc * 2; return st * 1024 + (ob ^ (((ob >> 9) & 1) << 5)); }
__host__ __device__ __forceinline__ void stage_rc(int b, int& R, int& C) { const int st = b / 1024, sb = b % 1024, swz = sb ^ (((sb >> 9) & 1) << 5); R = (st >> 1) * 16 + swz / 64; C = (st & 1) * 32 + (swz % 64) / 2; }
struct Unit { int pm, pn; };
struct Gemm { const h16* A; const h16* Bt; int M, N, K; };
struct StaticOrder {
    int nM, nN, nwg, G, c;
    __host__ __device__ void init(int M, int N, int G_, int c_) { nM = M / BM; nN = N / BM; nwg = nM * nN; G = G_; c = c_; }
    __host__ __device__ bool next(int i, Unit& u) const {
        const long L = (long)i * G + c; if (L >= nwg) return false;
        int wgid = (int)L; { const int q = nwg / NXCD, r = nwg % NXCD, xcd = wgid % NXCD, off = wgid / NXCD; wgid = (xcd < r ? xcd * (q + 1) : r * (q + 1) + (xcd - r) * q) + off; }
        const int nig = WGM * nN, gid = wgid / nig, fm = gid * WGM, gsz = (nM - fm) < WGM ? (nM - fm) : WGM;
        u.pm = fm + ((wgid % nig) % gsz); u.pn = (wgid % nig) / gsz; return true;
    }
};
template <class Epi>
__device__ __forceinline__ void gemm_phase(LAS unsigned char* lds, const Gemm g, const StaticOrder& S, const Epi& E) {
    int tid = threadIdx.x; asm volatile("" : "+v"(tid));
    const int wid = __builtin_amdgcn_readfirstlane(tid >> 6), lane = tid & 63, wr = wid >> 2, wc = wid & 3, fr = lane & 15, fq = lane >> 4;
    const int K = g.K, nt = K / BK;
    unsigned voffA[2];
#pragma unroll
    for (int i = 0; i < 2; ++i) { int R, C; stage_rc(tid * 16 + i * 8192, R, C); voffA[i] = (unsigned)(R * K + C) * 2u; }
    const size_t kstep = (size_t)(BK * 2);
    const size_t hstep = (size_t)HALF * K * 2;
    const size_t tstep = 2 * hstep;
    const unsigned ldsw = (unsigned)wid * 1024u;
    const int aoff = lds_byte(wr * 64 + fr, fq * 8), boff = lds_byte(wc * 32 + fr, fq * 8);
#define PG8_SA(b, h) (((b) * 2 + (h)) * HTB)
#define PG8_SB(b, h) ((4 + (b) * 2 + (h)) * HTB)
#define PG8_STAGE(bufoff, gbase) do { _Pragma("unroll") for (int _i = 0; _i < 2; ++_i) \
        __builtin_amdgcn_global_load_lds((const unsigned*)((const char*)(gbase) + voffA[_i]), (LAS unsigned*)(lds + (bufoff) + ldsw + _i * 8192), 16, 0, 0); } while (0)
#define PG8_LDA(dst, b, h) do { _Pragma("unroll") for (int m = 0; m < 4; ++m) _Pragma("unroll") for (int k = 0; k < 2; ++k) dst[m][k] = *(const LAS h16x8*)(lds + PG8_SA(b, h) + aoff + m * 2048 + k * 1024); } while (0)
#define PG8_LDB(dst, b, h) do { _Pragma("unroll") for (int n = 0; n < 2; ++n) _Pragma("unroll") for (int k = 0; k < 2; ++k) dst[n][k] = *(const LAS h16x8*)(lds + PG8_SB(b, h) + boff + n * 2048 + k * 1024); } while (0)
#define PG8_MMA(ai, bj, At, Bt) do { __builtin_amdgcn_s_setprio(1); _Pragma("unroll") for (int m = 0; m < 4; ++m) _Pragma("unroll") for (int n = 0; n < 2; ++n) _Pragma("unroll") for (int k = 0; k < 2; ++k) \
        acc[ai][bj][m][n] = __builtin_amdgcn_mfma_f32_16x16x32_f16(Bt[n][k], At[m][k], acc[ai][bj][m][n], 0, 0, 0); __builtin_amdgcn_s_setprio(0); } while (0)
#define PG8_WAIT_V(n) asm volatile("s_waitcnt vmcnt(" #n ")" ::: "memory")
#define PG8_WAIT_L(n) asm volatile("s_waitcnt lgkmcnt(" #n ")" ::: "memory")
#define PG8_BAR __builtin_amdgcn_s_barrier()
#define PG8_SCHED __builtin_amdgcn_sched_barrier(0)
    Unit cur, nxt; int ui = 0;
    if (!S.next(0, cur)) return;
    f32x4 acc[2][2][4][2];
#pragma unroll
    for (int a = 0; a < 2; ++a)
#pragma unroll
        for (int b = 0; b < 2; ++b)
#pragma unroll
            for (int m = 0; m < 4; ++m)
#pragma unroll
                for (int n = 0; n < 2; ++n) acc[a][b][m][n] = (f32x4){0.f, 0.f, 0.f, 0.f};
    h16x8 At[4][2], B0[2][2], B1[2][2];
    const char* cA = (const char*)g.A + (size_t)cur.pm * tstep; const char* cB = (const char*)g.Bt + (size_t)cur.pn * tstep;
    PG8_STAGE(PG8_SB(0, 0), cB); PG8_STAGE(PG8_SA(0, 0), cA); PG8_STAGE(PG8_SB(0, 1), cB + hstep); PG8_STAGE(PG8_SA(0, 1), cA + hstep);
    if (wr == 1) PG8_BAR;
    PG8_WAIT_V(4); PG8_BAR;
    PG8_STAGE(PG8_SB(1, 0), cB + kstep); PG8_STAGE(PG8_SA(1, 0), cA + kstep); PG8_STAGE(PG8_SB(1, 1), cB + hstep + kstep);
    PG8_WAIT_V(6); PG8_BAR;
    for (;;) {
        const bool has_next = S.next(ui + 1, nxt);
        const char* nA = has_next ? (const char*)g.A + (size_t)nxt.pm * tstep : cA; const char* nB = has_next ? (const char*)g.Bt + (size_t)nxt.pn * tstep : cB;
        for (int t = 0; t < nt; t += 2) {
            const bool last = (t == nt - 2);
            const char* a1 = cA + (size_t)(t + 1) * kstep;
            const char* a2 = last ? nA : cA + (size_t)(t + 2) * kstep; const char* b2 = last ? nB : cB + (size_t)(t + 2) * kstep;
            const char* a3 = a2 + kstep; const char* b3 = b2 + kstep;
            PG8_LDB(B0, 0, 0); PG8_SCHED; PG8_LDA(At, 0, 0); PG8_STAGE(PG8_SA(1, 1), a1 + hstep);
            PG8_WAIT_L(8); PG8_BAR; PG8_WAIT_L(0); PG8_MMA(0, 0, At, B0); PG8_BAR; PG8_SCHED;
            PG8_LDB(B1, 0, 1); PG8_STAGE(PG8_SB(0, 0), b2);
            PG8_BAR; PG8_WAIT_L(0); PG8_MMA(0, 1, At, B1); PG8_BAR;
            PG8_LDA(At, 0, 1); PG8_STAGE(PG8_SA(0, 0), a2);
            PG8_BAR; PG8_WAIT_L(0); PG8_MMA(1, 0, At, B0); PG8_BAR; PG8_SCHED;
            PG8_STAGE(PG8_SB(0, 1), b2 + hstep);
            PG8_WAIT_V(6); PG8_BAR; PG8_MMA(1, 1, At, B1); PG8_BAR;
            PG8_LDB(B0, 1, 0); PG8_SCHED; PG8_LDA(At, 1, 0); PG8_STAGE(PG8_SA(0, 1), a2 + hstep);
            PG8_WAIT_L(8); PG8_BAR; PG8_WAIT_L(0); PG8_MMA(0, 0, At, B0); PG8_BAR; PG8_SCHED;
            PG8_LDB(B1, 1, 1); PG8_STAGE(PG8_SB(1, 0), b3);
            PG8_BAR; PG8_WAIT_L(0); PG8_MMA(0, 1, At, B1); PG8_BAR;
            PG8_LDA(At, 1, 1); PG8_STAGE(PG8_SA(1, 0), a3);
            PG8_BAR; PG8_WAIT_L(0); PG8_MMA(1, 0, At, B0); PG8_BAR; PG8_SCHED;
            PG8_STAGE(PG8_SB(1, 1), b3 + hstep);
            PG8_WAIT_V(6); PG8_BAR; PG8_MMA(1, 1, At, B1); PG8_BAR;
        }
        E(acc, cur, wr, wc, fr, fq);
        if (!has_next) break;
#pragma unroll
        for (int a = 0; a < 2; ++a)
#pragma unroll
            for (int b = 0; b < 2; ++b)
#pragma unroll
                for (int m = 0; m < 4; ++m)
#pragma unroll
                    for (int n = 0; n < 2; ++n) acc[a][b][m][n] = (f32x4){0.f, 0.f, 0.f, 0.f};
        cur = nxt; cA = nA; cB = nB; ++ui;
    }
    PG8_WAIT_V(0);
    if (wr == 0) PG8_BAR;
    PG8_BAR;
#undef PG8_SA
#undef PG8_SB
#undef PG8_STAGE
#undef PG8_LDA
#undef PG8_LDB
#undef PG8_MMA
#undef PG8_WAIT_V
#undef PG8_WAIT_L
#undef PG8_BAR
#undef PG8_SCHED
}
}
using pg8::Unit;
typedef f32x4 Acc[2][2][4][2];

__device__ __forceinline__ void st4h(h16* p, f32x4 v) { h16x4 o; o[0] = (h16)v[0]; o[1] = (h16)v[1]; o[2] = (h16)v[2]; o[3] = (h16)v[3]; *(h16x4*)p = o; }
__device__ __forceinline__ f32x4 ld4h(const h16* p) { const h16x4 o = *(const h16x4*)p; return (f32x4){(float)o[0], (float)o[1], (float)o[2], (float)o[3]}; }
__device__ __forceinline__ float sigmoidf_(float x) { return 1.0f / (1.0f + __expf(-x)); }
__device__ __forceinline__ float logsigmoidf_(float z) { return fminf(z, 0.f) - __logf(1.0f + __expf(-fabsf(z))); }
__device__ __forceinline__ float wave_sum(float v) {
#pragma unroll
    for (int o = 1; o < 64; o <<= 1) v += __shfl_xor(v, o);
    return v;
}

struct EpiInProj {
    unsigned char* ws; const float* b_f;
    __device__ __forceinline__ void operator()(const Acc& acc, const Unit& u, int wr, int wc, int fr, int fq) const {
        const int pn = u.pn, row0 = u.pm * 256 + wr * 64 + fr;
        const float* ROPE = (const float*)(ws + WS_ROPE);
#pragma unroll
        for (int ai = 0; ai < 2; ++ai)
#pragma unroll
            for (int m = 0; m < 4; ++m) {
                const int row = row0 + ai * 128 + m * 16, b = row >> 12, t = row & 4095;
                const float* rp = ROPE + (size_t)row * 48;
#pragma unroll
                for (int bj = 0; bj < 2; ++bj) {
                    f32x4 v0 = acc[ai][bj][m][0], v1 = acc[ai][bj][m][1];
                    const int d0 = 32 * wc + 4 * fq;
                    if (pn < 6) {
                        size_t off;
                        if (pn < 4) off = WS_QA + (((size_t)(b * HA + pn * 2 + bj) * T + t) * HD) * 2;
                        else off = (pn == 4 ? WS_KA : WS_VA) + (((size_t)(b * HAKV + bj) * T + t) * HD) * 2;
                        h16* dst = (h16*)(ws + off);
                        if (pn < 5 && wc == 0) {
                            const f32x4 c = *(const f32x4*)(rp + 4 * fq), s = *(const f32x4*)(rp + 16 + 4 * fq);
                            const f32x4 y0 = v0 * c - v1 * s, y1 = v1 * c + v0 * s; v0 = y0; v1 = y1;
                        }
                        st4h(dst + d0, v0); st4h(dst + d0 + 16, v1);
                    } else if (pn < 11) {
                        const bool is_q = pn < 10;
                        if (is_q || bj == 0) {
                            if (is_q || wc < 2) {
                                const int dd = 32 * (wc & 1) + 4 * fq;
                                const size_t off = is_q ? WS_QI + ((size_t)row * 1024 + ((pn - 6) * 4 + 2 * bj + (wc >> 1)) * 64) * 2 : WS_KI + ((size_t)row * 64) * 2;
                                h16* dst = (h16*)(ws + off);
                                if ((wc & 1) == 0) {
                                    f32x4 pr;
#pragma unroll
                                    for (int j = 0; j < 4; ++j) pr[j] = __shfl_xor(v0[j], 32);
                                    const f32x4 c = *(const f32x4*)(rp + 32 + 4 * (fq & 1)), s = *(const f32x4*)(rp + 40 + 4 * (fq & 1));
                                    v0 = (fq < 2) ? (v0 * c - pr * s) : (v0 * c + pr * s);
                                }
                                st4h(dst + dd, v0); st4h(dst + dd + 16, v1);
                            } else if (wc == 2) {
                                *(f32x4*)((float*)(ws + WS_WI) + (size_t)row * 16 + 4 * fq) = v0 * 0.03125f;
                                if (fq < 2) { const f32x4 bf = *(const f32x4*)(b_f + 4 * fq); f32x4 o;
#pragma unroll
                                    for (int j = 0; j < 4; ++j) o[j] = logsigmoidf_(v1[j] + bf[j]);
                                    *(f32x4*)((float*)(ws + WS_LOGF) + (size_t)row * 8 + 4 * fq) = o; }
                            }
                        }
                    } else if (pn < 23) {
                        const int q = pn - 11, which = q >> 2, head = (q & 3) * 2 + bj;
                        h16* dst = (h16*)(ws + WS_QB + (size_t)which * (WS_KB - WS_QB)) + ((size_t)(b * HB + head) * T + t) * HD;
                        st4h(dst + d0, v0); st4h(dst + d0 + 16, v1);
                    } else {
                        const int q = pn - 23; const int col = (q & 7) * 256 + 128 * bj + d0;
                        h16* base = (h16*)(ws + WS_SIGA + (size_t)(q >> 3) * (WS_SIGB - WS_SIGA));
#pragma unroll
                        for (int j = 0; j < 4; ++j) { v0[j] = sigmoidf_(v0[j]); v1[j] = sigmoidf_(v1[j]); }
                        st4h(base + (size_t)row * DM + col, v0); st4h(base + (size_t)row * DM + col + 16, v1);
                    }
                }
            }
    }
};
static_assert(WS_VB - WS_KB == WS_KB - WS_QB, "QB/KB/VB equally spaced");
template <bool FIRST> struct EpiGate {
    const h16* SIG; h16* MIXED;
    __device__ __forceinline__ void operator()(const Acc& acc, const Unit& u, int wr, int wc, int fr, int fq) const {
        const int row0 = u.pm * 256 + wr * 64 + fr, col0 = u.pn * 256 + 32 * wc + 4 * fq;
#pragma unroll
        for (int ai = 0; ai < 2; ++ai)
#pragma unroll
            for (int m = 0; m < 4; ++m)
#pragma unroll
                for (int bj = 0; bj < 2; ++bj)
#pragma unroll
                    for (int n = 0; n < 2; ++n) { const size_t off = (size_t)(row0 + ai * 128 + m * 16) * DM + col0 + bj * 128 + n * 16;
                        f32x4 v = ld4h(SIG + off) * acc[ai][bj][m][n]; if (!FIRST) v += ld4h(MIXED + off); st4h(MIXED + off, v); }
    }
};
struct EpiResid {
    const float* BASE; float* OUT;
    __device__ __forceinline__ void operator()(const Acc& acc, const Unit& u, int wr, int wc, int fr, int fq) const {
        const int row0 = u.pm * 256 + wr * 64 + fr, col0 = u.pn * 256 + 32 * wc + 4 * fq;
#pragma unroll
        for (int ai = 0; ai < 2; ++ai)
#pragma unroll
            for (int m = 0; m < 4; ++m)
#pragma unroll
                for (int bj = 0; bj < 2; ++bj)
#pragma unroll
                    for (int n = 0; n < 2; ++n) { const size_t off = (size_t)(row0 + ai * 128 + m * 16) * DM + col0 + bj * 128 + n * 16;
                        *(f32x4*)(OUT + off) = *(const f32x4*)(BASE + off) + acc[ai][bj][m][n]; }
    }
};
struct EpiSwiGLU {
    h16* ACT;
    __device__ __forceinline__ void operator()(const Acc& acc, const Unit& u, int wr, int wc, int fr, int fq) const {
        const int row0 = u.pm * 256 + wr * 64 + fr;
#pragma unroll
        for (int ai = 0; ai < 2; ++ai)
#pragma unroll
            for (int m = 0; m < 4; ++m)
#pragma unroll
                for (int bj = 0; bj < 2; ++bj) { const f32x4 g = acc[ai][bj][m][0], uu = acc[ai][bj][m][1]; f32x4 o;
#pragma unroll
                    for (int j = 0; j < 4; ++j) o[j] = g[j] * sigmoidf_(g[j]) * uu[j];
                    st4h(ACT + (size_t)(row0 + ai * 128 + m * 16) * DFF + 16 * (u.pn * 8 + bj * 4 + wc) + 4 * fq, o); }
    }
};
struct EpiStoreH {
    h16* O; int ldc;
    __device__ __forceinline__ void operator()(const Acc& acc, const Unit& u, int wr, int wc, int fr, int fq) const {
        const int row0 = u.pm * 256 + wr * 64 + fr, col0 = u.pn * 256 + 32 * wc + 4 * fq;
#pragma unroll
        for (int ai = 0; ai < 2; ++ai)
#pragma unroll
            for (int m = 0; m < 4; ++m)
#pragma unroll
                for (int bj = 0; bj < 2; ++bj)
#pragma unroll
                    for (int n = 0; n < 2; ++n) st4h(O + (size_t)(row0 + ai * 128 + m * 16) * ldc + col0 + bj * 128 + n * 16, acc[ai][bj][m][n]);
    }
};
struct EpiPLE {
    const h16* PP; float* X;
    __device__ __forceinline__ void operator()(const Acc& acc, const Unit& u, int wr, int wc, int fr, int fq) const {
        const int row0 = u.pm * 256 + wr * 64 + fr, col0 = u.pn * 256 + 32 * wc + 4 * fq;
#pragma unroll
        for (int ai = 0; ai < 2; ++ai)
#pragma unroll
            for (int m = 0; m < 4; ++m)
#pragma unroll
                for (int bj = 0; bj < 2; ++bj)
#pragma unroll
                    for (int n = 0; n < 2; ++n) { const size_t off = (size_t)(row0 + ai * 128 + m * 16) * DM + col0 + bj * 128 + n * 16;
                        const f32x4 a = acc[ai][bj][m][n], pp = ld4h(PP + off); f32x4 x = *(const f32x4*)(X + off);
#pragma unroll
                        for (int j = 0; j < 4; ++j) x[j] += sigmoidf_(a[j]) * pp[j];
                        *(f32x4*)(X + off) = x; }
    }
};


__device__ __forceinline__ int map_in(int p) {
    if (p < 2560) return p;
    if (p < 2816) { const int c = p - 2560; if (c < 64) return 2560 + c; if (c < 80) return 2624 + (c - 64); if (c < 88) return 5712 + (c - 80); return -1; }
    const int q = p - 2816; if (q < 3072) return 2640 + q; return 5720 + (q - 3072);
}
template <int MODE>
__device__ __forceinline__ void ph_transpose(const float* W0, const float* W1, int K, int Nsrc, h16* WT, int Nphys, LAS float* scr, int gw, int NGW, int lane) {
    const int nblk = Nphys / 32, nitems = (K / 64) * nblk;
    for (int item = gw; item < nitems; item += NGW) {
        const int kb = item / nblk, nb = item % nblk, k0 = 64 * kb, n0 = 32 * nb;
        const int n = n0 + (lane & 31);
        const float* src = nullptr;
        if (MODE == 0) { if (n < Nsrc) src = W0 + n; }
        else if (MODE == 1) { const int c = map_in(n); if (c >= 0) src = W0 + c; }
        else { src = (((n >> 4) & 1) ? W1 : W0) + 16 * (n >> 5) + (n & 15); }
#pragma unroll 8
        for (int i = 0; i < 32; ++i) { const int kk = 2 * i + (lane >> 5); scr[kk * 33 + (lane & 31)] = src ? src[(size_t)(k0 + kk) * Nsrc] : 0.f; }
        __builtin_amdgcn_wave_barrier(); asm volatile("s_waitcnt lgkmcnt(0)" ::: "memory");
        const int c = lane & 7;
#pragma unroll
        for (int j = 0; j < 4; ++j) { const int nn = (lane >> 3) + 8 * j; const LAS float* s = scr + (8 * c) * 33 + nn;
            h16x8 o;
#pragma unroll
            for (int e = 0; e < 8; ++e) o[e] = (h16)s[e * 33];
            *(h16x8*)(WT + (size_t)(n0 + nn) * K + k0 + 8 * c) = o; }
        __builtin_amdgcn_wave_barrier(); asm volatile("s_waitcnt lgkmcnt(0)" ::: "memory");
    }
}
__device__ __forceinline__ void sincos_f32arg(float ang, float& sn, float& cs) {
    const double a = (double)ang;
    const double rev = a * 0.15915494309189535;
    const double fr = rev - __builtin_rint(rev);
    const double q4 = fr * 4.0; const double qi = __builtin_rint(q4); const int qq = ((int)qi) & 3;
    const double r = (q4 - qi) * 1.5707963267948966;
    const double r2 = r * r;
    const double s = r * (1.0 + r2 * (-1.0 / 6 + r2 * (1.0 / 120 + r2 * (-1.0 / 5040 + r2 * (1.0 / 362880 + r2 * (-1.0 / 39916800))))));
    const double c = 1.0 + r2 * (-0.5 + r2 * (1.0 / 24 + r2 * (-1.0 / 720 + r2 * (1.0 / 40320 + r2 * (-1.0 / 3628800 + r2 * (1.0 / 479001600))))));
    double so, co;
    if (qq == 0) { so = s; co = c; } else if (qq == 1) { so = c; co = -s; } else if (qq == 2) { so = -s; co = -c; } else { so = -c; co = s; }
    sn = (float)so; cs = (float)co;
}
__device__ __forceinline__ void ph_rope(const int* pos, float* ROPE, int gtid, int NGT) {
    for (int idx = gtid; idx < MTOK * 24; idx += NGT) {
        const int tok = idx / 24, i = idx % 24, k = i < 16 ? i : 2 * (i - 16);
        float f = 0x1.000000p+0f;
        f = k == 1 ? 0x1.c2ef76p-2f : f; f = k == 2 ? 0x1.8d275ep-3f : f; f = k == 3 ? 0x1.5dc95ap-4f : f; f = k == 4 ? 0x1.341190p-5f : f; f = k == 5 ? 0x1.0f5384p-6f : f;
        f = k == 6 ? 0x1.ddee9cp-8f : f; f = k == 7 ? 0x1.a4ee3ep-9f : f; f = k == 8 ? 0x1.72ba44p-10f : f; f = k == 9 ? 0x1.468318p-11f : f; f = k == 10 ? 0x1.1f91f0p-12f : f;
        f = k == 11 ? 0x1.fa8b84p-14f : f; f = k == 12 ? 0x1.be218ap-15f : f; f = k == 13 ? 0x1.88ec22p-16f : f; f = k == 14 ? 0x1.5a0f50p-17f : f; f = k == 15 ? 0x1.30c94ep-18f : f;
        const float ang = (float)pos[tok] * f;
        float sn, cs; sincos_f32arg(ang, sn, cs);
        float* rp = ROPE + (size_t)tok * 48;
        if (i < 16) { rp[i] = cs; rp[16 + i] = sn; } else { rp[32 + (i - 16)] = cs; rp[40 + (i - 16)] = sn; }
    }
}
template <bool TO_F32>
__device__ __forceinline__ void ph_rmsnorm(const float* X, const float* g, h16* OUTH, float* OUTF, int gw, int NGW, int lane) {
    for (int row = gw; row < MTOK; row += NGW) {
        const f32x4* xr = (const f32x4*)(X + (size_t)row * DM) + lane;
        f32x4 v[8]; float s = 0.f;
#pragma unroll
        for (int j = 0; j < 8; ++j) { v[j] = xr[64 * j]; s += (v[j][0] * v[j][0] + v[j][1] * v[j][1]) + (v[j][2] * v[j][2] + v[j][3] * v[j][3]); }
        const float r = 1.0f / sqrtf(wave_sum(s) * (1.0f / DM) + EPS);
#pragma unroll
        for (int j = 0; j < 8; ++j) { const f32x4 gg = *((const f32x4*)g + lane + 64 * j); const f32x4 o = v[j] * r * gg;
            if (TO_F32) *((f32x4*)(OUTF + (size_t)row * DM) + lane + 64 * j) = o; else st4h(OUTH + (size_t)row * DM + 4 * (lane + 64 * j), o); }
    }
}
__device__ __forceinline__ void ph_cumsum(const float* LOGF, float* CB, int bh, int lane) {
    const int b = bh >> 3, h = bh & 7;
    float loc[64]; float s = 0.f;
#pragma unroll
    for (int i = 0; i < 64; ++i) { s += LOGF[(size_t)(b * T + lane * 64 + i) * 8 + h]; loc[i] = s; }
    float inc = s;
#pragma unroll
    for (int o = 1; o < 64; o <<= 1) { const float nb = __shfl_up(inc, o); if (lane >= o) inc += nb; }
    const float base = inc - s;
#pragma unroll
    for (int i = 0; i < 64; ++i) CB[(size_t)bh * T + lane * 64 + i] = base + loc[i];
}

__device__ __forceinline__ unsigned fkey(float f) { const unsigned u = __float_as_uint(f + 0.0f); return (u & 0x80000000u) ? ~u : (u | 0x80000000u); }
__device__ __forceinline__ unsigned count_ge(const unsigned (&key)[64], unsigned th) {
    unsigned c = 0;
#pragma unroll
    for (int j = 0; j < 64; ++j) c += (unsigned)__builtin_popcountll(__ballot(key[j] >= th));
    return c;
}
__device__ __forceinline__ u64 topk_select(const unsigned (&key)[64], int nvalid, int lane) {
    u64 myword = 0;
    if (nvalid <= TOPK) {
#pragma unroll
        for (int j = 0; j < 64; ++j) { const u64 bal = __ballot(key[j] != 0u); if (lane == j) myword = bal; }
    } else {
        unsigned th = 0u; bool exact = false;
        for (int bit = 31; bit >= 0; --bit) { const unsigned tc = th | (1u << bit); const unsigned c = count_ge(key, tc); if (c >= (unsigned)TOPK) th = tc; if (c == (unsigned)TOPK) { exact = true; break; } }
        if (exact) {
#pragma unroll
            for (int j = 0; j < 64; ++j) { const u64 bal = __ballot(key[j] >= th); if (lane == j) myword = bal; }
        } else {
            unsigned cgt = 0;
#pragma unroll
            for (int j = 0; j < 64; ++j) cgt += (unsigned)__builtin_popcountll(__ballot(key[j] > th));
            int need = TOPK - (int)cgt;
#pragma unroll
            for (int j = 0; j < 64; ++j) { u64 eq = __ballot(key[j] == th); const u64 gt = __ballot(key[j] > th);
                int pc = __builtin_popcountll(eq);
                while (pc > need) { eq &= ~(1ull << (63 - __builtin_clzll(eq))); --pc; }
                need -= pc; if (lane == j) myword = gt | eq; }
        }
    }
    return myword;
}
__device__ __forceinline__ void ph_topk_naive(const h16* QI, const h16* KI, const float* WI, u64* MASK, LAS float* qs, LAS unsigned* ks, int gw, int NGW, int lane) {
    for (int row = gw; row < MTOK; row += NGW) {
        const int b = row >> 12, t = row & 4095;
        { const h16* qp = QI + (size_t)row * 1024 + lane * 16;
#pragma unroll
          for (int i = 0; i < 16; ++i) qs[lane * 16 + i] = (float)qp[i]; }
        if (lane < 16) qs[1024 + lane] = WI[(size_t)row * 16 + lane];
        __builtin_amdgcn_wave_barrier(); asm volatile("s_waitcnt lgkmcnt(0)" ::: "memory");
#pragma unroll 1
        for (int j = 0; j < 64; ++j) {
            unsigned kk = 0u;
            const int s = 64 * j + lane;
            if (s <= t) {
                float kf[64];
                const h16x8* kp = (const h16x8*)(KI + (size_t)(b * T + s) * 64);
#pragma unroll
                for (int c = 0; c < 8; ++c) { const h16x8 kv = kp[c];
#pragma unroll
                    for (int e = 0; e < 8; ++e) kf[c * 8 + e] = (float)kv[e]; }
                float sc = 0.f;
#pragma unroll 1
                for (int h = 0; h < 16; ++h) { float d = 0.f;
#pragma unroll
                    for (int e = 0; e < 64; ++e) d = fmaf(qs[h * 64 + e], kf[e], d);
                    sc = fmaf(qs[1024 + h], fmaxf(d, 0.f), sc); }
                kk = fkey(sc);
            }
            ks[j * 64 + lane] = kk;
        }
        __builtin_amdgcn_wave_barrier(); asm volatile("s_waitcnt lgkmcnt(0)" ::: "memory");
        unsigned key[64];
#pragma unroll
        for (int j = 0; j < 64; ++j) key[j] = ks[j * 64 + lane];
        MASK[(size_t)row * 64 + lane] = topk_select(key, t + 1, lane);
        __builtin_amdgcn_wave_barrier(); asm volatile("s_waitcnt lgkmcnt(0)" ::: "memory");
    }
}

template <bool MIXB>
__device__ __forceinline__ void ph_attn_naive(const h16* Q, const h16* Kp, const h16* Vp, const u64* MASK, const float* CB, h16* OUT, int task, int lane) {
    const int half = task & 1, tg = 63 - ((task >> 1) & 63), bh = task >> 7, b = bh >> 3, h = bh & 7, t = tg * 64 + lane;
    const int kvh = MIXB ? (b * HB + h) : (b * HAKV + (h >> 2));
    h16x2 q[64];
    { const h16x2* qp = (const h16x2*)(Q + ((size_t)bh * T + t) * HD);
#pragma unroll
      for (int i = 0; i < 64; ++i) q[i] = qp[i]; }
    float o[64];
#pragma unroll
    for (int i = 0; i < 64; ++i) o[i] = 0.f;
    float mrun = -1e30f, l = 0.f;
    const h16* kb = Kp + (size_t)kvh * T * HD; const h16* vb = Vp + (size_t)kvh * T * HD + half * 64;
    if (MIXB) {
        const float* cb = CB + (size_t)bh * T; const float ct = cb[t];
        const int tmax = tg * 64 + 63;
        for (int s = 0; s <= tmax; ++s) {
            const h16x2* kp = (const h16x2*)(kb + (size_t)s * HD);
            float d = 0.f;
#pragma unroll
            for (int i = 0; i < 64; ++i) { const h16x2 kk = kp[i]; d = fmaf((float)q[i][0], (float)kk[0], d); d = fmaf((float)q[i][1], (float)kk[1], d); }
            d = d * ATT_SCALE + (ct - cb[s]);
            if (s > t) d = -__builtin_inff();
            const float mn = fmaxf(mrun, d), al = __expf(mrun - mn), p = __expf(d - mn);
            l = l * al + p; mrun = mn;
            const h16x2* vp = (const h16x2*)(vb + (size_t)s * HD);
#pragma unroll
            for (int i = 0; i < 32; ++i) { const h16x2 vv = vp[i]; o[2 * i] = o[2 * i] * al + p * (float)vv[0]; o[2 * i + 1] = o[2 * i + 1] * al + p * (float)vv[1]; }
        }
    } else {
        const u64* mp = MASK + (size_t)(b * T + t) * 64;
        for (int wj = 0; wj < 64; ++wj) {
            u64 wbits = mp[wj];
            while (wbits) {
                const int s = wj * 64 + __builtin_ctzll(wbits); wbits &= wbits - 1;
                if (s > t) continue;
                const h16x2* kp = (const h16x2*)(kb + (size_t)s * HD);
                float d = 0.f;
#pragma unroll
                for (int i = 0; i < 64; ++i) { const h16x2 kk = kp[i]; d = fmaf((float)q[i][0], (float)kk[0], d); d = fmaf((float)q[i][1], (float)kk[1], d); }
                d *= ATT_SCALE;
                const float mn = fmaxf(mrun, d), al = __expf(mrun - mn), p = __expf(d - mn);
                l = l * al + p; mrun = mn;
                const h16x2* vp = (const h16x2*)(vb + (size_t)s * HD);
#pragma unroll
                for (int i = 0; i < 32; ++i) { const h16x2 vv = vp[i]; o[2 * i] = o[2 * i] * al + p * (float)vv[0]; o[2 * i + 1] = o[2 * i + 1] * al + p * (float)vv[1]; }
            }
        }
    }
    const float rl = 1.0f / l;
    h16* op = OUT + (size_t)(b * T + t) * 1024 + h * HD + half * 64;
#pragma unroll
    for (int i = 0; i < 16; ++i) { f32x4 v = {o[4 * i] * rl, o[4 * i + 1] * rl, o[4 * i + 2] * rl, o[4 * i + 3] * rl}; st4h(op + 4 * i, v); }
}

namespace cg = cooperative_groups;
constexpr int LDS_BYTES = pg8::STAGE_BYTES;
struct Params { const float* in[17]; float* out; unsigned char* ws; };
template <class Epi>
__device__ __forceinline__ void run_gemm(LAS unsigned char* lds, const h16* A, const h16* Bt, int M, int N, int K, const Epi& e) {
    pg8::Gemm g{A, Bt, M, N, K}; pg8::StaticOrder S; S.init(M, N, (int)gridDim.x, (int)blockIdx.x);
    pg8::gemm_phase<Epi>(lds, g, S, e);
}
__global__ void __launch_bounds__(512, 2) mega_fwd(Params P) {
    extern __shared__ __attribute__((aligned(16))) unsigned char lds_raw[];
    LAS unsigned char* lds = (LAS unsigned char*)lds_raw;
    cg::grid_group grid = cg::this_grid();
    const int tid = threadIdx.x, lane = tid & 63, wave = __builtin_amdgcn_readfirstlane(tid >> 6);
    const int gw = blockIdx.x * 8 + wave, NGW = gridDim.x * 8;
    const float* x = P.in[0]; const float* p = P.in[1]; const int* pos = (const int*)P.in[2];
    const float* g_mix = P.in[3]; const float* w_in = P.in[4]; const float* b_f = P.in[5];
    const float* w_o_a = P.in[6]; const float* w_o_b = P.in[7]; const float* w_out = P.in[8];
    const float* g_ffn = P.in[9]; const float* w_g = P.in[10]; const float* w_u = P.in[11]; const float* w_d = P.in[12];
    const float* g_ple = P.in[13]; const float* w_pg = P.in[14]; const float* w_pp = P.in[15]; const float* g_final = P.in[16];
    unsigned char* ws = P.ws; float* out = P.out;
    float* ROPE = (float*)(ws + WS_ROPE); float* CB = (float*)(ws + WS_CB); float* LOGF = (float*)(ws + WS_LOGF); u64* MASK = (u64*)(ws + WS_MASK);
    h16* WIN = (h16*)(ws + WS_WIN); h16* WOA = (h16*)(ws + WS_WOA); h16* WOB = (h16*)(ws + WS_WOB); h16* WOUT = (h16*)(ws + WS_WOUT);
    h16* WGU = (h16*)(ws + WS_WGU); h16* WDN = (h16*)(ws + WS_WDN); h16* WPG = (h16*)(ws + WS_WPG); h16* WPP = (h16*)(ws + WS_WPP);
    h16* QA = (h16*)(ws + WS_QA); h16* KA = (h16*)(ws + WS_KA); h16* VA = (h16*)(ws + WS_VA); h16* QI = (h16*)(ws + WS_QI); h16* KI = (h16*)(ws + WS_KI); float* WI = (float*)(ws + WS_WI);
    h16* QB = (h16*)(ws + WS_QB); h16* KB = (h16*)(ws + WS_KB); h16* VB = (h16*)(ws + WS_VB); h16* SIGA = (h16*)(ws + WS_SIGA); h16* SIGB = (h16*)(ws + WS_SIGB);
    h16* OUTA = (h16*)(ws + WS_OUTA); h16* OUTB = (h16*)(ws + WS_OUTB); h16* P16 = (h16*)(ws + WS_P16);
    h16* MIXED = (h16*)(ws + WS_MIXED); h16* H2 = (h16*)(ws + WS_H2); h16* ACT = (h16*)(ws + WS_ACT); h16* PP = (h16*)(ws + WS_PP);
    h16* H1 = (h16*)P.out;

    { LAS float* scr = (LAS float*)(lds + wave * 8448);
      ph_transpose<1>(w_in, nullptr, DM, N_IN, WIN, N_INP, scr, gw, NGW, lane);
      ph_transpose<0>(w_o_a, nullptr, 1024, DM, WOA, DM, scr, gw, NGW, lane);
      ph_transpose<0>(w_o_b, nullptr, 1024, DM, WOB, DM, scr, gw, NGW, lane);
      ph_transpose<0>(w_out, nullptr, DM, DM, WOUT, DM, scr, gw, NGW, lane);
      ph_transpose<2>(w_g, w_u, DM, DFF, WGU, 2 * DFF, scr, gw, NGW, lane);
      ph_transpose<0>(w_d, nullptr, DFF, DM, WDN, DM, scr, gw, NGW, lane);
      ph_transpose<0>(w_pg, nullptr, DM, DM, WPG, DM, scr, gw, NGW, lane);
      ph_transpose<0>(w_pp, nullptr, DPLE, DM, WPP, DM, scr, gw, NGW, lane);
      ph_rope(pos, ROPE, blockIdx.x * 512 + tid, gridDim.x * 512);
      ph_rmsnorm<false>(x, g_mix, H1, nullptr, gw, NGW, lane);
    }
    grid.sync();
    { EpiInProj e{ws, b_f}; run_gemm(lds, H1, WIN, MTOK, N_INP, DM, e); }
    grid.sync();
    if (gw >= NGW - 16) ph_cumsum(LOGF, CB, NGW - 1 - gw, lane);
    if (wave < 4) ph_topk_naive(QI, KI, WI, MASK, (LAS float*)(lds + wave * 20544), (LAS unsigned*)(lds + wave * 20544 + 4160), blockIdx.x * 4 + wave, gridDim.x * 4, lane);
    for (int i = blockIdx.x * 512 + tid; i < MTOK * DPLE / 4; i += gridDim.x * 512) st4h(P16 + 4 * (size_t)i, *((const f32x4*)p + i));
    grid.sync();
    for (int task = gw; task < 2048; task += NGW) ph_attn_naive<false>(QA, KA, VA, MASK, nullptr, OUTA, task, lane);
    for (int task = gw; task < 2048; task += NGW) ph_attn_naive<true>(QB, KB, VB, nullptr, CB, OUTB, task, lane);
    grid.sync();
    { EpiGate<true> e{SIGA, MIXED}; run_gemm(lds, OUTA, WOA, MTOK, DM, 1024, e); }
    { EpiGate<false> e{SIGB, MIXED}; run_gemm(lds, OUTB, WOB, MTOK, DM, 1024, e); }
    grid.sync();
    { EpiResid e{x, out}; run_gemm(lds, MIXED, WOUT, MTOK, DM, DM, e); }
    grid.sync();
    ph_rmsnorm<false>(out, g_ffn, H2, nullptr, gw, NGW, lane);
    grid.sync();
    { EpiSwiGLU e{ACT}; run_gemm(lds, H2, WGU, MTOK, 2 * DFF, DM, e); }
    grid.sync();
    { EpiResid e{out, out}; run_gemm(lds, ACT, WDN, MTOK, DM, DFF, e); }
    grid.sync();
    ph_rmsnorm<false>(out, g_ple, H2, nullptr, gw, NGW, lane);
    grid.sync();
    { EpiStoreH e{PP, DM}; run_gemm(lds, P16, WPP, MTOK, DM, DPLE, e); }
    { EpiPLE e{PP, out}; run_gemm(lds, H2, WPG, MTOK, DM, DM, e); }
    grid.sync();
    ph_rmsnorm<true>(out, g_final, nullptr, out, gw, NGW, lane);
}

extern "C" void kernel_launch(void* const* d_in, const int* in_sizes, int n_in, void* d_out, int out_size, void* d_ws, size_t ws_size, hipStream_t stream) {
    if (n_in != 17 || out_size != MTOK * DM || ws_size < WS_END) { fprintf(stderr, "kernel_launch: unexpected shapes / workspace (%d inputs, out %d, ws %zu)\n", n_in, out_size, ws_size); return; }
    static int grid_blocks = 0;
    if (!grid_blocks) {
        int dev = 0, cus = 0, per_cu = 0;
        (void)hipGetDevice(&dev);
        (void)hipDeviceGetAttribute(&cus, hipDeviceAttributeMultiprocessorCount, dev);
        (void)hipFuncSetAttribute((const void*)mega_fwd, hipFuncAttributeMaxDynamicSharedMemorySize, LDS_BYTES);
        (void)hipOccupancyMaxActiveBlocksPerMultiprocessor(&per_cu, (const void*)mega_fwd, 512, LDS_BYTES);
        if (per_cu < 1) { fprintf(stderr, "kernel_launch: occupancy query says %d blocks per CU\n", per_cu); per_cu = 1; }
        if (per_cu > 1) per_cu = 1;
        grid_blocks = cus * per_cu;
    }
    Params prm{};
    for (int i = 0; i < 17; ++i) prm.in[i] = (const float*)d_in[i];
    prm.out = (float*)d_out; prm.ws = (unsigned char*)d_ws;
    void* args[] = {&prm};
    hipError_t e = hipLaunchCooperativeKernel((const void*)mega_fwd, dim3(grid_blocks), dim3(512), args, LDS_BYTES, stream);
    if (e != hipSuccess) fprintf(stderr, "cooperative launch failed: %s (grid %d)\n", hipGetErrorString(e), grid_blocks);
}
```

```cpp
#include <hip/hip_runtime.h>
#include <hip/hip_cooperative_groups.h>
#include <stdint.h>
#include <cstdio>

#define LAS __attribute__((address_space(3)))
typedef _Float16 h16;
typedef _Float16 h16x8 __attribute__((ext_vector_type(8)));
typedef _Float16 h16x4 __attribute__((ext_vector_type(4)));
typedef _Float16 h16x2 __attribute__((ext_vector_type(2)));
typedef float f32x4 __attribute__((ext_vector_type(4)));
typedef float f32x2 __attribute__((ext_vector_type(2)));
typedef unsigned u32x4 __attribute__((ext_vector_type(4)));
typedef unsigned u32x2 __attribute__((ext_vector_type(2)));
typedef unsigned long long u64;

constexpr int NBATCH = 2, T = 4096, MTOK = NBATCH * T, DM = 2048;
constexpr int HA = 8, HAKV = 2, HIDX = 16, DIDX = 64, HB = 8, HD = 128;
constexpr int N_IN = 9816, N_INP = 9984, DFF = 5632, DPLE = 256, TOPK = 256;
constexpr float EPS = 1e-6f;
constexpr float ATT_SCALE = 0.08838834764831845f;

constexpr size_t MiB = 1u << 20;
constexpr size_t WS_CTL = 0;
constexpr size_t WS_ROPE = 1 * MiB;
constexpr size_t WS_CB = 3 * MiB;
constexpr size_t WS_LOGF = 3 * MiB + 512 * 1024;
constexpr size_t WS_MASK = 4 * MiB;
constexpr size_t WS_WIN = 8 * MiB;
constexpr size_t WS_OUTA = 8 * MiB, WS_OUTB = 24 * MiB, WS_P16 = 40 * MiB;
constexpr size_t WS_WOA = 47 * MiB, WS_WOB = 51 * MiB, WS_WOUT = 55 * MiB, WS_WGU = 63 * MiB, WS_WDN = 107 * MiB, WS_WPG = 129 * MiB, WS_WPP = 137 * MiB;
constexpr size_t WS_QA = 138 * MiB, WS_KA = 154 * MiB, WS_VA = 158 * MiB, WS_QI = 162 * MiB, WS_KI = 178 * MiB, WS_WI = 179 * MiB;
constexpr size_t WS_QB = 180 * MiB, WS_KB = 196 * MiB, WS_VB = 212 * MiB, WS_SIGA = 228 * MiB, WS_SIGB = 260 * MiB, WS_NBQ = 292 * MiB, WS_END = 296 * MiB;
constexpr size_t WS_MIXED = WS_QB;
constexpr size_t WS_H2 = WS_QA;
constexpr size_t WS_ACT = WS_QB;
constexpr size_t WS_PP = WS_QB;

namespace pg8 {
constexpr int BM = 256, BK = 64, HALF = 128, HTB = HALF * BK * 2, STAGE_BYTES = 8 * HTB, NXCD = 8, WGM = 8;
__host__ __device__ __forceinline__ int lds_byte(int r, int c) { const int st = (r >> 4) * 2 + (c >> 5), rr = r & 15, cc = c & 31, ob = rr * 64 + cc * 2; return st * 1024 + (ob ^ (((ob >> 9) & 1) << 5)); }
__host__ __device__ __forceinline__ void stage_rc(int b, int& R, int& C) { const int st = b / 1024, sb = b % 1024, swz = sb ^ (((sb >> 9) & 1) << 5); R = (st >> 1) * 16 + swz / 64; C = (st & 1) * 32 + (swz % 64) / 2; }
struct Unit { int pm, pn; };
struct Gemm { const h16* A; const h16* Bt; int M, N, K; };
struct StaticOrder {
    int nM, nN, nwg, G, c;
    __host__ __device__ void init(int M, int N, int G_, int c_) { nM = M / BM; nN = N / BM; nwg = nM * nN; G = G_; c = c_; }
    __host__ __device__ bool next(int i, Unit& u) const {
        const long L = (long)i * G + c; if (L >= nwg) return false;
        int wgid = (int)L; { const int q = nwg / NXCD, r = nwg % NXCD, xcd = wgid % NXCD, off = wgid / NXCD; wgid = (xcd < r ? xcd * (q + 1) : r * (q + 1) + (xcd - r) * q) + off; }
        const int nig = WGM * nN, gid = wgid / nig, fm = gid * WGM, gsz = (nM - fm) < WGM ? (nM - fm) : WGM;
        u.pm = fm + ((wgid % nig) % gsz); u.pn = (wgid % nig) / gsz; return true;
    }
};
template <class Epi>
__device__ __forceinline__ void gemm_phase(LAS unsigned char* lds, const Gemm g, const StaticOrder& S, const Epi& E) {
    int tid = threadIdx.x; asm volatile("" : "+v"(tid));
    const int wid = __builtin_amdgcn_readfirstlane(tid >> 6), lane = tid & 63, wr = wid >> 2, wc = wid & 3, fr = lane & 15, fq = lane >> 4;
    const int K = g.K, nt = K / BK;
    unsigned voffA[2];
#pragma unroll
    for (int i = 0; i < 2; ++i) { int R, C; stage_rc(tid * 16 + i * 8192, R, C); voffA[i] = (unsigned)(R * K + C) * 2u; }
    const size_t kstep = (size_t)(BK * 2);
    const size_t hstep = (size_t)HALF * K * 2;
    const size_t tstep = 2 * hstep;
    const unsigned ldsw = (unsigned)wid * 1024u;
    const int aoff = lds_byte(wr * 64 + fr, fq * 8), boff = lds_byte(wc * 32 + fr, fq * 8);
#define PG8_SA(b, h) (((b) * 2 + (h)) * HTB)
#define PG8_SB(b, h) ((4 + (b) * 2 + (h)) * HTB)
#define PG8_STAGE(bufoff, gbase) do { _Pragma("unroll") for (int _i = 0; _i < 2; ++_i) \
        __builtin_amdgcn_global_load_lds((const unsigned*)((const char*)(gbase) + voffA[_i]), (LAS unsigned*)(lds + (bufoff) + ldsw + _i * 8192), 16, 0, 0); } while (0)
#define PG8_LDA(dst, b, h) do { _Pragma("unroll") for (int m = 0; m < 4; ++m) _Pragma("unroll") for (int k = 0; k < 2; ++k) dst[m][k] = *(const LAS h16x8*)(lds + PG8_SA(b, h) + aoff + m * 2048 + k * 1024); } while (0)
#define PG8_LDB(dst, b, h) do { _Pragma("unroll") for (int n = 0; n < 2; ++n) _Pragma("unroll") for (int k = 0; k < 2; ++k) dst[n][k] = *(const LAS h16x8*)(lds + PG8_SB(b, h) + boff + n * 2048 + k * 1024); } while (0)
#define PG8_MMA(ai, bj, At, Bt) do { __builtin_amdgcn_s_setprio(1); _Pragma("unroll") for (int m = 0; m < 4; ++m) _Pragma("unroll") for (int n = 0; n < 2; ++n) _Pragma("unroll") for (int k = 0; k < 2; ++k) \
        acc[ai][bj][m][n] = __builtin_amdgcn_mfma_f32_16x16x32_f16(Bt[n][k], At[m][k], acc[ai][bj][m][n], 0, 0, 0); __builtin_amdgcn_s_setprio(0); } while (0)
#define PG8_WAIT_V(n) asm volatile("s_waitcnt vmcnt(" #n ")" ::: "memory")
#define PG8_WAIT_L(n) asm volatile("s_waitcnt lgkmcnt(" #n ")" ::: "memory")
#define PG8_BAR __builtin_amdgcn_s_barrier()
#define PG8_SCHED __builtin_amdgcn_sched_barrier(0)
    Unit cur, nxt; int ui = 0;
    if (!S.next(0, cur)) return;
    f32x4 acc[2][2][4][2];
#pragma unroll
    for (int a = 0; a < 2; ++a)
#pragma unroll
        for (int b = 0; b < 2; ++b)
#pragma unroll
            for (int m = 0; m < 4; ++m)
#pragma unroll
                for (int n = 0; n < 2; ++n) acc[a][b][m][n] = (f32x4){0.f, 0.f, 0.f, 0.f};
    h16x8 At[4][2], B0[2][2], B1[2][2];
    const char* cA = (const char*)g.A + (size_t)cur.pm * tstep; const char* cB = (const char*)g.Bt + (size_t)cur.pn * tstep;
    PG8_STAGE(PG8_SB(0, 0), cB); PG8_STAGE(PG8_SA(0, 0), cA); PG8_STAGE(PG8_SB(0, 1), cB + hstep); PG8_STAGE(PG8_SA(0, 1), cA + hstep);
    if (wr == 1) PG8_BAR;
    PG8_WAIT_V(4); PG8_BAR;
    PG8_STAGE(PG8_SB(1, 0), cB + kstep); PG8_STAGE(PG8_SA(1, 0), cA + kstep); PG8_STAGE(PG8_SB(1, 1), cB + hstep + kstep);
    PG8_WAIT_V(6); PG8_BAR;
    for (;;) {
        const bool has_next = S.next(ui + 1, nxt);
        const char* nA = has_next ? (const char*)g.A + (size_t)nxt.pm * tstep : cA; const char* nB = has_next ? (const char*)g.Bt + (size_t)nxt.pn * tstep : cB;
        for (int t = 0; t < nt; t += 2) {
            const bool last = (t == nt - 2);
            const char* a1 = cA + (size_t)(t + 1) * kstep;
            const char* a2 = last ? nA : cA + (size_t)(t + 2) * kstep; const char* b2 = last ? nB : cB + (size_t)(t + 2) * kstep;
            const char* a3 = a2 + kstep; const char* b3 = b2 + kstep;
            PG8_LDB(B0, 0, 0); PG8_SCHED; PG8_LDA(At, 0, 0); PG8_STAGE(PG8_SA(1, 1), a1 + hstep);
            PG8_WAIT_L(8); PG8_BAR; PG8_WAIT_L(0); PG8_MMA(0, 0, At, B0); PG8_BAR; PG8_SCHED;
            PG8_LDB(B1, 0, 1); PG8_STAGE(PG8_SB(0, 0), b2);
            PG8_BAR; PG8_WAIT_L(0); PG8_MMA(0, 1, At, B1); PG8_BAR;
            PG8_LDA(At, 0, 1); PG8_STAGE(PG8_SA(0, 0), a2);
            PG8_BAR; PG8_WAIT_L(0); PG8_MMA(1, 0, At, B0); PG8_BAR; PG8_SCHED;
            PG8_STAGE(PG8_SB(0, 1), b2 + hstep);
            PG8_WAIT_V(6); PG8_BAR; PG8_MMA(1, 1, At, B1); PG8_BAR;
            PG8_LDB(B0, 1, 0); PG8_SCHED; PG8_LDA(At, 1, 0); PG8_STAGE(PG8_SA(0, 1), a2 + hstep);
            PG8_WAIT_L(8); PG8_BAR; PG8_WAIT_L(0); PG8_MMA(0, 0, At, B0); PG8_BAR; PG8_SCHED;
            PG8_LDB(B1, 1, 1); PG8_STAGE(PG8_SB(1, 0), b3);
            PG8_BAR; PG8_WAIT_L(0); PG8_MMA(0, 1, At, B1); PG8_BAR;
            PG8_LDA(At, 1, 1); PG8_STAGE(PG8_SA(1, 0), a3);
            PG8_BAR; PG8_WAIT_L(0); PG8_MMA(1, 0, At, B0); PG8_BAR; PG8_SCHED;
            PG8_STAGE(PG8_SB(1, 1), b3 + hstep);
            PG8_WAIT_V(6); PG8_BAR; PG8_MMA(1, 1, At, B1); PG8_BAR;
        }
        E(acc, cur, wr, wc, fr, fq);
        if (!has_next) break;
#pragma unroll
        for (int a = 0; a < 2; ++a)
#pragma unroll
            for (int b = 0; b < 2; ++b)
#pragma unroll
                for (int m = 0; m < 4; ++m)
#pragma unroll
                    for (int n = 0; n < 2; ++n) acc[a][b][m][n] = (f32x4){0.f, 0.f, 0.f, 0.f};
        cur = nxt; cA = nA; cB = nB; ++ui;
    }
    PG8_WAIT_V(0);
    if (wr == 0) PG8_BAR;
    PG8_BAR;
#undef PG8_SA
#undef PG8_SB
#undef PG8_STAGE
#undef PG8_LDA
#undef PG8_LDB
#undef PG8_MMA
#undef PG8_WAIT_V
#undef PG8_WAIT_L
#undef PG8_BAR
#undef PG8_SCHED
}
}
using pg8::Unit;
typedef f32x4 Acc[2][2][4][2];

__device__ __forceinline__ void st4h(h16* p, f32x4 v) { h16x4 o; o[0] = (h16)v[0]; o[1] = (h16)v[1]; o[2] = (h16)v[2]; o[3] = (h16)v[3]; *(h16x4*)p = o; }
__device__ __forceinline__ f32x4 ld4h(const h16* p) { const h16x4 o = *(const h16x4*)p; return (f32x4){(float)o[0], (float)o[1], (float)o[2], (float)o[3]}; }
__device__ __forceinline__ float sigmoidf_(float x) { return 1.0f / (1.0f + __expf(-x)); }
__device__ __forceinline__ float logsigmoidf_(float z) { return fminf(z, 0.f) - __logf(1.0f + __expf(-fabsf(z))); }
__device__ __forceinline__ float wave_sum(float v) {
#pragma unroll
    for (int o = 1; o < 64; o <<= 1) v += __shfl_xor(v, o);
    return v;
}

struct EpiInProj {
    unsigned char* ws; const float* b_f;
    __device__ __forceinline__ void operator()(const Acc& acc, const Unit& u, int wr, int wc, int fr, int fq) const {
        const int pn = u.pn, row0 = u.pm * 256 + wr * 64 + fr;
        const float* ROPE = (const float*)(ws + WS_ROPE);
#pragma unroll
        for (int ai = 0; ai < 2; ++ai)
#pragma unroll
            for (int m = 0; m < 4; ++m) {
                const int row = row0 + ai * 128 + m * 16, b = row >> 12, t = row & 4095;
                const float* rp = ROPE + (size_t)row * 48;
#pragma unroll
                for (int bj = 0; bj < 2; ++bj) {
                    f32x4 v0 = acc[ai][bj][m][0], v1 = acc[ai][bj][m][1];
                    const int d0 = 32 * wc + 4 * fq;
                    if (pn < 6) {
                        size_t off;
                        if (pn < 4) off = WS_QA + (((size_t)(b * HA + pn * 2 + bj) * T + t) * HD) * 2;
                        else off = (pn == 4 ? WS_KA : WS_VA) + (((size_t)(b * HAKV + bj) * T + t) * HD) * 2;
                        h16* dst = (h16*)(ws + off);
                        if (pn < 5 && wc == 0) {
                            const f32x4 c = *(const f32x4*)(rp + 4 * fq), s = *(const f32x4*)(rp + 16 + 4 * fq);
                            const f32x4 y0 = v0 * c - v1 * s, y1 = v1 * c + v0 * s; v0 = y0; v1 = y1;
                        }
                        st4h(dst + d0, v0); st4h(dst + d0 + 16, v1);
                    } else if (pn < 11) {
                        const bool is_q = pn < 10;
                        if (is_q || bj == 0) {
                            if (is_q || wc < 2) {
                                const int dd = 32 * (wc & 1) + 4 * fq;
                                const size_t off = is_q ? WS_QI + ((size_t)row * 1024 + ((pn - 6) * 4 + 2 * bj + (wc >> 1)) * 64) * 2 : WS_KI + ((size_t)row * 64) * 2;
                                h16* dst = (h16*)(ws + off);
                                if ((wc & 1) == 0) {
                                    f32x4 pr;
#pragma unroll
                                    for (int j = 0; j < 4; ++j) pr[j] = __shfl_xor(v0[j], 32);
                                    const f32x4 c = *(const f32x4*)(rp + 32 + 4 * (fq & 1)), s = *(const f32x4*)(rp + 40 + 4 * (fq & 1));
                                    v0 = (fq < 2) ? (v0 * c - pr * s) : (v0 * c + pr * s);
                                }
                                st4h(dst + dd, v0); st4h(dst + dd + 16, v1);
                            } else if (wc == 2) {
                                *(f32x4*)((float*)(ws + WS_WI) + (size_t)row * 16 + 4 * fq) = v0 * 0.03125f;
                                if (fq < 2) { const f32x4 bf = *(const f32x4*)(b_f + 4 * fq); f32x4 o;
#pragma unroll
                                    for (int j = 0; j < 4; ++j) o[j] = logsigmoidf_(v1[j] + bf[j]);
                                    *(f32x4*)((float*)(ws + WS_LOGF) + (size_t)row * 8 + 4 * fq) = o; }
                            }
                        }
                    } else if (pn < 23) {
                        const int q = pn - 11, which = q >> 2, head = (q & 3) * 2 + bj;
                        h16* dst = (h16*)(ws + WS_QB + (size_t)which * (WS_KB - WS_QB)) + ((size_t)(b * HB + head) * T + t) * HD;
                        st4h(dst + d0, v0); st4h(dst + d0 + 16, v1);
                    } else {
                        const int q = pn - 23; const int col = (q & 7) * 256 + 128 * bj + d0;
                        h16* base = (h16*)(ws + WS_SIGA + (size_t)(q >> 3) * (WS_SIGB - WS_SIGA));
#pragma unroll
                        for (int j = 0; j < 4; ++j) { v0[j] = sigmoidf_(v0[j]); v1[j] = sigmoidf_(v1[j]); }
                        st4h(base + (size_t)row * DM + col, v0); st4h(base + (size_t)row * DM + col + 16, v1);
                    }
                }
            }
    }
};
static_assert(WS_VB - WS_KB == WS_KB - WS_QB, "QB/KB/VB equally spaced");
template <bool FIRST> struct EpiGate {
    const h16* SIG; h16* MIXED;
    __device__ __forceinline__ void operator()(const Acc& acc, const Unit& u, int wr, int wc, int fr, int fq) const {
        const int row0 = u.pm * 256 + wr * 64 + fr, col0 = u.pn * 256 + 32 * wc + 4 * fq;
#pragma unroll
        for (int ai = 0; ai < 2; ++ai)
#pragma unroll
            for (int m = 0; m < 4; ++m)
#pragma unroll
                for (int bj = 0; bj < 2; ++bj)
#pragma unroll
                    for (int n = 0; n < 2; ++n) { const size_t off = (size_t)(row0 + ai * 128 + m * 16) * DM + col0 + bj * 128 + n * 16;
                        f32x4 v = ld4h(SIG + off) * acc[ai][bj][m][n]; if (!FIRST) v += ld4h(MIXED + off); st4h(MIXED + off, v); }
    }
};
struct EpiResid {
    const float* BASE; float* OUT;
    __device__ __forceinline__ void operator()(const Acc& acc, const Unit& u, int wr, int wc, int fr, int fq) const {
        const int row0 = u.pm * 256 + wr * 64 + fr, col0 = u.pn * 256 + 32 * wc + 4 * fq;
#pragma unroll
        for (int ai = 0; ai < 2; ++ai)
#pragma unroll
            for (int m = 0; m < 4; ++m)
#pragma unroll
                for (int bj = 0; bj < 2; ++bj)
#pragma unroll
                    for (int n = 0; n < 2; ++n) { const size_t off = (size_t)(row0 + ai * 128 + m * 16) * DM + col0 + bj * 128 + n * 16;
                        *(f32x4*)(OUT + off) = *(const f32x4*)(BASE + off) + acc[ai][bj][m][n]; }
    }
};
struct EpiSwiGLU {
    h16* ACT;
    __device__ __forceinline__ void operator()(const Acc& acc, const Unit& u, int wr, int wc, int fr, int fq) const {
        const int row0 = u.pm * 256 + wr * 64 + fr;
#pragma unroll
        for (int ai = 0; ai < 2; ++ai)
#pragma unroll
            for (int m = 0; m < 4; ++m)
#pragma unroll
                for (int bj = 0; bj < 2; ++bj) { const f32x4 g = acc[ai][bj][m][0], uu = acc[ai][bj][m][1]; f32x4 o;
#pragma unroll
                    for (int j = 0; j < 4; ++j) o[j] = g[j] * sigmoidf_(g[j]) * uu[j];
                    st4h(ACT + (size_t)(row0 + ai * 128 + m * 16) * DFF + 16 * (u.pn * 8 + bj * 4 + wc) + 4 * fq, o); }
    }
};
struct EpiStoreH {
    h16* O; int ldc;
    __device__ __forceinline__ void operator()(const Acc& acc, const Unit& u, int wr, int wc, int fr, int fq) const {
        const int row0 = u.pm * 256 + wr * 64 + fr, col0 = u.pn * 256 + 32 * wc + 4 * fq;
#pragma unroll
        for (int ai = 0; ai < 2; ++ai)
#pragma unroll
            for (int m = 0; m < 4; ++m)
#pragma unroll
                for (int bj = 0; bj < 2; ++bj)
#pragma unroll
                    for (int n = 0; n < 2; ++n) st4h(O + (size_t)(row0 + ai * 128 + m * 16) * ldc + col0 + bj * 128 + n * 16, acc[ai][bj][m][n]);
    }
};
struct EpiPLE {
    const h16* PP; float* X;
    __device__ __forceinline__ void operator()(const Acc& acc, const Unit& u, int wr, int wc, int fr, int fq) const {
        const int row0 = u.pm * 256 + wr * 64 + fr, col0 = u.pn * 256 + 32 * wc + 4 * fq;
#pragma unroll
        for (int ai = 0; ai < 2; ++ai)
#pragma unroll
            for (int m = 0; m < 4; ++m)
#pragma unroll
                for (int bj = 0; bj < 2; ++bj)
#pragma unroll
                    for (int n = 0; n < 2; ++n) { const size_t off = (size_t)(row0 + ai * 128 + m * 16) * DM + col0 + bj * 128 + n * 16;
                        const f32x4 a = acc[ai][bj][m][n], pp = ld4h(PP + off); f32x4 x = *(const f32x4*)(X + off);
#pragma unroll
                        for (int j = 0; j < 4; ++j) x[j] += sigmoidf_(a[j]) * pp[j];
                        *(f32x4*)(X + off) = x; }
    }
};


__device__ __forceinline__ int map_in(int p) {
    if (p < 2560) return p;
    if (p < 2816) { const int c = p - 2560; if (c < 64) return 2560 + c; if (c < 80) return 2624 + (c - 64); if (c < 88) return 5712 + (c - 80); return -1; }
    const int q = p - 2816; if (q < 3072) return 2640 + q; return 5720 + (q - 3072);
}
template <int MODE>
__device__ __forceinline__ void ph_transpose(const float* W0, const float* W1, int K, int Nsrc, h16* WT, int Nphys, LAS float* scr, int gw, int NGW, int lane) {
    const int nblk = Nphys / 32, nitems = (K / 64) * nblk;
    for (int item = gw; item < nitems; item += NGW) {
        const int kb = item / nblk, nb = item % nblk, k0 = 64 * kb, n0 = 32 * nb;
        const int n = n0 + (lane & 31);
        const float* src = nullptr;
        if (MODE == 0) { if (n < Nsrc) src = W0 + n; }
        else if (MODE == 1) { const int c = map_in(n); if (c >= 0) src = W0 + c; }
        else { src = (((n >> 4) & 1) ? W1 : W0) + 16 * (n >> 5) + (n & 15); }
#pragma unroll 8
        for (int i = 0; i < 32; ++i) { const int kk = 2 * i + (lane >> 5); scr[kk * 33 + (lane & 31)] = src ? src[(size_t)(k0 + kk) * Nsrc] : 0.f; }
        __builtin_amdgcn_wave_barrier(); asm volatile("s_waitcnt lgkmcnt(0)" ::: "memory");
        const int c = lane & 7;
#pragma unroll
        for (int j = 0; j < 4; ++j) { const int nn = (lane >> 3) + 8 * j; const LAS float* s = scr + (8 * c) * 33 + nn;
            h16x8 o;
#pragma unroll
            for (int e = 0; e < 8; ++e) o[e] = (h16)s[e * 33];
            *(h16x8*)(WT + (size_t)(n0 + nn) * K + k0 + 8 * c) = o; }
        __builtin_amdgcn_wave_barrier(); asm volatile("s_waitcnt lgkmcnt(0)" ::: "memory");
    }
}
__device__ __forceinline__ void sincos_f32arg(float ang, float& sn, float& cs) {
    const double a = (double)ang;
    const double rev = a * 0.15915494309189535;
    const double fr = rev - __builtin_rint(rev);
    const double q4 = fr * 4.0; const double qi = __builtin_rint(q4); const int qq = ((int)qi) & 3;
    const double r = (q4 - qi) * 1.5707963267948966;
    const double r2 = r * r;
    const double s = r * (1.0 + r2 * (-1.0 / 6 + r2 * (1.0 / 120 + r2 * (-1.0 / 5040 + r2 * (1.0 / 362880 + r2 * (-1.0 / 39916800))))));
    const double c = 1.0 + r2 * (-0.5 + r2 * (1.0 / 24 + r2 * (-1.0 / 720 + r2 * (1.0 / 40320 + r2 * (-1.0 / 3628800 + r2 * (1.0 / 479001600))))));
    double so, co;
    if (qq == 0) { so = s; co = c; } else if (qq == 1) { so = c; co = -s; } else if (qq == 2) { so = -s; co = -c; } else { so = -c; co = s; }
    sn = (float)so; cs = (float)co;
}
__device__ __forceinline__ void ph_rope(const int* pos, float* ROPE, int gtid, int NGT) {
    for (int idx = gtid; idx < MTOK * 24; idx += NGT) {
        const int tok = idx / 24, i = idx % 24, k = i < 16 ? i : 2 * (i - 16);
        float f = 0x1.000000p+0f;
        f = k == 1 ? 0x1.c2ef76p-2f : f; f = k == 2 ? 0x1.8d275ep-3f : f; f = k == 3 ? 0x1.5dc95ap-4f : f; f = k == 4 ? 0x1.341190p-5f : f; f = k == 5 ? 0x1.0f5384p-6f : f;
        f = k == 6 ? 0x1.ddee9cp-8f : f; f = k == 7 ? 0x1.a4ee3ep-9f : f; f = k == 8 ? 0x1.72ba44p-10f : f; f = k == 9 ? 0x1.468318p-11f : f; f = k == 10 ? 0x1.1f91f0p-12f : f;
        f = k == 11 ? 0x1.fa8b84p-14f : f; f = k == 12 ? 0x1.be218ap-15f : f; f = k == 13 ? 0x1.88ec22p-16f : f; f = k == 14 ? 0x1.5a0f50p-17f : f; f = k == 15 ? 0x1.30c94ep-18f : f;
        const float ang = (float)pos[tok] * f;
        float sn, cs; sincos_f32arg(ang, sn, cs);
        float* rp = ROPE + (size_t)tok * 48;
        if (i < 16) { rp[i] = cs; rp[16 + i] = sn; } else { rp[32 + (i - 16)] = cs; rp[40 + (i - 16)] = sn; }
    }
}
template <bool TO_F32>
__device__ __forceinline__ void ph_rmsnorm(const float* X, const float* g, h16* OUTH, float* OUTF, int gw, int NGW, int lane) {
    for (int row = gw; row < MTOK; row += NGW) {
        const f32x4* xr = (const f32x4*)(X + (size_t)row * DM) + lane;
        f32x4 v[8]; float s = 0.f;
#pragma unroll
        for (int j = 0; j < 8; ++j) { v[j] = xr[64 * j]; s += (v[j][0] * v[j][0] + v[j][1] * v[j][1]) + (v[j][2] * v[j][2] + v[j][3] * v[j][3]); }
        const float r = 1.0f / sqrtf(wave_sum(s) * (1.0f / DM) + EPS);
#pragma unroll
        for (int j = 0; j < 8; ++j) { const f32x4 gg = *((const f32x4*)g + lane + 64 * j); const f32x4 o = v[j] * r * gg;
            if (TO_F32) *((f32x4*)(OUTF + (size_t)row * DM) + lane + 64 * j) = o; else st4h(OUTH + (size_t)row * DM + 4 * (lane + 64 * j), o); }
    }
}
__device__ __forceinline__ void ph_cumsum(const float* LOGF, float* CB, float* NBQ, int bh, int lane) {
    const int b = bh >> 3, h = bh & 7;
    float loc[64]; float s = 0.f;
#pragma unroll
    for (int i = 0; i < 64; ++i) { s += LOGF[(size_t)(b * T + lane * 64 + i) * 8 + h]; loc[i] = s; }
    float inc = s;
#pragma unroll
    for (int o = 1; o < 64; o <<= 1) { const float nb = __shfl_up(inc, o); if (lane >= o) inc += nb; }
    const float base = inc - s;
#pragma unroll
    for (int i = 0; i < 64; ++i) { loc[i] += base; CB[(size_t)bh * T + lane * 64 + i] = loc[i]; }
#pragma unroll 1
    for (int qb = 0; qb < 16; ++qb) {
        const float ref = __shfl(loc[63], 4 * qb + 3);
        if (lane < 4 * (qb + 1)) { float* dst = NBQ + ((size_t)bh * 16 + qb) * T + lane * 64;
#pragma unroll
            for (int i = 0; i < 64; ++i) dst[i] = (ref - loc[i]) * 11.313708498984761f; }
    }
}

__device__ __forceinline__ unsigned fkey(float f) { const unsigned u = __float_as_uint(f + 0.0f); return (u & 0x80000000u) ? ~u : (u | 0x80000000u); }
__device__ __forceinline__ unsigned count_ge(const unsigned (&key)[64], unsigned th) {
    unsigned c = 0;
#pragma unroll
    for (int j = 0; j < 64; ++j) c += (unsigned)__builtin_popcountll(__ballot(key[j] >= th));
    return c;
}
__device__ __forceinline__ u64 topk_select(const unsigned (&key)[64], int nvalid, int lane) {
    u64 myword = 0;
    if (nvalid <= TOPK) {
#pragma unroll
        for (int j = 0; j < 64; ++j) { const u64 bal = __ballot(key[j] != 0u); if (lane == j) myword = bal; }
    } else {
        unsigned th = 0u; bool exact = false;
        for (int bit = 31; bit >= 0; --bit) { const unsigned tc = th | (1u << bit); const unsigned c = count_ge(key, tc); if (c >= (unsigned)TOPK) th = tc; if (c == (unsigned)TOPK) { exact = true; break; } }
        if (exact) {
#pragma unroll
            for (int j = 0; j < 64; ++j) { const u64 bal = __ballot(key[j] >= th); if (lane == j) myword = bal; }
        } else {
            unsigned cgt = 0;
#pragma unroll
            for (int j = 0; j < 64; ++j) cgt += (unsigned)__builtin_popcountll(__ballot(key[j] > th));
            int need = TOPK - (int)cgt;
#pragma unroll
            for (int j = 0; j < 64; ++j) { u64 eq = __ballot(key[j] == th); const u64 gt = __ballot(key[j] > th);
                int pc = __builtin_popcountll(eq);
                while (pc > need) { eq &= ~(1ull << (63 - __builtin_clzll(eq))); --pc; }
                need -= pc; if (lane == j) myword = gt | eq; }
        }
    }
    return myword;
}
__device__ __forceinline__ void ph_topk_naive(const h16* QI, const h16* KI, const float* WI, u64* MASK, LAS float* qs, LAS unsigned* ks, int gw, int NGW, int lane) {
    for (int row = gw; row < MTOK; row += NGW) {
        const int b = row >> 12, t = row & 4095;
        { const h16* qp = QI + (size_t)row * 1024 + lane * 16;
#pragma unroll
          for (int i = 0; i < 16; ++i) qs[lane * 16 + i] = (float)qp[i]; }
        if (lane < 16) qs[1024 + lane] = WI[(size_t)row * 16 + lane];
        __builtin_amdgcn_wave_barrier(); asm volatile("s_waitcnt lgkmcnt(0)" ::: "memory");
#pragma unroll 1
        for (int j = 0; j < 64; ++j) {
            unsigned kk = 0u;
            const int s = 64 * j + lane;
            if (s <= t) {
                float kf[64];
                const h16x8* kp = (const h16x8*)(KI + (size_t)(b * T + s) * 64);
#pragma unroll
                for (int c = 0; c < 8; ++c) { const h16x8 kv = kp[c];
#pragma unroll
                    for (int e = 0; e < 8; ++e) kf[c * 8 + e] = (float)kv[e]; }
                float sc = 0.f;
#pragma unroll 1
                for (int h = 0; h < 16; ++h) { float d = 0.f;
#pragma unroll
                    for (int e = 0; e < 64; ++e) d = fmaf(qs[h * 64 + e], kf[e], d);
                    sc = fmaf(qs[1024 + h], fmaxf(d, 0.f), sc); }
                kk = fkey(sc);
            }
            ks[j * 64 + lane] = kk;
        }
        __builtin_amdgcn_wave_barrier(); asm volatile("s_waitcnt lgkmcnt(0)" ::: "memory");
        unsigned key[64];
#pragma unroll
        for (int j = 0; j < 64; ++j) key[j] = ks[j * 64 + lane];
        MASK[(size_t)row * 64 + lane] = topk_select(key, t + 1, lane);
        __builtin_amdgcn_wave_barrier(); asm volatile("s_waitcnt lgkmcnt(0)" ::: "memory");
    }
}

namespace att {
constexpr int NW = 8, QBLK = 32, KVBLK = 64, QB = NW * QBLK, D = 128;
constexpr int SHM_V = KVBLK * D * 2, SHM_K = KVBLK * D * 2;
constexpr int LDS_NEED = 2 * SHM_V + 2 * SHM_K + NW * 64 * 4;
constexpr float THR = 8.f, SCALE = 0.08838834764831845f;
typedef short s16x8 __attribute__((ext_vector_type(8)));
typedef short s16x4 __attribute__((ext_vector_type(4)));
typedef float f32x16 __attribute__((ext_vector_type(16)));
#define KSWZ(row, colB) ((row) * 256 + ((colB) ^ (((row) & 7) << 4)))
#define SBAR() __builtin_amdgcn_sched_barrier(0)
__device__ __forceinline__ int v_st(int k, int c) { const int kk = (k & ~0xC) | ((k & 4) << 1) | ((k & 8) >> 1); return ((kk >> 3) * 4 + (c >> 5)) * 512 + ((kk & 7) * 32 + (c & 31)) * 2; }
__device__ __forceinline__ int v_rd_base(int lane) { return ((lane & 3) << 3) | (((lane >> 2) & 3) << 6) | (((lane >> 4) & 1) << 5) | (((lane >> 5) & 1) << 8); }
constexpr int v_rd_off(int d0, int ks, int half) { return d0 * 512 + ks * 4096 + half * 2048; }
__device__ __forceinline__ int crow(int r, int hi) { return (r & 3) + 8 * (r >> 2) + 4 * hi; }
__device__ __forceinline__ unsigned cvtpk(float lo, float hi) { unsigned r; asm volatile("v_cvt_pk_f16_f32 %0, %1, %2" : "=v"(r) : "v"(lo), "v"(hi)); return r; }
__device__ __forceinline__ f32x16 mfma16(s16x8 a, s16x8 b, f32x16 c) { return __builtin_amdgcn_mfma_f32_32x32x16_f16(__builtin_bit_cast(h16x8, a), __builtin_bit_cast(h16x8, b), c, 0, 0, 0); }
__device__ __forceinline__ s16x8 load8(const h16* p) { return *reinterpret_cast<const s16x8*>(p); }
__device__ __forceinline__ void mask_causal(f32x16& p0, f32x16& p1, int dq) {
    const float NEG = -__builtin_inff();
#pragma unroll
    for (int r = 0; r < 16; ++r) { const int c = (r & 3) + 8 * (r >> 2); if (dq - c < 0) p0[r] = NEG; if (dq - c - 32 < 0) p1[r] = NEG; }
}
__device__ __forceinline__ void mask_bits(f32x16& p0, f32x16& p1, u64 w, int hi) {
    const float NEG = -__builtin_inff();
    const unsigned lo = (unsigned)w >> (4 * hi), up = (unsigned)(w >> 32) >> (4 * hi);
#pragma unroll
    for (int r = 0; r < 16; ++r) { const int c = (r & 3) + 8 * (r >> 2); if (!((lo >> c) & 1u)) p0[r] = NEG; if (!((up >> c) & 1u)) p1[r] = NEG; }
}
__device__ __forceinline__ void partialSM(f32x16& p0, f32x16& p1, float& m_reg, float& mn, float& alpha) {
    float pmax = p0[0]; for (int r = 1; r < 16; ++r) pmax = fmaxf(pmax, p0[r]); for (int r = 0; r < 16; ++r) pmax = fmaxf(pmax, p1[r]);
    { auto rr = __builtin_amdgcn_permlane32_swap(__float_as_uint(pmax), __float_as_uint(pmax), false, false);
      pmax = fmaxf(__uint_as_float(rr[0]), __uint_as_float(rr[1])); }
    constexpr float C2 = 1.4426950408889634f * SCALE;
    if (__builtin_expect(__all((pmax - m_reg) * SCALE <= THR), 1)) { mn = m_reg; alpha = 1.f; }
    else { mn = fmaxf(m_reg, pmax); alpha = __builtin_amdgcn_exp2f((m_reg - mn) * C2); m_reg = mn; }
    const float mnL = -mn * C2;
    for (int r = 0; r < 16; ++r) p0[r] = fmaf(p0[r], C2, mnL); for (int r = 0; r < 16; ++r) p1[r] = fmaf(p1[r], C2, mnL);
    for (int r = 0; r < 16; ++r) p0[r] = __builtin_amdgcn_exp2f(p0[r]);
}
__device__ __forceinline__ void finishSM(f32x16& p0, f32x16& p1, float alpha, float& l_reg, s16x8& pa0, s16x8& pa1, s16x8& pa2, s16x8& pa3) {
    for (int r = 0; r < 16; ++r) p1[r] = __builtin_amdgcn_exp2f(p1[r]);
    float ps = 0; for (int r = 0; r < 16; ++r) ps += p0[r]; for (int r = 0; r < 16; ++r) ps += p1[r];
    { auto rr = __builtin_amdgcn_permlane32_swap(__float_as_uint(ps), __float_as_uint(ps), false, false);
      ps = __uint_as_float(rr[0]) + __uint_as_float(rr[1]); }
    l_reg = l_reg * alpha + ps;
#define PK4(P, B_, OUT) do { unsigned a0 = cvtpk(P[B_+0], P[B_+1]), a1 = cvtpk(P[B_+2], P[B_+3]);                          \
        unsigned b0 = cvtpk(P[B_+4], P[B_+5]), b1 = cvtpk(P[B_+6], P[B_+7]);                                             \
        auto r0 = __builtin_amdgcn_permlane32_swap(a0, b0, false, false); auto r1 = __builtin_amdgcn_permlane32_swap(a1, b1, false, false); \
        u32x4 w = {r0[0], r1[0], r0[1], r1[1]}; OUT = *reinterpret_cast<s16x8*>(&w); } while (0)
    PK4(p0, 0, pa0); PK4(p0, 8, pa1); PK4(p1, 0, pa2); PK4(p1, 8, pa3);
#undef PK4
}
template <int KB>
__device__ __forceinline__ void qkt(f32x16& p0, f32x16& p1, const char* K_lds, int r32, int hi, const s16x8* qr) {
    const char* kb[4];
#pragma unroll
    for (int dd = 0; dd < 4; ++dd) kb[dd] = K_lds + KB * SHM_K + KSWZ(r32, (dd * 16 + hi * 8) * 2);
#pragma unroll
    for (int d0 = 0; d0 < 8; ++d0) { const char* a = kb[d0 & 3] + (d0 >> 2) * 128;
        s16x8 b0 = *reinterpret_cast<const s16x8*>(a);
        s16x8 b1 = *reinterpret_cast<const s16x8*>(a + 32 * 256);
        p0 = mfma16(b0, qr[d0], p0);
        p1 = mfma16(b1, qr[d0], p1); }
}
template <int VB>
__device__ __forceinline__ void pv_tile(f32x16* o, int vb0, s16x8 pa0, s16x8 pa1, s16x8 pa2, s16x8 pa3) {
#define TRRD(dst, off) asm volatile("ds_read_b64_tr_b16 %0, %1 offset:%2" : "=&v"(dst) : "v"(vb0), "i"(off) : "memory")
#define PV_D0(d0) do { s16x4 l0, l1, l2, l3, h0, h1, h2, h3; constexpr int b_ = VB * SHM_V + v_rd_off(d0, 0, 0); \
        TRRD(l0, b_); TRRD(h0, b_ + 2048); TRRD(l1, b_ + 4096); TRRD(h1, b_ + 6144); TRRD(l2, b_ + 8192); TRRD(h2, b_ + 10240); TRRD(l3, b_ + 12288); TRRD(h3, b_ + 14336); \
        asm volatile("s_waitcnt lgkmcnt(0)" ::: "memory"); SBAR();   \
        o[d0] = mfma16(pa0, (s16x8){l0[0], l0[1], l0[2], l0[3], h0[0], h0[1], h0[2], h0[3]}, o[d0]);   \
        o[d0] = mfma16(pa1, (s16x8){l1[0], l1[1], l1[2], l1[3], h1[0], h1[1], h1[2], h1[3]}, o[d0]);   \
        o[d0] = mfma16(pa2, (s16x8){l2[0], l2[1], l2[2], l2[3], h2[0], h2[1], h2[2], h2[3]}, o[d0]);   \
        o[d0] = mfma16(pa3, (s16x8){l3[0], l3[1], l3[2], l3[3], h3[0], h3[1], h3[2], h3[3]}, o[d0]); } while (0)
    PV_D0(0); PV_D0(1); PV_D0(2); PV_D0(3);
#undef PV_D0
#undef TRRD
}
struct BlockRef { const char* Q; const char* K; const char* V; char* O; int P0; const char* NBQ; const char* MK; };
struct Seam { s16x8 qr[8]; s16x8 st_v0, st_v1, st_k0, st_k1; };
#define LD16(base, off) (*reinterpret_cast<const s16x8*>((base) + (off)))
#define VMW() asm volatile("s_waitcnt vmcnt(0)" ::: "memory")
#define VMWN(n) asm volatile("s_waitcnt vmcnt(%0)" :: "i"(n) : "memory")
#define SLOAD_H(Kp, Vp, k0) do { const char* vb_ = (Vp) + (size_t)(k0) * (D * 2); const char* kb_ = (Kp) + (size_t)(k0) * (D * 2); \
        S.st_v0 = LD16(vb_, st_off); S.st_v1 = LD16(vb_ + 32 * D * 2, st_off); S.st_k0 = LD16(kb_, st_off); S.st_k1 = LD16(kb_ + 32 * D * 2, st_off); } while (0)
#define SWRITE_HK(bf) do { *(s16x8*)(K_lds + (bf) * SHM_K + kws) = S.st_k0; *(s16x8*)(K_lds + (bf) * SHM_K + kws + 32 * 256) = S.st_k1; } while (0)
#define SWRITE_HV(bf) do { *(s16x8*)(V_lds + (bf) * SHM_V + vst0) = S.st_v0; *(s16x8*)(V_lds + (bf) * SHM_V + vst1) = S.st_v1; } while (0)
#define SWRITE_H(bf) do { SWRITE_HV(bf); SWRITE_HK(bf); } while (0)
__device__ __forceinline__ void prime(const BlockRef& cur, char* lds, Seam& S) {
    int tid = threadIdx.x; asm volatile("" : "+v"(tid));
    const int wid = __builtin_amdgcn_readfirstlane(tid >> 6), lane = tid & 63, r32 = lane & 31, hi = lane >> 5;
    const int sr = tid >> 4, sc = (tid & 15) * 8, kws = KSWZ(sr, sc * 2); char* K_lds = lds + 2 * SHM_V;
    const unsigned st_off = (unsigned)(sr * D + sc) * 2u, q_off = (unsigned)((wid * QBLK + r32) * D + hi * 8) * 2u;
#pragma unroll
    for (int d0 = 0; d0 < 8; ++d0) S.qr[d0] = LD16(cur.Q + d0 * 32, q_off);
    SLOAD_H(cur.K, cur.V, 0); VMW(); SWRITE_HK(0);
    __syncthreads();
}
template <bool MIXB>
__device__ __forceinline__ void block(const BlockRef& cur, const BlockRef& nxt, char* lds, Seam& S) {
    int tid = threadIdx.x; asm volatile("" : "+v"(tid));
    const int wid = __builtin_amdgcn_readfirstlane(tid >> 6), lane = tid & 63, r32 = lane & 31, hi = lane >> 5;
    const int NT = cur.P0 / KVBLK + 4;
    const int qlo = cur.P0 + wid * QBLK, qm = qlo + r32 - 4 * hi;
    char* V_lds = lds; char* K_lds = lds + 2 * SHM_V;
    float* wsf = (float*)(lds + 2 * SHM_V + 2 * SHM_K) + wid * 64; float* li_l = wsf, * al_l = wsf + 32;
    float m_reg = -1e30f, l_reg = 0; f32x16 o[4] = {};
    const int sr = tid >> 4, sc = (tid & 15) * 8, vst0 = v_st(sr, sc), vst1 = v_st(32 + sr, sc), kws = KSWZ(sr, sc * 2);
    const int vb0 = (int)(uintptr_t)V_lds + v_rd_base(lane);
    const unsigned st_off = (unsigned)(sr * D + sc) * 2u, q_off = (unsigned)((wid * QBLK + r32) * D + hi * 8) * 2u;
    const unsigned nb_off = (unsigned)hi * 16u, mk_off = (unsigned)(wid * QBLK + r32) * 512u;
    const char* Kh = cur.K; const char* Vh = cur.V;
#define RESC(a) do { if (__any((a) < 1.f)) { if (hi == 0) al_l[r32] = (a); asm volatile("s_waitcnt lgkmcnt(0)" ::: "memory");              \
                     for (int d_ = 0; d_ < 4; ++d_) for (int r = 0; r < 16; ++r) o[d_][r] *= al_l[crow(r, hi)]; } } while (0)
#define KBASE(t) ((t) * KVBLK)
#define PINIT(P0_, P1_, t) do { if (MIXB) { const char* nb_ = cur.NBQ + (size_t)KBASE(t) * 4; _Pragma("unroll") for (int g_ = 0; g_ < 4; ++g_) { \
            const f32x4 b0_ = *(const f32x4*)(nb_ + 32 * g_ + nb_off), b1_ = *(const f32x4*)(nb_ + 128 + 32 * g_ + nb_off); \
            _Pragma("unroll") for (int j_ = 0; j_ < 4; ++j_) { P0_[4 * g_ + j_] = b0_[j_]; P1_[4 * g_ + j_] = b1_[j_]; } } } else { P0_ = f32x16{}; P1_ = f32x16{}; } } while (0)
#define MKW(t) (*(const u64*)(cur.MK + (size_t)(t) * 8 + mk_off))
#define MASKT(P0_, P1_, t, MW_) do { if (MIXB) { const int kb_ = KBASE(t); if (kb_ + KVBLK - 1 > qlo) mask_causal(P0_, P1_, qm - kb_); } else mask_bits(P0_, P1_, MW_, hi); } while (0)
    f32x16 pA0, pA1, pB0, pB1; float mnA, mnB, alA, alB; s16x8 pa0, pa1, pa2, pa3;
    u64 mwA = 0, mwB = 0;
    if (!MIXB) { mwA = MKW(0); if (NT > 1) mwB = MKW(1); }
    PINIT(pA0, pA1, 0);
    if (NT > 1) PINIT(pB0, pB1, 1);
    SWRITE_HV(0); SBAR();
    if (NT > 1) SLOAD_H(Kh, Vh, KBASE(1));
    SBAR(); qkt<0>(pA0, pA1, K_lds, r32, hi, S.qr);
    MASKT(pA0, pA1, 0, mwA); if (!MIXB) { if (NT > 2) mwA = MKW(2); }
    partialSM(pA0, pA1, m_reg, mnA, alA);
    if (NT > 1) { VMW(); SWRITE_H(1); }
    __syncthreads();
#define HALF_STEP(PX0, PX1, mnX, alX, MWX, PY0, PY1, alY, t, KB, VB, SB) do {                                               \
        SBAR(); qkt<KB>(PX0, PX1, K_lds, r32, hi, S.qr);                                                                      \
        finishSM(PY0, PY1, alY, l_reg, pa0, pa1, pa2, pa3); SBAR();                                                           \
        if ((t) + 1 < NT) { PINIT(PY0, PY1, (t) + 1); SLOAD_H(Kh, Vh, KBASE((t) + 1)); SBAR(); }                             \
        pv_tile<VB>(o, vb0, pa0, pa1, pa2, pa3); MASKT(PX0, PX1, (t), MWX); if (!MIXB) { if ((t) + 2 < NT) MWX = MKW((t) + 2); } \
        partialSM(PX0, PX1, m_reg, mnX, alX);                                                                                 \
        __syncthreads();                                                                                                      \
        if ((t) + 1 < NT) { VMW(); SWRITE_H(SB); }                                                                            \
        RESC(alX); __syncthreads(); } while (0)
    for (int t = 1; t + 1 < NT; t += 2) {
        HALF_STEP(pB0, pB1, mnB, alB, mwB, pA0, pA1, alA, t, 1, 0, 0);
        HALF_STEP(pA0, pA1, mnA, alA, mwA, pB0, pB1, alB, t + 1, 0, 1, 1);
    }
    const bool even = (NT & 1) == 0;
    if (even) { SBAR(); qkt<1>(pB0, pB1, K_lds, r32, hi, S.qr); SBAR(); }
    SLOAD_H(nxt.K, nxt.V, 0); SBAR();
#pragma unroll
    for (int d0 = 0; d0 < 8; ++d0) S.qr[d0] = LD16(nxt.Q + d0 * 32, q_off);
    SBAR();
    finishSM(pA0, pA1, alA, l_reg, pa0, pa1, pa2, pa3); SBAR();
    pv_tile<0>(o, vb0, pa0, pa1, pa2, pa3);
    if (even) { MASKT(pB0, pB1, NT - 1, mwB); partialSM(pB0, pB1, m_reg, mnB, alB); __syncthreads(); RESC(alB);
        finishSM(pB0, pB1, alB, l_reg, pa0, pa1, pa2, pa3); SBAR(); pv_tile<1>(o, vb0, pa0, pa1, pa2, pa3); }
    SBAR(); VMWN(8); SWRITE_HK(0); SBAR();
    if (hi == 0) li_l[r32] = l_reg; asm volatile("s_waitcnt lgkmcnt(0)" ::: "memory");
    float rli[16];
#pragma unroll
    for (int r = 0; r < 16; ++r) rli[r] = __builtin_amdgcn_rcpf(li_l[crow(r, hi)]);
    const unsigned o_off = (unsigned)((wid * QBLK + 4 * hi) * 1024 + r32) * 2u;
#pragma unroll
    for (int r = 0; r < 16; ++r) {
#pragma unroll
        for (int d0 = 0; d0 < 4; ++d0) { const float v = o[d0][r] * rli[r];
            const float vn = __shfl_xor(v, 1);
            if ((r32 & 1) == 0) *(unsigned*)(cur.O + (size_t)(((r & 3) + 8 * (r >> 2)) * 2048 + d0 * 64) + o_off) = cvtpk(v, vn); } }
    __syncthreads();
#undef RESC
#undef KBASE
#undef PINIT
#undef MKW
#undef MASKT
#undef HALF_STEP
}
#undef LD16
#undef VMW
#undef VMWN
#undef SLOAD_H
#undef SWRITE_HK
#undef SWRITE_HV
#undef SWRITE_H
__device__ __forceinline__ BlockRef make_ref(bool mixb, unsigned char* ws, int bh, int qb) {
    const int b = bh >> 3, h = bh & 7, kvh = mixb ? bh : (b * HAKV + (h >> 2));
    BlockRef r;
    r.Q = (const char*)ws + (mixb ? WS_QB : WS_QA) + ((size_t)bh * T + (size_t)qb * QB) * D * 2;
    r.K = (const char*)ws + (mixb ? WS_KB : WS_KA) + (size_t)kvh * T * D * 2;
    r.V = (const char*)ws + (mixb ? WS_VB : WS_VA) + (size_t)kvh * T * D * 2;
    r.O = (char*)ws + (mixb ? WS_OUTB : WS_OUTA) + ((size_t)(b * T + qb * QB) * 1024 + h * D) * 2;
    r.P0 = qb * QB;
    r.NBQ = (const char*)ws + WS_NBQ + ((size_t)bh * 16 + qb) * T * 4;
    r.MK = (const char*)ws + WS_MASK + (size_t)(b * T + qb * QB) * 64 * 8;
    return r;
}
template <bool MIXB>
__device__ __forceinline__ void run_item(int item, unsigned char* ws, char* lds) {
    const int bh = (item >> 3) & 15, x = item & 7;
    Seam S;
    BlockRef cur = make_ref(MIXB, ws, bh, x);
    prime(cur, lds, S);
#pragma unroll 1
    for (int pass = 0; pass < 2; ++pass) {
        const BlockRef nxt = make_ref(MIXB, ws, bh, 15 - x);
        block<MIXB>(cur, nxt, lds, S);
        cur = nxt;
    }
}
}

namespace cg = cooperative_groups;
constexpr int LDS_BYTES = pg8::STAGE_BYTES;
struct Params { const float* in[17]; float* out; unsigned char* ws; };
template <class Epi>
__device__ __forceinline__ void run_gemm(LAS unsigned char* lds, const h16* A, const h16* Bt, int M, int N, int K, const Epi& e) {
    pg8::Gemm g{A, Bt, M, N, K}; pg8::StaticOrder S; S.init(M, N, (int)gridDim.x, (int)blockIdx.x);
    pg8::gemm_phase<Epi>(lds, g, S, e);
}
__global__ void __launch_bounds__(512, 2) mega_fwd(Params P) {
    extern __shared__ __attribute__((aligned(16))) unsigned char lds_raw[];
    LAS unsigned char* lds = (LAS unsigned char*)lds_raw;
    cg::grid_group grid = cg::this_grid();
#define IDS() int tid = threadIdx.x; asm volatile("" : "+v"(tid)); const int lane = tid & 63, wave = __builtin_amdgcn_readfirstlane(tid >> 6), gw = blockIdx.x * 8 + wave, NGW = gridDim.x * 8; (void)lane; (void)gw; (void)NGW
    const float* x = P.in[0]; const float* p = P.in[1]; const int* pos = (const int*)P.in[2];
    const float* g_mix = P.in[3]; const float* w_in = P.in[4]; const float* b_f = P.in[5];
    const float* w_o_a = P.in[6]; const float* w_o_b = P.in[7]; const float* w_out = P.in[8];
    const float* g_ffn = P.in[9]; const float* w_g = P.in[10]; const float* w_u = P.in[11]; const float* w_d = P.in[12];
    const float* g_ple = P.in[13]; const float* w_pg = P.in[14]; const float* w_pp = P.in[15]; const float* g_final = P.in[16];
    unsigned char* ws = P.ws; float* out = P.out;
    float* ROPE = (float*)(ws + WS_ROPE); float* CB = (float*)(ws + WS_CB); float* LOGF = (float*)(ws + WS_LOGF); u64* MASK = (u64*)(ws + WS_MASK);
    h16* WIN = (h16*)(ws + WS_WIN); h16* WOA = (h16*)(ws + WS_WOA); h16* WOB = (h16*)(ws + WS_WOB); h16* WOUT = (h16*)(ws + WS_WOUT);
    h16* WGU = (h16*)(ws + WS_WGU); h16* WDN = (h16*)(ws + WS_WDN); h16* WPG = (h16*)(ws + WS_WPG); h16* WPP = (h16*)(ws + WS_WPP);
    h16* QI = (h16*)(ws + WS_QI); h16* KI = (h16*)(ws + WS_KI); float* WI = (float*)(ws + WS_WI);
    h16* SIGA = (h16*)(ws + WS_SIGA); h16* SIGB = (h16*)(ws + WS_SIGB);
    h16* OUTA = (h16*)(ws + WS_OUTA); h16* OUTB = (h16*)(ws + WS_OUTB); h16* P16 = (h16*)(ws + WS_P16);
    h16* MIXED = (h16*)(ws + WS_MIXED); h16* H2 = (h16*)(ws + WS_H2); h16* ACT = (h16*)(ws + WS_ACT); h16* PP = (h16*)(ws + WS_PP);
    h16* H1 = (h16*)P.out;

    { IDS(); LAS float* scr = (LAS float*)(lds + wave * 8448);
      ph_transpose<1>(w_in, nullptr, DM, N_IN, WIN, N_INP, scr, gw, NGW, lane);
      ph_transpose<0>(w_o_a, nullptr, 1024, DM, WOA, DM, scr, gw, NGW, lane);
      ph_transpose<0>(w_o_b, nullptr, 1024, DM, WOB, DM, scr, gw, NGW, lane);
      ph_transpose<0>(w_out, nullptr, DM, DM, WOUT, DM, scr, gw, NGW, lane);
      ph_transpose<2>(w_g, w_u, DM, DFF, WGU, 2 * DFF, scr, gw, NGW, lane);
      ph_transpose<0>(w_d, nullptr, DFF, DM, WDN, DM, scr, gw, NGW, lane);
      ph_transpose<0>(w_pg, nullptr, DM, DM, WPG, DM, scr, gw, NGW, lane);
      ph_transpose<0>(w_pp, nullptr, DPLE, DM, WPP, DM, scr, gw, NGW, lane);
      ph_rope(pos, ROPE, blockIdx.x * 512 + tid, gridDim.x * 512);
      ph_rmsnorm<false>(x, g_mix, H1, nullptr, gw, NGW, lane);
    }
    grid.sync();
    { EpiInProj e{ws, b_f}; run_gemm(lds, H1, WIN, MTOK, N_INP, DM, e); }
    grid.sync();
    { IDS();
      if (gw >= NGW - 16) ph_cumsum(LOGF, CB, (float*)(ws + WS_NBQ), NGW - 1 - gw, lane);
      if (wave < 4) ph_topk_naive(QI, KI, WI, MASK, (LAS float*)(lds + wave * 20544), (LAS unsigned*)(lds + wave * 20544 + 4160), blockIdx.x * 4 + wave, gridDim.x * 4, lane);
      for (int i = blockIdx.x * 512 + tid; i < MTOK * DPLE / 4; i += gridDim.x * 512) st4h(P16 + 4 * (size_t)i, *((const f32x4*)p + i));
    }
    grid.sync();
    for (int it = blockIdx.x; it < 256; it += gridDim.x) {
        const int item = (it & 7) * 32 + (it >> 3);
        if (item < 128) att::run_item<false>(item, ws, (char*)lds_raw); else att::run_item<true>(item, ws, (char*)lds_raw);
    }
    grid.sync();
    { EpiGate<true> e{SIGA, MIXED}; run_gemm(lds, OUTA, WOA, MTOK, DM, 1024, e); }
    { EpiGate<false> e{SIGB, MIXED}; run_gemm(lds, OUTB, WOB, MTOK, DM, 1024, e); }
    grid.sync();
    { EpiResid e{x, out}; run_gemm(lds, MIXED, WOUT, MTOK, DM, DM, e); }
    grid.sync();
    { IDS(); ph_rmsnorm<false>(out, g_ffn, H2, nullptr, gw, NGW, lane); }
    grid.sync();
    { EpiSwiGLU e{ACT}; run_gemm(lds, H2, WGU, MTOK, 2 * DFF, DM, e); }
    grid.sync();
    { EpiResid e{out, out}; run_gemm(lds, ACT, WDN, MTOK, DM, DFF, e); }
    grid.sync();
    { IDS(); ph_rmsnorm<false>(out, g_ple, H2, nullptr, gw, NGW, lane); }
    grid.sync();
    { EpiStoreH e{PP, DM}; run_gemm(lds, P16, WPP, MTOK, DM, DPLE, e); }
    { EpiPLE e{PP, out}; run_gemm(lds, H2, WPG, MTOK, DM, DM, e); }
    grid.sync();
    { IDS(); ph_rmsnorm<true>(out, g_final, nullptr, out, gw, NGW, lane); }
#undef IDS
}

extern "C" void kernel_launch(void* const* d_in, const int* in_sizes, int n_in, void* d_out, int out_size, void* d_ws, size_t ws_size, hipStream_t stream) {
    if (n_in != 17 || out_size != MTOK * DM || ws_size < WS_END) { fprintf(stderr, "kernel_launch: unexpected shapes / workspace (%d inputs, out %d, ws %zu)\n", n_in, out_size, ws_size); return; }
    static int grid_blocks = 0;
    if (!grid_blocks) {
        int dev = 0, cus = 0, per_cu = 0;
        (void)hipGetDevice(&dev);
        (void)hipDeviceGetAttribute(&cus, hipDeviceAttributeMultiprocessorCount, dev);
        (void)hipFuncSetAttribute((const void*)mega_fwd, hipFuncAttributeMaxDynamicSharedMemorySize, LDS_BYTES);
        (void)hipOccupancyMaxActiveBlocksPerMultiprocessor(&per_cu, (const void*)mega_fwd, 512, LDS_BYTES);
        if (per_cu < 1) { fprintf(stderr, "kernel_launch: occupancy query says %d blocks per CU\n", per_cu); per_cu = 1; }
        if (per_cu > 1) per_cu = 1;
        grid_blocks = cus * per_cu;
    }
    Params prm{};
    for (int i = 0; i < 17; ++i) prm.in[i] = (const float*)d_in[i];
    prm.out = (float*)d_out; prm.ws = (unsigned char*)d_ws;
    void* args[] = {&prm};
    hipError_t e = hipLaunchCooperativeKernel((const void*)mega_fwd, dim3(grid_blocks), dim3(512), args, LDS_BYTES, stream);
    if (e != hipSuccess) fprintf(stderr, "cooperative launch failed: %s (grid %d)\n", hipGetErrorString(e), grid_blocks);
}
```

```cpp
#include <hip/hip_runtime.h>
#include <hip/hip_cooperative_groups.h>
#include <stdint.h>
#include <cstdio>

#define LAS __attribute__((address_space(3)))
typedef _Float16 h16;
typedef _Float16 h16x8 __attribute__((ext_vector_type(8)));
typedef _Float16 h16x4 __attribute__((ext_vector_type(4)));
typedef _Float16 h16x2 __attribute__((ext_vector_type(2)));
typedef float f32x4 __attribute__((ext_vector_type(4)));
typedef float f32x2 __attribute__((ext_vector_type(2)));
typedef unsigned u32x4 __attribute__((ext_vector_type(4)));
typedef unsigned u32x2 __attribute__((ext_vector_type(2)));
typedef unsigned long long u64;

constexpr int NBATCH = 2, T = 4096, MTOK = NBATCH * T, DM = 2048;
constexpr int HA = 8, HAKV = 2, HIDX = 16, DIDX = 64, HB = 8, HD = 128;
constexpr int N_IN = 9816, N_INP = 9984, DFF = 5632, DPLE = 256, TOPK = 256;
constexpr float EPS = 1e-6f;
constexpr float ATT_SCALE = 0.08838834764831845f;

constexpr size_t MiB = 1u << 20;
constexpr size_t WS_CTL = 0;
constexpr size_t WS_ROPE = 1 * MiB;
constexpr size_t WS_CB = 3 * MiB;
constexpr size_t WS_LOGF = 3 * MiB + 512 * 1024;
constexpr size_t WS_MASK = 4 * MiB;
constexpr size_t WS_WIN = 8 * MiB;
constexpr size_t WS_OUTA = 8 * MiB, WS_OUTB = 24 * MiB, WS_P16 = 40 * MiB;
constexpr size_t WS_WOA = 47 * MiB, WS_WOB = 51 * MiB, WS_WOUT = 55 * MiB, WS_WGU = 63 * MiB, WS_WDN = 107 * MiB, WS_WPG = 129 * MiB, WS_WPP = 137 * MiB;
constexpr size_t WS_QA = 138 * MiB, WS_KA = 154 * MiB, WS_VA = 158 * MiB, WS_QI = 162 * MiB, WS_KI = 178 * MiB, WS_WI = 179 * MiB;
constexpr size_t WS_QB = 180 * MiB, WS_KB = 196 * MiB, WS_VB = 212 * MiB, WS_SIGA = 228 * MiB, WS_SIGB = 260 * MiB, WS_NBQ = 292 * MiB, WS_END = 296 * MiB;
constexpr size_t WS_MIXED = WS_QB;
constexpr size_t WS_H2 = WS_QA;
constexpr size_t WS_ACT = WS_QB;
constexpr size_t WS_PP = WS_QB;

namespace pg8 {
constexpr int BM = 256, BK = 64, HALF = 128, HTB = HALF * BK * 2, STAGE_BYTES = 8 * HTB, NXCD = 8, WGM = 8;
__host__ __device__ __forceinline__ int lds_byte(int r, int c) { const int st = (r >> 4) * 2 + (c >> 5), rr = r & 15, cc = c & 31, ob = rr * 64 + cc * 2; return st * 1024 + (ob ^ (((ob >> 9) & 1) << 5)); }
__host__ __device__ __forceinline__ void stage_rc(int b, int& R, int& C) { const int st = b / 1024, sb = b % 1024, swz = sb ^ (((sb >> 9) & 1) << 5); R = (st >> 1) * 16 + swz / 64; C = (st & 1) * 32 + (swz % 64) / 2; }
struct Unit { int pm, pn; };
struct Gemm { const h16* A; const h16* Bt; int M, N, K; };
struct StaticOrder {
    int nM, nN, nwg, G, c;
    __host__ __device__ void init(int M, int N, int G_, int c_) { nM = M / BM; nN = N / BM; nwg = nM * nN; G = G_; c = c_; }
    __host__ __device__ bool next(int i, Unit& u) const {
        const long L = (long)i * G + c; if (L >= nwg) return false;
        int wgid = (int)L; { const int q = nwg / NXCD, r = nwg % NXCD, xcd = wgid % NXCD, off = wgid / NXCD; wgid = (xcd < r ? xcd * (q + 1) : r * (q + 1) + (xcd - r) * q) + off; }
        const int nig = WGM * nN, gid = wgid / nig, fm = gid * WGM, gsz = (nM - fm) < WGM ? (nM - fm) : WGM;
        u.pm = fm + ((wgid % nig) % gsz); u.pn = (wgid % nig) / gsz; return true;
    }
};
template <class Epi>
__device__ __forceinline__ void gemm_phase(LAS unsigned char* lds, const Gemm g, const StaticOrder& S, const Epi& E) {
    int tid = threadIdx.x; asm volatile("" : "+v"(tid));
    const int wid = __builtin_amdgcn_readfirstlane(tid >> 6), lane = tid & 63, wr = wid >> 2, wc = wid & 3, fr = lane & 15, fq = lane >> 4;
    const int K = g.K, nt = K / BK;
    unsigned voffA[2];
#pragma unroll
    for (int i = 0; i < 2; ++i) { int R, C; stage_rc(tid * 16 + i * 8192, R, C); voffA[i] = (unsigned)(R * K + C) * 2u; }
    const size_t kstep = (size_t)(BK * 2);
    const size_t hstep = (size_t)HALF * K * 2;
    const size_t tstep = 2 * hstep;
    const unsigned ldsw = (unsigned)wid * 1024u;
    const int aoff = lds_byte(wr * 64 + fr, fq * 8), boff = lds_byte(wc * 32 + fr, fq * 8);
#define PG8_SA(b, h) (((b) * 2 + (h)) * HTB)
#define PG8_SB(b, h) ((4 + (b) * 2 + (h)) * HTB)
#define PG8_STAGE(bufoff, gbase) do { _Pragma("unroll") for (int _i = 0; _i < 2; ++_i) \
        __builtin_amdgcn_global_load_lds((const unsigned*)((const char*)(gbase) + voffA[_i]), (LAS unsigned*)(lds + (bufoff) + ldsw + _i * 8192), 16, 0, 0); } while (0)
#define PG8_LDA(dst, b, h) do { _Pragma("unroll") for (int m = 0; m < 4; ++m) _Pragma("unroll") for (int k = 0; k < 2; ++k) dst[m][k] = *(const LAS h16x8*)(lds + PG8_SA(b, h) + aoff + m * 2048 + k * 1024); } while (0)
#define PG8_LDB(dst, b, h) do { _Pragma("unroll") for (int n = 0; n < 2; ++n) _Pragma("unroll") for (int k = 0; k < 2; ++k) dst[n][k] = *(const LAS h16x8*)(lds + PG8_SB(b, h) + boff + n * 2048 + k * 1024); } while (0)
#define PG8_MMA(ai, bj, At, Bt) do { __builtin_amdgcn_s_setprio(1); _Pragma("unroll") for (int m = 0; m < 4; ++m) _Pragma("unroll") for (int n = 0; n < 2; ++n) _Pragma("unroll") for (int k = 0; k < 2; ++k) \
        acc[ai][bj][m][n] = __builtin_amdgcn_mfma_f32_16x16x32_f16(Bt[n][k], At[m][k], acc[ai][bj][m][n], 0, 0, 0); __builtin_amdgcn_s_setprio(0); } while (0)
#define PG8_WAIT_V(n) asm volatile("s_waitcnt vmcnt(" #n ")" ::: "memory")
#define PG8_WAIT_L(n) asm volatile("s_waitcnt lgkmcnt(" #n ")" ::: "memory")
#define PG8_BAR __builtin_amdgcn_s_barrier()
#define PG8_SCHED __builtin_amdgcn_sched_barrier(0)
    Unit cur, nxt; int ui = 0;
    if (!S.next(0, cur)) return;
    f32x4 acc[2][2][4][2];
#pragma unroll
    for (int a = 0; a < 2; ++a)
#pragma unroll
        for (int b = 0; b < 2; ++b)
#pragma unroll
            for (int m = 0; m < 4; ++m)
#pragma unroll
                for (int n = 0; n < 2; ++n) acc[a][b][m][n] = (f32x4){0.f, 0.f, 0.f, 0.f};
    h16x8 At[4][2], B0[2][2], B1[2][2];
    const char* cA = (const char*)g.A + (size_t)cur.pm * tstep; const char* cB = (const char*)g.Bt + (size_t)cur.pn * tstep;
    PG8_STAGE(PG8_SB(0, 0), cB); PG8_STAGE(PG8_SA(0, 0), cA); PG8_STAGE(PG8_SB(0, 1), cB + hstep); PG8_STAGE(PG8_SA(0, 1), cA + hstep);
    if (wr == 1) PG8_BAR;
    PG8_WAIT_V(4); PG8_BAR;
    PG8_STAGE(PG8_SB(1, 0), cB + kstep); PG8_STAGE(PG8_SA(1, 0), cA + kstep); PG8_STAGE(PG8_SB(1, 1), cB + hstep + kstep);
    PG8_WAIT_V(6); PG8_BAR;
    for (;;) {
        const bool has_next = S.next(ui + 1, nxt);
        const char* nA = has_next ? (const char*)g.A + (size_t)nxt.pm * tstep : cA; const char* nB = has_next ? (const char*)g.Bt + (size_t)nxt.pn * tstep : cB;
        for (int t = 0; t < nt; t += 2) {
            const bool last = (t == nt - 2);
            const char* a1 = cA + (size_t)(t + 1) * kstep;
            const char* a2 = last ? nA : cA + (size_t)(t + 2) * kstep; const char* b2 = last ? nB : cB + (size_t)(t + 2) * kstep;
            const char* a3 = a2 + kstep; const char* b3 = b2 + kstep;
            PG8_LDB(B0, 0, 0); PG8_SCHED; PG8_LDA(At, 0, 0); PG8_STAGE(PG8_SA(1, 1), a1 + hstep);
            PG8_WAIT_L(8); PG8_BAR; PG8_WAIT_L(0); PG8_MMA(0, 0, At, B0); PG8_BAR; PG8_SCHED;
            PG8_LDB(B1, 0, 1); PG8_STAGE(PG8_SB(0, 0), b2);
            PG8_BAR; PG8_WAIT_L(0); PG8_MMA(0, 1, At, B1); PG8_BAR;
            PG8_LDA(At, 0, 1); PG8_STAGE(PG8_SA(0, 0), a2);
            PG8_BAR; PG8_WAIT_L(0); PG8_MMA(1, 0, At, B0); PG8_BAR; PG8_SCHED;
            PG8_STAGE(PG8_SB(0, 1), b2 + hstep);
            PG8_WAIT_V(6); PG8_BAR; PG8_MMA(1, 1, At, B1); PG8_BAR;
            PG8_LDB(B0, 1, 0); PG8_SCHED; PG8_LDA(At, 1, 0); PG8_STAGE(PG8_SA(0, 1), a2 + hstep);
            PG8_WAIT_L(8); PG8_BAR; PG8_WAIT_L(0); PG8_MMA(0, 0, At, B0); PG8_BAR; PG8_SCHED;
            PG8_LDB(B1, 1, 1); PG8_STAGE(PG8_SB(1, 0), b3);
            PG8_BAR; PG8_WAIT_L(0); PG8_MMA(0, 1, At, B1); PG8_BAR;
            PG8_LDA(At, 1, 1); PG8_STAGE(PG8_SA(1, 0), a3);
            PG8_BAR; PG8_WAIT_L(0); PG8_MMA(1, 0, At, B0); PG8_BAR; PG8_SCHED;
            PG8_STAGE(PG8_SB(1, 1), b3 + hstep);
            PG8_WAIT_V(6); PG8_BAR; PG8_MMA(1, 1, At, B1); PG8_BAR;
        }
        E(acc, cur, wr, wc, fr, fq);
        if (!has_next) break;
#pragma unroll
        for (int a = 0; a < 2; ++a)
#pragma unroll
            for (int b = 0; b < 2; ++b)
#pragma unroll
                for (int m = 0; m < 4; ++m)
#pragma unroll
                    for (int n = 0; n < 2; ++n) acc[a][b][m][n] = (f32x4){0.f, 0.f, 0.f, 0.f};
        cur = nxt; cA = nA; cB = nB; ++ui;
    }
    PG8_WAIT_V(0);
    if (wr == 0) PG8_BAR;
    PG8_BAR;
#undef PG8_SA
#undef PG8_SB
#undef PG8_STAGE
#undef PG8_LDA
#undef PG8_LDB
#undef PG8_MMA
#undef PG8_WAIT_V
#undef PG8_WAIT_L
#undef PG8_BAR
#undef PG8_SCHED
}
}
using pg8::Unit;
typedef f32x4 Acc[2][2][4][2];

__device__ __forceinline__ void st4h(h16* p, f32x4 v) { h16x4 o; o[0] = (h16)v[0]; o[1] = (h16)v[1]; o[2] = (h16)v[2]; o[3] = (h16)v[3]; *(h16x4*)p = o; }
__device__ __forceinline__ f32x4 ld4h(const h16* p) { const h16x4 o = *(const h16x4*)p; return (f32x4){(float)o[0], (float)o[1], (float)o[2], (float)o[3]}; }
__device__ __forceinline__ float sigmoidf_(float x) { return 1.0f / (1.0f + __expf(-x)); }
__device__ __forceinline__ float logsigmoidf_(float z) { return fminf(z, 0.f) - __logf(1.0f + __expf(-fabsf(z))); }
__device__ __forceinline__ float wave_sum(float v) {
#pragma unroll
    for (int o = 1; o < 64; o <<= 1) v += __shfl_xor(v, o);
    return v;
}

struct EpiInProj {
    unsigned char* ws; const float* b_f;
    __device__ __forceinline__ void operator()(const Acc& acc, const Unit& u, int wr, int wc, int fr, int fq) const {
        const int pn = u.pn, row0 = u.pm * 256 + wr * 64 + fr;
        const float* ROPE = (const float*)(ws + WS_ROPE);
#pragma unroll
        for (int ai = 0; ai < 2; ++ai)
#pragma unroll
            for (int m = 0; m < 4; ++m) {
                const int row = row0 + ai * 128 + m * 16, b = row >> 12, t = row & 4095;
                const float* rp = ROPE + (size_t)row * 48;
#pragma unroll
                for (int bj = 0; bj < 2; ++bj) {
                    f32x4 v0 = acc[ai][bj][m][0], v1 = acc[ai][bj][m][1];
                    const int d0 = 32 * wc + 4 * fq;
                    if (pn < 6) {
                        size_t off;
                        if (pn < 4) off = WS_QA + (((size_t)(b * HA + pn * 2 + bj) * T + t) * HD) * 2;
                        else off = (pn == 4 ? WS_KA : WS_VA) + (((size_t)(b * HAKV + bj) * T + t) * HD) * 2;
                        h16* dst = (h16*)(ws + off);
                        if (pn < 5 && wc == 0) {
                            const f32x4 c = *(const f32x4*)(rp + 4 * fq), s = *(const f32x4*)(rp + 16 + 4 * fq);
                            const f32x4 y0 = v0 * c - v1 * s, y1 = v1 * c + v0 * s; v0 = y0; v1 = y1;
                        }
                        st4h(dst + d0, v0); st4h(dst + d0 + 16, v1);
                    } else if (pn < 11) {
                        const bool is_q = pn < 10;
                        if (is_q || bj == 0) {
                            if (is_q || wc < 2) {
                                const int dd = 32 * (wc & 1) + 4 * fq;
                                const size_t off = is_q ? WS_QI + ((size_t)row * 1024 + ((pn - 6) * 4 + 2 * bj + (wc >> 1)) * 64) * 2 : WS_KI + ((size_t)row * 64) * 2;
                                h16* dst = (h16*)(ws + off);
                                if ((wc & 1) == 0) {
                                    f32x4 pr;
#pragma unroll
                                    for (int j = 0; j < 4; ++j) pr[j] = __shfl_xor(v0[j], 32);
                                    const f32x4 c = *(const f32x4*)(rp + 32 + 4 * (fq & 1)), s = *(const f32x4*)(rp + 40 + 4 * (fq & 1));
                                    v0 = (fq < 2) ? (v0 * c - pr * s) : (v0 * c + pr * s);
                                }
                                st4h(dst + dd, v0); st4h(dst + dd + 16, v1);
                            } else if (wc == 2) {
                                *(f32x4*)((float*)(ws + WS_WI) + (size_t)row * 16 + 4 * fq) = v0 * 0.03125f;
                                if (fq < 2) { const f32x4 bf = *(const f32x4*)(b_f + 4 * fq); f32x4 o;
#pragma unroll
                                    for (int j = 0; j < 4; ++j) o[j] = logsigmoidf_(v1[j] + bf[j]);
                                    *(f32x4*)((float*)(ws + WS_LOGF) + (size_t)row * 8 + 4 * fq) = o; }
                            }
                        }
                    } else if (pn < 23) {
                        const int q = pn - 11, which = q >> 2, head = (q & 3) * 2 + bj;
                        h16* dst = (h16*)(ws + WS_QB + (size_t)which * (WS_KB - WS_QB)) + ((size_t)(b * HB + head) * T + t) * HD;
                        st4h(dst + d0, v0); st4h(dst + d0 + 16, v1);
                    } else {
                        const int q = pn - 23; const int col = (q & 7) * 256 + 128 * bj + d0;
                        h16* base = (h16*)(ws + WS_SIGA + (size_t)(q >> 3) * (WS_SIGB - WS_SIGA));
#pragma unroll
                        for (int j = 0; j < 4; ++j) { v0[j] = sigmoidf_(v0[j]); v1[j] = sigmoidf_(v1[j]); }
                        st4h(base + (size_t)row * DM + col, v0); st4h(base + (size_t)row * DM + col + 16, v1);
                    }
                }
            }
    }
};
static_assert(WS_VB - WS_KB == WS_KB - WS_QB, "QB/KB/VB equally spaced");
template <bool FIRST> struct EpiGate {
    const h16* SIG; h16* MIXED;
    __device__ __forceinline__ void operator()(const Acc& acc, const Unit& u, int wr, int wc, int fr, int fq) const {
        const int row0 = u.pm * 256 + wr * 64 + fr, col0 = u.pn * 256 + 32 * wc + 4 * fq;
#pragma unroll
        for (int ai = 0; ai < 2; ++ai)
#pragma unroll
            for (int m = 0; m < 4; ++m)
#pragma unroll
                for (int bj = 0; bj < 2; ++bj)
#pragma unroll
                    for (int n = 0; n < 2; ++n) { const size_t off = (size_t)(row0 + ai * 128 + m * 16) * DM + col0 + bj * 128 + n * 16;
                        f32x4 v = ld4h(SIG + off) * acc[ai][bj][m][n]; if (!FIRST) v += ld4h(MIXED + off); st4h(MIXED + off, v); }
    }
};
struct EpiResid {
    const float* BASE; float* OUT;
    __device__ __forceinline__ void operator()(const Acc& acc, const Unit& u, int wr, int wc, int fr, int fq) const {
        const int row0 = u.pm * 256 + wr * 64 + fr, col0 = u.pn * 256 + 32 * wc + 4 * fq;
#pragma unroll
        for (int ai = 0; ai < 2; ++ai)
#pragma unroll
            for (int m = 0; m < 4; ++m)
#pragma unroll
                for (int bj = 0; bj < 2; ++bj)
#pragma unroll
                    for (int n = 0; n < 2; ++n) { const size_t off = (size_t)(row0 + ai * 128 + m * 16) * DM + col0 + bj * 128 + n * 16;
                        *(f32x4*)(OUT + off) = *(const f32x4*)(BASE + off) + acc[ai][bj][m][n]; }
    }
};
struct EpiSwiGLU {
    h16* ACT;
    __device__ __forceinline__ void operator()(const Acc& acc, const Unit& u, int wr, int wc, int fr, int fq) const {
        const int row0 = u.pm * 256 + wr * 64 + fr;
#pragma unroll
        for (int ai = 0; ai < 2; ++ai)
#pragma unroll
            for (int m = 0; m < 4; ++m)
#pragma unroll
                for (int bj = 0; bj < 2; ++bj) { const f32x4 g = acc[ai][bj][m][0], uu = acc[ai][bj][m][1]; f32x4 o;
#pragma unroll
                    for (int j = 0; j < 4; ++j) o[j] = g[j] * sigmoidf_(g[j]) * uu[j];
                    st4h(ACT + (size_t)(row0 + ai * 128 + m * 16) * DFF + 16 * (u.pn * 8 + bj * 4 + wc) + 4 * fq, o); }
    }
};
struct EpiStoreH {
    h16* O; int ldc;
    __device__ __forceinline__ void operator()(const Acc& acc, const Unit& u, int wr, int wc, int fr, int fq) const {
        const int row0 = u.pm * 256 + wr * 64 + fr, col0 = u.pn * 256 + 32 * wc + 4 * fq;
#pragma unroll
        for (int ai = 0; ai < 2; ++ai)
#pragma unroll
            for (int m = 0; m < 4; ++m)
#pragma unroll
                for (int bj = 0; bj < 2; ++bj)
#pragma unroll
                    for (int n = 0; n < 2; ++n) st4h(O + (size_t)(row0 + ai * 128 + m * 16) * ldc + col0 + bj * 128 + n * 16, acc[ai][bj][m][n]);
    }
};
struct EpiPLE {
    const h16* PP; float* X;
    __device__ __forceinline__ void operator()(const Acc& acc, const Unit& u, int wr, int wc, int fr, int fq) const {
        const int row0 = u.pm * 256 + wr * 64 + fr, col0 = u.pn * 256 + 32 * wc + 4 * fq;
#pragma unroll
        for (int ai = 0; ai < 2; ++ai)
#pragma unroll
            for (int m = 0; m < 4; ++m)
#pragma unroll
                for (int bj = 0; bj < 2; ++bj)
#pragma unroll
                    for (int n = 0; n < 2; ++n) { const size_t off = (size_t)(row0 + ai * 128 + m * 16) * DM + col0 + bj * 128 + n * 16;
                        const f32x4 a = acc[ai][bj][m][n], pp = ld4h(PP + off); f32x4 x = *(const f32x4*)(X + off);
#pragma unroll
                        for (int j = 0; j < 4; ++j) x[j] += sigmoidf_(a[j]) * pp[j];
                        *(f32x4*)(X + off) = x; }
    }
};


__device__ __forceinline__ int map_in(int p) {
    if (p < 2560) return p;
    if (p < 2816) { const int c = p - 2560; if (c < 64) return 2560 + c; if (c < 80) return 2624 + (c - 64); if (c < 88) return 5712 + (c - 80); return -1; }
    const int q = p - 2816; if (q < 3072) return 2640 + q; return 5720 + (q - 3072);
}
template <int MODE>
__device__ __forceinline__ void ph_transpose(const float* W0, const float* W1, int K, int Nsrc, h16* WT, int Nphys, LAS float* scr, int gw, int NGW, int lane) {
    const int nblk = Nphys / 32, nitems = (K / 64) * nblk;
    for (int item = gw; item < nitems; item += NGW) {
        const int kb = item / nblk, nb = item % nblk, k0 = 64 * kb, n0 = 32 * nb;
        const int n = n0 + (lane & 31);
        const float* src = nullptr;
        if (MODE == 0) { if (n < Nsrc) src = W0 + n; }
        else if (MODE == 1) { const int c = map_in(n); if (c >= 0) src = W0 + c; }
        else { src = (((n >> 4) & 1) ? W1 : W0) + 16 * (n >> 5) + (n & 15); }
#pragma unroll 8
        for (int i = 0; i < 32; ++i) { const int kk = 2 * i + (lane >> 5); scr[kk * 33 + (lane & 31)] = src ? src[(size_t)(k0 + kk) * Nsrc] : 0.f; }
        __builtin_amdgcn_wave_barrier(); asm volatile("s_waitcnt lgkmcnt(0)" ::: "memory");
        const int c = lane & 7;
#pragma unroll
        for (int j = 0; j < 4; ++j) { const int nn = (lane >> 3) + 8 * j; const LAS float* s = scr + (8 * c) * 33 + nn;
            h16x8 o;
#pragma unroll
            for (int e = 0; e < 8; ++e) o[e] = (h16)s[e * 33];
            *(h16x8*)(WT + (size_t)(n0 + nn) * K + k0 + 8 * c) = o; }
        __builtin_amdgcn_wave_barrier(); asm volatile("s_waitcnt lgkmcnt(0)" ::: "memory");
    }
}
__device__ __forceinline__ void sincos_f32arg(float ang, float& sn, float& cs) {
    const double a = (double)ang;
    const double rev = a * 0.15915494309189535;
    const double fr = rev - __builtin_rint(rev);
    const double q4 = fr * 4.0; const double qi = __builtin_rint(q4); const int qq = ((int)qi) & 3;
    const double r = (q4 - qi) * 1.5707963267948966;
    const double r2 = r * r;
    const double s = r * (1.0 + r2 * (-1.0 / 6 + r2 * (1.0 / 120 + r2 * (-1.0 / 5040 + r2 * (1.0 / 362880 + r2 * (-1.0 / 39916800))))));
    const double c = 1.0 + r2 * (-0.5 + r2 * (1.0 / 24 + r2 * (-1.0 / 720 + r2 * (1.0 / 40320 + r2 * (-1.0 / 3628800 + r2 * (1.0 / 479001600))))));
    double so, co;
    if (qq == 0) { so = s; co = c; } else if (qq == 1) { so = c; co = -s; } else if (qq == 2) { so = -s; co = -c; } else { so = -c; co = s; }
    sn = (float)so; cs = (float)co;
}
__device__ __forceinline__ void ph_rope(const int* pos, float* ROPE, int gtid, int NGT) {
    for (int idx = gtid; idx < MTOK * 24; idx += NGT) {
        const int tok = idx / 24, i = idx % 24, k = i < 16 ? i : 2 * (i - 16);
        float f = 0x1.000000p+0f;
        f = k == 1 ? 0x1.c2ef76p-2f : f; f = k == 2 ? 0x1.8d275ep-3f : f; f = k == 3 ? 0x1.5dc95ap-4f : f; f = k == 4 ? 0x1.341190p-5f : f; f = k == 5 ? 0x1.0f5384p-6f : f;
        f = k == 6 ? 0x1.ddee9cp-8f : f; f = k == 7 ? 0x1.a4ee3ep-9f : f; f = k == 8 ? 0x1.72ba44p-10f : f; f = k == 9 ? 0x1.468318p-11f : f; f = k == 10 ? 0x1.1f91f0p-12f : f;
        f = k == 11 ? 0x1.fa8b84p-14f : f; f = k == 12 ? 0x1.be218ap-15f : f; f = k == 13 ? 0x1.88ec22p-16f : f; f = k == 14 ? 0x1.5a0f50p-17f : f; f = k == 15 ? 0x1.30c94ep-18f : f;
        const float ang = (float)pos[tok] * f;
        float sn, cs; sincos_f32arg(ang, sn, cs);
        float* rp = ROPE + (size_t)tok * 48;
        if (i < 16) { rp[i] = cs; rp[16 + i] = sn; } else { rp[32 + (i - 16)] = cs; rp[40 + (i - 16)] = sn; }
    }
}
template <bool TO_F32>
__device__ __forceinline__ void ph_rmsnorm(const float* X, const float* g, h16* OUTH, float* OUTF, int gw, int NGW, int lane) {
    for (int row = gw; row < MTOK; row += NGW) {
        const f32x4* xr = (const f32x4*)(X + (size_t)row * DM) + lane;
        f32x4 v[8]; float s = 0.f;
#pragma unroll
        for (int j = 0; j < 8; ++j) { v[j] = xr[64 * j]; s += (v[j][0] * v[j][0] + v[j][1] * v[j][1]) + (v[j][2] * v[j][2] + v[j][3] * v[j][3]); }
        const float r = 1.0f / sqrtf(wave_sum(s) * (1.0f / DM) + EPS);
#pragma unroll
        for (int j = 0; j < 8; ++j) { const f32x4 gg = *((const f32x4*)g + lane + 64 * j); const f32x4 o = v[j] * r * gg;
            if (TO_F32) *((f32x4*)(OUTF + (size_t)row * DM) + lane + 64 * j) = o; else st4h(OUTH + (size_t)row * DM + 4 * (lane + 64 * j), o); }
    }
}
__device__ __forceinline__ void ph_cumsum(const float* LOGF, float* CB, float* NBQ, int bh, int lane) {
    const int b = bh >> 3, h = bh & 7;
    float loc[64]; float s = 0.f;
#pragma unroll
    for (int i = 0; i < 64; ++i) { s += LOGF[(size_t)(b * T + lane * 64 + i) * 8 + h]; loc[i] = s; }
    float inc = s;
#pragma unroll
    for (int o = 1; o < 64; o <<= 1) { const float nb = __shfl_up(inc, o); if (lane >= o) inc += nb; }
    const float base = inc - s;
#pragma unroll
    for (int i = 0; i < 64; ++i) { loc[i] += base; CB[(size_t)bh * T + lane * 64 + i] = loc[i]; }
#pragma unroll 1
    for (int qb = 0; qb < 16; ++qb) {
        const float ref = __shfl(loc[63], 4 * qb + 3);
        if (lane < 4 * (qb + 1)) { float* dst = NBQ + ((size_t)bh * 16 + qb) * T + lane * 64;
#pragma unroll
            for (int i = 0; i < 64; ++i) dst[i] = (ref - loc[i]) * 11.313708498984761f; }
    }
}

__device__ __forceinline__ unsigned fkey(float f) { const unsigned u = __float_as_uint(f + 0.0f); return (u & 0x80000000u) ? ~u : (u | 0x80000000u); }
__device__ __forceinline__ unsigned count_ge(const unsigned (&key)[64], unsigned th) {
    unsigned c = 0;
#pragma unroll
    for (int j = 0; j < 64; ++j) c += (unsigned)__builtin_popcountll(__ballot(key[j] >= th));
    return c;
}
__device__ __forceinline__ u64 topk_select(const unsigned (&key)[64], int nvalid, int lane) {
    u64 myword = 0;
    if (nvalid <= TOPK) {
#pragma unroll
        for (int j = 0; j < 64; ++j) { const u64 bal = __ballot(key[j] != 0u); if (lane == j) myword = bal; }
    } else {
        unsigned th = 0u; bool exact = false;
        for (int bit = 31; bit >= 0; --bit) { const unsigned tc = th | (1u << bit); const unsigned c = count_ge(key, tc); if (c >= (unsigned)TOPK) th = tc; if (c == (unsigned)TOPK) { exact = true; break; } }
        if (exact) {
#pragma unroll
            for (int j = 0; j < 64; ++j) { const u64 bal = __ballot(key[j] >= th); if (lane == j) myword = bal; }
        } else {
            unsigned cgt = 0;
#pragma unroll
            for (int j = 0; j < 64; ++j) cgt += (unsigned)__builtin_popcountll(__ballot(key[j] > th));
            int need = TOPK - (int)cgt;
#pragma unroll
            for (int j = 0; j < 64; ++j) { u64 eq = __ballot(key[j] == th); const u64 gt = __ballot(key[j] > th);
                int pc = __builtin_popcountll(eq);
                while (pc > need) { eq &= ~(1ull << (63 - __builtin_clzll(eq))); --pc; }
                need -= pc; if (lane == j) myword = gt | eq; }
        }
    }
    return myword;
}
__device__ __forceinline__ void ph_topk_naive(const h16* QI, const h16* KI, const float* WI, u64* MASK, LAS float* qs, LAS unsigned* ks, int gw, int NGW, int lane) {
    for (int row = gw; row < MTOK; row += NGW) {
        const int b = row >> 12, t = row & 4095;
        { const h16* qp = QI + (size_t)row * 1024 + lane * 16;
#pragma unroll
          for (int i = 0; i < 16; ++i) qs[lane * 16 + i] = (float)qp[i]; }
        if (lane < 16) qs[1024 + lane] = WI[(size_t)row * 16 + lane];
        __builtin_amdgcn_wave_barrier(); asm volatile("s_waitcnt lgkmcnt(0)" ::: "memory");
#pragma unroll 1
        for (int j = 0; j < 64; ++j) {
            unsigned kk = 0u;
            const int s = 64 * j + lane;
            if (s <= t) {
                float kf[64];
                const h16x8* kp = (const h16x8*)(KI + (size_t)(b * T + s) * 64);
#pragma unroll
                for (int c = 0; c < 8; ++c) { const h16x8 kv = kp[c];
#pragma unroll
                    for (int e = 0; e < 8; ++e) kf[c * 8 + e] = (float)kv[e]; }
                float sc = 0.f;
#pragma unroll 1
                for (int h = 0; h < 16; ++h) { float d = 0.f;
#pragma unroll
                    for (int e = 0; e < 64; ++e) d = fmaf(qs[h * 64 + e], kf[e], d);
                    sc = fmaf(qs[1024 + h], fmaxf(d, 0.f), sc); }
                kk = fkey(sc);
            }
            ks[j * 64 + lane] = kk;
        }
        __builtin_amdgcn_wave_barrier(); asm volatile("s_waitcnt lgkmcnt(0)" ::: "memory");
        unsigned key[64];
#pragma unroll
        for (int j = 0; j < 64; ++j) key[j] = ks[j * 64 + lane];
        MASK[(size_t)row * 64 + lane] = topk_select(key, t + 1, lane);
        __builtin_amdgcn_wave_barrier(); asm volatile("s_waitcnt lgkmcnt(0)" ::: "memory");
    }
}


namespace idx {
typedef short s16x8 __attribute__((ext_vector_type(8)));
typedef float f32x16 __attribute__((ext_vector_type(16)));
constexpr int CHK = 128, CHB = CHK * 128;
__device__ __forceinline__ unsigned half_sum(unsigned v) {
#pragma unroll
    for (int o = 1; o < 32; o <<= 1) v += __shfl_xor(v, o);
    return v;
}
__device__ __forceinline__ void run_group(unsigned char* ws, char* lds, int b, int g) {
    int tid = threadIdx.x; asm volatile("" : "+v"(tid));
    const int wid = __builtin_amdgcn_readfirstlane(tid >> 6), lane = tid & 63, c = lane & 31, hi = lane >> 5;
    const int t0 = 16 * g + 2 * wid, t = t0 + hi, row = b * T + t, tmaxblk = 16 * g + 15, nch = (tmaxblk >> 7) + 1;
    const h16* QI = (const h16*)(ws + WS_QI); const char* KIb = (const char*)ws + WS_KI + (size_t)b * T * 128; const float* WI = (const float*)(ws + WS_WI);
    s16x8 A[4];
    { const int rho = c, qsel = (rho >> 2) & 1, head = (rho & 3) + 4 * (rho >> 3);
      const h16* qp = QI + (size_t)(b * T + t0 + qsel) * 1024 + head * 64 + 8 * hi;
#pragma unroll
      for (int ks = 0; ks < 4; ++ks) A[ks] = *reinterpret_cast<const s16x8*>(qp + 16 * ks); }
    float w[16];
    { const f32x4* wp = (const f32x4*)(WI + (size_t)row * 16);
#pragma unroll
      for (int i = 0; i < 4; ++i) { const f32x4 v = wp[i]; w[4 * i] = v[0]; w[4 * i + 1] = v[1]; w[4 * i + 2] = v[2]; w[4 * i + 3] = v[3]; } }
    const int pr0 = tid >> 3, pp = tid & 7;
    const unsigned g_off = (unsigned)(pr0 * 128 + pp * 16);
    const int l_off0 = pr0 * 128 + ((pp ^ ((pr0 >> 1) & 7)) << 4), l_off1 = l_off0 + 64 * 128;
    const int rd_base = c * 128; const int sw = (c >> 1) & 7;
    int rd_off[4];
#pragma unroll
    for (int ks = 0; ks < 4; ++ks) rd_off[ks] = rd_base + (((2 * ks + hi) ^ sw) << 4);
    unsigned kreg[128];
    s16x8 st0, st1;
    { const char* src = KIb; st0 = *reinterpret_cast<const s16x8*>(src + g_off); st1 = *reinterpret_cast<const s16x8*>(src + 64 * 128 + g_off); }
    *reinterpret_cast<s16x8*>(lds + l_off0) = st0; *reinterpret_cast<s16x8*>(lds + l_off1) = st1;
    __syncthreads();
#pragma unroll
    for (int ch = 0; ch < 32; ++ch) {
        if (ch < nch) {
            const char* buf = lds + (ch & 1) * CHB;
            if (ch + 1 < nch) { const char* src = KIb + (size_t)(ch + 1) * CHB; st0 = *reinterpret_cast<const s16x8*>(src + g_off); st1 = *reinterpret_cast<const s16x8*>(src + 64 * 128 + g_off); }
#pragma unroll
            for (int st = 0; st < 4; ++st) {
                f32x16 acc = {};
#pragma unroll
                for (int ks = 0; ks < 4; ++ks) { const s16x8 Bf = *reinterpret_cast<const s16x8*>(buf + st * 4096 + rd_off[ks]);
                    acc = __builtin_amdgcn_mfma_f32_32x32x16_f16(__builtin_bit_cast(h16x8, A[ks]), __builtin_bit_cast(h16x8, Bf), acc, 0, 0, 0); }
                float sc = 0.f;
#pragma unroll
                for (int r = 0; r < 16; ++r) sc = fmaf(w[r], fmaxf(acc[r], 0.f), sc);
                const int sidx = ch * CHK + st * 32 + c;
                { unsigned kv_ = (sidx <= t) ? fkey(sc) : 0u; asm volatile("" : "+v"(kv_)); kreg[ch * 4 + st] = kv_; }
            }
            if (ch + 1 < nch) { char* dst = lds + ((ch + 1) & 1) * CHB; *reinterpret_cast<s16x8*>(dst + l_off0) = st0; *reinterpret_cast<s16x8*>(dst + l_off1) = st1; }
            __syncthreads();
        } else {
#pragma unroll
            for (int st = 0; st < 4; ++st) kreg[ch * 4 + st] = 0u;
        }
    }
    bool done = (t < TOPK); unsigned th = done ? 1u : 0u;
    for (int bit = 31; bit >= 0; --bit) {
        if (__all(done)) break;
        const unsigned tc = th | (1u << bit);
        unsigned cnt = 0;
#pragma unroll
        for (int s_ = 0; s_ < 128; ++s_) cnt += (kreg[s_] >= tc) ? 1u : 0u;
        cnt = half_sum(cnt);
        if (!done) { if (cnt >= (unsigned)TOPK) th = tc; if (cnt == (unsigned)TOPK) done = true; }
    }
    int need = 0; const bool tie = !done;
    if (__any(tie)) {
        unsigned cgt = 0;
#pragma unroll
        for (int s_ = 0; s_ < 128; ++s_) cgt += (kreg[s_] > th) ? 1u : 0u;
        cgt = half_sum(cgt); need = TOPK - (int)cgt;
    }
    u64 w0 = 0, w1 = 0;
#pragma unroll
    for (int j = 0; j < 64; ++j) {
        u64 bal[2];
#pragma unroll
        for (int e = 0; e < 2; ++e) {
            const unsigned k = kreg[2 * j + e];
            bool sel = tie ? (k > th) : (k >= th);
            if (__any(tie)) {
                const u64 eqm = __ballot(tie && k == th);
                const unsigned mine = (unsigned)(eqm >> (32 * hi));
                const int pc = __builtin_popcount(mine);
                unsigned keep = mine; int kc = pc;
                while (kc > (need > 0 ? need : 0)) { keep &= ~(1u << (31 - __builtin_clz(keep))); --kc; }
                if (tie) { need -= kc; if ((keep >> c) & 1u) sel = true; }
            }
            bal[e] = __ballot(sel);
        }
        const u64 q0 = (bal[0] & 0xffffffffull) | (bal[1] << 32), q1 = (bal[0] >> 32) | (bal[1] & 0xffffffff00000000ull);
        if (lane == j) { w0 = q0; w1 = q1; }
    }
    u64* MASK = (u64*)(ws + WS_MASK);
    MASK[(size_t)(b * T + t0) * 64 + lane] = w0;
    MASK[(size_t)(b * T + t0 + 1) * 64 + lane] = w1;
}
}

namespace att {
constexpr int NW = 8, QBLK = 32, KVBLK = 64, QB = NW * QBLK, D = 128;
constexpr int SHM_V = KVBLK * D * 2, SHM_K = KVBLK * D * 2;
constexpr int LDS_NEED = 2 * SHM_V + 2 * SHM_K + NW * 64 * 4;
constexpr float THR = 8.f, SCALE = 0.08838834764831845f;
typedef short s16x8 __attribute__((ext_vector_type(8)));
typedef short s16x4 __attribute__((ext_vector_type(4)));
typedef float f32x16 __attribute__((ext_vector_type(16)));
#define KSWZ(row, colB) ((row) * 256 + ((colB) ^ (((row) & 7) << 4)))
#define SBAR() __builtin_amdgcn_sched_barrier(0)
__device__ __forceinline__ int v_st(int k, int c) { const int kk = (k & ~0xC) | ((k & 4) << 1) | ((k & 8) >> 1); return ((kk >> 3) * 4 + (c >> 5)) * 512 + ((kk & 7) * 32 + (c & 31)) * 2; }
__device__ __forceinline__ int v_rd_base(int lane) { return ((lane & 3) << 3) | (((lane >> 2) & 3) << 6) | (((lane >> 4) & 1) << 5) | (((lane >> 5) & 1) << 8); }
constexpr int v_rd_off(int d0, int ks, int half) { return d0 * 512 + ks * 4096 + half * 2048; }
__device__ __forceinline__ int crow(int r, int hi) { return (r & 3) + 8 * (r >> 2) + 4 * hi; }
__device__ __forceinline__ unsigned cvtpk(float lo, float hi) { unsigned r; asm volatile("v_cvt_pk_f16_f32 %0, %1, %2" : "=v"(r) : "v"(lo), "v"(hi)); return r; }
__device__ __forceinline__ f32x16 mfma16(s16x8 a, s16x8 b, f32x16 c) { return __builtin_amdgcn_mfma_f32_32x32x16_f16(__builtin_bit_cast(h16x8, a), __builtin_bit_cast(h16x8, b), c, 0, 0, 0); }
__device__ __forceinline__ s16x8 load8(const h16* p) { return *reinterpret_cast<const s16x8*>(p); }
__device__ __forceinline__ void mask_causal(f32x16& p0, f32x16& p1, int dq) {
    const float NEG = -__builtin_inff();
#pragma unroll
    for (int r = 0; r < 16; ++r) { const int c = (r & 3) + 8 * (r >> 2); if (dq - c < 0) p0[r] = NEG; if (dq - c - 32 < 0) p1[r] = NEG; }
}
__device__ __forceinline__ void mask_bits(f32x16& p0, f32x16& p1, u64 w, int hi) {
    const float NEG = -__builtin_inff();
    const unsigned lo = (unsigned)w >> (4 * hi), up = (unsigned)(w >> 32) >> (4 * hi);
#pragma unroll
    for (int r = 0; r < 16; ++r) { const int c = (r & 3) + 8 * (r >> 2); if (!((lo >> c) & 1u)) p0[r] = NEG; if (!((up >> c) & 1u)) p1[r] = NEG; }
}
__device__ __forceinline__ void partialSM(f32x16& p0, f32x16& p1, float& m_reg, float& mn, float& alpha) {
    float pmax = p0[0]; for (int r = 1; r < 16; ++r) pmax = fmaxf(pmax, p0[r]); for (int r = 0; r < 16; ++r) pmax = fmaxf(pmax, p1[r]);
    { auto rr = __builtin_amdgcn_permlane32_swap(__float_as_uint(pmax), __float_as_uint(pmax), false, false);
      pmax = fmaxf(__uint_as_float(rr[0]), __uint_as_float(rr[1])); }
    constexpr float C2 = 1.4426950408889634f * SCALE;
    if (__builtin_expect(__all((pmax - m_reg) * SCALE <= THR), 1)) { mn = m_reg; alpha = 1.f; }
    else { mn = fmaxf(m_reg, pmax); alpha = __builtin_amdgcn_exp2f((m_reg - mn) * C2); m_reg = mn; }
    const float mnL = -mn * C2;
    for (int r = 0; r < 16; ++r) p0[r] = fmaf(p0[r], C2, mnL); for (int r = 0; r < 16; ++r) p1[r] = fmaf(p1[r], C2, mnL);
    for (int r = 0; r < 16; ++r) p0[r] = __builtin_amdgcn_exp2f(p0[r]);
}
__device__ __forceinline__ void finishSM(f32x16& p0, f32x16& p1, float alpha, float& l_reg, s16x8& pa0, s16x8& pa1, s16x8& pa2, s16x8& pa3) {
    for (int r = 0; r < 16; ++r) p1[r] = __builtin_amdgcn_exp2f(p1[r]);
    float ps = 0; for (int r = 0; r < 16; ++r) ps += p0[r]; for (int r = 0; r < 16; ++r) ps += p1[r];
    { auto rr = __builtin_amdgcn_permlane32_swap(__float_as_uint(ps), __float_as_uint(ps), false, false);
      ps = __uint_as_float(rr[0]) + __uint_as_float(rr[1]); }
    l_reg = l_reg * alpha + ps;
#define PK4(P, B_, OUT) do { unsigned a0 = cvtpk(P[B_+0], P[B_+1]), a1 = cvtpk(P[B_+2], P[B_+3]);                          \
        unsigned b0 = cvtpk(P[B_+4], P[B_+5]), b1 = cvtpk(P[B_+6], P[B_+7]);                                             \
        auto r0 = __builtin_amdgcn_permlane32_swap(a0, b0, false, false); auto r1 = __builtin_amdgcn_permlane32_swap(a1, b1, false, false); \
        u32x4 w = {r0[0], r1[0], r0[1], r1[1]}; OUT = *reinterpret_cast<s16x8*>(&w); } while (0)
    PK4(p0, 0, pa0); PK4(p0, 8, pa1); PK4(p1, 0, pa2); PK4(p1, 8, pa3);
#undef PK4
}
template <int KB>
__device__ __forceinline__ void qkt(f32x16& p0, f32x16& p1, const char* K_lds, int r32, int hi, const s16x8* qr) {
    const char* kb[4];
#pragma unroll
    for (int dd = 0; dd < 4; ++dd) kb[dd] = K_lds + KB * SHM_K + KSWZ(r32, (dd * 16 + hi * 8) * 2);
#pragma unroll
    for (int d0 = 0; d0 < 8; ++d0) { const char* a = kb[d0 & 3] + (d0 >> 2) * 128;
        s16x8 b0 = *reinterpret_cast<const s16x8*>(a);
        s16x8 b1 = *reinterpret_cast<const s16x8*>(a + 32 * 256);
        p0 = mfma16(b0, qr[d0], p0);
        p1 = mfma16(b1, qr[d0], p1); }
}
template <int VB>
__device__ __forceinline__ void pv_tile(f32x16* o, int vb0, s16x8 pa0, s16x8 pa1, s16x8 pa2, s16x8 pa3) {
#define TRRD(dst, off) asm volatile("ds_read_b64_tr_b16 %0, %1 offset:%2" : "=&v"(dst) : "v"(vb0), "i"(off) : "memory")
#define PV_D0(d0) do { s16x4 l0, l1, l2, l3, h0, h1, h2, h3; constexpr int b_ = VB * SHM_V + v_rd_off(d0, 0, 0); \
        TRRD(l0, b_); TRRD(h0, b_ + 2048); TRRD(l1, b_ + 4096); TRRD(h1, b_ + 6144); TRRD(l2, b_ + 8192); TRRD(h2, b_ + 10240); TRRD(l3, b_ + 12288); TRRD(h3, b_ + 14336); \
        asm volatile("s_waitcnt lgkmcnt(0)" ::: "memory"); SBAR();   \
        o[d0] = mfma16(pa0, (s16x8){l0[0], l0[1], l0[2], l0[3], h0[0], h0[1], h0[2], h0[3]}, o[d0]);   \
        o[d0] = mfma16(pa1, (s16x8){l1[0], l1[1], l1[2], l1[3], h1[0], h1[1], h1[2], h1[3]}, o[d0]);   \
        o[d0] = mfma16(pa2, (s16x8){l2[0], l2[1], l2[2], l2[3], h2[0], h2[1], h2[2], h2[3]}, o[d0]);   \
        o[d0] = mfma16(pa3, (s16x8){l3[0], l3[1], l3[2], l3[3], h3[0], h3[1], h3[2], h3[3]}, o[d0]); } while (0)
    PV_D0(0); PV_D0(1); PV_D0(2); PV_D0(3);
#undef PV_D0
#undef TRRD
}
struct BlockRef { const char* Q; const char* K; const char* V; char* O; int P0; const char* NBQ; const char* MK; };
struct Seam { s16x8 qr[8]; s16x8 st_v0, st_v1, st_k0, st_k1; };
#define LD16(base, off) (*reinterpret_cast<const s16x8*>((base) + (off)))
#define VMW() asm volatile("s_waitcnt vmcnt(0)" ::: "memory")
#define VMWN(n) asm volatile("s_waitcnt vmcnt(%0)" :: "i"(n) : "memory")
#define SLOAD_H(Kp, Vp, k0) do { const char* vb_ = (Vp) + (size_t)(k0) * (D * 2); const char* kb_ = (Kp) + (size_t)(k0) * (D * 2); \
        S.st_v0 = LD16(vb_, st_off); S.st_v1 = LD16(vb_ + 32 * D * 2, st_off); S.st_k0 = LD16(kb_, st_off); S.st_k1 = LD16(kb_ + 32 * D * 2, st_off); } while (0)
#define SWRITE_HK(bf) do { *(s16x8*)(K_lds + (bf) * SHM_K + kws) = S.st_k0; *(s16x8*)(K_lds + (bf) * SHM_K + kws + 32 * 256) = S.st_k1; } while (0)
#define SWRITE_HV(bf) do { *(s16x8*)(V_lds + (bf) * SHM_V + vst0) = S.st_v0; *(s16x8*)(V_lds + (bf) * SHM_V + vst1) = S.st_v1; } while (0)
#define SWRITE_H(bf) do { SWRITE_HV(bf); SWRITE_HK(bf); } while (0)
__device__ __forceinline__ void prime(const BlockRef& cur, char* lds, Seam& S) {
    int tid = threadIdx.x; asm volatile("" : "+v"(tid));
    const int wid = __builtin_amdgcn_readfirstlane(tid >> 6), lane = tid & 63, r32 = lane & 31, hi = lane >> 5;
    const int sr = tid >> 4, sc = (tid & 15) * 8, kws = KSWZ(sr, sc * 2); char* K_lds = lds + 2 * SHM_V;
    const unsigned st_off = (unsigned)(sr * D + sc) * 2u, q_off = (unsigned)((wid * QBLK + r32) * D + hi * 8) * 2u;
#pragma unroll
    for (int d0 = 0; d0 < 8; ++d0) S.qr[d0] = LD16(cur.Q + d0 * 32, q_off);
    SLOAD_H(cur.K, cur.V, 0); VMW(); SWRITE_HK(0);
    __syncthreads();
}
template <bool MIXB>
__device__ __forceinline__ void block(const BlockRef& cur, const BlockRef& nxt, char* lds, Seam& S) {
    int tid = threadIdx.x; asm volatile("" : "+v"(tid));
    const int wid = __builtin_amdgcn_readfirstlane(tid >> 6), lane = tid & 63, r32 = lane & 31, hi = lane >> 5;
    const int NT = cur.P0 / KVBLK + 4;
    const int qlo = cur.P0 + wid * QBLK, qm = qlo + r32 - 4 * hi;
    char* V_lds = lds; char* K_lds = lds + 2 * SHM_V;
    float* wsf = (float*)(lds + 2 * SHM_V + 2 * SHM_K) + wid * 64; float* li_l = wsf, * al_l = wsf + 32;
    float m_reg = -1e30f, l_reg = 0; f32x16 o[4] = {};
    const int sr = tid >> 4, sc = (tid & 15) * 8, vst0 = v_st(sr, sc), vst1 = v_st(32 + sr, sc), kws = KSWZ(sr, sc * 2);
    const int vb0 = (int)(uintptr_t)V_lds + v_rd_base(lane);
    const unsigned st_off = (unsigned)(sr * D + sc) * 2u, q_off = (unsigned)((wid * QBLK + r32) * D + hi * 8) * 2u;
    const unsigned nb_off = (unsigned)hi * 16u, mk_off = (unsigned)(wid * QBLK + r32) * 512u;
    const char* Kh = cur.K; const char* Vh = cur.V;
#define RESC(a) do { if (__any((a) < 1.f)) { if (hi == 0) al_l[r32] = (a); asm volatile("s_waitcnt lgkmcnt(0)" ::: "memory");              \
                     for (int d_ = 0; d_ < 4; ++d_) for (int r = 0; r < 16; ++r) o[d_][r] *= al_l[crow(r, hi)]; } } while (0)
#define KBASE(t) ((t) * KVBLK)
#define PINIT(P0_, P1_, t) do { if (MIXB) { const char* nb_ = cur.NBQ + (size_t)KBASE(t) * 4; _Pragma("unroll") for (int g_ = 0; g_ < 4; ++g_) { \
            const f32x4 b0_ = *(const f32x4*)(nb_ + 32 * g_ + nb_off), b1_ = *(const f32x4*)(nb_ + 128 + 32 * g_ + nb_off); \
            _Pragma("unroll") for (int j_ = 0; j_ < 4; ++j_) { P0_[4 * g_ + j_] = b0_[j_]; P1_[4 * g_ + j_] = b1_[j_]; } } } else { P0_ = f32x16{}; P1_ = f32x16{}; } } while (0)
#define MKW(t) (*(const u64*)(cur.MK + (size_t)(t) * 8 + mk_off))
#define MASKT(P0_, P1_, t, MW_) do { if (MIXB) { const int kb_ = KBASE(t); if (kb_ + KVBLK - 1 > qlo) mask_causal(P0_, P1_, qm - kb_); } else mask_bits(P0_, P1_, MW_, hi); } while (0)
    f32x16 pA0, pA1, pB0, pB1; float mnA, mnB, alA, alB; s16x8 pa0, pa1, pa2, pa3;
    u64 mwA = 0, mwB = 0;
    if (!MIXB) { mwA = MKW(0); if (NT > 1) mwB = MKW(1); }
    PINIT(pA0, pA1, 0);
    if (NT > 1) PINIT(pB0, pB1, 1);
    SWRITE_HV(0); SBAR();
    if (NT > 1) SLOAD_H(Kh, Vh, KBASE(1));
    SBAR(); qkt<0>(pA0, pA1, K_lds, r32, hi, S.qr);
    MASKT(pA0, pA1, 0, mwA); if (!MIXB) { if (NT > 2) mwA = MKW(2); }
    partialSM(pA0, pA1, m_reg, mnA, alA);
    if (NT > 1) { VMW(); SWRITE_H(1); }
    __syncthreads();
#define HALF_STEP(PX0, PX1, mnX, alX, MWX, PY0, PY1, alY, t, KB, VB, SB) do {                                               \
        SBAR(); qkt<KB>(PX0, PX1, K_lds, r32, hi, S.qr);                                                                      \
        finishSM(PY0, PY1, alY, l_reg, pa0, pa1, pa2, pa3); SBAR();                                                           \
        if ((t) + 1 < NT) { PINIT(PY0, PY1, (t) + 1); SLOAD_H(Kh, Vh, KBASE((t) + 1)); SBAR(); }                             \
        pv_tile<VB>(o, vb0, pa0, pa1, pa2, pa3); MASKT(PX0, PX1, (t), MWX); if (!MIXB) { if ((t) + 2 < NT) MWX = MKW((t) + 2); } \
        partialSM(PX0, PX1, m_reg, mnX, alX);                                                                                 \
        __syncthreads();                                                                                                      \
        if ((t) + 1 < NT) { VMW(); SWRITE_H(SB); }                                                                            \
        RESC(alX); __syncthreads(); } while (0)
    for (int t = 1; t + 1 < NT; t += 2) {
        HALF_STEP(pB0, pB1, mnB, alB, mwB, pA0, pA1, alA, t, 1, 0, 0);
        HALF_STEP(pA0, pA1, mnA, alA, mwA, pB0, pB1, alB, t + 1, 0, 1, 1);
    }
    const bool even = (NT & 1) == 0;
    if (even) { SBAR(); qkt<1>(pB0, pB1, K_lds, r32, hi, S.qr); SBAR(); }
    SLOAD_H(nxt.K, nxt.V, 0); SBAR();
#pragma unroll
    for (int d0 = 0; d0 < 8; ++d0) S.qr[d0] = LD16(nxt.Q + d0 * 32, q_off);
    SBAR();
    finishSM(pA0, pA1, alA, l_reg, pa0, pa1, pa2, pa3); SBAR();
    pv_tile<0>(o, vb0, pa0, pa1, pa2, pa3);
    if (even) { MASKT(pB0, pB1, NT - 1, mwB); partialSM(pB0, pB1, m_reg, mnB, alB); __syncthreads(); RESC(alB);
        finishSM(pB0, pB1, alB, l_reg, pa0, pa1, pa2, pa3); SBAR(); pv_tile<1>(o, vb0, pa0, pa1, pa2, pa3); }
    SBAR(); VMWN(8); SWRITE_HK(0); SBAR();
    if (hi == 0) li_l[r32] = l_reg; asm volatile("s_waitcnt lgkmcnt(0)" ::: "memory");
    float rli[16];
#pragma unroll
    for (int r = 0; r < 16; ++r) rli[r] = __builtin_amdgcn_rcpf(li_l[crow(r, hi)]);
    const unsigned o_off = (unsigned)((wid * QBLK + 4 * hi) * 1024 + r32) * 2u;
#pragma unroll
    for (int r = 0; r < 16; ++r) {
#pragma unroll
        for (int d0 = 0; d0 < 4; ++d0) { const float v = o[d0][r] * rli[r];
            const float vn = __shfl_xor(v, 1);
            if ((r32 & 1) == 0) *(unsigned*)(cur.O + (size_t)(((r & 3) + 8 * (r >> 2)) * 2048 + d0 * 64) + o_off) = cvtpk(v, vn); } }
    __syncthreads();
#undef RESC
#undef KBASE
#undef PINIT
#undef MKW
#undef MASKT
#undef HALF_STEP
}
#undef LD16
#undef VMW
#undef VMWN
#undef SLOAD_H
#undef SWRITE_HK
#undef SWRITE_HV
#undef SWRITE_H
__device__ __forceinline__ BlockRef make_ref(bool mixb, unsigned char* ws, int bh, int qb) {
    const int b = bh >> 3, h = bh & 7, kvh = mixb ? bh : (b * HAKV + (h >> 2));
    BlockRef r;
    r.Q = (const char*)ws + (mixb ? WS_QB : WS_QA) + ((size_t)bh * T + (size_t)qb * QB) * D * 2;
    r.K = (const char*)ws + (mixb ? WS_KB : WS_KA) + (size_t)kvh * T * D * 2;
    r.V = (const char*)ws + (mixb ? WS_VB : WS_VA) + (size_t)kvh * T * D * 2;
    r.O = (char*)ws + (mixb ? WS_OUTB : WS_OUTA) + ((size_t)(b * T + qb * QB) * 1024 + h * D) * 2;
    r.P0 = qb * QB;
    r.NBQ = (const char*)ws + WS_NBQ + ((size_t)bh * 16 + qb) * T * 4;
    r.MK = (const char*)ws + WS_MASK + (size_t)(b * T + qb * QB) * 64 * 8;
    return r;
}
template <bool MIXB>
__device__ __forceinline__ void run_item(int item, unsigned char* ws, char* lds) {
    const int bh = (item >> 3) & 15, x = item & 7;
    Seam S;
    BlockRef cur = make_ref(MIXB, ws, bh, x);
    prime(cur, lds, S);
#pragma unroll 1
    for (int pass = 0; pass < 2; ++pass) {
        const BlockRef nxt = make_ref(MIXB, ws, bh, 15 - x);
        block<MIXB>(cur, nxt, lds, S);
        cur = nxt;
    }
}
}

namespace cg = cooperative_groups;
constexpr int LDS_BYTES = pg8::STAGE_BYTES;
struct Params { const float* in[17]; float* out; unsigned char* ws; };
template <class Epi>
__device__ __forceinline__ void run_gemm(LAS unsigned char* lds, const h16* A, const h16* Bt, int M, int N, int K, const Epi& e) {
    pg8::Gemm g{A, Bt, M, N, K}; pg8::StaticOrder S; S.init(M, N, (int)gridDim.x, (int)blockIdx.x);
    pg8::gemm_phase<Epi>(lds, g, S, e);
}
__global__ void __launch_bounds__(512, 2) mega_fwd(Params P) {
    extern __shared__ __attribute__((aligned(16))) unsigned char lds_raw[];
    LAS unsigned char* lds = (LAS unsigned char*)lds_raw;
    cg::grid_group grid = cg::this_grid();
#define IDS() int tid = threadIdx.x; asm volatile("" : "+v"(tid)); const int lane = tid & 63, wave = __builtin_amdgcn_readfirstlane(tid >> 6), gw = blockIdx.x * 8 + wave, NGW = gridDim.x * 8; (void)lane; (void)gw; (void)NGW
    const float* x = P.in[0]; const float* p = P.in[1]; const int* pos = (const int*)P.in[2];
    const float* g_mix = P.in[3]; const float* w_in = P.in[4]; const float* b_f = P.in[5];
    const float* w_o_a = P.in[6]; const float* w_o_b = P.in[7]; const float* w_out = P.in[8];
    const float* g_ffn = P.in[9]; const float* w_g = P.in[10]; const float* w_u = P.in[11]; const float* w_d = P.in[12];
    const float* g_ple = P.in[13]; const float* w_pg = P.in[14]; const float* w_pp = P.in[15]; const float* g_final = P.in[16];
    unsigned char* ws = P.ws; float* out = P.out;
    float* ROPE = (float*)(ws + WS_ROPE); float* CB = (float*)(ws + WS_CB); float* LOGF = (float*)(ws + WS_LOGF); u64* MASK = (u64*)(ws + WS_MASK);
    h16* WIN = (h16*)(ws + WS_WIN); h16* WOA = (h16*)(ws + WS_WOA); h16* WOB = (h16*)(ws + WS_WOB); h16* WOUT = (h16*)(ws + WS_WOUT);
    h16* WGU = (h16*)(ws + WS_WGU); h16* WDN = (h16*)(ws + WS_WDN); h16* WPG = (h16*)(ws + WS_WPG); h16* WPP = (h16*)(ws + WS_WPP);
    h16* QI = (h16*)(ws + WS_QI); h16* KI = (h16*)(ws + WS_KI); float* WI = (float*)(ws + WS_WI);
    h16* SIGA = (h16*)(ws + WS_SIGA); h16* SIGB = (h16*)(ws + WS_SIGB);
    h16* OUTA = (h16*)(ws + WS_OUTA); h16* OUTB = (h16*)(ws + WS_OUTB); h16* P16 = (h16*)(ws + WS_P16);
    h16* MIXED = (h16*)(ws + WS_MIXED); h16* H2 = (h16*)(ws + WS_H2); h16* ACT = (h16*)(ws + WS_ACT); h16* PP = (h16*)(ws + WS_PP);
    h16* H1 = (h16*)P.out;

    { IDS(); LAS float* scr = (LAS float*)(lds + wave * 8448);
      ph_transpose<1>(w_in, nullptr, DM, N_IN, WIN, N_INP, scr, gw, NGW, lane);
      ph_transpose<0>(w_o_a, nullptr, 1024, DM, WOA, DM, scr, gw, NGW, lane);
      ph_transpose<0>(w_o_b, nullptr, 1024, DM, WOB, DM, scr, gw, NGW, lane);
      ph_transpose<0>(w_out, nullptr, DM, DM, WOUT, DM, scr, gw, NGW, lane);
      ph_transpose<2>(w_g, w_u, DM, DFF, WGU, 2 * DFF, scr, gw, NGW, lane);
      ph_transpose<0>(w_d, nullptr, DFF, DM, WDN, DM, scr, gw, NGW, lane);
      ph_transpose<0>(w_pg, nullptr, DM, DM, WPG, DM, scr, gw, NGW, lane);
      ph_transpose<0>(w_pp, nullptr, DPLE, DM, WPP, DM, scr, gw, NGW, lane);
      ph_rope(pos, ROPE, blockIdx.x * 512 + tid, gridDim.x * 512);
      ph_rmsnorm<false>(x, g_mix, H1, nullptr, gw, NGW, lane);
    }
    grid.sync();
    { EpiInProj e{ws, b_f}; run_gemm(lds, H1, WIN, MTOK, N_INP, DM, e); }
    grid.sync();
    { IDS();
      if (gw >= NGW - 16) ph_cumsum(LOGF, CB, (float*)(ws + WS_NBQ), NGW - 1 - gw, lane);
      for (int it = blockIdx.x; it < 256; it += gridDim.x) { const int bb = it & 1, gi = it >> 1; idx::run_group(ws, (char*)lds_raw, bb, gi); idx::run_group(ws, (char*)lds_raw, bb, 255 - gi); }
      for (int i = blockIdx.x * 512 + tid; i < MTOK * DPLE / 4; i += gridDim.x * 512) st4h(P16 + 4 * (size_t)i, *((const f32x4*)p + i));
    }
    grid.sync();
    for (int it = blockIdx.x; it < 256; it += gridDim.x) {
        const int item = (it & 7) * 32 + (it >> 3);
        if (item < 128) att::run_item<false>(item, ws, (char*)lds_raw); else att::run_item<true>(item, ws, (char*)lds_raw);
    }
    grid.sync();
    { EpiGate<true> e{SIGA, MIXED}; run_gemm(lds, OUTA, WOA, MTOK, DM, 1024, e); }
    { EpiGate<false> e{SIGB, MIXED}; run_gemm(lds, OUTB, WOB, MTOK, DM, 1024, e); }
    grid.sync();
    { EpiResid e{x, out}; run_gemm(lds, MIXED, WOUT, MTOK, DM, DM, e); }
    grid.sync();
    { IDS(); ph_rmsnorm<false>(out, g_ffn, H2, nullptr, gw, NGW, lane); }
    grid.sync();
    { EpiSwiGLU e{ACT}; run_gemm(lds, H2, WGU, MTOK, 2 * DFF, DM, e); }
    grid.sync();
    { EpiResid e{out, out}; run_gemm(lds, ACT, WDN, MTOK, DM, DFF, e); }
    grid.sync();
    { IDS(); ph_rmsnorm<false>(out, g_ple, H2, nullptr, gw, NGW, lane); }
    grid.sync();
    { EpiStoreH e{PP, DM}; run_gemm(lds, P16, WPP, MTOK, DM, DPLE, e); }
    { EpiPLE e{PP, out}; run_gemm(lds, H2, WPG, MTOK, DM, DM, e); }
    grid.sync();
    { IDS(); ph_rmsnorm<true>(out, g_final, nullptr, out, gw, NGW, lane); }
#undef IDS
}

extern "C" void kernel_launch(void* const* d_in, const int* in_sizes, int n_in, void* d_out, int out_size, void* d_ws, size_t ws_size, hipStream_t stream) {
    if (n_in != 17 || out_size != MTOK * DM || ws_size < WS_END) { fprintf(stderr, "kernel_launch: unexpected shapes / workspace (%d inputs, out %d, ws %zu)\n", n_in, out_size, ws_size); return; }
    static int grid_blocks = 0;
    if (!grid_blocks) {
        int dev = 0, cus = 0, per_cu = 0;
        (void)hipGetDevice(&dev);
        (void)hipDeviceGetAttribute(&cus, hipDeviceAttributeMultiprocessorCount, dev);
        (void)hipFuncSetAttribute((const void*)mega_fwd, hipFuncAttributeMaxDynamicSharedMemorySize, LDS_BYTES);
        (void)hipOccupancyMaxActiveBlocksPerMultiprocessor(&per_cu, (const void*)mega_fwd, 512, LDS_BYTES);
        if (per_cu < 1) { fprintf(stderr, "kernel_launch: occupancy query says %d blocks per CU\n", per_cu); per_cu = 1; }
        if (per_cu > 1) per_cu = 1;
        grid_blocks = cus * per_cu;
    }
    Params prm{};
    for (int i = 0; i < 17; ++i) prm.in[i] = (const float*)d_in[i];
    prm.out = (float*)d_out; prm.ws = (unsigned char*)d_ws;
    void* args[] = {&prm};
    hipError_t e = hipLaunchCooperativeKernel((const void*)mega_fwd, dim3(grid_blocks), dim3(512), args, LDS_BYTES, stream);
    if (e != hipSuccess) fprintf(stderr, "cooperative launch failed: %s (grid %d)\n", hipGetErrorString(e), grid_blocks);
}
```

```cpp
#include <hip/hip_runtime.h>
#include <hip/hip_cooperative_groups.h>
#include <stdint.h>
#include <cstdio>

#define LAS __attribute__((address_space(3)))
typedef _Float16 h16;
typedef _Float16 h16x8 __attribute__((ext_vector_type(8)));
typedef _Float16 h16x4 __attribute__((ext_vector_type(4)));
typedef _Float16 h16x2 __attribute__((ext_vector_type(2)));
typedef float f32x4 __attribute__((ext_vector_type(4)));
typedef float f32x2 __attribute__((ext_vector_type(2)));
typedef unsigned u32x4 __attribute__((ext_vector_type(4)));
typedef unsigned u32x2 __attribute__((ext_vector_type(2)));
typedef unsigned long long u64;

constexpr int NBATCH = 2, T = 4096, MTOK = NBATCH * T, DM = 2048;
constexpr int HA = 8, HAKV = 2, HIDX = 16, DIDX = 64, HB = 8, HD = 128;
constexpr int N_IN = 9816, N_INP = 9984, DFF = 5632, DPLE = 256, TOPK = 256;
constexpr float EPS = 1e-6f;
constexpr float ATT_SCALE = 0.08838834764831845f;

constexpr size_t MiB = 1u << 20;
constexpr size_t WS_CTL = 0;
constexpr size_t WS_ROPE = 1 * MiB;
constexpr size_t WS_CB = 3 * MiB;
constexpr size_t WS_LOGF = 3 * MiB + 512 * 1024;
constexpr size_t WS_MASK = 4 * MiB;
constexpr size_t WS_WIN = 8 * MiB;
constexpr size_t WS_OUTA = 8 * MiB, WS_OUTB = 24 * MiB, WS_P16 = 40 * MiB;
constexpr size_t WS_WOA = 47 * MiB, WS_WOB = 51 * MiB, WS_WOUT = 55 * MiB, WS_WGU = 63 * MiB, WS_WDN = 107 * MiB, WS_WPG = 129 * MiB, WS_WPP = 137 * MiB;
constexpr size_t WS_QA = 138 * MiB, WS_KA = 154 * MiB, WS_VA = 158 * MiB, WS_QI = 162 * MiB, WS_KI = 178 * MiB, WS_WI = 179 * MiB;
constexpr size_t WS_QB = 180 * MiB, WS_KB = 196 * MiB, WS_VB = 212 * MiB, WS_SIGA = 228 * MiB, WS_SIGB = 260 * MiB, WS_NBQ = 292 * MiB, WS_END = 296 * MiB;
constexpr size_t WS_MIXED = WS_QB;
constexpr size_t WS_H2 = WS_QA;
constexpr size_t WS_ACT = WS_QB;
constexpr size_t WS_PP = WS_QB;

namespace pg8 {
constexpr int BM = 256, BK = 64, HALF = 128, HTB = HALF * BK * 2, STAGE_BYTES = 8 * HTB, NXCD = 8, WGM = 8;
__host__ __device__ __forceinline__ int lds_byte(int r, int c) { const int st = (r >> 4) * 2 + (c >> 5), rr = r & 15, cc = c & 31, ob = rr * 64 + cc * 2; return st * 1024 + (ob ^ (((ob >> 9) & 1) << 5)); }
__host__ __device__ __forceinline__ void stage_rc(int b, int& R, int& C) { const int st = b / 1024, sb = b % 1024, swz = sb ^ (((sb >> 9) & 1) << 5); R = (st >> 1) * 16 + swz / 64; C = (st & 1) * 32 + (swz % 64) / 2; }
struct Unit { int pm, pn; };
struct Gemm { const h16* A; const h16* Bt; int M, N, K; };
struct StaticOrder {
    int nM, nN, nwg, G, c;
    __host__ __device__ void init(int M, int N, int G_, int c_) { nM = M / BM; nN = N / BM; nwg = nM * nN; G = G_; c = c_; }
    __host__ __device__ bool next(int i, Unit& u) const {
        const long L = (long)i * G + c; if (L >= nwg) return false;
        int wgid = (int)L; { const int q = nwg / NXCD, r = nwg % NXCD, xcd = wgid % NXCD, off = wgid / NXCD; wgid = (xcd < r ? xcd * (q + 1) : r * (q + 1) + (xcd - r) * q) + off; }
        const int nig = WGM * nN, gid = wgid / nig, fm = gid * WGM, gsz = (nM - fm) < WGM ? (nM - fm) : WGM;
        u.pm = fm + ((wgid % nig) % gsz); u.pn = (wgid % nig) / gsz; return true;
    }
};
template <class Epi>
__device__ __forceinline__ void gemm_phase(LAS unsigned char* lds, const Gemm g, const StaticOrder& S, const Epi& E) {
    int tid = threadIdx.x; asm volatile("" : "+v"(tid));
    const int wid = __builtin_amdgcn_readfirstlane(tid >> 6), lane = tid & 63, wr = wid >> 2, wc = wid & 3, fr = lane & 15, fq = lane >> 4;
    const int K = g.K, nt = K / BK;
    unsigned voffA[2];
#pragma unroll
    for (int i = 0; i < 2; ++i) { int R, C; stage_rc(tid * 16 + i * 8192, R, C); voffA[i] = (unsigned)(R * K + C) * 2u; }
    const size_t kstep = (size_t)(BK * 2);
    const size_t hstep = (size_t)HALF * K * 2;
    const size_t tstep = 2 * hstep;
    const unsigned ldsw = (unsigned)wid * 1024u;
    const int aoff = lds_byte(wr * 64 + fr, fq * 8), boff = lds_byte(wc * 32 + fr, fq * 8);
#define PG8_SA(b, h) (((b) * 2 + (h)) * HTB)
#define PG8_SB(b, h) ((4 + (b) * 2 + (h)) * HTB)
#define PG8_STAGE(bufoff, gbase) do { _Pragma("unroll") for (int _i = 0; _i < 2; ++_i) \
        __builtin_amdgcn_global_load_lds((const unsigned*)((const char*)(gbase) + voffA[_i]), (LAS unsigned*)(lds + (bufoff) + ldsw + _i * 8192), 16, 0, 0); } while (0)
#define PG8_LDA(dst, b, h) do { _Pragma("unroll") for (int m = 0; m < 4; ++m) _Pragma("unroll") for (int k = 0; k < 2; ++k) dst[m][k] = *(const LAS h16x8*)(lds + PG8_SA(b, h) + aoff + m * 2048 + k * 1024); } while (0)
#define PG8_LDB(dst, b, h) do { _Pragma("unroll") for (int n = 0; n < 2; ++n) _Pragma("unroll") for (int k = 0; k < 2; ++k) dst[n][k] = *(const LAS h16x8*)(lds + PG8_SB(b, h) + boff + n * 2048 + k * 1024); } while (0)
#define PG8_MMA(ai, bj, At, Bt) do { __builtin_amdgcn_s_setprio(1); _Pragma("unroll") for (int m = 0; m < 4; ++m) _Pragma("unroll") for (int n = 0; n < 2; ++n) _Pragma("unroll") for (int k = 0; k < 2; ++k) \
        acc[ai][bj][m][n] = __builtin_amdgcn_mfma_f32_16x16x32_f16(Bt[n][k], At[m][k], acc[ai][bj][m][n], 0, 0, 0); __builtin_amdgcn_s_setprio(0); } while (0)
#define PG8_WAIT_V(n) asm volatile("s_waitcnt vmcnt(" #n ")" ::: "memory")
#define PG8_WAIT_L(n) asm volatile("s_waitcnt lgkmcnt(" #n ")" ::: "memory")
#define PG8_BAR __builtin_amdgcn_s_barrier()
#define PG8_SCHED __builtin_amdgcn_sched_barrier(0)
    Unit cur, nxt; int ui = 0;
    if (!S.next(0, cur)) return;
    f32x4 acc[2][2][4][2];
#pragma unroll
    for (int a = 0; a < 2; ++a)
#pragma unroll
        for (int b = 0; b < 2; ++b)
#pragma unroll
            for (int m = 0; m < 4; ++m)
#pragma unroll
                for (int n = 0; n < 2; ++n) acc[a][b][m][n] = (f32x4){0.f, 0.f, 0.f, 0.f};
    h16x8 At[4][2], B0[2][2], B1[2][2];
    const char* cA = (const char*)g.A + (size_t)cur.pm * tstep; const char* cB = (const char*)g.Bt + (size_t)cur.pn * tstep;
    PG8_STAGE(PG8_SB(0, 0), cB); PG8_STAGE(PG8_SA(0, 0), cA); PG8_STAGE(PG8_SB(0, 1), cB + hstep); PG8_STAGE(PG8_SA(0, 1), cA + hstep);
    if (wr == 1) PG8_BAR;
    PG8_WAIT_V(4); PG8_BAR;
    PG8_STAGE(PG8_SB(1, 0), cB + kstep); PG8_STAGE(PG8_SA(1, 0), cA + kstep); PG8_STAGE(PG8_SB(1, 1), cB + hstep + kstep);
    PG8_WAIT_V(6); PG8_BAR;
    for (;;) {
        const bool has_next = S.next(ui + 1, nxt);
        const char* nA = has_next ? (const char*)g.A + (size_t)nxt.pm * tstep : cA; const char* nB = has_next ? (const char*)g.Bt + (size_t)nxt.pn * tstep : cB;
        for (int t = 0; t < nt; t += 2) {
            const bool last = (t == nt - 2);
            const char* a1 = cA + (size_t)(t + 1) * kstep;
            const char* a2 = last ? nA : cA + (size_t)(t + 2) * kstep; const char* b2 = last ? nB : cB + (size_t)(t + 2) * kstep;
            const char* a3 = a2 + kstep; const char* b3 = b2 + kstep;
            PG8_LDB(B0, 0, 0); PG8_SCHED; PG8_LDA(At, 0, 0); PG8_STAGE(PG8_SA(1, 1), a1 + hstep);
            PG8_WAIT_L(8); PG8_BAR; PG8_WAIT_L(0); PG8_MMA(0, 0, At, B0); PG8_BAR; PG8_SCHED;
            PG8_LDB(B1, 0, 1); PG8_STAGE(PG8_SB(0, 0), b2);
            PG8_BAR; PG8_WAIT_L(0); PG8_MMA(0, 1, At, B1); PG8_BAR;
            PG8_LDA(At, 0, 1); PG8_STAGE(PG8_SA(0, 0), a2);
            PG8_BAR; PG8_WAIT_L(0); PG8_MMA(1, 0, At, B0); PG8_BAR; PG8_SCHED;
            PG8_STAGE(PG8_SB(0, 1), b2 + hstep);
            PG8_WAIT_V(6); PG8_BAR; PG8_MMA(1, 1, At, B1); PG8_BAR;
            PG8_LDB(B0, 1, 0); PG8_SCHED; PG8_LDA(At, 1, 0); PG8_STAGE(PG8_SA(0, 1), a2 + hstep);
            PG8_WAIT_L(8); PG8_BAR; PG8_WAIT_L(0); PG8_MMA(0, 0, At, B0); PG8_BAR; PG8_SCHED;
            PG8_LDB(B1, 1, 1); PG8_STAGE(PG8_SB(1, 0), b3);
            PG8_BAR; PG8_WAIT_L(0); PG8_MMA(0, 1, At, B1); PG8_BAR;
            PG8_LDA(At, 1, 1); PG8_STAGE(PG8_SA(1, 0), a3);
            PG8_BAR; PG8_WAIT_L(0); PG8_MMA(1, 0, At, B0); PG8_BAR; PG8_SCHED;
            PG8_STAGE(PG8_SB(1, 1), b3 + hstep);
            PG8_WAIT_V(6); PG8_BAR; PG8_MMA(1, 1, At, B1); PG8_BAR;
        }
        E(acc, cur, wr, wc, fr, fq);
        if (!has_next) break;
#pragma unroll
        for (int a = 0; a < 2; ++a)
#pragma unroll
            for (int b = 0; b < 2; ++b)
#pragma unroll
                for (int m = 0; m < 4; ++m)
#pragma unroll
                    for (int n = 0; n < 2; ++n) acc[a][b][m][n] = (f32x4){0.f, 0.f, 0.f, 0.f};
        cur = nxt; cA = nA; cB = nB; ++ui;
    }
    PG8_WAIT_V(0);
    if (wr == 0) PG8_BAR;
    PG8_BAR;
#undef PG8_SA
#undef PG8_SB
#undef PG8_STAGE
#undef PG8_LDA
#undef PG8_LDB
#undef PG8_MMA
#undef PG8_WAIT_V
#undef PG8_WAIT_L
#undef PG8_BAR
#undef PG8_SCHED
}
}
using pg8::Unit;
typedef f32x4 Acc[2][2][4][2];

__device__ __forceinline__ void st4h(h16* p, f32x4 v) { h16x4 o; o[0] = (h16)v[0]; o[1] = (h16)v[1]; o[2] = (h16)v[2]; o[3] = (h16)v[3]; *(h16x4*)p = o; }
__device__ __forceinline__ f32x4 ld4h(const h16* p) { const h16x4 o = *(const h16x4*)p; return (f32x4){(float)o[0], (float)o[1], (float)o[2], (float)o[3]}; }
__device__ __forceinline__ float sigmoidf_(float x) { return 1.0f / (1.0f + __expf(-x)); }
__device__ __forceinline__ float logsigmoidf_(float z) { return fminf(z, 0.f) - __logf(1.0f + __expf(-fabsf(z))); }
__device__ __forceinline__ float wave_sum(float v) {
#pragma unroll
    for (int o = 1; o < 64; o <<= 1) v += __shfl_xor(v, o);
    return v;
}

struct EpiInProj {
    unsigned char* ws; const float* b_f;
    __device__ __forceinline__ void operator()(const Acc& acc, const Unit& u, int wr, int wc, int fr, int fq) const {
        const int pn = u.pn, row0 = u.pm * 256 + wr * 64 + fr;
        const float* ROPE = (const float*)(ws + WS_ROPE);
#pragma unroll
        for (int ai = 0; ai < 2; ++ai)
#pragma unroll
            for (int m = 0; m < 4; ++m) {
                const int row = row0 + ai * 128 + m * 16, b = row >> 12, t = row & 4095;
                const float* rp = ROPE + (size_t)row * 48;
#pragma unroll
                for (int bj = 0; bj < 2; ++bj) {
                    f32x4 v0 = acc[ai][bj][m][0], v1 = acc[ai][bj][m][1];
                    const int d0 = 32 * wc + 4 * fq;
                    if (pn < 6) {
                        size_t off;
                        if (pn < 4) off = WS_QA + (((size_t)(b * HA + pn * 2 + bj) * T + t) * HD) * 2;
                        else off = (pn == 4 ? WS_KA : WS_VA) + (((size_t)(b * HAKV + bj) * T + t) * HD) * 2;
                        h16* dst = (h16*)(ws + off);
                        if (pn < 5 && wc == 0) {
                            const f32x4 c = *(const f32x4*)(rp + 4 * fq), s = *(const f32x4*)(rp + 16 + 4 * fq);
                            const f32x4 y0 = v0 * c - v1 * s, y1 = v1 * c + v0 * s; v0 = y0; v1 = y1;
                        }
                        st4h(dst + d0, v0); st4h(dst + d0 + 16, v1);
                    } else if (pn < 11) {
                        const bool is_q = pn < 10;
                        if (is_q || bj == 0) {
                            if (is_q || wc < 2) {
                                const int dd = 32 * (wc & 1) + 4 * fq;
                                const size_t off = is_q ? WS_QI + ((size_t)row * 1024 + ((pn - 6) * 4 + 2 * bj + (wc >> 1)) * 64) * 2 : WS_KI + ((size_t)row * 64) * 2;
                                h16* dst = (h16*)(ws + off);
                                if ((wc & 1) == 0) {
                                    f32x4 pr;
#pragma unroll
                                    for (int j = 0; j < 4; ++j) pr[j] = __shfl_xor(v0[j], 32);
                                    const f32x4 c = *(const f32x4*)(rp + 32 + 4 * (fq & 1)), s = *(const f32x4*)(rp + 40 + 4 * (fq & 1));
                                    v0 = (fq < 2) ? (v0 * c - pr * s) : (v0 * c + pr * s);
                                }
                                st4h(dst + dd, v0); st4h(dst + dd + 16, v1);
                            } else if (wc == 2) {
                                *(f32x4*)((float*)(ws + WS_WI) + (size_t)row * 16 + 4 * fq) = v0 * 0.03125f;
                                if (fq < 2) { const f32x4 bf = *(const f32x4*)(b_f + 4 * fq); f32x4 o;
#pragma unroll
                                    for (int j = 0; j < 4; ++j) o[j] = logsigmoidf_(v1[j] + bf[j]);
                                    *(f32x4*)((float*)(ws + WS_LOGF) + (size_t)row * 8 + 4 * fq) = o; }
                            }
                        }
                    } else if (pn < 23) {
                        const int q = pn - 11, which = q >> 2, head = (q & 3) * 2 + bj;
                        h16* dst = (h16*)(ws + WS_QB + (size_t)which * (WS_KB - WS_QB)) + ((size_t)(b * HB + head) * T + t) * HD;
                        st4h(dst + d0, v0); st4h(dst + d0 + 16, v1);
                    } else {
                        const int q = pn - 23; const int col = (q & 7) * 256 + 128 * bj + d0;
                        h16* base = (h16*)(ws + WS_SIGA + (size_t)(q >> 3) * (WS_SIGB - WS_SIGA));
#pragma unroll
                        for (int j = 0; j < 4; ++j) { v0[j] = sigmoidf_(v0[j]); v1[j] = sigmoidf_(v1[j]); }
                        st4h(base + (size_t)row * DM + col, v0); st4h(base + (size_t)row * DM + col + 16, v1);
                    }
                }
            }
    }
};
static_assert(WS_VB - WS_KB == WS_KB - WS_QB, "QB/KB/VB equally spaced");
template <bool FIRST> struct EpiGate {
    const h16* SIG; h16* MIXED;
    __device__ __forceinline__ void operator()(const Acc& acc, const Unit& u, int wr, int wc, int fr, int fq) const {
        const int row0 = u.pm * 256 + wr * 64 + fr, col0 = u.pn * 256 + 32 * wc + 4 * fq;
#pragma unroll
        for (int ai = 0; ai < 2; ++ai)
#pragma unroll
            for (int m = 0; m < 4; ++m)
#pragma unroll
                for (int bj = 0; bj < 2; ++bj)
#pragma unroll
                    for (int n = 0; n < 2; ++n) { const size_t off = (size_t)(row0 + ai * 128 + m * 16) * DM + col0 + bj * 128 + n * 16;
                        f32x4 v = ld4h(SIG + off) * acc[ai][bj][m][n]; if (!FIRST) v += ld4h(MIXED + off); st4h(MIXED + off, v); }
    }
};
struct EpiResid {
    const float* BASE; float* OUT;
    __device__ __forceinline__ void operator()(const Acc& acc, const Unit& u, int wr, int wc, int fr, int fq) const {
        const int row0 = u.pm * 256 + wr * 64 + fr, col0 = u.pn * 256 + 32 * wc + 4 * fq;
#pragma unroll
        for (int ai = 0; ai < 2; ++ai)
#pragma unroll
            for (int m = 0; m < 4; ++m)
#pragma unroll
                for (int bj = 0; bj < 2; ++bj)
#pragma unroll
                    for (int n = 0; n < 2; ++n) { const size_t off = (size_t)(row0 + ai * 128 + m * 16) * DM + col0 + bj * 128 + n * 16;
                        *(f32x4*)(OUT + off) = *(const f32x4*)(BASE + off) + acc[ai][bj][m][n]; }
    }
};
struct EpiSwiGLU {
    h16* ACT;
    __device__ __forceinline__ void operator()(const Acc& acc, const Unit& u, int wr, int wc, int fr, int fq) const {
        const int row0 = u.pm * 256 + wr * 64 + fr;
#pragma unroll
        for (int ai = 0; ai < 2; ++ai)
#pragma unroll
            for (int m = 0; m < 4; ++m)
#pragma unroll
                for (int bj = 0; bj < 2; ++bj) { const f32x4 g = acc[ai][bj][m][0], uu = acc[ai][bj][m][1]; f32x4 o;
#pragma unroll
                    for (int j = 0; j < 4; ++j) o[j] = g[j] * sigmoidf_(g[j]) * uu[j];
                    st4h(ACT + (size_t)(row0 + ai * 128 + m * 16) * DFF + 16 * (u.pn * 8 + bj * 4 + wc) + 4 * fq, o); }
    }
};
struct EpiStoreH {
    h16* O; int ldc;
    __device__ __forceinline__ void operator()(const Acc& acc, const Unit& u, int wr, int wc, int fr, int fq) const {
        const int row0 = u.pm * 256 + wr * 64 + fr, col0 = u.pn * 256 + 32 * wc + 4 * fq;
#pragma unroll
        for (int ai = 0; ai < 2; ++ai)
#pragma unroll
            for (int m = 0; m < 4; ++m)
#pragma unroll
                for (int bj = 0; bj < 2; ++bj)
#pragma unroll
                    for (int n = 0; n < 2; ++n) st4h(O + (size_t)(row0 + ai * 128 + m * 16) * ldc + col0 + bj * 128 + n * 16, acc[ai][bj][m][n]);
    }
};
struct EpiPLE {
    const h16* PP; float* X;
    __device__ __forceinline__ void operator()(const Acc& acc, const Unit& u, int wr, int wc, int fr, int fq) const {
        const int row0 = u.pm * 256 + wr * 64 + fr, col0 = u.pn * 256 + 32 * wc + 4 * fq;
#pragma unroll
        for (int ai = 0; ai < 2; ++ai)
#pragma unroll
            for (int m = 0; m < 4; ++m)
#pragma unroll
                for (int bj = 0; bj < 2; ++bj)
#pragma unroll
                    for (int n = 0; n < 2; ++n) { const size_t off = (size_t)(row0 + ai * 128 + m * 16) * DM + col0 + bj * 128 + n * 16;
                        const f32x4 a = acc[ai][bj][m][n], pp = ld4h(PP + off); f32x4 x = *(const f32x4*)(X + off);
#pragma unroll
                        for (int j = 0; j < 4; ++j) x[j] += sigmoidf_(a[j]) * pp[j];
                        *(f32x4*)(X + off) = x; }
    }
};


__device__ __forceinline__ int map_in(int p) {
    if (p < 2560) return p;
    if (p < 2816) { const int c = p - 2560; if (c < 64) return 2560 + c; if (c < 80) return 2624 + (c - 64); if (c < 88) return 5712 + (c - 80); return -1; }
    const int q = p - 2816; if (q < 3072) return 2640 + q; return 5720 + (q - 3072);
}
template <int MODE>
__device__ __forceinline__ void ph_transpose(const float* W0, const float* W1, int K, int Nsrc, h16* WT, int Nphys, LAS float* scr, int gw, int NGW, int lane) {
    const int nblk = Nphys / 32, nitems = (K / 64) * nblk;
    for (int item = gw; item < nitems; item += NGW) {
        const int kb = item / nblk, nb = item % nblk, k0 = 64 * kb, n0 = 32 * nb;
        const int n = n0 + (lane & 31);
        const float* src = nullptr;
        if (MODE == 0) { if (n < Nsrc) src = W0 + n; }
        else if (MODE == 1) { const int c = map_in(n); if (c >= 0) src = W0 + c; }
        else { src = (((n >> 4) & 1) ? W1 : W0) + 16 * (n >> 5) + (n & 15); }
#pragma unroll 8
        for (int i = 0; i < 32; ++i) { const int kk = 2 * i + (lane >> 5); scr[kk * 33 + (lane & 31)] = src ? src[(size_t)(k0 + kk) * Nsrc] : 0.f; }
        __builtin_amdgcn_wave_barrier(); asm volatile("s_waitcnt lgkmcnt(0)" ::: "memory");
        const int c = lane & 7;
#pragma unroll
        for (int j = 0; j < 4; ++j) { const int nn = (lane >> 3) + 8 * j; const LAS float* s = scr + (8 * c) * 33 + nn;
            h16x8 o;
#pragma unroll
            for (int e = 0; e < 8; ++e) o[e] = (h16)s[e * 33];
            *(h16x8*)(WT + (size_t)(n0 + nn) * K + k0 + 8 * c) = o; }
        __builtin_amdgcn_wave_barrier(); asm volatile("s_waitcnt lgkmcnt(0)" ::: "memory");
    }
}
__device__ __forceinline__ void sincos_f32arg(float ang, float& sn, float& cs) {
    const double a = (double)ang;
    const double rev = a * 0.15915494309189535;
    const double fr = rev - __builtin_rint(rev);
    const double q4 = fr * 4.0; const double qi = __builtin_rint(q4); const int qq = ((int)qi) & 3;
    const double r = (q4 - qi) * 1.5707963267948966;
    const double r2 = r * r;
    const double s = r * (1.0 + r2 * (-1.0 / 6 + r2 * (1.0 / 120 + r2 * (-1.0 / 5040 + r2 * (1.0 / 362880 + r2 * (-1.0 / 39916800))))));
    const double c = 1.0 + r2 * (-0.5 + r2 * (1.0 / 24 + r2 * (-1.0 / 720 + r2 * (1.0 / 40320 + r2 * (-1.0 / 3628800 + r2 * (1.0 / 479001600))))));
    double so, co;
    if (qq == 0) { so = s; co = c; } else if (qq == 1) { so = c; co = -s; } else if (qq == 2) { so = -s; co = -c; } else { so = -c; co = s; }
    sn = (float)so; cs = (float)co;
}
__device__ __forceinline__ void ph_rope(const int* pos, float* ROPE, int gtid, int NGT) {
    for (int idx = gtid; idx < MTOK * 24; idx += NGT) {
        const int tok = idx / 24, i = idx % 24, k = i < 16 ? i : 2 * (i - 16);
        float f = 0x1.000000p+0f;
        f = k == 1 ? 0x1.c2ef76p-2f : f; f = k == 2 ? 0x1.8d275ep-3f : f; f = k == 3 ? 0x1.5dc95ap-4f : f; f = k == 4 ? 0x1.341190p-5f : f; f = k == 5 ? 0x1.0f5384p-6f : f;
        f = k == 6 ? 0x1.ddee9cp-8f : f; f = k == 7 ? 0x1.a4ee3ep-9f : f; f = k == 8 ? 0x1.72ba44p-10f : f; f = k == 9 ? 0x1.468318p-11f : f; f = k == 10 ? 0x1.1f91f0p-12f : f;
        f = k == 11 ? 0x1.fa8b84p-14f : f; f = k == 12 ? 0x1.be218ap-15f : f; f = k == 13 ? 0x1.88ec22p-16f : f; f = k == 14 ? 0x1.5a0f50p-17f : f; f = k == 15 ? 0x1.30c94ep-18f : f;
        const float ang = (float)pos[tok] * f;
        float sn, cs; sincos_f32arg(ang, sn, cs);
        float* rp = ROPE + (size_t)tok * 48;
        if (i < 16) { rp[i] = cs; rp[16 + i] = sn; } else { rp[32 + (i - 16)] = cs; rp[40 + (i - 16)] = sn; }
    }
}
template <bool TO_F32>
__device__ __forceinline__ void ph_rmsnorm(const float* X, const float* g, h16* OUTH, float* OUTF, int gw, int NGW, int lane) {
    for (int row = gw; row < MTOK; row += NGW) {
        const f32x4* xr = (const f32x4*)(X + (size_t)row * DM) + lane;
        f32x4 v[8]; float s = 0.f;
#pragma unroll
        for (int j = 0; j < 8; ++j) { v[j] = xr[64 * j]; s += (v[j][0] * v[j][0] + v[j][1] * v[j][1]) + (v[j][2] * v[j][2] + v[j][3] * v[j][3]); }
        const float r = 1.0f / sqrtf(wave_sum(s) * (1.0f / DM) + EPS);
#pragma unroll
        for (int j = 0; j < 8; ++j) { const f32x4 gg = *((const f32x4*)g + lane + 64 * j); const f32x4 o = v[j] * r * gg;
            if (TO_F32) *((f32x4*)(OUTF + (size_t)row * DM) + lane + 64 * j) = o; else st4h(OUTH + (size_t)row * DM + 4 * (lane + 64 * j), o); }
    }
}
__device__ __forceinline__ void ph_cumsum(const float* LOGF, float* CB, float* NBQ, int bh, int lane) {
    const int b = bh >> 3, h = bh & 7;
    float loc[64]; float s = 0.f;
#pragma unroll
    for (int i = 0; i < 64; ++i) { s += LOGF[(size_t)(b * T + lane * 64 + i) * 8 + h]; loc[i] = s; }
    float inc = s;
#pragma unroll
    for (int o = 1; o < 64; o <<= 1) { const float nb = __shfl_up(inc, o); if (lane >= o) inc += nb; }
    const float base = inc - s;
#pragma unroll
    for (int i = 0; i < 64; ++i) { loc[i] += base; CB[(size_t)bh * T + lane * 64 + i] = loc[i]; }
#pragma unroll 1
    for (int qb = 0; qb < 16; ++qb) {
        const float ref = __shfl(loc[63], 4 * qb + 3);
        if (lane < 4 * (qb + 1)) { float* dst = NBQ + ((size_t)bh * 16 + qb) * T + lane * 64;
#pragma unroll
            for (int i = 0; i < 64; ++i) dst[i] = (ref - loc[i]) * 11.313708498984761f; }
    }
}

__device__ __forceinline__ unsigned fkey(float f) { const unsigned u = __float_as_uint(f + 0.0f); return (u & 0x80000000u) ? ~u : (u | 0x80000000u); }
__device__ __forceinline__ unsigned count_ge(const unsigned (&key)[64], unsigned th) {
    unsigned c = 0;
#pragma unroll
    for (int j = 0; j < 64; ++j) c += (unsigned)__builtin_popcountll(__ballot(key[j] >= th));
    return c;
}
__device__ __forceinline__ u64 topk_select(const unsigned (&key)[64], int nvalid, int lane) {
    u64 myword = 0;
    if (nvalid <= TOPK) {
#pragma unroll
        for (int j = 0; j < 64; ++j) { const u64 bal = __ballot(key[j] != 0u); if (lane == j) myword = bal; }
    } else {
        unsigned th = 0u; bool exact = false;
        for (int bit = 31; bit >= 0; --bit) { const unsigned tc = th | (1u << bit); const unsigned c = count_ge(key, tc); if (c >= (unsigned)TOPK) th = tc; if (c == (unsigned)TOPK) { exact = true; break; } }
        if (exact) {
#pragma unroll
            for (int j = 0; j < 64; ++j) { const u64 bal = __ballot(key[j] >= th); if (lane == j) myword = bal; }
        } else {
            unsigned cgt = 0;
#pragma unroll
            for (int j = 0; j < 64; ++j) cgt += (unsigned)__builtin_popcountll(__ballot(key[j] > th));
            int need = TOPK - (int)cgt;
#pragma unroll
            for (int j = 0; j < 64; ++j) { u64 eq = __ballot(key[j] == th); const u64 gt = __ballot(key[j] > th);
                int pc = __builtin_popcountll(eq);
                while (pc > need) { eq &= ~(1ull << (63 - __builtin_clzll(eq))); --pc; }
                need -= pc; if (lane == j) myword = gt | eq; }
        }
    }
    return myword;
}
__device__ __forceinline__ void ph_topk_naive(const h16* QI, const h16* KI, const float* WI, u64* MASK, LAS float* qs, LAS unsigned* ks, int gw, int NGW, int lane) {
    for (int row = gw; row < MTOK; row += NGW) {
        const int b = row >> 12, t = row & 4095;
        { const h16* qp = QI + (size_t)row * 1024 + lane * 16;
#pragma unroll
          for (int i = 0; i < 16; ++i) qs[lane * 16 + i] = (float)qp[i]; }
        if (lane < 16) qs[1024 + lane] = WI[(size_t)row * 16 + lane];
        __builtin_amdgcn_wave_barrier(); asm volatile("s_waitcnt lgkmcnt(0)" ::: "memory");
#pragma unroll 1
        for (int j = 0; j < 64; ++j) {
            unsigned kk = 0u;
            const int s = 64 * j + lane;
            if (s <= t) {
                float kf[64];
                const h16x8* kp = (const h16x8*)(KI + (size_t)(b * T + s) * 64);
#pragma unroll
                for (int c = 0; c < 8; ++c) { const h16x8 kv = kp[c];
#pragma unroll
                    for (int e = 0; e < 8; ++e) kf[c * 8 + e] = (float)kv[e]; }
                float sc = 0.f;
#pragma unroll 1
                for (int h = 0; h < 16; ++h) { float d = 0.f;
#pragma unroll
                    for (int e = 0; e < 64; ++e) d = fmaf(qs[h * 64 + e], kf[e], d);
                    sc = fmaf(qs[1024 + h], fmaxf(d, 0.f), sc); }
                kk = fkey(sc);
            }
            ks[j * 64 + lane] = kk;
        }
        __builtin_amdgcn_wave_barrier(); asm volatile("s_waitcnt lgkmcnt(0)" ::: "memory");
        unsigned key[64];
#pragma unroll
        for (int j = 0; j < 64; ++j) key[j] = ks[j * 64 + lane];
        MASK[(size_t)row * 64 + lane] = topk_select(key, t + 1, lane);
        __builtin_amdgcn_wave_barrier(); asm volatile("s_waitcnt lgkmcnt(0)" ::: "memory");
    }
}


namespace idx {
typedef short s16x8 __attribute__((ext_vector_type(8)));
typedef float f32x16 __attribute__((ext_vector_type(16)));
constexpr int CHK = 128, CHB = CHK * 128;
__device__ __forceinline__ unsigned half_sum(unsigned v) {
#pragma unroll
    for (int o = 1; o < 32; o <<= 1) v += __shfl_xor(v, o);
    return v;
}
__device__ __forceinline__ void run_group(unsigned char* ws, char* lds, int b, int g) {
    int tid = threadIdx.x; asm volatile("" : "+v"(tid));
    const int wid = __builtin_amdgcn_readfirstlane(tid >> 6), lane = tid & 63, c = lane & 31, hi = lane >> 5;
    const int t0 = 16 * g + 2 * wid, t = t0 + hi, row = b * T + t, tmaxblk = 16 * g + 15, nch = (tmaxblk >> 7) + 1;
    const h16* QI = (const h16*)(ws + WS_QI); const char* KIb = (const char*)ws + WS_KI + (size_t)b * T * 128; const float* WI = (const float*)(ws + WS_WI);
    s16x8 A[4];
    { const int rho = c, qsel = (rho >> 2) & 1, head = (rho & 3) + 4 * (rho >> 3);
      const h16* qp = QI + (size_t)(b * T + t0 + qsel) * 1024 + head * 64 + 8 * hi;
#pragma unroll
      for (int ks = 0; ks < 4; ++ks) A[ks] = *reinterpret_cast<const s16x8*>(qp + 16 * ks); }
    float w[16];
    { const f32x4* wp = (const f32x4*)(WI + (size_t)row * 16);
#pragma unroll
      for (int i = 0; i < 4; ++i) { const f32x4 v = wp[i]; w[4 * i] = v[0]; w[4 * i + 1] = v[1]; w[4 * i + 2] = v[2]; w[4 * i + 3] = v[3]; } }
    const int pr0 = tid >> 3, pp = tid & 7;
    const unsigned g_off = (unsigned)(pr0 * 128 + pp * 16);
    const int l_off0 = pr0 * 128 + ((pp ^ ((pr0 >> 1) & 7)) << 4), l_off1 = l_off0 + 64 * 128;
    const int rd_base = c * 128; const int sw = (c >> 1) & 7;
    int rd_off[4];
#pragma unroll
    for (int ks = 0; ks < 4; ++ks) rd_off[ks] = rd_base + (((2 * ks + hi) ^ sw) << 4);
    unsigned kreg[128];
    s16x8 st0, st1;
    { const char* src = KIb; st0 = *reinterpret_cast<const s16x8*>(src + g_off); st1 = *reinterpret_cast<const s16x8*>(src + 64 * 128 + g_off); }
    *reinterpret_cast<s16x8*>(lds + l_off0) = st0; *reinterpret_cast<s16x8*>(lds + l_off1) = st1;
    __syncthreads();
#pragma unroll
    for (int ch = 0; ch < 32; ++ch) {
        if (ch < nch) {
            const char* buf = lds + (ch & 1) * CHB;
            if (ch + 1 < nch) { const char* src = KIb + (size_t)(ch + 1) * CHB; st0 = *reinterpret_cast<const s16x8*>(src + g_off); st1 = *reinterpret_cast<const s16x8*>(src + 64 * 128 + g_off); }
#pragma unroll
            for (int st = 0; st < 4; ++st) {
                f32x16 acc = {};
#pragma unroll
                for (int ks = 0; ks < 4; ++ks) { const s16x8 Bf = *reinterpret_cast<const s16x8*>(buf + st * 4096 + rd_off[ks]);
                    acc = __builtin_amdgcn_mfma_f32_32x32x16_f16(__builtin_bit_cast(h16x8, A[ks]), __builtin_bit_cast(h16x8, Bf), acc, 0, 0, 0); }
                float sc = 0.f;
#pragma unroll
                for (int r = 0; r < 16; ++r) sc = fmaf(w[r], fmaxf(acc[r], 0.f), sc);
                const int sidx = ch * CHK + st * 32 + c;
                { unsigned kv_ = (sidx <= t) ? fkey(sc) : 0u; asm volatile("" : "+v"(kv_)); kreg[ch * 4 + st] = kv_; }
            }
            if (ch + 1 < nch) { char* dst = lds + ((ch + 1) & 1) * CHB; *reinterpret_cast<s16x8*>(dst + l_off0) = st0; *reinterpret_cast<s16x8*>(dst + l_off1) = st1; }
            __syncthreads();
        } else {
#pragma unroll
            for (int st = 0; st < 4; ++st) kreg[ch * 4 + st] = 0u;
        }
    }
    bool done = (t < TOPK); unsigned th = done ? 1u : 0u;
    for (int bit = 31; bit >= 0; --bit) {
        if (__all(done)) break;
        const unsigned tc = th | (1u << bit);
        unsigned cnt = 0;
#pragma unroll
        for (int s_ = 0; s_ < 128; ++s_) cnt += (kreg[s_] >= tc) ? 1u : 0u;
        cnt = half_sum(cnt);
        if (!done) { if (cnt >= (unsigned)TOPK) th = tc; if (cnt == (unsigned)TOPK) done = true; }
    }
    int need = 0; const bool tie = !done;
    if (__any(tie)) {
        unsigned cgt = 0;
#pragma unroll
        for (int s_ = 0; s_ < 128; ++s_) cgt += (kreg[s_] > th) ? 1u : 0u;
        cgt = half_sum(cgt); need = TOPK - (int)cgt;
    }
    u64 w0 = 0, w1 = 0;
#pragma unroll
    for (int j = 0; j < 64; ++j) {
        u64 bal[2];
#pragma unroll
        for (int e = 0; e < 2; ++e) {
            const unsigned k = kreg[2 * j + e];
            bool sel = tie ? (k > th) : (k >= th);
            if (__any(tie)) {
                const u64 eqm = __ballot(tie && k == th);
                const unsigned mine = (unsigned)(eqm >> (32 * hi));
                const int pc = __builtin_popcount(mine);
                unsigned keep = mine; int kc = pc;
                while (kc > (need > 0 ? need : 0)) { keep &= ~(1u << (31 - __builtin_clz(keep))); --kc; }
                if (tie) { need -= kc; if ((keep >> c) & 1u) sel = true; }
            }
            bal[e] = __ballot(sel);
        }
        const u64 q0 = (bal[0] & 0xffffffffull) | (bal[1] << 32), q1 = (bal[0] >> 32) | (bal[1] & 0xffffffff00000000ull);
        if (lane == j) { w0 = q0; w1 = q1; }
    }
    u64* MASK = (u64*)(ws + WS_MASK);
    MASK[(size_t)(b * T + t0) * 64 + lane] = w0;
    MASK[(size_t)(b * T + t0 + 1) * 64 + lane] = w1;
}
}

namespace att {
constexpr int NW = 8, QBLK = 32, KVBLK = 64, QB = NW * QBLK, D = 128;
constexpr int SHM_V = KVBLK * D * 2, SHM_K = KVBLK * D * 2;
constexpr int LDS_NEED = 2 * SHM_V + 2 * SHM_K + NW * 64 * 4;
constexpr float THR = 8.f, SCALE = 0.08838834764831845f;
typedef short s16x8 __attribute__((ext_vector_type(8)));
typedef short s16x4 __attribute__((ext_vector_type(4)));
typedef float f32x16 __attribute__((ext_vector_type(16)));
#define KSWZ(row, colB) ((row) * 256 + ((colB) ^ (((row) & 7) << 4)))
#define SBAR() __builtin_amdgcn_sched_barrier(0)
__device__ __forceinline__ int v_st(int k, int c) { const int kk = (k & ~0xC) | ((k & 4) << 1) | ((k & 8) >> 1); return ((kk >> 3) * 4 + (c >> 5)) * 512 + ((kk & 7) * 32 + (c & 31)) * 2; }
__device__ __forceinline__ int v_rd_base(int lane) { return ((lane & 3) << 3) | (((lane >> 2) & 3) << 6) | (((lane >> 4) & 1) << 5) | (((lane >> 5) & 1) << 8); }
constexpr int v_rd_off(int d0, int ks, int half) { return d0 * 512 + ks * 4096 + half * 2048; }
__device__ __forceinline__ int crow(int r, int hi) { return (r & 3) + 8 * (r >> 2) + 4 * hi; }
__device__ __forceinline__ unsigned cvtpk(float lo, float hi) { unsigned r; asm volatile("v_cvt_pk_f16_f32 %0, %1, %2" : "=v"(r) : "v"(lo), "v"(hi)); return r; }
__device__ __forceinline__ f32x16 mfma16(s16x8 a, s16x8 b, f32x16 c) { return __builtin_amdgcn_mfma_f32_32x32x16_f16(__builtin_bit_cast(h16x8, a), __builtin_bit_cast(h16x8, b), c, 0, 0, 0); }
__device__ __forceinline__ s16x8 load8(const h16* p) { return *reinterpret_cast<const s16x8*>(p); }
__device__ __forceinline__ void mask_causal(f32x16& p0, f32x16& p1, int dq) {
    const float NEG = -__builtin_inff();
#pragma unroll
    for (int r = 0; r < 16; ++r) { const int c = (r & 3) + 8 * (r >> 2); if (dq - c < 0) p0[r] = NEG; if (dq - c - 32 < 0) p1[r] = NEG; }
}
__device__ __forceinline__ void mask_bits(f32x16& p0, f32x16& p1, u64 w, int hi) {
    const float NEG = -__builtin_inff();
    const unsigned lo = (unsigned)w >> (4 * hi), up = (unsigned)(w >> 32) >> (4 * hi);
#pragma unroll
    for (int r = 0; r < 16; ++r) { const int c = (r & 3) + 8 * (r >> 2); if (!((lo >> c) & 1u)) p0[r] = NEG; if (!((up >> c) & 1u)) p1[r] = NEG; }
}
__device__ __forceinline__ void partialSM(f32x16& p0, f32x16& p1, float& m_reg, float& mn, float& alpha) {
    float pmax = p0[0]; for (int r = 1; r < 16; ++r) pmax = fmaxf(pmax, p0[r]); for (int r = 0; r < 16; ++r) pmax = fmaxf(pmax, p1[r]);
    { auto rr = __builtin_amdgcn_permlane32_swap(__float_as_uint(pmax), __float_as_uint(pmax), false, false);
      pmax = fmaxf(__uint_as_float(rr[0]), __uint_as_float(rr[1])); }
    constexpr float C2 = 1.4426950408889634f * SCALE;
    if (__builtin_expect(__all((pmax - m_reg) * SCALE <= THR), 1)) { mn = m_reg; alpha = 1.f; }
    else { mn = fmaxf(m_reg, pmax); alpha = __builtin_amdgcn_exp2f((m_reg - mn) * C2); m_reg = mn; }
    const float mnL = -mn * C2;
    for (int r = 0; r < 16; ++r) p0[r] = fmaf(p0[r], C2, mnL); for (int r = 0; r < 16; ++r) p1[r] = fmaf(p1[r], C2, mnL);
    for (int r = 0; r < 16; ++r) p0[r] = __builtin_amdgcn_exp2f(p0[r]);
}
__device__ __forceinline__ void finishSM(f32x16& p0, f32x16& p1, float alpha, float& l_reg, s16x8& pa0, s16x8& pa1, s16x8& pa2, s16x8& pa3) {
    for (int r = 0; r < 16; ++r) p1[r] = __builtin_amdgcn_exp2f(p1[r]);
    float ps = 0; for (int r = 0; r < 16; ++r) ps += p0[r]; for (int r = 0; r < 16; ++r) ps += p1[r];
    { auto rr = __builtin_amdgcn_permlane32_swap(__float_as_uint(ps), __float_as_uint(ps), false, false);
      ps = __uint_as_float(rr[0]) + __uint_as_float(rr[1]); }
    l_reg = l_reg * alpha + ps;
#define PK4(P, B_, OUT) do { unsigned a0 = cvtpk(P[B_+0], P[B_+1]), a1 = cvtpk(P[B_+2], P[B_+3]);                          \
        unsigned b0 = cvtpk(P[B_+4], P[B_+5]), b1 = cvtpk(P[B_+6], P[B_+7]);                                             \
        auto r0 = __builtin_amdgcn_permlane32_swap(a0, b0, false, false); auto r1 = __builtin_amdgcn_permlane32_swap(a1, b1, false, false); \
        u32x4 w = {r0[0], r1[0], r0[1], r1[1]}; OUT = *reinterpret_cast<s16x8*>(&w); } while (0)
    PK4(p0, 0, pa0); PK4(p0, 8, pa1); PK4(p1, 0, pa2); PK4(p1, 8, pa3);
#undef PK4
}
template <int KB>
__device__ __forceinline__ void qkt(f32x16& p0, f32x16& p1, const char* K_lds, int r32, int hi, const s16x8* qr) {
    const char* kb[4];
#pragma unroll
    for (int dd = 0; dd < 4; ++dd) kb[dd] = K_lds + KB * SHM_K + KSWZ(r32, (dd * 16 + hi * 8) * 2);
#pragma unroll
    for (int d0 = 0; d0 < 8; ++d0) { const char* a = kb[d0 & 3] + (d0 >> 2) * 128;
        s16x8 b0 = *reinterpret_cast<const s16x8*>(a);
        s16x8 b1 = *reinterpret_cast<const s16x8*>(a + 32 * 256);
        p0 = mfma16(b0, qr[d0], p0);
        p1 = mfma16(b1, qr[d0], p1); }
}
template <int VB>
__device__ __forceinline__ void pv_tile(f32x16* o, int vb0, s16x8 pa0, s16x8 pa1, s16x8 pa2, s16x8 pa3) {
#define TRRD(dst, off) asm volatile("ds_read_b64_tr_b16 %0, %1 offset:%2" : "=&v"(dst) : "v"(vb0), "i"(off) : "memory")
#define PV_D0(d0) do { s16x4 l0, l1, l2, l3, h0, h1, h2, h3; constexpr int b_ = VB * SHM_V + v_rd_off(d0, 0, 0); \
        TRRD(l0, b_); TRRD(h0, b_ + 2048); TRRD(l1, b_ + 4096); TRRD(h1, b_ + 6144); TRRD(l2, b_ + 8192); TRRD(h2, b_ + 10240); TRRD(l3, b_ + 12288); TRRD(h3, b_ + 14336); \
        asm volatile("s_waitcnt lgkmcnt(0)" ::: "memory"); SBAR();   \
        o[d0] = mfma16(pa0, (s16x8){l0[0], l0[1], l0[2], l0[3], h0[0], h0[1], h0[2], h0[3]}, o[d0]);   \
        o[d0] = mfma16(pa1, (s16x8){l1[0], l1[1], l1[2], l1[3], h1[0], h1[1], h1[2], h1[3]}, o[d0]);   \
        o[d0] = mfma16(pa2, (s16x8){l2[0], l2[1], l2[2], l2[3], h2[0], h2[1], h2[2], h2[3]}, o[d0]);   \
        o[d0] = mfma16(pa3, (s16x8){l3[0], l3[1], l3[2], l3[3], h3[0], h3[1], h3[2], h3[3]}, o[d0]); } while (0)
    PV_D0(0); PV_D0(1); PV_D0(2); PV_D0(3);
#undef PV_D0
#undef TRRD
}
struct BlockRef { const char* Q; const char* K; const char* V; char* O; int P0; const char* NBQ; const char* MK; };
struct Seam { s16x8 qr[8]; s16x8 st_v0, st_v1, st_k0, st_k1; };
#define LD16(base, off) (*reinterpret_cast<const s16x8*>((base) + (off)))
#define VMW() asm volatile("s_waitcnt vmcnt(0)" ::: "memory")
#define VMWN(n) asm volatile("s_waitcnt vmcnt(%0)" :: "i"(n) : "memory")
#define SLOAD_H(Kp, Vp, k0) do { const char* vb_ = (Vp) + (size_t)(k0) * (D * 2); const char* kb_ = (Kp) + (size_t)(k0) * (D * 2); \
        S.st_v0 = LD16(vb_, st_off); S.st_v1 = LD16(vb_ + 32 * D * 2, st_off); S.st_k0 = LD16(kb_, st_off); S.st_k1 = LD16(kb_ + 32 * D * 2, st_off); } while (0)
#define SWRITE_HK(bf) do { *(s16x8*)(K_lds + (bf) * SHM_K + kws) = S.st_k0; *(s16x8*)(K_lds + (bf) * SHM_K + kws + 32 * 256) = S.st_k1; } while (0)
#define SWRITE_HV(bf) do { *(s16x8*)(V_lds + (bf) * SHM_V + vst0) = S.st_v0; *(s16x8*)(V_lds + (bf) * SHM_V + vst1) = S.st_v1; } while (0)
#define SWRITE_H(bf) do { SWRITE_HV(bf); SWRITE_HK(bf); } while (0)
__device__ __forceinline__ void prime(const BlockRef& cur, char* lds, Seam& S) {
    int tid = threadIdx.x; asm volatile("" : "+v"(tid));
    const int wid = __builtin_amdgcn_readfirstlane(tid >> 6), lane = tid & 63, r32 = lane & 31, hi = lane >> 5;
    const int sr = tid >> 4, sc = (tid & 15) * 8, kws = KSWZ(sr, sc * 2); char* K_lds = lds + 2 * SHM_V;
    const unsigned st_off = (unsigned)(sr * D + sc) * 2u, q_off = (unsigned)((wid * QBLK + r32) * D + hi * 8) * 2u;
#pragma unroll
    for (int d0 = 0; d0 < 8; ++d0) S.qr[d0] = LD16(cur.Q + d0 * 32, q_off);
    SLOAD_H(cur.K, cur.V, 0); VMW(); SWRITE_HK(0);
    __syncthreads();
}
template <bool MIXB>
__device__ __forceinline__ void block(const BlockRef& cur, const BlockRef& nxt, char* lds, Seam& S) {
    int tid = threadIdx.x; asm volatile("" : "+v"(tid));
    const int wid = __builtin_amdgcn_readfirstlane(tid >> 6), lane = tid & 63, r32 = lane & 31, hi = lane >> 5;
    const int NT = cur.P0 / KVBLK + 4;
    const int qlo = cur.P0 + wid * QBLK, qm = qlo + r32 - 4 * hi;
    char* V_lds = lds; char* K_lds = lds + 2 * SHM_V;
    float* wsf = (float*)(lds + 2 * SHM_V + 2 * SHM_K) + wid * 64; float* li_l = wsf, * al_l = wsf + 32;
    float m_reg = -1e30f, l_reg = 0; f32x16 o[4] = {};
    const int sr = tid >> 4, sc = (tid & 15) * 8, vst0 = v_st(sr, sc), vst1 = v_st(32 + sr, sc), kws = KSWZ(sr, sc * 2);
    const int vb0 = (int)(uintptr_t)V_lds + v_rd_base(lane);
    const unsigned st_off = (unsigned)(sr * D + sc) * 2u, q_off = (unsigned)((wid * QBLK + r32) * D + hi * 8) * 2u;
    const unsigned nb_off = (unsigned)hi * 16u, mk_off = (unsigned)(wid * QBLK + r32) * 512u;
    const char* Kh = cur.K; const char* Vh = cur.V;
#define RESC(a) do { if (__any((a) < 1.f)) { if (hi == 0) al_l[r32] = (a); asm volatile("s_waitcnt lgkmcnt(0)" ::: "memory");              \
                     for (int d_ = 0; d_ < 4; ++d_) for (int r = 0; r < 16; ++r) o[d_][r] *= al_l[crow(r, hi)]; } } while (0)
#define KBASE(t) ((t) * KVBLK)
#define PINIT(P0_, P1_, t) do { if (MIXB) { const char* nb_ = cur.NBQ + (size_t)KBASE(t) * 4; _Pragma("unroll") for (int g_ = 0; g_ < 4; ++g_) { \
            const f32x4 b0_ = *(const f32x4*)(nb_ + 32 * g_ + nb_off), b1_ = *(const f32x4*)(nb_ + 128 + 32 * g_ + nb_off); \
            _Pragma("unroll") for (int j_ = 0; j_ < 4; ++j_) { P0_[4 * g_ + j_] = b0_[j_]; P1_[4 * g_ + j_] = b1_[j_]; } } } else { P0_ = f32x16{}; P1_ = f32x16{}; } } while (0)
#define MKW(t) (*(const u64*)(cur.MK + (size_t)(t) * 8 + mk_off))
#define MASKT(P0_, P1_, t, MW_) do { if (MIXB) { const int kb_ = KBASE(t); if (kb_ + KVBLK - 1 > qlo) mask_causal(P0_, P1_, qm - kb_); } else mask_bits(P0_, P1_, MW_, hi); } while (0)
    f32x16 pA0, pA1, pB0, pB1; float mnA, mnB, alA, alB; s16x8 pa0, pa1, pa2, pa3;
    u64 mwA = 0, mwB = 0;
    if (!MIXB) { mwA = MKW(0); if (NT > 1) mwB = MKW(1); }
    PINIT(pA0, pA1, 0);
    if (NT > 1) PINIT(pB0, pB1, 1);
    SWRITE_HV(0); SBAR();
    if (NT > 1) SLOAD_H(Kh, Vh, KBASE(1));
    SBAR(); qkt<0>(pA0, pA1, K_lds, r32, hi, S.qr);
    MASKT(pA0, pA1, 0, mwA); if (!MIXB) { if (NT > 2) mwA = MKW(2); }
    partialSM(pA0, pA1, m_reg, mnA, alA);
    if (NT > 1) { VMW(); SWRITE_H(1); }
    __syncthreads();
#define HALF_STEP(PX0, PX1, mnX, alX, MWX, PY0, PY1, alY, t, KB, VB, SB) do {                                               \
        SBAR(); qkt<KB>(PX0, PX1, K_lds, r32, hi, S.qr);                                                                      \
        finishSM(PY0, PY1, alY, l_reg, pa0, pa1, pa2, pa3); SBAR();                                                           \
        if ((t) + 1 < NT) { PINIT(PY0, PY1, (t) + 1); SLOAD_H(Kh, Vh, KBASE((t) + 1)); SBAR(); }                             \
        pv_tile<VB>(o, vb0, pa0, pa1, pa2, pa3); MASKT(PX0, PX1, (t), MWX); if (!MIXB) { if ((t) + 2 < NT) MWX = MKW((t) + 2); } \
        partialSM(PX0, PX1, m_reg, mnX, alX);                                                                                 \
        __syncthreads();                                                                                                      \
        if ((t) + 1 < NT) { VMW(); SWRITE_H(SB); }                                                                            \
        RESC(alX); __syncthreads(); } while (0)
    for (int t = 1; t + 1 < NT; t += 2) {
        HALF_STEP(pB0, pB1, mnB, alB, mwB, pA0, pA1, alA, t, 1, 0, 0);
        HALF_STEP(pA0, pA1, mnA, alA, mwA, pB0, pB1, alB, t + 1, 0, 1, 1);
    }
    const bool even = (NT & 1) == 0;
    if (even) { SBAR(); qkt<1>(pB0, pB1, K_lds, r32, hi, S.qr); SBAR(); }
    SLOAD_H(nxt.K, nxt.V, 0); SBAR();
#pragma unroll
    for (int d0 = 0; d0 < 8; ++d0) S.qr[d0] = LD16(nxt.Q + d0 * 32, q_off);
    SBAR();
    finishSM(pA0, pA1, alA, l_reg, pa0, pa1, pa2, pa3); SBAR();
    pv_tile<0>(o, vb0, pa0, pa1, pa2, pa3);
    if (even) { MASKT(pB0, pB1, NT - 1, mwB); partialSM(pB0, pB1, m_reg, mnB, alB); __syncthreads(); RESC(alB);
        finishSM(pB0, pB1, alB, l_reg, pa0, pa1, pa2, pa3); SBAR(); pv_tile<1>(o, vb0, pa0, pa1, pa2, pa3); }
    SBAR(); VMWN(8); SWRITE_HK(0); SBAR();
    if (hi == 0) li_l[r32] = l_reg; asm volatile("s_waitcnt lgkmcnt(0)" ::: "memory");
    float rli[16];
#pragma unroll
    for (int r = 0; r < 16; ++r) rli[r] = __builtin_amdgcn_rcpf(li_l[crow(r, hi)]);
    const unsigned o_off = (unsigned)((wid * QBLK + 4 * hi) * 1024 + r32) * 2u;
#pragma unroll
    for (int r = 0; r < 16; ++r) {
#pragma unroll
        for (int d0 = 0; d0 < 4; ++d0) { const float v = o[d0][r] * rli[r];
            const float vn = __shfl_xor(v, 1);
            if ((r32 & 1) == 0) *(unsigned*)(cur.O + (size_t)(((r & 3) + 8 * (r >> 2)) * 2048 + d0 * 64) + o_off) = cvtpk(v, vn); } }
    __syncthreads();
#undef RESC
#undef KBASE
#undef PINIT
#undef MKW
#undef MASKT
#undef HALF_STEP
}
#undef LD16
#undef VMW
#undef VMWN
#undef SLOAD_H
#undef SWRITE_HK
#undef SWRITE_HV
#undef SWRITE_H
__device__ __forceinline__ BlockRef make_ref(bool mixb, unsigned char* ws, int bh, int qb) {
    const int b = bh >> 3, h = bh & 7, kvh = mixb ? bh : (b * HAKV + (h >> 2));
    BlockRef r;
    r.Q = (const char*)ws + (mixb ? WS_QB : WS_QA) + ((size_t)bh * T + (size_t)qb * QB) * D * 2;
    r.K = (const char*)ws + (mixb ? WS_KB : WS_KA) + (size_t)kvh * T * D * 2;
    r.V = (const char*)ws + (mixb ? WS_VB : WS_VA) + (size_t)kvh * T * D * 2;
    r.O = (char*)ws + (mixb ? WS_OUTB : WS_OUTA) + ((size_t)(b * T + qb * QB) * 1024 + h * D) * 2;
    r.P0 = qb * QB;
    r.NBQ = (const char*)ws + WS_NBQ + ((size_t)bh * 16 + qb) * T * 4;
    r.MK = (const char*)ws + WS_MASK + (size_t)(b * T + qb * QB) * 64 * 8;
    return r;
}
template <bool MIXB>
__device__ __forceinline__ void run_item(int item, unsigned char* ws, char* lds) {
    const int bh = (item >> 3) & 15, x = item & 7;
    Seam S;
    BlockRef cur = make_ref(MIXB, ws, bh, x);
    prime(cur, lds, S);
#pragma unroll 1
    for (int pass = 0; pass < 2; ++pass) {
        const BlockRef nxt = make_ref(MIXB, ws, bh, 15 - x);
        block<MIXB>(cur, nxt, lds, S);
        cur = nxt;
    }
}
}


#define XB_TMO      128
#define XB_XCNT(j)  (256  + 64 * (j))
#define XB_XSUB(j)  (1280 + 64 * (j))
#define XB_XGEN(j)  (2304 + 64 * (j))
#define XB_TOP      3328
#define XB_TOPGEN   3392
#define XCD_BAR_WORDS 3456
#define XB_SPIN_CAP (1u << 24)
__device__ __forceinline__ unsigned xb_ld(unsigned* p)              { return __hip_atomic_load(p, __ATOMIC_RELAXED, __HIP_MEMORY_SCOPE_AGENT); }
__device__ __forceinline__ unsigned xb_add(unsigned* p, unsigned v) { return __hip_atomic_fetch_add(p, v, __ATOMIC_RELAXED, __HIP_MEMORY_SCOPE_AGENT); }
__device__ __forceinline__ unsigned xb_xcc_id() { return (unsigned)__builtin_amdgcn_s_getreg((3 << 11) | 20) & 0xFu; }
#define XB_SPIN(cond, bar) do { unsigned _sp = 0; while (cond) { __builtin_amdgcn_s_sleep(1); \
    if ((++_sp & 255u) == 0u) { if (xb_ld(&(bar)[XB_TMO])) break; if (_sp > XB_SPIN_CAP) { atomicAdd(&(bar)[XB_TMO], 1u); break; } } } } while (0)
struct XcdBarrier { unsigned* bar; unsigned x; volatile LAS unsigned* st; };
__device__ __forceinline__ XcdBarrier xcd_barrier_post(unsigned* bar, volatile LAS unsigned* st) {
    XcdBarrier b; b.bar = bar; b.x = xb_xcc_id(); b.st = st;
    if (threadIdx.x == 0) (void)xb_add(&bar[XB_XCNT(b.x)], 1u);
    return b;
}
__device__ __forceinline__ void xcd_barrier_complete(unsigned* bar, unsigned x, unsigned& nloc, unsigned& nx) {
    const unsigned G = gridDim.x * gridDim.y * gridDim.z;
    unsigned sum, cnt, mine, sp = 0u;
    for (;;) {
        sum = 0u; cnt = 0u; mine = 0u;
#pragma unroll
        for (unsigned j = 0; j < 16; ++j) { const unsigned c = xb_ld(&bar[XB_XCNT(j)]); sum += c; cnt += (c > 0u) ? 1u : 0u; mine = (j == x) ? c : mine; }
        if (sum == G) break;
        __builtin_amdgcn_s_sleep(1);
        if ((++sp & 255u) == 0u) { if (xb_ld(&bar[XB_TMO])) break; if (sp > XB_SPIN_CAP) { atomicAdd(&bar[XB_TMO], 1u); break; } }
    }
    nloc = mine > 0u ? mine : 1u; nx = cnt > 0u ? cnt : 1u;
}
__device__ __forceinline__ void xcd_barrier(const XcdBarrier& b) {
    asm volatile("s_waitcnt vmcnt(0)" ::: "memory");
    __syncthreads();
    if (threadIdx.x == 0) {
        unsigned* bar = b.bar;
        __builtin_amdgcn_s_waitcnt(0);
        unsigned nloc = b.st[0], nx = b.st[1];
        if (nloc == 0u) { xcd_barrier_complete(bar, b.x, nloc, nx); b.st[0] = nloc; b.st[1] = nx; }
        const unsigned old = xb_add(&bar[XB_XSUB(b.x)], 1u);
        const unsigned gen = old / nloc;
        if (old + 1u == (gen + 1u) * nloc) {
            __builtin_amdgcn_fence(__ATOMIC_RELEASE, "agent");
            asm volatile("s_waitcnt vmcnt(0)" ::: "memory");
            const unsigned og = xb_add(&bar[XB_TOP], 1u);
            const unsigned tg = og / nx;
            if (og + 1u == (tg + 1u) * nx) xb_add(&bar[XB_TOPGEN], 1u);
            else XB_SPIN(xb_ld(&bar[XB_TOPGEN]) == tg, bar);
            __builtin_amdgcn_fence(__ATOMIC_ACQUIRE, "agent");
            xb_add(&bar[XB_XGEN(b.x)], 1u);
            asm volatile("s_waitcnt vmcnt(0)" ::: "memory");
        } else {
            XB_SPIN(xb_ld(&bar[XB_XGEN(b.x)]) == gen, bar);
            __builtin_amdgcn_fence(__ATOMIC_ACQUIRE, "agent");
            asm volatile("s_waitcnt vmcnt(0)" ::: "memory");
        }
    }
    __syncthreads();
}

namespace cg = cooperative_groups;
constexpr int LDS_BYTES = pg8::STAGE_BYTES + 256;
constexpr int CW_BAR = 4096;
struct Params { const float* in[17]; float* out; unsigned char* ws; };
template <class Epi>
__device__ __forceinline__ void run_gemm(LAS unsigned char* lds, const h16* A, const h16* Bt, int M, int N, int K, const Epi& e) {
    pg8::Gemm g{A, Bt, M, N, K}; pg8::StaticOrder S; S.init(M, N, (int)gridDim.x, (int)blockIdx.x);
    pg8::gemm_phase<Epi>(lds, g, S, e);
}
__global__ void __launch_bounds__(512, 2) mega_fwd(Params P) {
    extern __shared__ __attribute__((aligned(16))) unsigned char lds_raw[];
    LAS unsigned char* lds = (LAS unsigned char*)lds_raw;
    cg::grid_group grid = cg::this_grid();
    volatile LAS unsigned* bst = (volatile LAS unsigned*)(lds + pg8::STAGE_BYTES);
    if (threadIdx.x < 2) bst[threadIdx.x] = 0u;
    __syncthreads();
    const XcdBarrier xbar = xcd_barrier_post((unsigned*)(P.ws + WS_CTL) + CW_BAR, bst);
#define GRID_BAR() xcd_barrier(xbar)
#define IDS() int tid = threadIdx.x; asm volatile("" : "+v"(tid)); const int lane = tid & 63, wave = __builtin_amdgcn_readfirstlane(tid >> 6), gw = blockIdx.x * 8 + wave, NGW = gridDim.x * 8; (void)lane; (void)gw; (void)NGW
    const float* x = P.in[0]; const float* p = P.in[1]; const int* pos = (const int*)P.in[2];
    const float* g_mix = P.in[3]; const float* w_in = P.in[4]; const float* b_f = P.in[5];
    const float* w_o_a = P.in[6]; const float* w_o_b = P.in[7]; const float* w_out = P.in[8];
    const float* g_ffn = P.in[9]; const float* w_g = P.in[10]; const float* w_u = P.in[11]; const float* w_d = P.in[12];
    const float* g_ple = P.in[13]; const float* w_pg = P.in[14]; const float* w_pp = P.in[15]; const float* g_final = P.in[16];
    unsigned char* ws = P.ws; float* out = P.out;
    float* ROPE = (float*)(ws + WS_ROPE); float* CB = (float*)(ws + WS_CB); float* LOGF = (float*)(ws + WS_LOGF); u64* MASK = (u64*)(ws + WS_MASK);
    h16* WIN = (h16*)(ws + WS_WIN); h16* WOA = (h16*)(ws + WS_WOA); h16* WOB = (h16*)(ws + WS_WOB); h16* WOUT = (h16*)(ws + WS_WOUT);
    h16* WGU = (h16*)(ws + WS_WGU); h16* WDN = (h16*)(ws + WS_WDN); h16* WPG = (h16*)(ws + WS_WPG); h16* WPP = (h16*)(ws + WS_WPP);
    h16* QI = (h16*)(ws + WS_QI); h16* KI = (h16*)(ws + WS_KI); float* WI = (float*)(ws + WS_WI);
    h16* SIGA = (h16*)(ws + WS_SIGA); h16* SIGB = (h16*)(ws + WS_SIGB);
    h16* OUTA = (h16*)(ws + WS_OUTA); h16* OUTB = (h16*)(ws + WS_OUTB); h16* P16 = (h16*)(ws + WS_P16);
    h16* MIXED = (h16*)(ws + WS_MIXED); h16* H2 = (h16*)(ws + WS_H2); h16* ACT = (h16*)(ws + WS_ACT); h16* PP = (h16*)(ws + WS_PP);
    h16* H1 = (h16*)P.out;

    { IDS(); LAS float* scr = (LAS float*)(lds + wave * 8448);
      ph_transpose<1>(w_in, nullptr, DM, N_IN, WIN, N_INP, scr, gw, NGW, lane);
      ph_transpose<0>(w_o_a, nullptr, 1024, DM, WOA, DM, scr, gw, NGW, lane);
      ph_transpose<0>(w_o_b, nullptr, 1024, DM, WOB, DM, scr, gw, NGW, lane);
      ph_transpose<0>(w_out, nullptr, DM, DM, WOUT, DM, scr, gw, NGW, lane);
      ph_transpose<2>(w_g, w_u, DM, DFF, WGU, 2 * DFF, scr, gw, NGW, lane);
      ph_transpose<0>(w_d, nullptr, DFF, DM, WDN, DM, scr, gw, NGW, lane);
      ph_transpose<0>(w_pg, nullptr, DM, DM, WPG, DM, scr, gw, NGW, lane);
      ph_transpose<0>(w_pp, nullptr, DPLE, DM, WPP, DM, scr, gw, NGW, lane);
      ph_rope(pos, ROPE, blockIdx.x * 512 + tid, gridDim.x * 512);
      ph_rmsnorm<false>(x, g_mix, H1, nullptr, gw, NGW, lane);
    }
    grid.sync();
    { EpiInProj e{ws, b_f}; run_gemm(lds, H1, WIN, MTOK, N_INP, DM, e); }
    GRID_BAR();
    { IDS();
      if (gw >= NGW - 16) ph_cumsum(LOGF, CB, (float*)(ws + WS_NBQ), NGW - 1 - gw, lane);
      for (int it = blockIdx.x; it < 256; it += gridDim.x) { const int bb = it & 1, gi = it >> 1; idx::run_group(ws, (char*)lds_raw, bb, gi); idx::run_group(ws, (char*)lds_raw, bb, 255 - gi); }
      for (int i = blockIdx.x * 512 + tid; i < MTOK * DPLE / 4; i += gridDim.x * 512) st4h(P16 + 4 * (size_t)i, *((const f32x4*)p + i));
    }
    GRID_BAR();
    for (int it = blockIdx.x; it < 256; it += gridDim.x) {
        const int item = (it & 7) * 32 + (it >> 3);
        if (item < 128) att::run_item<false>(item, ws, (char*)lds_raw); else att::run_item<true>(item, ws, (char*)lds_raw);
    }
    GRID_BAR();
    { EpiGate<true> e{SIGA, MIXED}; run_gemm(lds, OUTA, WOA, MTOK, DM, 1024, e); }
    { EpiGate<false> e{SIGB, MIXED}; run_gemm(lds, OUTB, WOB, MTOK, DM, 1024, e); }
    GRID_BAR();
    { EpiResid e{x, out}; run_gemm(lds, MIXED, WOUT, MTOK, DM, DM, e); }
    GRID_BAR();
    { IDS(); ph_rmsnorm<false>(out, g_ffn, H2, nullptr, gw, NGW, lane); }
    GRID_BAR();
    { EpiSwiGLU e{ACT}; run_gemm(lds, H2, WGU, MTOK, 2 * DFF, DM, e); }
    GRID_BAR();
    { EpiResid e{out, out}; run_gemm(lds, ACT, WDN, MTOK, DM, DFF, e); }
    GRID_BAR();
    { IDS(); ph_rmsnorm<false>(out, g_ple, H2, nullptr, gw, NGW, lane); }
    GRID_BAR();
    { EpiStoreH e{PP, DM}; run_gemm(lds, P16, WPP, MTOK, DM, DPLE, e); }
    { EpiPLE e{PP, out}; run_gemm(lds, H2, WPG, MTOK, DM, DM, e); }
    GRID_BAR();
    { IDS(); ph_rmsnorm<true>(out, g_final, nullptr, out, gw, NGW, lane); }
#undef IDS
#undef GRID_BAR
}

extern "C" void kernel_launch(void* const* d_in, const int* in_sizes, int n_in, void* d_out, int out_size, void* d_ws, size_t ws_size, hipStream_t stream) {
    if (n_in != 17 || out_size != MTOK * DM || ws_size < WS_END) { fprintf(stderr, "kernel_launch: unexpected shapes / workspace (%d inputs, out %d, ws %zu)\n", n_in, out_size, ws_size); return; }
    static int grid_blocks = 0;
    if (!grid_blocks) {
        int dev = 0, cus = 0, per_cu = 0;
        (void)hipGetDevice(&dev);
        (void)hipDeviceGetAttribute(&cus, hipDeviceAttributeMultiprocessorCount, dev);
        (void)hipFuncSetAttribute((const void*)mega_fwd, hipFuncAttributeMaxDynamicSharedMemorySize, LDS_BYTES);
        (void)hipOccupancyMaxActiveBlocksPerMultiprocessor(&per_cu, (const void*)mega_fwd, 512, LDS_BYTES);
        if (per_cu < 1) { fprintf(stderr, "kernel_launch: occupancy query says %d blocks per CU\n", per_cu); per_cu = 1; }
        if (per_cu > 1) per_cu = 1;
        grid_blocks = cus * per_cu;
    }
    (void)hipMemsetAsync((char*)d_ws + WS_CTL, 0, 64 * 1024, stream);
    Params prm{};
    for (int i = 0; i < 17; ++i) prm.in[i] = (const float*)d_in[i];
    prm.out = (float*)d_out; prm.ws = (unsigned char*)d_ws;
    void* args[] = {&prm};
    hipError_t e = hipLaunchCooperativeKernel((const void*)mega_fwd, dim3(grid_blocks), dim3(512), args, LDS_BYTES, stream);
    if (e != hipSuccess) fprintf(stderr, "cooperative launch failed: %s (grid %d)\n", hipGetErrorString(e), grid_blocks);
}
```

```cpp
#include <hip/hip_runtime.h>
#include <hip/hip_cooperative_groups.h>
#include <stdint.h>
#include <cstdio>

#define LAS __attribute__((address_space(3)))
typedef _Float16 h16;
typedef _Float16 h16x8 __attribute__((ext_vector_type(8)));
typedef _Float16 h16x4 __attribute__((ext_vector_type(4)));
typedef _Float16 h16x2 __attribute__((ext_vector_type(2)));
typedef float f32x4 __attribute__((ext_vector_type(4)));
typedef float f32x2 __attribute__((ext_vector_type(2)));
typedef unsigned u32x4 __attribute__((ext_vector_type(4)));
typedef unsigned u32x2 __attribute__((ext_vector_type(2)));
typedef unsigned long long u64;

constexpr int NBATCH = 2, T = 4096, MTOK = NBATCH * T, DM = 2048;
constexpr int HA = 8, HAKV = 2, HIDX = 16, DIDX = 64, HB = 8, HD = 128;
constexpr int N_IN = 9816, N_INP = 9984, DFF = 5632, DPLE = 256, TOPK = 256;
constexpr float EPS = 1e-6f;
constexpr float ATT_SCALE = 0.08838834764831845f;

constexpr size_t MiB = 1u << 20;
constexpr size_t WS_CTL = 0;
constexpr size_t WS_ROPE = 1 * MiB;
constexpr size_t WS_CB = 3 * MiB;
constexpr size_t WS_LOGF = 3 * MiB + 512 * 1024;
constexpr size_t WS_MASK = 4 * MiB;
constexpr size_t WS_WIN = 8 * MiB;
constexpr size_t WS_OUTA = 8 * MiB, WS_OUTB = 24 * MiB, WS_P16 = 40 * MiB;
constexpr size_t WS_WOA = 47 * MiB, WS_WOB = 51 * MiB, WS_WOUT = 55 * MiB, WS_WGU = 63 * MiB, WS_WDN = 107 * MiB, WS_WPG = 129 * MiB, WS_WPP = 137 * MiB;
constexpr size_t WS_QA = 138 * MiB, WS_KA = 154 * MiB, WS_VA = 158 * MiB, WS_QI = 162 * MiB, WS_KI = 178 * MiB, WS_WI = 179 * MiB;
constexpr size_t WS_QB = 180 * MiB, WS_KB = 196 * MiB, WS_VB = 212 * MiB, WS_SIGA = 228 * MiB, WS_SIGB = 260 * MiB, WS_NBQ = 292 * MiB, WS_END = 296 * MiB;
constexpr size_t WS_MIXED = WS_QB;
constexpr size_t WS_H2 = WS_QA;
constexpr size_t WS_ACT = WS_QB;
constexpr size_t WS_PP = WS_QB;

namespace pg8 {
constexpr int BM = 256, BK = 64, HALF = 128, HTB = HALF * BK * 2, STAGE_BYTES = 8 * HTB, NXCD = 8, WGM = 8;
__host__ __device__ __forceinline__ int lds_byte(int r, int c) { const int st = (r >> 4) * 2 + (c >> 5), rr = r & 15, cc = c & 31, ob = rr * 64 + cc * 2; return st * 1024 + (ob ^ (((ob >> 9) & 1) << 5)); }
__host__ __device__ __forceinline__ void stage_rc(int b, int& R, int& C) { const int st = b / 1024, sb = b % 1024, swz = sb ^ (((sb >> 9) & 1) << 5); R = (st >> 1) * 16 + swz / 64; C = (st & 1) * 32 + (swz % 64) / 2; }
struct Unit { int pm, pn; };
struct Gemm { const h16* A; const h16* Bt; int M, N, K; };
struct StaticOrder {
    int nM, nN, nwg, G, c;
    __host__ __device__ void init(int M, int N, int G_, int c_) { nM = M / BM; nN = N / BM; nwg = nM * nN; G = G_; c = c_; }
    __host__ __device__ bool next(int i, Unit& u) const {
        const long L = (long)i * G + c; if (L >= nwg) return false;
        int wgid = (int)L; { const int q = nwg / NXCD, r = nwg % NXCD, xcd = wgid % NXCD, off = wgid / NXCD; wgid = (xcd < r ? xcd * (q + 1) : r * (q + 1) + (xcd - r) * q) + off; }
        const int nig = WGM * nN, gid = wgid / nig, fm = gid * WGM, gsz = (nM - fm) < WGM ? (nM - fm) : WGM;
        u.pm = fm + ((wgid % nig) % gsz); u.pn = (wgid % nig) / gsz; return true;
    }
};
template <class Epi>
__device__ __forceinline__ void gemm_phase(LAS unsigned char* lds, const Gemm g, const StaticOrder& S, const Epi& E) {
    int tid = threadIdx.x; asm volatile("" : "+v"(tid));
    const int wid = __builtin_amdgcn_readfirstlane(tid >> 6), lane = tid & 63, wr = wid >> 2, wc = wid & 3, fr = lane & 15, fq = lane >> 4;
    const int K = g.K, nt = K / BK;
    unsigned voffA[2];
#pragma unroll
    for (int i = 0; i < 2; ++i) { int R, C; stage_rc(tid * 16 + i * 8192, R, C); voffA[i] = (unsigned)(R * K + C) * 2u; }
    const size_t kstep = (size_t)(BK * 2);
    const size_t hstep = (size_t)HALF * K * 2;
    const size_t tstep = 2 * hstep;
    const unsigned ldsw = (unsigned)wid * 1024u;
    const int aoff = lds_byte(wr * 64 + fr, fq * 8), boff = lds_byte(wc * 32 + fr, fq * 8);
#define PG8_SA(b, h) (((b) * 2 + (h)) * HTB)
#define PG8_SB(b, h) ((4 + (b) * 2 + (h)) * HTB)
#define PG8_STAGE(bufoff, gbase) do { _Pragma("unroll") for (int _i = 0; _i < 2; ++_i) \
        __builtin_amdgcn_global_load_lds((const unsigned*)((const char*)(gbase) + voffA[_i]), (LAS unsigned*)(lds + (bufoff) + ldsw + _i * 8192), 16, 0, 0); } while (0)
#define PG8_LDA(dst, b, h) do { _Pragma("unroll") for (int m = 0; m < 4; ++m) _Pragma("unroll") for (int k = 0; k < 2; ++k) dst[m][k] = *(const LAS h16x8*)(lds + PG8_SA(b, h) + aoff + m * 2048 + k * 1024); } while (0)
#define PG8_LDB(dst, b, h) do { _Pragma("unroll") for (int n = 0; n < 2; ++n) _Pragma("unroll") for (int k = 0; k < 2; ++k) dst[n][k] = *(const LAS h16x8*)(lds + PG8_SB(b, h) + boff + n * 2048 + k * 1024); } while (0)
#define PG8_MMA(ai, bj, At, Bt) do { __builtin_amdgcn_s_setprio(1); _Pragma("unroll") for (int m = 0; m < 4; ++m) _Pragma("unroll") for (int n = 0; n < 2; ++n) _Pragma("unroll") for (int k = 0; k < 2; ++k) \
        acc[ai][bj][m][n] = __builtin_amdgcn_mfma_f32_16x16x32_f16(Bt[n][k], At[m][k], acc[ai][bj][m][n], 0, 0, 0); __builtin_amdgcn_s_setprio(0); } while (0)
#define PG8_WAIT_V(n) asm volatile("s_waitcnt vmcnt(" #n ")" ::: "memory")
#define PG8_WAIT_L(n) asm volatile("s_waitcnt lgkmcnt(" #n ")" ::: "memory")
#define PG8_BAR __builtin_amdgcn_s_barrier()
#define PG8_SCHED __builtin_amdgcn_sched_barrier(0)
    Unit cur, nxt; int ui = 0;
    if (!S.next(0, cur)) return;
    f32x4 acc[2][2][4][2];
#pragma unroll
    for (int a = 0; a < 2; ++a)
#pragma unroll
        for (int b = 0; b < 2; ++b)
#pragma unroll
            for (int m = 0; m < 4; ++m)
#pragma unroll
                for (int n = 0; n < 2; ++n) acc[a][b][m][n] = (f32x4){0.f, 0.f, 0.f, 0.f};
    h16x8 At[4][2], B0[2][2], B1[2][2];
    const char* cA = (const char*)g.A + (size_t)cur.pm * tstep; const char* cB = (const char*)g.Bt + (size_t)cur.pn * tstep;
    PG8_STAGE(PG8_SB(0, 0), cB); PG8_STAGE(PG8_SA(0, 0), cA); PG8_STAGE(PG8_SB(0, 1), cB + hstep); PG8_STAGE(PG8_SA(0, 1), cA + hstep);
    if (wr == 1) PG8_BAR;
    PG8_WAIT_V(4); PG8_BAR;
    PG8_STAGE(PG8_SB(1, 0), cB + kstep); PG8_STAGE(PG8_SA(1, 0), cA + kstep); PG8_STAGE(PG8_SB(1, 1), cB + hstep + kstep);
    PG8_WAIT_V(6); PG8_BAR;
    for (;;) {
        const bool has_next = S.next(ui + 1, nxt);
        const char* nA = has_next ? (const char*)g.A + (size_t)nxt.pm * tstep : cA; const char* nB = has_next ? (const char*)g.Bt + (size_t)nxt.pn * tstep : cB;
        for (int t = 0; t < nt; t += 2) {
            const bool last = (t == nt - 2);
            const char* a1 = cA + (size_t)(t + 1) * kstep;
            const char* a2 = last ? nA : cA + (size_t)(t + 2) * kstep; const char* b2 = last ? nB : cB + (size_t)(t + 2) * kstep;
            const char* a3 = a2 + kstep; const char* b3 = b2 + kstep;
            PG8_LDB(B0, 0, 0); PG8_SCHED; PG8_LDA(At, 0, 0); PG8_STAGE(PG8_SA(1, 1), a1 + hstep);
            PG8_WAIT_L(8); PG8_BAR; PG8_WAIT_L(0); PG8_MMA(0, 0, At, B0); PG8_BAR; PG8_SCHED;
            PG8_LDB(B1, 0, 1); PG8_STAGE(PG8_SB(0, 0), b2);
            PG8_BAR; PG8_WAIT_L(0); PG8_MMA(0, 1, At, B1); PG8_BAR;
            PG8_LDA(At, 0, 1); PG8_STAGE(PG8_SA(0, 0), a2);
            PG8_BAR; PG8_WAIT_L(0); PG8_MMA(1, 0, At, B0); PG8_BAR; PG8_SCHED;
            PG8_STAGE(PG8_SB(0, 1), b2 + hstep);
            PG8_WAIT_V(6); PG8_BAR; PG8_MMA(1, 1, At, B1); PG8_BAR;
            PG8_LDB(B0, 1, 0); PG8_SCHED; PG8_LDA(At, 1, 0); PG8_STAGE(PG8_SA(0, 1), a2 + hstep);
            PG8_WAIT_L(8); PG8_BAR; PG8_WAIT_L(0); PG8_MMA(0, 0, At, B0); PG8_BAR; PG8_SCHED;
            PG8_LDB(B1, 1, 1); PG8_STAGE(PG8_SB(1, 0), b3);
            PG8_BAR; PG8_WAIT_L(0); PG8_MMA(0, 1, At, B1); PG8_BAR;
            PG8_LDA(At, 1, 1); PG8_STAGE(PG8_SA(1, 0), a3);
            PG8_BAR; PG8_WAIT_L(0); PG8_MMA(1, 0, At, B0); PG8_BAR; PG8_SCHED;
            PG8_STAGE(PG8_SB(1, 1), b3 + hstep);
            PG8_WAIT_V(6); PG8_BAR; PG8_MMA(1, 1, At, B1); PG8_BAR;
        }
        E(acc, cur, wr, wc, fr, fq);
        if (!has_next) break;
#pragma unroll
        for (int a = 0; a < 2; ++a)
#pragma unroll
            for (int b = 0; b < 2; ++b)
#pragma unroll
                for (int m = 0; m < 4; ++m)
#pragma unroll
                    for (int n = 0; n < 2; ++n) acc[a][b][m][n] = (f32x4){0.f, 0.f, 0.f, 0.f};
        cur = nxt; cA = nA; cB = nB; ++ui;
    }
    PG8_WAIT_V(0);
    if (wr == 0) PG8_BAR;
    PG8_BAR;
#undef PG8_SA
#undef PG8_SB
#undef PG8_STAGE
#undef PG8_LDA
#undef PG8_LDB
#undef PG8_MMA
#undef PG8_WAIT_V
#undef PG8_WAIT_L
#undef PG8_BAR
#undef PG8_SCHED
}
}
using pg8::Unit;
typedef f32x4 Acc[2][2][4][2];

__device__ __forceinline__ void st4h(h16* p, f32x4 v) { h16x4 o; o[0] = (h16)v[0]; o[1] = (h16)v[1]; o[2] = (h16)v[2]; o[3] = (h16)v[3]; *(h16x4*)p = o; }
__device__ __forceinline__ f32x4 ld4h(const h16* p) { const h16x4 o = *(const h16x4*)p; return (f32x4){(float)o[0], (float)o[1], (float)o[2], (float)o[3]}; }
__device__ __forceinline__ float sigmoidf_(float x) { return 1.0f / (1.0f + __expf(-x)); }
__device__ __forceinline__ float logsigmoidf_(float z) { return fminf(z, 0.f) - __logf(1.0f + __expf(-fabsf(z))); }
__device__ __forceinline__ float wave_sum(float v) {
#pragma unroll
    for (int o = 1; o < 64; o <<= 1) v += __shfl_xor(v, o);
    return v;
}

struct EpiInProj {
    unsigned char* ws; const float* b_f;
    __device__ __forceinline__ void operator()(const Acc& acc, const Unit& u, int wr, int wc, int fr, int fq) const {
        const int pn = u.pn, row0 = u.pm * 256 + wr * 64 + fr;
        const float* ROPE = (const float*)(ws + WS_ROPE);
#pragma unroll
        for (int ai = 0; ai < 2; ++ai)
#pragma unroll
            for (int m = 0; m < 4; ++m) {
                const int row = row0 + ai * 128 + m * 16, b = row >> 12, t = row & 4095;
                const float* rp = ROPE + (size_t)row * 48;
#pragma unroll
                for (int bj = 0; bj < 2; ++bj) {
                    f32x4 v0 = acc[ai][bj][m][0], v1 = acc[ai][bj][m][1];
                    const int d0 = 32 * wc + 4 * fq;
                    if (pn < 6) {
                        size_t off;
                        if (pn < 4) off = WS_QA + (((size_t)(b * HA + pn * 2 + bj) * T + t) * HD) * 2;
                        else off = (pn == 4 ? WS_KA : WS_VA) + (((size_t)(b * HAKV + bj) * T + t) * HD) * 2;
                        h16* dst = (h16*)(ws + off);
                        if (pn < 5 && wc == 0) {
                            const f32x4 c = *(const f32x4*)(rp + 4 * fq), s = *(const f32x4*)(rp + 16 + 4 * fq);
                            const f32x4 y0 = v0 * c - v1 * s, y1 = v1 * c + v0 * s; v0 = y0; v1 = y1;
                        }
                        st4h(dst + d0, v0); st4h(dst + d0 + 16, v1);
                    } else if (pn < 11) {
                        const bool is_q = pn < 10;
                        if (is_q || bj == 0) {
                            if (is_q || wc < 2) {
                                const int dd = 32 * (wc & 1) + 4 * fq;
                                const size_t off = is_q ? WS_QI + ((size_t)row * 1024 + ((pn - 6) * 4 + 2 * bj + (wc >> 1)) * 64) * 2 : WS_KI + ((size_t)row * 64) * 2;
                                h16* dst = (h16*)(ws + off);
                                if ((wc & 1) == 0) {
                                    f32x4 pr;
#pragma unroll
                                    for (int j = 0; j < 4; ++j) pr[j] = __shfl_xor(v0[j], 32);
                                    const f32x4 c = *(const f32x4*)(rp + 32 + 4 * (fq & 1)), s = *(const f32x4*)(rp + 40 + 4 * (fq & 1));
                                    v0 = (fq < 2) ? (v0 * c - pr * s) : (v0 * c + pr * s);
                                }
                                st4h(dst + dd, v0); st4h(dst + dd + 16, v1);
                            } else if (wc == 2) {
                                *(f32x4*)((float*)(ws + WS_WI) + (size_t)row * 16 + 4 * fq) = v0 * 0.03125f;
                                if (fq < 2) { const f32x4 bf = *(const f32x4*)(b_f + 4 * fq); f32x4 o;
#pragma unroll
                                    for (int j = 0; j < 4; ++j) o[j] = logsigmoidf_(v1[j] + bf[j]);
                                    *(f32x4*)((float*)(ws + WS_LOGF) + (size_t)row * 8 + 4 * fq) = o; }
                            }
                        }
                    } else if (pn < 23) {
                        const int q = pn - 11, which = q >> 2, head = (q & 3) * 2 + bj;
                        h16* dst = (h16*)(ws + WS_QB + (size_t)which * (WS_KB - WS_QB)) + ((size_t)(b * HB + head) * T + t) * HD;
                        st4h(dst + d0, v0); st4h(dst + d0 + 16, v1);
                    } else {
                        const int q = pn - 23; const int col = (q & 7) * 256 + 128 * bj + d0;
                        h16* base = (h16*)(ws + WS_SIGA + (size_t)(q >> 3) * (WS_SIGB - WS_SIGA));
#pragma unroll
                        for (int j = 0; j < 4; ++j) { v0[j] = sigmoidf_(v0[j]); v1[j] = sigmoidf_(v1[j]); }
                        st4h(base + (size_t)row * DM + col, v0); st4h(base + (size_t)row * DM + col + 16, v1);
                    }
                }
            }
    }
};
static_assert(WS_VB - WS_KB == WS_KB - WS_QB, "QB/KB/VB equally spaced");
template <bool FIRST> struct EpiGate {
    const h16* SIG; h16* MIXED;
    __device__ __forceinline__ void operator()(const Acc& acc, const Unit& u, int wr, int wc, int fr, int fq) const {
        const int row0 = u.pm * 256 + wr * 64 + fr, col0 = u.pn * 256 + 32 * wc + 4 * fq;
#pragma unroll
        for (int ai = 0; ai < 2; ++ai)
#pragma unroll
            for (int m = 0; m < 4; ++m)
#pragma unroll
                for (int bj = 0; bj < 2; ++bj)
#pragma unroll
                    for (int n = 0; n < 2; ++n) { const size_t off = (size_t)(row0 + ai * 128 + m * 16) * DM + col0 + bj * 128 + n * 16;
                        f32x4 v = ld4h(SIG + off) * acc[ai][bj][m][n]; if (!FIRST) v += ld4h(MIXED + off); st4h(MIXED + off, v); }
    }
};
struct EpiResid {
    const float* BASE; float* OUT;
    __device__ __forceinline__ void operator()(const Acc& acc, const Unit& u, int wr, int wc, int fr, int fq) const {
        const int row0 = u.pm * 256 + wr * 64 + fr, col0 = u.pn * 256 + 32 * wc + 4 * fq;
#pragma unroll
        for (int ai = 0; ai < 2; ++ai)
#pragma unroll
            for (int m = 0; m < 4; ++m)
#pragma unroll
                for (int bj = 0; bj < 2; ++bj)
#pragma unroll
                    for (int n = 0; n < 2; ++n) { const size_t off = (size_t)(row0 + ai * 128 + m * 16) * DM + col0 + bj * 128 + n * 16;
                        *(f32x4*)(OUT + off) = *(const f32x4*)(BASE + off) + acc[ai][bj][m][n]; }
    }
};
struct EpiSwiGLU {
    h16* ACT;
    __device__ __forceinline__ void operator()(const Acc& acc, const Unit& u, int wr, int wc, int fr, int fq) const {
        const int row0 = u.pm * 256 + wr * 64 + fr;
#pragma unroll
        for (int ai = 0; ai < 2; ++ai)
#pragma unroll
            for (int m = 0; m < 4; ++m)
#pragma unroll
                for (int bj = 0; bj < 2; ++bj) { const f32x4 g = acc[ai][bj][m][0], uu = acc[ai][bj][m][1]; f32x4 o;
#pragma unroll
                    for (int j = 0; j < 4; ++j) o[j] = g[j] * sigmoidf_(g[j]) * uu[j];
                    st4h(ACT + (size_t)(row0 + ai * 128 + m * 16) * DFF + 16 * (u.pn * 8 + bj * 4 + wc) + 4 * fq, o); }
    }
};
struct EpiStoreH {
    h16* O; int ldc;
    __device__ __forceinline__ void operator()(const Acc& acc, const Unit& u, int wr, int wc, int fr, int fq) const {
        const int row0 = u.pm * 256 + wr * 64 + fr, col0 = u.pn * 256 + 32 * wc + 4 * fq;
#pragma unroll
        for (int ai = 0; ai < 2; ++ai)
#pragma unroll
            for (int m = 0; m < 4; ++m)
#pragma unroll
                for (int bj = 0; bj < 2; ++bj)
#pragma unroll
                    for (int n = 0; n < 2; ++n) st4h(O + (size_t)(row0 + ai * 128 + m * 16) * ldc + col0 + bj * 128 + n * 16, acc[ai][bj][m][n]);
    }
};
struct EpiPLE {
    const h16* PP; float* X;
    __device__ __forceinline__ void operator()(const Acc& acc, const Unit& u, int wr, int wc, int fr, int fq) const {
        const int row0 = u.pm * 256 + wr * 64 + fr, col0 = u.pn * 256 + 32 * wc + 4 * fq;
#pragma unroll
        for (int ai = 0; ai < 2; ++ai)
#pragma unroll
            for (int m = 0; m < 4; ++m)
#pragma unroll
                for (int bj = 0; bj < 2; ++bj)
#pragma unroll
                    for (int n = 0; n < 2; ++n) { const size_t off = (size_t)(row0 + ai * 128 + m * 16) * DM + col0 + bj * 128 + n * 16;
                        const f32x4 a = acc[ai][bj][m][n], pp = ld4h(PP + off); f32x4 x = *(const f32x4*)(X + off);
#pragma unroll
                        for (int j = 0; j < 4; ++j) x[j] += sigmoidf_(a[j]) * pp[j];
                        *(f32x4*)(X + off) = x; }
    }
};


__device__ __forceinline__ int map_in(int p) {
    if (p < 2560) return p;
    if (p < 2816) { const int c = p - 2560; if (c < 64) return 2560 + c; if (c < 80) return 2624 + (c - 64); if (c < 88) return 5712 + (c - 80); return -1; }
    const int q = p - 2816; if (q < 3072) return 2640 + q; return 5720 + (q - 3072);
}
template <int MODE>
__device__ __forceinline__ const float* tr_src(const float* W0, const float* W1, int Nsrc, int n) {
    if (MODE == 0) return n < Nsrc ? W0 + n : nullptr;
    if (MODE == 1) { const int c = map_in(n); return c >= 0 ? W0 + c : nullptr; }
    return (((n >> 4) & 1) ? W1 : W0) + 16 * (n >> 5) + (n & 15);
}
template <int MODE>
__device__ __forceinline__ void ph_transpose(const float* W0, const float* W1, int K, int Nsrc, h16* WT, int Nphys, LAS float* scr, int gw, int NGW, int lane) {
    const int nblk = Nphys / 32, nitems = (K / 64) * nblk;
    const int lr = lane >> 3, lc = (lane & 7) * 4;
    f32x4 cur[8], nxt[8];
    int item = gw;
    if (item < nitems) { const int kb = item / nblk, nb = item % nblk; const float* src = tr_src<MODE>(W0, W1, Nsrc, 32 * nb + lc);
#pragma unroll
        for (int i = 0; i < 8; ++i) cur[i] = src ? *(const f32x4*)(src + (size_t)(64 * kb + lr + 8 * i) * Nsrc) : (f32x4){0.f, 0.f, 0.f, 0.f}; }
    for (; item < nitems; item += NGW) {
        const int kb = item / nblk, nb = item % nblk, k0 = 64 * kb, n0 = 32 * nb;
        const int itn = item + NGW;
        if (itn < nitems) { const int kbn = itn / nblk, nbn = itn % nblk; const float* src = tr_src<MODE>(W0, W1, Nsrc, 32 * nbn + lc);
#pragma unroll
            for (int i = 0; i < 8; ++i) nxt[i] = src ? *(const f32x4*)(src + (size_t)(64 * kbn + lr + 8 * i) * Nsrc) : (f32x4){0.f, 0.f, 0.f, 0.f}; }
#pragma unroll
        for (int i = 0; i < 8; ++i) { LAS float* d = scr + (lr + 8 * i) * 33 + lc; d[0] = cur[i][0]; d[1] = cur[i][1]; d[2] = cur[i][2]; d[3] = cur[i][3]; }
        __builtin_amdgcn_wave_barrier(); asm volatile("s_waitcnt lgkmcnt(0)" ::: "memory");
        const int c = lane & 7;
#pragma unroll
        for (int j = 0; j < 4; ++j) { const int nn = (lane >> 3) + 8 * j; const LAS float* sp = scr + (8 * c) * 33 + nn;
            h16x8 o;
#pragma unroll
            for (int e = 0; e < 8; ++e) o[e] = (h16)sp[e * 33];
            *(h16x8*)(WT + (size_t)(n0 + nn) * K + k0 + 8 * c) = o; }
        __builtin_amdgcn_wave_barrier(); asm volatile("s_waitcnt lgkmcnt(0)" ::: "memory");
#pragma unroll
        for (int i = 0; i < 8; ++i) cur[i] = nxt[i];
    }
}
__device__ __forceinline__ void sincos_f32arg(float ang, float& sn, float& cs) {
    const double a = (double)ang;
    const double rev = a * 0.15915494309189535;
    const double fr = rev - __builtin_rint(rev);
    const double q4 = fr * 4.0; const double qi = __builtin_rint(q4); const int qq = ((int)qi) & 3;
    const double r = (q4 - qi) * 1.5707963267948966;
    const double r2 = r * r;
    const double s = r * (1.0 + r2 * (-1.0 / 6 + r2 * (1.0 / 120 + r2 * (-1.0 / 5040 + r2 * (1.0 / 362880 + r2 * (-1.0 / 39916800))))));
    const double c = 1.0 + r2 * (-0.5 + r2 * (1.0 / 24 + r2 * (-1.0 / 720 + r2 * (1.0 / 40320 + r2 * (-1.0 / 3628800 + r2 * (1.0 / 479001600))))));
    double so, co;
    if (qq == 0) { so = s; co = c; } else if (qq == 1) { so = c; co = -s; } else if (qq == 2) { so = -s; co = -c; } else { so = -c; co = s; }
    sn = (float)so; cs = (float)co;
}
__device__ __forceinline__ void ph_rope(const int* pos, float* ROPE, int gtid, int NGT) {
    for (int idx = gtid; idx < MTOK * 24; idx += NGT) {
        const int tok = idx / 24, i = idx % 24, k = i < 16 ? i : 2 * (i - 16);
        float f = 0x1.000000p+0f;
        f = k == 1 ? 0x1.c2ef76p-2f : f; f = k == 2 ? 0x1.8d275ep-3f : f; f = k == 3 ? 0x1.5dc95ap-4f : f; f = k == 4 ? 0x1.341190p-5f : f; f = k == 5 ? 0x1.0f5384p-6f : f;
        f = k == 6 ? 0x1.ddee9cp-8f : f; f = k == 7 ? 0x1.a4ee3ep-9f : f; f = k == 8 ? 0x1.72ba44p-10f : f; f = k == 9 ? 0x1.468318p-11f : f; f = k == 10 ? 0x1.1f91f0p-12f : f;
        f = k == 11 ? 0x1.fa8b84p-14f : f; f = k == 12 ? 0x1.be218ap-15f : f; f = k == 13 ? 0x1.88ec22p-16f : f; f = k == 14 ? 0x1.5a0f50p-17f : f; f = k == 15 ? 0x1.30c94ep-18f : f;
        const float ang = (float)pos[tok] * f;
        float sn, cs; sincos_f32arg(ang, sn, cs);
        float* rp = ROPE + (size_t)tok * 48;
        if (i < 16) { rp[i] = cs; rp[16 + i] = sn; } else { rp[32 + (i - 16)] = cs; rp[40 + (i - 16)] = sn; }
    }
}
template <bool TO_F32>
__device__ __forceinline__ void ph_rmsnorm(const float* X, const float* g, h16* OUTH, float* OUTF, int gw, int NGW, int lane) {
    for (int row = gw; row < MTOK; row += NGW) {
        const f32x4* xr = (const f32x4*)(X + (size_t)row * DM) + lane;
        f32x4 v[8]; float s = 0.f;
#pragma unroll
        for (int j = 0; j < 8; ++j) { v[j] = xr[64 * j]; s += (v[j][0] * v[j][0] + v[j][1] * v[j][1]) + (v[j][2] * v[j][2] + v[j][3] * v[j][3]); }
        const float r = 1.0f / sqrtf(wave_sum(s) * (1.0f / DM) + EPS);
#pragma unroll
        for (int j = 0; j < 8; ++j) { const f32x4 gg = *((const f32x4*)g + lane + 64 * j); const f32x4 o = v[j] * r * gg;
            if (TO_F32) *((f32x4*)(OUTF + (size_t)row * DM) + lane + 64 * j) = o; else st4h(OUTH + (size_t)row * DM + 4 * (lane + 64 * j), o); }
    }
}
__device__ __forceinline__ void ph_cumsum(const float* LOGF, float* CB, float* NBQ, int bh, int lane) {
    const int b = bh >> 3, h = bh & 7;
    float loc[64]; float s = 0.f;
#pragma unroll
    for (int i = 0; i < 64; ++i) { s += LOGF[(size_t)(b * T + lane * 64 + i) * 8 + h]; loc[i] = s; }
    float inc = s;
#pragma unroll
    for (int o = 1; o < 64; o <<= 1) { const float nb = __shfl_up(inc, o); if (lane >= o) inc += nb; }
    const float base = inc - s;
#pragma unroll
    for (int i = 0; i < 64; ++i) { loc[i] += base; CB[(size_t)bh * T + lane * 64 + i] = loc[i]; }
#pragma unroll 1
    for (int qb = 0; qb < 16; ++qb) {
        const float ref = __shfl(loc[63], 4 * qb + 3);
        if (lane < 4 * (qb + 1)) { float* dst = NBQ + ((size_t)bh * 16 + qb) * T + lane * 64;
#pragma unroll
            for (int i = 0; i < 64; ++i) dst[i] = (ref - loc[i]) * 11.313708498984761f; }
    }
}

__device__ __forceinline__ unsigned fkey(float f) { const unsigned u = __float_as_uint(f + 0.0f); return (u & 0x80000000u) ? ~u : (u | 0x80000000u); }
__device__ __forceinline__ unsigned count_ge(const unsigned (&key)[64], unsigned th) {
    unsigned c = 0;
#pragma unroll
    for (int j = 0; j < 64; ++j) c += (unsigned)__builtin_popcountll(__ballot(key[j] >= th));
    return c;
}
__device__ __forceinline__ u64 topk_select(const unsigned (&key)[64], int nvalid, int lane) {
    u64 myword = 0;
    if (nvalid <= TOPK) {
#pragma unroll
        for (int j = 0; j < 64; ++j) { const u64 bal = __ballot(key[j] != 0u); if (lane == j) myword = bal; }
    } else {
        unsigned th = 0u; bool exact = false;
        for (int bit = 31; bit >= 0; --bit) { const unsigned tc = th | (1u << bit); const unsigned c = count_ge(key, tc); if (c >= (unsigned)TOPK) th = tc; if (c == (unsigned)TOPK) { exact = true; break; } }
        if (exact) {
#pragma unroll
            for (int j = 0; j < 64; ++j) { const u64 bal = __ballot(key[j] >= th); if (lane == j) myword = bal; }
        } else {
            unsigned cgt = 0;
#pragma unroll
            for (int j = 0; j < 64; ++j) cgt += (unsigned)__builtin_popcountll(__ballot(key[j] > th));
            int need = TOPK - (int)cgt;
#pragma unroll
            for (int j = 0; j < 64; ++j) { u64 eq = __ballot(key[j] == th); const u64 gt = __ballot(key[j] > th);
                int pc = __builtin_popcountll(eq);
                while (pc > need) { eq &= ~(1ull << (63 - __builtin_clzll(eq))); --pc; }
                need -= pc; if (lane == j) myword = gt | eq; }
        }
    }
    return myword;
}
__device__ __forceinline__ void ph_topk_naive(const h16* QI, const h16* KI, const float* WI, u64* MASK, LAS float* qs, LAS unsigned* ks, int gw, int NGW, int lane) {
    for (int row = gw; row < MTOK; row += NGW) {
        const int b = row >> 12, t = row & 4095;
        { const h16* qp = QI + (size_t)row * 1024 + lane * 16;
#pragma unroll
          for (int i = 0; i < 16; ++i) qs[lane * 16 + i] = (float)qp[i]; }
        if (lane < 16) qs[1024 + lane] = WI[(size_t)row * 16 + lane];
        __builtin_amdgcn_wave_barrier(); asm volatile("s_waitcnt lgkmcnt(0)" ::: "memory");
#pragma unroll 1
        for (int j = 0; j < 64; ++j) {
            unsigned kk = 0u;
            const int s = 64 * j + lane;
            if (s <= t) {
                float kf[64];
                const h16x8* kp = (const h16x8*)(KI + (size_t)(b * T + s) * 64);
#pragma unroll
                for (int c = 0; c < 8; ++c) { const h16x8 kv = kp[c];
#pragma unroll
                    for (int e = 0; e < 8; ++e) kf[c * 8 + e] = (float)kv[e]; }
                float sc = 0.f;
#pragma unroll 1
                for (int h = 0; h < 16; ++h) { float d = 0.f;
#pragma unroll
                    for (int e = 0; e < 64; ++e) d = fmaf(qs[h * 64 + e], kf[e], d);
                    sc = fmaf(qs[1024 + h], fmaxf(d, 0.f), sc); }
                kk = fkey(sc);
            }
            ks[j * 64 + lane] = kk;
        }
        __builtin_amdgcn_wave_barrier(); asm volatile("s_waitcnt lgkmcnt(0)" ::: "memory");
        unsigned key[64];
#pragma unroll
        for (int j = 0; j < 64; ++j) key[j] = ks[j * 64 + lane];
        MASK[(size_t)row * 64 + lane] = topk_select(key, t + 1, lane);
        __builtin_amdgcn_wave_barrier(); asm volatile("s_waitcnt lgkmcnt(0)" ::: "memory");
    }
}


namespace idx {
typedef short s16x8 __attribute__((ext_vector_type(8)));
typedef float f32x16 __attribute__((ext_vector_type(16)));
constexpr int CHK = 128, CHB = CHK * 128;
__device__ __forceinline__ unsigned half_sum(unsigned v) {
#pragma unroll
    for (int o = 1; o < 32; o <<= 1) v += __shfl_xor(v, o);
    return v;
}
__device__ __forceinline__ void run_group(unsigned char* ws, char* lds, int b, int g) {
    int tid = threadIdx.x; asm volatile("" : "+v"(tid));
    const int wid = __builtin_amdgcn_readfirstlane(tid >> 6), lane = tid & 63, c = lane & 31, hi = lane >> 5;
    const int t0 = 16 * g + 2 * wid, t = t0 + hi, row = b * T + t, tmaxblk = 16 * g + 15, nch = (tmaxblk >> 7) + 1;
    const h16* QI = (const h16*)(ws + WS_QI); const char* KIb = (const char*)ws + WS_KI + (size_t)b * T * 128; const float* WI = (const float*)(ws + WS_WI);
    s16x8 A[4];
    { const int rho = c, qsel = (rho >> 2) & 1, head = (rho & 3) + 4 * (rho >> 3);
      const h16* qp = QI + (size_t)(b * T + t0 + qsel) * 1024 + head * 64 + 8 * hi;
#pragma unroll
      for (int ks = 0; ks < 4; ++ks) A[ks] = *reinterpret_cast<const s16x8*>(qp + 16 * ks); }
    float w[16];
    { const f32x4* wp = (const f32x4*)(WI + (size_t)row * 16);
#pragma unroll
      for (int i = 0; i < 4; ++i) { const f32x4 v = wp[i]; w[4 * i] = v[0]; w[4 * i + 1] = v[1]; w[4 * i + 2] = v[2]; w[4 * i + 3] = v[3]; } }
    const int pr0 = tid >> 3, pp = tid & 7;
    const unsigned g_off = (unsigned)(pr0 * 128 + pp * 16);
    const int l_off0 = pr0 * 128 + ((pp ^ ((pr0 >> 1) & 7)) << 4), l_off1 = l_off0 + 64 * 128;
    const int rd_base = c * 128; const int sw = (c >> 1) & 7;
    int rd_off[4];
#pragma unroll
    for (int ks = 0; ks < 4; ++ks) rd_off[ks] = rd_base + (((2 * ks + hi) ^ sw) << 4);
    unsigned kreg[128];
    s16x8 st0, st1;
    { const char* src = KIb; st0 = *reinterpret_cast<const s16x8*>(src + g_off); st1 = *reinterpret_cast<const s16x8*>(src + 64 * 128 + g_off); }
    *reinterpret_cast<s16x8*>(lds + l_off0) = st0; *reinterpret_cast<s16x8*>(lds + l_off1) = st1;
    __syncthreads();
#pragma unroll
    for (int ch = 0; ch < 32; ++ch) {
        if (ch < nch) {
            const char* buf = lds + (ch & 1) * CHB;
            if (ch + 1 < nch) { const char* src = KIb + (size_t)(ch + 1) * CHB; st0 = *reinterpret_cast<const s16x8*>(src + g_off); st1 = *reinterpret_cast<const s16x8*>(src + 64 * 128 + g_off); }
#pragma unroll
            for (int st = 0; st < 4; ++st) {
                f32x16 acc = {};
#pragma unroll
                for (int ks = 0; ks < 4; ++ks) { const s16x8 Bf = *reinterpret_cast<const s16x8*>(buf + st * 4096 + rd_off[ks]);
                    acc = __builtin_amdgcn_mfma_f32_32x32x16_f16(__builtin_bit_cast(h16x8, A[ks]), __builtin_bit_cast(h16x8, Bf), acc, 0, 0, 0); }
                float sc = 0.f;
#pragma unroll
                for (int r = 0; r < 16; ++r) sc = fmaf(w[r], fmaxf(acc[r], 0.f), sc);
                const int sidx = ch * CHK + st * 32 + c;
                { unsigned kv_ = (sidx <= t) ? fkey(sc) : 0u; asm volatile("" : "+v"(kv_)); kreg[ch * 4 + st] = kv_; }
            }
            if (ch + 1 < nch) { char* dst = lds + ((ch + 1) & 1) * CHB; *reinterpret_cast<s16x8*>(dst + l_off0) = st0; *reinterpret_cast<s16x8*>(dst + l_off1) = st1; }
            __syncthreads();
        } else {
#pragma unroll
            for (int st = 0; st < 4; ++st) kreg[ch * 4 + st] = 0u;
        }
    }
    bool done = (t < TOPK); unsigned th = done ? 1u : 0u;
    for (int bit = 31; bit >= 0; --bit) {
        if (__all(done)) break;
        const unsigned tc = th | (1u << bit);
        unsigned cnt = 0;
#pragma unroll
        for (int c8 = 0; c8 < 16; ++c8) {
            if (2 * c8 < nch) {
#pragma unroll
                for (int s_ = 8 * c8; s_ < 8 * c8 + 8; ++s_) cnt += (kreg[s_] >= tc) ? 1u : 0u;
            }
        }
        cnt = half_sum(cnt);
        if (!done) { if (cnt >= (unsigned)TOPK) th = tc; if (cnt == (unsigned)TOPK) done = true; }
    }
    int need = 0; const bool tie = !done;
    if (__any(tie)) {
        unsigned cgt = 0;
#pragma unroll
        for (int s_ = 0; s_ < 128; ++s_) cgt += (kreg[s_] > th) ? 1u : 0u;
        cgt = half_sum(cgt); need = TOPK - (int)cgt;
    }
    u64 w0 = 0, w1 = 0;
#pragma unroll
    for (int j = 0; j < 64; ++j) {
        u64 bal[2];
#pragma unroll
        for (int e = 0; e < 2; ++e) {
            const unsigned k = kreg[2 * j + e];
            bool sel = tie ? (k > th) : (k >= th);
            if (__any(tie)) {
                const u64 eqm = __ballot(tie && k == th);
                const unsigned mine = (unsigned)(eqm >> (32 * hi));
                const int pc = __builtin_popcount(mine);
                unsigned keep = mine; int kc = pc;
                while (kc > (need > 0 ? need : 0)) { keep &= ~(1u << (31 - __builtin_clz(keep))); --kc; }
                if (tie) { need -= kc; if ((keep >> c) & 1u) sel = true; }
            }
            bal[e] = __ballot(sel);
        }
        const u64 q0 = (bal[0] & 0xffffffffull) | (bal[1] << 32), q1 = (bal[0] >> 32) | (bal[1] & 0xffffffff00000000ull);
        if (lane == j) { w0 = q0; w1 = q1; }
    }
    u64* MASK = (u64*)(ws + WS_MASK);
    MASK[(size_t)(b * T + t0) * 64 + lane] = w0;
    MASK[(size_t)(b * T + t0 + 1) * 64 + lane] = w1;
}
}

namespace att {
constexpr int NW = 8, QBLK = 32, KVBLK = 64, QB = NW * QBLK, D = 128;
constexpr int SHM_V = KVBLK * D * 2, SHM_K = KVBLK * D * 2;
constexpr int LDS_NEED = 2 * SHM_V + 2 * SHM_K + NW * 64 * 4;
constexpr float THR = 8.f, SCALE = 0.08838834764831845f;
typedef short s16x8 __attribute__((ext_vector_type(8)));
typedef short s16x4 __attribute__((ext_vector_type(4)));
typedef float f32x16 __attribute__((ext_vector_type(16)));
#define KSWZ(row, colB) ((row) * 256 + ((colB) ^ (((row) & 7) << 4)))
#define SBAR() __builtin_amdgcn_sched_barrier(0)
__device__ __forceinline__ int v_st(int k, int c) { const int kk = (k & ~0xC) | ((k & 4) << 1) | ((k & 8) >> 1); return ((kk >> 3) * 4 + (c >> 5)) * 512 + ((kk & 7) * 32 + (c & 31)) * 2; }
__device__ __forceinline__ int v_rd_base(int lane) { return ((lane & 3) << 3) | (((lane >> 2) & 3) << 6) | (((lane >> 4) & 1) << 5) | (((lane >> 5) & 1) << 8); }
constexpr int v_rd_off(int d0, int ks, int half) { return d0 * 512 + ks * 4096 + half * 2048; }
__device__ __forceinline__ int crow(int r, int hi) { return (r & 3) + 8 * (r >> 2) + 4 * hi; }
__device__ __forceinline__ unsigned cvtpk(float lo, float hi) { unsigned r; asm volatile("v_cvt_pk_f16_f32 %0, %1, %2" : "=v"(r) : "v"(lo), "v"(hi)); return r; }
__device__ __forceinline__ f32x16 mfma16(s16x8 a, s16x8 b, f32x16 c) { return __builtin_amdgcn_mfma_f32_32x32x16_f16(__builtin_bit_cast(h16x8, a), __builtin_bit_cast(h16x8, b), c, 0, 0, 0); }
__device__ __forceinline__ s16x8 load8(const h16* p) { return *reinterpret_cast<const s16x8*>(p); }
__device__ __forceinline__ void mask_causal(f32x16& p0, f32x16& p1, int dq) {
    const float NEG = -__builtin_inff();
#pragma unroll
    for (int r = 0; r < 16; ++r) { const int c = (r & 3) + 8 * (r >> 2); if (dq - c < 0) p0[r] = NEG; if (dq - c - 32 < 0) p1[r] = NEG; }
}
__device__ __forceinline__ void mask_bits(f32x16& p0, f32x16& p1, u64 w, int hi) {
    const float NEG = -__builtin_inff();
    const unsigned lo = (unsigned)w >> (4 * hi), up = (unsigned)(w >> 32) >> (4 * hi);
#pragma unroll
    for (int r = 0; r < 16; ++r) { const int c = (r & 3) + 8 * (r >> 2); if (!((lo >> c) & 1u)) p0[r] = NEG; if (!((up >> c) & 1u)) p1[r] = NEG; }
}
__device__ __forceinline__ void partialSM(f32x16& p0, f32x16& p1, float& m_reg, float& mn, float& alpha) {
    float pmax = p0[0]; for (int r = 1; r < 16; ++r) pmax = fmaxf(pmax, p0[r]); for (int r = 0; r < 16; ++r) pmax = fmaxf(pmax, p1[r]);
    { auto rr = __builtin_amdgcn_permlane32_swap(__float_as_uint(pmax), __float_as_uint(pmax), false, false);
      pmax = fmaxf(__uint_as_float(rr[0]), __uint_as_float(rr[1])); }
    constexpr float C2 = 1.4426950408889634f * SCALE;
    if (__builtin_expect(__all((pmax - m_reg) * SCALE <= THR), 1)) { mn = m_reg; alpha = 1.f; }
    else { mn = fmaxf(m_reg, pmax); alpha = __builtin_amdgcn_exp2f((m_reg - mn) * C2); m_reg = mn; }
    const float mnL = -mn * C2;
    for (int r = 0; r < 16; ++r) p0[r] = fmaf(p0[r], C2, mnL); for (int r = 0; r < 16; ++r) p1[r] = fmaf(p1[r], C2, mnL);
    for (int r = 0; r < 16; ++r) p0[r] = __builtin_amdgcn_exp2f(p0[r]);
}
__device__ __forceinline__ void finishSM(f32x16& p0, f32x16& p1, float alpha, float& l_reg, s16x8& pa0, s16x8& pa1, s16x8& pa2, s16x8& pa3) {
    for (int r = 0; r < 16; ++r) p1[r] = __builtin_amdgcn_exp2f(p1[r]);
    float ps = 0; for (int r = 0; r < 16; ++r) ps += p0[r]; for (int r = 0; r < 16; ++r) ps += p1[r];
    { auto rr = __builtin_amdgcn_permlane32_swap(__float_as_uint(ps), __float_as_uint(ps), false, false);
      ps = __uint_as_float(rr[0]) + __uint_as_float(rr[1]); }
    l_reg = l_reg * alpha + ps;
#define PK4(P, B_, OUT) do { unsigned a0 = cvtpk(P[B_+0], P[B_+1]), a1 = cvtpk(P[B_+2], P[B_+3]);                          \
        unsigned b0 = cvtpk(P[B_+4], P[B_+5]), b1 = cvtpk(P[B_+6], P[B_+7]);                                             \
        auto r0 = __builtin_amdgcn_permlane32_swap(a0, b0, false, false); auto r1 = __builtin_amdgcn_permlane32_swap(a1, b1, false, false); \
        u32x4 w = {r0[0], r1[0], r0[1], r1[1]}; OUT = *reinterpret_cast<s16x8*>(&w); } while (0)
    PK4(p0, 0, pa0); PK4(p0, 8, pa1); PK4(p1, 0, pa2); PK4(p1, 8, pa3);
#undef PK4
}
template <int KB>
__device__ __forceinline__ void qkt(f32x16& p0, f32x16& p1, const char* K_lds, int r32, int hi, const s16x8* qr) {
    const char* kb[4];
#pragma unroll
    for (int dd = 0; dd < 4; ++dd) kb[dd] = K_lds + KB * SHM_K + KSWZ(r32, (dd * 16 + hi * 8) * 2);
#pragma unroll
    for (int d0 = 0; d0 < 8; ++d0) { const char* a = kb[d0 & 3] + (d0 >> 2) * 128;
        s16x8 b0 = *reinterpret_cast<const s16x8*>(a);
        s16x8 b1 = *reinterpret_cast<const s16x8*>(a + 32 * 256);
        p0 = mfma16(b0, qr[d0], p0);
        p1 = mfma16(b1, qr[d0], p1); }
}
template <int VB>
__device__ __forceinline__ void pv_tile(f32x16* o, int vb0, s16x8 pa0, s16x8 pa1, s16x8 pa2, s16x8 pa3) {
#define TRRD(dst, off) asm volatile("ds_read_b64_tr_b16 %0, %1 offset:%2" : "=&v"(dst) : "v"(vb0), "i"(off) : "memory")
#define PV_D0(d0) do { s16x4 l0, l1, l2, l3, h0, h1, h2, h3; constexpr int b_ = VB * SHM_V + v_rd_off(d0, 0, 0); \
        TRRD(l0, b_); TRRD(h0, b_ + 2048); TRRD(l1, b_ + 4096); TRRD(h1, b_ + 6144); TRRD(l2, b_ + 8192); TRRD(h2, b_ + 10240); TRRD(l3, b_ + 12288); TRRD(h3, b_ + 14336); \
        asm volatile("s_waitcnt lgkmcnt(0)" ::: "memory"); SBAR();   \
        o[d0] = mfma16(pa0, (s16x8){l0[0], l0[1], l0[2], l0[3], h0[0], h0[1], h0[2], h0[3]}, o[d0]);   \
        o[d0] = mfma16(pa1, (s16x8){l1[0], l1[1], l1[2], l1[3], h1[0], h1[1], h1[2], h1[3]}, o[d0]);   \
        o[d0] = mfma16(pa2, (s16x8){l2[0], l2[1], l2[2], l2[3], h2[0], h2[1], h2[2], h2[3]}, o[d0]);   \
        o[d0] = mfma16(pa3, (s16x8){l3[0], l3[1], l3[2], l3[3], h3[0], h3[1], h3[2], h3[3]}, o[d0]); } while (0)
    PV_D0(0); PV_D0(1); PV_D0(2); PV_D0(3);
#undef PV_D0
#undef TRRD
}
struct BlockRef { const char* Q; const char* K; const char* V; char* O; int P0; const char* NBQ; const char* MK; };
struct Seam { s16x8 qr[8]; s16x8 st_v0, st_v1, st_k0, st_k1; };
#define LD16(base, off) (*reinterpret_cast<const s16x8*>((base) + (off)))
#define VMW() asm volatile("s_waitcnt vmcnt(0)" ::: "memory")
#define VMWN(n) asm volatile("s_waitcnt vmcnt(%0)" :: "i"(n) : "memory")
#define SLOAD_H(Kp, Vp, k0) do { const char* vb_ = (Vp) + (size_t)(k0) * (D * 2); const char* kb_ = (Kp) + (size_t)(k0) * (D * 2); \
        S.st_v0 = LD16(vb_, st_off); S.st_v1 = LD16(vb_ + 32 * D * 2, st_off); S.st_k0 = LD16(kb_, st_off); S.st_k1 = LD16(kb_ + 32 * D * 2, st_off); } while (0)
#define SWRITE_HK(bf) do { *(s16x8*)(K_lds + (bf) * SHM_K + kws) = S.st_k0; *(s16x8*)(K_lds + (bf) * SHM_K + kws + 32 * 256) = S.st_k1; } while (0)
#define SWRITE_HV(bf) do { *(s16x8*)(V_lds + (bf) * SHM_V + vst0) = S.st_v0; *(s16x8*)(V_lds + (bf) * SHM_V + vst1) = S.st_v1; } while (0)
#define SWRITE_H(bf) do { SWRITE_HV(bf); SWRITE_HK(bf); } while (0)
__device__ __forceinline__ void prime(const BlockRef& cur, char* lds, Seam& S) {
    int tid = threadIdx.x; asm volatile("" : "+v"(tid));
    const int wid = __builtin_amdgcn_readfirstlane(tid >> 6), lane = tid & 63, r32 = lane & 31, hi = lane >> 5;
    const int sr = tid >> 4, sc = (tid & 15) * 8, kws = KSWZ(sr, sc * 2); char* K_lds = lds + 2 * SHM_V;
    const unsigned st_off = (unsigned)(sr * D + sc) * 2u, q_off = (unsigned)((wid * QBLK + r32) * D + hi * 8) * 2u;
#pragma unroll
    for (int d0 = 0; d0 < 8; ++d0) S.qr[d0] = LD16(cur.Q + d0 * 32, q_off);
    SLOAD_H(cur.K, cur.V, 0); VMW(); SWRITE_HK(0);
    __syncthreads();
}
template <bool MIXB>
__device__ __forceinline__ void block(const BlockRef& cur, const BlockRef& nxt, char* lds, Seam& S) {
    int tid = threadIdx.x; asm volatile("" : "+v"(tid));
    const int wid = __builtin_amdgcn_readfirstlane(tid >> 6), lane = tid & 63, r32 = lane & 31, hi = lane >> 5;
    const int NT = cur.P0 / KVBLK + 4;
    const int qlo = cur.P0 + wid * QBLK, qm = qlo + r32 - 4 * hi;
    char* V_lds = lds; char* K_lds = lds + 2 * SHM_V;
    float* wsf = (float*)(lds + 2 * SHM_V + 2 * SHM_K) + wid * 64; float* li_l = wsf, * al_l = wsf + 32;
    float m_reg = -1e30f, l_reg = 0; f32x16 o[4] = {};
    const int sr = tid >> 4, sc = (tid & 15) * 8, vst0 = v_st(sr, sc), vst1 = v_st(32 + sr, sc), kws = KSWZ(sr, sc * 2);
    const int vb0 = (int)(uintptr_t)V_lds + v_rd_base(lane);
    const unsigned st_off = (unsigned)(sr * D + sc) * 2u, q_off = (unsigned)((wid * QBLK + r32) * D + hi * 8) * 2u;
    const unsigned nb_off = (unsigned)hi * 16u, mk_off = (unsigned)(wid * QBLK + r32) * 512u;
    const char* Kh = cur.K; const char* Vh = cur.V;
#define RESC(a) do { if (__any((a) < 1.f)) { if (hi == 0) al_l[r32] = (a); asm volatile("s_waitcnt lgkmcnt(0)" ::: "memory");              \
                     for (int d_ = 0; d_ < 4; ++d_) for (int r = 0; r < 16; ++r) o[d_][r] *= al_l[crow(r, hi)]; } } while (0)
#define KBASE(t) ((t) * KVBLK)
#define PINIT(P0_, P1_, t) do { if (MIXB) { const char* nb_ = cur.NBQ + (size_t)KBASE(t) * 4; _Pragma("unroll") for (int g_ = 0; g_ < 4; ++g_) { \
            const f32x4 b0_ = *(const f32x4*)(nb_ + 32 * g_ + nb_off), b1_ = *(const f32x4*)(nb_ + 128 + 32 * g_ + nb_off); \
            _Pragma("unroll") for (int j_ = 0; j_ < 4; ++j_) { P0_[4 * g_ + j_] = b0_[j_]; P1_[4 * g_ + j_] = b1_[j_]; } } } else { P0_ = f32x16{}; P1_ = f32x16{}; } } while (0)
#define MKW(t) (*(const u64*)(cur.MK + (size_t)(t) * 8 + mk_off))
#define MASKT(P0_, P1_, t, MW_) do { if (MIXB) { const int kb_ = KBASE(t); if (kb_ + KVBLK - 1 > qlo) mask_causal(P0_, P1_, qm - kb_); } else mask_bits(P0_, P1_, MW_, hi); } while (0)
    f32x16 pA0, pA1, pB0, pB1; float mnA, mnB, alA, alB; s16x8 pa0, pa1, pa2, pa3;
    u64 mwA = 0, mwB = 0;
    if (!MIXB) { mwA = MKW(0); if (NT > 1) mwB = MKW(1); }
    PINIT(pA0, pA1, 0);
    if (NT > 1) PINIT(pB0, pB1, 1);
    SWRITE_HV(0); SBAR();
    if (NT > 1) SLOAD_H(Kh, Vh, KBASE(1));
    SBAR(); qkt<0>(pA0, pA1, K_lds, r32, hi, S.qr);
    MASKT(pA0, pA1, 0, mwA); if (!MIXB) { if (NT > 2) mwA = MKW(2); }
    partialSM(pA0, pA1, m_reg, mnA, alA);
    if (NT > 1) { VMW(); SWRITE_H(1); }
    __syncthreads();
#define HALF_STEP(PX0, PX1, mnX, alX, MWX, PY0, PY1, alY, t, KB, VB, SB) do {                                               \
        SBAR(); qkt<KB>(PX0, PX1, K_lds, r32, hi, S.qr);                                                                      \
        finishSM(PY0, PY1, alY, l_reg, pa0, pa1, pa2, pa3); SBAR();                                                           \
        if ((t) + 1 < NT) { PINIT(PY0, PY1, (t) + 1); SLOAD_H(Kh, Vh, KBASE((t) + 1)); SBAR(); }                             \
        pv_tile<VB>(o, vb0, pa0, pa1, pa2, pa3); MASKT(PX0, PX1, (t), MWX); if (!MIXB) { if ((t) + 2 < NT) MWX = MKW((t) + 2); } \
        partialSM(PX0, PX1, m_reg, mnX, alX);                                                                                 \
        __syncthreads();                                                                                                      \
        if ((t) + 1 < NT) { VMW(); SWRITE_H(SB); }                                                                            \
        RESC(alX); __syncthreads(); } while (0)
    for (int t = 1; t + 1 < NT; t += 2) {
        HALF_STEP(pB0, pB1, mnB, alB, mwB, pA0, pA1, alA, t, 1, 0, 0);
        HALF_STEP(pA0, pA1, mnA, alA, mwA, pB0, pB1, alB, t + 1, 0, 1, 1);
    }
    const bool even = (NT & 1) == 0;
    if (even) { SBAR(); qkt<1>(pB0, pB1, K_lds, r32, hi, S.qr); SBAR(); }
    SLOAD_H(nxt.K, nxt.V, 0); SBAR();
#pragma unroll
    for (int d0 = 0; d0 < 8; ++d0) S.qr[d0] = LD16(nxt.Q + d0 * 32, q_off);
    SBAR();
    finishSM(pA0, pA1, alA, l_reg, pa0, pa1, pa2, pa3); SBAR();
    pv_tile<0>(o, vb0, pa0, pa1, pa2, pa3);
    if (even) { MASKT(pB0, pB1, NT - 1, mwB); partialSM(pB0, pB1, m_reg, mnB, alB); __syncthreads(); RESC(alB);
        finishSM(pB0, pB1, alB, l_reg, pa0, pa1, pa2, pa3); SBAR(); pv_tile<1>(o, vb0, pa0, pa1, pa2, pa3); }
    SBAR(); VMWN(8); SWRITE_HK(0); SBAR();
    if (hi == 0) li_l[r32] = l_reg; asm volatile("s_waitcnt lgkmcnt(0)" ::: "memory");
    float rli[16];
#pragma unroll
    for (int r = 0; r < 16; ++r) rli[r] = __builtin_amdgcn_rcpf(li_l[crow(r, hi)]);
    const unsigned o_off = (unsigned)((wid * QBLK + 4 * hi) * 1024 + r32) * 2u;
#pragma unroll
    for (int r = 0; r < 16; ++r) {
#pragma unroll
        for (int d0 = 0; d0 < 4; ++d0) { const float v = o[d0][r] * rli[r];
            const float vn = __shfl_xor(v, 1);
            if ((r32 & 1) == 0) *(unsigned*)(cur.O + (size_t)(((r & 3) + 8 * (r >> 2)) * 2048 + d0 * 64) + o_off) = cvtpk(v, vn); } }
    __syncthreads();
#undef RESC
#undef KBASE
#undef PINIT
#undef MKW
#undef MASKT
#undef HALF_STEP
}
#undef LD16
#undef VMW
#undef VMWN
#undef SLOAD_H
#undef SWRITE_HK
#undef SWRITE_HV
#undef SWRITE_H
__device__ __forceinline__ BlockRef make_ref(bool mixb, unsigned char* ws, int bh, int qb) {
    const int b = bh >> 3, h = bh & 7, kvh = mixb ? bh : (b * HAKV + (h >> 2));
    BlockRef r;
    r.Q = (const char*)ws + (mixb ? WS_QB : WS_QA) + ((size_t)bh * T + (size_t)qb * QB) * D * 2;
    r.K = (const char*)ws + (mixb ? WS_KB : WS_KA) + (size_t)kvh * T * D * 2;
    r.V = (const char*)ws + (mixb ? WS_VB : WS_VA) + (size_t)kvh * T * D * 2;
    r.O = (char*)ws + (mixb ? WS_OUTB : WS_OUTA) + ((size_t)(b * T + qb * QB) * 1024 + h * D) * 2;
    r.P0 = qb * QB;
    r.NBQ = (const char*)ws + WS_NBQ + ((size_t)bh * 16 + qb) * T * 4;
    r.MK = (const char*)ws + WS_MASK + (size_t)(b * T + qb * QB) * 64 * 8;
    return r;
}
template <bool MIXB>
__device__ __forceinline__ void run_item(int item, unsigned char* ws, char* lds) {
    const int bh = (item >> 3) & 15, x = item & 7;
    Seam S;
    BlockRef cur = make_ref(MIXB, ws, bh, x);
    prime(cur, lds, S);
#pragma unroll 1
    for (int pass = 0; pass < 2; ++pass) {
        const BlockRef nxt = make_ref(MIXB, ws, bh, 15 - x);
        block<MIXB>(cur, nxt, lds, S);
        cur = nxt;
    }
}
}


#define XB_TMO      128
#define XB_XCNT(j)  (256  + 64 * (j))
#define XB_XSUB(j)  (1280 + 64 * (j))
#define XB_XGEN(j)  (2304 + 64 * (j))
#define XB_TOP      3328
#define XB_TOPGEN   3392
#define XCD_BAR_WORDS 3456
#define XB_SPIN_CAP (1u << 24)
__device__ __forceinline__ unsigned xb_ld(unsigned* p)              { return __hip_atomic_load(p, __ATOMIC_RELAXED, __HIP_MEMORY_SCOPE_AGENT); }
__device__ __forceinline__ unsigned xb_add(unsigned* p, unsigned v) { return __hip_atomic_fetch_add(p, v, __ATOMIC_RELAXED, __HIP_MEMORY_SCOPE_AGENT); }
__device__ __forceinline__ unsigned xb_xcc_id() { return (unsigned)__builtin_amdgcn_s_getreg((3 << 11) | 20) & 0xFu; }
#define XB_SPIN(cond, bar) do { unsigned _sp = 0; while (cond) { __builtin_amdgcn_s_sleep(1); \
    if ((++_sp & 255u) == 0u) { if (xb_ld(&(bar)[XB_TMO])) break; if (_sp > XB_SPIN_CAP) { atomicAdd(&(bar)[XB_TMO], 1u); break; } } } } while (0)
struct XcdBarrier { unsigned* bar; unsigned x; volatile LAS unsigned* st; };
__device__ __forceinline__ XcdBarrier xcd_barrier_post(unsigned* bar, volatile LAS unsigned* st) {
    XcdBarrier b; b.bar = bar; b.x = xb_xcc_id(); b.st = st;
    if (threadIdx.x == 0) (void)xb_add(&bar[XB_XCNT(b.x)], 1u);
    return b;
}
__device__ __forceinline__ void xcd_barrier_complete(unsigned* bar, unsigned x, unsigned& nloc, unsigned& nx) {
    const unsigned G = gridDim.x * gridDim.y * gridDim.z;
    unsigned sum, cnt, mine, sp = 0u;
    for (;;) {
        sum = 0u; cnt = 0u; mine = 0u;
#pragma unroll
        for (unsigned j = 0; j < 16; ++j) { const unsigned c = xb_ld(&bar[XB_XCNT(j)]); sum += c; cnt += (c > 0u) ? 1u : 0u; mine = (j == x) ? c : mine; }
        if (sum == G) break;
        __builtin_amdgcn_s_sleep(1);
        if ((++sp & 255u) == 0u) { if (xb_ld(&bar[XB_TMO])) break; if (sp > XB_SPIN_CAP) { atomicAdd(&bar[XB_TMO], 1u); break; } }
    }
    nloc = mine > 0u ? mine : 1u; nx = cnt > 0u ? cnt : 1u;
}
__device__ __forceinline__ void xcd_barrier(const XcdBarrier& b) {
    asm volatile("s_waitcnt vmcnt(0)" ::: "memory");
    __syncthreads();
    if (threadIdx.x == 0) {
        unsigned* bar = b.bar;
        __builtin_amdgcn_s_waitcnt(0);
        unsigned nloc = b.st[0], nx = b.st[1];
        if (nloc == 0u) { xcd_barrier_complete(bar, b.x, nloc, nx); b.st[0] = nloc; b.st[1] = nx; }
        const unsigned old = xb_add(&bar[XB_XSUB(b.x)], 1u);
        const unsigned gen = old / nloc;
        if (old + 1u == (gen + 1u) * nloc) {
            __builtin_amdgcn_fence(__ATOMIC_RELEASE, "agent");
            asm volatile("s_waitcnt vmcnt(0)" ::: "memory");
            const unsigned og = xb_add(&bar[XB_TOP], 1u);
            const unsigned tg = og / nx;
            if (og + 1u == (tg + 1u) * nx) xb_add(&bar[XB_TOPGEN], 1u);
            else XB_SPIN(xb_ld(&bar[XB_TOPGEN]) == tg, bar);
            __builtin_amdgcn_fence(__ATOMIC_ACQUIRE, "agent");
            xb_add(&bar[XB_XGEN(b.x)], 1u);
            asm volatile("s_waitcnt vmcnt(0)" ::: "memory");
        } else {
            XB_SPIN(xb_ld(&bar[XB_XGEN(b.x)]) == gen, bar);
            __builtin_amdgcn_fence(__ATOMIC_ACQUIRE, "agent");
            asm volatile("s_waitcnt vmcnt(0)" ::: "memory");
        }
    }
    __syncthreads();
}

namespace cg = cooperative_groups;
#ifndef PROBE_DUP
#define PROBE_DUP 0
#endif
#define REP(k) for (int rep_ = 0; rep_ < (((PROBE_DUP) >> (k)) & 1) + 1; ++rep_)
constexpr int LDS_BYTES = pg8::STAGE_BYTES + 256;
constexpr int CW_BAR = 4096;
struct Params { const float* in[17]; float* out; unsigned char* ws; };
template <class Epi>
__device__ __forceinline__ void run_gemm(LAS unsigned char* lds, const h16* A, const h16* Bt, int M, int N, int K, const Epi& e) {
    pg8::Gemm g{A, Bt, M, N, K}; pg8::StaticOrder S; S.init(M, N, (int)gridDim.x, (int)blockIdx.x);
    pg8::gemm_phase<Epi>(lds, g, S, e);
}
__global__ void __launch_bounds__(512, 2) mega_fwd(Params P) {
    extern __shared__ __attribute__((aligned(16))) unsigned char lds_raw[];
    LAS unsigned char* lds = (LAS unsigned char*)lds_raw;
    cg::grid_group grid = cg::this_grid();
    volatile LAS unsigned* bst = (volatile LAS unsigned*)(lds + pg8::STAGE_BYTES);
    if (threadIdx.x < 2) bst[threadIdx.x] = 0u;
    __syncthreads();
    const XcdBarrier xbar = xcd_barrier_post((unsigned*)(P.ws + WS_CTL) + CW_BAR, bst);
#define GRID_BAR() xcd_barrier(xbar)
#define IDS() int tid = threadIdx.x; asm volatile("" : "+v"(tid)); const int lane = tid & 63, wave = __builtin_amdgcn_readfirstlane(tid >> 6), gw = blockIdx.x * 8 + wave, NGW = gridDim.x * 8; (void)lane; (void)gw; (void)NGW
    const float* x = P.in[0]; const float* p = P.in[1]; const int* pos = (const int*)P.in[2];
    const float* g_mix = P.in[3]; const float* w_in = P.in[4]; const float* b_f = P.in[5];
    const float* w_o_a = P.in[6]; const float* w_o_b = P.in[7]; const float* w_out = P.in[8];
    const float* g_ffn = P.in[9]; const float* w_g = P.in[10]; const float* w_u = P.in[11]; const float* w_d = P.in[12];
    const float* g_ple = P.in[13]; const float* w_pg = P.in[14]; const float* w_pp = P.in[15]; const float* g_final = P.in[16];
    unsigned char* ws = P.ws; float* out = P.out;
    float* ROPE = (float*)(ws + WS_ROPE); float* CB = (float*)(ws + WS_CB); float* LOGF = (float*)(ws + WS_LOGF); u64* MASK = (u64*)(ws + WS_MASK);
    h16* WIN = (h16*)(ws + WS_WIN); h16* WOA = (h16*)(ws + WS_WOA); h16* WOB = (h16*)(ws + WS_WOB); h16* WOUT = (h16*)(ws + WS_WOUT);
    h16* WGU = (h16*)(ws + WS_WGU); h16* WDN = (h16*)(ws + WS_WDN); h16* WPG = (h16*)(ws + WS_WPG); h16* WPP = (h16*)(ws + WS_WPP);
    h16* QI = (h16*)(ws + WS_QI); h16* KI = (h16*)(ws + WS_KI); float* WI = (float*)(ws + WS_WI);
    h16* SIGA = (h16*)(ws + WS_SIGA); h16* SIGB = (h16*)(ws + WS_SIGB);
    h16* OUTA = (h16*)(ws + WS_OUTA); h16* OUTB = (h16*)(ws + WS_OUTB); h16* P16 = (h16*)(ws + WS_P16);
    h16* MIXED = (h16*)(ws + WS_MIXED); h16* H2 = (h16*)(ws + WS_H2); h16* ACT = (h16*)(ws + WS_ACT); h16* PP = (h16*)(ws + WS_PP);
    h16* H1 = (h16*)P.out;

    REP(0) { IDS(); LAS float* scr = (LAS float*)(lds + wave * 8448);
      ph_transpose<1>(w_in, nullptr, DM, N_IN, WIN, N_INP, scr, gw, NGW, lane);
      ph_transpose<0>(w_o_a, nullptr, 1024, DM, WOA, DM, scr, gw, NGW, lane);
      ph_transpose<0>(w_o_b, nullptr, 1024, DM, WOB, DM, scr, gw, NGW, lane);
      ph_transpose<0>(w_out, nullptr, DM, DM, WOUT, DM, scr, gw, NGW, lane);
      ph_transpose<2>(w_g, w_u, DM, DFF, WGU, 2 * DFF, scr, gw, NGW, lane);
      ph_transpose<0>(w_d, nullptr, DFF, DM, WDN, DM, scr, gw, NGW, lane);
      ph_transpose<0>(w_pg, nullptr, DM, DM, WPG, DM, scr, gw, NGW, lane);
      ph_transpose<0>(w_pp, nullptr, DPLE, DM, WPP, DM, scr, gw, NGW, lane);
      ph_rope(pos, ROPE, blockIdx.x * 512 + tid, gridDim.x * 512);
      ph_rmsnorm<false>(x, g_mix, H1, nullptr, gw, NGW, lane);
    }
    grid.sync();
    REP(1) { EpiInProj e{ws, b_f}; run_gemm(lds, H1, WIN, MTOK, N_INP, DM, e); }
    GRID_BAR();
    REP(2) { IDS();
      if (gw >= NGW - 16) ph_cumsum(LOGF, CB, (float*)(ws + WS_NBQ), NGW - 1 - gw, lane);
      for (int it = blockIdx.x; it < 256; it += gridDim.x) { const int bb = it & 1, gi = it >> 1; idx::run_group(ws, (char*)lds_raw, bb, gi); idx::run_group(ws, (char*)lds_raw, bb, 255 - gi); }
      for (int i = blockIdx.x * 512 + tid; i < MTOK * DPLE / 4; i += gridDim.x * 512) st4h(P16 + 4 * (size_t)i, *((const f32x4*)p + i));
    }
    GRID_BAR();
    REP(3) for (int it = blockIdx.x; it < 256; it += gridDim.x) {
        const int item = (it & 7) * 32 + (it >> 3);
        if (item < 128) att::run_item<false>(item, ws, (char*)lds_raw); else att::run_item<true>(item, ws, (char*)lds_raw);
    }
    GRID_BAR();
    REP(4) { { EpiGate<true> e{SIGA, MIXED}; run_gemm(lds, OUTA, WOA, MTOK, DM, 1024, e); }
    { EpiGate<false> e{SIGB, MIXED}; run_gemm(lds, OUTB, WOB, MTOK, DM, 1024, e); } }
    GRID_BAR();
    REP(5) { EpiResid e{x, out}; run_gemm(lds, MIXED, WOUT, MTOK, DM, DM, e); }
    GRID_BAR();
    REP(7) { IDS(); ph_rmsnorm<false>(out, g_ffn, H2, nullptr, gw, NGW, lane); }
    GRID_BAR();
    REP(6) { EpiSwiGLU e{ACT}; run_gemm(lds, H2, WGU, MTOK, 2 * DFF, DM, e); }
    GRID_BAR();
    { EpiResid e{out, out}; run_gemm(lds, ACT, WDN, MTOK, DM, DFF, e); }
    GRID_BAR();
    { IDS(); ph_rmsnorm<false>(out, g_ple, H2, nullptr, gw, NGW, lane); }
    GRID_BAR();
    { EpiStoreH e{PP, DM}; run_gemm(lds, P16, WPP, MTOK, DM, DPLE, e); }
    { EpiPLE e{PP, out}; run_gemm(lds, H2, WPG, MTOK, DM, DM, e); }
    GRID_BAR();
    { IDS(); ph_rmsnorm<true>(out, g_final, nullptr, out, gw, NGW, lane); }
#undef IDS
#undef GRID_BAR
}

extern "C" void kernel_launch(void* const* d_in, const int* in_sizes, int n_in, void* d_out, int out_size, void* d_ws, size_t ws_size, hipStream_t stream) {
    if (n_in != 17 || out_size != MTOK * DM || ws_size < WS_END) { fprintf(stderr, "kernel_launch: unexpected shapes / workspace (%d inputs, out %d, ws %zu)\n", n_in, out_size, ws_size); return; }
    static int grid_blocks = 0;
    if (!grid_blocks) {
        int dev = 0, cus = 0, per_cu = 0;
        (void)hipGetDevice(&dev);
        (void)hipDeviceGetAttribute(&cus, hipDeviceAttributeMultiprocessorCount, dev);
        (void)hipFuncSetAttribute((const void*)mega_fwd, hipFuncAttributeMaxDynamicSharedMemorySize, LDS_BYTES);
        (void)hipOccupancyMaxActiveBlocksPerMultiprocessor(&per_cu, (const void*)mega_fwd, 512, LDS_BYTES);
        if (per_cu < 1) { fprintf(stderr, "kernel_launch: occupancy query says %d blocks per CU\n", per_cu); per_cu = 1; }
        if (per_cu > 1) per_cu = 1;
        grid_blocks = cus * per_cu;
    }
    (void)hipMemsetAsync((char*)d_ws + WS_CTL, 0, 64 * 1024, stream);
    Params prm{};
    for (int i = 0; i < 17; ++i) prm.in[i] = (const float*)d_in[i];
    prm.out = (float*)d_out; prm.ws = (unsigned char*)d_ws;
    void* args[] = {&prm};
    hipError_t e = hipLaunchCooperativeKernel((const void*)mega_fwd, dim3(grid_blocks), dim3(512), args, LDS_BYTES, stream);
    if (e != hipSuccess) fprintf(stderr, "cooperative launch failed: %s (grid %d)\n", hipGetErrorString(e), grid_blocks);
}
```

```cpp
#include <hip/hip_runtime.h>
#include <hip/hip_cooperative_groups.h>
#include <stdint.h>
#include <cstdio>

#define LAS __attribute__((address_space(3)))
typedef _Float16 h16;
typedef _Float16 h16x8 __attribute__((ext_vector_type(8)));
typedef _Float16 h16x4 __attribute__((ext_vector_type(4)));
typedef _Float16 h16x2 __attribute__((ext_vector_type(2)));
typedef float f32x4 __attribute__((ext_vector_type(4)));
typedef float f32x2 __attribute__((ext_vector_type(2)));
typedef unsigned u32x4 __attribute__((ext_vector_type(4)));
typedef unsigned u32x2 __attribute__((ext_vector_type(2)));
typedef unsigned long long u64;
__device__ __forceinline__ int lane_id() { int r; asm volatile("v_mbcnt_lo_u32_b32 %0, -1, 0\n\tv_mbcnt_hi_u32_b32 %0, -1, %0" : "=v"(r)); return r; }

constexpr int NBATCH = 2, T = 4096, MTOK = NBATCH * T, DM = 2048;
constexpr int HA = 8, HAKV = 2, HIDX = 16, DIDX = 64, HB = 8, HD = 128;
constexpr int N_IN = 9816, N_INP = 9984, DFF = 5632, DPLE = 256, TOPK = 256;
constexpr float EPS = 1e-6f;
constexpr float ATT_SCALE = 0.08838834764831845f;

constexpr size_t MiB = 1u << 20;
constexpr size_t WS_CTL = 0;
constexpr size_t WS_RS = 512 * 1024;
constexpr size_t WS_ROPE = 1 * MiB;
constexpr size_t WS_CB = 3 * MiB;
constexpr size_t WS_LOGF = 3 * MiB + 512 * 1024;
constexpr size_t WS_MASK = 4 * MiB;
constexpr size_t WS_WIN = 8 * MiB;
constexpr size_t WS_OUTA = 8 * MiB, WS_OUTB = 24 * MiB, WS_P16 = 40 * MiB;
constexpr size_t WS_WOA = 47 * MiB, WS_WOB = 51 * MiB, WS_WOUT = 55 * MiB, WS_WGU = 63 * MiB, WS_WDN = 107 * MiB, WS_WPG = 129 * MiB, WS_WPP = 137 * MiB;
constexpr size_t WS_QA = 138 * MiB, WS_KA = 154 * MiB, WS_VA = 158 * MiB, WS_QI = 162 * MiB, WS_KI = 178 * MiB, WS_WI = 179 * MiB;
constexpr size_t WS_QB = 180 * MiB, WS_KB = 196 * MiB, WS_VB = 212 * MiB, WS_SIGA = 228 * MiB, WS_SIGB = 260 * MiB, WS_NBQ = 292 * MiB, WS_END = 296 * MiB;
constexpr size_t WS_MIXED = WS_QB;
constexpr size_t WS_H2 = WS_QA;
constexpr size_t WS_ACT = WS_QB;
constexpr size_t WS_PP = WS_QB;

namespace pg8 {
constexpr int BM = 256, BK = 64, HALF = 128, HTB = HALF * BK * 2, STAGE_BYTES = 8 * HTB, NXCD = 8, WGM = 8;
__host__ __device__ __forceinline__ int lds_byte(int r, int c) { const int st = (r >> 4) * 2 + (c >> 5), rr = r & 15, cc = c & 31, ob = rr * 64 + cc * 2; return st * 1024 + (ob ^ (((ob >> 9) & 1) << 5)); }
__host__ __device__ __forceinline__ void stage_rc(int b, int& R, int& C) { const int st = b / 1024, sb = b % 1024, swz = sb ^ (((sb >> 9) & 1) << 5); R = (st >> 1) * 16 + swz / 64; C = (st & 1) * 32 + (swz % 64) / 2; }
struct Unit { int pm, pn; };
struct Gemm { const h16* A; const h16* Bt; int M, N, K; };
struct StaticOrder {
    int nM, nN, nwg, G, c;
    __host__ __device__ void init(int M, int N, int G_, int c_) { nM = M / BM; nN = N / BM; nwg = nM * nN; G = G_; c = c_; }
    __host__ __device__ bool next(int i, Unit& u) const {
        const long L = (long)i * G + c; if (L >= nwg) return false;
        int wgid = (int)L; { const int q = nwg / NXCD, r = nwg % NXCD, xcd = wgid % NXCD, off = wgid / NXCD; wgid = (xcd < r ? xcd * (q + 1) : r * (q + 1) + (xcd - r) * q) + off; }
        const int nig = WGM * nN, gid = wgid / nig, fm = gid * WGM, gsz = (nM - fm) < WGM ? (nM - fm) : WGM;
        u.pm = fm + ((wgid % nig) % gsz); u.pn = (wgid % nig) / gsz; return true;
    }
};
template <class Epi>
__device__ __forceinline__ void gemm_phase(LAS unsigned char* lds, const Gemm g, const StaticOrder& S, const Epi& E, int wv) {
    int tid = wv * 64 + lane_id(); asm volatile("" : "+v"(tid));
    const int wid = __builtin_amdgcn_readfirstlane(tid >> 6), lane = tid & 63, wr = wid >> 2, wc = wid & 3, fr = lane & 15, fq = lane >> 4;
    const int K = g.K, nt = K / BK;
    unsigned voffA[2];
#pragma unroll
    for (int i = 0; i < 2; ++i) { int R, C; stage_rc(tid * 16 + i * 8192, R, C); voffA[i] = (unsigned)(R * K + C) * 2u; }
    const size_t kstep = (size_t)(BK * 2);
    const size_t hstep = (size_t)HALF * K * 2;
    const size_t tstep = 2 * hstep;
    const unsigned ldsw = (unsigned)wid * 1024u;
    const int aoff = lds_byte(wr * 64 + fr, fq * 8), boff = lds_byte(wc * 32 + fr, fq * 8);
#define PG8_SA(b, h) (((b) * 2 + (h)) * HTB)
#define PG8_SB(b, h) ((4 + (b) * 2 + (h)) * HTB)
#define PG8_STAGE(bufoff, gbase) do { _Pragma("unroll") for (int _i = 0; _i < 2; ++_i) \
        __builtin_amdgcn_global_load_lds((const unsigned*)((const char*)(gbase) + voffA[_i]), (LAS unsigned*)(lds + (bufoff) + ldsw + _i * 8192), 16, 0, 0); } while (0)
#define PG8_LDA(dst, b, h) do { _Pragma("unroll") for (int m = 0; m < 4; ++m) _Pragma("unroll") for (int k = 0; k < 2; ++k) dst[m][k] = *(const LAS h16x8*)(lds + PG8_SA(b, h) + aoff + m * 2048 + k * 1024); } while (0)
#define PG8_LDB(dst, b, h) do { _Pragma("unroll") for (int n = 0; n < 2; ++n) _Pragma("unroll") for (int k = 0; k < 2; ++k) dst[n][k] = *(const LAS h16x8*)(lds + PG8_SB(b, h) + boff + n * 2048 + k * 1024); } while (0)
#define PG8_MMA(ai, bj, At, Bt) do { __builtin_amdgcn_s_setprio(1); _Pragma("unroll") for (int m = 0; m < 4; ++m) _Pragma("unroll") for (int n = 0; n < 2; ++n) _Pragma("unroll") for (int k = 0; k < 2; ++k) \
        acc[ai][bj][m][n] = __builtin_amdgcn_mfma_f32_16x16x32_f16(Bt[n][k], At[m][k], acc[ai][bj][m][n], 0, 0, 0); __builtin_amdgcn_s_setprio(0); } while (0)
#define PG8_WAIT_V(n) asm volatile("s_waitcnt vmcnt(" #n ")" ::: "memory")
#define PG8_WAIT_L(n) asm volatile("s_waitcnt lgkmcnt(" #n ")" ::: "memory")
#define PG8_BAR __builtin_amdgcn_s_barrier()
#define PG8_SCHED __builtin_amdgcn_sched_barrier(0)
    Unit cur, nxt; int ui = 0;
    if (!S.next(0, cur)) return;
    f32x4 acc[2][2][4][2];
#pragma unroll
    for (int a = 0; a < 2; ++a)
#pragma unroll
        for (int b = 0; b < 2; ++b)
#pragma unroll
            for (int m = 0; m < 4; ++m)
#pragma unroll
                for (int n = 0; n < 2; ++n) acc[a][b][m][n] = (f32x4){0.f, 0.f, 0.f, 0.f};
    h16x8 At[4][2], B0[2][2], B1[2][2];
    const char* cA = (const char*)g.A + (size_t)cur.pm * tstep; const char* cB = (const char*)g.Bt + (size_t)cur.pn * tstep;
    PG8_STAGE(PG8_SB(0, 0), cB); PG8_STAGE(PG8_SA(0, 0), cA); PG8_STAGE(PG8_SB(0, 1), cB + hstep); PG8_STAGE(PG8_SA(0, 1), cA + hstep);
    if (wr == 1) PG8_BAR;
    PG8_WAIT_V(4); PG8_BAR;
    PG8_STAGE(PG8_SB(1, 0), cB + kstep); PG8_STAGE(PG8_SA(1, 0), cA + kstep); PG8_STAGE(PG8_SB(1, 1), cB + hstep + kstep);
    PG8_WAIT_V(6); PG8_BAR;
    for (;;) {
        const bool has_next = S.next(ui + 1, nxt);
        const char* nA = has_next ? (const char*)g.A + (size_t)nxt.pm * tstep : cA; const char* nB = has_next ? (const char*)g.Bt + (size_t)nxt.pn * tstep : cB;
        for (int t = 0; t < nt; t += 2) {
            const bool last = (t == nt - 2);
            const char* a1 = cA + (size_t)(t + 1) * kstep;
            const char* a2 = last ? nA : cA + (size_t)(t + 2) * kstep; const char* b2 = last ? nB : cB + (size_t)(t + 2) * kstep;
            const char* a3 = a2 + kstep; const char* b3 = b2 + kstep;
            PG8_LDB(B0, 0, 0); PG8_SCHED; PG8_LDA(At, 0, 0); PG8_STAGE(PG8_SA(1, 1), a1 + hstep);
            PG8_WAIT_L(8); PG8_BAR; PG8_WAIT_L(0); PG8_MMA(0, 0, At, B0); PG8_BAR; PG8_SCHED;
            PG8_LDB(B1, 0, 1); PG8_STAGE(PG8_SB(0, 0), b2);
            PG8_BAR; PG8_WAIT_L(0); PG8_MMA(0, 1, At, B1); PG8_BAR;
            PG8_LDA(At, 0, 1); PG8_STAGE(PG8_SA(0, 0), a2);
            PG8_BAR; PG8_WAIT_L(0); PG8_MMA(1, 0, At, B0); PG8_BAR; PG8_SCHED;
            PG8_STAGE(PG8_SB(0, 1), b2 + hstep);
            PG8_WAIT_V(6); PG8_BAR; PG8_MMA(1, 1, At, B1); PG8_BAR;
            PG8_LDB(B0, 1, 0); PG8_SCHED; PG8_LDA(At, 1, 0); PG8_STAGE(PG8_SA(0, 1), a2 + hstep);
            PG8_WAIT_L(8); PG8_BAR; PG8_WAIT_L(0); PG8_MMA(0, 0, At, B0); PG8_BAR; PG8_SCHED;
            PG8_LDB(B1, 1, 1); PG8_STAGE(PG8_SB(1, 0), b3);
            PG8_BAR; PG8_WAIT_L(0); PG8_MMA(0, 1, At, B1); PG8_BAR;
            PG8_LDA(At, 1, 1); PG8_STAGE(PG8_SA(1, 0), a3);
            PG8_BAR; PG8_WAIT_L(0); PG8_MMA(1, 0, At, B0); PG8_BAR; PG8_SCHED;
            PG8_STAGE(PG8_SB(1, 1), b3 + hstep);
            PG8_WAIT_V(6); PG8_BAR; PG8_MMA(1, 1, At, B1); PG8_BAR;
        }
        E(acc, cur, wr, wc, fr, fq);
        if (!has_next) break;
#pragma unroll
        for (int a = 0; a < 2; ++a)
#pragma unroll
            for (int b = 0; b < 2; ++b)
#pragma unroll
                for (int m = 0; m < 4; ++m)
#pragma unroll
                    for (int n = 0; n < 2; ++n) acc[a][b][m][n] = (f32x4){0.f, 0.f, 0.f, 0.f};
        cur = nxt; cA = nA; cB = nB; ++ui;
    }
    PG8_WAIT_V(0);
    if (wr == 0) PG8_BAR;
    PG8_BAR;
#undef PG8_SA
#undef PG8_SB
#undef PG8_STAGE
#undef PG8_LDA
#undef PG8_LDB
#undef PG8_MMA
#undef PG8_WAIT_V
#undef PG8_WAIT_L
#undef PG8_BAR
#undef PG8_SCHED
}
}
using pg8::Unit;
typedef f32x4 Acc[2][2][4][2];

__device__ __forceinline__ void st4h(h16* p, f32x4 v) { h16x4 o; o[0] = (h16)v[0]; o[1] = (h16)v[1]; o[2] = (h16)v[2]; o[3] = (h16)v[3]; *(h16x4*)p = o; }
__device__ __forceinline__ f32x4 ld4h(const h16* p) { const h16x4 o = *(const h16x4*)p; return (f32x4){(float)o[0], (float)o[1], (float)o[2], (float)o[3]}; }
__device__ __forceinline__ float sigmoidf_(float x) { return __builtin_amdgcn_rcpf(1.0f + __expf(-x)); }
__device__ __forceinline__ float logsigmoidf_(float z) { return fminf(z, 0.f) - __logf(1.0f + __expf(-fabsf(z))); }
__device__ __forceinline__ float wave_sum(float v) {
#pragma unroll
    for (int o = 1; o < 64; o <<= 1) v += __shfl_xor(v, o);
    return v;
}

struct EpiInProj {
    unsigned char* ws; const float* b_f;
    __device__ __forceinline__ void operator()(const Acc& acc, const Unit& u, int wr, int wc, int fr, int fq) const {
        const int pn = u.pn, row0 = u.pm * 256 + wr * 64 + fr;
        const float* ROPE = (const float*)(ws + WS_ROPE);
#pragma unroll
        for (int ai = 0; ai < 2; ++ai)
#pragma unroll
            for (int m = 0; m < 4; ++m) {
                const int row = row0 + ai * 128 + m * 16, b = row >> 12, t = row & 4095;
                const float* rp = ROPE + (size_t)row * 48;
#pragma unroll
                for (int bj = 0; bj < 2; ++bj) {
                    f32x4 v0 = acc[ai][bj][m][0], v1 = acc[ai][bj][m][1];
                    const int d0 = 32 * wc + 4 * fq;
                    if (pn < 6) {
                        size_t off;
                        if (pn < 4) off = WS_QA + (((size_t)(b * HA + pn * 2 + bj) * T + t) * HD) * 2;
                        else off = (pn == 4 ? WS_KA : WS_VA) + (((size_t)(b * HAKV + bj) * T + t) * HD) * 2;
                        h16* dst = (h16*)(ws + off);
                        if (pn < 5 && wc == 0) {
                            const f32x4 c = *(const f32x4*)(rp + 4 * fq), s = *(const f32x4*)(rp + 16 + 4 * fq);
                            const f32x4 y0 = v0 * c - v1 * s, y1 = v1 * c + v0 * s; v0 = y0; v1 = y1;
                        }
                        st4h(dst + d0, v0); st4h(dst + d0 + 16, v1);
                    } else if (pn < 11) {
                        const bool is_q = pn < 10;
                        if (is_q || bj == 0) {
                            if (is_q || wc < 2) {
                                const int dd = 32 * (wc & 1) + 4 * fq;
                                const size_t off = is_q ? WS_QI + ((size_t)row * 1024 + ((pn - 6) * 4 + 2 * bj + (wc >> 1)) * 64) * 2 : WS_KI + ((size_t)row * 64) * 2;
                                h16* dst = (h16*)(ws + off);
                                if ((wc & 1) == 0) {
                                    f32x4 pr;
#pragma unroll
                                    for (int j = 0; j < 4; ++j) pr[j] = __shfl_xor(v0[j], 32);
                                    const f32x4 c = *(const f32x4*)(rp + 32 + 4 * (fq & 1)), s = *(const f32x4*)(rp + 40 + 4 * (fq & 1));
                                    v0 = (fq < 2) ? (v0 * c - pr * s) : (v0 * c + pr * s);
                                }
                                st4h(dst + dd, v0); st4h(dst + dd + 16, v1);
                            } else if (wc == 2) {
                                *(f32x4*)((float*)(ws + WS_WI) + (size_t)row * 16 + 4 * fq) = v0 * 0.03125f;
                                if (fq < 2) { const f32x4 bf = *(const f32x4*)(b_f + 4 * fq); f32x4 o;
#pragma unroll
                                    for (int j = 0; j < 4; ++j) o[j] = logsigmoidf_(v1[j] + bf[j]);
                                    *(f32x4*)((float*)(ws + WS_LOGF) + (size_t)row * 8 + 4 * fq) = o; }
                            }
                        }
                    } else if (pn < 23) {
                        const int q = pn - 11, which = q >> 2, head = (q & 3) * 2 + bj;
                        h16* dst = (h16*)(ws + WS_QB + (size_t)which * (WS_KB - WS_QB)) + ((size_t)(b * HB + head) * T + t) * HD;
                        st4h(dst + d0, v0); st4h(dst + d0 + 16, v1);
                    } else {
                        const int q = pn - 23; const int col = (q & 7) * 256 + 128 * bj + d0;
                        h16* base = (h16*)(ws + WS_SIGA + (size_t)(q >> 3) * (WS_SIGB - WS_SIGA));
#pragma unroll
                        for (int j = 0; j < 4; ++j) { v0[j] = sigmoidf_(v0[j]); v1[j] = sigmoidf_(v1[j]); }
                        st4h(base + (size_t)row * DM + col, v0); st4h(base + (size_t)row * DM + col + 16, v1);
                    }
                }
            }
    }
};
static_assert(WS_VB - WS_KB == WS_KB - WS_QB, "QB/KB/VB equally spaced");
template <bool FIRST> struct EpiGate {
    const h16* SIG; h16* MIXED;
    __device__ __forceinline__ void operator()(const Acc& acc, const Unit& u, int wr, int wc, int fr, int fq) const {
        const int row0 = u.pm * 256 + wr * 64 + fr, col0 = u.pn * 256 + 32 * wc + 4 * fq;
#pragma unroll
        for (int ai = 0; ai < 2; ++ai)
#pragma unroll
            for (int m = 0; m < 4; ++m)
#pragma unroll
                for (int bj = 0; bj < 2; ++bj)
#pragma unroll
                    for (int n = 0; n < 2; ++n) { const size_t off = (size_t)(row0 + ai * 128 + m * 16) * DM + col0 + bj * 128 + n * 16;
                        f32x4 v = ld4h(SIG + off) * acc[ai][bj][m][n]; if (!FIRST) v += ld4h(MIXED + off); st4h(MIXED + off, v); }
    }
};
__device__ __forceinline__ float sumsq4(f32x4 v) { return (v[0] * v[0] + v[1] * v[1]) + (v[2] * v[2] + v[3] * v[3]); }
struct EpiResidNorm {
    const float* BASE; float* OUT; h16* XH; float* RS;
    __device__ __forceinline__ void operator()(const Acc& acc, const Unit& u, int wr, int wc, int fr, int fq) const {
        const int row0 = u.pm * 256 + wr * 64 + fr, col0 = u.pn * 256 + 32 * wc + 4 * fq;
#pragma unroll
        for (int ai = 0; ai < 2; ++ai)
#pragma unroll
            for (int m = 0; m < 4; ++m) { const int row = row0 + ai * 128 + m * 16; float ss = 0.f;
#pragma unroll
                for (int bj = 0; bj < 2; ++bj)
#pragma unroll
                    for (int n = 0; n < 2; ++n) { const size_t off = (size_t)row * DM + col0 + bj * 128 + n * 16;
                        const f32x4 v = *(const f32x4*)(BASE + off) + acc[ai][bj][m][n]; *(f32x4*)(OUT + off) = v; st4h(XH + off, v); ss += sumsq4(v); }
                ss += __shfl_xor(ss, 16); ss += __shfl_xor(ss, 32);
                if (fq == 0) atomicAdd(RS + row, ss); }
    }
};
struct EpiSwiGLU {
    h16* ACT; const float* RS;
    __device__ __forceinline__ void operator()(const Acc& acc, const Unit& u, int wr, int wc, int fr, int fq) const {
        const int row0 = u.pm * 256 + wr * 64 + fr;
#pragma unroll
        for (int ai = 0; ai < 2; ++ai)
#pragma unroll
            for (int m = 0; m < 4; ++m) { const int row = row0 + ai * 128 + m * 16; const float r = __builtin_amdgcn_rsqf(RS[row] * (1.0f / DM) + EPS);
#pragma unroll
                for (int bj = 0; bj < 2; ++bj) { const f32x4 g = acc[ai][bj][m][0] * r, uu = acc[ai][bj][m][1] * r; f32x4 o;
#pragma unroll
                    for (int j = 0; j < 4; ++j) o[j] = g[j] * sigmoidf_(g[j]) * uu[j];
                    st4h(ACT + (size_t)row * DFF + 16 * (u.pn * 8 + bj * 4 + wc) + 4 * fq, o); } }
    }
};
struct EpiStoreH {
    h16* O; int ldc;
    __device__ __forceinline__ void operator()(const Acc& acc, const Unit& u, int wr, int wc, int fr, int fq) const {
        const int row0 = u.pm * 256 + wr * 64 + fr, col0 = u.pn * 256 + 32 * wc + 4 * fq;
#pragma unroll
        for (int ai = 0; ai < 2; ++ai)
#pragma unroll
            for (int m = 0; m < 4; ++m)
#pragma unroll
                for (int bj = 0; bj < 2; ++bj)
#pragma unroll
                    for (int n = 0; n < 2; ++n) st4h(O + (size_t)(row0 + ai * 128 + m * 16) * ldc + col0 + bj * 128 + n * 16, acc[ai][bj][m][n]);
    }
};
struct EpiPLE {
    const h16* PP; float* X; const float* RSIN; float* RSOUT;
    __device__ __forceinline__ void operator()(const Acc& acc, const Unit& u, int wr, int wc, int fr, int fq) const {
        const int row0 = u.pm * 256 + wr * 64 + fr, col0 = u.pn * 256 + 32 * wc + 4 * fq;
#pragma unroll
        for (int ai = 0; ai < 2; ++ai)
#pragma unroll
            for (int m = 0; m < 4; ++m) { const int row = row0 + ai * 128 + m * 16; const float r = __builtin_amdgcn_rsqf(RSIN[row] * (1.0f / DM) + EPS); float ss = 0.f;
#pragma unroll
                for (int bj = 0; bj < 2; ++bj)
#pragma unroll
                    for (int n = 0; n < 2; ++n) { const size_t off = (size_t)row * DM + col0 + bj * 128 + n * 16;
                        const f32x4 a = acc[ai][bj][m][n] * r, pp = ld4h(PP + off); f32x4 x = *(const f32x4*)(X + off);
#pragma unroll
                        for (int j = 0; j < 4; ++j) x[j] += sigmoidf_(a[j]) * pp[j];
                        *(f32x4*)(X + off) = x; ss += sumsq4(x); }
                ss += __shfl_xor(ss, 16); ss += __shfl_xor(ss, 32);
                if (fq == 0) atomicAdd(RSOUT + row, ss); }
    }
};

__device__ __forceinline__ int map_in(int p) {
    if (p < 2560) return p;
    if (p < 2816) { const int c = p - 2560; if (c < 64) return 2560 + c; if (c < 80) return 2624 + (c - 64); if (c < 88) return 5712 + (c - 80); return -1; }
    const int q = p - 2816; if (q < 3072) return 2640 + q; return 5720 + (q - 3072);
}
template <int MODE>
__device__ __forceinline__ const float* tr_src(const float* W0, const float* W1, int Nsrc, int n) {
    if (MODE == 0) return n < Nsrc ? W0 + n : nullptr;
    if (MODE == 1) { const int c = map_in(n); return c >= 0 ? W0 + c : nullptr; }
    return (((n >> 4) & 1) ? W1 : W0) + 16 * (n >> 5) + (n & 15);
}
template <int MODE>
__device__ __forceinline__ void ph_transpose(const float* W0, const float* W1, const float* gk, int K, int Nsrc, h16* WT, int Nphys, LAS float* scr, int gw, int NGW, int lane) {
    const int nblk = Nphys / 32, nitems = (K / 64) * nblk;
    const int lr = lane >> 3, lc = (lane & 7) * 4;
    f32x4 cur[8], nxt[8];
    int item = gw;
    if (item < nitems) { const int kb = item / nblk, nb = item % nblk; const float* src = tr_src<MODE>(W0, W1, Nsrc, 32 * nb + lc);
#pragma unroll
        for (int i = 0; i < 8; ++i) cur[i] = src ? *(const f32x4*)(src + (size_t)(64 * kb + lr + 8 * i) * Nsrc) : (f32x4){0.f, 0.f, 0.f, 0.f}; }
    for (; item < nitems; item += NGW) {
        const int kb = item / nblk, nb = item % nblk, k0 = 64 * kb, n0 = 32 * nb;
        const int itn = item + NGW;
        if (itn < nitems) { const int kbn = itn / nblk, nbn = itn % nblk; const float* src = tr_src<MODE>(W0, W1, Nsrc, 32 * nbn + lc);
#pragma unroll
            for (int i = 0; i < 8; ++i) nxt[i] = src ? *(const f32x4*)(src + (size_t)(64 * kbn + lr + 8 * i) * Nsrc) : (f32x4){0.f, 0.f, 0.f, 0.f}; }
#pragma unroll
        for (int i = 0; i < 8; ++i) { LAS float* d = scr + (lr + 8 * i) * 33 + lc; const float gg = gk ? gk[k0 + lr + 8 * i] : 1.0f; d[0] = cur[i][0] * gg; d[1] = cur[i][1] * gg; d[2] = cur[i][2] * gg; d[3] = cur[i][3] * gg; }
        __builtin_amdgcn_wave_barrier(); asm volatile("s_waitcnt lgkmcnt(0)" ::: "memory");
        const int c = lane & 7;
#pragma unroll
        for (int j = 0; j < 4; ++j) { const int nn = (lane >> 3) + 8 * j; const LAS float* sp = scr + (8 * c) * 33 + nn;
            h16x8 o;
#pragma unroll
            for (int e = 0; e < 8; ++e) o[e] = (h16)sp[e * 33];
            *(h16x8*)(WT + (size_t)(n0 + nn) * K + k0 + 8 * c) = o; }
        __builtin_amdgcn_wave_barrier(); asm volatile("s_waitcnt lgkmcnt(0)" ::: "memory");
#pragma unroll
        for (int i = 0; i < 8; ++i) cur[i] = nxt[i];
    }
}
__device__ __forceinline__ void sincos_f32arg(float ang, float& sn, float& cs) {
    const double a = (double)ang;
    const double rev = a * 0.15915494309189535;
    const double fr = rev - __builtin_rint(rev);
    const double q4 = fr * 4.0; const double qi = __builtin_rint(q4); const int qq = ((int)qi) & 3;
    const double r = (q4 - qi) * 1.5707963267948966;
    const double r2 = r * r;
    const double s = r * (1.0 + r2 * (-1.0 / 6 + r2 * (1.0 / 120 + r2 * (-1.0 / 5040 + r2 * (1.0 / 362880 + r2 * (-1.0 / 39916800))))));
    const double c = 1.0 + r2 * (-0.5 + r2 * (1.0 / 24 + r2 * (-1.0 / 720 + r2 * (1.0 / 40320 + r2 * (-1.0 / 3628800 + r2 * (1.0 / 479001600))))));
    double so, co;
    if (qq == 0) { so = s; co = c; } else if (qq == 1) { so = c; co = -s; } else if (qq == 2) { so = -s; co = -c; } else { so = -c; co = s; }
    sn = (float)so; cs = (float)co;
}
__device__ __forceinline__ void ph_rope(const int* pos, float* ROPE, int gtid, int NGT) {
    for (int idx = gtid; idx < MTOK * 24; idx += NGT) {
        const int tok = idx / 24, i = idx % 24, k = i < 16 ? i : 2 * (i - 16);
        float f = 0x1.000000p+0f;
        f = k == 1 ? 0x1.c2ef76p-2f : f; f = k == 2 ? 0x1.8d275ep-3f : f; f = k == 3 ? 0x1.5dc95ap-4f : f; f = k == 4 ? 0x1.341190p-5f : f; f = k == 5 ? 0x1.0f5384p-6f : f;
        f = k == 6 ? 0x1.ddee9cp-8f : f; f = k == 7 ? 0x1.a4ee3ep-9f : f; f = k == 8 ? 0x1.72ba44p-10f : f; f = k == 9 ? 0x1.468318p-11f : f; f = k == 10 ? 0x1.1f91f0p-12f : f;
        f = k == 11 ? 0x1.fa8b84p-14f : f; f = k == 12 ? 0x1.be218ap-15f : f; f = k == 13 ? 0x1.88ec22p-16f : f; f = k == 14 ? 0x1.5a0f50p-17f : f; f = k == 15 ? 0x1.30c94ep-18f : f;
        const float ang = (float)pos[tok] * f;
        float sn, cs; sincos_f32arg(ang, sn, cs);
        float* rp = ROPE + (size_t)tok * 48;
        if (i < 16) { rp[i] = cs; rp[16 + i] = sn; } else { rp[32 + (i - 16)] = cs; rp[40 + (i - 16)] = sn; }
    }
}
template <bool TO_F32>
__device__ __forceinline__ void ph_rmsnorm(const float* X, const float* g, h16* OUTH, float* OUTF, int gw, int NGW, int lane) {
    for (int row = gw; row < MTOK; row += NGW) {
        const f32x4* xr = (const f32x4*)(X + (size_t)row * DM) + lane;
        f32x4 v[8]; float s = 0.f;
#pragma unroll
        for (int j = 0; j < 8; ++j) { v[j] = xr[64 * j]; s += (v[j][0] * v[j][0] + v[j][1] * v[j][1]) + (v[j][2] * v[j][2] + v[j][3] * v[j][3]); }
        const float r = 1.0f / sqrtf(wave_sum(s) * (1.0f / DM) + EPS);
#pragma unroll
        for (int j = 0; j < 8; ++j) { const f32x4 gg = *((const f32x4*)g + lane + 64 * j); const f32x4 o = v[j] * r * gg;
            if (TO_F32) *((f32x4*)(OUTF + (size_t)row * DM) + lane + 64 * j) = o; else st4h(OUTH + (size_t)row * DM + 4 * (lane + 64 * j), o); }
    }
}
__device__ __forceinline__ void ph_final(float* X, const float* g, const float* RS, int gw, int NGW, int lane) {
    for (int row = gw; row < MTOK; row += NGW) {
        f32x4* xr = (f32x4*)(X + (size_t)row * DM) + lane; const float r = __builtin_amdgcn_rsqf(RS[row] * (1.0f / DM) + EPS);
        f32x4 v[8];
#pragma unroll
        for (int j = 0; j < 8; ++j) v[j] = xr[64 * j];
#pragma unroll
        for (int j = 0; j < 8; ++j) xr[64 * j] = v[j] * r * *((const f32x4*)g + lane + 64 * j);
    }
}
__device__ __forceinline__ void ph_cumsum(const float* LOGF, float* CBS, int bh, int lane) {
    const int b = bh >> 3, h = bh & 7;
    float v[64];
#pragma unroll
    for (int it = 0; it < 64; ++it) v[it] = LOGF[(size_t)(b * T + it * 64 + lane) * 8 + h];
    float run = 0.f;
#pragma unroll
    for (int it = 0; it < 64; ++it) {
        float x = v[it];
#pragma unroll
        for (int o = 1; o < 64; o <<= 1) { const float nb = __shfl_up(x, o); if (lane >= o) x += nb; }
        CBS[(size_t)bh * T + it * 64 + lane] = (run + x) * -11.313708498984761f;
        run += __shfl(x, 63);
    }
}

__device__ __forceinline__ unsigned fkey(float f) { const unsigned u = __float_as_uint(f + 0.0f); return (u & 0x80000000u) ? ~u : (u | 0x80000000u); }
__device__ __forceinline__ unsigned count_ge(const unsigned (&key)[64], unsigned th, int nj) {
    unsigned c = 0;
#pragma unroll
    for (int j8 = 0; j8 < 8; ++j8) {
        if (8 * j8 < nj) {
#pragma unroll
            for (int j = 8 * j8; j < 8 * j8 + 8; ++j) c += (key[j] >= th) ? 1u : 0u;
        }
    }
#pragma unroll
    for (int o = 1; o < 64; o <<= 1) c += __shfl_xor(c, o);
    return c;
}
__device__ __forceinline__ u64 topk_select(const unsigned (&key)[64], int nvalid, int lane) {
    u64 myword = 0;
    if (nvalid <= TOPK) {
#pragma unroll
        for (int j = 0; j < 64; ++j) { const u64 bal = __ballot(key[j] != 0u); if (lane == j) myword = bal; }
    } else {
        unsigned th = 0u; bool exact = false;
        for (int bit = 31; bit >= 0; --bit) { const unsigned tc = th | (1u << bit); const unsigned c = count_ge(key, tc, (nvalid + 63) >> 6); if (c >= (unsigned)TOPK) th = tc; if (c == (unsigned)TOPK) { exact = true; break; } }
        if (exact) {
#pragma unroll
            for (int j = 0; j < 64; ++j) { const u64 bal = __ballot(key[j] >= th); if (lane == j) myword = bal; }
        } else {
            unsigned cgt = 0;
#pragma unroll
            for (int j = 0; j < 64; ++j) cgt += (unsigned)__builtin_popcountll(__ballot(key[j] > th));
            int need = TOPK - (int)cgt;
#pragma unroll
            for (int j = 0; j < 64; ++j) { u64 eq = __ballot(key[j] == th); const u64 gt = __ballot(key[j] > th);
                int pc = __builtin_popcountll(eq);
                while (pc > need) { eq &= ~(1ull << (63 - __builtin_clzll(eq))); --pc; }
                need -= pc; if (lane == j) myword = gt | eq; }
        }
    }
    return myword;
}
__device__ __forceinline__ void ph_topk_naive(const h16* QI, const h16* KI, const float* WI, u64* MASK, LAS float* qs, LAS unsigned* ks, int gw, int NGW, int lane) {
    for (int row = gw; row < MTOK; row += NGW) {
        const int b = row >> 12, t = row & 4095;
        { const h16* qp = QI + (size_t)row * 1024 + lane * 16;
#pragma unroll
          for (int i = 0; i < 16; ++i) qs[lane * 16 + i] = (float)qp[i]; }
        if (lane < 16) qs[1024 + lane] = WI[(size_t)row * 16 + lane];
        __builtin_amdgcn_wave_barrier(); asm volatile("s_waitcnt lgkmcnt(0)" ::: "memory");
#pragma unroll 1
        for (int j = 0; j < 64; ++j) {
            unsigned kk = 0u;
            const int s = 64 * j + lane;
            if (s <= t) {
                float kf[64];
                const h16x8* kp = (const h16x8*)(KI + (size_t)(b * T + s) * 64);
#pragma unroll
                for (int c = 0; c < 8; ++c) { const h16x8 kv = kp[c];
#pragma unroll
                    for (int e = 0; e < 8; ++e) kf[c * 8 + e] = (float)kv[e]; }
                float sc = 0.f;
#pragma unroll 1
                for (int h = 0; h < 16; ++h) { float d = 0.f;
#pragma unroll
                    for (int e = 0; e < 64; ++e) d = fmaf(qs[h * 64 + e], kf[e], d);
                    sc = fmaf(qs[1024 + h], fmaxf(d, 0.f), sc); }
                kk = fkey(sc);
            }
            ks[j * 64 + lane] = kk;
        }
        __builtin_amdgcn_wave_barrier(); asm volatile("s_waitcnt lgkmcnt(0)" ::: "memory");
        unsigned key[64];
#pragma unroll
        for (int j = 0; j < 64; ++j) key[j] = ks[j * 64 + lane];
        MASK[(size_t)row * 64 + lane] = topk_select(key, t + 1, lane);
        __builtin_amdgcn_wave_barrier(); asm volatile("s_waitcnt lgkmcnt(0)" ::: "memory");
    }
}


namespace idx {
typedef short s16x8 __attribute__((ext_vector_type(8)));
typedef float f32x16 __attribute__((ext_vector_type(16)));
constexpr int CHK = 128, CHB = CHK * 128;
__device__ __forceinline__ unsigned half_sum(unsigned v) {
#pragma unroll
    for (int o = 1; o < 32; o <<= 1) v += __shfl_xor(v, o);
    return v;
}
__device__ __forceinline__ void run_group(unsigned char* ws, char* lds, unsigned* scr, int b, int g, int wv) {
    int tid = wv * 64 + lane_id(); asm volatile("" : "+v"(tid));
    const int wid = __builtin_amdgcn_readfirstlane(tid >> 6), lane = tid & 63, c = lane & 31, hi = lane >> 5;
    const int t0 = 16 * g + 2 * wid, t = t0 + hi, row = b * T + t, tmaxblk = 16 * g + 15, nch = (tmaxblk >> 7) + 1;
    const h16* QI = (const h16*)(ws + WS_QI); const char* KIb = (const char*)ws + WS_KI + (size_t)b * T * 128; const float* WI = (const float*)(ws + WS_WI);
    s16x8 A[4];
    { const int rho = c, qsel = (rho >> 2) & 1, head = (rho & 3) + 4 * (rho >> 3);
      const h16* qp = QI + (size_t)(b * T + t0 + qsel) * 1024 + head * 64 + 8 * hi;
#pragma unroll
      for (int ks = 0; ks < 4; ++ks) A[ks] = *reinterpret_cast<const s16x8*>(qp + 16 * ks); }
    float w[16];
    { const f32x4* wp = (const f32x4*)(WI + (size_t)row * 16);
#pragma unroll
      for (int i = 0; i < 4; ++i) { const f32x4 v = wp[i]; w[4 * i] = v[0]; w[4 * i + 1] = v[1]; w[4 * i + 2] = v[2]; w[4 * i + 3] = v[3]; } }
    const int pr0 = tid >> 3, pp = tid & 7;
    const unsigned g_off = (unsigned)(pr0 * 128 + pp * 16);
    const int l_off0 = pr0 * 128 + ((pp ^ ((pr0 >> 1) & 7)) << 4), l_off1 = l_off0 + 64 * 128;
    const int rd_base = c * 128; const int sw = (c >> 1) & 7;
    int rd_off[4];
#pragma unroll
    for (int ks = 0; ks < 4; ++ks) rd_off[ks] = rd_base + (((2 * ks + hi) ^ sw) << 4);
    unsigned* myscr = scr + (size_t)(2 * wid + hi) * T + c;
    s16x8 st0, st1;
    { const char* src = KIb; st0 = *reinterpret_cast<const s16x8*>(src + g_off); st1 = *reinterpret_cast<const s16x8*>(src + 64 * 128 + g_off); }
    *reinterpret_cast<s16x8*>(lds + l_off0) = st0; *reinterpret_cast<s16x8*>(lds + l_off1) = st1;
    __syncthreads();
#pragma unroll 1
    for (int ch = 0; ch < nch; ++ch) {
        const char* buf = lds + (ch & 1) * CHB;
        if (ch + 1 < nch) { const char* src = KIb + (size_t)(ch + 1) * CHB; st0 = *reinterpret_cast<const s16x8*>(src + g_off); st1 = *reinterpret_cast<const s16x8*>(src + 64 * 128 + g_off); }
#pragma unroll
        for (int st = 0; st < 4; ++st) {
            f32x16 acc = {};
#pragma unroll
            for (int ks = 0; ks < 4; ++ks) { const s16x8 Bf = *reinterpret_cast<const s16x8*>(buf + st * 4096 + rd_off[ks]);
                acc = __builtin_amdgcn_mfma_f32_32x32x16_f16(__builtin_bit_cast(h16x8, A[ks]), __builtin_bit_cast(h16x8, Bf), acc, 0, 0, 0); }
            float sc = 0.f;
#pragma unroll
            for (int r = 0; r < 16; ++r) sc = fmaf(w[r], fmaxf(acc[r], 0.f), sc);
            const int sidx = ch * CHK + st * 32 + c;
            myscr[ch * CHK + st * 32] = (sidx <= t) ? fkey(sc) : 0u;
        }
        if (ch + 1 < nch) { char* dst = lds + ((ch + 1) & 1) * CHB; *reinterpret_cast<s16x8*>(dst + l_off0) = st0; *reinterpret_cast<s16x8*>(dst + l_off1) = st1; }
        __syncthreads();
    }
    asm volatile("s_waitcnt vmcnt(0)" ::: "memory");
    u64* MASK = (u64*)(ws + WS_MASK);
#pragma unroll 1
    for (int qq = 0; qq < 2; ++qq) {
        const int tq = t0 + qq, nj = (tq >> 6) + 1;
        const unsigned* src = scr + (size_t)(2 * wid + qq) * T + lane;
        unsigned key[64];
#pragma unroll
        for (int j = 0; j < 64; ++j) key[j] = (j < nj) ? __hip_atomic_load(src + 64 * j, __ATOMIC_RELAXED, __HIP_MEMORY_SCOPE_AGENT) : 0u;
        MASK[(size_t)(b * T + tq) * 64 + lane] = topk_select(key, tq + 1, lane);
    }
}
}

namespace att {
constexpr int NW = 8, QBLK = 32, KVBLK = 64, QB = NW * QBLK, D = 128;
constexpr int SHM_V = KVBLK * D * 2, SHM_K = KVBLK * D * 2;
constexpr int LDS_NEED = 2 * SHM_V + 2 * SHM_K + NW * 64 * 4;
constexpr float THR = 8.f, SCALE = 0.08838834764831845f;
typedef short s16x8 __attribute__((ext_vector_type(8)));
typedef short s16x4 __attribute__((ext_vector_type(4)));
typedef float f32x16 __attribute__((ext_vector_type(16)));
#define KSWZ(row, colB) ((row) * 256 + ((colB) ^ (((row) & 7) << 4)))
#define SBAR() __builtin_amdgcn_sched_barrier(0)
__device__ __forceinline__ int v_st(int k, int c) { const int kk = (k & ~0xC) | ((k & 4) << 1) | ((k & 8) >> 1); return ((kk >> 3) * 4 + (c >> 5)) * 512 + ((kk & 7) * 32 + (c & 31)) * 2; }
__device__ __forceinline__ int v_rd_base(int lane) { return ((lane & 3) << 3) | (((lane >> 2) & 3) << 6) | (((lane >> 4) & 1) << 5) | (((lane >> 5) & 1) << 8); }
constexpr int v_rd_off(int d0, int ks, int half) { return d0 * 512 + ks * 4096 + half * 2048; }
__device__ __forceinline__ int crow(int r, int hi) { return (r & 3) + 8 * (r >> 2) + 4 * hi; }
__device__ __forceinline__ unsigned cvtpk(float lo, float hi) { unsigned r; asm volatile("v_cvt_pk_f16_f32 %0, %1, %2" : "=v"(r) : "v"(lo), "v"(hi)); return r; }
__device__ __forceinline__ f32x16 mfma16(s16x8 a, s16x8 b, f32x16 c) { return __builtin_amdgcn_mfma_f32_32x32x16_f16(__builtin_bit_cast(h16x8, a), __builtin_bit_cast(h16x8, b), c, 0, 0, 0); }
__device__ __forceinline__ s16x8 load8(const h16* p) { return *reinterpret_cast<const s16x8*>(p); }
__device__ __forceinline__ void mask_causal(f32x16& p0, f32x16& p1, int dq) {
    const float NEG = -__builtin_inff();
#pragma unroll
    for (int r = 0; r < 16; ++r) { const int c = (r & 3) + 8 * (r >> 2); if (dq - c < 0) p0[r] = NEG; if (dq - c - 32 < 0) p1[r] = NEG; }
}
__device__ __forceinline__ void mask_bits(f32x16& p0, f32x16& p1, u64 w, int hi) {
    const float NEG = -__builtin_inff();
    const unsigned lo = (unsigned)w >> (4 * hi), up = (unsigned)(w >> 32) >> (4 * hi);
#pragma unroll
    for (int r = 0; r < 16; ++r) { const int c = (r & 3) + 8 * (r >> 2); if (!((lo >> c) & 1u)) p0[r] = NEG; if (!((up >> c) & 1u)) p1[r] = NEG; }
}
__device__ __forceinline__ void partialSM(f32x16& p0, f32x16& p1, float& m_reg, float& mn, float& alpha) {
    float pmax = p0[0]; for (int r = 1; r < 16; ++r) pmax = fmaxf(pmax, p0[r]); for (int r = 0; r < 16; ++r) pmax = fmaxf(pmax, p1[r]);
    { auto rr = __builtin_amdgcn_permlane32_swap(__float_as_uint(pmax), __float_as_uint(pmax), false, false);
      pmax = fmaxf(__uint_as_float(rr[0]), __uint_as_float(rr[1])); }
    constexpr float C2 = 1.4426950408889634f * SCALE;
    if (__builtin_expect(__all((pmax - m_reg) * SCALE <= THR), 1)) { mn = m_reg; alpha = 1.f; }
    else { mn = fmaxf(m_reg, pmax); alpha = __builtin_amdgcn_exp2f((m_reg - mn) * C2); m_reg = mn; }
    const float mnL = -mn * C2;
    for (int r = 0; r < 16; ++r) p0[r] = fmaf(p0[r], C2, mnL); for (int r = 0; r < 16; ++r) p1[r] = fmaf(p1[r], C2, mnL);
    for (int r = 0; r < 16; ++r) p0[r] = __builtin_amdgcn_exp2f(p0[r]);
}
__device__ __forceinline__ void finishSM(f32x16& p0, f32x16& p1, float alpha, float& l_reg, s16x8& pa0, s16x8& pa1, s16x8& pa2, s16x8& pa3) {
    for (int r = 0; r < 16; ++r) p1[r] = __builtin_amdgcn_exp2f(p1[r]);
    float ps = 0; for (int r = 0; r < 16; ++r) ps += p0[r]; for (int r = 0; r < 16; ++r) ps += p1[r];
    { auto rr = __builtin_amdgcn_permlane32_swap(__float_as_uint(ps), __float_as_uint(ps), false, false);
      ps = __uint_as_float(rr[0]) + __uint_as_float(rr[1]); }
    l_reg = l_reg * alpha + ps;
#define PK4(P, B_, OUT) do { unsigned a0 = cvtpk(P[B_+0], P[B_+1]), a1 = cvtpk(P[B_+2], P[B_+3]);                          \
        unsigned b0 = cvtpk(P[B_+4], P[B_+5]), b1 = cvtpk(P[B_+6], P[B_+7]);                                             \
        auto r0 = __builtin_amdgcn_permlane32_swap(a0, b0, false, false); auto r1 = __builtin_amdgcn_permlane32_swap(a1, b1, false, false); \
        u32x4 w = {r0[0], r1[0], r0[1], r1[1]}; OUT = *reinterpret_cast<s16x8*>(&w); } while (0)
    PK4(p0, 0, pa0); PK4(p0, 8, pa1); PK4(p1, 0, pa2); PK4(p1, 8, pa3);
#undef PK4
}
template <int KB>
__device__ __forceinline__ void qkt(f32x16& p0, f32x16& p1, const char* K_lds, int r32, int hi, const s16x8* qr) {
    const char* kb[4];
#pragma unroll
    for (int dd = 0; dd < 4; ++dd) kb[dd] = K_lds + KB * SHM_K + KSWZ(r32, (dd * 16 + hi * 8) * 2);
#pragma unroll
    for (int d0 = 0; d0 < 8; ++d0) { const char* a = kb[d0 & 3] + (d0 >> 2) * 128;
        s16x8 b0 = *reinterpret_cast<const s16x8*>(a);
        s16x8 b1 = *reinterpret_cast<const s16x8*>(a + 32 * 256);
        p0 = mfma16(b0, qr[d0], p0);
        p1 = mfma16(b1, qr[d0], p1); }
}
template <int VB>
__device__ __forceinline__ void pv_tile(f32x16* o, int vb0, s16x8 pa0, s16x8 pa1, s16x8 pa2, s16x8 pa3) {
#define TRRD(dst, off) asm volatile("ds_read_b64_tr_b16 %0, %1 offset:%2" : "=&v"(dst) : "v"(vb0), "i"(off) : "memory")
#define PV_D0(d0) do { s16x4 l0, l1, l2, l3, h0, h1, h2, h3; constexpr int b_ = VB * SHM_V + v_rd_off(d0, 0, 0); \
        TRRD(l0, b_); TRRD(h0, b_ + 2048); TRRD(l1, b_ + 4096); TRRD(h1, b_ + 6144); TRRD(l2, b_ + 8192); TRRD(h2, b_ + 10240); TRRD(l3, b_ + 12288); TRRD(h3, b_ + 14336); \
        asm volatile("s_waitcnt lgkmcnt(0)" ::: "memory"); SBAR();   \
        o[d0] = mfma16(pa0, (s16x8){l0[0], l0[1], l0[2], l0[3], h0[0], h0[1], h0[2], h0[3]}, o[d0]);   \
        o[d0] = mfma16(pa1, (s16x8){l1[0], l1[1], l1[2], l1[3], h1[0], h1[1], h1[2], h1[3]}, o[d0]);   \
        o[d0] = mfma16(pa2, (s16x8){l2[0], l2[1], l2[2], l2[3], h2[0], h2[1], h2[2], h2[3]}, o[d0]);   \
        o[d0] = mfma16(pa3, (s16x8){l3[0], l3[1], l3[2], l3[3], h3[0], h3[1], h3[2], h3[3]}, o[d0]); } while (0)
    PV_D0(0); PV_D0(1); PV_D0(2); PV_D0(3);
#undef PV_D0
#undef TRRD
}
struct BlockRef { const char* Q; const char* K; const char* V; char* O; int P0; const char* NBQ; const char* MK; };
struct Seam { s16x8 qr[8]; s16x8 st_v0, st_v1, st_k0, st_k1; };
#define LD16(base, off) (*reinterpret_cast<const s16x8*>((base) + (off)))
#define VMW() asm volatile("s_waitcnt vmcnt(0)" ::: "memory")
#define VMWN(n) asm volatile("s_waitcnt vmcnt(%0)" :: "i"(n) : "memory")
#define SLOAD_H(Kp, Vp, k0) do { const char* vb_ = (Vp) + (size_t)(k0) * (D * 2); const char* kb_ = (Kp) + (size_t)(k0) * (D * 2); \
        S.st_v0 = LD16(vb_, st_off); S.st_v1 = LD16(vb_ + 32 * D * 2, st_off); S.st_k0 = LD16(kb_, st_off); S.st_k1 = LD16(kb_ + 32 * D * 2, st_off); } while (0)
#define SWRITE_HK(bf) do { *(s16x8*)(K_lds + (bf) * SHM_K + kws) = S.st_k0; *(s16x8*)(K_lds + (bf) * SHM_K + kws + 32 * 256) = S.st_k1; } while (0)
#define SWRITE_HV(bf) do { *(s16x8*)(V_lds + (bf) * SHM_V + vst0) = S.st_v0; *(s16x8*)(V_lds + (bf) * SHM_V + vst1) = S.st_v1; } while (0)
#define SWRITE_H(bf) do { SWRITE_HV(bf); SWRITE_HK(bf); } while (0)
__device__ __forceinline__ void prime(const BlockRef& cur, char* lds, Seam& S, int wv) {
    int tid = wv * 64 + lane_id(); asm volatile("" : "+v"(tid));
    const int wid = __builtin_amdgcn_readfirstlane(tid >> 6), lane = tid & 63, r32 = lane & 31, hi = lane >> 5;
    const int sr = tid >> 4, sc = (tid & 15) * 8, kws = KSWZ(sr, sc * 2); char* K_lds = lds + 2 * SHM_V;
    const unsigned st_off = (unsigned)(sr * D + sc) * 2u, q_off = (unsigned)((wid * QBLK + r32) * D + hi * 8) * 2u;
#pragma unroll
    for (int d0 = 0; d0 < 8; ++d0) S.qr[d0] = LD16(cur.Q + d0 * 32, q_off);
    SLOAD_H(cur.K, cur.V, 0); VMW(); SWRITE_HK(0);
    __syncthreads();
}
template <bool MIXB>
__device__ __forceinline__ void block(const BlockRef& cur, const BlockRef& nxt, char* lds, Seam& S, int wv) {
    int tid = wv * 64 + lane_id(); asm volatile("" : "+v"(tid));
    const int wid = __builtin_amdgcn_readfirstlane(tid >> 6), lane = tid & 63, r32 = lane & 31, hi = lane >> 5;
    const int NT = cur.P0 / KVBLK + 4;
    const int qlo = cur.P0 + wid * QBLK, qm = qlo + r32 - 4 * hi;
    char* V_lds = lds; char* K_lds = lds + 2 * SHM_V;
    float* wsf = (float*)(lds + 2 * SHM_V + 2 * SHM_K) + wid * 64; float* li_l = wsf, * al_l = wsf + 32;
    float m_reg = -1e30f, l_reg = 0; f32x16 o[4] = {};
    const int sr = tid >> 4, sc = (tid & 15) * 8, vst0 = v_st(sr, sc), vst1 = v_st(32 + sr, sc), kws = KSWZ(sr, sc * 2);
    const int vb0 = (int)(uintptr_t)V_lds + v_rd_base(lane);
    const unsigned st_off = (unsigned)(sr * D + sc) * 2u, q_off = (unsigned)((wid * QBLK + r32) * D + hi * 8) * 2u;
    const unsigned nb_off = (unsigned)hi * 16u, mk_off = (unsigned)(wid * QBLK + r32) * 512u;
    const char* Kh = cur.K; const char* Vh = cur.V;
    const char* bias_l = lds + LDS_NEED;
    if (MIXB) { const float nbref = *(const float*)(cur.NBQ + (size_t)(cur.P0 + QB - 1) * 4);
        for (int i = tid; i < cur.P0 + QB; i += NW * 64) ((float*)bias_l)[i] = ((const float*)cur.NBQ)[i] - nbref;
        __syncthreads(); }
#define RESC(a) do { if (__any((a) < 1.f)) { if (hi == 0) al_l[r32] = (a); asm volatile("s_waitcnt lgkmcnt(0)" ::: "memory");              \
                     for (int d_ = 0; d_ < 4; ++d_) for (int r = 0; r < 16; ++r) o[d_][r] *= al_l[crow(r, hi)]; } } while (0)
#define KBASE(t) ((t) * KVBLK)
#define PINIT(P0_, P1_, t) do { if (MIXB) { const char* nb_ = bias_l + KBASE(t) * 4 + nb_off; _Pragma("unroll") for (int g_ = 0; g_ < 4; ++g_) { \
            const f32x4 b0_ = *(const f32x4*)(nb_ + 32 * g_), b1_ = *(const f32x4*)(nb_ + 128 + 32 * g_); \
            _Pragma("unroll") for (int j_ = 0; j_ < 4; ++j_) { P0_[4 * g_ + j_] = b0_[j_]; P1_[4 * g_ + j_] = b1_[j_]; } } } else { P0_ = f32x16{}; P1_ = f32x16{}; } } while (0)
#define MKW(t) (*(const u64*)(cur.MK + (size_t)(t) * 8 + mk_off))
#define MASKT(P0_, P1_, t, MW_) do { if (MIXB) { const int kb_ = KBASE(t); if (kb_ + KVBLK - 1 > qlo) mask_causal(P0_, P1_, qm - kb_); } else mask_bits(P0_, P1_, MW_, hi); } while (0)
    f32x16 pA0, pA1, pB0, pB1; float mnA, mnB, alA, alB; s16x8 pa0, pa1, pa2, pa3;
    u64 mwA = 0, mwB = 0;
    if (!MIXB) { mwA = MKW(0); if (NT > 1) mwB = MKW(1); }
    PINIT(pA0, pA1, 0);
    if (NT > 1) PINIT(pB0, pB1, 1);
    SWRITE_HV(0); SBAR();
    if (NT > 1) SLOAD_H(Kh, Vh, KBASE(1));
    SBAR(); qkt<0>(pA0, pA1, K_lds, r32, hi, S.qr);
    MASKT(pA0, pA1, 0, mwA); if (!MIXB) { if (NT > 2) mwA = MKW(2); }
    partialSM(pA0, pA1, m_reg, mnA, alA);
    if (NT > 1) { VMW(); SWRITE_H(1); }
    __syncthreads();
#define HALF_STEP(PX0, PX1, mnX, alX, MWX, PY0, PY1, alY, t, KB, VB, SB) do {                                               \
        SBAR(); qkt<KB>(PX0, PX1, K_lds, r32, hi, S.qr);                                                                      \
        finishSM(PY0, PY1, alY, l_reg, pa0, pa1, pa2, pa3); SBAR();                                                           \
        if ((t) + 1 < NT) { PINIT(PY0, PY1, (t) + 1); SLOAD_H(Kh, Vh, KBASE((t) + 1)); SBAR(); }                             \
        pv_tile<VB>(o, vb0, pa0, pa1, pa2, pa3); MASKT(PX0, PX1, (t), MWX); if (!MIXB) { if ((t) + 2 < NT) MWX = MKW((t) + 2); } \
        partialSM(PX0, PX1, m_reg, mnX, alX);                                                                                 \
        __syncthreads();                                                                                                      \
        if ((t) + 1 < NT) { VMW(); SWRITE_H(SB); }                                                                            \
        RESC(alX); __syncthreads(); } while (0)
    for (int t = 1; t + 1 < NT; t += 2) {
        HALF_STEP(pB0, pB1, mnB, alB, mwB, pA0, pA1, alA, t, 1, 0, 0);
        HALF_STEP(pA0, pA1, mnA, alA, mwA, pB0, pB1, alB, t + 1, 0, 1, 1);
    }
    const bool even = (NT & 1) == 0;
    if (even) { SBAR(); qkt<1>(pB0, pB1, K_lds, r32, hi, S.qr); SBAR(); }
    SLOAD_H(nxt.K, nxt.V, 0); SBAR();
#pragma unroll
    for (int d0 = 0; d0 < 8; ++d0) S.qr[d0] = LD16(nxt.Q + d0 * 32, q_off);
    SBAR();
    finishSM(pA0, pA1, alA, l_reg, pa0, pa1, pa2, pa3); SBAR();
    pv_tile<0>(o, vb0, pa0, pa1, pa2, pa3);
    if (even) { MASKT(pB0, pB1, NT - 1, mwB); partialSM(pB0, pB1, m_reg, mnB, alB); __syncthreads(); RESC(alB);
        finishSM(pB0, pB1, alB, l_reg, pa0, pa1, pa2, pa3); SBAR(); pv_tile<1>(o, vb0, pa0, pa1, pa2, pa3); }
    SBAR(); VMWN(8); SWRITE_HK(0); SBAR();
    if (hi == 0) li_l[r32] = l_reg; asm volatile("s_waitcnt lgkmcnt(0)" ::: "memory");
    float rli[16];
#pragma unroll
    for (int r = 0; r < 16; ++r) rli[r] = __builtin_amdgcn_rcpf(li_l[crow(r, hi)]);
    const unsigned o_off = (unsigned)((wid * QBLK + 4 * hi) * 1024 + r32) * 2u;
#pragma unroll
    for (int r = 0; r < 16; ++r) {
#pragma unroll
        for (int d0 = 0; d0 < 4; ++d0) { const float v = o[d0][r] * rli[r];
            const float vn = __shfl_xor(v, 1);
            if ((r32 & 1) == 0) *(unsigned*)(cur.O + (size_t)(((r & 3) + 8 * (r >> 2)) * 2048 + d0 * 64) + o_off) = cvtpk(v, vn); } }
    __syncthreads();
#undef RESC
#undef KBASE
#undef PINIT
#undef MKW
#undef MASKT
#undef HALF_STEP
}
#undef LD16
#undef VMW
#undef VMWN
#undef SLOAD_H
#undef SWRITE_HK
#undef SWRITE_HV
#undef SWRITE_H
__device__ __forceinline__ BlockRef make_ref(bool mixb, unsigned char* ws, int bh, int qb) {
    const int b = bh >> 3, h = bh & 7, kvh = mixb ? bh : (b * HAKV + (h >> 2));
    BlockRef r;
    r.Q = (const char*)ws + (mixb ? WS_QB : WS_QA) + ((size_t)bh * T + (size_t)qb * QB) * D * 2;
    r.K = (const char*)ws + (mixb ? WS_KB : WS_KA) + (size_t)kvh * T * D * 2;
    r.V = (const char*)ws + (mixb ? WS_VB : WS_VA) + (size_t)kvh * T * D * 2;
    r.O = (char*)ws + (mixb ? WS_OUTB : WS_OUTA) + ((size_t)(b * T + qb * QB) * 1024 + h * D) * 2;
    r.P0 = qb * QB;
    r.NBQ = (const char*)ws + WS_CB + (size_t)bh * T * 4;
    r.MK = (const char*)ws + WS_MASK + (size_t)(b * T + qb * QB) * 64 * 8;
    return r;
}
template <bool MIXB>
__device__ __forceinline__ void run_item(int item, unsigned char* ws, char* lds, int wv) {
    const int bh = (item >> 3) & 15, x = item & 7;
    Seam S;
    BlockRef cur = make_ref(MIXB, ws, bh, x);
    prime(cur, lds, S, wv);
#pragma unroll 1
    for (int pass = 0; pass < 2; ++pass) {
        const BlockRef nxt = make_ref(MIXB, ws, bh, 15 - x);
        block<MIXB>(cur, nxt, lds, S, wv);
        cur = nxt;
    }
}
}


#define XB_TMO      128
#define XB_XCNT(j)  (256  + 64 * (j))
#define XB_XSUB(j)  (1280 + 64 * (j))
#define XB_XGEN(j)  (2304 + 64 * (j))
#define XB_TOP      3328
#define XB_TOPGEN   3392
#define XCD_BAR_WORDS 3456
#define XB_SPIN_CAP (1u << 24)
__device__ __forceinline__ unsigned xb_ld(unsigned* p)              { return __hip_atomic_load(p, __ATOMIC_RELAXED, __HIP_MEMORY_SCOPE_AGENT); }
__device__ __forceinline__ unsigned xb_add(unsigned* p, unsigned v) { return __hip_atomic_fetch_add(p, v, __ATOMIC_RELAXED, __HIP_MEMORY_SCOPE_AGENT); }
__device__ __forceinline__ unsigned xb_xcc_id() { return (unsigned)__builtin_amdgcn_s_getreg((3 << 11) | 20) & 0xFu; }
#define XB_SPIN(cond, bar) do { unsigned _sp = 0; while (cond) { __builtin_amdgcn_s_sleep(1); \
    if ((++_sp & 255u) == 0u) { if (xb_ld(&(bar)[XB_TMO])) break; if (_sp > XB_SPIN_CAP) { atomicAdd(&(bar)[XB_TMO], 1u); break; } } } } while (0)
struct XcdBarrier { unsigned* bar; unsigned x; volatile LAS unsigned* st; };
__device__ __forceinline__ XcdBarrier xcd_barrier_post(unsigned* bar, volatile LAS unsigned* st, int wv) {
    XcdBarrier b; b.bar = bar; b.x = xb_xcc_id(); b.st = st;
    if (wv == 0 && lane_id() == 0) (void)xb_add(&bar[XB_XCNT(b.x)], 1u);
    return b;
}
__device__ __forceinline__ void xcd_barrier_complete(unsigned* bar, unsigned x, unsigned& nloc, unsigned& nx) {
    const unsigned G = gridDim.x * gridDim.y * gridDim.z;
    unsigned sum, cnt, mine, sp = 0u;
    for (;;) {
        sum = 0u; cnt = 0u; mine = 0u;
#pragma unroll
        for (unsigned j = 0; j < 16; ++j) { const unsigned c = xb_ld(&bar[XB_XCNT(j)]); sum += c; cnt += (c > 0u) ? 1u : 0u; mine = (j == x) ? c : mine; }
        if (sum == G) break;
        __builtin_amdgcn_s_sleep(1);
        if ((++sp & 255u) == 0u) { if (xb_ld(&bar[XB_TMO])) break; if (sp > XB_SPIN_CAP) { atomicAdd(&bar[XB_TMO], 1u); break; } }
    }
    nloc = mine > 0u ? mine : 1u; nx = cnt > 0u ? cnt : 1u;
}
__device__ __forceinline__ void xcd_barrier(const XcdBarrier& b, int wv) {
    asm volatile("s_waitcnt vmcnt(0)" ::: "memory");
    __syncthreads();
    if (wv == 0 && lane_id() == 0) {
        unsigned* bar = b.bar;
        __builtin_amdgcn_s_waitcnt(0);
        unsigned nloc = b.st[0], nx = b.st[1];
        if (nloc == 0u) { xcd_barrier_complete(bar, b.x, nloc, nx); b.st[0] = nloc; b.st[1] = nx; }
        const unsigned old = xb_add(&bar[XB_XSUB(b.x)], 1u);
        const unsigned gen = old / nloc;
        if (old + 1u == (gen + 1u) * nloc) {
            __builtin_amdgcn_fence(__ATOMIC_RELEASE, "agent");
            asm volatile("s_waitcnt vmcnt(0)" ::: "memory");
            const unsigned og = xb_add(&bar[XB_TOP], 1u);
            const unsigned tg = og / nx;
            if (og + 1u == (tg + 1u) * nx) xb_add(&bar[XB_TOPGEN], 1u);
            else XB_SPIN(xb_ld(&bar[XB_TOPGEN]) == tg, bar);
            __builtin_amdgcn_fence(__ATOMIC_ACQUIRE, "agent");
            xb_add(&bar[XB_XGEN(b.x)], 1u);
            asm volatile("s_waitcnt vmcnt(0)" ::: "memory");
        } else {
            XB_SPIN(xb_ld(&bar[XB_XGEN(b.x)]) == gen, bar);
            __builtin_amdgcn_fence(__ATOMIC_ACQUIRE, "agent");
            asm volatile("s_waitcnt vmcnt(0)" ::: "memory");
        }
    }
    __syncthreads();
}

namespace cg = cooperative_groups;
#ifndef PROBE_DUP
#define PROBE_DUP 0
#endif
#define REP(k) for (int rep_ = 0; rep_ < (((PROBE_DUP) >> (k)) & 1) + 1; ++rep_)
constexpr int LDS_BYTES = pg8::STAGE_BYTES + 256;
constexpr int CW_BAR = 4096;
struct Params { const float* in[17]; float* out; unsigned char* ws; };
template <class Epi>
__device__ __forceinline__ void run_gemm(LAS unsigned char* lds, const h16* A, const h16* Bt, int M, int N, int K, const Epi& e, int wv) {
    pg8::Gemm g{A, Bt, M, N, K}; pg8::StaticOrder S; S.init(M, N, (int)gridDim.x, (int)blockIdx.x);
    pg8::gemm_phase<Epi>(lds, g, S, e, wv);
}
__global__ void __launch_bounds__(512, 2) mega_fwd(Params P) {
    extern __shared__ __attribute__((aligned(16))) unsigned char lds_raw[];
    LAS unsigned char* lds = (LAS unsigned char*)lds_raw;
    const int wv = __builtin_amdgcn_readfirstlane(threadIdx.x >> 6);
    volatile LAS unsigned* bst = (volatile LAS unsigned*)(lds + pg8::STAGE_BYTES);
    if (wv == 0 && lane_id() < 2) bst[lane_id()] = 0u;
    __syncthreads();
    const XcdBarrier xbar = xcd_barrier_post((unsigned*)(P.ws + WS_CTL) + CW_BAR, bst, wv);
#define GRID_BAR() xcd_barrier(xbar, wv)
#define IDS() int lane = lane_id(); asm volatile("" : "+v"(lane)); const int wave = wv, tid = wave * 64 + lane, gw = blockIdx.x * 8 + wave, NGW = gridDim.x * 8; (void)tid; (void)gw; (void)NGW
    const float* x = P.in[0]; const float* p = P.in[1]; const int* pos = (const int*)P.in[2];
    const float* g_mix = P.in[3]; const float* w_in = P.in[4]; const float* b_f = P.in[5];
    const float* w_o_a = P.in[6]; const float* w_o_b = P.in[7]; const float* w_out = P.in[8];
    const float* g_ffn = P.in[9]; const float* w_g = P.in[10]; const float* w_u = P.in[11]; const float* w_d = P.in[12];
    const float* g_ple = P.in[13]; const float* w_pg = P.in[14]; const float* w_pp = P.in[15]; const float* g_final = P.in[16];
    unsigned char* ws = P.ws; float* out = P.out;
    float* RS = (float*)(ws + WS_RS); float* ROPE = (float*)(ws + WS_ROPE); float* CB = (float*)(ws + WS_CB); float* LOGF = (float*)(ws + WS_LOGF); u64* MASK = (u64*)(ws + WS_MASK);
    h16* WIN = (h16*)(ws + WS_WIN); h16* WOA = (h16*)(ws + WS_WOA); h16* WOB = (h16*)(ws + WS_WOB); h16* WOUT = (h16*)(ws + WS_WOUT);
    h16* WGU = (h16*)(ws + WS_WGU); h16* WDN = (h16*)(ws + WS_WDN); h16* WPG = (h16*)(ws + WS_WPG); h16* WPP = (h16*)(ws + WS_WPP);
    h16* QI = (h16*)(ws + WS_QI); h16* KI = (h16*)(ws + WS_KI); float* WI = (float*)(ws + WS_WI);
    h16* SIGA = (h16*)(ws + WS_SIGA); h16* SIGB = (h16*)(ws + WS_SIGB);
    h16* OUTA = (h16*)(ws + WS_OUTA); h16* OUTB = (h16*)(ws + WS_OUTB); h16* P16 = (h16*)(ws + WS_P16);
    h16* MIXED = (h16*)(ws + WS_MIXED); h16* H2 = (h16*)(ws + WS_H2); h16* ACT = (h16*)(ws + WS_ACT); h16* PP = (h16*)(ws + WS_PP);
    h16* H1 = (h16*)P.out;

    REP(0) { IDS(); LAS float* scr = (LAS float*)(lds + wave * 8448);
      ph_transpose<1>(w_in, nullptr, nullptr, DM, N_IN, WIN, N_INP, scr, gw, NGW, lane);
      ph_transpose<0>(w_o_a, nullptr, nullptr, 1024, DM, WOA, DM, scr, gw, NGW, lane);
      ph_transpose<0>(w_o_b, nullptr, nullptr, 1024, DM, WOB, DM, scr, gw, NGW, lane);
      ph_transpose<0>(w_out, nullptr, nullptr, DM, DM, WOUT, DM, scr, gw, NGW, lane);
      ph_transpose<2>(w_g, w_u, g_ffn, DM, DFF, WGU, 2 * DFF, scr, gw, NGW, lane);
      ph_transpose<0>(w_d, nullptr, nullptr, DFF, DM, WDN, DM, scr, gw, NGW, lane);
      ph_transpose<0>(w_pg, nullptr, g_ple, DM, DM, WPG, DM, scr, gw, NGW, lane);
      ph_transpose<0>(w_pp, nullptr, nullptr, DPLE, DM, WPP, DM, scr, gw, NGW, lane);
      ph_rope(pos, ROPE, blockIdx.x * 512 + tid, gridDim.x * 512);
      for (int i = blockIdx.x * 512 + tid; i < 3 * MTOK; i += gridDim.x * 512) RS[i] = 0.f;
      ph_rmsnorm<false>(x, g_mix, H1, nullptr, gw, NGW, lane);
    }
    GRID_BAR();
    REP(1) { EpiInProj e{ws, b_f}; run_gemm(lds, H1, WIN, MTOK, N_INP, DM, e, wv); }
    GRID_BAR();
    REP(2) { IDS();
      if (gw >= NGW - 16) ph_cumsum(LOGF, CB, NGW - 1 - gw, lane);
      for (int it = blockIdx.x; it < 256; it += gridDim.x) { const int bb = it & 1, gi = it >> 1;
#pragma unroll 1
          for (int pass = 0; pass < 2; ++pass) idx::run_group(ws, (char*)lds_raw, (unsigned*)out + (size_t)blockIdx.x * 16 * T, bb, pass ? 255 - gi : gi, wv); }
      for (int i = blockIdx.x * 512 + tid; i < MTOK * DPLE / 4; i += gridDim.x * 512) st4h(P16 + 4 * (size_t)i, *((const f32x4*)p + i));
    }
    GRID_BAR();
    REP(3) for (int it = blockIdx.x; it < 256; it += gridDim.x) {
        const int item = (it & 7) * 32 + (it >> 3);
        if (item < 128) att::run_item<false>(item, ws, (char*)lds_raw, wv); else att::run_item<true>(item, ws, (char*)lds_raw, wv);
    }
    GRID_BAR();
    REP(4) { { EpiGate<true> e{SIGA, MIXED}; run_gemm(lds, OUTA, WOA, MTOK, DM, 1024, e, wv); }
    { EpiGate<false> e{SIGB, MIXED}; run_gemm(lds, OUTB, WOB, MTOK, DM, 1024, e, wv); } }
    GRID_BAR();
    REP(5) { EpiResidNorm e{x, out, H2, RS}; run_gemm(lds, MIXED, WOUT, MTOK, DM, DM, e, wv); }
    GRID_BAR();
    REP(6) { EpiSwiGLU e{ACT, RS}; run_gemm(lds, H2, WGU, MTOK, 2 * DFF, DM, e, wv); }
    GRID_BAR();
    { EpiResidNorm e{out, out, H2, RS + MTOK}; run_gemm(lds, ACT, WDN, MTOK, DM, DFF, e, wv); }
    GRID_BAR();
    { EpiStoreH e{PP, DM}; run_gemm(lds, P16, WPP, MTOK, DM, DPLE, e, wv); }
    { EpiPLE e{PP, out, RS + MTOK, RS + 2 * MTOK}; run_gemm(lds, H2, WPG, MTOK, DM, DM, e, wv); }
    GRID_BAR();
    { IDS(); ph_final(out, g_final, RS + 2 * MTOK, gw, NGW, lane); }
#undef IDS
#undef GRID_BAR
}

extern "C" void kernel_launch(void* const* d_in, const int* in_sizes, int n_in, void* d_out, int out_size, void* d_ws, size_t ws_size, hipStream_t stream) {
    if (n_in != 17 || out_size != MTOK * DM || ws_size < WS_END) { fprintf(stderr, "kernel_launch: unexpected shapes / workspace (%d inputs, out %d, ws %zu)\n", n_in, out_size, ws_size); return; }
    static int grid_blocks = 0;
    if (!grid_blocks) {
        int dev = 0, cus = 0, per_cu = 0;
        (void)hipGetDevice(&dev);
        (void)hipDeviceGetAttribute(&cus, hipDeviceAttributeMultiprocessorCount, dev);
        (void)hipFuncSetAttribute((const void*)mega_fwd, hipFuncAttributeMaxDynamicSharedMemorySize, LDS_BYTES);
        (void)hipOccupancyMaxActiveBlocksPerMultiprocessor(&per_cu, (const void*)mega_fwd, 512, LDS_BYTES);
        if (per_cu < 1) { fprintf(stderr, "kernel_launch: occupancy query says %d blocks per CU\n", per_cu); per_cu = 1; }
        if (per_cu > 1) per_cu = 1;
        grid_blocks = cus * per_cu;
    }
    (void)hipMemsetAsync((char*)d_ws + WS_CTL, 0, 64 * 1024, stream);
    Params prm{};
    for (int i = 0; i < 17; ++i) prm.in[i] = (const float*)d_in[i];
    prm.out = (float*)d_out; prm.ws = (unsigned char*)d_ws;
    void* args[] = {&prm};
    hipError_t e = hipLaunchCooperativeKernel((const void*)mega_fwd, dim3(grid_blocks), dim3(512), args, LDS_BYTES, stream);
    if (e != hipSuccess) fprintf(stderr, "cooperative launch failed: %s (grid %d)\n", hipGetErrorString(e), grid_blocks);
}
```

```cpp
#include <hip/hip_runtime.h>
#include <hip/hip_cooperative_groups.h>
#include <stdint.h>
#include <cstdio>

#define LAS __attribute__((address_space(3)))
typedef _Float16 h16;
typedef _Float16 h16x8 __attribute__((ext_vector_type(8)));
typedef _Float16 h16x4 __attribute__((ext_vector_type(4)));
typedef _Float16 h16x2 __attribute__((ext_vector_type(2)));
typedef float f32x4 __attribute__((ext_vector_type(4)));
typedef float f32x2 __attribute__((ext_vector_type(2)));
typedef unsigned u32x4 __attribute__((ext_vector_type(4)));
typedef unsigned u32x2 __attribute__((ext_vector_type(2)));
typedef unsigned long long u64;
__device__ __forceinline__ int lane_id() { int r; asm volatile("v_mbcnt_lo_u32_b32 %0, -1, 0\n\tv_mbcnt_hi_u32_b32 %0, -1, %0" : "=v"(r)); return r; }

constexpr int NBATCH = 2, T = 4096, MTOK = NBATCH * T, DM = 2048;
constexpr int HA = 8, HAKV = 2, HIDX = 16, DIDX = 64, HB = 8, HD = 128;
constexpr int N_IN = 9816, N_INP = 9984, DFF = 5632, DPLE = 256, TOPK = 256;
constexpr float EPS = 1e-6f;
constexpr float ATT_SCALE = 0.08838834764831845f;

constexpr size_t MiB = 1u << 20;
constexpr size_t WS_CTL = 0;
constexpr size_t WS_RS = 512 * 1024;
constexpr size_t WS_ROPE = 1 * MiB;
constexpr size_t WS_CB = 3 * MiB;
constexpr size_t WS_LOGF = 3 * MiB + 512 * 1024;
constexpr size_t WS_MASK = 4 * MiB;
constexpr size_t WS_WIN = 8 * MiB;
constexpr size_t WS_OUTA = 8 * MiB, WS_OUTB = 24 * MiB, WS_P16 = 40 * MiB;
constexpr size_t WS_WOA = 47 * MiB, WS_WOB = 51 * MiB, WS_WOUT = 55 * MiB, WS_WGU = 63 * MiB, WS_WDN = 107 * MiB, WS_WPG = 129 * MiB, WS_WPP = 137 * MiB;
constexpr size_t WS_QA = 138 * MiB, WS_KA = 154 * MiB, WS_VA = 158 * MiB, WS_QI = 162 * MiB, WS_KI = 178 * MiB, WS_WI = 179 * MiB;
constexpr size_t WS_QB = 180 * MiB, WS_KB = 196 * MiB, WS_VB = 212 * MiB, WS_SIGA = 228 * MiB, WS_SIGB = 260 * MiB, WS_NBQ = 292 * MiB, WS_END = 296 * MiB;
constexpr size_t WS_MIXED = WS_QB;
constexpr size_t WS_H2 = WS_QA;
constexpr size_t WS_ACT = WS_QB;
constexpr size_t WS_PP = WS_QB;

namespace pg8 {
constexpr int BM = 256, BK = 64, HALF = 128, HTB = HALF * BK * 2, STAGE_BYTES = 8 * HTB, NXCD = 8, WGM = 8;
__host__ __device__ __forceinline__ int lds_byte(int r, int c) { const int st = (r >> 4) * 2 + (c >> 5), rr = r & 15, cc = c & 31, ob = rr * 64 + cc * 2; return st * 1024 + (ob ^ (((ob >> 9) & 1) << 5)); }
__host__ __device__ __forceinline__ void stage_rc(int b, int& R, int& C) { const int st = b / 1024, sb = b % 1024, swz = sb ^ (((sb >> 9) & 1) << 5); R = (st >> 1) * 16 + swz / 64; C = (st & 1) * 32 + (swz % 64) / 2; }
struct Unit { int pm, pn; };
struct Gemm { const h16* A; const h16* Bt; int M, N, K; };
struct StaticOrder {
    int nM, nN, nwg, G, c;
    __host__ __device__ void init(int M, int N, int G_, int c_) { nM = M / BM; nN = N / BM; nwg = nM * nN; G = G_; c = c_; }
    __host__ __device__ bool next(int i, Unit& u) const {
        const long L = (long)i * G + c; if (L >= nwg) return false;
        int wgid = (int)L; { const int q = nwg / NXCD, r = nwg % NXCD, xcd = wgid % NXCD, off = wgid / NXCD; wgid = (xcd < r ? xcd * (q + 1) : r * (q + 1) + (xcd - r) * q) + off; }
        const int nig = WGM * nN, gid = wgid / nig, fm = gid * WGM, gsz = (nM - fm) < WGM ? (nM - fm) : WGM;
        u.pm = fm + ((wgid % nig) % gsz); u.pn = (wgid % nig) / gsz; return true;
    }
};
template <class Epi>
__device__ __forceinline__ void gemm_phase(LAS unsigned char* lds, const Gemm g, const StaticOrder& S, const Epi& E, int wv) {
    int tid = wv * 64 + lane_id(); asm volatile("" : "+v"(tid));
    const int wid = __builtin_amdgcn_readfirstlane(tid >> 6), lane = tid & 63, wr = wid >> 2, wc = wid & 3, fr = lane & 15, fq = lane >> 4;
    const int K = g.K, nt = K / BK;
    unsigned voffA[2];
#pragma unroll
    for (int i = 0; i < 2; ++i) { int R, C; stage_rc(tid * 16 + i * 8192, R, C); voffA[i] = (unsigned)(R * K + C) * 2u; }
    const size_t kstep = (size_t)(BK * 2);
    const size_t hstep = (size_t)HALF * K * 2;
    const size_t tstep = 2 * hstep;
    const unsigned ldsw = (unsigned)wid * 1024u;
    const int aoff = lds_byte(wr * 64 + fr, fq * 8), boff = lds_byte(wc * 32 + fr, fq * 8);
#define PG8_SA(b, h) (((b) * 2 + (h)) * HTB)
#define PG8_SB(b, h) ((4 + (b) * 2 + (h)) * HTB)
#define PG8_STAGE(bufoff, gbase) do { _Pragma("unroll") for (int _i = 0; _i < 2; ++_i) \
        __builtin_amdgcn_global_load_lds((const unsigned*)((const char*)(gbase) + voffA[_i]), (LAS unsigned*)(lds + (bufoff) + ldsw + _i * 8192), 16, 0, 0); } while (0)
#define PG8_LDA(dst, b, h) do { _Pragma("unroll") for (int m = 0; m < 4; ++m) _Pragma("unroll") for (int k = 0; k < 2; ++k) dst[m][k] = *(const LAS h16x8*)(lds + PG8_SA(b, h) + aoff + m * 2048 + k * 1024); } while (0)
#define PG8_LDB(dst, b, h) do { _Pragma("unroll") for (int n = 0; n < 2; ++n) _Pragma("unroll") for (int k = 0; k < 2; ++k) dst[n][k] = *(const LAS h16x8*)(lds + PG8_SB(b, h) + boff + n * 2048 + k * 1024); } while (0)
#define PG8_MMA(ai, bj, At, Bt) do { __builtin_amdgcn_s_setprio(1); _Pragma("unroll") for (int m = 0; m < 4; ++m) _Pragma("unroll") for (int n = 0; n < 2; ++n) _Pragma("unroll") for (int k = 0; k < 2; ++k) \
        acc[ai][bj][m][n] = __builtin_amdgcn_mfma_f32_16x16x32_f16(Bt[n][k], At[m][k], acc[ai][bj][m][n], 0, 0, 0); __builtin_amdgcn_s_setprio(0); } while (0)
#define PG8_WAIT_V(n) asm volatile("s_waitcnt vmcnt(" #n ")" ::: "memory")
#define PG8_WAIT_L(n) asm volatile("s_waitcnt lgkmcnt(" #n ")" ::: "memory")
#define PG8_BAR __builtin_amdgcn_s_barrier()
#define PG8_SCHED __builtin_amdgcn_sched_barrier(0)
    Unit cur, nxt; int ui = 0;
    if (!S.next(0, cur)) return;
    f32x4 acc[2][2][4][2];
#pragma unroll
    for (int a = 0; a < 2; ++a)
#pragma unroll
        for (int b = 0; b < 2; ++b)
#pragma unroll
            for (int m = 0; m < 4; ++m)
#pragma unroll
                for (int n = 0; n < 2; ++n) acc[a][b][m][n] = (f32x4){0.f, 0.f, 0.f, 0.f};
    h16x8 At[4][2], B0[2][2], B1[2][2];
    const char* cA = (const char*)g.A + (size_t)cur.pm * tstep; const char* cB = (const char*)g.Bt + (size_t)cur.pn * tstep;
    PG8_STAGE(PG8_SB(0, 0), cB); PG8_STAGE(PG8_SA(0, 0), cA); PG8_STAGE(PG8_SB(0, 1), cB + hstep); PG8_STAGE(PG8_SA(0, 1), cA + hstep);
    if (wr == 1) PG8_BAR;
    PG8_WAIT_V(4); PG8_BAR;
    PG8_STAGE(PG8_SB(1, 0), cB + kstep); PG8_STAGE(PG8_SA(1, 0), cA + kstep); PG8_STAGE(PG8_SB(1, 1), cB + hstep + kstep);
    PG8_WAIT_V(6); PG8_BAR;
    for (;;) {
        const bool has_next = S.next(ui + 1, nxt);
        const char* nA = has_next ? (const char*)g.A + (size_t)nxt.pm * tstep : cA; const char* nB = has_next ? (const char*)g.Bt + (size_t)nxt.pn * tstep : cB;
        for (int t = 0; t < nt; t += 2) {
            const bool last = (t == nt - 2);
            const char* a1 = cA + (size_t)(t + 1) * kstep;
            const char* a2 = last ? nA : cA + (size_t)(t + 2) * kstep; const char* b2 = last ? nB : cB + (size_t)(t + 2) * kstep;
            const char* a3 = a2 + kstep; const char* b3 = b2 + kstep;
            PG8_LDB(B0, 0, 0); PG8_SCHED; PG8_LDA(At, 0, 0); PG8_STAGE(PG8_SA(1, 1), a1 + hstep);
            PG8_WAIT_L(8); PG8_BAR; PG8_WAIT_L(0); PG8_MMA(0, 0, At, B0); PG8_BAR; PG8_SCHED;
            PG8_LDB(B1, 0, 1); PG8_STAGE(PG8_SB(0, 0), b2);
            PG8_BAR; PG8_WAIT_L(0); PG8_MMA(0, 1, At, B1); PG8_BAR;
            PG8_LDA(At, 0, 1); PG8_STAGE(PG8_SA(0, 0), a2);
            PG8_BAR; PG8_WAIT_L(0); PG8_MMA(1, 0, At, B0); PG8_BAR; PG8_SCHED;
            PG8_STAGE(PG8_SB(0, 1), b2 + hstep);
            PG8_WAIT_V(6); PG8_BAR; PG8_MMA(1, 1, At, B1); PG8_BAR;
            PG8_LDB(B0, 1, 0); PG8_SCHED; PG8_LDA(At, 1, 0); PG8_STAGE(PG8_SA(0, 1), a2 + hstep);
            PG8_WAIT_L(8); PG8_BAR; PG8_WAIT_L(0); PG8_MMA(0, 0, At, B0); PG8_BAR; PG8_SCHED;
            PG8_LDB(B1, 1, 1); PG8_STAGE(PG8_SB(1, 0), b3);
            PG8_BAR; PG8_WAIT_L(0); PG8_MMA(0, 1, At, B1); PG8_BAR;
            PG8_LDA(At, 1, 1); PG8_STAGE(PG8_SA(1, 0), a3);
            PG8_BAR; PG8_WAIT_L(0); PG8_MMA(1, 0, At, B0); PG8_BAR; PG8_SCHED;
            PG8_STAGE(PG8_SB(1, 1), b3 + hstep);
            PG8_WAIT_V(6); PG8_BAR; PG8_MMA(1, 1, At, B1); PG8_BAR;
        }
        E(acc, cur, wr, wc, fr, fq);
        if (!has_next) break;
#pragma unroll
        for (int a = 0; a < 2; ++a)
#pragma unroll
            for (int b = 0; b < 2; ++b)
#pragma unroll
                for (int m = 0; m < 4; ++m)
#pragma unroll
                    for (int n = 0; n < 2; ++n) acc[a][b][m][n] = (f32x4){0.f, 0.f, 0.f, 0.f};
        cur = nxt; cA = nA; cB = nB; ++ui;
    }
    PG8_WAIT_V(0);
    if (wr == 0) PG8_BAR;
    PG8_BAR;
#undef PG8_SA
#undef PG8_SB
#undef PG8_STAGE
#undef PG8_LDA
#undef PG8_LDB
#undef PG8_MMA
#undef PG8_WAIT_V
#undef PG8_WAIT_L
#undef PG8_BAR
#undef PG8_SCHED
}
}
using pg8::Unit;
typedef f32x4 Acc[2][2][4][2];

__device__ __forceinline__ void st4h(h16* p, f32x4 v) { h16x4 o; o[0] = (h16)v[0]; o[1] = (h16)v[1]; o[2] = (h16)v[2]; o[3] = (h16)v[3]; *(h16x4*)p = o; }
__device__ __forceinline__ f32x4 ld4h(const h16* p) { const h16x4 o = *(const h16x4*)p; return (f32x4){(float)o[0], (float)o[1], (float)o[2], (float)o[3]}; }
__device__ __forceinline__ float sigmoidf_(float x) { return __builtin_amdgcn_rcpf(1.0f + __expf(-x)); }
__device__ __forceinline__ float logsigmoidf_(float z) { return fminf(z, 0.f) - __logf(1.0f + __expf(-fabsf(z))); }
__device__ __forceinline__ float wave_sum(float v) {
#pragma unroll
    for (int o = 1; o < 64; o <<= 1) v += __shfl_xor(v, o);
    return v;
}

struct EpiInProj {
    unsigned char* ws; const float* b_f;
    __device__ __forceinline__ void operator()(const Acc& acc, const Unit& u, int wr, int wc, int fr, int fq) const {
        const int pn = u.pn, row0 = u.pm * 256 + wr * 64 + fr;
        const float* ROPE = (const float*)(ws + WS_ROPE);
#pragma unroll
        for (int ai = 0; ai < 2; ++ai)
#pragma unroll
            for (int m = 0; m < 4; ++m) {
                const int row = row0 + ai * 128 + m * 16, b = row >> 12, t = row & 4095;
                const float* rp = ROPE + (size_t)row * 48;
#pragma unroll
                for (int bj = 0; bj < 2; ++bj) {
                    f32x4 v0 = acc[ai][bj][m][0], v1 = acc[ai][bj][m][1];
                    const int d0 = 32 * wc + 4 * fq;
                    if (pn < 6) {
                        size_t off;
                        if (pn < 4) off = WS_QA + (((size_t)(b * HA + pn * 2 + bj) * T + t) * HD) * 2;
                        else off = (pn == 4 ? WS_KA : WS_VA) + (((size_t)(b * HAKV + bj) * T + t) * HD) * 2;
                        h16* dst = (h16*)(ws + off);
                        if (pn < 5 && wc == 0) {
                            const f32x4 c = *(const f32x4*)(rp + 4 * fq), s = *(const f32x4*)(rp + 16 + 4 * fq);
                            const f32x4 y0 = v0 * c - v1 * s, y1 = v1 * c + v0 * s; v0 = y0; v1 = y1;
                        }
                        st4h(dst + d0, v0); st4h(dst + d0 + 16, v1);
                    } else if (pn < 11) {
                        const bool is_q = pn < 10;
                        if (is_q || bj == 0) {
                            if (is_q || wc < 2) {
                                const int dd = 32 * (wc & 1) + 4 * fq;
                                const size_t off = is_q ? WS_QI + ((size_t)row * 1024 + ((pn - 6) * 4 + 2 * bj + (wc >> 1)) * 64) * 2 : WS_KI + ((size_t)row * 64) * 2;
                                h16* dst = (h16*)(ws + off);
                                if ((wc & 1) == 0) {
                                    f32x4 pr;
#pragma unroll
                                    for (int j = 0; j < 4; ++j) pr[j] = __shfl_xor(v0[j], 32);
                                    const f32x4 c = *(const f32x4*)(rp + 32 + 4 * (fq & 1)), s = *(const f32x4*)(rp + 40 + 4 * (fq & 1));
                                    v0 = (fq < 2) ? (v0 * c - pr * s) : (v0 * c + pr * s);
                                }
                                st4h(dst + dd, v0); st4h(dst + dd + 16, v1);
                            } else if (wc == 2) {
                                *(f32x4*)((float*)(ws + WS_WI) + (size_t)row * 16 + 4 * fq) = v0 * 0.03125f;
                                if (fq < 2) { const f32x4 bf = *(const f32x4*)(b_f + 4 * fq); f32x4 o;
#pragma unroll
                                    for (int j = 0; j < 4; ++j) o[j] = logsigmoidf_(v1[j] + bf[j]);
                                    *(f32x4*)((float*)(ws + WS_LOGF) + (size_t)row * 8 + 4 * fq) = o; }
                            }
                        }
                    } else if (pn < 23) {
                        const int q = pn - 11, which = q >> 2, head = (q & 3) * 2 + bj;
                        h16* dst = (h16*)(ws + WS_QB + (size_t)which * (WS_KB - WS_QB)) + ((size_t)(b * HB + head) * T + t) * HD;
                        st4h(dst + d0, v0); st4h(dst + d0 + 16, v1);
                    } else {
                        const int q = pn - 23; const int col = (q & 7) * 256 + 128 * bj + d0;
                        h16* base = (h16*)(ws + WS_SIGA + (size_t)(q >> 3) * (WS_SIGB - WS_SIGA));
#pragma unroll
                        for (int j = 0; j < 4; ++j) { v0[j] = sigmoidf_(v0[j]); v1[j] = sigmoidf_(v1[j]); }
                        st4h(base + (size_t)row * DM + col, v0); st4h(base + (size_t)row * DM + col + 16, v1);
                    }
                }
            }
    }
};
static_assert(WS_VB - WS_KB == WS_KB - WS_QB, "QB/KB/VB equally spaced");
template <bool FIRST> struct EpiGate {
    const h16* SIG; h16* MIXED;
    __device__ __forceinline__ void operator()(const Acc& acc, const Unit& u, int wr, int wc, int fr, int fq) const {
        const int row0 = u.pm * 256 + wr * 64 + fr, col0 = u.pn * 256 + 32 * wc + 4 * fq;
#pragma unroll
        for (int ai = 0; ai < 2; ++ai)
#pragma unroll
            for (int m = 0; m < 4; ++m)
#pragma unroll
                for (int bj = 0; bj < 2; ++bj)
#pragma unroll
                    for (int n = 0; n < 2; ++n) { const size_t off = (size_t)(row0 + ai * 128 + m * 16) * DM + col0 + bj * 128 + n * 16;
                        f32x4 v = ld4h(SIG + off) * acc[ai][bj][m][n]; if (!FIRST) v += ld4h(MIXED + off); st4h(MIXED + off, v); }
    }
};
__device__ __forceinline__ float sumsq4(f32x4 v) { return (v[0] * v[0] + v[1] * v[1]) + (v[2] * v[2] + v[3] * v[3]); }
struct EpiResidNorm {
    const float* BASE; float* OUT; h16* XH; float* RS;
    __device__ __forceinline__ void operator()(const Acc& acc, const Unit& u, int wr, int wc, int fr, int fq) const {
        const int row0 = u.pm * 256 + wr * 64 + fr, col0 = u.pn * 256 + 32 * wc + 4 * fq;
#pragma unroll
        for (int ai = 0; ai < 2; ++ai)
#pragma unroll
            for (int m = 0; m < 4; ++m) { const int row = row0 + ai * 128 + m * 16; float ss = 0.f;
#pragma unroll
                for (int bj = 0; bj < 2; ++bj)
#pragma unroll
                    for (int n = 0; n < 2; ++n) { const size_t off = (size_t)row * DM + col0 + bj * 128 + n * 16;
                        const f32x4 v = *(const f32x4*)(BASE + off) + acc[ai][bj][m][n]; *(f32x4*)(OUT + off) = v; st4h(XH + off, v); ss += sumsq4(v); }
                ss += __shfl_xor(ss, 16); ss += __shfl_xor(ss, 32);
                if (fq == 0) atomicAdd(RS + row, ss); }
    }
};
struct EpiSwiGLU {
    h16* ACT; const float* RS;
    __device__ __forceinline__ void operator()(const Acc& acc, const Unit& u, int wr, int wc, int fr, int fq) const {
        const int row0 = u.pm * 256 + wr * 64 + fr;
#pragma unroll
        for (int ai = 0; ai < 2; ++ai)
#pragma unroll
            for (int m = 0; m < 4; ++m) { const int row = row0 + ai * 128 + m * 16; const float r = __builtin_amdgcn_rsqf(RS[row] * (1.0f / DM) + EPS);
#pragma unroll
                for (int bj = 0; bj < 2; ++bj) { const f32x4 g = acc[ai][bj][m][0] * r, uu = acc[ai][bj][m][1] * r; f32x4 o;
#pragma unroll
                    for (int j = 0; j < 4; ++j) o[j] = g[j] * sigmoidf_(g[j]) * uu[j];
                    st4h(ACT + (size_t)row * DFF + 16 * (u.pn * 8 + bj * 4 + wc) + 4 * fq, o); } }
    }
};
struct EpiStoreH {
    h16* O; int ldc;
    __device__ __forceinline__ void operator()(const Acc& acc, const Unit& u, int wr, int wc, int fr, int fq) const {
        const int row0 = u.pm * 256 + wr * 64 + fr, col0 = u.pn * 256 + 32 * wc + 4 * fq;
#pragma unroll
        for (int ai = 0; ai < 2; ++ai)
#pragma unroll
            for (int m = 0; m < 4; ++m)
#pragma unroll
                for (int bj = 0; bj < 2; ++bj)
#pragma unroll
                    for (int n = 0; n < 2; ++n) st4h(O + (size_t)(row0 + ai * 128 + m * 16) * ldc + col0 + bj * 128 + n * 16, acc[ai][bj][m][n]);
    }
};
struct EpiPLE {
    const h16* PP; float* X; const float* RSIN; float* RSOUT;
    __device__ __forceinline__ void operator()(const Acc& acc, const Unit& u, int wr, int wc, int fr, int fq) const {
        const int row0 = u.pm * 256 + wr * 64 + fr, col0 = u.pn * 256 + 32 * wc + 4 * fq;
#pragma unroll
        for (int ai = 0; ai < 2; ++ai)
#pragma unroll
            for (int m = 0; m < 4; ++m) { const int row = row0 + ai * 128 + m * 16; const float r = __builtin_amdgcn_rsqf(RSIN[row] * (1.0f / DM) + EPS); float ss = 0.f;
#pragma unroll
                for (int bj = 0; bj < 2; ++bj)
#pragma unroll
                    for (int n = 0; n < 2; ++n) { const size_t off = (size_t)row * DM + col0 + bj * 128 + n * 16;
                        const f32x4 a = acc[ai][bj][m][n] * r, pp = ld4h(PP + off); f32x4 x = *(const f32x4*)(X + off);
#pragma unroll
                        for (int j = 0; j < 4; ++j) x[j] += sigmoidf_(a[j]) * pp[j];
                        *(f32x4*)(X + off) = x; ss += sumsq4(x); }
                ss += __shfl_xor(ss, 16); ss += __shfl_xor(ss, 32);
                if (fq == 0) atomicAdd(RSOUT + row, ss); }
    }
};

__device__ __forceinline__ int map_in(int p) {
    if (p < 2560) return p;
    if (p < 2816) { const int c = p - 2560; if (c < 64) return 2560 + c; if (c < 80) return 2624 + (c - 64); if (c < 88) return 5712 + (c - 80); return -1; }
    const int q = p - 2816; if (q < 3072) return 2640 + q; return 5720 + (q - 3072);
}
template <int MODE>
__device__ __forceinline__ const float* tr_src(const float* W0, const float* W1, int Nsrc, int n) {
    if (MODE == 0) return n < Nsrc ? W0 + n : nullptr;
    if (MODE == 1) { const int c = map_in(n); return c >= 0 ? W0 + c : nullptr; }
    return (((n >> 4) & 1) ? W1 : W0) + 16 * (n >> 5) + (n & 15);
}
template <int MODE>
__device__ __forceinline__ void ph_transpose(const float* W0, const float* W1, const float* gk, int K, int Nsrc, h16* WT, int Nphys, LAS float* scr, int gw, int NGW, int lane) {
    const int nblk = Nphys / 32, nitems = (K / 64) * nblk;
    const int lr = lane >> 3, lc = (lane & 7) * 4;
    f32x4 cur[8], nxt[8];
    int item = gw;
    if (item < nitems) { const int kb = item / nblk, nb = item % nblk; const float* src = tr_src<MODE>(W0, W1, Nsrc, 32 * nb + lc);
#pragma unroll
        for (int i = 0; i < 8; ++i) cur[i] = src ? *(const f32x4*)(src + (size_t)(64 * kb + lr + 8 * i) * Nsrc) : (f32x4){0.f, 0.f, 0.f, 0.f}; }
    for (; item < nitems; item += NGW) {
        const int kb = item / nblk, nb = item % nblk, k0 = 64 * kb, n0 = 32 * nb;
        const int itn = item + NGW;
        if (itn < nitems) { const int kbn = itn / nblk, nbn = itn % nblk; const float* src = tr_src<MODE>(W0, W1, Nsrc, 32 * nbn + lc);
#pragma unroll
            for (int i = 0; i < 8; ++i) nxt[i] = src ? *(const f32x4*)(src + (size_t)(64 * kbn + lr + 8 * i) * Nsrc) : (f32x4){0.f, 0.f, 0.f, 0.f}; }
#pragma unroll
        for (int i = 0; i < 8; ++i) { LAS float* d = scr + (lr + 8 * i) * 33 + lc; const float gg = gk ? gk[k0 + lr + 8 * i] : 1.0f; d[0] = cur[i][0] * gg; d[1] = cur[i][1] * gg; d[2] = cur[i][2] * gg; d[3] = cur[i][3] * gg; }
        __builtin_amdgcn_wave_barrier(); asm volatile("s_waitcnt lgkmcnt(0)" ::: "memory");
        const int c = lane & 7;
#pragma unroll
        for (int j = 0; j < 4; ++j) { const int nn = (lane >> 3) + 8 * j; const LAS float* sp = scr + (8 * c) * 33 + nn;
            h16x8 o;
#pragma unroll
            for (int e = 0; e < 8; ++e) o[e] = (h16)sp[e * 33];
            *(h16x8*)(WT + (size_t)(n0 + nn) * K + k0 + 8 * c) = o; }
        __builtin_amdgcn_wave_barrier(); asm volatile("s_waitcnt lgkmcnt(0)" ::: "memory");
#pragma unroll
        for (int i = 0; i < 8; ++i) cur[i] = nxt[i];
    }
}
__device__ __forceinline__ void sincos_f32arg(float ang, float& sn, float& cs) {
    const double a = (double)ang;
    const double rev = a * 0.15915494309189535;
    const double fr = rev - __builtin_rint(rev);
    const double q4 = fr * 4.0; const double qi = __builtin_rint(q4); const int qq = ((int)qi) & 3;
    const double r = (q4 - qi) * 1.5707963267948966;
    const double r2 = r * r;
    const double s = r * (1.0 + r2 * (-1.0 / 6 + r2 * (1.0 / 120 + r2 * (-1.0 / 5040 + r2 * (1.0 / 362880 + r2 * (-1.0 / 39916800))))));
    const double c = 1.0 + r2 * (-0.5 + r2 * (1.0 / 24 + r2 * (-1.0 / 720 + r2 * (1.0 / 40320 + r2 * (-1.0 / 3628800 + r2 * (1.0 / 479001600))))));
    double so, co;
    if (qq == 0) { so = s; co = c; } else if (qq == 1) { so = c; co = -s; } else if (qq == 2) { so = -s; co = -c; } else { so = -c; co = s; }
    sn = (float)so; cs = (float)co;
}
__device__ __forceinline__ void ph_rope(const int* pos, float* ROPE, int gtid, int NGT) {
    for (int idx = gtid; idx < MTOK * 24; idx += NGT) {
        const int tok = idx / 24, i = idx % 24, k = i < 16 ? i : 2 * (i - 16);
        float f = 0x1.000000p+0f;
        f = k == 1 ? 0x1.c2ef76p-2f : f; f = k == 2 ? 0x1.8d275ep-3f : f; f = k == 3 ? 0x1.5dc95ap-4f : f; f = k == 4 ? 0x1.341190p-5f : f; f = k == 5 ? 0x1.0f5384p-6f : f;
        f = k == 6 ? 0x1.ddee9cp-8f : f; f = k == 7 ? 0x1.a4ee3ep-9f : f; f = k == 8 ? 0x1.72ba44p-10f : f; f = k == 9 ? 0x1.468318p-11f : f; f = k == 10 ? 0x1.1f91f0p-12f : f;
        f = k == 11 ? 0x1.fa8b84p-14f : f; f = k == 12 ? 0x1.be218ap-15f : f; f = k == 13 ? 0x1.88ec22p-16f : f; f = k == 14 ? 0x1.5a0f50p-17f : f; f = k == 15 ? 0x1.30c94ep-18f : f;
        const float ang = (float)pos[tok] * f;
        float sn, cs; sincos_f32arg(ang, sn, cs);
        float* rp = ROPE + (size_t)tok * 48;
        if (i < 16) { rp[i] = cs; rp[16 + i] = sn; } else { rp[32 + (i - 16)] = cs; rp[40 + (i - 16)] = sn; }
    }
}
template <bool TO_F32>
__device__ __forceinline__ void ph_rmsnorm(const float* X, const float* g, h16* OUTH, float* OUTF, int gw, int NGW, int lane) {
    for (int row = gw; row < MTOK; row += NGW) {
        const f32x4* xr = (const f32x4*)(X + (size_t)row * DM) + lane;
        f32x4 v[8]; float s = 0.f;
#pragma unroll
        for (int j = 0; j < 8; ++j) { v[j] = xr[64 * j]; s += (v[j][0] * v[j][0] + v[j][1] * v[j][1]) + (v[j][2] * v[j][2] + v[j][3] * v[j][3]); }
        const float r = 1.0f / sqrtf(wave_sum(s) * (1.0f / DM) + EPS);
#pragma unroll
        for (int j = 0; j < 8; ++j) { const f32x4 gg = *((const f32x4*)g + lane + 64 * j); const f32x4 o = v[j] * r * gg;
            if (TO_F32) *((f32x4*)(OUTF + (size_t)row * DM) + lane + 64 * j) = o; else st4h(OUTH + (size_t)row * DM + 4 * (lane + 64 * j), o); }
    }
}
__device__ __forceinline__ void ph_final(float* X, const float* g, const float* RS, int gw, int NGW, int lane) {
    for (int row = gw; row < MTOK; row += NGW) {
        f32x4* xr = (f32x4*)(X + (size_t)row * DM) + lane; const float r = __builtin_amdgcn_rsqf(RS[row] * (1.0f / DM) + EPS);
        f32x4 v[8];
#pragma unroll
        for (int j = 0; j < 8; ++j) v[j] = xr[64 * j];
#pragma unroll
        for (int j = 0; j < 8; ++j) xr[64 * j] = v[j] * r * *((const f32x4*)g + lane + 64 * j);
    }
}
__device__ __forceinline__ void ph_cumsum(const float* LOGF, float* CBS, int bh, int lane) {
    const int b = bh >> 3, h = bh & 7;
    float v[64];
#pragma unroll
    for (int it = 0; it < 64; ++it) v[it] = LOGF[(size_t)(b * T + it * 64 + lane) * 8 + h];
    float run = 0.f;
#pragma unroll
    for (int it = 0; it < 64; ++it) {
        float x = v[it];
#pragma unroll
        for (int o = 1; o < 64; o <<= 1) { const float nb = __shfl_up(x, o); if (lane >= o) x += nb; }
        CBS[(size_t)bh * T + it * 64 + lane] = (run + x) * -11.313708498984761f;
        run += __shfl(x, 63);
    }
}

__device__ __forceinline__ unsigned fkey(float f) { const unsigned u = __float_as_uint(f + 0.0f); return (u & 0x80000000u) ? ~u : (u | 0x80000000u); }
__device__ __forceinline__ unsigned count_ge(const unsigned (&key)[64], unsigned th, int nj) {
    unsigned c = 0;
#pragma unroll
    for (int j8 = 0; j8 < 8; ++j8) {
        if (8 * j8 < nj) {
#pragma unroll
            for (int j = 8 * j8; j < 8 * j8 + 8; ++j) c += (key[j] >= th) ? 1u : 0u;
        }
    }
#pragma unroll
    for (int o = 1; o < 64; o <<= 1) c += __shfl_xor(c, o);
    return c;
}
__device__ __forceinline__ u64 topk_select(const unsigned (&key)[64], int nvalid, int lane) {
    u64 myword = 0;
    if (nvalid <= TOPK) {
#pragma unroll
        for (int j = 0; j < 64; ++j) { const u64 bal = __ballot(key[j] != 0u); if (lane == j) myword = bal; }
    } else {
        unsigned th = 0u; bool exact = false;
        for (int bit = 31; bit >= 0; --bit) { const unsigned tc = th | (1u << bit); const unsigned c = count_ge(key, tc, (nvalid + 63) >> 6); if (c >= (unsigned)TOPK) th = tc; if (c == (unsigned)TOPK) { exact = true; break; } }
        if (exact) {
#pragma unroll
            for (int j = 0; j < 64; ++j) { const u64 bal = __ballot(key[j] >= th); if (lane == j) myword = bal; }
        } else {
            unsigned cgt = 0;
#pragma unroll
            for (int j = 0; j < 64; ++j) cgt += (unsigned)__builtin_popcountll(__ballot(key[j] > th));
            int need = TOPK - (int)cgt;
#pragma unroll
            for (int j = 0; j < 64; ++j) { u64 eq = __ballot(key[j] == th); const u64 gt = __ballot(key[j] > th);
                int pc = __builtin_popcountll(eq);
                while (pc > need) { eq &= ~(1ull << (63 - __builtin_clzll(eq))); --pc; }
                need -= pc; if (lane == j) myword = gt | eq; }
        }
    }
    return myword;
}
template <int LVL>
__device__ __forceinline__ void hist_level(const unsigned (&key)[64], int nj, int lane, LAS unsigned* hist, unsigned& prefix, unsigned& need, unsigned& cnt_eq) {
    constexpr int SH = LVL == 0 ? 21 : (LVL == 1 ? 10 : 0), PSH = LVL == 1 ? 21 : 10, NB = LVL == 2 ? 10 : 11;
#pragma unroll
    for (int i = 0; i < 8; ++i) *(LAS u32x4*)(hist + lane * 32 + 4 * i) = (u32x4){0u, 0u, 0u, 0u};
    asm volatile("s_waitcnt lgkmcnt(0)" ::: "memory"); __builtin_amdgcn_wave_barrier();
#pragma unroll
    for (int j8 = 0; j8 < 8; ++j8) {
        if (8 * j8 < nj) {
            if (LVL == 0) {
#pragma unroll
                for (int j = 8 * j8; j < 8 * j8 + 8; ++j) __hip_atomic_fetch_add(hist + (key[j] >> 21), 1u, __ATOMIC_RELAXED, __HIP_MEMORY_SCOPE_WORKGROUP);
            } else {
                bool any = false;
#pragma unroll
                for (int j = 8 * j8; j < 8 * j8 + 8; ++j) any = any || ((key[j] >> PSH) == prefix);
                if (LVL == 1 || __any(any)) {
#pragma unroll
                    for (int j = 8 * j8; j < 8 * j8 + 8; ++j) { const unsigned k = key[j];
                        if ((k >> PSH) == prefix) __hip_atomic_fetch_add(hist + ((k >> SH) & ((1u << NB) - 1u)), 1u, __ATOMIC_RELAXED, __HIP_MEMORY_SCOPE_WORKGROUP); }
                }
            }
        }
    }
    asm volatile("s_waitcnt lgkmcnt(0)" ::: "memory"); __builtin_amdgcn_wave_barrier();
    unsigned s = 0;
#pragma unroll
    for (int i = 0; i < 8; ++i) { const u32x4 v = *(const LAS u32x4*)(hist + lane * 32 + 4 * i); s += (v[0] + v[1]) + (v[2] + v[3]); }
    unsigned S = s;
#pragma unroll
    for (int o = 1; o < 64; o <<= 1) { const unsigned nb = __shfl_down(S, o); if (lane + o < 64) S += nb; }
    const int L = 63 - __builtin_clzll(__ballot(S >= need));
    const unsigned aboveL = __shfl(S - s, L);
    const int bi = lane & 31;
    const unsigned hb = hist[L * 32 + bi];
    unsigned R = hb;
#pragma unroll
    for (int o = 1; o < 32; o <<= 1) { const unsigned nb = __shfl_down(R, o); if (bi + o < 32) R += nb; }
    const int B = 31 - __builtin_clz((unsigned)__ballot(aboveL + R >= need));
    const unsigned abB = __shfl(aboveL + R - hb, B);
    cnt_eq = __shfl(hb, B);
    prefix = (prefix << NB) | (unsigned)(L * 32 + B);
    need -= abB;
    __builtin_amdgcn_wave_barrier();
}
__device__ __forceinline__ u64 topk_select_hist(const unsigned (&key)[64], int nvalid, int lane, LAS unsigned* hist) {
    const int nj = (nvalid + 63) >> 6;
    unsigned prefix = 0, need = TOPK, cnt_eq = 0;
    hist_level<0>(key, nj, lane, hist, prefix, need, cnt_eq);
    hist_level<1>(key, nj, lane, hist, prefix, need, cnt_eq);
    hist_level<2>(key, nj, lane, hist, prefix, need, cnt_eq);
    u64 mw = 0;
    if (need == cnt_eq) {
#pragma unroll
        for (int j = 0; j < 64; ++j) { const u64 bal = __ballot(key[j] >= prefix); if (lane == j) mw = bal; }
    } else {
        int nd = (int)need;
#pragma unroll
        for (int j = 0; j < 64; ++j) { u64 eq = __ballot(key[j] == prefix); const u64 gt = __ballot(key[j] > prefix);
            int pc = __builtin_popcountll(eq);
            while (pc > nd) { eq &= ~(1ull << (63 - __builtin_clzll(eq))); --pc; }
            nd -= pc; if (lane == j) mw = gt | eq; }
    }
    return mw;
}
__device__ __forceinline__ void ph_topk_naive(const h16* QI, const h16* KI, const float* WI, u64* MASK, LAS float* qs, LAS unsigned* ks, int gw, int NGW, int lane) {
    for (int row = gw; row < MTOK; row += NGW) {
        const int b = row >> 12, t = row & 4095;
        { const h16* qp = QI + (size_t)row * 1024 + lane * 16;
#pragma unroll
          for (int i = 0; i < 16; ++i) qs[lane * 16 + i] = (float)qp[i]; }
        if (lane < 16) qs[1024 + lane] = WI[(size_t)row * 16 + lane];
        __builtin_amdgcn_wave_barrier(); asm volatile("s_waitcnt lgkmcnt(0)" ::: "memory");
#pragma unroll 1
        for (int j = 0; j < 64; ++j) {
            unsigned kk = 0u;
            const int s = 64 * j + lane;
            if (s <= t) {
                float kf[64];
                const h16x8* kp = (const h16x8*)(KI + (size_t)(b * T + s) * 64);
#pragma unroll
                for (int c = 0; c < 8; ++c) { const h16x8 kv = kp[c];
#pragma unroll
                    for (int e = 0; e < 8; ++e) kf[c * 8 + e] = (float)kv[e]; }
                float sc = 0.f;
#pragma unroll 1
                for (int h = 0; h < 16; ++h) { float d = 0.f;
#pragma unroll
                    for (int e = 0; e < 64; ++e) d = fmaf(qs[h * 64 + e], kf[e], d);
                    sc = fmaf(qs[1024 + h], fmaxf(d, 0.f), sc); }
                kk = fkey(sc);
            }
            ks[j * 64 + lane] = kk;
        }
        __builtin_amdgcn_wave_barrier(); asm volatile("s_waitcnt lgkmcnt(0)" ::: "memory");
        unsigned key[64];
#pragma unroll
        for (int j = 0; j < 64; ++j) key[j] = ks[j * 64 + lane];
        MASK[(size_t)row * 64 + lane] = topk_select(key, t + 1, lane);
        __builtin_amdgcn_wave_barrier(); asm volatile("s_waitcnt lgkmcnt(0)" ::: "memory");
    }
}


namespace idx {
typedef short s16x8 __attribute__((ext_vector_type(8)));
typedef float f32x16 __attribute__((ext_vector_type(16)));
constexpr int CHK = 128, CHB = CHK * 128;
__device__ __forceinline__ unsigned half_sum(unsigned v) {
#pragma unroll
    for (int o = 1; o < 32; o <<= 1) v += __shfl_xor(v, o);
    return v;
}
__device__ __forceinline__ void run_group(unsigned char* ws, char* lds, unsigned* scr, int b, int g, int wv) {
    int tid = wv * 64 + lane_id(); asm volatile("" : "+v"(tid));
    const int wid = __builtin_amdgcn_readfirstlane(tid >> 6), lane = tid & 63, c = lane & 31, hi = lane >> 5;
    const int t0 = 16 * g + 2 * wid, t = t0 + hi, row = b * T + t, tmaxblk = 16 * g + 15, nch = (tmaxblk >> 7) + 1;
    const h16* QI = (const h16*)(ws + WS_QI); const char* KIb = (const char*)ws + WS_KI + (size_t)b * T * 128; const float* WI = (const float*)(ws + WS_WI);
    s16x8 A[4];
    { const int rho = c, qsel = (rho >> 2) & 1, head = (rho & 3) + 4 * (rho >> 3);
      const h16* qp = QI + (size_t)(b * T + t0 + qsel) * 1024 + head * 64 + 8 * hi;
#pragma unroll
      for (int ks = 0; ks < 4; ++ks) A[ks] = *reinterpret_cast<const s16x8*>(qp + 16 * ks); }
    float w[16];
    { const f32x4* wp = (const f32x4*)(WI + (size_t)row * 16);
#pragma unroll
      for (int i = 0; i < 4; ++i) { const f32x4 v = wp[i]; w[4 * i] = v[0]; w[4 * i + 1] = v[1]; w[4 * i + 2] = v[2]; w[4 * i + 3] = v[3]; } }
    const int pr0 = tid >> 3, pp = tid & 7;
    const unsigned g_off = (unsigned)(pr0 * 128 + pp * 16);
    const int l_off0 = pr0 * 128 + ((pp ^ ((pr0 >> 1) & 7)) << 4), l_off1 = l_off0 + 64 * 128;
    const int rd_base = c * 128; const int sw = (c >> 1) & 7;
    int rd_off[4];
#pragma unroll
    for (int ks = 0; ks < 4; ++ks) rd_off[ks] = rd_base + (((2 * ks + hi) ^ sw) << 4);
    unsigned* myscr = scr + (size_t)(2 * wid + hi) * T + c;
    asm volatile("" :: "v"(A[0]), "v"(A[1]), "v"(A[2]), "v"(A[3]), "v"(w[0]), "v"(w[4]), "v"(w[8]), "v"(w[12]));
    s16x8 st0, st1;
    { const char* src = KIb; st0 = *reinterpret_cast<const s16x8*>(src + g_off); st1 = *reinterpret_cast<const s16x8*>(src + 64 * 128 + g_off); }
    *reinterpret_cast<s16x8*>(lds + l_off0) = st0; *reinterpret_cast<s16x8*>(lds + l_off1) = st1;
    __syncthreads();
#pragma unroll 1
    for (int ch = 0; ch < nch; ++ch) {
        const char* buf = lds + (ch & 1) * CHB;
        if (ch + 1 < nch) { const char* src = KIb + (size_t)(ch + 1) * CHB; st0 = *reinterpret_cast<const s16x8*>(src + g_off); st1 = *reinterpret_cast<const s16x8*>(src + 64 * 128 + g_off); }
#pragma unroll
        for (int st = 0; st < 4; ++st) {
            f32x16 acc = {};
#pragma unroll
            for (int ks = 0; ks < 4; ++ks) { const s16x8 Bf = *reinterpret_cast<const s16x8*>(buf + st * 4096 + rd_off[ks]);
                acc = __builtin_amdgcn_mfma_f32_32x32x16_f16(__builtin_bit_cast(h16x8, A[ks]), __builtin_bit_cast(h16x8, Bf), acc, 0, 0, 0); }
            float sc = 0.f;
#pragma unroll
            for (int r = 0; r < 16; ++r) { const int ri = __float_as_int(acc[r]); sc = fmaf(w[r], __int_as_float(ri > 0 ? ri : 0), sc); }
            const int sidx = ch * CHK + st * 32 + c;
            myscr[ch * CHK + st * 32] = (sidx <= t) ? fkey(sc) : 0u;
        }
        if (ch + 1 < nch) { char* dst = lds + ((ch + 1) & 1) * CHB; *reinterpret_cast<s16x8*>(dst + l_off0) = st0; *reinterpret_cast<s16x8*>(dst + l_off1) = st1; }
        __syncthreads();
    }
    asm volatile("s_waitcnt vmcnt(0)" ::: "memory");
    u64* MASK = (u64*)(ws + WS_MASK);
#pragma unroll 1
    for (int qq = 0; qq < 2; ++qq) {
        const int tq = t0 + qq, nj = (tq >> 6) + 1;
        const unsigned* src = scr + (size_t)(2 * wid + qq) * T + lane;
        unsigned key[64];
#pragma unroll
        for (int j = 0; j < 64; ++j) key[j] = (j < nj) ? __hip_atomic_load(src + 64 * j, __ATOMIC_RELAXED, __HIP_MEMORY_SCOPE_AGENT) : 0u;
        u64 mw;
        if (tq + 1 <= TOPK) {
            mw = 0;
#pragma unroll
            for (int j = 0; j < 4; ++j) { const u64 bal = __ballot(key[j] != 0u); if (lane == j) mw = bal; }
        } else mw = topk_select_hist(key, tq + 1, lane, (LAS unsigned*)(lds + 2 * CHB + wid * 8192));
        MASK[(size_t)(b * T + tq) * 64 + lane] = mw;
    }
}
}

namespace att {
constexpr int NW = 8, QBLK = 32, KVBLK = 64, QB = NW * QBLK, D = 128;
constexpr int SHM_V = KVBLK * D * 2, SHM_K = KVBLK * D * 2;
constexpr int LDS_NEED = 2 * SHM_V + 2 * SHM_K + NW * 64 * 4;
constexpr float THR = 8.f, SCALE = 0.08838834764831845f;
typedef short s16x8 __attribute__((ext_vector_type(8)));
typedef short s16x4 __attribute__((ext_vector_type(4)));
typedef float f32x16 __attribute__((ext_vector_type(16)));
#define KSWZ(row, colB) ((row) * 256 + ((colB) ^ (((row) & 7) << 4)))
#define SBAR() __builtin_amdgcn_sched_barrier(0)
__device__ __forceinline__ int v_st(int k, int c) { const int kk = (k & ~0xC) | ((k & 4) << 1) | ((k & 8) >> 1); return ((kk >> 3) * 4 + (c >> 5)) * 512 + ((kk & 7) * 32 + (c & 31)) * 2; }
__device__ __forceinline__ int v_rd_base(int lane) { return ((lane & 3) << 3) | (((lane >> 2) & 3) << 6) | (((lane >> 4) & 1) << 5) | (((lane >> 5) & 1) << 8); }
constexpr int v_rd_off(int d0, int ks, int half) { return d0 * 512 + ks * 4096 + half * 2048; }
__device__ __forceinline__ int crow(int r, int hi) { return (r & 3) + 8 * (r >> 2) + 4 * hi; }
__device__ __forceinline__ unsigned cvtpk(float lo, float hi) { unsigned r; asm volatile("v_cvt_pk_f16_f32 %0, %1, %2" : "=v"(r) : "v"(lo), "v"(hi)); return r; }
__device__ __forceinline__ f32x16 mfma16(s16x8 a, s16x8 b, f32x16 c) { return __builtin_amdgcn_mfma_f32_32x32x16_f16(__builtin_bit_cast(h16x8, a), __builtin_bit_cast(h16x8, b), c, 0, 0, 0); }
__device__ __forceinline__ s16x8 load8(const h16* p) { return *reinterpret_cast<const s16x8*>(p); }
__device__ __forceinline__ void mask_causal(f32x16& p0, f32x16& p1, int dq) {
    const float NEG = -__builtin_inff();
#pragma unroll
    for (int r = 0; r < 16; ++r) { const int c = (r & 3) + 8 * (r >> 2); if (dq - c < 0) p0[r] = NEG; if (dq - c - 32 < 0) p1[r] = NEG; }
}
__device__ __forceinline__ void mask_bits(f32x16& p0, f32x16& p1, u64 w, int hi) {
    const float NEG = -__builtin_inff();
    const unsigned lo = (unsigned)w >> (4 * hi), up = (unsigned)(w >> 32) >> (4 * hi);
#pragma unroll
    for (int r = 0; r < 16; ++r) { const int c = (r & 3) + 8 * (r >> 2); if (!((lo >> c) & 1u)) p0[r] = NEG; if (!((up >> c) & 1u)) p1[r] = NEG; }
}
__device__ __forceinline__ void partialSM(f32x16& p0, f32x16& p1, float& m_reg, float& mn, float& alpha) {
    float pmax = p0[0]; for (int r = 1; r < 16; ++r) pmax = fmaxf(pmax, p0[r]); for (int r = 0; r < 16; ++r) pmax = fmaxf(pmax, p1[r]);
    { auto rr = __builtin_amdgcn_permlane32_swap(__float_as_uint(pmax), __float_as_uint(pmax), false, false);
      pmax = fmaxf(__uint_as_float(rr[0]), __uint_as_float(rr[1])); }
    constexpr float C2 = 1.4426950408889634f * SCALE;
    if (__builtin_expect(__all((pmax - m_reg) * SCALE <= THR), 1)) { mn = m_reg; alpha = 1.f; }
    else { mn = fmaxf(m_reg, pmax); alpha = __builtin_amdgcn_exp2f((m_reg - mn) * C2); m_reg = mn; }
    const float mnL = -mn * C2;
    for (int r = 0; r < 16; ++r) p0[r] = fmaf(p0[r], C2, mnL); for (int r = 0; r < 16; ++r) p1[r] = fmaf(p1[r], C2, mnL);
    for (int r = 0; r < 16; ++r) p0[r] = __builtin_amdgcn_exp2f(p0[r]);
}
__device__ __forceinline__ void finishSM(f32x16& p0, f32x16& p1, float alpha, float& l_reg, s16x8& pa0, s16x8& pa1, s16x8& pa2, s16x8& pa3) {
    for (int r = 0; r < 16; ++r) p1[r] = __builtin_amdgcn_exp2f(p1[r]);
    float ps = 0; for (int r = 0; r < 16; ++r) ps += p0[r]; for (int r = 0; r < 16; ++r) ps += p1[r];
    { auto rr = __builtin_amdgcn_permlane32_swap(__float_as_uint(ps), __float_as_uint(ps), false, false);
      ps = __uint_as_float(rr[0]) + __uint_as_float(rr[1]); }
    l_reg = l_reg * alpha + ps;
#define PK4(P, B_, OUT) do { unsigned a0 = cvtpk(P[B_+0], P[B_+1]), a1 = cvtpk(P[B_+2], P[B_+3]);                          \
        unsigned b0 = cvtpk(P[B_+4], P[B_+5]), b1 = cvtpk(P[B_+6], P[B_+7]);                                             \
        auto r0 = __builtin_amdgcn_permlane32_swap(a0, b0, false, false); auto r1 = __builtin_amdgcn_permlane32_swap(a1, b1, false, false); \
        u32x4 w = {r0[0], r1[0], r0[1], r1[1]}; OUT = *reinterpret_cast<s16x8*>(&w); } while (0)
    PK4(p0, 0, pa0); PK4(p0, 8, pa1); PK4(p1, 0, pa2); PK4(p1, 8, pa3);
#undef PK4
}
template <int KB>
__device__ __forceinline__ void qkt(f32x16& p0, f32x16& p1, const char* K_lds, int r32, int hi, const s16x8* qr) {
    const char* kb[4];
#pragma unroll
    for (int dd = 0; dd < 4; ++dd) kb[dd] = K_lds + KB * SHM_K + KSWZ(r32, (dd * 16 + hi * 8) * 2);
#pragma unroll
    for (int d0 = 0; d0 < 8; ++d0) { const char* a = kb[d0 & 3] + (d0 >> 2) * 128;
        s16x8 b0 = *reinterpret_cast<const s16x8*>(a);
        s16x8 b1 = *reinterpret_cast<const s16x8*>(a + 32 * 256);
        p0 = mfma16(b0, qr[d0], p0);
        p1 = mfma16(b1, qr[d0], p1); }
}
template <int VB>
__device__ __forceinline__ void pv_tile(f32x16* o, int vb0, s16x8 pa0, s16x8 pa1, s16x8 pa2, s16x8 pa3) {
#define TRRD(dst, off) asm volatile("ds_read_b64_tr_b16 %0, %1 offset:%2" : "=&v"(dst) : "v"(vb0), "i"(off) : "memory")
#define PV_D0(d0) do { s16x4 l0, l1, l2, l3, h0, h1, h2, h3; constexpr int b_ = VB * SHM_V + v_rd_off(d0, 0, 0); \
        TRRD(l0, b_); TRRD(h0, b_ + 2048); TRRD(l1, b_ + 4096); TRRD(h1, b_ + 6144); TRRD(l2, b_ + 8192); TRRD(h2, b_ + 10240); TRRD(l3, b_ + 12288); TRRD(h3, b_ + 14336); \
        asm volatile("s_waitcnt lgkmcnt(0)" ::: "memory"); SBAR();   \
        o[d0] = mfma16(pa0, (s16x8){l0[0], l0[1], l0[2], l0[3], h0[0], h0[1], h0[2], h0[3]}, o[d0]);   \
        o[d0] = mfma16(pa1, (s16x8){l1[0], l1[1], l1[2], l1[3], h1[0], h1[1], h1[2], h1[3]}, o[d0]);   \
        o[d0] = mfma16(pa2, (s16x8){l2[0], l2[1], l2[2], l2[3], h2[0], h2[1], h2[2], h2[3]}, o[d0]);   \
        o[d0] = mfma16(pa3, (s16x8){l3[0], l3[1], l3[2], l3[3], h3[0], h3[1], h3[2], h3[3]}, o[d0]); } while (0)
    PV_D0(0); PV_D0(1); PV_D0(2); PV_D0(3);
#undef PV_D0
#undef TRRD
}
struct BlockRef { const char* Q; const char* K; const char* V; char* O; int P0; const char* NBQ; const char* MK; };
struct Seam { s16x8 qr[8]; s16x8 st_v0, st_v1, st_k0, st_k1; };
#define LD16(base, off) (*reinterpret_cast<const s16x8*>((base) + (off)))
#define VMW() asm volatile("s_waitcnt vmcnt(0)" ::: "memory")
#define VMWN(n) asm volatile("s_waitcnt vmcnt(%0)" :: "i"(n) : "memory")
#define SLOAD_H(Kp, Vp, k0) do { const char* vb_ = (Vp) + (size_t)(k0) * (D * 2); const char* kb_ = (Kp) + (size_t)(k0) * (D * 2); \
        S.st_v0 = LD16(vb_, st_off); S.st_v1 = LD16(vb_ + 32 * D * 2, st_off); S.st_k0 = LD16(kb_, st_off); S.st_k1 = LD16(kb_ + 32 * D * 2, st_off); } while (0)
#define SWRITE_HK(bf) do { *(s16x8*)(K_lds + (bf) * SHM_K + kws) = S.st_k0; *(s16x8*)(K_lds + (bf) * SHM_K + kws + 32 * 256) = S.st_k1; } while (0)
#define SWRITE_HV(bf) do { *(s16x8*)(V_lds + (bf) * SHM_V + vst0) = S.st_v0; *(s16x8*)(V_lds + (bf) * SHM_V + vst1) = S.st_v1; } while (0)
#define SWRITE_H(bf) do { SWRITE_HV(bf); SWRITE_HK(bf); } while (0)
__device__ __forceinline__ void prime(const BlockRef& cur, char* lds, Seam& S, int wv) {
    int tid = wv * 64 + lane_id(); asm volatile("" : "+v"(tid));
    const int wid = __builtin_amdgcn_readfirstlane(tid >> 6), lane = tid & 63, r32 = lane & 31, hi = lane >> 5;
    const int sr = tid >> 4, sc = (tid & 15) * 8, kws = KSWZ(sr, sc * 2); char* K_lds = lds + 2 * SHM_V;
    const unsigned st_off = (unsigned)(sr * D + sc) * 2u, q_off = (unsigned)((wid * QBLK + r32) * D + hi * 8) * 2u;
#pragma unroll
    for (int d0 = 0; d0 < 8; ++d0) S.qr[d0] = LD16(cur.Q + d0 * 32, q_off);
    SLOAD_H(cur.K, cur.V, 0); VMW(); SWRITE_HK(0);
    __syncthreads();
}
template <bool MIXB>
__device__ __forceinline__ void block(const BlockRef& cur, const BlockRef& nxt, char* lds, Seam& S, int wv) {
    int tid = wv * 64 + lane_id(); asm volatile("" : "+v"(tid));
    const int wid = __builtin_amdgcn_readfirstlane(tid >> 6), lane = tid & 63, r32 = lane & 31, hi = lane >> 5;
    const int NT = cur.P0 / KVBLK + 4;
    const int qlo = cur.P0 + wid * QBLK, qm = qlo + r32 - 4 * hi;
    char* V_lds = lds; char* K_lds = lds + 2 * SHM_V;
    float* wsf = (float*)(lds + 2 * SHM_V + 2 * SHM_K) + wid * 64; float* li_l = wsf, * al_l = wsf + 32;
    float m_reg = -1e30f, l_reg = 0; f32x16 o[4] = {};
    const int sr = tid >> 4, sc = (tid & 15) * 8, vst0 = v_st(sr, sc), vst1 = v_st(32 + sr, sc), kws = KSWZ(sr, sc * 2);
    const int vb0 = (int)(uintptr_t)V_lds + v_rd_base(lane);
    const unsigned st_off = (unsigned)(sr * D + sc) * 2u, q_off = (unsigned)((wid * QBLK + r32) * D + hi * 8) * 2u;
    const unsigned nb_off = (unsigned)hi * 16u, mk_off = (unsigned)(wid * QBLK + r32) * 512u;
    const char* Kh = cur.K; const char* Vh = cur.V;
    const char* bias_l = lds + LDS_NEED;
    if (MIXB) { const float nbref = *(const float*)(cur.NBQ + (size_t)(cur.P0 + QB - 1) * 4);
        for (int i = tid; i < cur.P0 + QB; i += NW * 64) ((float*)bias_l)[i] = ((const float*)cur.NBQ)[i] - nbref;
        __syncthreads(); }
#define RESC(a) do { if (__any((a) < 1.f)) { if (hi == 0) al_l[r32] = (a); asm volatile("s_waitcnt lgkmcnt(0)" ::: "memory");              \
                     for (int d_ = 0; d_ < 4; ++d_) for (int r = 0; r < 16; ++r) o[d_][r] *= al_l[crow(r, hi)]; } } while (0)
#define KBASE(t) ((t) * KVBLK)
#define PINIT(P0_, P1_, t) do { if (MIXB) { const char* nb_ = bias_l + KBASE(t) * 4 + nb_off; _Pragma("unroll") for (int g_ = 0; g_ < 4; ++g_) { \
            const f32x4 b0_ = *(const f32x4*)(nb_ + 32 * g_), b1_ = *(const f32x4*)(nb_ + 128 + 32 * g_); \
            _Pragma("unroll") for (int j_ = 0; j_ < 4; ++j_) { P0_[4 * g_ + j_] = b0_[j_]; P1_[4 * g_ + j_] = b1_[j_]; } } } else { P0_ = f32x16{}; P1_ = f32x16{}; } } while (0)
#define MKW(t) (*(const u64*)(cur.MK + (size_t)(t) * 8 + mk_off))
#define MASKT(P0_, P1_, t, MW_) do { if (MIXB) { const int kb_ = KBASE(t); if (kb_ + KVBLK - 1 > qlo) mask_causal(P0_, P1_, qm - kb_); } else mask_bits(P0_, P1_, MW_, hi); } while (0)
    f32x16 pA0, pA1, pB0, pB1; float mnA, mnB, alA, alB; s16x8 pa0, pa1, pa2, pa3;
    u64 mwA = 0, mwB = 0;
    if (!MIXB) { mwA = MKW(0); if (NT > 1) mwB = MKW(1); }
    PINIT(pA0, pA1, 0);
    if (NT > 1) PINIT(pB0, pB1, 1);
    SWRITE_HV(0); SBAR();
    if (NT > 1) SLOAD_H(Kh, Vh, KBASE(1));
    SBAR(); qkt<0>(pA0, pA1, K_lds, r32, hi, S.qr);
    MASKT(pA0, pA1, 0, mwA); if (!MIXB) { if (NT > 2) mwA = MKW(2); }
    partialSM(pA0, pA1, m_reg, mnA, alA);
    if (NT > 1) { VMW(); SWRITE_H(1); }
    __syncthreads();
#define HALF_STEP(PX0, PX1, mnX, alX, MWX, PY0, PY1, alY, t, KB, VB, SB) do {                                               \
        SBAR(); qkt<KB>(PX0, PX1, K_lds, r32, hi, S.qr);                                                                      \
        finishSM(PY0, PY1, alY, l_reg, pa0, pa1, pa2, pa3); SBAR();                                                           \
        if ((t) + 1 < NT) { PINIT(PY0, PY1, (t) + 1); SLOAD_H(Kh, Vh, KBASE((t) + 1)); SBAR(); }                             \
        pv_tile<VB>(o, vb0, pa0, pa1, pa2, pa3); MASKT(PX0, PX1, (t), MWX); if (!MIXB) { if ((t) + 2 < NT) MWX = MKW((t) + 2); } \
        partialSM(PX0, PX1, m_reg, mnX, alX);                                                                                 \
        __syncthreads();                                                                                                      \
        if ((t) + 1 < NT) { VMW(); SWRITE_H(SB); }                                                                            \
        RESC(alX); __syncthreads(); } while (0)
    for (int t = 1; t + 1 < NT; t += 2) {
        HALF_STEP(pB0, pB1, mnB, alB, mwB, pA0, pA1, alA, t, 1, 0, 0);
        HALF_STEP(pA0, pA1, mnA, alA, mwA, pB0, pB1, alB, t + 1, 0, 1, 1);
    }
    const bool even = (NT & 1) == 0;
    if (even) { SBAR(); qkt<1>(pB0, pB1, K_lds, r32, hi, S.qr); SBAR(); }
    SLOAD_H(nxt.K, nxt.V, 0); SBAR();
#pragma unroll
    for (int d0 = 0; d0 < 8; ++d0) S.qr[d0] = LD16(nxt.Q + d0 * 32, q_off);
    SBAR();
    finishSM(pA0, pA1, alA, l_reg, pa0, pa1, pa2, pa3); SBAR();
    pv_tile<0>(o, vb0, pa0, pa1, pa2, pa3);
    if (even) { MASKT(pB0, pB1, NT - 1, mwB); partialSM(pB0, pB1, m_reg, mnB, alB); __syncthreads(); RESC(alB);
        finishSM(pB0, pB1, alB, l_reg, pa0, pa1, pa2, pa3); SBAR(); pv_tile<1>(o, vb0, pa0, pa1, pa2, pa3); }
    SBAR(); VMWN(8); SWRITE_HK(0); SBAR();
    if (hi == 0) li_l[r32] = l_reg; asm volatile("s_waitcnt lgkmcnt(0)" ::: "memory");
    float rli[16];
#pragma unroll
    for (int r = 0; r < 16; ++r) rli[r] = __builtin_amdgcn_rcpf(li_l[crow(r, hi)]);
    const unsigned o_off = (unsigned)((wid * QBLK + 4 * hi) * 1024 + r32) * 2u;
#pragma unroll
    for (int r = 0; r < 16; ++r) {
#pragma unroll
        for (int d0 = 0; d0 < 4; ++d0) { const float v = o[d0][r] * rli[r];
            const float vn = __shfl_xor(v, 1);
            if ((r32 & 1) == 0) *(unsigned*)(cur.O + (size_t)(((r & 3) + 8 * (r >> 2)) * 2048 + d0 * 64) + o_off) = cvtpk(v, vn); } }
    __syncthreads();
#undef RESC
#undef KBASE
#undef PINIT
#undef MKW
#undef MASKT
#undef HALF_STEP
}
#undef LD16
#undef VMW
#undef VMWN
#undef SLOAD_H
#undef SWRITE_HK
#undef SWRITE_HV
#undef SWRITE_H
__device__ __forceinline__ BlockRef make_ref(bool mixb, unsigned char* ws, int bh, int qb) {
    const int b = bh >> 3, h = bh & 7, kvh = mixb ? bh : (b * HAKV + (h >> 2));
    BlockRef r;
    r.Q = (const char*)ws + (mixb ? WS_QB : WS_QA) + ((size_t)bh * T + (size_t)qb * QB) * D * 2;
    r.K = (const char*)ws + (mixb ? WS_KB : WS_KA) + (size_t)kvh * T * D * 2;
    r.V = (const char*)ws + (mixb ? WS_VB : WS_VA) + (size_t)kvh * T * D * 2;
    r.O = (char*)ws + (mixb ? WS_OUTB : WS_OUTA) + ((size_t)(b * T + qb * QB) * 1024 + h * D) * 2;
    r.P0 = qb * QB;
    r.NBQ = (const char*)ws + WS_CB + (size_t)bh * T * 4;
    r.MK = (const char*)ws + WS_MASK + (size_t)(b * T + qb * QB) * 64 * 8;
    return r;
}
template <bool MIXB>
__device__ __forceinline__ void run_item(int item, unsigned char* ws, char* lds, int wv) {
    const int bh = (item >> 3) & 15, x = item & 7;
    Seam S;
    BlockRef cur = make_ref(MIXB, ws, bh, x);
    prime(cur, lds, S, wv);
#pragma unroll 1
    for (int pass = 0; pass < 2; ++pass) {
        const BlockRef nxt = make_ref(MIXB, ws, bh, 15 - x);
        block<MIXB>(cur, nxt, lds, S, wv);
        cur = nxt;
    }
}
}


#define XB_TMO      128
#define XB_XCNT(j)  (256  + 64 * (j))
#define XB_XSUB(j)  (1280 + 64 * (j))
#define XB_XGEN(j)  (2304 + 64 * (j))
#define XB_TOP      3328
#define XB_TOPGEN   3392
#define XCD_BAR_WORDS 3456
#define XB_SPIN_CAP (1u << 24)
__device__ __forceinline__ unsigned xb_ld(unsigned* p)              { return __hip_atomic_load(p, __ATOMIC_RELAXED, __HIP_MEMORY_SCOPE_AGENT); }
__device__ __forceinline__ unsigned xb_add(unsigned* p, unsigned v) { return __hip_atomic_fetch_add(p, v, __ATOMIC_RELAXED, __HIP_MEMORY_SCOPE_AGENT); }
__device__ __forceinline__ unsigned xb_xcc_id() { return (unsigned)__builtin_amdgcn_s_getreg((3 << 11) | 20) & 0xFu; }
#define XB_SPIN(cond, bar) do { unsigned _sp = 0; while (cond) { __builtin_amdgcn_s_sleep(1); \
    if ((++_sp & 255u) == 0u) { if (xb_ld(&(bar)[XB_TMO])) break; if (_sp > XB_SPIN_CAP) { atomicAdd(&(bar)[XB_TMO], 1u); break; } } } } while (0)
struct XcdBarrier { unsigned* bar; unsigned x; volatile LAS unsigned* st; };
__device__ __forceinline__ XcdBarrier xcd_barrier_post(unsigned* bar, volatile LAS unsigned* st, int wv) {
    XcdBarrier b; b.bar = bar; b.x = xb_xcc_id(); b.st = st;
    if (wv == 0 && lane_id() == 0) (void)xb_add(&bar[XB_XCNT(b.x)], 1u);
    return b;
}
__device__ __forceinline__ void xcd_barrier_complete(unsigned* bar, unsigned x, unsigned& nloc, unsigned& nx) {
    const unsigned G = gridDim.x * gridDim.y * gridDim.z;
    unsigned sum, cnt, mine, sp = 0u;
    for (;;) {
        sum = 0u; cnt = 0u; mine = 0u;
#pragma unroll
        for (unsigned j = 0; j < 16; ++j) { const unsigned c = xb_ld(&bar[XB_XCNT(j)]); sum += c; cnt += (c > 0u) ? 1u : 0u; mine = (j == x) ? c : mine; }
        if (sum == G) break;
        __builtin_amdgcn_s_sleep(1);
        if ((++sp & 255u) == 0u) { if (xb_ld(&bar[XB_TMO])) break; if (sp > XB_SPIN_CAP) { atomicAdd(&bar[XB_TMO], 1u); break; } }
    }
    nloc = mine > 0u ? mine : 1u; nx = cnt > 0u ? cnt : 1u;
}
__device__ __forceinline__ void xcd_barrier(const XcdBarrier& b, int wv) {
    asm volatile("s_waitcnt vmcnt(0)" ::: "memory");
    __syncthreads();
    if (wv == 0 && lane_id() == 0) {
        unsigned* bar = b.bar;
        __builtin_amdgcn_s_waitcnt(0);
        unsigned nloc = b.st[0], nx = b.st[1];
        if (nloc == 0u) { xcd_barrier_complete(bar, b.x, nloc, nx); b.st[0] = nloc; b.st[1] = nx; }
        const unsigned old = xb_add(&bar[XB_XSUB(b.x)], 1u);
        const unsigned gen = old / nloc;
        if (old + 1u == (gen + 1u) * nloc) {
            __builtin_amdgcn_fence(__ATOMIC_RELEASE, "agent");
            asm volatile("s_waitcnt vmcnt(0)" ::: "memory");
            const unsigned og = xb_add(&bar[XB_TOP], 1u);
            const unsigned tg = og / nx;
            if (og + 1u == (tg + 1u) * nx) xb_add(&bar[XB_TOPGEN], 1u);
            else XB_SPIN(xb_ld(&bar[XB_TOPGEN]) == tg, bar);
            __builtin_amdgcn_fence(__ATOMIC_ACQUIRE, "agent");
            xb_add(&bar[XB_XGEN(b.x)], 1u);
            asm volatile("s_waitcnt vmcnt(0)" ::: "memory");
        } else {
            XB_SPIN(xb_ld(&bar[XB_XGEN(b.x)]) == gen, bar);
            __builtin_amdgcn_fence(__ATOMIC_ACQUIRE, "agent");
            asm volatile("s_waitcnt vmcnt(0)" ::: "memory");
        }
    }
    __syncthreads();
}

namespace cg = cooperative_groups;
#ifndef PROBE_DUP
#define PROBE_DUP 0
#endif
#define REP(k) for (int rep_ = 0; rep_ < (((PROBE_DUP) >> (k)) & 1) + 1; ++rep_)
constexpr int LDS_BYTES = pg8::STAGE_BYTES + 256;
constexpr int CW_BAR = 4096;
struct Params { const float* in[17]; float* out; unsigned char* ws; };
template <class Epi>
__device__ __forceinline__ void run_gemm(LAS unsigned char* lds, const h16* A, const h16* Bt, int M, int N, int K, const Epi& e, int wv) {
    pg8::Gemm g{A, Bt, M, N, K}; pg8::StaticOrder S; S.init(M, N, (int)gridDim.x, (int)blockIdx.x);
    pg8::gemm_phase<Epi>(lds, g, S, e, wv);
}
__global__ void __launch_bounds__(512, 2) mega_fwd(Params P) {
    extern __shared__ __attribute__((aligned(16))) unsigned char lds_raw[];
    LAS unsigned char* lds = (LAS unsigned char*)lds_raw;
    const int wv = __builtin_amdgcn_readfirstlane(threadIdx.x >> 6);
    volatile LAS unsigned* bst = (volatile LAS unsigned*)(lds + pg8::STAGE_BYTES);
    if (wv == 0 && lane_id() < 2) bst[lane_id()] = 0u;
    __syncthreads();
    const XcdBarrier xbar = xcd_barrier_post((unsigned*)(P.ws + WS_CTL) + CW_BAR, bst, wv);
#define GRID_BAR() xcd_barrier(xbar, wv)
#define IDS() int lane = lane_id(); asm volatile("" : "+v"(lane)); const int wave = wv, tid = wave * 64 + lane, gw = blockIdx.x * 8 + wave, NGW = gridDim.x * 8; (void)tid; (void)gw; (void)NGW
    const float* x = P.in[0]; const float* p = P.in[1]; const int* pos = (const int*)P.in[2];
    const float* g_mix = P.in[3]; const float* w_in = P.in[4]; const float* b_f = P.in[5];
    const float* w_o_a = P.in[6]; const float* w_o_b = P.in[7]; const float* w_out = P.in[8];
    const float* g_ffn = P.in[9]; const float* w_g = P.in[10]; const float* w_u = P.in[11]; const float* w_d = P.in[12];
    const float* g_ple = P.in[13]; const float* w_pg = P.in[14]; const float* w_pp = P.in[15]; const float* g_final = P.in[16];
    unsigned char* ws = P.ws; float* out = P.out;
    float* RS = (float*)(ws + WS_RS); float* ROPE = (float*)(ws + WS_ROPE); float* CB = (float*)(ws + WS_CB); float* LOGF = (float*)(ws + WS_LOGF); u64* MASK = (u64*)(ws + WS_MASK);
    h16* WIN = (h16*)(ws + WS_WIN); h16* WOA = (h16*)(ws + WS_WOA); h16* WOB = (h16*)(ws + WS_WOB); h16* WOUT = (h16*)(ws + WS_WOUT);
    h16* WGU = (h16*)(ws + WS_WGU); h16* WDN = (h16*)(ws + WS_WDN); h16* WPG = (h16*)(ws + WS_WPG); h16* WPP = (h16*)(ws + WS_WPP);
    h16* QI = (h16*)(ws + WS_QI); h16* KI = (h16*)(ws + WS_KI); float* WI = (float*)(ws + WS_WI);
    h16* SIGA = (h16*)(ws + WS_SIGA); h16* SIGB = (h16*)(ws + WS_SIGB);
    h16* OUTA = (h16*)(ws + WS_OUTA); h16* OUTB = (h16*)(ws + WS_OUTB); h16* P16 = (h16*)(ws + WS_P16);
    h16* MIXED = (h16*)(ws + WS_MIXED); h16* H2 = (h16*)(ws + WS_H2); h16* ACT = (h16*)(ws + WS_ACT); h16* PP = (h16*)(ws + WS_PP);
    h16* H1 = (h16*)P.out;

    REP(0) { IDS(); LAS float* scr = (LAS float*)(lds + wave * 8448);
      ph_transpose<1>(w_in, nullptr, nullptr, DM, N_IN, WIN, N_INP, scr, gw, NGW, lane);
      ph_transpose<0>(w_o_a, nullptr, nullptr, 1024, DM, WOA, DM, scr, gw, NGW, lane);
      ph_transpose<0>(w_o_b, nullptr, nullptr, 1024, DM, WOB, DM, scr, gw, NGW, lane);
      ph_transpose<0>(w_out, nullptr, nullptr, DM, DM, WOUT, DM, scr, gw, NGW, lane);
      ph_transpose<2>(w_g, w_u, g_ffn, DM, DFF, WGU, 2 * DFF, scr, gw, NGW, lane);
      ph_transpose<0>(w_d, nullptr, nullptr, DFF, DM, WDN, DM, scr, gw, NGW, lane);
      ph_transpose<0>(w_pg, nullptr, g_ple, DM, DM, WPG, DM, scr, gw, NGW, lane);
      ph_transpose<0>(w_pp, nullptr, nullptr, DPLE, DM, WPP, DM, scr, gw, NGW, lane);
      ph_rope(pos, ROPE, blockIdx.x * 512 + tid, gridDim.x * 512);
      for (int i = blockIdx.x * 512 + tid; i < 3 * MTOK; i += gridDim.x * 512) RS[i] = 0.f;
      ph_rmsnorm<false>(x, g_mix, H1, nullptr, gw, NGW, lane);
    }
    GRID_BAR();
    REP(1) { EpiInProj e{ws, b_f}; run_gemm(lds, H1, WIN, MTOK, N_INP, DM, e, wv); }
    GRID_BAR();
    REP(2) { IDS();
      if (gw >= NGW - 16) ph_cumsum(LOGF, CB, NGW - 1 - gw, lane);
      for (int it = blockIdx.x; it < 256; it += gridDim.x) { const int bb = it & 1, gi = it >> 1;
#pragma unroll 1
          for (int pass = 0; pass < 2; ++pass) idx::run_group(ws, (char*)lds_raw, (unsigned*)out + (size_t)blockIdx.x * 16 * T, bb, pass ? 255 - gi : gi, wv); }
      for (int i = blockIdx.x * 512 + tid; i < MTOK * DPLE / 4; i += gridDim.x * 512) st4h(P16 + 4 * (size_t)i, *((const f32x4*)p + i));
    }
    GRID_BAR();
    REP(3) for (int it = blockIdx.x; it < 256; it += gridDim.x) {
        const int item = (it & 7) * 32 + (it >> 3);
        if (item < 128) att::run_item<false>(item, ws, (char*)lds_raw, wv); else att::run_item<true>(item, ws, (char*)lds_raw, wv);
    }
    GRID_BAR();
    REP(4) { { EpiGate<true> e{SIGA, MIXED}; run_gemm(lds, OUTA, WOA, MTOK, DM, 1024, e, wv); }
    { EpiGate<false> e{SIGB, MIXED}; run_gemm(lds, OUTB, WOB, MTOK, DM, 1024, e, wv); } }
    GRID_BAR();
    REP(5) { EpiResidNorm e{x, out, H2, RS}; run_gemm(lds, MIXED, WOUT, MTOK, DM, DM, e, wv); }
    GRID_BAR();
    REP(6) { EpiSwiGLU e{ACT, RS}; run_gemm(lds, H2, WGU, MTOK, 2 * DFF, DM, e, wv); }
    GRID_BAR();
    { EpiResidNorm e{out, out, H2, RS + MTOK}; run_gemm(lds, ACT, WDN, MTOK, DM, DFF, e, wv); }
    GRID_BAR();
    { EpiStoreH e{PP, DM}; run_gemm(lds, P16, WPP, MTOK, DM, DPLE, e, wv); }
    { EpiPLE e{PP, out, RS + MTOK, RS + 2 * MTOK}; run_gemm(lds, H2, WPG, MTOK, DM, DM, e, wv); }
    GRID_BAR();
    { IDS(); ph_final(out, g_final, RS + 2 * MTOK, gw, NGW, lane); }
#undef IDS
#undef GRID_BAR
}

extern "C" void kernel_launch(void* const* d_in, const int* in_sizes, int n_in, void* d_out, int out_size, void* d_ws, size_t ws_size, hipStream_t stream) {
    if (n_in != 17 || out_size != MTOK * DM || ws_size < WS_END) { fprintf(stderr, "kernel_launch: unexpected shapes / workspace (%d inputs, out %d, ws %zu)\n", n_in, out_size, ws_size); return; }
    static int grid_blocks = 0;
    if (!grid_blocks) {
        int dev = 0, cus = 0, per_cu = 0;
        (void)hipGetDevice(&dev);
        (void)hipDeviceGetAttribute(&cus, hipDeviceAttributeMultiprocessorCount, dev);
        (void)hipFuncSetAttribute((const void*)mega_fwd, hipFuncAttributeMaxDynamicSharedMemorySize, LDS_BYTES);
        (void)hipOccupancyMaxActiveBlocksPerMultiprocessor(&per_cu, (const void*)mega_fwd, 512, LDS_BYTES);
        if (per_cu < 1) { fprintf(stderr, "kernel_launch: occupancy query says %d blocks per CU\n", per_cu); per_cu = 1; }
        if (per_cu > 1) per_cu = 1;
        grid_blocks = cus * per_cu;
    }
    (void)hipMemsetAsync((char*)d_ws + WS_CTL, 0, 64 * 1024, stream);
    Params prm{};
    for (int i = 0; i < 17; ++i) prm.in[i] = (const float*)d_in[i];
    prm.out = (float*)d_out; prm.ws = (unsigned char*)d_ws;
    void* args[] = {&prm};
    hipError_t e = hipLaunchCooperativeKernel((const void*)mega_fwd, dim3(grid_blocks), dim3(512), args, LDS_BYTES, stream);
    if (e != hipSuccess) fprintf(stderr, "cooperative launch failed: %s (grid %d)\n", hipGetErrorString(e), grid_blocks);
}
```

```cpp
#include <hip/hip_runtime.h>
#include <hip/hip_cooperative_groups.h>
#include <stdint.h>
#include <cstdio>

#define LAS __attribute__((address_space(3)))
typedef _Float16 h16;
typedef _Float16 h16x8 __attribute__((ext_vector_type(8)));
typedef _Float16 h16x4 __attribute__((ext_vector_type(4)));
typedef _Float16 h16x2 __attribute__((ext_vector_type(2)));
typedef float f32x4 __attribute__((ext_vector_type(4)));
typedef float f32x2 __attribute__((ext_vector_type(2)));
typedef unsigned u32x4 __attribute__((ext_vector_type(4)));
typedef unsigned u32x2 __attribute__((ext_vector_type(2)));
typedef unsigned long long u64;
__device__ __forceinline__ int lane_id() { int r; asm volatile("v_mbcnt_lo_u32_b32 %0, -1, 0\n\tv_mbcnt_hi_u32_b32 %0, -1, %0" : "=v"(r)); return r; }

constexpr int NBATCH = 2, T = 4096, MTOK = NBATCH * T, DM = 2048;
constexpr int HA = 8, HAKV = 2, HIDX = 16, DIDX = 64, HB = 8, HD = 128;
constexpr int N_IN = 9816, N_INP = 9984, DFF = 5632, DPLE = 256, TOPK = 256;
constexpr float EPS = 1e-6f;
constexpr float ATT_SCALE = 0.08838834764831845f;

constexpr size_t MiB = 1u << 20;
constexpr size_t WS_CTL = 0;
constexpr size_t WS_RS = 512 * 1024;
constexpr size_t WS_ROPE = 1 * MiB;
constexpr size_t WS_CB = 3 * MiB;
constexpr size_t WS_LOGF = 3 * MiB + 512 * 1024;
constexpr size_t WS_MASK = 4 * MiB;
constexpr size_t WS_WIN = 8 * MiB;
constexpr size_t WS_OUTA = 8 * MiB, WS_OUTB = 24 * MiB, WS_P16 = 40 * MiB;
constexpr size_t WS_WOA = 47 * MiB, WS_WOB = 51 * MiB, WS_WOUT = 55 * MiB, WS_WGU = 63 * MiB, WS_WDN = 107 * MiB, WS_WPG = 129 * MiB, WS_WPP = 137 * MiB;
constexpr size_t WS_QA = 138 * MiB, WS_KA = 154 * MiB, WS_VA = 158 * MiB, WS_QI = 162 * MiB, WS_KI = 178 * MiB, WS_WI = 179 * MiB;
constexpr size_t WS_QB = 180 * MiB, WS_KB = 196 * MiB, WS_VB = 212 * MiB, WS_SIGA = 228 * MiB, WS_SIGB = 260 * MiB, WS_NBQ = 292 * MiB, WS_END = 296 * MiB;
constexpr size_t WS_MIXED = WS_QB;
constexpr size_t WS_H2 = WS_QA;
constexpr size_t WS_ACT = WS_QB;
constexpr size_t WS_PP = WS_QB;

namespace pg8 {
constexpr int BM = 256, BK = 64, HALF = 128, HTB = HALF * BK * 2, STAGE_BYTES = 8 * HTB, NXCD = 8, WGM = 8;
__host__ __device__ __forceinline__ int lds_byte(int r, int c) { const int st = (r >> 4) * 2 + (c >> 5), rr = r & 15, cc = c & 31, ob = rr * 64 + cc * 2; return st * 1024 + (ob ^ (((ob >> 9) & 1) << 5)); }
__host__ __device__ __forceinline__ void stage_rc(int b, int& R, int& C) { const int st = b / 1024, sb = b % 1024, swz = sb ^ (((sb >> 9) & 1) << 5); R = (st >> 1) * 16 + swz / 64; C = (st & 1) * 32 + (swz % 64) / 2; }
struct Unit { int pm, pn; };
struct Gemm { const h16* A; const h16* Bt; int M, N, K; };
struct StaticOrder {
    int nM, nN, nwg, G, c;
    __host__ __device__ void init(int M, int N, int G_, int c_) { nM = M / BM; nN = N / BM; nwg = nM * nN; G = G_; c = c_; }
    __host__ __device__ bool next(int i, Unit& u) const {
        const long L = (long)i * G + c; if (L >= nwg) return false;
        int wgid = (int)L; { const int q = nwg / NXCD, r = nwg % NXCD, xcd = wgid % NXCD, off = wgid / NXCD; wgid = (xcd < r ? xcd * (q + 1) : r * (q + 1) + (xcd - r) * q) + off; }
        const int nig = WGM * nN, gid = wgid / nig, fm = gid * WGM, gsz = (nM - fm) < WGM ? (nM - fm) : WGM;
        u.pm = fm + ((wgid % nig) % gsz); u.pn = (wgid % nig) / gsz; return true;
    }
};
template <class Epi>
__device__ __forceinline__ void gemm_phase(LAS unsigned char* lds, const Gemm g, const StaticOrder& S, const Epi& E, int wv) {
    int tid = wv * 64 + lane_id(); asm volatile("" : "+v"(tid));
    const int wid = __builtin_amdgcn_readfirstlane(tid >> 6), lane = tid & 63, wr = wid >> 2, wc = wid & 3, fr = lane & 15, fq = lane >> 4;
    const int K = g.K, nt = K / BK;
    unsigned voffA[2];
#pragma unroll
    for (int i = 0; i < 2; ++i) { int R, C; stage_rc(tid * 16 + i * 8192, R, C); voffA[i] = (unsigned)(R * K + C) * 2u; }
    const size_t kstep = (size_t)(BK * 2);
    const size_t hstep = (size_t)HALF * K * 2;
    const size_t tstep = 2 * hstep;
    const unsigned ldsw = (unsigned)wid * 1024u;
    const int aoff = lds_byte(wr * 64 + fr, fq * 8), boff = lds_byte(wc * 32 + fr, fq * 8);
#define PG8_SA(b, h) (((b) * 2 + (h)) * HTB)
#define PG8_SB(b, h) ((4 + (b) * 2 + (h)) * HTB)
#define PG8_STAGE(bufoff, gbase) do { _Pragma("unroll") for (int _i = 0; _i < 2; ++_i) \
        __builtin_amdgcn_global_load_lds((const unsigned*)((const char*)(gbase) + voffA[_i]), (LAS unsigned*)(lds + (bufoff) + ldsw + _i * 8192), 16, 0, 0); } while (0)
#define PG8_LDA(dst, b, h) do { _Pragma("unroll") for (int m = 0; m < 4; ++m) _Pragma("unroll") for (int k = 0; k < 2; ++k) dst[m][k] = *(const LAS h16x8*)(lds + PG8_SA(b, h) + aoff + m * 2048 + k * 1024); } while (0)
#define PG8_LDB(dst, b, h) do { _Pragma("unroll") for (int n = 0; n < 2; ++n) _Pragma("unroll") for (int k = 0; k < 2; ++k) dst[n][k] = *(const LAS h16x8*)(lds + PG8_SB(b, h) + boff + n * 2048 + k * 1024); } while (0)
#define PG8_MMA(ai, bj, At, Bt) do { __builtin_amdgcn_s_setprio(1); _Pragma("unroll") for (int m = 0; m < 4; ++m) _Pragma("unroll") for (int n = 0; n < 2; ++n) _Pragma("unroll") for (int k = 0; k < 2; ++k) \
        acc[ai][bj][m][n] = __builtin_amdgcn_mfma_f32_16x16x32_f16(Bt[n][k], At[m][k], acc[ai][bj][m][n], 0, 0, 0); __builtin_amdgcn_s_setprio(0); } while (0)
#define PG8_WAIT_V(n) asm volatile("s_waitcnt vmcnt(" #n ")" ::: "memory")
#define PG8_WAIT_L(n) asm volatile("s_waitcnt lgkmcnt(" #n ")" ::: "memory")
#define PG8_BAR __builtin_amdgcn_s_barrier()
#define PG8_SCHED __builtin_amdgcn_sched_barrier(0)
    Unit cur, nxt; int ui = 0;
    if (!S.next(0, cur)) return;
    f32x4 acc[2][2][4][2];
#pragma unroll
    for (int a = 0; a < 2; ++a)
#pragma unroll
        for (int b = 0; b < 2; ++b)
#pragma unroll
            for (int m = 0; m < 4; ++m)
#pragma unroll
                for (int n = 0; n < 2; ++n) acc[a][b][m][n] = (f32x4){0.f, 0.f, 0.f, 0.f};
    h16x8 At[4][2], B0[2][2], B1[2][2];
    const char* cA = (const char*)g.A + (size_t)cur.pm * tstep; const char* cB = (const char*)g.Bt + (size_t)cur.pn * tstep;
    PG8_STAGE(PG8_SB(0, 0), cB); PG8_STAGE(PG8_SA(0, 0), cA); PG8_STAGE(PG8_SB(0, 1), cB + hstep); PG8_STAGE(PG8_SA(0, 1), cA + hstep);
    if (wr == 1) PG8_BAR;
    PG8_WAIT_V(4); PG8_BAR;
    PG8_STAGE(PG8_SB(1, 0), cB + kstep); PG8_STAGE(PG8_SA(1, 0), cA + kstep); PG8_STAGE(PG8_SB(1, 1), cB + hstep + kstep);
    PG8_WAIT_V(6); PG8_BAR;
    for (;;) {
        const bool has_next = S.next(ui + 1, nxt);
        const char* nA = has_next ? (const char*)g.A + (size_t)nxt.pm * tstep : cA; const char* nB = has_next ? (const char*)g.Bt + (size_t)nxt.pn * tstep : cB;
        for (int t = 0; t < nt; t += 2) {
            const bool last = (t == nt - 2);
            const char* a1 = cA + (size_t)(t + 1) * kstep;
            const char* a2 = last ? nA : cA + (size_t)(t + 2) * kstep; const char* b2 = last ? nB : cB + (size_t)(t + 2) * kstep;
            const char* a3 = a2 + kstep; const char* b3 = b2 + kstep;
            PG8_LDB(B0, 0, 0); PG8_SCHED; PG8_LDA(At, 0, 0); PG8_STAGE(PG8_SA(1, 1), a1 + hstep);
            PG8_WAIT_L(8); PG8_BAR; PG8_WAIT_L(0); PG8_MMA(0, 0, At, B0); PG8_BAR; PG8_SCHED;
            PG8_LDB(B1, 0, 1); PG8_STAGE(PG8_SB(0, 0), b2);
            PG8_BAR; PG8_WAIT_L(0); PG8_MMA(0, 1, At, B1); PG8_BAR;
            PG8_LDA(At, 0, 1); PG8_STAGE(PG8_SA(0, 0), a2);
            PG8_BAR; PG8_WAIT_L(0); PG8_MMA(1, 0, At, B0); PG8_BAR; PG8_SCHED;
            PG8_STAGE(PG8_SB(0, 1), b2 + hstep);
            PG8_WAIT_V(6); PG8_BAR; PG8_MMA(1, 1, At, B1); PG8_BAR;
            PG8_LDB(B0, 1, 0); PG8_SCHED; PG8_LDA(At, 1, 0); PG8_STAGE(PG8_SA(0, 1), a2 + hstep);
            PG8_WAIT_L(8); PG8_BAR; PG8_WAIT_L(0); PG8_MMA(0, 0, At, B0); PG8_BAR; PG8_SCHED;
            PG8_LDB(B1, 1, 1); PG8_STAGE(PG8_SB(1, 0), b3);
            PG8_BAR; PG8_WAIT_L(0); PG8_MMA(0, 1, At, B1); PG8_BAR;
            PG8_LDA(At, 1, 1); PG8_STAGE(PG8_SA(1, 0), a3);
            PG8_BAR; PG8_WAIT_L(0); PG8_MMA(1, 0, At, B0); PG8_BAR; PG8_SCHED;
            PG8_STAGE(PG8_SB(1, 1), b3 + hstep);
            PG8_WAIT_V(6); PG8_BAR; PG8_MMA(1, 1, At, B1); PG8_BAR;
        }
        E(acc, cur, wr, wc, fr, fq);
        if (!has_next) break;
#pragma unroll
        for (int a = 0; a < 2; ++a)
#pragma unroll
            for (int b = 0; b < 2; ++b)
#pragma unroll
                for (int m = 0; m < 4; ++m)
#pragma unroll
                    for (int n = 0; n < 2; ++n) acc[a][b][m][n] = (f32x4){0.f, 0.f, 0.f, 0.f};
        cur = nxt; cA = nA; cB = nB; ++ui;
    }
    PG8_WAIT_V(0);
    if (wr == 0) PG8_BAR;
    PG8_BAR;
#undef PG8_SA
#undef PG8_SB
#undef PG8_STAGE
#undef PG8_LDA
#undef PG8_LDB
#undef PG8_MMA
#undef PG8_WAIT_V
#undef PG8_WAIT_L
#undef PG8_BAR
#undef PG8_SCHED
}
}
using pg8::Unit;
typedef f32x4 Acc[2][2][4][2];

__device__ __forceinline__ void st4h(h16* p, f32x4 v) { h16x4 o; o[0] = (h16)v[0]; o[1] = (h16)v[1]; o[2] = (h16)v[2]; o[3] = (h16)v[3]; *(h16x4*)p = o; }
__device__ __forceinline__ f32x4 ld4h(const h16* p) { const h16x4 o = *(const h16x4*)p; return (f32x4){(float)o[0], (float)o[1], (float)o[2], (float)o[3]}; }
__device__ __forceinline__ float sigmoidf_(float x) { return __builtin_amdgcn_rcpf(1.0f + __expf(-x)); }
__device__ __forceinline__ float logsigmoidf_(float z) { return fminf(z, 0.f) - __logf(1.0f + __expf(-fabsf(z))); }
__device__ __forceinline__ float wave_sum(float v) {
#pragma unroll
    for (int o = 1; o < 64; o <<= 1) v += __shfl_xor(v, o);
    return v;
}

struct EpiInProj {
    unsigned char* ws; const float* b_f;
    __device__ __forceinline__ void operator()(const Acc& acc, const Unit& u, int wr, int wc, int fr, int fq) const {
        const int pn = u.pn, row0 = u.pm * 256 + wr * 64 + fr;
        const float* ROPE = (const float*)(ws + WS_ROPE);
#pragma unroll
        for (int ai = 0; ai < 2; ++ai)
#pragma unroll
            for (int m = 0; m < 4; ++m) {
                const int row = row0 + ai * 128 + m * 16, b = row >> 12, t = row & 4095;
                const float* rp = ROPE + (size_t)row * 48;
#pragma unroll
                for (int bj = 0; bj < 2; ++bj) {
                    f32x4 v0 = acc[ai][bj][m][0], v1 = acc[ai][bj][m][1];
                    const int d0 = 32 * wc + 4 * fq;
                    if (pn < 6) {
                        size_t off;
                        if (pn < 4) off = WS_QA + (((size_t)(b * HA + pn * 2 + bj) * T + t) * HD) * 2;
                        else off = (pn == 4 ? WS_KA : WS_VA) + (((size_t)(b * HAKV + bj) * T + t) * HD) * 2;
                        h16* dst = (h16*)(ws + off);
                        if (pn < 5 && wc == 0) {
                            const f32x4 c = *(const f32x4*)(rp + 4 * fq), s = *(const f32x4*)(rp + 16 + 4 * fq);
                            const f32x4 y0 = v0 * c - v1 * s, y1 = v1 * c + v0 * s; v0 = y0; v1 = y1;
                        }
                        st4h(dst + d0, v0); st4h(dst + d0 + 16, v1);
                    } else if (pn < 11) {
                        const bool is_q = pn < 10;
                        if (is_q || bj == 0) {
                            if (is_q || wc < 2) {
                                const int dd = 32 * (wc & 1) + 4 * fq;
                                const size_t off = is_q ? WS_QI + ((size_t)row * 1024 + ((pn - 6) * 4 + 2 * bj + (wc >> 1)) * 64) * 2 : WS_KI + ((size_t)row * 64) * 2;
                                h16* dst = (h16*)(ws + off);
                                if ((wc & 1) == 0) {
                                    f32x4 pr;
#pragma unroll
                                    for (int j = 0; j < 4; ++j) pr[j] = __shfl_xor(v0[j], 32);
                                    const f32x4 c = *(const f32x4*)(rp + 32 + 4 * (fq & 1)), s = *(const f32x4*)(rp + 40 + 4 * (fq & 1));
                                    v0 = (fq < 2) ? (v0 * c - pr * s) : (v0 * c + pr * s);
                                }
                                st4h(dst + dd, v0); st4h(dst + dd + 16, v1);
                            } else if (wc == 2) {
                                *(f32x4*)((float*)(ws + WS_WI) + (size_t)row * 16 + 4 * fq) = v0 * 0.03125f;
                                if (fq < 2) { const f32x4 bf = *(const f32x4*)(b_f + 4 * fq); f32x4 o;
#pragma unroll
                                    for (int j = 0; j < 4; ++j) o[j] = logsigmoidf_(v1[j] + bf[j]);
                                    *(f32x4*)((float*)(ws + WS_LOGF) + (size_t)row * 8 + 4 * fq) = o; }
                            }
                        }
                    } else if (pn < 23) {
                        const int q = pn - 11, which = q >> 2, head = (q & 3) * 2 + bj;
                        h16* dst = (h16*)(ws + WS_QB + (size_t)which * (WS_KB - WS_QB)) + ((size_t)(b * HB + head) * T + t) * HD;
                        st4h(dst + d0, v0); st4h(dst + d0 + 16, v1);
                    } else {
                        const int q = pn - 23; const int col = (q & 7) * 256 + 128 * bj + d0;
                        h16* base = (h16*)(ws + WS_SIGA + (size_t)(q >> 3) * (WS_SIGB - WS_SIGA));
#pragma unroll
                        for (int j = 0; j < 4; ++j) { v0[j] = sigmoidf_(v0[j]); v1[j] = sigmoidf_(v1[j]); }
                        st4h(base + (size_t)row * DM + col, v0); st4h(base + (size_t)row * DM + col + 16, v1);
                    }
                }
            }
    }
};
static_assert(WS_VB - WS_KB == WS_KB - WS_QB, "QB/KB/VB equally spaced");
template <bool FIRST> struct EpiGate {
    const h16* SIG; h16* MIXED;
    __device__ __forceinline__ void operator()(const Acc& acc, const Unit& u, int wr, int wc, int fr, int fq) const {
        const int row0 = u.pm * 256 + wr * 64 + fr, col0 = u.pn * 256 + 32 * wc + 4 * fq;
#pragma unroll
        for (int ai = 0; ai < 2; ++ai)
#pragma unroll
            for (int m = 0; m < 4; ++m)
#pragma unroll
                for (int bj = 0; bj < 2; ++bj)
#pragma unroll
                    for (int n = 0; n < 2; ++n) { const size_t off = (size_t)(row0 + ai * 128 + m * 16) * DM + col0 + bj * 128 + n * 16;
                        f32x4 v = ld4h(SIG + off) * acc[ai][bj][m][n]; if (!FIRST) v += ld4h(MIXED + off); st4h(MIXED + off, v); }
    }
};
__device__ __forceinline__ float sumsq4(f32x4 v) { return (v[0] * v[0] + v[1] * v[1]) + (v[2] * v[2] + v[3] * v[3]); }
template <bool BASE_F32> struct EpiResidNorm {
    const float* BASE; h16* XH; float* RS;
    __device__ __forceinline__ void operator()(const Acc& acc, const Unit& u, int wr, int wc, int fr, int fq) const {
        const int row0 = u.pm * 256 + wr * 64 + fr, col0 = u.pn * 256 + 32 * wc + 4 * fq;
#pragma unroll
        for (int ai = 0; ai < 2; ++ai)
#pragma unroll
            for (int m = 0; m < 4; ++m) { const int row = row0 + ai * 128 + m * 16; float ss = 0.f;
#pragma unroll
                for (int bj = 0; bj < 2; ++bj)
#pragma unroll
                    for (int n = 0; n < 2; ++n) { const size_t off = (size_t)row * DM + col0 + bj * 128 + n * 16;
                        const f32x4 v = (BASE_F32 ? *(const f32x4*)(BASE + off) : ld4h(XH + off)) + acc[ai][bj][m][n]; st4h(XH + off, v); ss += sumsq4(v); }
                ss += __shfl_xor(ss, 16); ss += __shfl_xor(ss, 32);
                if (fq == 0) atomicAdd(RS + row, ss); }
    }
};
struct EpiSwiGLU {
    h16* ACT; const float* RS;
    __device__ __forceinline__ void operator()(const Acc& acc, const Unit& u, int wr, int wc, int fr, int fq) const {
        const int row0 = u.pm * 256 + wr * 64 + fr;
#pragma unroll
        for (int ai = 0; ai < 2; ++ai)
#pragma unroll
            for (int m = 0; m < 4; ++m) { const int row = row0 + ai * 128 + m * 16; const float r = __builtin_amdgcn_rsqf(RS[row] * (1.0f / DM) + EPS);
#pragma unroll
                for (int bj = 0; bj < 2; ++bj) { const f32x4 g = acc[ai][bj][m][0] * r, uu = acc[ai][bj][m][1] * r; f32x4 o;
#pragma unroll
                    for (int j = 0; j < 4; ++j) o[j] = g[j] * sigmoidf_(g[j]) * uu[j];
                    st4h(ACT + (size_t)row * DFF + 16 * (u.pn * 8 + bj * 4 + wc) + 4 * fq, o); } }
    }
};
struct EpiStoreH {
    h16* O; int ldc;
    __device__ __forceinline__ void operator()(const Acc& acc, const Unit& u, int wr, int wc, int fr, int fq) const {
        const int row0 = u.pm * 256 + wr * 64 + fr, col0 = u.pn * 256 + 32 * wc + 4 * fq;
#pragma unroll
        for (int ai = 0; ai < 2; ++ai)
#pragma unroll
            for (int m = 0; m < 4; ++m)
#pragma unroll
                for (int bj = 0; bj < 2; ++bj)
#pragma unroll
                    for (int n = 0; n < 2; ++n) st4h(O + (size_t)(row0 + ai * 128 + m * 16) * ldc + col0 + bj * 128 + n * 16, acc[ai][bj][m][n]);
    }
};
struct EpiPLE {
    const h16* PP; const h16* XI; h16* XO; const float* RSIN; float* RSOUT;
    __device__ __forceinline__ void operator()(const Acc& acc, const Unit& u, int wr, int wc, int fr, int fq) const {
        const int row0 = u.pm * 256 + wr * 64 + fr, col0 = u.pn * 256 + 32 * wc + 4 * fq;
#pragma unroll
        for (int ai = 0; ai < 2; ++ai)
#pragma unroll
            for (int m = 0; m < 4; ++m) { const int row = row0 + ai * 128 + m * 16; const float r = __builtin_amdgcn_rsqf(RSIN[row] * (1.0f / DM) + EPS); float ss = 0.f;
#pragma unroll
                for (int bj = 0; bj < 2; ++bj)
#pragma unroll
                    for (int n = 0; n < 2; ++n) { const size_t off = (size_t)row * DM + col0 + bj * 128 + n * 16;
                        const f32x4 a = acc[ai][bj][m][n] * r, pp = ld4h(PP + off); f32x4 x = ld4h(XI + off);
#pragma unroll
                        for (int j = 0; j < 4; ++j) x[j] += sigmoidf_(a[j]) * pp[j];
                        st4h(XO + off, x); ss += sumsq4(x); }
                ss += __shfl_xor(ss, 16); ss += __shfl_xor(ss, 32);
                if (fq == 0) atomicAdd(RSOUT + row, ss); }
    }
};

__device__ __forceinline__ int map_in(int p) {
    if (p < 2560) return p;
    if (p < 2816) { const int c = p - 2560; if (c < 64) return 2560 + c; if (c < 80) return 2624 + (c - 64); if (c < 88) return 5712 + (c - 80); return -1; }
    const int q = p - 2816; if (q < 3072) return 2640 + q; return 5720 + (q - 3072);
}
template <int MODE>
__device__ __forceinline__ const float* tr_src(const float* W0, const float* W1, int Nsrc, int n) {
    if (MODE == 0) return n < Nsrc ? W0 + n : nullptr;
    if (MODE == 1) { const int c = map_in(n); return c >= 0 ? W0 + c : nullptr; }
    return (((n >> 4) & 1) ? W1 : W0) + 16 * (n >> 5) + (n & 15);
}
template <int MODE>
__device__ __forceinline__ void ph_transpose(const float* W0, const float* W1, const float* gk, int K, int Nsrc, h16* WT, int Nphys, LAS float* scr, int gw, int NGW, int lane) {
    const int nblk = Nphys / 32, nitems = (K / 64) * nblk;
    const int lr = lane >> 3, lc = (lane & 7) * 4;
    f32x4 cur[8], nxt[8];
    int item = gw;
    if (item < nitems) { const int kb = item / nblk, nb = item % nblk; const float* src = tr_src<MODE>(W0, W1, Nsrc, 32 * nb + lc);
#pragma unroll
        for (int i = 0; i < 8; ++i) cur[i] = src ? *(const f32x4*)(src + (size_t)(64 * kb + lr + 8 * i) * Nsrc) : (f32x4){0.f, 0.f, 0.f, 0.f}; }
    for (; item < nitems; item += NGW) {
        const int kb = item / nblk, nb = item % nblk, k0 = 64 * kb, n0 = 32 * nb;
        const int itn = item + NGW;
        if (itn < nitems) { const int kbn = itn / nblk, nbn = itn % nblk; const float* src = tr_src<MODE>(W0, W1, Nsrc, 32 * nbn + lc);
#pragma unroll
            for (int i = 0; i < 8; ++i) nxt[i] = src ? *(const f32x4*)(src + (size_t)(64 * kbn + lr + 8 * i) * Nsrc) : (f32x4){0.f, 0.f, 0.f, 0.f}; }
#pragma unroll
        for (int i = 0; i < 8; ++i) { LAS float* d = scr + (lr + 8 * i) * 33 + lc; const float gg = gk ? gk[k0 + lr + 8 * i] : 1.0f; d[0] = cur[i][0] * gg; d[1] = cur[i][1] * gg; d[2] = cur[i][2] * gg; d[3] = cur[i][3] * gg; }
        __builtin_amdgcn_wave_barrier(); asm volatile("s_waitcnt lgkmcnt(0)" ::: "memory");
        const int c = lane & 7;
#pragma unroll
        for (int j = 0; j < 4; ++j) { const int nn = (lane >> 3) + 8 * j; const LAS float* sp = scr + (8 * c) * 33 + nn;
            h16x8 o;
#pragma unroll
            for (int e = 0; e < 8; ++e) o[e] = (h16)sp[e * 33];
            *(h16x8*)(WT + (size_t)(n0 + nn) * K + k0 + 8 * c) = o; }
        __builtin_amdgcn_wave_barrier(); asm volatile("s_waitcnt lgkmcnt(0)" ::: "memory");
#pragma unroll
        for (int i = 0; i < 8; ++i) cur[i] = nxt[i];
    }
}
__device__ __forceinline__ void sincos_f32arg(float ang, float& sn, float& cs) {
    const double a = (double)ang;
    const double rev = a * 0.15915494309189535;
    const double fr = rev - __builtin_rint(rev);
    const double q4 = fr * 4.0; const double qi = __builtin_rint(q4); const int qq = ((int)qi) & 3;
    const double r = (q4 - qi) * 1.5707963267948966;
    const double r2 = r * r;
    const double s = r * (1.0 + r2 * (-1.0 / 6 + r2 * (1.0 / 120 + r2 * (-1.0 / 5040 + r2 * (1.0 / 362880 + r2 * (-1.0 / 39916800))))));
    const double c = 1.0 + r2 * (-0.5 + r2 * (1.0 / 24 + r2 * (-1.0 / 720 + r2 * (1.0 / 40320 + r2 * (-1.0 / 3628800 + r2 * (1.0 / 479001600))))));
    double so, co;
    if (qq == 0) { so = s; co = c; } else if (qq == 1) { so = c; co = -s; } else if (qq == 2) { so = -s; co = -c; } else { so = -c; co = s; }
    sn = (float)so; cs = (float)co;
}
__device__ __forceinline__ void ph_rope(const int* pos, float* ROPE, int gtid, int NGT) {
    for (int idx = gtid; idx < MTOK * 24; idx += NGT) {
        const int tok = idx / 24, i = idx % 24, k = i < 16 ? i : 2 * (i - 16);
        float f = 0x1.000000p+0f;
        f = k == 1 ? 0x1.c2ef76p-2f : f; f = k == 2 ? 0x1.8d275ep-3f : f; f = k == 3 ? 0x1.5dc95ap-4f : f; f = k == 4 ? 0x1.341190p-5f : f; f = k == 5 ? 0x1.0f5384p-6f : f;
        f = k == 6 ? 0x1.ddee9cp-8f : f; f = k == 7 ? 0x1.a4ee3ep-9f : f; f = k == 8 ? 0x1.72ba44p-10f : f; f = k == 9 ? 0x1.468318p-11f : f; f = k == 10 ? 0x1.1f91f0p-12f : f;
        f = k == 11 ? 0x1.fa8b84p-14f : f; f = k == 12 ? 0x1.be218ap-15f : f; f = k == 13 ? 0x1.88ec22p-16f : f; f = k == 14 ? 0x1.5a0f50p-17f : f; f = k == 15 ? 0x1.30c94ep-18f : f;
        const float ang = (float)pos[tok] * f;
        float sn, cs; sincos_f32arg(ang, sn, cs);
        float* rp = ROPE + (size_t)tok * 48;
        if (i < 16) { rp[i] = cs; rp[16 + i] = sn; } else { rp[32 + (i - 16)] = cs; rp[40 + (i - 16)] = sn; }
    }
}
template <bool TO_F32>
__device__ __forceinline__ void ph_rmsnorm(const float* X, const float* g, h16* OUTH, float* OUTF, int gw, int NGW, int lane) {
    for (int row = gw; row < MTOK; row += NGW) {
        const f32x4* xr = (const f32x4*)(X + (size_t)row * DM) + lane;
        f32x4 v[8]; float s = 0.f;
#pragma unroll
        for (int j = 0; j < 8; ++j) { v[j] = xr[64 * j]; s += (v[j][0] * v[j][0] + v[j][1] * v[j][1]) + (v[j][2] * v[j][2] + v[j][3] * v[j][3]); }
        const float r = 1.0f / sqrtf(wave_sum(s) * (1.0f / DM) + EPS);
#pragma unroll
        for (int j = 0; j < 8; ++j) { const f32x4 gg = *((const f32x4*)g + lane + 64 * j); const f32x4 o = v[j] * r * gg;
            if (TO_F32) *((f32x4*)(OUTF + (size_t)row * DM) + lane + 64 * j) = o; else st4h(OUTH + (size_t)row * DM + 4 * (lane + 64 * j), o); }
    }
}
__device__ __forceinline__ void ph_final(const h16* X, float* OUT, const float* g, const float* RS, int gw, int NGW, int lane) {
    for (int row = gw; row < MTOK; row += NGW) {
        const float r = __builtin_amdgcn_rsqf(RS[row] * (1.0f / DM) + EPS);
        h16x8 v[4];
#pragma unroll
        for (int j = 0; j < 4; ++j) v[j] = *((const h16x8*)(X + (size_t)row * DM) + lane + 64 * j);
#pragma unroll
        for (int j = 0; j < 4; ++j) { const float* gp = g + 8 * (lane + 64 * j); float* op = OUT + (size_t)row * DM + 8 * (lane + 64 * j);
            const f32x4 g0 = *(const f32x4*)gp, g1 = *(const f32x4*)(gp + 4);
            f32x4 o0 = {(float)v[j][0], (float)v[j][1], (float)v[j][2], (float)v[j][3]}, o1 = {(float)v[j][4], (float)v[j][5], (float)v[j][6], (float)v[j][7]};
            *(f32x4*)op = o0 * r * g0; *(f32x4*)(op + 4) = o1 * r * g1; }
    }
}
__device__ __forceinline__ void ph_cumsum(const float* LOGF, float* CBS, int bh, int lane) {
    const int b = bh >> 3, h = bh & 7;
    float v[64];
#pragma unroll
    for (int it = 0; it < 64; ++it) v[it] = LOGF[(size_t)(b * T + it * 64 + lane) * 8 + h];
    float run = 0.f;
#pragma unroll
    for (int it = 0; it < 64; ++it) {
        float x = v[it];
#pragma unroll
        for (int o = 1; o < 64; o <<= 1) { const float nb = __shfl_up(x, o); if (lane >= o) x += nb; }
        CBS[(size_t)bh * T + it * 64 + lane] = (run + x) * -11.313708498984761f;
        run += __shfl(x, 63);
    }
}

__device__ __forceinline__ unsigned fkey(float f) { const unsigned u = __float_as_uint(f + 0.0f); return (u & 0x80000000u) ? ~u : (u | 0x80000000u); }
__device__ __forceinline__ unsigned count_ge(const unsigned (&key)[64], unsigned th, int nj) {
    unsigned c = 0;
#pragma unroll
    for (int j8 = 0; j8 < 8; ++j8) {
        if (8 * j8 < nj) {
#pragma unroll
            for (int j = 8 * j8; j < 8 * j8 + 8; ++j) c += (key[j] >= th) ? 1u : 0u;
        }
    }
#pragma unroll
    for (int o = 1; o < 64; o <<= 1) c += __shfl_xor(c, o);
    return c;
}
__device__ __forceinline__ u64 topk_select(const unsigned (&key)[64], int nvalid, int lane) {
    u64 myword = 0;
    if (nvalid <= TOPK) {
#pragma unroll
        for (int j = 0; j < 64; ++j) { const u64 bal = __ballot(key[j] != 0u); if (lane == j) myword = bal; }
    } else {
        unsigned th = 0u; bool exact = false;
        for (int bit = 31; bit >= 0; --bit) { const unsigned tc = th | (1u << bit); const unsigned c = count_ge(key, tc, (nvalid + 63) >> 6); if (c >= (unsigned)TOPK) th = tc; if (c == (unsigned)TOPK) { exact = true; break; } }
        if (exact) {
#pragma unroll
            for (int j = 0; j < 64; ++j) { const u64 bal = __ballot(key[j] >= th); if (lane == j) myword = bal; }
        } else {
            unsigned cgt = 0;
#pragma unroll
            for (int j = 0; j < 64; ++j) cgt += (unsigned)__builtin_popcountll(__ballot(key[j] > th));
            int need = TOPK - (int)cgt;
#pragma unroll
            for (int j = 0; j < 64; ++j) { u64 eq = __ballot(key[j] == th); const u64 gt = __ballot(key[j] > th);
                int pc = __builtin_popcountll(eq);
                while (pc > need) { eq &= ~(1ull << (63 - __builtin_clzll(eq))); --pc; }
                need -= pc; if (lane == j) myword = gt | eq; }
        }
    }
    return myword;
}
template <int LVL>
__device__ __forceinline__ void hist_level(const unsigned (&key)[64], int nj, int lane, LAS unsigned* hist, unsigned& prefix, unsigned& need, unsigned& cnt_eq) {
    constexpr int SH = LVL == 0 ? 21 : (LVL == 1 ? 10 : 0), PSH = LVL == 1 ? 21 : 10, NB = LVL == 2 ? 10 : 11;
#pragma unroll
    for (int i = 0; i < 8; ++i) *(LAS u32x4*)(hist + lane * 32 + 4 * i) = (u32x4){0u, 0u, 0u, 0u};
    asm volatile("s_waitcnt lgkmcnt(0)" ::: "memory"); __builtin_amdgcn_wave_barrier();
#pragma unroll
    for (int j8 = 0; j8 < 8; ++j8) {
        if (8 * j8 < nj) {
            if (LVL == 0) {
#pragma unroll
                for (int j = 8 * j8; j < 8 * j8 + 8; ++j) __hip_atomic_fetch_add(hist + (key[j] >> 21), 1u, __ATOMIC_RELAXED, __HIP_MEMORY_SCOPE_WORKGROUP);
            } else {
                bool any = false;
#pragma unroll
                for (int j = 8 * j8; j < 8 * j8 + 8; ++j) any = any || ((key[j] >> PSH) == prefix);
                if (LVL == 1 || __any(any)) {
#pragma unroll
                    for (int j = 8 * j8; j < 8 * j8 + 8; ++j) { const unsigned k = key[j];
                        if ((k >> PSH) == prefix) __hip_atomic_fetch_add(hist + ((k >> SH) & ((1u << NB) - 1u)), 1u, __ATOMIC_RELAXED, __HIP_MEMORY_SCOPE_WORKGROUP); }
                }
            }
        }
    }
    asm volatile("s_waitcnt lgkmcnt(0)" ::: "memory"); __builtin_amdgcn_wave_barrier();
    unsigned s = 0;
#pragma unroll
    for (int i = 0; i < 8; ++i) { const u32x4 v = *(const LAS u32x4*)(hist + lane * 32 + 4 * i); s += (v[0] + v[1]) + (v[2] + v[3]); }
    unsigned S = s;
#pragma unroll
    for (int o = 1; o < 64; o <<= 1) { const unsigned nb = __shfl_down(S, o); if (lane + o < 64) S += nb; }
    const int L = 63 - __builtin_clzll(__ballot(S >= need));
    const unsigned aboveL = __shfl(S - s, L);
    const int bi = lane & 31;
    const unsigned hb = hist[L * 32 + bi];
    unsigned R = hb;
#pragma unroll
    for (int o = 1; o < 32; o <<= 1) { const unsigned nb = __shfl_down(R, o); if (bi + o < 32) R += nb; }
    const int B = 31 - __builtin_clz((unsigned)__ballot(aboveL + R >= need));
    const unsigned abB = __shfl(aboveL + R - hb, B);
    cnt_eq = __shfl(hb, B);
    prefix = (prefix << NB) | (unsigned)(L * 32 + B);
    need -= abB;
    __builtin_amdgcn_wave_barrier();
}
__device__ __forceinline__ u64 topk_select_hist(const unsigned (&key)[64], int nvalid, int lane, LAS unsigned* hist) {
    const int nj = (nvalid + 63) >> 6;
    unsigned prefix = 0, need = TOPK, cnt_eq = 0;
    hist_level<0>(key, nj, lane, hist, prefix, need, cnt_eq);
    hist_level<1>(key, nj, lane, hist, prefix, need, cnt_eq);
    hist_level<2>(key, nj, lane, hist, prefix, need, cnt_eq);
    u64 mw = 0;
    if (need == cnt_eq) {
#pragma unroll
        for (int j = 0; j < 64; ++j) { const u64 bal = __ballot(key[j] >= prefix); if (lane == j) mw = bal; }
    } else {
        int nd = (int)need;
#pragma unroll
        for (int j = 0; j < 64; ++j) { u64 eq = __ballot(key[j] == prefix); const u64 gt = __ballot(key[j] > prefix);
            int pc = __builtin_popcountll(eq);
            while (pc > nd) { eq &= ~(1ull << (63 - __builtin_clzll(eq))); --pc; }
            nd -= pc; if (lane == j) mw = gt | eq; }
    }
    return mw;
}
__device__ __forceinline__ void ph_topk_naive(const h16* QI, const h16* KI, const float* WI, u64* MASK, LAS float* qs, LAS unsigned* ks, int gw, int NGW, int lane) {
    for (int row = gw; row < MTOK; row += NGW) {
        const int b = row >> 12, t = row & 4095;
        { const h16* qp = QI + (size_t)row * 1024 + lane * 16;
#pragma unroll
          for (int i = 0; i < 16; ++i) qs[lane * 16 + i] = (float)qp[i]; }
        if (lane < 16) qs[1024 + lane] = WI[(size_t)row * 16 + lane];
        __builtin_amdgcn_wave_barrier(); asm volatile("s_waitcnt lgkmcnt(0)" ::: "memory");
#pragma unroll 1
        for (int j = 0; j < 64; ++j) {
            unsigned kk = 0u;
            const int s = 64 * j + lane;
            if (s <= t) {
                float kf[64];
                const h16x8* kp = (const h16x8*)(KI + (size_t)(b * T + s) * 64);
#pragma unroll
                for (int c = 0; c < 8; ++c) { const h16x8 kv = kp[c];
#pragma unroll
                    for (int e = 0; e < 8; ++e) kf[c * 8 + e] = (float)kv[e]; }
                float sc = 0.f;
#pragma unroll 1
                for (int h = 0; h < 16; ++h) { float d = 0.f;
#pragma unroll
                    for (int e = 0; e < 64; ++e) d = fmaf(qs[h * 64 + e], kf[e], d);
                    sc = fmaf(qs[1024 + h], fmaxf(d, 0.f), sc); }
                kk = fkey(sc);
            }
            ks[j * 64 + lane] = kk;
        }
        __builtin_amdgcn_wave_barrier(); asm volatile("s_waitcnt lgkmcnt(0)" ::: "memory");
        unsigned key[64];
#pragma unroll
        for (int j = 0; j < 64; ++j) key[j] = ks[j * 64 + lane];
        MASK[(size_t)row * 64 + lane] = topk_select(key, t + 1, lane);
        __builtin_amdgcn_wave_barrier(); asm volatile("s_waitcnt lgkmcnt(0)" ::: "memory");
    }
}


namespace idx {
typedef short s16x8 __attribute__((ext_vector_type(8)));
typedef float f32x16 __attribute__((ext_vector_type(16)));
constexpr int CHK = 128, CHB = CHK * 128;
__device__ __forceinline__ unsigned half_sum(unsigned v) {
#pragma unroll
    for (int o = 1; o < 32; o <<= 1) v += __shfl_xor(v, o);
    return v;
}
__device__ __forceinline__ void run_group(unsigned char* ws, char* lds, unsigned* scr, int b, int g, int wv) {
    int tid = wv * 64 + lane_id(); asm volatile("" : "+v"(tid));
    const int wid = __builtin_amdgcn_readfirstlane(tid >> 6), lane = tid & 63, c = lane & 31, hi = lane >> 5;
    const int t0 = 16 * g + 2 * wid, t = t0 + hi, row = b * T + t, tmaxblk = 16 * g + 15, nch = (tmaxblk >> 7) + 1;
    const h16* QI = (const h16*)(ws + WS_QI); const char* KIb = (const char*)ws + WS_KI + (size_t)b * T * 128; const float* WI = (const float*)(ws + WS_WI);
    s16x8 A[4];
    { const int rho = c, qsel = (rho >> 2) & 1, head = (rho & 3) + 4 * (rho >> 3);
      const h16* qp = QI + (size_t)(b * T + t0 + qsel) * 1024 + head * 64 + 8 * hi;
#pragma unroll
      for (int ks = 0; ks < 4; ++ks) A[ks] = *reinterpret_cast<const s16x8*>(qp + 16 * ks); }
    float w[16];
    { const f32x4* wp = (const f32x4*)(WI + (size_t)row * 16);
#pragma unroll
      for (int i = 0; i < 4; ++i) { const f32x4 v = wp[i]; w[4 * i] = v[0]; w[4 * i + 1] = v[1]; w[4 * i + 2] = v[2]; w[4 * i + 3] = v[3]; } }
    const int pr0 = tid >> 3, pp = tid & 7;
    const unsigned g_off = (unsigned)(pr0 * 128 + pp * 16);
    const int l_off0 = pr0 * 128 + ((pp ^ ((pr0 >> 1) & 7)) << 4), l_off1 = l_off0 + 64 * 128;
    const int rd_base = c * 128; const int sw = (c >> 1) & 7;
    int rd_off[4];
#pragma unroll
    for (int ks = 0; ks < 4; ++ks) rd_off[ks] = rd_base + (((2 * ks + hi) ^ sw) << 4);
    unsigned* myscr = scr + (size_t)(2 * wid + hi) * T + c;
    asm volatile("" :: "v"(A[0]), "v"(A[1]), "v"(A[2]), "v"(A[3]), "v"(w[0]), "v"(w[4]), "v"(w[8]), "v"(w[12]));
    s16x8 st0, st1;
    { const char* src = KIb; st0 = *reinterpret_cast<const s16x8*>(src + g_off); st1 = *reinterpret_cast<const s16x8*>(src + 64 * 128 + g_off); }
    *reinterpret_cast<s16x8*>(lds + l_off0) = st0; *reinterpret_cast<s16x8*>(lds + l_off1) = st1;
    __syncthreads();
#pragma unroll 1
    for (int ch = 0; ch < nch; ++ch) {
        const char* buf = lds + (ch & 1) * CHB;
        if (ch + 1 < nch) { const char* src = KIb + (size_t)(ch + 1) * CHB; st0 = *reinterpret_cast<const s16x8*>(src + g_off); st1 = *reinterpret_cast<const s16x8*>(src + 64 * 128 + g_off); }
#pragma unroll
        for (int st = 0; st < 4; ++st) {
            f32x16 acc = {};
#pragma unroll
            for (int ks = 0; ks < 4; ++ks) { const s16x8 Bf = *reinterpret_cast<const s16x8*>(buf + st * 4096 + rd_off[ks]);
                acc = __builtin_amdgcn_mfma_f32_32x32x16_f16(__builtin_bit_cast(h16x8, A[ks]), __builtin_bit_cast(h16x8, Bf), acc, 0, 0, 0); }
            float sc = 0.f;
#pragma unroll
            for (int r = 0; r < 16; ++r) { const int ri = __float_as_int(acc[r]); sc = fmaf(w[r], __int_as_float(ri > 0 ? ri : 0), sc); }
            const int sidx = ch * CHK + st * 32 + c;
            myscr[ch * CHK + st * 32] = (sidx <= t) ? fkey(sc) : 0u;
        }
        if (ch + 1 < nch) { char* dst = lds + ((ch + 1) & 1) * CHB; *reinterpret_cast<s16x8*>(dst + l_off0) = st0; *reinterpret_cast<s16x8*>(dst + l_off1) = st1; }
        __syncthreads();
    }
    asm volatile("s_waitcnt vmcnt(0)" ::: "memory");
    u64* MASK = (u64*)(ws + WS_MASK);
#pragma unroll 1
    for (int qq = 0; qq < 2; ++qq) {
        const int tq = t0 + qq, nj = (tq >> 6) + 1;
        const unsigned* src = scr + (size_t)(2 * wid + qq) * T + lane;
        unsigned key[64];
#pragma unroll
        for (int j = 0; j < 64; ++j) key[j] = (j < nj) ? __hip_atomic_load(src + 64 * j, __ATOMIC_RELAXED, __HIP_MEMORY_SCOPE_AGENT) : 0u;
        u64 mw;
        if (tq + 1 <= TOPK) {
            mw = 0;
#pragma unroll
            for (int j = 0; j < 4; ++j) { const u64 bal = __ballot(key[j] != 0u); if (lane == j) mw = bal; }
        } else mw = topk_select_hist(key, tq + 1, lane, (LAS unsigned*)(lds + 2 * CHB + wid * 8192));
        MASK[(size_t)(b * T + tq) * 64 + lane] = mw;
    }
}
}

namespace att {
constexpr int NW = 8, QBLK = 32, KVBLK = 64, QB = NW * QBLK, D = 128;
constexpr int SHM_V = KVBLK * D * 2, SHM_K = KVBLK * D * 2;
constexpr int LDS_NEED = 2 * SHM_V + 2 * SHM_K + NW * 64 * 4;
constexpr float THR = 8.f, SCALE = 0.08838834764831845f;
typedef short s16x8 __attribute__((ext_vector_type(8)));
typedef short s16x4 __attribute__((ext_vector_type(4)));
typedef float f32x16 __attribute__((ext_vector_type(16)));
#define KSWZ(row, colB) ((row) * 256 + ((colB) ^ (((row) & 7) << 4)))
#define SBAR() __builtin_amdgcn_sched_barrier(0)
__device__ __forceinline__ int v_st(int k, int c) { const int kk = (k & ~0xC) | ((k & 4) << 1) | ((k & 8) >> 1); return ((kk >> 3) * 4 + (c >> 5)) * 512 + ((kk & 7) * 32 + (c & 31)) * 2; }
__device__ __forceinline__ int v_rd_base(int lane) { return ((lane & 3) << 3) | (((lane >> 2) & 3) << 6) | (((lane >> 4) & 1) << 5) | (((lane >> 5) & 1) << 8); }
constexpr int v_rd_off(int d0, int ks, int half) { return d0 * 512 + ks * 4096 + half * 2048; }
__device__ __forceinline__ int crow(int r, int hi) { return (r & 3) + 8 * (r >> 2) + 4 * hi; }
__device__ __forceinline__ unsigned cvtpk(float lo, float hi) { unsigned r; asm volatile("v_cvt_pk_f16_f32 %0, %1, %2" : "=v"(r) : "v"(lo), "v"(hi)); return r; }
__device__ __forceinline__ f32x16 mfma16(s16x8 a, s16x8 b, f32x16 c) { return __builtin_amdgcn_mfma_f32_32x32x16_f16(__builtin_bit_cast(h16x8, a), __builtin_bit_cast(h16x8, b), c, 0, 0, 0); }
__device__ __forceinline__ s16x8 load8(const h16* p) { return *reinterpret_cast<const s16x8*>(p); }
__device__ __forceinline__ void mask_causal(f32x16& p0, f32x16& p1, int dq) {
    const float NEG = -__builtin_inff();
#pragma unroll
    for (int r = 0; r < 16; ++r) { const int c = (r & 3) + 8 * (r >> 2); if (dq - c < 0) p0[r] = NEG; if (dq - c - 32 < 0) p1[r] = NEG; }
}
__device__ __forceinline__ void mask_bits(f32x16& p0, f32x16& p1, u64 w, int hi) {
    const float NEG = -__builtin_inff();
    const unsigned lo = (unsigned)w >> (4 * hi), up = (unsigned)(w >> 32) >> (4 * hi);
#pragma unroll
    for (int r = 0; r < 16; ++r) { const int c = (r & 3) + 8 * (r >> 2); if (!((lo >> c) & 1u)) p0[r] = NEG; if (!((up >> c) & 1u)) p1[r] = NEG; }
}
__device__ __forceinline__ void partialSM(f32x16& p0, f32x16& p1, float& m_reg, float& mn, float& alpha) {
    float pmax = p0[0]; for (int r = 1; r < 16; ++r) pmax = fmaxf(pmax, p0[r]); for (int r = 0; r < 16; ++r) pmax = fmaxf(pmax, p1[r]);
    { auto rr = __builtin_amdgcn_permlane32_swap(__float_as_uint(pmax), __float_as_uint(pmax), false, false);
      pmax = fmaxf(__uint_as_float(rr[0]), __uint_as_float(rr[1])); }
    constexpr float C2 = 1.4426950408889634f * SCALE;
    if (__builtin_expect(__all((pmax - m_reg) * SCALE <= THR), 1)) { mn = m_reg; alpha = 1.f; }
    else { mn = fmaxf(m_reg, pmax); alpha = __builtin_amdgcn_exp2f((m_reg - mn) * C2); m_reg = mn; }
    const float mnL = -mn * C2;
    for (int r = 0; r < 16; ++r) p0[r] = fmaf(p0[r], C2, mnL); for (int r = 0; r < 16; ++r) p1[r] = fmaf(p1[r], C2, mnL);
    for (int r = 0; r < 16; ++r) p0[r] = __builtin_amdgcn_exp2f(p0[r]);
}
__device__ __forceinline__ void finishSM(f32x16& p0, f32x16& p1, float alpha, float& l_reg, s16x8& pa0, s16x8& pa1, s16x8& pa2, s16x8& pa3) {
    for (int r = 0; r < 16; ++r) p1[r] = __builtin_amdgcn_exp2f(p1[r]);
    float ps = 0; for (int r = 0; r < 16; ++r) ps += p0[r]; for (int r = 0; r < 16; ++r) ps += p1[r];
    { auto rr = __builtin_amdgcn_permlane32_swap(__float_as_uint(ps), __float_as_uint(ps), false, false);
      ps = __uint_as_float(rr[0]) + __uint_as_float(rr[1]); }
    l_reg = l_reg * alpha + ps;
#define PK4(P, B_, OUT) do { unsigned a0 = cvtpk(P[B_+0], P[B_+1]), a1 = cvtpk(P[B_+2], P[B_+3]);                          \
        unsigned b0 = cvtpk(P[B_+4], P[B_+5]), b1 = cvtpk(P[B_+6], P[B_+7]);                                             \
        auto r0 = __builtin_amdgcn_permlane32_swap(a0, b0, false, false); auto r1 = __builtin_amdgcn_permlane32_swap(a1, b1, false, false); \
        u32x4 w = {r0[0], r1[0], r0[1], r1[1]}; OUT = *reinterpret_cast<s16x8*>(&w); } while (0)
    PK4(p0, 0, pa0); PK4(p0, 8, pa1); PK4(p1, 0, pa2); PK4(p1, 8, pa3);
#undef PK4
}
template <int KB>
__device__ __forceinline__ void qkt(f32x16& p0, f32x16& p1, const char* K_lds, int r32, int hi, const s16x8* qr) {
    const char* kb[4];
#pragma unroll
    for (int dd = 0; dd < 4; ++dd) kb[dd] = K_lds + KB * SHM_K + KSWZ(r32, (dd * 16 + hi * 8) * 2);
#pragma unroll
    for (int d0 = 0; d0 < 8; ++d0) { const char* a = kb[d0 & 3] + (d0 >> 2) * 128;
        s16x8 b0 = *reinterpret_cast<const s16x8*>(a);
        s16x8 b1 = *reinterpret_cast<const s16x8*>(a + 32 * 256);
        p0 = mfma16(b0, qr[d0], p0);
        p1 = mfma16(b1, qr[d0], p1); }
}
template <int VB>
__device__ __forceinline__ void pv_tile(f32x16* o, int vb0, s16x8 pa0, s16x8 pa1, s16x8 pa2, s16x8 pa3) {
#define TRRD(dst, off) asm volatile("ds_read_b64_tr_b16 %0, %1 offset:%2" : "=&v"(dst) : "v"(vb0), "i"(off) : "memory")
#define PV_D0(d0) do { s16x4 l0, l1, l2, l3, h0, h1, h2, h3; constexpr int b_ = VB * SHM_V + v_rd_off(d0, 0, 0); \
        TRRD(l0, b_); TRRD(h0, b_ + 2048); TRRD(l1, b_ + 4096); TRRD(h1, b_ + 6144); TRRD(l2, b_ + 8192); TRRD(h2, b_ + 10240); TRRD(l3, b_ + 12288); TRRD(h3, b_ + 14336); \
        asm volatile("s_waitcnt lgkmcnt(0)" ::: "memory"); SBAR();   \
        o[d0] = mfma16(pa0, (s16x8){l0[0], l0[1], l0[2], l0[3], h0[0], h0[1], h0[2], h0[3]}, o[d0]);   \
        o[d0] = mfma16(pa1, (s16x8){l1[0], l1[1], l1[2], l1[3], h1[0], h1[1], h1[2], h1[3]}, o[d0]);   \
        o[d0] = mfma16(pa2, (s16x8){l2[0], l2[1], l2[2], l2[3], h2[0], h2[1], h2[2], h2[3]}, o[d0]);   \
        o[d0] = mfma16(pa3, (s16x8){l3[0], l3[1], l3[2], l3[3], h3[0], h3[1], h3[2], h3[3]}, o[d0]); } while (0)
    PV_D0(0); PV_D0(1); PV_D0(2); PV_D0(3);
#undef PV_D0
#undef TRRD
}
struct BlockRef { const char* Q; const char* K; const char* V; char* O; int P0; const char* NBQ; const char* MK; };
struct Seam { s16x8 qr[8]; s16x8 st_v0, st_v1, st_k0, st_k1; };
#define LD16(base, off) (*reinterpret_cast<const s16x8*>((base) + (off)))
#define VMW() asm volatile("s_waitcnt vmcnt(0)" ::: "memory")
#define VMWN(n) asm volatile("s_waitcnt vmcnt(%0)" :: "i"(n) : "memory")
#define SLOAD_H(Kp, Vp, k0) do { const char* vb_ = (Vp) + (size_t)(k0) * (D * 2); const char* kb_ = (Kp) + (size_t)(k0) * (D * 2); \
        S.st_v0 = LD16(vb_, st_off); S.st_v1 = LD16(vb_ + 32 * D * 2, st_off); S.st_k0 = LD16(kb_, st_off); S.st_k1 = LD16(kb_ + 32 * D * 2, st_off); } while (0)
#define SWRITE_HK(bf) do { *(s16x8*)(K_lds + (bf) * SHM_K + kws) = S.st_k0; *(s16x8*)(K_lds + (bf) * SHM_K + kws + 32 * 256) = S.st_k1; } while (0)
#define SWRITE_HV(bf) do { *(s16x8*)(V_lds + (bf) * SHM_V + vst0) = S.st_v0; *(s16x8*)(V_lds + (bf) * SHM_V + vst1) = S.st_v1; } while (0)
#define SWRITE_H(bf) do { SWRITE_HV(bf); SWRITE_HK(bf); } while (0)
__device__ __forceinline__ void prime(const BlockRef& cur, char* lds, Seam& S, int wv) {
    int tid = wv * 64 + lane_id(); asm volatile("" : "+v"(tid));
    const int wid = __builtin_amdgcn_readfirstlane(tid >> 6), lane = tid & 63, r32 = lane & 31, hi = lane >> 5;
    const int sr = tid >> 4, sc = (tid & 15) * 8, kws = KSWZ(sr, sc * 2); char* K_lds = lds + 2 * SHM_V;
    const unsigned st_off = (unsigned)(sr * D + sc) * 2u, q_off = (unsigned)((wid * QBLK + r32) * D + hi * 8) * 2u;
#pragma unroll
    for (int d0 = 0; d0 < 8; ++d0) S.qr[d0] = LD16(cur.Q + d0 * 32, q_off);
    SLOAD_H(cur.K, cur.V, 0); VMW(); SWRITE_HK(0);
    __syncthreads();
}
template <bool MIXB>
__device__ __forceinline__ void block(const BlockRef& cur, const BlockRef& nxt, char* lds, Seam& S, int wv) {
    int tid = wv * 64 + lane_id(); asm volatile("" : "+v"(tid));
    const int wid = __builtin_amdgcn_readfirstlane(tid >> 6), lane = tid & 63, r32 = lane & 31, hi = lane >> 5;
    const int NT = cur.P0 / KVBLK + 4;
    const int qlo = cur.P0 + wid * QBLK, qm = qlo + r32 - 4 * hi;
    char* V_lds = lds; char* K_lds = lds + 2 * SHM_V;
    float* wsf = (float*)(lds + 2 * SHM_V + 2 * SHM_K) + wid * 64; float* li_l = wsf, * al_l = wsf + 32;
    float m_reg = -1e30f, l_reg = 0; f32x16 o[4] = {};
    const int sr = tid >> 4, sc = (tid & 15) * 8, vst0 = v_st(sr, sc), vst1 = v_st(32 + sr, sc), kws = KSWZ(sr, sc * 2);
    const int vb0 = (int)(uintptr_t)V_lds + v_rd_base(lane);
    const unsigned st_off = (unsigned)(sr * D + sc) * 2u, q_off = (unsigned)((wid * QBLK + r32) * D + hi * 8) * 2u;
    const unsigned nb_off = (unsigned)hi * 16u, mk_off = (unsigned)(wid * QBLK + r32) * 512u;
    const char* Kh = cur.K; const char* Vh = cur.V;
    const char* bias_l = lds + LDS_NEED;
    if (MIXB) { const float nbref = *(const float*)(cur.NBQ + (size_t)(cur.P0 + QB - 1) * 4);
        for (int i = tid; i < cur.P0 + QB; i += NW * 64) ((float*)bias_l)[i] = ((const float*)cur.NBQ)[i] - nbref;
        __syncthreads(); }
#define RESC(a) do { if (__any((a) < 1.f)) { if (hi == 0) al_l[r32] = (a); asm volatile("s_waitcnt lgkmcnt(0)" ::: "memory");              \
                     for (int d_ = 0; d_ < 4; ++d_) for (int r = 0; r < 16; ++r) o[d_][r] *= al_l[crow(r, hi)]; } } while (0)
#define KBASE(t) ((t) * KVBLK)
#define PINIT(P0_, P1_, t) do { if (MIXB) { const char* nb_ = bias_l + KBASE(t) * 4 + nb_off; _Pragma("unroll") for (int g_ = 0; g_ < 4; ++g_) { \
            const f32x4 b0_ = *(const f32x4*)(nb_ + 32 * g_), b1_ = *(const f32x4*)(nb_ + 128 + 32 * g_); \
            _Pragma("unroll") for (int j_ = 0; j_ < 4; ++j_) { P0_[4 * g_ + j_] = b0_[j_]; P1_[4 * g_ + j_] = b1_[j_]; } } } else { P0_ = f32x16{}; P1_ = f32x16{}; } } while (0)
#define MKW(t) (*(const u64*)(cur.MK + (size_t)(t) * 8 + mk_off))
#define MASKT(P0_, P1_, t, MW_) do { if (MIXB) { const int kb_ = KBASE(t); if (kb_ + KVBLK - 1 > qlo) mask_causal(P0_, P1_, qm - kb_); } else mask_bits(P0_, P1_, MW_, hi); } while (0)
    f32x16 pA0, pA1, pB0, pB1; float mnA, mnB, alA, alB; s16x8 pa0, pa1, pa2, pa3;
    u64 mwA = 0, mwB = 0;
    if (!MIXB) { mwA = MKW(0); if (NT > 1) mwB = MKW(1); }
    PINIT(pA0, pA1, 0);
    if (NT > 1) PINIT(pB0, pB1, 1);
    SWRITE_HV(0); SBAR();
    if (NT > 1) SLOAD_H(Kh, Vh, KBASE(1));
    SBAR(); qkt<0>(pA0, pA1, K_lds, r32, hi, S.qr);
    MASKT(pA0, pA1, 0, mwA); if (!MIXB) { if (NT > 2) mwA = MKW(2); }
    partialSM(pA0, pA1, m_reg, mnA, alA);
    if (NT > 1) { VMW(); SWRITE_H(1); }
    __syncthreads();
#define HALF_STEP(PX0, PX1, mnX, alX, MWX, PY0, PY1, alY, t, KB, VB, SB) do {                                               \
        SBAR(); qkt<KB>(PX0, PX1, K_lds, r32, hi, S.qr);                                                                      \
        finishSM(PY0, PY1, alY, l_reg, pa0, pa1, pa2, pa3); SBAR();                                                           \
        if ((t) + 1 < NT) { PINIT(PY0, PY1, (t) + 1); SLOAD_H(Kh, Vh, KBASE((t) + 1)); SBAR(); }                             \
        pv_tile<VB>(o, vb0, pa0, pa1, pa2, pa3); MASKT(PX0, PX1, (t), MWX); if (!MIXB) { if ((t) + 2 < NT) MWX = MKW((t) + 2); } \
        partialSM(PX0, PX1, m_reg, mnX, alX);                                                                                 \
        __syncthreads();                                                                                                      \
        if ((t) + 1 < NT) { VMW(); SWRITE_H(SB); }                                                                            \
        RESC(alX); __syncthreads(); } while (0)
    for (int t = 1; t + 1 < NT; t += 2) {
        HALF_STEP(pB0, pB1, mnB, alB, mwB, pA0, pA1, alA, t, 1, 0, 0);
        HALF_STEP(pA0, pA1, mnA, alA, mwA, pB0, pB1, alB, t + 1, 0, 1, 1);
    }
    const bool even = (NT & 1) == 0;
    if (even) { SBAR(); qkt<1>(pB0, pB1, K_lds, r32, hi, S.qr); SBAR(); }
    SLOAD_H(nxt.K, nxt.V, 0); SBAR();
#pragma unroll
    for (int d0 = 0; d0 < 8; ++d0) S.qr[d0] = LD16(nxt.Q + d0 * 32, q_off);
    SBAR();
    finishSM(pA0, pA1, alA, l_reg, pa0, pa1, pa2, pa3); SBAR();
    pv_tile<0>(o, vb0, pa0, pa1, pa2, pa3);
    if (even) { MASKT(pB0, pB1, NT - 1, mwB); partialSM(pB0, pB1, m_reg, mnB, alB); __syncthreads(); RESC(alB);
        finishSM(pB0, pB1, alB, l_reg, pa0, pa1, pa2, pa3); SBAR(); pv_tile<1>(o, vb0, pa0, pa1, pa2, pa3); }
    SBAR(); VMWN(8); SWRITE_HK(0); SBAR();
    if (hi == 0) li_l[r32] = l_reg; asm volatile("s_waitcnt lgkmcnt(0)" ::: "memory");
    float rli[16];
#pragma unroll
    for (int r = 0; r < 16; ++r) rli[r] = __builtin_amdgcn_rcpf(li_l[crow(r, hi)]);
    const unsigned o_off = (unsigned)((wid * QBLK + 4 * hi) * 1024 + r32) * 2u;
#pragma unroll
    for (int r = 0; r < 16; ++r) {
#pragma unroll
        for (int d0 = 0; d0 < 4; ++d0) { const float v = o[d0][r] * rli[r];
            const float vn = __shfl_xor(v, 1);
            if ((r32 & 1) == 0) *(unsigned*)(cur.O + (size_t)(((r & 3) + 8 * (r >> 2)) * 2048 + d0 * 64) + o_off) = cvtpk(v, vn); } }
    __syncthreads();
#undef RESC
#undef KBASE
#undef PINIT
#undef MKW
#undef MASKT
#undef HALF_STEP
}
#undef LD16
#undef VMW
#undef VMWN
#undef SLOAD_H
#undef SWRITE_HK
#undef SWRITE_HV
#undef SWRITE_H
__device__ __forceinline__ BlockRef make_ref(bool mixb, unsigned char* ws, int bh, int qb) {
    const int b = bh >> 3, h = bh & 7, kvh = mixb ? bh : (b * HAKV + (h >> 2));
    BlockRef r;
    r.Q = (const char*)ws + (mixb ? WS_QB : WS_QA) + ((size_t)bh * T + (size_t)qb * QB) * D * 2;
    r.K = (const char*)ws + (mixb ? WS_KB : WS_KA) + (size_t)kvh * T * D * 2;
    r.V = (const char*)ws + (mixb ? WS_VB : WS_VA) + (size_t)kvh * T * D * 2;
    r.O = (char*)ws + (mixb ? WS_OUTB : WS_OUTA) + ((size_t)(b * T + qb * QB) * 1024 + h * D) * 2;
    r.P0 = qb * QB;
    r.NBQ = (const char*)ws + WS_CB + (size_t)bh * T * 4;
    r.MK = (const char*)ws + WS_MASK + (size_t)(b * T + qb * QB) * 64 * 8;
    return r;
}
template <bool MIXB>
__device__ __forceinline__ void run_item(int item, unsigned char* ws, char* lds, int wv) {
    const int bh = (item >> 3) & 15, x = item & 7;
    Seam S;
    BlockRef cur = make_ref(MIXB, ws, bh, x);
    prime(cur, lds, S, wv);
#pragma unroll 1
    for (int pass = 0; pass < 2; ++pass) {
        const BlockRef nxt = make_ref(MIXB, ws, bh, 15 - x);
        block<MIXB>(cur, nxt, lds, S, wv);
        cur = nxt;
    }
}
}


#define XB_TMO      128
#define XB_XCNT(j)  (256  + 64 * (j))
#define XB_XSUB(j)  (1280 + 64 * (j))
#define XB_XGEN(j)  (2304 + 64 * (j))
#define XB_TOP      3328
#define XB_TOPGEN   3392
#define XCD_BAR_WORDS 3456
#define XB_SPIN_CAP (1u << 24)
__device__ __forceinline__ unsigned xb_ld(unsigned* p)              { return __hip_atomic_load(p, __ATOMIC_RELAXED, __HIP_MEMORY_SCOPE_AGENT); }
__device__ __forceinline__ unsigned xb_add(unsigned* p, unsigned v) { return __hip_atomic_fetch_add(p, v, __ATOMIC_RELAXED, __HIP_MEMORY_SCOPE_AGENT); }
__device__ __forceinline__ unsigned xb_xcc_id() { return (unsigned)__builtin_amdgcn_s_getreg((3 << 11) | 20) & 0xFu; }
#define XB_SPIN(cond, bar) do { unsigned _sp = 0; while (cond) { __builtin_amdgcn_s_sleep(1); \
    if ((++_sp & 255u) == 0u) { if (xb_ld(&(bar)[XB_TMO])) break; if (_sp > XB_SPIN_CAP) { atomicAdd(&(bar)[XB_TMO], 1u); break; } } } } while (0)
struct XcdBarrier { unsigned* bar; unsigned x; volatile LAS unsigned* st; };
__device__ __forceinline__ XcdBarrier xcd_barrier_post(unsigned* bar, volatile LAS unsigned* st, int wv) {
    XcdBarrier b; b.bar = bar; b.x = xb_xcc_id(); b.st = st;
    if (wv == 0 && lane_id() == 0) (void)xb_add(&bar[XB_XCNT(b.x)], 1u);
    return b;
}
__device__ __forceinline__ void xcd_barrier_complete(unsigned* bar, unsigned x, unsigned& nloc, unsigned& nx) {
    const unsigned G = gridDim.x * gridDim.y * gridDim.z;
    unsigned sum, cnt, mine, sp = 0u;
    for (;;) {
        sum = 0u; cnt = 0u; mine = 0u;
#pragma unroll
        for (unsigned j = 0; j < 16; ++j) { const unsigned c = xb_ld(&bar[XB_XCNT(j)]); sum += c; cnt += (c > 0u) ? 1u : 0u; mine = (j == x) ? c : mine; }
        if (sum == G) break;
        __builtin_amdgcn_s_sleep(1);
        if ((++sp & 255u) == 0u) { if (xb_ld(&bar[XB_TMO])) break; if (sp > XB_SPIN_CAP) { atomicAdd(&bar[XB_TMO], 1u); break; } }
    }
    nloc = mine > 0u ? mine : 1u; nx = cnt > 0u ? cnt : 1u;
}
__device__ __forceinline__ void xcd_barrier(const XcdBarrier& b, int wv) {
    asm volatile("s_waitcnt vmcnt(0)" ::: "memory");
    __syncthreads();
    if (wv == 0 && lane_id() == 0) {
        unsigned* bar = b.bar;
        __builtin_amdgcn_s_waitcnt(0);
        unsigned nloc = b.st[0], nx = b.st[1];
        if (nloc == 0u) { xcd_barrier_complete(bar, b.x, nloc, nx); b.st[0] = nloc; b.st[1] = nx; }
        const unsigned old = xb_add(&bar[XB_XSUB(b.x)], 1u);
        const unsigned gen = old / nloc;
        if (old + 1u == (gen + 1u) * nloc) {
            __builtin_amdgcn_fence(__ATOMIC_RELEASE, "agent");
            asm volatile("s_waitcnt vmcnt(0)" ::: "memory");
            const unsigned og = xb_add(&bar[XB_TOP], 1u);
            const unsigned tg = og / nx;
            if (og + 1u == (tg + 1u) * nx) xb_add(&bar[XB_TOPGEN], 1u);
            else XB_SPIN(xb_ld(&bar[XB_TOPGEN]) == tg, bar);
            __builtin_amdgcn_fence(__ATOMIC_ACQUIRE, "agent");
            xb_add(&bar[XB_XGEN(b.x)], 1u);
            asm volatile("s_waitcnt vmcnt(0)" ::: "memory");
        } else {
            XB_SPIN(xb_ld(&bar[XB_XGEN(b.x)]) == gen, bar);
            __builtin_amdgcn_fence(__ATOMIC_ACQUIRE, "agent");
            asm volatile("s_waitcnt vmcnt(0)" ::: "memory");
        }
    }
    __syncthreads();
}

namespace cg = cooperative_groups;
#ifndef PROBE_DUP
#define PROBE_DUP 0
#endif
#define REP(k) for (int rep_ = 0; rep_ < (((PROBE_DUP) >> (k)) & 1) + 1; ++rep_)
constexpr int LDS_BYTES = pg8::STAGE_BYTES + 256;
constexpr int CW_BAR = 4096;
struct Params { const float* in[17]; float* out; unsigned char* ws; };
template <class Epi>
__device__ __forceinline__ void run_gemm(LAS unsigned char* lds, const h16* A, const h16* Bt, int M, int N, int K, const Epi& e, int wv) {
    pg8::Gemm g{A, Bt, M, N, K}; pg8::StaticOrder S; S.init(M, N, (int)gridDim.x, (int)blockIdx.x);
    pg8::gemm_phase<Epi>(lds, g, S, e, wv);
}
__global__ void __launch_bounds__(512, 2) mega_fwd(Params P) {
    extern __shared__ __attribute__((aligned(16))) unsigned char lds_raw[];
    LAS unsigned char* lds = (LAS unsigned char*)lds_raw;
    const int wv = __builtin_amdgcn_readfirstlane(threadIdx.x >> 6);
    volatile LAS unsigned* bst = (volatile LAS unsigned*)(lds + pg8::STAGE_BYTES);
    if (wv == 0 && lane_id() < 2) bst[lane_id()] = 0u;
    __syncthreads();
    const XcdBarrier xbar = xcd_barrier_post((unsigned*)(P.ws + WS_CTL) + CW_BAR, bst, wv);
#define GRID_BAR() xcd_barrier(xbar, wv)
#define IDS() int lane = lane_id(); asm volatile("" : "+v"(lane)); const int wave = wv, tid = wave * 64 + lane, gw = blockIdx.x * 8 + wave, NGW = gridDim.x * 8; (void)tid; (void)gw; (void)NGW
    const float* x = P.in[0]; const float* p = P.in[1]; const int* pos = (const int*)P.in[2];
    const float* g_mix = P.in[3]; const float* w_in = P.in[4]; const float* b_f = P.in[5];
    const float* w_o_a = P.in[6]; const float* w_o_b = P.in[7]; const float* w_out = P.in[8];
    const float* g_ffn = P.in[9]; const float* w_g = P.in[10]; const float* w_u = P.in[11]; const float* w_d = P.in[12];
    const float* g_ple = P.in[13]; const float* w_pg = P.in[14]; const float* w_pp = P.in[15]; const float* g_final = P.in[16];
    unsigned char* ws = P.ws; float* out = P.out;
    float* RS = (float*)(ws + WS_RS); float* ROPE = (float*)(ws + WS_ROPE); float* CB = (float*)(ws + WS_CB); float* LOGF = (float*)(ws + WS_LOGF); u64* MASK = (u64*)(ws + WS_MASK);
    h16* WIN = (h16*)(ws + WS_WIN); h16* WOA = (h16*)(ws + WS_WOA); h16* WOB = (h16*)(ws + WS_WOB); h16* WOUT = (h16*)(ws + WS_WOUT);
    h16* WGU = (h16*)(ws + WS_WGU); h16* WDN = (h16*)(ws + WS_WDN); h16* WPG = (h16*)(ws + WS_WPG); h16* WPP = (h16*)(ws + WS_WPP);
    h16* QI = (h16*)(ws + WS_QI); h16* KI = (h16*)(ws + WS_KI); float* WI = (float*)(ws + WS_WI);
    h16* SIGA = (h16*)(ws + WS_SIGA); h16* SIGB = (h16*)(ws + WS_SIGB);
    h16* OUTA = (h16*)(ws + WS_OUTA); h16* OUTB = (h16*)(ws + WS_OUTB); h16* P16 = (h16*)(ws + WS_P16);
    h16* X3H = (h16*)(ws + WS_SIGA);
    h16* MIXED = (h16*)(ws + WS_MIXED); h16* H2 = (h16*)(ws + WS_H2); h16* ACT = (h16*)(ws + WS_ACT); h16* PP = (h16*)(ws + WS_PP);
    h16* H1 = (h16*)P.out;

    REP(0) { IDS(); LAS float* scr = (LAS float*)(lds + wave * 8448);
      ph_transpose<1>(w_in, nullptr, nullptr, DM, N_IN, WIN, N_INP, scr, gw, NGW, lane);
      ph_transpose<0>(w_o_a, nullptr, nullptr, 1024, DM, WOA, DM, scr, gw, NGW, lane);
      ph_transpose<0>(w_o_b, nullptr, nullptr, 1024, DM, WOB, DM, scr, gw, NGW, lane);
      ph_transpose<0>(w_out, nullptr, nullptr, DM, DM, WOUT, DM, scr, gw, NGW, lane);
      ph_transpose<2>(w_g, w_u, g_ffn, DM, DFF, WGU, 2 * DFF, scr, gw, NGW, lane);
      ph_transpose<0>(w_d, nullptr, nullptr, DFF, DM, WDN, DM, scr, gw, NGW, lane);
      ph_transpose<0>(w_pg, nullptr, g_ple, DM, DM, WPG, DM, scr, gw, NGW, lane);
      ph_transpose<0>(w_pp, nullptr, nullptr, DPLE, DM, WPP, DM, scr, gw, NGW, lane);
      ph_rope(pos, ROPE, blockIdx.x * 512 + tid, gridDim.x * 512);
      for (int i = blockIdx.x * 512 + tid; i < 3 * MTOK; i += gridDim.x * 512) RS[i] = 0.f;
      ph_rmsnorm<false>(x, g_mix, H1, nullptr, gw, NGW, lane);
    }
    GRID_BAR();
    REP(1) { EpiInProj e{ws, b_f}; run_gemm(lds, H1, WIN, MTOK, N_INP, DM, e, wv); }
    GRID_BAR();
    REP(2) { IDS();
      if (gw >= NGW - 16) ph_cumsum(LOGF, CB, NGW - 1 - gw, lane);
      for (int it = blockIdx.x; it < 256; it += gridDim.x) { const int bb = it & 1, gi = it >> 1;
#pragma unroll 1
          for (int pass = 0; pass < 2; ++pass) idx::run_group(ws, (char*)lds_raw, (unsigned*)out + (size_t)blockIdx.x * 16 * T, bb, pass ? 255 - gi : gi, wv); }
      for (int i = blockIdx.x * 512 + tid; i < MTOK * DPLE / 4; i += gridDim.x * 512) st4h(P16 + 4 * (size_t)i, *((const f32x4*)p + i));
    }
    GRID_BAR();
    REP(3) for (int it = blockIdx.x; it < 256; it += gridDim.x) {
        const int item = (it & 7) * 32 + (it >> 3);
        if (item < 128) att::run_item<false>(item, ws, (char*)lds_raw, wv); else att::run_item<true>(item, ws, (char*)lds_raw, wv);
    }
    GRID_BAR();
    REP(4) { { EpiGate<true> e{SIGA, MIXED}; run_gemm(lds, OUTA, WOA, MTOK, DM, 1024, e, wv); }
    { EpiGate<false> e{SIGB, MIXED}; run_gemm(lds, OUTB, WOB, MTOK, DM, 1024, e, wv); } }
    GRID_BAR();
    REP(5) { EpiResidNorm<true> e{x, H2, RS}; run_gemm(lds, MIXED, WOUT, MTOK, DM, DM, e, wv); }
    GRID_BAR();
    REP(6) { EpiSwiGLU e{ACT, RS}; run_gemm(lds, H2, WGU, MTOK, 2 * DFF, DM, e, wv); }
    GRID_BAR();
    { EpiResidNorm<false> e{nullptr, H2, RS + MTOK}; run_gemm(lds, ACT, WDN, MTOK, DM, DFF, e, wv); }
    GRID_BAR();
    { EpiStoreH e{PP, DM}; run_gemm(lds, P16, WPP, MTOK, DM, DPLE, e, wv); }
    { EpiPLE e{PP, H2, X3H, RS + MTOK, RS + 2 * MTOK}; run_gemm(lds, H2, WPG, MTOK, DM, DM, e, wv); }
    GRID_BAR();
    { IDS(); ph_final(X3H, out, g_final, RS + 2 * MTOK, gw, NGW, lane); }
#undef IDS
#undef GRID_BAR
}

extern "C" void kernel_launch(void* const* d_in, const int* in_sizes, int n_in, void* d_out, int out_size, void* d_ws, size_t ws_size, hipStream_t stream) {
    if (n_in != 17 || out_size != MTOK * DM || ws_size < WS_END) { fprintf(stderr, "kernel_launch: unexpected shapes / workspace (%d inputs, out %d, ws %zu)\n", n_in, out_size, ws_size); return; }
    static int grid_blocks = 0;
    if (!grid_blocks) {
        int dev = 0, cus = 0, per_cu = 0;
        (void)hipGetDevice(&dev);
        (void)hipDeviceGetAttribute(&cus, hipDeviceAttributeMultiprocessorCount, dev);
        (void)hipFuncSetAttribute((const void*)mega_fwd, hipFuncAttributeMaxDynamicSharedMemorySize, LDS_BYTES);
        (void)hipOccupancyMaxActiveBlocksPerMultiprocessor(&per_cu, (const void*)mega_fwd, 512, LDS_BYTES);
        if (per_cu < 1) { fprintf(stderr, "kernel_launch: occupancy query says %d blocks per CU\n", per_cu); per_cu = 1; }
        if (per_cu > 1) per_cu = 1;
        grid_blocks = cus * per_cu;
    }
    (void)hipMemsetAsync((char*)d_ws + WS_CTL, 0, 64 * 1024, stream);
    Params prm{};
    for (int i = 0; i < 17; ++i) prm.in[i] = (const float*)d_in[i];
    prm.out = (float*)d_out; prm.ws = (unsigned char*)d_ws;
    void* args[] = {&prm};
    hipError_t e = hipLaunchCooperativeKernel((const void*)mega_fwd, dim3(grid_blocks), dim3(512), args, LDS_BYTES, stream);
    if (e != hipSuccess) fprintf(stderr, "cooperative launch failed: %s (grid %d)\n", hipGetErrorString(e), grid_blocks);
}
```

```cpp
#include <hip/hip_runtime.h>
#include <hip/hip_cooperative_groups.h>
#include <stdint.h>
#include <cstdio>

#define LAS __attribute__((address_space(3)))
typedef _Float16 h16;
typedef _Float16 h16x8 __attribute__((ext_vector_type(8)));
typedef _Float16 h16x4 __attribute__((ext_vector_type(4)));
typedef _Float16 h16x2 __attribute__((ext_vector_type(2)));
typedef float f32x4 __attribute__((ext_vector_type(4)));
typedef float f32x2 __attribute__((ext_vector_type(2)));
typedef unsigned u32x4 __attribute__((ext_vector_type(4)));
typedef unsigned u32x2 __attribute__((ext_vector_type(2)));
typedef unsigned long long u64;
__device__ __forceinline__ int lane_id() { int r; asm volatile("v_mbcnt_lo_u32_b32 %0, -1, 0\n\tv_mbcnt_hi_u32_b32 %0, -1, %0" : "=v"(r)); return r; }

constexpr int NBATCH = 2, T = 4096, MTOK = NBATCH * T, DM = 2048;
constexpr int HA = 8, HAKV = 2, HIDX = 16, DIDX = 64, HB = 8, HD = 128;
constexpr int N_IN = 9816, N_INP = 9984, DFF = 5632, DPLE = 256, TOPK = 256;
constexpr float EPS = 1e-6f;
constexpr float ATT_SCALE = 0.08838834764831845f;

constexpr size_t MiB = 1u << 20;
constexpr size_t WS_CTL = 0;
constexpr size_t WS_RS = 512 * 1024;
constexpr size_t WS_ROPE = 1 * MiB;
constexpr size_t WS_CB = 3 * MiB;
constexpr size_t WS_LOGF = 3 * MiB + 512 * 1024;
constexpr size_t WS_MASK = 4 * MiB;
constexpr size_t WS_WIN = 8 * MiB;
constexpr size_t WS_OUTA = 8 * MiB, WS_OUTB = 24 * MiB, WS_P16 = 40 * MiB;
constexpr size_t WS_WOA = 47 * MiB, WS_WOB = 51 * MiB, WS_WOUT = 55 * MiB, WS_WGU = 63 * MiB, WS_WDN = 107 * MiB, WS_WPG = 129 * MiB, WS_WPP = 137 * MiB;
constexpr size_t WS_QA = 138 * MiB, WS_KA = 154 * MiB, WS_VA = 158 * MiB, WS_QI = 162 * MiB, WS_KI = 178 * MiB, WS_WI = 179 * MiB;
constexpr size_t WS_QB = 180 * MiB, WS_KB = 196 * MiB, WS_VB = 212 * MiB, WS_SIGA = 228 * MiB, WS_SIGB = 260 * MiB, WS_NBQ = 292 * MiB, WS_END = 296 * MiB;
constexpr size_t WS_MIXED = WS_QB;
constexpr size_t WS_H2 = WS_QA;
constexpr size_t WS_ACT = WS_QB;
constexpr size_t WS_PP = WS_QB;

namespace pg8 {
constexpr int BM = 256, BK = 64, HALF = 128, HTB = HALF * BK * 2, STAGE_BYTES = 8 * HTB, NXCD = 8, WGM = 4;
__host__ __device__ __forceinline__ int lds_byte(int r, int c) { const int st = (r >> 4) * 2 + (c >> 5), rr = r & 15, cc = c & 31, ob = rr * 64 + cc * 2; return st * 1024 + (ob ^ (((ob >> 9) & 1) << 5)); }
__host__ __device__ __forceinline__ int perm32(int rho) { const int n = rho >> 4, i = rho & 15; return 8 * (i >> 2) + 4 * n + (i & 3); }
__host__ __device__ __forceinline__ void stage_rc(int b, int& R, int& C) { const int st = b / 1024, sb = b % 1024, swz = sb ^ (((sb >> 9) & 1) << 5); R = (st >> 1) * 16 + swz / 64; C = (st & 1) * 32 + (swz % 64) / 2; }
struct Unit { int pm, pn; };
struct Gemm { const h16* A; const h16* Bt; int M, N, K; };
struct StaticOrder {
    int nM, nN, nwg, G, c;
    __host__ __device__ void init(int M, int N, int G_, int c_) { nM = M / BM; nN = N / BM; nwg = nM * nN; G = G_; c = c_; }
    __host__ __device__ bool next(int i, Unit& u) const {
        const long L = (long)i * G + c; if (L >= nwg) return false;
        int wgid = (int)L; { const int q = nwg / NXCD, r = nwg % NXCD, xcd = wgid % NXCD, off = wgid / NXCD; wgid = (xcd < r ? xcd * (q + 1) : r * (q + 1) + (xcd - r) * q) + off; }
        const int nig = WGM * nN, gid = wgid / nig, fm = gid * WGM, gsz = (nM - fm) < WGM ? (nM - fm) : WGM;
        u.pm = fm + ((wgid % nig) % gsz); u.pn = (wgid % nig) / gsz; return true;
    }
};
template <class Epi>
__device__ __forceinline__ void gemm_phase(LAS unsigned char* lds, const Gemm g, const StaticOrder& S, const Epi& E, int wv) {
    int tid = wv * 64 + lane_id(); asm volatile("" : "+v"(tid));
    const int wid = __builtin_amdgcn_readfirstlane(tid >> 6), lane = tid & 63, wr = wid >> 2, wc = wid & 3, fr = lane & 15, fq = lane >> 4;
    const int K = g.K, nt = K / BK;
    unsigned voffA[2], voffBp[2];
#pragma unroll
    for (int i = 0; i < 2; ++i) { int R, C; stage_rc(tid * 16 + i * 8192, R, C); voffA[i] = (unsigned)(R * K + C) * 2u; voffBp[i] = (unsigned)(((R & ~31) + perm32(R & 31)) * K + C) * 2u; }
    const size_t kstep = (size_t)(BK * 2);
    const size_t hstep = (size_t)HALF * K * 2;
    const size_t tstep = 2 * hstep;
    const unsigned ldsw = (unsigned)wid * 1024u;
    const int aoff = lds_byte(wr * 64 + fr, fq * 8), boff = lds_byte(wc * 32 + fr, fq * 8);
#define PG8_SA(b, h) (((b) * 2 + (h)) * HTB)
#define PG8_SB(b, h) ((4 + (b) * 2 + (h)) * HTB)
#define PG8_STAGE(bufoff, gbase) do { _Pragma("unroll") for (int _i = 0; _i < 2; ++_i) \
        __builtin_amdgcn_global_load_lds((const unsigned*)((const char*)(gbase) + voffA[_i]), (LAS unsigned*)(lds + (bufoff) + ldsw + _i * 8192), 16, 0, 0); } while (0)
#define PG8_STAGEB(bufoff, gbase, pf) do { _Pragma("unroll") for (int _i = 0; _i < 2; ++_i) \
        __builtin_amdgcn_global_load_lds((const unsigned*)((const char*)(gbase) + ((pf) ? voffBp[_i] : voffA[_i])), (LAS unsigned*)(lds + (bufoff) + ldsw + _i * 8192), 16, 0, 0); } while (0)
#define PG8_LDA(dst, b, h) do { _Pragma("unroll") for (int m = 0; m < 4; ++m) _Pragma("unroll") for (int k = 0; k < 2; ++k) dst[m][k] = *(const LAS h16x8*)(lds + PG8_SA(b, h) + aoff + m * 2048 + k * 1024); } while (0)
#define PG8_LDB(dst, b, h) do { _Pragma("unroll") for (int n = 0; n < 2; ++n) _Pragma("unroll") for (int k = 0; k < 2; ++k) dst[n][k] = *(const LAS h16x8*)(lds + PG8_SB(b, h) + boff + n * 2048 + k * 1024); } while (0)
#define PG8_MMA(ai, bj, At, Bt) do { __builtin_amdgcn_s_setprio(1); _Pragma("unroll") for (int m = 0; m < 4; ++m) _Pragma("unroll") for (int n = 0; n < 2; ++n) _Pragma("unroll") for (int k = 0; k < 2; ++k) \
        acc[ai][bj][m][n] = __builtin_amdgcn_mfma_f32_16x16x32_f16(Bt[n][k], At[m][k], acc[ai][bj][m][n], 0, 0, 0); __builtin_amdgcn_s_setprio(0); } while (0)
#define PG8_WAIT_V(n) asm volatile("s_waitcnt vmcnt(" #n ")" ::: "memory")
#define PG8_WAIT_L(n) asm volatile("s_waitcnt lgkmcnt(" #n ")" ::: "memory")
#define PG8_BAR __builtin_amdgcn_s_barrier()
#define PG8_SCHED __builtin_amdgcn_sched_barrier(0)
    Unit cur, nxt; int ui = 0;
    if (!S.next(0, cur)) return;
    f32x4 acc[2][2][4][2];
#pragma unroll
    for (int a = 0; a < 2; ++a)
#pragma unroll
        for (int b = 0; b < 2; ++b)
#pragma unroll
            for (int m = 0; m < 4; ++m)
#pragma unroll
                for (int n = 0; n < 2; ++n) acc[a][b][m][n] = (f32x4){0.f, 0.f, 0.f, 0.f};
    h16x8 At[4][2], B0[2][2], B1[2][2];
    const char* cA = (const char*)g.A + (size_t)cur.pm * tstep; const char* cB = (const char*)g.Bt + (size_t)cur.pn * tstep;
    bool pfc = Epi::perm(cur.pn);
    PG8_STAGEB(PG8_SB(0, 0), cB, pfc); PG8_STAGE(PG8_SA(0, 0), cA); PG8_STAGEB(PG8_SB(0, 1), cB + hstep, pfc); PG8_STAGE(PG8_SA(0, 1), cA + hstep);
    if (wr == 1) PG8_BAR;
    PG8_WAIT_V(4); PG8_BAR;
    PG8_STAGEB(PG8_SB(1, 0), cB + kstep, pfc); PG8_STAGE(PG8_SA(1, 0), cA + kstep); PG8_STAGEB(PG8_SB(1, 1), cB + hstep + kstep, pfc);
    PG8_WAIT_V(6); PG8_BAR;
    for (;;) {
        const bool has_next = S.next(ui + 1, nxt);
        const char* nA = has_next ? (const char*)g.A + (size_t)nxt.pm * tstep : cA; const char* nB = has_next ? (const char*)g.Bt + (size_t)nxt.pn * tstep : cB;
        const bool pfn = has_next ? Epi::perm(nxt.pn) : pfc;
        for (int t = 0; t < nt; t += 2) {
            const bool last = (t == nt - 2);
            const char* a1 = cA + (size_t)(t + 1) * kstep;
            const char* a2 = last ? nA : cA + (size_t)(t + 2) * kstep; const char* b2 = last ? nB : cB + (size_t)(t + 2) * kstep;
            const char* a3 = a2 + kstep; const char* b3 = b2 + kstep;
            const bool pf2 = last ? pfn : pfc;
            PG8_LDB(B0, 0, 0); PG8_SCHED; PG8_LDA(At, 0, 0); PG8_STAGE(PG8_SA(1, 1), a1 + hstep);
            PG8_WAIT_L(8); PG8_BAR; PG8_WAIT_L(0); PG8_MMA(0, 0, At, B0); PG8_BAR; PG8_SCHED;
            PG8_LDB(B1, 0, 1); PG8_STAGEB(PG8_SB(0, 0), b2, pf2);
            PG8_BAR; PG8_WAIT_L(0); PG8_MMA(0, 1, At, B1); PG8_BAR;
            PG8_LDA(At, 0, 1); PG8_STAGE(PG8_SA(0, 0), a2);
            PG8_BAR; PG8_WAIT_L(0); PG8_MMA(1, 0, At, B0); PG8_BAR; PG8_SCHED;
            PG8_STAGEB(PG8_SB(0, 1), b2 + hstep, pf2);
            PG8_WAIT_V(6); PG8_BAR; PG8_MMA(1, 1, At, B1); PG8_BAR;
            PG8_LDB(B0, 1, 0); PG8_SCHED; PG8_LDA(At, 1, 0); PG8_STAGE(PG8_SA(0, 1), a2 + hstep);
            PG8_WAIT_L(8); PG8_BAR; PG8_WAIT_L(0); PG8_MMA(0, 0, At, B0); PG8_BAR; PG8_SCHED;
            PG8_LDB(B1, 1, 1); PG8_STAGEB(PG8_SB(1, 0), b3, pf2);
            PG8_BAR; PG8_WAIT_L(0); PG8_MMA(0, 1, At, B1); PG8_BAR;
            PG8_LDA(At, 1, 1); PG8_STAGE(PG8_SA(1, 0), a3);
            PG8_BAR; PG8_WAIT_L(0); PG8_MMA(1, 0, At, B0); PG8_BAR; PG8_SCHED;
            PG8_STAGEB(PG8_SB(1, 1), b3 + hstep, pf2);
            PG8_WAIT_V(6); PG8_BAR; PG8_MMA(1, 1, At, B1); PG8_BAR;
        }
        E(acc, cur, wr, wc, fr, fq);
        if (!has_next) break;
#pragma unroll
        for (int a = 0; a < 2; ++a)
#pragma unroll
            for (int b = 0; b < 2; ++b)
#pragma unroll
                for (int m = 0; m < 4; ++m)
#pragma unroll
                    for (int n = 0; n < 2; ++n) acc[a][b][m][n] = (f32x4){0.f, 0.f, 0.f, 0.f};
        cur = nxt; cA = nA; cB = nB; pfc = pfn; ++ui;
    }
    PG8_WAIT_V(0);
    if (wr == 0) PG8_BAR;
    PG8_BAR;
#undef PG8_SA
#undef PG8_SB
#undef PG8_STAGE
#undef PG8_STAGEB
#undef PG8_LDA
#undef PG8_LDB
#undef PG8_MMA
#undef PG8_WAIT_V
#undef PG8_WAIT_L
#undef PG8_BAR
#undef PG8_SCHED
}
}
using pg8::Unit;
typedef f32x4 Acc[2][2][4][2];

__device__ __forceinline__ void st4h(h16* p, f32x4 v) { h16x4 o; o[0] = (h16)v[0]; o[1] = (h16)v[1]; o[2] = (h16)v[2]; o[3] = (h16)v[3]; *(h16x4*)p = o; }
__device__ __forceinline__ void st8h(h16* p, f32x4 a, f32x4 b) { h16x8 o; o[0] = (h16)a[0]; o[1] = (h16)a[1]; o[2] = (h16)a[2]; o[3] = (h16)a[3]; o[4] = (h16)b[0]; o[5] = (h16)b[1]; o[6] = (h16)b[2]; o[7] = (h16)b[3]; *(h16x8*)p = o; }
__device__ __forceinline__ void ld8h(const h16* p, f32x4& a, f32x4& b) { const h16x8 o = *(const h16x8*)p; a = (f32x4){(float)o[0], (float)o[1], (float)o[2], (float)o[3]}; b = (f32x4){(float)o[4], (float)o[5], (float)o[6], (float)o[7]}; }
__device__ __forceinline__ f32x4 ld4h(const h16* p) { const h16x4 o = *(const h16x4*)p; return (f32x4){(float)o[0], (float)o[1], (float)o[2], (float)o[3]}; }
__device__ __forceinline__ float sigmoidf_(float x) { return __builtin_amdgcn_rcpf(1.0f + __expf(-x)); }
__device__ __forceinline__ float logsigmoidf_(float z) { return fminf(z, 0.f) - __logf(1.0f + __expf(-fabsf(z))); }
__device__ __forceinline__ float wave_sum(float v) {
#pragma unroll
    for (int o = 1; o < 64; o <<= 1) v += __shfl_xor(v, o);
    return v;
}

struct EpiInProj {
    static __device__ __forceinline__ bool perm(int pn) { return pn == 5 || pn >= 11; }
    unsigned char* ws; const float* b_f;
    __device__ __forceinline__ void operator()(const Acc& acc, const Unit& u, int wr, int wc, int fr, int fq) const {
        const int pn = u.pn, row0 = u.pm * 256 + wr * 64 + fr;
        const float* ROPE = (const float*)(ws + WS_ROPE);
#pragma unroll
        for (int ai = 0; ai < 2; ++ai)
#pragma unroll
            for (int m = 0; m < 4; ++m) {
                const int row = row0 + ai * 128 + m * 16, b = row >> 12, t = row & 4095;
                const float* rp = ROPE + (size_t)row * 48;
#pragma unroll
                for (int bj = 0; bj < 2; ++bj) {
                    f32x4 v0 = acc[ai][bj][m][0], v1 = acc[ai][bj][m][1];
                    const int d0 = 32 * wc + 4 * fq;
                    const int d8 = 32 * wc + 8 * fq;
                    if (pn < 6) {
                        size_t off;
                        if (pn < 4) off = WS_QA + (((size_t)(b * HA + pn * 2 + bj) * T + t) * HD) * 2;
                        else off = (pn == 4 ? WS_KA : WS_VA) + (((size_t)(b * HAKV + bj) * T + t) * HD) * 2;
                        h16* dst = (h16*)(ws + off);
                        if (pn < 5 && wc == 0) {
                            const f32x4 c = *(const f32x4*)(rp + 4 * fq), s = *(const f32x4*)(rp + 16 + 4 * fq);
                            const f32x4 y0 = v0 * c - v1 * s, y1 = v1 * c + v0 * s; v0 = y0; v1 = y1;
                        }
                        if (pn == 5) st8h(dst + d8, v0, v1); else { st4h(dst + d0, v0); st4h(dst + d0 + 16, v1); }
                    } else if (pn < 11) {
                        const bool is_q = pn < 10;
                        if (is_q || bj == 0) {
                            if (is_q || wc < 2) {
                                const int dd = 32 * (wc & 1) + 4 * fq;
                                const size_t off = is_q ? WS_QI + ((size_t)row * 1024 + ((pn - 6) * 4 + 2 * bj + (wc >> 1)) * 64) * 2 : WS_KI + ((size_t)row * 64) * 2;
                                h16* dst = (h16*)(ws + off);
                                if ((wc & 1) == 0) {
                                    f32x4 pr;
#pragma unroll
                                    for (int j = 0; j < 4; ++j) pr[j] = __shfl_xor(v0[j], 32);
                                    const f32x4 c = *(const f32x4*)(rp + 32 + 4 * (fq & 1)), s = *(const f32x4*)(rp + 40 + 4 * (fq & 1));
                                    v0 = (fq < 2) ? (v0 * c - pr * s) : (v0 * c + pr * s);
                                }
                                st4h(dst + dd, v0); st4h(dst + dd + 16, v1);
                            } else if (wc == 2) {
                                *(f32x4*)((float*)(ws + WS_WI) + (size_t)row * 16 + 4 * fq) = v0 * 0.03125f;
                                if (fq < 2) { const f32x4 bf = *(const f32x4*)(b_f + 4 * fq); f32x4 o;
#pragma unroll
                                    for (int j = 0; j < 4; ++j) o[j] = logsigmoidf_(v1[j] + bf[j]);
                                    *(f32x4*)((float*)(ws + WS_LOGF) + (size_t)row * 8 + 4 * fq) = o; }
                            }
                        }
                    } else if (pn < 23) {
                        const int q = pn - 11, which = q >> 2, head = (q & 3) * 2 + bj;
                        h16* dst = (h16*)(ws + WS_QB + (size_t)which * (WS_KB - WS_QB)) + ((size_t)(b * HB + head) * T + t) * HD;
                        st8h(dst + d8, v0, v1);
                    } else {
                        const int q = pn - 23; const int col = (q & 7) * 256 + 128 * bj + d8;
                        h16* base = (h16*)(ws + WS_SIGA + (size_t)(q >> 3) * (WS_SIGB - WS_SIGA));
#pragma unroll
                        for (int j = 0; j < 4; ++j) { v0[j] = sigmoidf_(v0[j]); v1[j] = sigmoidf_(v1[j]); }
                        st8h(base + (size_t)row * DM + col, v0, v1);
                    }
                }
            }
    }
};
static_assert(WS_VB - WS_KB == WS_KB - WS_QB, "QB/KB/VB equally spaced");
template <bool FIRST> struct EpiGate {
    static __device__ __forceinline__ bool perm(int) { return true; }
    const h16* SIG; h16* MIXED;
    __device__ __forceinline__ void operator()(const Acc& acc, const Unit& u, int wr, int wc, int fr, int fq) const {
        const int row0 = u.pm * 256 + wr * 64 + fr, col0 = u.pn * 256 + 32 * wc + 8 * fq;
#pragma unroll
        for (int ai = 0; ai < 2; ++ai)
#pragma unroll
            for (int m = 0; m < 4; ++m)
#pragma unroll
                for (int bj = 0; bj < 2; ++bj) { const size_t off = (size_t)(row0 + ai * 128 + m * 16) * DM + col0 + bj * 128;
                    f32x4 s0, s1; ld8h(SIG + off, s0, s1); f32x4 v0 = s0 * acc[ai][bj][m][0], v1 = s1 * acc[ai][bj][m][1];
                    if (!FIRST) { f32x4 m0, m1; ld8h(MIXED + off, m0, m1); v0 += m0; v1 += m1; }
                    st8h(MIXED + off, v0, v1); }
    }
};
__device__ __forceinline__ float sumsq4(f32x4 v) { return (v[0] * v[0] + v[1] * v[1]) + (v[2] * v[2] + v[3] * v[3]); }
template <bool BASE_F32> struct EpiResidNorm {
    static __device__ __forceinline__ bool perm(int) { return true; }
    const float* BASE; h16* XH; float* RS;
    __device__ __forceinline__ void operator()(const Acc& acc, const Unit& u, int wr, int wc, int fr, int fq) const {
        const int row0 = u.pm * 256 + wr * 64 + fr, col0 = u.pn * 256 + 32 * wc + 8 * fq;
#pragma unroll
        for (int ai = 0; ai < 2; ++ai)
#pragma unroll
            for (int m = 0; m < 4; ++m) { const int row = row0 + ai * 128 + m * 16; float ss = 0.f;
#pragma unroll
                for (int bj = 0; bj < 2; ++bj) { const size_t off = (size_t)row * DM + col0 + bj * 128;
                    f32x4 b0, b1; if (BASE_F32) { b0 = *(const f32x4*)(BASE + off); b1 = *(const f32x4*)(BASE + off + 4); } else ld8h(XH + off, b0, b1);
                    const f32x4 v0 = b0 + acc[ai][bj][m][0], v1 = b1 + acc[ai][bj][m][1]; st8h(XH + off, v0, v1); ss += sumsq4(v0) + sumsq4(v1); }
                ss += __shfl_xor(ss, 16); ss += __shfl_xor(ss, 32);
                if (fq == 0) atomicAdd(RS + row, ss); }
    }
};
struct EpiSwiGLU {
    static __device__ __forceinline__ bool perm(int) { return false; }
    h16* ACT; const float* RS;
    __device__ __forceinline__ void operator()(const Acc& acc, const Unit& u, int wr, int wc, int fr, int fq) const {
        const int row0 = u.pm * 256 + wr * 64 + fr;
#pragma unroll
        for (int ai = 0; ai < 2; ++ai)
#pragma unroll
            for (int m = 0; m < 4; ++m) { const int row = row0 + ai * 128 + m * 16; const float r = __builtin_amdgcn_rsqf(RS[row] * (1.0f / DM) + EPS);
#pragma unroll
                for (int bj = 0; bj < 2; ++bj) { const f32x4 g = acc[ai][bj][m][0] * r, uu = acc[ai][bj][m][1] * r; f32x4 o;
#pragma unroll
                    for (int j = 0; j < 4; ++j) o[j] = g[j] * sigmoidf_(g[j]) * uu[j];
                    st4h(ACT + (size_t)row * DFF + 16 * (u.pn * 8 + bj * 4 + wc) + 4 * fq, o); } }
    }
};
struct EpiStoreH {
    static __device__ __forceinline__ bool perm(int) { return true; }
    h16* O; int ldc;
    __device__ __forceinline__ void operator()(const Acc& acc, const Unit& u, int wr, int wc, int fr, int fq) const {
        const int row0 = u.pm * 256 + wr * 64 + fr, col0 = u.pn * 256 + 32 * wc + 8 * fq;
#pragma unroll
        for (int ai = 0; ai < 2; ++ai)
#pragma unroll
            for (int m = 0; m < 4; ++m)
#pragma unroll
                for (int bj = 0; bj < 2; ++bj) st8h(O + (size_t)(row0 + ai * 128 + m * 16) * ldc + col0 + bj * 128, acc[ai][bj][m][0], acc[ai][bj][m][1]);
    }
};
struct EpiPLE {
    static __device__ __forceinline__ bool perm(int) { return true; }
    const h16* PP; const h16* XI; h16* XO; const float* RSIN; float* RSOUT;
    __device__ __forceinline__ void operator()(const Acc& acc, const Unit& u, int wr, int wc, int fr, int fq) const {
        const int row0 = u.pm * 256 + wr * 64 + fr, col0 = u.pn * 256 + 32 * wc + 8 * fq;
#pragma unroll
        for (int ai = 0; ai < 2; ++ai)
#pragma unroll
            for (int m = 0; m < 4; ++m) { const int row = row0 + ai * 128 + m * 16; const float r = __builtin_amdgcn_rsqf(RSIN[row] * (1.0f / DM) + EPS); float ss = 0.f;
#pragma unroll
                for (int bj = 0; bj < 2; ++bj) { const size_t off = (size_t)row * DM + col0 + bj * 128;
                    const f32x4 a0 = acc[ai][bj][m][0] * r, a1 = acc[ai][bj][m][1] * r; f32x4 p0, p1, x0, x1; ld8h(PP + off, p0, p1); ld8h(XI + off, x0, x1);
#pragma unroll
                    for (int j = 0; j < 4; ++j) { x0[j] += sigmoidf_(a0[j]) * p0[j]; x1[j] += sigmoidf_(a1[j]) * p1[j]; }
                    st8h(XO + off, x0, x1); ss += sumsq4(x0) + sumsq4(x1); }
                ss += __shfl_xor(ss, 16); ss += __shfl_xor(ss, 32);
                if (fq == 0) atomicAdd(RSOUT + row, ss); }
    }
};

__device__ __forceinline__ int map_in(int p) {
    if (p < 2560) return p;
    if (p < 2816) { const int c = p - 2560; if (c < 64) return 2560 + c; if (c < 80) return 2624 + (c - 64); if (c < 88) return 5712 + (c - 80); return -1; }
    const int q = p - 2816; if (q < 3072) return 2640 + q; return 5720 + (q - 3072);
}
template <int MODE>
__device__ __forceinline__ const float* tr_src(const float* W0, const float* W1, int Nsrc, int n) {
    if (MODE == 0) return n < Nsrc ? W0 + n : nullptr;
    if (MODE == 1) { const int c = map_in(n); return c >= 0 ? W0 + c : nullptr; }
    return (((n >> 4) & 1) ? W1 : W0) + 16 * (n >> 5) + (n & 15);
}
template <int MODE>
__device__ __forceinline__ void ph_transpose(const float* W0, const float* W1, const float* gk, int K, int Nsrc, h16* WT, int Nphys, LAS float* scr, int gw, int NGW, int lane) {
    const int nblk = Nphys / 32, nitems = (K / 64) * nblk;
    const int lr = lane >> 3, lc = (lane & 7) * 4;
    f32x4 cur[8], nxt[8];
    int item = gw;
    if (item < nitems) { const int kb = item / nblk, nb = item % nblk; const float* src = tr_src<MODE>(W0, W1, Nsrc, 32 * nb + lc);
#pragma unroll
        for (int i = 0; i < 8; ++i) cur[i] = src ? *(const f32x4*)(src + (size_t)(64 * kb + lr + 8 * i) * Nsrc) : (f32x4){0.f, 0.f, 0.f, 0.f}; }
    for (; item < nitems; item += NGW) {
        const int kb = item / nblk, nb = item % nblk, k0 = 64 * kb, n0 = 32 * nb;
        const int itn = item + NGW;
        if (itn < nitems) { const int kbn = itn / nblk, nbn = itn % nblk; const float* src = tr_src<MODE>(W0, W1, Nsrc, 32 * nbn + lc);
#pragma unroll
            for (int i = 0; i < 8; ++i) nxt[i] = src ? *(const f32x4*)(src + (size_t)(64 * kbn + lr + 8 * i) * Nsrc) : (f32x4){0.f, 0.f, 0.f, 0.f}; }
#pragma unroll
        for (int i = 0; i < 8; ++i) { LAS float* d = scr + (lr + 8 * i) * 33 + lc; const float gg = gk ? gk[k0 + lr + 8 * i] : 1.0f; d[0] = cur[i][0] * gg; d[1] = cur[i][1] * gg; d[2] = cur[i][2] * gg; d[3] = cur[i][3] * gg; }
        __builtin_amdgcn_wave_barrier(); asm volatile("s_waitcnt lgkmcnt(0)" ::: "memory");
        const int c = lane & 7;
#pragma unroll
        for (int j = 0; j < 4; ++j) { const int nn = (lane >> 3) + 8 * j; const LAS float* sp = scr + (8 * c) * 33 + nn;
            h16x8 o;
#pragma unroll
            for (int e = 0; e < 8; ++e) o[e] = (h16)sp[e * 33];
            *(h16x8*)(WT + (size_t)(n0 + nn) * K + k0 + 8 * c) = o; }
        __builtin_amdgcn_wave_barrier(); asm volatile("s_waitcnt lgkmcnt(0)" ::: "memory");
#pragma unroll
        for (int i = 0; i < 8; ++i) cur[i] = nxt[i];
    }
}
__device__ __forceinline__ void sincos_f32arg(float ang, float& sn, float& cs) {
    const double a = (double)ang;
    const double rev = a * 0.15915494309189535;
    const double fr = rev - __builtin_rint(rev);
    const double q4 = fr * 4.0; const double qi = __builtin_rint(q4); const int qq = ((int)qi) & 3;
    const double r = (q4 - qi) * 1.5707963267948966;
    const double r2 = r * r;
    const double s = r * (1.0 + r2 * (-1.0 / 6 + r2 * (1.0 / 120 + r2 * (-1.0 / 5040 + r2 * (1.0 / 362880 + r2 * (-1.0 / 39916800))))));
    const double c = 1.0 + r2 * (-0.5 + r2 * (1.0 / 24 + r2 * (-1.0 / 720 + r2 * (1.0 / 40320 + r2 * (-1.0 / 3628800 + r2 * (1.0 / 479001600))))));
    double so, co;
    if (qq == 0) { so = s; co = c; } else if (qq == 1) { so = c; co = -s; } else if (qq == 2) { so = -s; co = -c; } else { so = -c; co = s; }
    sn = (float)so; cs = (float)co;
}
__device__ __forceinline__ void ph_rope(const int* pos, float* ROPE, int gtid, int NGT) {
    for (int idx = gtid; idx < MTOK * 24; idx += NGT) {
        const int tok = idx / 24, i = idx % 24, k = i < 16 ? i : 2 * (i - 16);
        float f = 0x1.000000p+0f;
        f = k == 1 ? 0x1.c2ef76p-2f : f; f = k == 2 ? 0x1.8d275ep-3f : f; f = k == 3 ? 0x1.5dc95ap-4f : f; f = k == 4 ? 0x1.341190p-5f : f; f = k == 5 ? 0x1.0f5384p-6f : f;
        f = k == 6 ? 0x1.ddee9cp-8f : f; f = k == 7 ? 0x1.a4ee3ep-9f : f; f = k == 8 ? 0x1.72ba44p-10f : f; f = k == 9 ? 0x1.468318p-11f : f; f = k == 10 ? 0x1.1f91f0p-12f : f;
        f = k == 11 ? 0x1.fa8b84p-14f : f; f = k == 12 ? 0x1.be218ap-15f : f; f = k == 13 ? 0x1.88ec22p-16f : f; f = k == 14 ? 0x1.5a0f50p-17f : f; f = k == 15 ? 0x1.30c94ep-18f : f;
        const float ang = (float)pos[tok] * f;
        float sn, cs; sincos_f32arg(ang, sn, cs);
        float* rp = ROPE + (size_t)tok * 48;
        if (i < 16) { rp[i] = cs; rp[16 + i] = sn; } else { rp[32 + (i - 16)] = cs; rp[40 + (i - 16)] = sn; }
    }
}
template <bool TO_F32>
__device__ __forceinline__ void ph_rmsnorm(const float* X, const float* g, h16* OUTH, float* OUTF, int gw, int NGW, int lane) {
    for (int row = gw; row < MTOK; row += NGW) {
        const f32x4* xr = (const f32x4*)(X + (size_t)row * DM) + lane;
        f32x4 v[8]; float s = 0.f;
#pragma unroll
        for (int j = 0; j < 8; ++j) { v[j] = xr[64 * j]; s += (v[j][0] * v[j][0] + v[j][1] * v[j][1]) + (v[j][2] * v[j][2] + v[j][3] * v[j][3]); }
        const float r = 1.0f / sqrtf(wave_sum(s) * (1.0f / DM) + EPS);
#pragma unroll
        for (int j = 0; j < 8; ++j) { const f32x4 gg = *((const f32x4*)g + lane + 64 * j); const f32x4 o = v[j] * r * gg;
            if (TO_F32) *((f32x4*)(OUTF + (size_t)row * DM) + lane + 64 * j) = o; else st4h(OUTH + (size_t)row * DM + 4 * (lane + 64 * j), o); }
    }
}
__device__ __forceinline__ void ph_final(const h16* X, float* OUT, const float* g, const float* RS, int gw, int NGW, int lane) {
    for (int row = gw; row < MTOK; row += NGW) {
        const float r = __builtin_amdgcn_rsqf(RS[row] * (1.0f / DM) + EPS);
        h16x8 v[4];
#pragma unroll
        for (int j = 0; j < 4; ++j) v[j] = *((const h16x8*)(X + (size_t)row * DM) + lane + 64 * j);
#pragma unroll
        for (int j = 0; j < 4; ++j) { const float* gp = g + 8 * (lane + 64 * j); float* op = OUT + (size_t)row * DM + 8 * (lane + 64 * j);
            const f32x4 g0 = *(const f32x4*)gp, g1 = *(const f32x4*)(gp + 4);
            f32x4 o0 = {(float)v[j][0], (float)v[j][1], (float)v[j][2], (float)v[j][3]}, o1 = {(float)v[j][4], (float)v[j][5], (float)v[j][6], (float)v[j][7]};
            *(f32x4*)op = o0 * r * g0; *(f32x4*)(op + 4) = o1 * r * g1; }
    }
}
__device__ __forceinline__ void ph_cumsum(const float* LOGF, float* CBS, int bh, int lane) {
    const int b = bh >> 3, h = bh & 7;
    float v[64];
#pragma unroll
    for (int it = 0; it < 64; ++it) v[it] = LOGF[(size_t)(b * T + it * 64 + lane) * 8 + h];
    float run = 0.f;
#pragma unroll
    for (int it = 0; it < 64; ++it) {
        float x = v[it];
#pragma unroll
        for (int o = 1; o < 64; o <<= 1) { const float nb = __shfl_up(x, o); if (lane >= o) x += nb; }
        CBS[(size_t)bh * T + it * 64 + lane] = (run + x) * -11.313708498984761f;
        run += __shfl(x, 63);
    }
}

__device__ __forceinline__ unsigned fkey(float f) { const unsigned u = __float_as_uint(f + 0.0f); return (u & 0x80000000u) ? ~u : (u | 0x80000000u); }
__device__ __forceinline__ unsigned count_ge(const unsigned (&key)[64], unsigned th, int nj) {
    unsigned c = 0;
#pragma unroll
    for (int j8 = 0; j8 < 8; ++j8) {
        if (8 * j8 < nj) {
#pragma unroll
            for (int j = 8 * j8; j < 8 * j8 + 8; ++j) c += (key[j] >= th) ? 1u : 0u;
        }
    }
#pragma unroll
    for (int o = 1; o < 64; o <<= 1) c += __shfl_xor(c, o);
    return c;
}
__device__ __forceinline__ u64 topk_select(const unsigned (&key)[64], int nvalid, int lane) {
    u64 myword = 0;
    if (nvalid <= TOPK) {
#pragma unroll
        for (int j = 0; j < 64; ++j) { const u64 bal = __ballot(key[j] != 0u); if (lane == j) myword = bal; }
    } else {
        unsigned th = 0u; bool exact = false;
        for (int bit = 31; bit >= 0; --bit) { const unsigned tc = th | (1u << bit); const unsigned c = count_ge(key, tc, (nvalid + 63) >> 6); if (c >= (unsigned)TOPK) th = tc; if (c == (unsigned)TOPK) { exact = true; break; } }
        if (exact) {
#pragma unroll
            for (int j = 0; j < 64; ++j) { const u64 bal = __ballot(key[j] >= th); if (lane == j) myword = bal; }
        } else {
            unsigned cgt = 0;
#pragma unroll
            for (int j = 0; j < 64; ++j) cgt += (unsigned)__builtin_popcountll(__ballot(key[j] > th));
            int need = TOPK - (int)cgt;
#pragma unroll
            for (int j = 0; j < 64; ++j) { u64 eq = __ballot(key[j] == th); const u64 gt = __ballot(key[j] > th);
                int pc = __builtin_popcountll(eq);
                while (pc > need) { eq &= ~(1ull << (63 - __builtin_clzll(eq))); --pc; }
                need -= pc; if (lane == j) myword = gt | eq; }
        }
    }
    return myword;
}
template <int LVL>
__device__ __forceinline__ void hist_level(const unsigned (&key)[64], int nj, int lane, LAS unsigned* hist, unsigned& prefix, unsigned& need, unsigned& cnt_eq) {
    constexpr int SH = LVL == 0 ? 21 : (LVL == 1 ? 10 : 0), PSH = LVL == 1 ? 21 : 10, NB = LVL == 2 ? 10 : 11;
#pragma unroll
    for (int i = 0; i < 8; ++i) *(LAS u32x4*)(hist + lane * 32 + 4 * i) = (u32x4){0u, 0u, 0u, 0u};
    asm volatile("s_waitcnt lgkmcnt(0)" ::: "memory"); __builtin_amdgcn_wave_barrier();
#pragma unroll
    for (int j8 = 0; j8 < 8; ++j8) {
        if (8 * j8 < nj) {
            if (LVL == 0) {
#pragma unroll
                for (int j = 8 * j8; j < 8 * j8 + 8; ++j) __hip_atomic_fetch_add(hist + (key[j] >> 21), 1u, __ATOMIC_RELAXED, __HIP_MEMORY_SCOPE_WORKGROUP);
            } else {
                bool any = false;
#pragma unroll
                for (int j = 8 * j8; j < 8 * j8 + 8; ++j) any = any || ((key[j] >> PSH) == prefix);
                if (LVL == 1 || __any(any)) {
#pragma unroll
                    for (int j = 8 * j8; j < 8 * j8 + 8; ++j) { const unsigned k = key[j];
                        if ((k >> PSH) == prefix) __hip_atomic_fetch_add(hist + ((k >> SH) & ((1u << NB) - 1u)), 1u, __ATOMIC_RELAXED, __HIP_MEMORY_SCOPE_WORKGROUP); }
                }
            }
        }
    }
    asm volatile("s_waitcnt lgkmcnt(0)" ::: "memory"); __builtin_amdgcn_wave_barrier();
    unsigned s = 0;
#pragma unroll
    for (int i = 0; i < 8; ++i) { const u32x4 v = *(const LAS u32x4*)(hist + lane * 32 + 4 * i); s += (v[0] + v[1]) + (v[2] + v[3]); }
    unsigned S = s;
#pragma unroll
    for (int o = 1; o < 64; o <<= 1) { const unsigned nb = __shfl_down(S, o); if (lane + o < 64) S += nb; }
    const int L = 63 - __builtin_clzll(__ballot(S >= need));
    const unsigned aboveL = __shfl(S - s, L);
    const int bi = lane & 31;
    const unsigned hb = hist[L * 32 + bi];
    unsigned R = hb;
#pragma unroll
    for (int o = 1; o < 32; o <<= 1) { const unsigned nb = __shfl_down(R, o); if (bi + o < 32) R += nb; }
    const int B = 31 - __builtin_clz((unsigned)__ballot(aboveL + R >= need));
    const unsigned abB = __shfl(aboveL + R - hb, B);
    cnt_eq = __shfl(hb, B);
    prefix = (prefix << NB) | (unsigned)(L * 32 + B);
    need -= abB;
    __builtin_amdgcn_wave_barrier();
}
__device__ __forceinline__ u64 topk_select_hist(const unsigned (&key)[64], int nvalid, int lane, LAS unsigned* hist) {
    const int nj = (nvalid + 63) >> 6;
    unsigned prefix = 0, need = TOPK, cnt_eq = 0;
    hist_level<0>(key, nj, lane, hist, prefix, need, cnt_eq);
    hist_level<1>(key, nj, lane, hist, prefix, need, cnt_eq);
    hist_level<2>(key, nj, lane, hist, prefix, need, cnt_eq);
    u64 mw = 0;
    if (need == cnt_eq) {
#pragma unroll
        for (int j = 0; j < 64; ++j) { const u64 bal = __ballot(key[j] >= prefix); if (lane == j) mw = bal; }
    } else {
        int nd = (int)need;
#pragma unroll
        for (int j = 0; j < 64; ++j) { u64 eq = __ballot(key[j] == prefix); const u64 gt = __ballot(key[j] > prefix);
            int pc = __builtin_popcountll(eq);
            while (pc > nd) { eq &= ~(1ull << (63 - __builtin_clzll(eq))); --pc; }
            nd -= pc; if (lane == j) mw = gt | eq; }
    }
    return mw;
}
__device__ __forceinline__ void ph_topk_naive(const h16* QI, const h16* KI, const float* WI, u64* MASK, LAS float* qs, LAS unsigned* ks, int gw, int NGW, int lane) {
    for (int row = gw; row < MTOK; row += NGW) {
        const int b = row >> 12, t = row & 4095;
        { const h16* qp = QI + (size_t)row * 1024 + lane * 16;
#pragma unroll
          for (int i = 0; i < 16; ++i) qs[lane * 16 + i] = (float)qp[i]; }
        if (lane < 16) qs[1024 + lane] = WI[(size_t)row * 16 + lane];
        __builtin_amdgcn_wave_barrier(); asm volatile("s_waitcnt lgkmcnt(0)" ::: "memory");
#pragma unroll 1
        for (int j = 0; j < 64; ++j) {
            unsigned kk = 0u;
            const int s = 64 * j + lane;
            if (s <= t) {
                float kf[64];
                const h16x8* kp = (const h16x8*)(KI + (size_t)(b * T + s) * 64);
#pragma unroll
                for (int c = 0; c < 8; ++c) { const h16x8 kv = kp[c];
#pragma unroll
                    for (int e = 0; e < 8; ++e) kf[c * 8 + e] = (float)kv[e]; }
                float sc = 0.f;
#pragma unroll 1
                for (int h = 0; h < 16; ++h) { float d = 0.f;
#pragma unroll
                    for (int e = 0; e < 64; ++e) d = fmaf(qs[h * 64 + e], kf[e], d);
                    sc = fmaf(qs[1024 + h], fmaxf(d, 0.f), sc); }
                kk = fkey(sc);
            }
            ks[j * 64 + lane] = kk;
        }
        __builtin_amdgcn_wave_barrier(); asm volatile("s_waitcnt lgkmcnt(0)" ::: "memory");
        unsigned key[64];
#pragma unroll
        for (int j = 0; j < 64; ++j) key[j] = ks[j * 64 + lane];
        MASK[(size_t)row * 64 + lane] = topk_select(key, t + 1, lane);
        __builtin_amdgcn_wave_barrier(); asm volatile("s_waitcnt lgkmcnt(0)" ::: "memory");
    }
}


namespace idx {
typedef short s16x8 __attribute__((ext_vector_type(8)));
typedef float f32x16 __attribute__((ext_vector_type(16)));
constexpr int CHK = 128, CHB = CHK * 128;
__device__ __forceinline__ unsigned half_sum(unsigned v) {
#pragma unroll
    for (int o = 1; o < 32; o <<= 1) v += __shfl_xor(v, o);
    return v;
}
__device__ __forceinline__ void run_group(unsigned char* ws, char* lds, unsigned* scr, int b, int g, int wv) {
    int tid = wv * 64 + lane_id(); asm volatile("" : "+v"(tid));
    const int wid = __builtin_amdgcn_readfirstlane(tid >> 6), lane = tid & 63, c = lane & 31, hi = lane >> 5;
    const int t0 = 16 * g + 2 * wid, t = t0 + hi, row = b * T + t, tmaxblk = 16 * g + 15, nch = (tmaxblk >> 7) + 1;
    const h16* QI = (const h16*)(ws + WS_QI); const char* KIb = (const char*)ws + WS_KI + (size_t)b * T * 128; const float* WI = (const float*)(ws + WS_WI);
    s16x8 A[4];
    { const int rho = c, qsel = (rho >> 2) & 1, head = (rho & 3) + 4 * (rho >> 3);
      const h16* qp = QI + (size_t)(b * T + t0 + qsel) * 1024 + head * 64 + 8 * hi;
#pragma unroll
      for (int ks = 0; ks < 4; ++ks) A[ks] = *reinterpret_cast<const s16x8*>(qp + 16 * ks); }
    float w[16];
    { const f32x4* wp = (const f32x4*)(WI + (size_t)row * 16);
#pragma unroll
      for (int i = 0; i < 4; ++i) { const f32x4 v = wp[i]; w[4 * i] = v[0]; w[4 * i + 1] = v[1]; w[4 * i + 2] = v[2]; w[4 * i + 3] = v[3]; } }
    const int pr0 = tid >> 3, pp = tid & 7;
    const unsigned g_off = (unsigned)(pr0 * 128 + pp * 16);
    const int l_off0 = pr0 * 128 + ((pp ^ ((pr0 >> 1) & 7)) << 4), l_off1 = l_off0 + 64 * 128;
    const int rd_base = c * 128; const int sw = (c >> 1) & 7;
    int rd_off[4];
#pragma unroll
    for (int ks = 0; ks < 4; ++ks) rd_off[ks] = rd_base + (((2 * ks + hi) ^ sw) << 4);
    unsigned* myscr = scr + (size_t)(2 * wid + hi) * T + c;
    asm volatile("" :: "v"(A[0]), "v"(A[1]), "v"(A[2]), "v"(A[3]), "v"(w[0]), "v"(w[4]), "v"(w[8]), "v"(w[12]));
    s16x8 st0, st1;
    { const char* src = KIb; st0 = *reinterpret_cast<const s16x8*>(src + g_off); st1 = *reinterpret_cast<const s16x8*>(src + 64 * 128 + g_off); }
    *reinterpret_cast<s16x8*>(lds + l_off0) = st0; *reinterpret_cast<s16x8*>(lds + l_off1) = st1;
    __syncthreads();
#pragma unroll 1
    for (int ch = 0; ch < nch; ++ch) {
        const char* buf = lds + (ch & 1) * CHB;
        if (ch + 1 < nch) { const char* src = KIb + (size_t)(ch + 1) * CHB; st0 = *reinterpret_cast<const s16x8*>(src + g_off); st1 = *reinterpret_cast<const s16x8*>(src + 64 * 128 + g_off); }
#pragma unroll
        for (int st = 0; st < 4; ++st) {
            f32x16 acc = {};
#pragma unroll
            for (int ks = 0; ks < 4; ++ks) { const s16x8 Bf = *reinterpret_cast<const s16x8*>(buf + st * 4096 + rd_off[ks]);
                acc = __builtin_amdgcn_mfma_f32_32x32x16_f16(__builtin_bit_cast(h16x8, A[ks]), __builtin_bit_cast(h16x8, Bf), acc, 0, 0, 0); }
            float sc = 0.f;
#pragma unroll
            for (int r = 0; r < 16; ++r) { const int ri = __float_as_int(acc[r]); sc = fmaf(w[r], __int_as_float(ri > 0 ? ri : 0), sc); }
            const int sidx = ch * CHK + st * 32 + c;
            myscr[ch * CHK + st * 32] = (sidx <= t) ? fkey(sc) : 0u;
        }
        if (ch + 1 < nch) { char* dst = lds + ((ch + 1) & 1) * CHB; *reinterpret_cast<s16x8*>(dst + l_off0) = st0; *reinterpret_cast<s16x8*>(dst + l_off1) = st1; }
        __syncthreads();
    }
    asm volatile("s_waitcnt vmcnt(0)" ::: "memory");
    u64* MASK = (u64*)(ws + WS_MASK);
#pragma unroll 1
    for (int qq = 0; qq < 2; ++qq) {
        const int tq = t0 + qq, nj = (tq >> 6) + 1;
        const unsigned* src = scr + (size_t)(2 * wid + qq) * T + lane;
        unsigned key[64];
#pragma unroll
        for (int j = 0; j < 64; ++j) key[j] = (j < nj) ? __hip_atomic_load(src + 64 * j, __ATOMIC_RELAXED, __HIP_MEMORY_SCOPE_AGENT) : 0u;
        u64 mw;
        if (tq + 1 <= TOPK) {
            mw = 0;
#pragma unroll
            for (int j = 0; j < 4; ++j) { const u64 bal = __ballot(key[j] != 0u); if (lane == j) mw = bal; }
        } else mw = topk_select_hist(key, tq + 1, lane, (LAS unsigned*)(lds + 2 * CHB + wid * 8192));
        MASK[(size_t)(b * T + tq) * 64 + lane] = mw;
    }
}
}

namespace att {
constexpr int NW = 8, QBLK = 32, KVBLK = 64, QB = NW * QBLK, D = 128;
constexpr int SHM_V = KVBLK * D * 2, SHM_K = KVBLK * D * 2;
constexpr int LDS_NEED = 2 * SHM_V + 2 * SHM_K + NW * 64 * 4;
constexpr float THR = 8.f, SCALE = 0.08838834764831845f;
typedef short s16x8 __attribute__((ext_vector_type(8)));
typedef short s16x4 __attribute__((ext_vector_type(4)));
typedef float f32x16 __attribute__((ext_vector_type(16)));
#define KSWZ(row, colB) ((row) * 256 + ((colB) ^ (((row) & 7) << 4)))
#define SBAR() __builtin_amdgcn_sched_barrier(0)
__device__ __forceinline__ int v_st(int k, int c) { const int kk = (k & ~0xC) | ((k & 4) << 1) | ((k & 8) >> 1); return ((kk >> 3) * 4 + (c >> 5)) * 512 + ((kk & 7) * 32 + (c & 31)) * 2; }
__device__ __forceinline__ int v_rd_base(int lane) { return ((lane & 3) << 3) | (((lane >> 2) & 3) << 6) | (((lane >> 4) & 1) << 5) | (((lane >> 5) & 1) << 8); }
constexpr int v_rd_off(int d0, int ks, int half) { return d0 * 512 + ks * 4096 + half * 2048; }
__device__ __forceinline__ int crow(int r, int hi) { return (r & 3) + 8 * (r >> 2) + 4 * hi; }
__device__ __forceinline__ unsigned cvtpk(float lo, float hi) { unsigned r; asm volatile("v_cvt_pk_f16_f32 %0, %1, %2" : "=v"(r) : "v"(lo), "v"(hi)); return r; }
__device__ __forceinline__ f32x16 mfma16(s16x8 a, s16x8 b, f32x16 c) { return __builtin_amdgcn_mfma_f32_32x32x16_f16(__builtin_bit_cast(h16x8, a), __builtin_bit_cast(h16x8, b), c, 0, 0, 0); }
__device__ __forceinline__ s16x8 load8(const h16* p) { return *reinterpret_cast<const s16x8*>(p); }
__device__ __forceinline__ void mask_causal(f32x16& p0, f32x16& p1, int dq) {
    const float NEG = -__builtin_inff();
#pragma unroll
    for (int r = 0; r < 16; ++r) { const int c = (r & 3) + 8 * (r >> 2); if (dq - c < 0) p0[r] = NEG; if (dq - c - 32 < 0) p1[r] = NEG; }
}
__device__ __forceinline__ void mask_bits(f32x16& p0, f32x16& p1, u64 w, int hi) {
    const float NEG = -__builtin_inff();
    const unsigned lo = (unsigned)w >> (4 * hi), up = (unsigned)(w >> 32) >> (4 * hi);
#pragma unroll
    for (int r = 0; r < 16; ++r) { const int c = (r & 3) + 8 * (r >> 2); if (!((lo >> c) & 1u)) p0[r] = NEG; if (!((up >> c) & 1u)) p1[r] = NEG; }
}
__device__ __forceinline__ void partialSM(f32x16& p0, f32x16& p1, float& m_reg, float& mn, float& alpha) {
    float pmax = p0[0]; for (int r = 1; r < 16; ++r) pmax = fmaxf(pmax, p0[r]); for (int r = 0; r < 16; ++r) pmax = fmaxf(pmax, p1[r]);
    { auto rr = __builtin_amdgcn_permlane32_swap(__float_as_uint(pmax), __float_as_uint(pmax), false, false);
      pmax = fmaxf(__uint_as_float(rr[0]), __uint_as_float(rr[1])); }
    constexpr float C2 = 1.4426950408889634f * SCALE;
    if (__builtin_expect(__all((pmax - m_reg) * SCALE <= THR), 1)) { mn = m_reg; alpha = 1.f; }
    else { mn = fmaxf(m_reg, pmax); alpha = __builtin_amdgcn_exp2f((m_reg - mn) * C2); m_reg = mn; }
    const float mnL = -mn * C2;
    for (int r = 0; r < 16; ++r) p0[r] = fmaf(p0[r], C2, mnL); for (int r = 0; r < 16; ++r) p1[r] = fmaf(p1[r], C2, mnL);
    for (int r = 0; r < 16; ++r) p0[r] = __builtin_amdgcn_exp2f(p0[r]);
}
__device__ __forceinline__ void finishSM(f32x16& p0, f32x16& p1, float alpha, float& l_reg, s16x8& pa0, s16x8& pa1, s16x8& pa2, s16x8& pa3) {
    for (int r = 0; r < 16; ++r) p1[r] = __builtin_amdgcn_exp2f(p1[r]);
    float ps = 0; for (int r = 0; r < 16; ++r) ps += p0[r]; for (int r = 0; r < 16; ++r) ps += p1[r];
    { auto rr = __builtin_amdgcn_permlane32_swap(__float_as_uint(ps), __float_as_uint(ps), false, false);
      ps = __uint_as_float(rr[0]) + __uint_as_float(rr[1]); }
    l_reg = l_reg * alpha + ps;
#define PK4(P, B_, OUT) do { unsigned a0 = cvtpk(P[B_+0], P[B_+1]), a1 = cvtpk(P[B_+2], P[B_+3]);                          \
        unsigned b0 = cvtpk(P[B_+4], P[B_+5]), b1 = cvtpk(P[B_+6], P[B_+7]);                                             \
        auto r0 = __builtin_amdgcn_permlane32_swap(a0, b0, false, false); auto r1 = __builtin_amdgcn_permlane32_swap(a1, b1, false, false); \
        u32x4 w = {r0[0], r1[0], r0[1], r1[1]}; OUT = *reinterpret_cast<s16x8*>(&w); } while (0)
    PK4(p0, 0, pa0); PK4(p0, 8, pa1); PK4(p1, 0, pa2); PK4(p1, 8, pa3);
#undef PK4
}
template <int KB>
__device__ __forceinline__ void qkt(f32x16& p0, f32x16& p1, const char* K_lds, int r32, int hi, const s16x8* qr) {
    const char* kb[4];
#pragma unroll
    for (int dd = 0; dd < 4; ++dd) kb[dd] = K_lds + KB * SHM_K + KSWZ(r32, (dd * 16 + hi * 8) * 2);
#pragma unroll
    for (int d0 = 0; d0 < 8; ++d0) { const char* a = kb[d0 & 3] + (d0 >> 2) * 128;
        s16x8 b0 = *reinterpret_cast<const s16x8*>(a);
        s16x8 b1 = *reinterpret_cast<const s16x8*>(a + 32 * 256);
        p0 = mfma16(b0, qr[d0], p0);
        p1 = mfma16(b1, qr[d0], p1); }
}
template <int VB>
__device__ __forceinline__ void pv_tile(f32x16* o, int vb0, s16x8 pa0, s16x8 pa1, s16x8 pa2, s16x8 pa3) {
#define TRRD(dst, off) asm volatile("ds_read_b64_tr_b16 %0, %1 offset:%2" : "=&v"(dst) : "v"(vb0), "i"(off) : "memory")
#define PV_D0(d0) do { s16x4 l0, l1, l2, l3, h0, h1, h2, h3; constexpr int b_ = VB * SHM_V + v_rd_off(d0, 0, 0); \
        TRRD(l0, b_); TRRD(h0, b_ + 2048); TRRD(l1, b_ + 4096); TRRD(h1, b_ + 6144); TRRD(l2, b_ + 8192); TRRD(h2, b_ + 10240); TRRD(l3, b_ + 12288); TRRD(h3, b_ + 14336); \
        asm volatile("s_waitcnt lgkmcnt(0)" ::: "memory"); SBAR();   \
        o[d0] = mfma16(pa0, (s16x8){l0[0], l0[1], l0[2], l0[3], h0[0], h0[1], h0[2], h0[3]}, o[d0]);   \
        o[d0] = mfma16(pa1, (s16x8){l1[0], l1[1], l1[2], l1[3], h1[0], h1[1], h1[2], h1[3]}, o[d0]);   \
        o[d0] = mfma16(pa2, (s16x8){l2[0], l2[1], l2[2], l2[3], h2[0], h2[1], h2[2], h2[3]}, o[d0]);   \
        o[d0] = mfma16(pa3, (s16x8){l3[0], l3[1], l3[2], l3[3], h3[0], h3[1], h3[2], h3[3]}, o[d0]); } while (0)
    PV_D0(0); PV_D0(1); PV_D0(2); PV_D0(3);
#undef PV_D0
#undef TRRD
}
struct BlockRef { const char* Q; const char* K; const char* V; char* O; int P0; const char* NBQ; const char* MK; };
struct Seam { s16x8 qr[8]; s16x8 st_v0, st_v1, st_k0, st_k1; };
#define LD16(base, off) (*reinterpret_cast<const s16x8*>((base) + (off)))
#define VMW() asm volatile("s_waitcnt vmcnt(0)" ::: "memory")
#define VMWN(n) asm volatile("s_waitcnt vmcnt(%0)" :: "i"(n) : "memory")
#define SLOAD_H(Kp, Vp, k0) do { const char* vb_ = (Vp) + (size_t)(k0) * (D * 2); const char* kb_ = (Kp) + (size_t)(k0) * (D * 2); \
        S.st_v0 = LD16(vb_, st_off); S.st_v1 = LD16(vb_ + 32 * D * 2, st_off); S.st_k0 = LD16(kb_, st_off); S.st_k1 = LD16(kb_ + 32 * D * 2, st_off); } while (0)
#define SWRITE_HK(bf) do { *(s16x8*)(K_lds + (bf) * SHM_K + kws) = S.st_k0; *(s16x8*)(K_lds + (bf) * SHM_K + kws + 32 * 256) = S.st_k1; } while (0)
#define SWRITE_HV(bf) do { *(s16x8*)(V_lds + (bf) * SHM_V + vst0) = S.st_v0; *(s16x8*)(V_lds + (bf) * SHM_V + vst1) = S.st_v1; } while (0)
#define SWRITE_H(bf) do { SWRITE_HV(bf); SWRITE_HK(bf); } while (0)
__device__ __forceinline__ void prime(const BlockRef& cur, char* lds, Seam& S, int wv) {
    int tid = wv * 64 + lane_id(); asm volatile("" : "+v"(tid));
    const int wid = __builtin_amdgcn_readfirstlane(tid >> 6), lane = tid & 63, r32 = lane & 31, hi = lane >> 5;
    const int sr = tid >> 4, sc = (tid & 15) * 8, kws = KSWZ(sr, sc * 2); char* K_lds = lds + 2 * SHM_V;
    const unsigned st_off = (unsigned)(sr * D + sc) * 2u, q_off = (unsigned)((wid * QBLK + r32) * D + hi * 8) * 2u;
#pragma unroll
    for (int d0 = 0; d0 < 8; ++d0) S.qr[d0] = LD16(cur.Q + d0 * 32, q_off);
    SLOAD_H(cur.K, cur.V, 0); VMW(); SWRITE_HK(0);
    __syncthreads();
}
template <bool MIXB>
__device__ __forceinline__ void block(const BlockRef& cur, const BlockRef& nxt, char* lds, Seam& S, int wv) {
    int tid = wv * 64 + lane_id(); asm volatile("" : "+v"(tid));
    const int wid = __builtin_amdgcn_readfirstlane(tid >> 6), lane = tid & 63, r32 = lane & 31, hi = lane >> 5;
    const int NT = cur.P0 / KVBLK + 4;
    const int qlo = cur.P0 + wid * QBLK, qm = qlo + r32 - 4 * hi;
    char* V_lds = lds; char* K_lds = lds + 2 * SHM_V;
    float* wsf = (float*)(lds + 2 * SHM_V + 2 * SHM_K) + wid * 64; float* li_l = wsf, * al_l = wsf + 32;
    float m_reg = -1e30f, l_reg = 0; f32x16 o[4] = {};
    const int sr = tid >> 4, sc = (tid & 15) * 8, vst0 = v_st(sr, sc), vst1 = v_st(32 + sr, sc), kws = KSWZ(sr, sc * 2);
    const int vb0 = (int)(uintptr_t)V_lds + v_rd_base(lane);
    const unsigned st_off = (unsigned)(sr * D + sc) * 2u, q_off = (unsigned)((wid * QBLK + r32) * D + hi * 8) * 2u;
    const unsigned nb_off = (unsigned)hi * 16u, mk_off = (unsigned)(wid * QBLK + r32) * 512u;
    const char* Kh = cur.K; const char* Vh = cur.V;
    const char* bias_l = lds + LDS_NEED;
    if (MIXB) { const float nbref = *(const float*)(cur.NBQ + (size_t)(cur.P0 + QB - 1) * 4);
        for (int i = tid; i < cur.P0 + QB; i += NW * 64) ((float*)bias_l)[i] = ((const float*)cur.NBQ)[i] - nbref;
        __syncthreads(); }
#define RESC(a) do { if (__any((a) < 1.f)) { if (hi == 0) al_l[r32] = (a); asm volatile("s_waitcnt lgkmcnt(0)" ::: "memory");              \
                     for (int d_ = 0; d_ < 4; ++d_) for (int r = 0; r < 16; ++r) o[d_][r] *= al_l[crow(r, hi)]; } } while (0)
#define KBASE(t) ((t) * KVBLK)
#define MKW(t) (*(const u64*)(cur.MK + (size_t)(t) * 8 + mk_off))
#define PINIT(P0_, P1_, t, MW_) do { if (MIXB) { const char* nb_ = bias_l + KBASE(t) * 4 + nb_off; _Pragma("unroll") for (int g_ = 0; g_ < 4; ++g_) { \
            const f32x4 b0_ = *(const f32x4*)(nb_ + 32 * g_), b1_ = *(const f32x4*)(nb_ + 128 + 32 * g_); \
            _Pragma("unroll") for (int j_ = 0; j_ < 4; ++j_) { P0_[4 * g_ + j_] = b0_[j_]; P1_[4 * g_ + j_] = b1_[j_]; } } } else { const u64 w_ = (MW_); const unsigned lo_ = (unsigned)w_ >> (4 * hi), up_ = (unsigned)(w_ >> 32) >> (4 * hi); \
            _Pragma("unroll") for (int r_ = 0; r_ < 16; ++r_) { const int c_ = (r_ & 3) + 8 * (r_ >> 2); \
                P0_[r_] = __uint_as_float((((lo_ >> c_) & 1u) - 1u) & 0xff800000u); P1_[r_] = __uint_as_float((((up_ >> c_) & 1u) - 1u) & 0xff800000u); } } } while (0)
#define MASKT(P0_, P1_, t, MW_) do { if (MIXB) { const int kb_ = KBASE(t); if (kb_ + KVBLK - 1 > qlo) mask_causal(P0_, P1_, qm - kb_); } } while (0)
    f32x16 pA0, pA1, pB0, pB1; float mnA, mnB, alA, alB; s16x8 pa0, pa1, pa2, pa3;
    u64 mwA = 0, mwB = 0;
    if (!MIXB) { mwA = MKW(0); if (NT > 1) mwB = MKW(1); }
    PINIT(pA0, pA1, 0, mwA); if (!MIXB) { if (NT > 2) mwA = MKW(2); }
    if (NT > 1) { PINIT(pB0, pB1, 1, mwB); if (!MIXB) { if (NT > 3) mwB = MKW(3); } }
    SWRITE_HV(0); SBAR();
    if (NT > 1) SLOAD_H(Kh, Vh, KBASE(1));
    SBAR(); qkt<0>(pA0, pA1, K_lds, r32, hi, S.qr);
    MASKT(pA0, pA1, 0, mwA);
    partialSM(pA0, pA1, m_reg, mnA, alA);
    if (NT > 1) { VMW(); SWRITE_H(1); }
    __syncthreads();
#define HALF_STEP(PX0, PX1, mnX, alX, MWX, PY0, PY1, alY, MWY, t, KB, VB, SB) do {                                               \
        SBAR(); qkt<KB>(PX0, PX1, K_lds, r32, hi, S.qr);                                                                      \
        finishSM(PY0, PY1, alY, l_reg, pa0, pa1, pa2, pa3); SBAR();                                                           \
        if ((t) + 1 < NT) { PINIT(PY0, PY1, (t) + 1, MWY); if (!MIXB) { if ((t) + 3 < NT) MWY = MKW((t) + 3); } SLOAD_H(Kh, Vh, KBASE((t) + 1)); SBAR(); }                             \
        pv_tile<VB>(o, vb0, pa0, pa1, pa2, pa3); MASKT(PX0, PX1, (t), MWX); \
        partialSM(PX0, PX1, m_reg, mnX, alX);                                                                                 \
        __syncthreads();                                                                                                      \
        if ((t) + 1 < NT) { VMW(); SWRITE_H(SB); }                                                                            \
        RESC(alX); __syncthreads(); } while (0)
    for (int t = 1; t + 1 < NT; t += 2) {
        HALF_STEP(pB0, pB1, mnB, alB, mwB, pA0, pA1, alA, mwA, t, 1, 0, 0);
        HALF_STEP(pA0, pA1, mnA, alA, mwA, pB0, pB1, alB, mwB, t + 1, 0, 1, 1);
    }
    const bool even = (NT & 1) == 0;
    if (even) { SBAR(); qkt<1>(pB0, pB1, K_lds, r32, hi, S.qr); SBAR(); }
    SLOAD_H(nxt.K, nxt.V, 0); SBAR();
#pragma unroll
    for (int d0 = 0; d0 < 8; ++d0) S.qr[d0] = LD16(nxt.Q + d0 * 32, q_off);
    SBAR();
    finishSM(pA0, pA1, alA, l_reg, pa0, pa1, pa2, pa3); SBAR();
    pv_tile<0>(o, vb0, pa0, pa1, pa2, pa3);
    if (even) { MASKT(pB0, pB1, NT - 1, mwB); partialSM(pB0, pB1, m_reg, mnB, alB); __syncthreads(); RESC(alB);
        finishSM(pB0, pB1, alB, l_reg, pa0, pa1, pa2, pa3); SBAR(); pv_tile<1>(o, vb0, pa0, pa1, pa2, pa3); }
    SBAR(); VMWN(8); SWRITE_HK(0); SBAR();
    if (hi == 0) li_l[r32] = l_reg; asm volatile("s_waitcnt lgkmcnt(0)" ::: "memory");
    float rli[16];
#pragma unroll
    for (int r = 0; r < 16; ++r) rli[r] = __builtin_amdgcn_rcpf(li_l[crow(r, hi)]);
    const unsigned o_off = (unsigned)((wid * QBLK + 4 * hi) * 1024 + r32) * 2u;
#pragma unroll
    for (int r = 0; r < 16; ++r) {
#pragma unroll
        for (int d0 = 0; d0 < 4; ++d0) { const float v = o[d0][r] * rli[r];
            const float vn = __shfl_xor(v, 1);
            if ((r32 & 1) == 0) *(unsigned*)(cur.O + (size_t)(((r & 3) + 8 * (r >> 2)) * 2048 + d0 * 64) + o_off) = cvtpk(v, vn); } }
    __syncthreads();
#undef RESC
#undef KBASE
#undef PINIT
#undef MKW
#undef MASKT
#undef HALF_STEP
}
#undef LD16
#undef VMW
#undef VMWN
#undef SLOAD_H
#undef SWRITE_HK
#undef SWRITE_HV
#undef SWRITE_H
__device__ __forceinline__ BlockRef make_ref(bool mixb, unsigned char* ws, int bh, int qb) {
    const int b = bh >> 3, h = bh & 7, kvh = mixb ? bh : (b * HAKV + (h >> 2));
    BlockRef r;
    r.Q = (const char*)ws + (mixb ? WS_QB : WS_QA) + ((size_t)bh * T + (size_t)qb * QB) * D * 2;
    r.K = (const char*)ws + (mixb ? WS_KB : WS_KA) + (size_t)kvh * T * D * 2;
    r.V = (const char*)ws + (mixb ? WS_VB : WS_VA) + (size_t)kvh * T * D * 2;
    r.O = (char*)ws + (mixb ? WS_OUTB : WS_OUTA) + ((size_t)(b * T + qb * QB) * 1024 + h * D) * 2;
    r.P0 = qb * QB;
    r.NBQ = (const char*)ws + WS_CB + (size_t)bh * T * 4;
    r.MK = (const char*)ws + WS_MASK + (size_t)(b * T + qb * QB) * 64 * 8;
    return r;
}
template <bool MIXB>
__device__ __forceinline__ void run_item(int item, unsigned char* ws, char* lds, int wv) {
    const int bh = (item >> 3) & 15, x = item & 7;
    Seam S;
    BlockRef cur = make_ref(MIXB, ws, bh, x);
    prime(cur, lds, S, wv);
#pragma unroll 1
    for (int pass = 0; pass < 2; ++pass) {
        const BlockRef nxt = make_ref(MIXB, ws, bh, 15 - x);
        block<MIXB>(cur, nxt, lds, S, wv);
        cur = nxt;
    }
}
}


#define XB_TMO      128
#define XB_XCNT(j)  (256  + 64 * (j))
#define XB_XSUB(j)  (1280 + 64 * (j))
#define XB_XGEN(j)  (2304 + 64 * (j))
#define XB_TOP      3328
#define XB_TOPGEN   3392
#define XCD_BAR_WORDS 3456
#define XB_SPIN_CAP (1u << 24)
__device__ __forceinline__ unsigned xb_ld(unsigned* p)              { return __hip_atomic_load(p, __ATOMIC_RELAXED, __HIP_MEMORY_SCOPE_AGENT); }
__device__ __forceinline__ unsigned xb_add(unsigned* p, unsigned v) { return __hip_atomic_fetch_add(p, v, __ATOMIC_RELAXED, __HIP_MEMORY_SCOPE_AGENT); }
__device__ __forceinline__ unsigned xb_xcc_id() { return (unsigned)__builtin_amdgcn_s_getreg((3 << 11) | 20) & 0xFu; }
#define XB_SPIN(cond, bar) do { unsigned _sp = 0; while (cond) { __builtin_amdgcn_s_sleep(1); \
    if ((++_sp & 255u) == 0u) { if (xb_ld(&(bar)[XB_TMO])) break; if (_sp > XB_SPIN_CAP) { atomicAdd(&(bar)[XB_TMO], 1u); break; } } } } while (0)
struct XcdBarrier { unsigned* bar; unsigned x; volatile LAS unsigned* st; };
__device__ __forceinline__ XcdBarrier xcd_barrier_post(unsigned* bar, volatile LAS unsigned* st, int wv) {
    XcdBarrier b; b.bar = bar; b.x = xb_xcc_id(); b.st = st;
    if (wv == 0 && lane_id() == 0) (void)xb_add(&bar[XB_XCNT(b.x)], 1u);
    return b;
}
__device__ __forceinline__ void xcd_barrier_complete(unsigned* bar, unsigned x, unsigned& nloc, unsigned& nx) {
    const unsigned G = gridDim.x * gridDim.y * gridDim.z;
    unsigned sum, cnt, mine, sp = 0u;
    for (;;) {
        sum = 0u; cnt = 0u; mine = 0u;
#pragma unroll
        for (unsigned j = 0; j < 16; ++j) { const unsigned c = xb_ld(&bar[XB_XCNT(j)]); sum += c; cnt += (c > 0u) ? 1u : 0u; mine = (j == x) ? c : mine; }
        if (sum == G) break;
        __builtin_amdgcn_s_sleep(1);
        if ((++sp & 255u) == 0u) { if (xb_ld(&bar[XB_TMO])) break; if (sp > XB_SPIN_CAP) { atomicAdd(&bar[XB_TMO], 1u); break; } }
    }
    nloc = mine > 0u ? mine : 1u; nx = cnt > 0u ? cnt : 1u;
}
__device__ __forceinline__ void xcd_barrier(const XcdBarrier& b, int wv) {
    asm volatile("s_waitcnt vmcnt(0)" ::: "memory");
    __syncthreads();
    if (wv == 0 && lane_id() == 0) {
        unsigned* bar = b.bar;
        __builtin_amdgcn_s_waitcnt(0);
        unsigned nloc = b.st[0], nx = b.st[1];
        if (nloc == 0u) { xcd_barrier_complete(bar, b.x, nloc, nx); b.st[0] = nloc; b.st[1] = nx; }
        const unsigned old = xb_add(&bar[XB_XSUB(b.x)], 1u);
        const unsigned gen = old / nloc;
        if (old + 1u == (gen + 1u) * nloc) {
            __builtin_amdgcn_fence(__ATOMIC_RELEASE, "agent");
            asm volatile("s_waitcnt vmcnt(0)" ::: "memory");
            const unsigned og = xb_add(&bar[XB_TOP], 1u);
            const unsigned tg = og / nx;
            if (og + 1u == (tg + 1u) * nx) xb_add(&bar[XB_TOPGEN], 1u);
            else XB_SPIN(xb_ld(&bar[XB_TOPGEN]) == tg, bar);
            __builtin_amdgcn_fence(__ATOMIC_ACQUIRE, "agent");
            xb_add(&bar[XB_XGEN(b.x)], 1u);
            asm volatile("s_waitcnt vmcnt(0)" ::: "memory");
        } else {
            XB_SPIN(xb_ld(&bar[XB_XGEN(b.x)]) == gen, bar);
            __builtin_amdgcn_fence(__ATOMIC_ACQUIRE, "agent");
            asm volatile("s_waitcnt vmcnt(0)" ::: "memory");
        }
    }
    __syncthreads();
}

namespace cg = cooperative_groups;
#ifndef PROBE_DUP
#define PROBE_DUP 0
#endif
#define REP(k) for (int rep_ = 0; rep_ < (((PROBE_DUP) >> (k)) & 1) + 1; ++rep_)
constexpr int LDS_BYTES = pg8::STAGE_BYTES + 256;
constexpr int CW_BAR = 4096;
struct Params { const float* in[17]; float* out; unsigned char* ws; };
template <class Epi>
__device__ __forceinline__ void run_gemm(LAS unsigned char* lds, const h16* A, const h16* Bt, int M, int N, int K, const Epi& e, int wv) {
    pg8::Gemm g{A, Bt, M, N, K}; pg8::StaticOrder S; S.init(M, N, (int)gridDim.x, (int)blockIdx.x);
    pg8::gemm_phase<Epi>(lds, g, S, e, wv);
}
__global__ void __launch_bounds__(512, 2) mega_fwd(Params P) {
    extern __shared__ __attribute__((aligned(16))) unsigned char lds_raw[];
    LAS unsigned char* lds = (LAS unsigned char*)lds_raw;
    const int wv = __builtin_amdgcn_readfirstlane(threadIdx.x >> 6);
    volatile LAS unsigned* bst = (volatile LAS unsigned*)(lds + pg8::STAGE_BYTES);
    if (wv == 0 && lane_id() < 2) bst[lane_id()] = 0u;
    __syncthreads();
    const XcdBarrier xbar = xcd_barrier_post((unsigned*)(P.ws + WS_CTL) + CW_BAR, bst, wv);
#define GRID_BAR() xcd_barrier(xbar, wv)
#define IDS() int lane = lane_id(); asm volatile("" : "+v"(lane)); const int wave = wv, tid = wave * 64 + lane, gw = blockIdx.x * 8 + wave, NGW = gridDim.x * 8; (void)tid; (void)gw; (void)NGW
    const float* x = P.in[0]; const float* p = P.in[1]; const int* pos = (const int*)P.in[2];
    const float* g_mix = P.in[3]; const float* w_in = P.in[4]; const float* b_f = P.in[5];
    const float* w_o_a = P.in[6]; const float* w_o_b = P.in[7]; const float* w_out = P.in[8];
    const float* g_ffn = P.in[9]; const float* w_g = P.in[10]; const float* w_u = P.in[11]; const float* w_d = P.in[12];
    const float* g_ple = P.in[13]; const float* w_pg = P.in[14]; const float* w_pp = P.in[15]; const float* g_final = P.in[16];
    unsigned char* ws = P.ws; float* out = P.out;
    float* RS = (float*)(ws + WS_RS); float* ROPE = (float*)(ws + WS_ROPE); float* CB = (float*)(ws + WS_CB); float* LOGF = (float*)(ws + WS_LOGF); u64* MASK = (u64*)(ws + WS_MASK);
    h16* WIN = (h16*)(ws + WS_WIN); h16* WOA = (h16*)(ws + WS_WOA); h16* WOB = (h16*)(ws + WS_WOB); h16* WOUT = (h16*)(ws + WS_WOUT);
    h16* WGU = (h16*)(ws + WS_WGU); h16* WDN = (h16*)(ws + WS_WDN); h16* WPG = (h16*)(ws + WS_WPG); h16* WPP = (h16*)(ws + WS_WPP);
    h16* QI = (h16*)(ws + WS_QI); h16* KI = (h16*)(ws + WS_KI); float* WI = (float*)(ws + WS_WI);
    h16* SIGA = (h16*)(ws + WS_SIGA); h16* SIGB = (h16*)(ws + WS_SIGB);
    h16* OUTA = (h16*)(ws + WS_OUTA); h16* OUTB = (h16*)(ws + WS_OUTB); h16* P16 = (h16*)(ws + WS_P16);
    h16* X3H = (h16*)(ws + WS_SIGA);
    h16* MIXED = (h16*)(ws + WS_MIXED); h16* H2 = (h16*)(ws + WS_H2); h16* ACT = (h16*)(ws + WS_ACT); h16* PP = (h16*)(ws + WS_PP);
    h16* H1 = (h16*)P.out;

    REP(0) { IDS(); LAS float* scr = (LAS float*)(lds + wave * 8448);
      ph_transpose<1>(w_in, nullptr, nullptr, DM, N_IN, WIN, N_INP, scr, gw, NGW, lane);
      ph_transpose<0>(w_o_a, nullptr, nullptr, 1024, DM, WOA, DM, scr, gw, NGW, lane);
      ph_transpose<0>(w_o_b, nullptr, nullptr, 1024, DM, WOB, DM, scr, gw, NGW, lane);
      ph_transpose<0>(w_out, nullptr, nullptr, DM, DM, WOUT, DM, scr, gw, NGW, lane);
      ph_transpose<2>(w_g, w_u, g_ffn, DM, DFF, WGU, 2 * DFF, scr, gw, NGW, lane);
      ph_transpose<0>(w_d, nullptr, nullptr, DFF, DM, WDN, DM, scr, gw, NGW, lane);
      ph_transpose<0>(w_pg, nullptr, g_ple, DM, DM, WPG, DM, scr, gw, NGW, lane);
      ph_transpose<0>(w_pp, nullptr, nullptr, DPLE, DM, WPP, DM, scr, gw, NGW, lane);
      ph_rope(pos, ROPE, blockIdx.x * 512 + tid, gridDim.x * 512);
      for (int i = blockIdx.x * 512 + tid; i < 3 * MTOK; i += gridDim.x * 512) RS[i] = 0.f;
      ph_rmsnorm<false>(x, g_mix, H1, nullptr, gw, NGW, lane);
    }
    GRID_BAR();
    REP(1) { EpiInProj e{ws, b_f}; run_gemm(lds, H1, WIN, MTOK, N_INP, DM, e, wv); }
    GRID_BAR();
    REP(2) { IDS();
      if (gw >= NGW - 16) ph_cumsum(LOGF, CB, NGW - 1 - gw, lane);
      for (int it = blockIdx.x; it < 256; it += gridDim.x) { const int bb = it & 1, gi = it >> 1;
#pragma unroll 1
          for (int pass = 0; pass < 2; ++pass) idx::run_group(ws, (char*)lds_raw, (unsigned*)out + (size_t)blockIdx.x * 16 * T, bb, pass ? 255 - gi : gi, wv); }
      for (int i = blockIdx.x * 512 + tid; i < MTOK * DPLE / 4; i += gridDim.x * 512) st4h(P16 + 4 * (size_t)i, *((const f32x4*)p + i));
    }
    GRID_BAR();
    REP(3) for (int it = blockIdx.x; it < 256; it += gridDim.x) {
        const int item = (it & 7) * 32 + (it >> 3);
        if (item < 128) att::run_item<false>(item, ws, (char*)lds_raw, wv); else att::run_item<true>(item, ws, (char*)lds_raw, wv);
    }
    GRID_BAR();
    REP(4) { { EpiGate<true> e{SIGA, MIXED}; run_gemm(lds, OUTA, WOA, MTOK, DM, 1024, e, wv); }
    { EpiGate<false> e{SIGB, MIXED}; run_gemm(lds, OUTB, WOB, MTOK, DM, 1024, e, wv); } }
    GRID_BAR();
    REP(5) { EpiResidNorm<true> e{x, H2, RS}; run_gemm(lds, MIXED, WOUT, MTOK, DM, DM, e, wv); }
    GRID_BAR();
    REP(6) { EpiSwiGLU e{ACT, RS}; run_gemm(lds, H2, WGU, MTOK, 2 * DFF, DM, e, wv); }
    GRID_BAR();
    { EpiResidNorm<false> e{nullptr, H2, RS + MTOK}; run_gemm(lds, ACT, WDN, MTOK, DM, DFF, e, wv); }
    GRID_BAR();
    { EpiStoreH e{PP, DM}; run_gemm(lds, P16, WPP, MTOK, DM, DPLE, e, wv); }
    { EpiPLE e{PP, H2, X3H, RS + MTOK, RS + 2 * MTOK}; run_gemm(lds, H2, WPG, MTOK, DM, DM, e, wv); }
    GRID_BAR();
    { IDS(); ph_final(X3H, out, g_final, RS + 2 * MTOK, gw, NGW, lane); }
#undef IDS
#undef GRID_BAR
}

extern "C" void kernel_launch(void* const* d_in, const int* in_sizes, int n_in, void* d_out, int out_size, void* d_ws, size_t ws_size, hipStream_t stream) {
    if (n_in != 17 || out_size != MTOK * DM || ws_size < WS_END) { fprintf(stderr, "kernel_launch: unexpected shapes / workspace (%d inputs, out %d, ws %zu)\n", n_in, out_size, ws_size); return; }
    static int grid_blocks = 0;
    if (!grid_blocks) {
        int dev = 0, cus = 0, per_cu = 0;
        (void)hipGetDevice(&dev);
        (void)hipDeviceGetAttribute(&cus, hipDeviceAttributeMultiprocessorCount, dev);
        (void)hipFuncSetAttribute((const void*)mega_fwd, hipFuncAttributeMaxDynamicSharedMemorySize, LDS_BYTES);
        (void)hipOccupancyMaxActiveBlocksPerMultiprocessor(&per_cu, (const void*)mega_fwd, 512, LDS_BYTES);
        if (per_cu < 1) { fprintf(stderr, "kernel_launch: occupancy query says %d blocks per CU\n", per_cu); per_cu = 1; }
        if (per_cu > 1) per_cu = 1;
        grid_blocks = cus * per_cu;
    }
    (void)hipMemsetAsync((char*)d_ws + WS_CTL, 0, 64 * 1024, stream);
    Params prm{};
    for (int i = 0; i < 17; ++i) prm.in[i] = (const float*)d_in[i];
    prm.out = (float*)d_out; prm.ws = (unsigned char*)d_ws;
    void* args[] = {&prm};
    hipError_t e = hipLaunchCooperativeKernel((const void*)mega_fwd, dim3(grid_blocks), dim3(512), args, LDS_BYTES, stream);
    if (e != hipSuccess) fprintf(stderr, "cooperative launch failed: %s (grid %d)\n", hipGetErrorString(e), grid_blocks);
}
```

```cpp
#include <hip/hip_runtime.h>
#include <hip/hip_cooperative_groups.h>
#include <stdint.h>
#include <cstdio>

#define LAS __attribute__((address_space(3)))
typedef _Float16 h16;
typedef _Float16 h16x8 __attribute__((ext_vector_type(8)));
typedef _Float16 h16x4 __attribute__((ext_vector_type(4)));
typedef _Float16 h16x2 __attribute__((ext_vector_type(2)));
typedef float f32x4 __attribute__((ext_vector_type(4)));
typedef float f32x2 __attribute__((ext_vector_type(2)));
typedef unsigned u32x4 __attribute__((ext_vector_type(4)));
typedef unsigned u32x2 __attribute__((ext_vector_type(2)));
typedef unsigned long long u64;
__device__ __forceinline__ int lane_id() { int r; asm volatile("v_mbcnt_lo_u32_b32 %0, -1, 0\n\tv_mbcnt_hi_u32_b32 %0, -1, %0" : "=v"(r)); return r; }

constexpr int NBATCH = 2, T = 4096, MTOK = NBATCH * T, DM = 2048;
constexpr int HA = 8, HAKV = 2, HIDX = 16, DIDX = 64, HB = 8, HD = 128;
constexpr int N_IN = 9816, N_INP = 9984, DFF = 5632, DPLE = 256, TOPK = 256;
constexpr float EPS = 1e-6f;
constexpr float ATT_SCALE = 0.08838834764831845f;

constexpr size_t MiB = 1u << 20;
constexpr size_t WS_CTL = 0;
constexpr size_t WS_RS = 512 * 1024;
constexpr size_t WS_ROPE = 1 * MiB;
constexpr size_t WS_CB = 3 * MiB;
constexpr size_t WS_LOGF = 3 * MiB + 512 * 1024;
constexpr size_t WS_MASK = 4 * MiB;
constexpr size_t WS_WIN = 8 * MiB;
constexpr size_t WS_OUTA = 8 * MiB, WS_OUTB = 24 * MiB, WS_P16 = 40 * MiB;
constexpr size_t WS_WOA = 47 * MiB, WS_WOB = 51 * MiB, WS_WOUT = 55 * MiB, WS_WGU = 63 * MiB, WS_WDN = 107 * MiB, WS_WPG = 129 * MiB, WS_WPP = 137 * MiB;
constexpr size_t WS_QA = 138 * MiB, WS_KA = 154 * MiB, WS_VA = 158 * MiB, WS_QI = 162 * MiB, WS_KI = 178 * MiB, WS_WI = 179 * MiB;
constexpr size_t WS_QB = 180 * MiB, WS_KB = 196 * MiB, WS_VB = 212 * MiB, WS_SIGA = 228 * MiB, WS_SIGB = 260 * MiB, WS_NBQ = 292 * MiB, WS_END = 296 * MiB;
constexpr size_t WS_MIXED = WS_QB;
constexpr size_t WS_H2 = WS_QA;
constexpr size_t WS_ACT = WS_QB;
constexpr size_t WS_PP = WS_QB;

namespace pg8 {
constexpr int BM = 256, BK = 64, HALF = 128, HTB = HALF * BK * 2, STAGE_BYTES = 8 * HTB, NXCD = 8, WGM = 4;
__host__ __device__ __forceinline__ int lds_byte(int r, int c) { const int st = (r >> 4) * 2 + (c >> 5), rr = r & 15, cc = c & 31, ob = rr * 64 + cc * 2; return st * 1024 + (ob ^ (((ob >> 9) & 1) << 5)); }
__host__ __device__ __forceinline__ int perm32(int rho) { const int n = rho >> 4, i = rho & 15; return 8 * (i >> 2) + 4 * n + (i & 3); }
__host__ __device__ __forceinline__ void stage_rc(int b, int& R, int& C) { const int st = b / 1024, sb = b % 1024, swz = sb ^ (((sb >> 9) & 1) << 5); R = (st >> 1) * 16 + swz / 64; C = (st & 1) * 32 + (swz % 64) / 2; }
struct Unit { int pm, pn; };
struct Gemm { const h16* A; const h16* Bt; int M, N, K; };
struct StaticOrder {
    int nM, nN, nwg, G, c;
    __host__ __device__ void init(int M, int N, int G_, int c_) { nM = M / BM; nN = N / BM; nwg = nM * nN; G = G_; c = c_; }
    __host__ __device__ bool next(int i, Unit& u) const {
        const long L = (long)i * G + c; if (L >= nwg) return false;
        int wgid = (int)L; { const int q = nwg / NXCD, r = nwg % NXCD, xcd = wgid % NXCD, off = wgid / NXCD; wgid = (xcd < r ? xcd * (q + 1) : r * (q + 1) + (xcd - r) * q) + off; }
        const int nig = WGM * nN, gid = wgid / nig, fm = gid * WGM, gsz = (nM - fm) < WGM ? (nM - fm) : WGM;
        u.pm = fm + ((wgid % nig) % gsz); u.pn = (wgid % nig) / gsz; return true;
    }
};
template <class Epi>
__device__ __forceinline__ void gemm_phase(LAS unsigned char* lds, const Gemm g, const StaticOrder& S, const Epi& E, int wv) {
    int tid = wv * 64 + lane_id(); asm volatile("" : "+v"(tid));
    const int wid = __builtin_amdgcn_readfirstlane(tid >> 6), lane = tid & 63, wr = wid >> 2, wc = wid & 3, fr = lane & 15, fq = lane >> 4;
    const int K = g.K, nt = K / BK;
    unsigned voffA[2], voffBp[2];
#pragma unroll
    for (int i = 0; i < 2; ++i) { int R, C; stage_rc(tid * 16 + i * 8192, R, C); voffA[i] = (unsigned)(R * K + C) * 2u; voffBp[i] = (unsigned)(((R & ~31) + perm32(R & 31)) * K + C) * 2u; }
    const size_t kstep = (size_t)(BK * 2);
    const size_t hstep = (size_t)HALF * K * 2;
    const size_t tstep = 2 * hstep;
    const unsigned ldsw = (unsigned)wid * 1024u;
    const int aoff = lds_byte(wr * 64 + fr, fq * 8), boff = lds_byte(wc * 32 + fr, fq * 8);
#define PG8_SA(b, h) (((b) * 2 + (h)) * HTB)
#define PG8_SB(b, h) ((4 + (b) * 2 + (h)) * HTB)
#define PG8_STAGE(bufoff, gbase) do { _Pragma("unroll") for (int _i = 0; _i < 2; ++_i) \
        __builtin_amdgcn_global_load_lds((const unsigned*)((const char*)(gbase) + voffA[_i]), (LAS unsigned*)(lds + (bufoff) + ldsw + _i * 8192), 16, 0, 0); } while (0)
#define PG8_STAGEB(bufoff, gbase, pf) do { _Pragma("unroll") for (int _i = 0; _i < 2; ++_i) \
        __builtin_amdgcn_global_load_lds((const unsigned*)((const char*)(gbase) + ((pf) ? voffBp[_i] : voffA[_i])), (LAS unsigned*)(lds + (bufoff) + ldsw + _i * 8192), 16, 0, 0); } while (0)
#define PG8_LDA(dst, b, h) do { _Pragma("unroll") for (int m = 0; m < 4; ++m) _Pragma("unroll") for (int k = 0; k < 2; ++k) dst[m][k] = *(const LAS h16x8*)(lds + PG8_SA(b, h) + aoff + m * 2048 + k * 1024); } while (0)
#define PG8_LDB(dst, b, h) do { _Pragma("unroll") for (int n = 0; n < 2; ++n) _Pragma("unroll") for (int k = 0; k < 2; ++k) dst[n][k] = *(const LAS h16x8*)(lds + PG8_SB(b, h) + boff + n * 2048 + k * 1024); } while (0)
#define PG8_MMA(ai, bj, At, Bt) do { __builtin_amdgcn_s_setprio(1); _Pragma("unroll") for (int m = 0; m < 4; ++m) _Pragma("unroll") for (int n = 0; n < 2; ++n) _Pragma("unroll") for (int k = 0; k < 2; ++k) \
        acc[ai][bj][m][n] = __builtin_amdgcn_mfma_f32_16x16x32_f16(Bt[n][k], At[m][k], acc[ai][bj][m][n], 0, 0, 0); __builtin_amdgcn_s_setprio(0); } while (0)
#define PG8_WAIT_V(n) asm volatile("s_waitcnt vmcnt(" #n ")" ::: "memory")
#define PG8_WAIT_L(n) asm volatile("s_waitcnt lgkmcnt(" #n ")" ::: "memory")
#define PG8_BAR __builtin_amdgcn_s_barrier()
#define PG8_SCHED __builtin_amdgcn_sched_barrier(0)
    Unit cur, nxt; int ui = 0;
    if (!S.next(0, cur)) return;
    f32x4 acc[2][2][4][2];
#pragma unroll
    for (int a = 0; a < 2; ++a)
#pragma unroll
        for (int b = 0; b < 2; ++b)
#pragma unroll
            for (int m = 0; m < 4; ++m)
#pragma unroll
                for (int n = 0; n < 2; ++n) acc[a][b][m][n] = (f32x4){0.f, 0.f, 0.f, 0.f};
    h16x8 At[4][2], B0[2][2], B1[2][2];
    const char* cA = (const char*)g.A + (size_t)cur.pm * tstep; const char* cB = (const char*)g.Bt + (size_t)cur.pn * tstep;
    bool pfc = Epi::perm(cur.pn);
    PG8_STAGEB(PG8_SB(0, 0), cB, pfc); PG8_STAGE(PG8_SA(0, 0), cA); PG8_STAGEB(PG8_SB(0, 1), cB + hstep, pfc); PG8_STAGE(PG8_SA(0, 1), cA + hstep);
    if (wr == 1) PG8_BAR;
    PG8_WAIT_V(4); PG8_BAR;
    PG8_STAGEB(PG8_SB(1, 0), cB + kstep, pfc); PG8_STAGE(PG8_SA(1, 0), cA + kstep); PG8_STAGEB(PG8_SB(1, 1), cB + hstep + kstep, pfc);
    PG8_WAIT_V(6); PG8_BAR;
    for (;;) {
        const bool has_next = S.next(ui + 1, nxt);
        const char* nA = has_next ? (const char*)g.A + (size_t)nxt.pm * tstep : cA; const char* nB = has_next ? (const char*)g.Bt + (size_t)nxt.pn * tstep : cB;
        const bool pfn = has_next ? Epi::perm(nxt.pn) : pfc;
        for (int t = 0; t < nt; t += 2) {
            const bool last = (t == nt - 2);
            const char* a1 = cA + (size_t)(t + 1) * kstep;
            const char* a2 = last ? nA : cA + (size_t)(t + 2) * kstep; const char* b2 = last ? nB : cB + (size_t)(t + 2) * kstep;
            const char* a3 = a2 + kstep; const char* b3 = b2 + kstep;
            const bool pf2 = last ? pfn : pfc;
            PG8_LDB(B0, 0, 0); PG8_SCHED; PG8_LDA(At, 0, 0); PG8_STAGE(PG8_SA(1, 1), a1 + hstep);
            PG8_WAIT_L(8); PG8_BAR; PG8_WAIT_L(0); PG8_MMA(0, 0, At, B0); PG8_BAR; PG8_SCHED;
            PG8_LDB(B1, 0, 1); PG8_STAGEB(PG8_SB(0, 0), b2, pf2);
            PG8_BAR; PG8_WAIT_L(0); PG8_MMA(0, 1, At, B1); PG8_BAR;
            PG8_LDA(At, 0, 1); PG8_STAGE(PG8_SA(0, 0), a2);
            PG8_BAR; PG8_WAIT_L(0); PG8_MMA(1, 0, At, B0); PG8_BAR; PG8_SCHED;
            PG8_STAGEB(PG8_SB(0, 1), b2 + hstep, pf2);
            PG8_WAIT_V(6); PG8_BAR; PG8_MMA(1, 1, At, B1); PG8_BAR;
            PG8_LDB(B0, 1, 0); PG8_SCHED; PG8_LDA(At, 1, 0); PG8_STAGE(PG8_SA(0, 1), a2 + hstep);
            PG8_WAIT_L(8); PG8_BAR; PG8_WAIT_L(0); PG8_MMA(0, 0, At, B0); PG8_BAR; PG8_SCHED;
            PG8_LDB(B1, 1, 1); PG8_STAGEB(PG8_SB(1, 0), b3, pf2);
            PG8_BAR; PG8_WAIT_L(0); PG8_MMA(0, 1, At, B1); PG8_BAR;
            PG8_LDA(At, 1, 1); PG8_STAGE(PG8_SA(1, 0), a3);
            PG8_BAR; PG8_WAIT_L(0); PG8_MMA(1, 0, At, B0); PG8_BAR; PG8_SCHED;
            PG8_STAGEB(PG8_SB(1, 1), b3 + hstep, pf2);
            PG8_WAIT_V(6); PG8_BAR; PG8_MMA(1, 1, At, B1); PG8_BAR;
        }
        E(acc, cur, wr, wc, fr, fq);
        if (!has_next) break;
#pragma unroll
        for (int a = 0; a < 2; ++a)
#pragma unroll
            for (int b = 0; b < 2; ++b)
#pragma unroll
                for (int m = 0; m < 4; ++m)
#pragma unroll
                    for (int n = 0; n < 2; ++n) acc[a][b][m][n] = (f32x4){0.f, 0.f, 0.f, 0.f};
        cur = nxt; cA = nA; cB = nB; pfc = pfn; ++ui;
    }
    PG8_WAIT_V(0);
    if (wr == 0) PG8_BAR;
    PG8_BAR;
#undef PG8_SA
#undef PG8_SB
#undef PG8_STAGE
#undef PG8_STAGEB
#undef PG8_LDA
#undef PG8_LDB
#undef PG8_MMA
#undef PG8_WAIT_V
#undef PG8_WAIT_L
#undef PG8_BAR
#undef PG8_SCHED
}
}
using pg8::Unit;
typedef f32x4 Acc[2][2][4][2];

__device__ __forceinline__ void st4h(h16* p, f32x4 v) { h16x4 o; o[0] = (h16)v[0]; o[1] = (h16)v[1]; o[2] = (h16)v[2]; o[3] = (h16)v[3]; *(h16x4*)p = o; }
__device__ __forceinline__ void st8h(h16* p, f32x4 a, f32x4 b) { h16x8 o; o[0] = (h16)a[0]; o[1] = (h16)a[1]; o[2] = (h16)a[2]; o[3] = (h16)a[3]; o[4] = (h16)b[0]; o[5] = (h16)b[1]; o[6] = (h16)b[2]; o[7] = (h16)b[3]; *(h16x8*)p = o; }
__device__ __forceinline__ void ld8h(const h16* p, f32x4& a, f32x4& b) { const h16x8 o = *(const h16x8*)p; a = (f32x4){(float)o[0], (float)o[1], (float)o[2], (float)o[3]}; b = (f32x4){(float)o[4], (float)o[5], (float)o[6], (float)o[7]}; }
__device__ __forceinline__ f32x4 ld4h(const h16* p) { const h16x4 o = *(const h16x4*)p; return (f32x4){(float)o[0], (float)o[1], (float)o[2], (float)o[3]}; }
__device__ __forceinline__ float sigmoidf_(float x) { return __builtin_amdgcn_rcpf(1.0f + __expf(-x)); }
__device__ __forceinline__ float logsigmoidf_(float z) { return fminf(z, 0.f) - __logf(1.0f + __expf(-fabsf(z))); }
__device__ __forceinline__ float wave_sum(float v) {
#pragma unroll
    for (int o = 1; o < 64; o <<= 1) v += __shfl_xor(v, o);
    return v;
}

struct EpiInProj {
    static __device__ __forceinline__ bool perm(int pn) { return pn == 5 || pn >= 11; }
    unsigned char* ws; const float* b_f;
    __device__ __forceinline__ void operator()(const Acc& acc, const Unit& u, int wr, int wc, int fr, int fq) const {
        const int pn = u.pn, row0 = u.pm * 256 + wr * 64 + fr;
        const float* ROPE = (const float*)(ws + WS_ROPE);
#pragma unroll
        for (int ai = 0; ai < 2; ++ai)
#pragma unroll
            for (int m = 0; m < 4; ++m) {
                const int row = row0 + ai * 128 + m * 16, b = row >> 12, t = row & 4095;
                const float* rp = ROPE + (size_t)row * 48;
#pragma unroll
                for (int bj = 0; bj < 2; ++bj) {
                    f32x4 v0 = acc[ai][bj][m][0], v1 = acc[ai][bj][m][1];
                    const int d0 = 32 * wc + 4 * fq;
                    const int d8 = 32 * wc + 8 * fq;
                    if (pn < 6) {
                        size_t off;
                        if (pn < 4) off = WS_QA + (((size_t)(b * HA + pn * 2 + bj) * T + t) * HD) * 2;
                        else off = (pn == 4 ? WS_KA : WS_VA) + (((size_t)(b * HAKV + bj) * T + t) * HD) * 2;
                        h16* dst = (h16*)(ws + off);
                        if (pn < 5 && wc == 0) {
                            const f32x4 c = *(const f32x4*)(rp + 4 * fq), s = *(const f32x4*)(rp + 16 + 4 * fq);
                            const f32x4 y0 = v0 * c - v1 * s, y1 = v1 * c + v0 * s; v0 = y0; v1 = y1;
                        }
                        if (pn == 5) st8h(dst + d8, v0, v1); else { st4h(dst + d0, v0); st4h(dst + d0 + 16, v1); }
                    } else if (pn < 11) {
                        const bool is_q = pn < 10;
                        if (is_q || bj == 0) {
                            if (is_q || wc < 2) {
                                const int dd = 32 * (wc & 1) + 4 * fq;
                                const size_t off = is_q ? WS_QI + ((size_t)row * 1024 + ((pn - 6) * 4 + 2 * bj + (wc >> 1)) * 64) * 2 : WS_KI + ((size_t)row * 64) * 2;
                                h16* dst = (h16*)(ws + off);
                                if ((wc & 1) == 0) {
                                    f32x4 pr;
#pragma unroll
                                    for (int j = 0; j < 4; ++j) pr[j] = __shfl_xor(v0[j], 32);
                                    const f32x4 c = *(const f32x4*)(rp + 32 + 4 * (fq & 1)), s = *(const f32x4*)(rp + 40 + 4 * (fq & 1));
                                    v0 = (fq < 2) ? (v0 * c - pr * s) : (v0 * c + pr * s);
                                }
                                st4h(dst + dd, v0); st4h(dst + dd + 16, v1);
                            } else if (wc == 2) {
                                *(f32x4*)((float*)(ws + WS_WI) + (size_t)row * 16 + 4 * fq) = v0 * 0.03125f;
                                if (fq < 2) { const f32x4 bf = *(const f32x4*)(b_f + 4 * fq); f32x4 o;
#pragma unroll
                                    for (int j = 0; j < 4; ++j) o[j] = logsigmoidf_(v1[j] + bf[j]);
                                    *(f32x4*)((float*)(ws + WS_LOGF) + (size_t)row * 8 + 4 * fq) = o; }
                            }
                        }
                    } else if (pn < 23) {
                        const int q = pn - 11, which = q >> 2, head = (q & 3) * 2 + bj;
                        h16* dst = (h16*)(ws + WS_QB + (size_t)which * (WS_KB - WS_QB)) + ((size_t)(b * HB + head) * T + t) * HD;
                        st8h(dst + d8, v0, v1);
                    } else {
                        const int q = pn - 23; const int col = (q & 7) * 256 + 128 * bj + d8;
                        h16* base = (h16*)(ws + WS_SIGA + (size_t)(q >> 3) * (WS_SIGB - WS_SIGA));
#pragma unroll
                        for (int j = 0; j < 4; ++j) { v0[j] = sigmoidf_(v0[j]); v1[j] = sigmoidf_(v1[j]); }
                        st8h(base + (size_t)row * DM + col, v0, v1);
                    }
                }
            }
    }
};
static_assert(WS_VB - WS_KB == WS_KB - WS_QB, "QB/KB/VB equally spaced");
template <bool FIRST> struct EpiGate {
    static __device__ __forceinline__ bool perm(int) { return true; }
    const h16* SIG; h16* MIXED;
    __device__ __forceinline__ void operator()(const Acc& acc, const Unit& u, int wr, int wc, int fr, int fq) const {
        const int row0 = u.pm * 256 + wr * 64 + fr, col0 = u.pn * 256 + 32 * wc + 8 * fq;
#pragma unroll
        for (int ai = 0; ai < 2; ++ai)
#pragma unroll
            for (int m = 0; m < 4; ++m)
#pragma unroll
                for (int bj = 0; bj < 2; ++bj) { const size_t off = (size_t)(row0 + ai * 128 + m * 16) * DM + col0 + bj * 128;
                    f32x4 s0, s1; ld8h(SIG + off, s0, s1); f32x4 v0 = s0 * acc[ai][bj][m][0], v1 = s1 * acc[ai][bj][m][1];
                    if (!FIRST) { f32x4 m0, m1; ld8h(MIXED + off, m0, m1); v0 += m0; v1 += m1; }
                    st8h(MIXED + off, v0, v1); }
    }
};
__device__ __forceinline__ float sumsq4(f32x4 v) { return (v[0] * v[0] + v[1] * v[1]) + (v[2] * v[2] + v[3] * v[3]); }
template <bool BASE_F32> struct EpiResidNorm {
    static __device__ __forceinline__ bool perm(int) { return true; }
    const float* BASE; h16* XH; float* RS;
    __device__ __forceinline__ void operator()(const Acc& acc, const Unit& u, int wr, int wc, int fr, int fq) const {
        const int row0 = u.pm * 256 + wr * 64 + fr, col0 = u.pn * 256 + 32 * wc + 8 * fq;
#pragma unroll
        for (int ai = 0; ai < 2; ++ai)
#pragma unroll
            for (int m = 0; m < 4; ++m) { const int row = row0 + ai * 128 + m * 16; float ss = 0.f;
#pragma unroll
                for (int bj = 0; bj < 2; ++bj) { const size_t off = (size_t)row * DM + col0 + bj * 128;
                    f32x4 b0, b1; if (BASE_F32) { b0 = *(const f32x4*)(BASE + off); b1 = *(const f32x4*)(BASE + off + 4); } else ld8h(XH + off, b0, b1);
                    const f32x4 v0 = b0 + acc[ai][bj][m][0], v1 = b1 + acc[ai][bj][m][1]; st8h(XH + off, v0, v1); ss += sumsq4(v0) + sumsq4(v1); }
                ss += __shfl_xor(ss, 16); ss += __shfl_xor(ss, 32);
                if (fq == 0) atomicAdd(RS + row, ss); }
    }
};
struct EpiSwiGLU {
    static __device__ __forceinline__ bool perm(int) { return false; }
    h16* ACT; const float* RS;
    __device__ __forceinline__ void operator()(const Acc& acc, const Unit& u, int wr, int wc, int fr, int fq) const {
        const int row0 = u.pm * 256 + wr * 64 + fr;
#pragma unroll
        for (int ai = 0; ai < 2; ++ai)
#pragma unroll
            for (int m = 0; m < 4; ++m) { const int row = row0 + ai * 128 + m * 16; const float r = __builtin_amdgcn_rsqf(RS[row] * (1.0f / DM) + EPS);
#pragma unroll
                for (int bj = 0; bj < 2; ++bj) { const f32x4 g = acc[ai][bj][m][0] * r, uu = acc[ai][bj][m][1] * r; f32x4 o;
#pragma unroll
                    for (int j = 0; j < 4; ++j) o[j] = g[j] * sigmoidf_(g[j]) * uu[j];
                    st4h(ACT + (size_t)row * DFF + 16 * (u.pn * 8 + bj * 4 + wc) + 4 * fq, o); } }
    }
};
struct EpiStoreH {
    static __device__ __forceinline__ bool perm(int) { return true; }
    h16* O; int ldc;
    __device__ __forceinline__ void operator()(const Acc& acc, const Unit& u, int wr, int wc, int fr, int fq) const {
        const int row0 = u.pm * 256 + wr * 64 + fr, col0 = u.pn * 256 + 32 * wc + 8 * fq;
#pragma unroll
        for (int ai = 0; ai < 2; ++ai)
#pragma unroll
            for (int m = 0; m < 4; ++m)
#pragma unroll
                for (int bj = 0; bj < 2; ++bj) st8h(O + (size_t)(row0 + ai * 128 + m * 16) * ldc + col0 + bj * 128, acc[ai][bj][m][0], acc[ai][bj][m][1]);
    }
};
struct EpiPLE {
    static __device__ __forceinline__ bool perm(int) { return true; }
    const h16* PP; const h16* XI; h16* XO; const float* RSIN; float* RSOUT;
    __device__ __forceinline__ void operator()(const Acc& acc, const Unit& u, int wr, int wc, int fr, int fq) const {
        const int row0 = u.pm * 256 + wr * 64 + fr, col0 = u.pn * 256 + 32 * wc + 8 * fq;
#pragma unroll
        for (int ai = 0; ai < 2; ++ai)
#pragma unroll
            for (int m = 0; m < 4; ++m) { const int row = row0 + ai * 128 + m * 16; const float r = __builtin_amdgcn_rsqf(RSIN[row] * (1.0f / DM) + EPS); float ss = 0.f;
#pragma unroll
                for (int bj = 0; bj < 2; ++bj) { const size_t off = (size_t)row * DM + col0 + bj * 128;
                    const f32x4 a0 = acc[ai][bj][m][0] * r, a1 = acc[ai][bj][m][1] * r; f32x4 p0, p1, x0, x1; ld8h(PP + off, p0, p1); ld8h(XI + off, x0, x1);
#pragma unroll
                    for (int j = 0; j < 4; ++j) { x0[j] += sigmoidf_(a0[j]) * p0[j]; x1[j] += sigmoidf_(a1[j]) * p1[j]; }
                    st8h(XO + off, x0, x1); ss += sumsq4(x0) + sumsq4(x1); }
                ss += __shfl_xor(ss, 16); ss += __shfl_xor(ss, 32);
                if (fq == 0) atomicAdd(RSOUT + row, ss); }
    }
};

__device__ __forceinline__ int map_in(int p) {
    if (p < 2560) return p;
    if (p < 2816) { const int c = p - 2560; if (c < 64) return 2560 + c; if (c < 80) return 2624 + (c - 64); if (c < 88) return 5712 + (c - 80); return -1; }
    const int q = p - 2816; if (q < 3072) return 2640 + q; return 5720 + (q - 3072);
}
template <int MODE>
__device__ __forceinline__ const float* tr_src(const float* W0, const float* W1, int Nsrc, int n) {
    if (MODE == 0) return n < Nsrc ? W0 + n : nullptr;
    if (MODE == 1) { const int c = map_in(n); return c >= 0 ? W0 + c : nullptr; }
    return (((n >> 4) & 1) ? W1 : W0) + 16 * (n >> 5) + (n & 15);
}
template <int MODE>
__device__ __forceinline__ void ph_transpose(const float* W0, const float* W1, const float* gk, int K, int Nsrc, h16* WT, int Nphys, LAS float* scr, int gw, int NGW, int lane) {
    const int nblk = Nphys / 32, nitems = (K / 64) * nblk;
    const int lr = lane >> 3, lc = (lane & 7) * 4;
    f32x4 cur[8], nxt[8];
    int item = gw;
    if (item < nitems) { const int kb = item / nblk, nb = item % nblk; const float* src = tr_src<MODE>(W0, W1, Nsrc, 32 * nb + lc);
#pragma unroll
        for (int i = 0; i < 8; ++i) cur[i] = src ? *(const f32x4*)(src + (size_t)(64 * kb + lr + 8 * i) * Nsrc) : (f32x4){0.f, 0.f, 0.f, 0.f}; }
    for (; item < nitems; item += NGW) {
        const int kb = item / nblk, nb = item % nblk, k0 = 64 * kb, n0 = 32 * nb;
        const int itn = item + NGW;
        if (itn < nitems) { const int kbn = itn / nblk, nbn = itn % nblk; const float* src = tr_src<MODE>(W0, W1, Nsrc, 32 * nbn + lc);
#pragma unroll
            for (int i = 0; i < 8; ++i) nxt[i] = src ? *(const f32x4*)(src + (size_t)(64 * kbn + lr + 8 * i) * Nsrc) : (f32x4){0.f, 0.f, 0.f, 0.f}; }
#pragma unroll
        for (int i = 0; i < 8; ++i) { LAS float* d = scr + (lr + 8 * i) * 33 + lc; const float gg = gk ? gk[k0 + lr + 8 * i] : 1.0f; d[0] = cur[i][0] * gg; d[1] = cur[i][1] * gg; d[2] = cur[i][2] * gg; d[3] = cur[i][3] * gg; }
        __builtin_amdgcn_wave_barrier(); asm volatile("s_waitcnt lgkmcnt(0)" ::: "memory");
        const int c = lane & 7;
#pragma unroll
        for (int j = 0; j < 4; ++j) { const int nn = (lane >> 3) + 8 * j; const LAS float* sp = scr + (8 * c) * 33 + nn;
            h16x8 o;
#pragma unroll
            for (int e = 0; e < 8; ++e) o[e] = (h16)sp[e * 33];
            *(h16x8*)(WT + (size_t)(n0 + nn) * K + k0 + 8 * c) = o; }
        __builtin_amdgcn_wave_barrier(); asm volatile("s_waitcnt lgkmcnt(0)" ::: "memory");
#pragma unroll
        for (int i = 0; i < 8; ++i) cur[i] = nxt[i];
    }
}
__device__ __forceinline__ void sincos_f32arg(float ang, float& sn, float& cs) {
    const double a = (double)ang;
    const double rev = a * 0.15915494309189535;
    const double fr = rev - __builtin_rint(rev);
    const double q4 = fr * 4.0; const double qi = __builtin_rint(q4); const int qq = ((int)qi) & 3;
    const double r = (q4 - qi) * 1.5707963267948966;
    const double r2 = r * r;
    const double s = r * (1.0 + r2 * (-1.0 / 6 + r2 * (1.0 / 120 + r2 * (-1.0 / 5040 + r2 * (1.0 / 362880 + r2 * (-1.0 / 39916800))))));
    const double c = 1.0 + r2 * (-0.5 + r2 * (1.0 / 24 + r2 * (-1.0 / 720 + r2 * (1.0 / 40320 + r2 * (-1.0 / 3628800 + r2 * (1.0 / 479001600))))));
    double so, co;
    if (qq == 0) { so = s; co = c; } else if (qq == 1) { so = c; co = -s; } else if (qq == 2) { so = -s; co = -c; } else { so = -c; co = s; }
    sn = (float)so; cs = (float)co;
}
__device__ __forceinline__ void ph_rope(const int* pos, float* ROPE, int gtid, int NGT) {
    for (int idx = gtid; idx < MTOK * 24; idx += NGT) {
        const int tok = idx / 24, i = idx % 24, k = i < 16 ? i : 2 * (i - 16);
        float f = 0x1.000000p+0f;
        f = k == 1 ? 0x1.c2ef76p-2f : f; f = k == 2 ? 0x1.8d275ep-3f : f; f = k == 3 ? 0x1.5dc95ap-4f : f; f = k == 4 ? 0x1.341190p-5f : f; f = k == 5 ? 0x1.0f5384p-6f : f;
        f = k == 6 ? 0x1.ddee9cp-8f : f; f = k == 7 ? 0x1.a4ee3ep-9f : f; f = k == 8 ? 0x1.72ba44p-10f : f; f = k == 9 ? 0x1.468318p-11f : f; f = k == 10 ? 0x1.1f91f0p-12f : f;
        f = k == 11 ? 0x1.fa8b84p-14f : f; f = k == 12 ? 0x1.be218ap-15f : f; f = k == 13 ? 0x1.88ec22p-16f : f; f = k == 14 ? 0x1.5a0f50p-17f : f; f = k == 15 ? 0x1.30c94ep-18f : f;
        const float ang = (float)pos[tok] * f;
        float sn, cs; sincos_f32arg(ang, sn, cs);
        float* rp = ROPE + (size_t)tok * 48;
        if (i < 16) { rp[i] = cs; rp[16 + i] = sn; } else { rp[32 + (i - 16)] = cs; rp[40 + (i - 16)] = sn; }
    }
}
template <bool TO_F32>
__device__ __forceinline__ void ph_rmsnorm(const float* X, const float* g, h16* OUTH, float* OUTF, int gw, int NGW, int lane) {
    for (int row = gw; row < MTOK; row += NGW) {
        const f32x4* xr = (const f32x4*)(X + (size_t)row * DM) + lane;
        f32x4 v[8]; float s = 0.f;
#pragma unroll
        for (int j = 0; j < 8; ++j) { v[j] = xr[64 * j]; s += (v[j][0] * v[j][0] + v[j][1] * v[j][1]) + (v[j][2] * v[j][2] + v[j][3] * v[j][3]); }
        const float r = 1.0f / sqrtf(wave_sum(s) * (1.0f / DM) + EPS);
#pragma unroll
        for (int j = 0; j < 8; ++j) { const f32x4 gg = *((const f32x4*)g + lane + 64 * j); const f32x4 o = v[j] * r * gg;
            if (TO_F32) *((f32x4*)(OUTF + (size_t)row * DM) + lane + 64 * j) = o; else st4h(OUTH + (size_t)row * DM + 4 * (lane + 64 * j), o); }
    }
}
__device__ __forceinline__ void ph_final(const h16* X, float* OUT, const float* g, const float* RS, int gw, int NGW, int lane) {
    for (int row = gw; row < MTOK; row += NGW) {
        const float r = __builtin_amdgcn_rsqf(RS[row] * (1.0f / DM) + EPS);
        h16x8 v[4];
#pragma unroll
        for (int j = 0; j < 4; ++j) v[j] = *((const h16x8*)(X + (size_t)row * DM) + lane + 64 * j);
#pragma unroll
        for (int j = 0; j < 4; ++j) { const float* gp = g + 8 * (lane + 64 * j); float* op = OUT + (size_t)row * DM + 8 * (lane + 64 * j);
            const f32x4 g0 = *(const f32x4*)gp, g1 = *(const f32x4*)(gp + 4);
            f32x4 o0 = {(float)v[j][0], (float)v[j][1], (float)v[j][2], (float)v[j][3]}, o1 = {(float)v[j][4], (float)v[j][5], (float)v[j][6], (float)v[j][7]};
            *(f32x4*)op = o0 * r * g0; *(f32x4*)(op + 4) = o1 * r * g1; }
    }
}
__device__ __forceinline__ void ph_cumsum(const float* LOGF, float* CBS, int bh, int lane) {
    const int b = bh >> 3, h = bh & 7;
    float v[64];
#pragma unroll
    for (int it = 0; it < 64; ++it) v[it] = LOGF[(size_t)(b * T + it * 64 + lane) * 8 + h];
    float run = 0.f;
#pragma unroll
    for (int it = 0; it < 64; ++it) {
        float x = v[it];
#pragma unroll
        for (int o = 1; o < 64; o <<= 1) { const float nb = __shfl_up(x, o); if (lane >= o) x += nb; }
        CBS[(size_t)bh * T + it * 64 + lane] = (run + x) * -11.313708498984761f;
        run += __shfl(x, 63);
    }
}

__device__ __forceinline__ unsigned fkey(float f) { const unsigned u = __float_as_uint(f + 0.0f); return (u & 0x80000000u) ? ~u : (u | 0x80000000u); }
__device__ __forceinline__ unsigned count_ge(const unsigned (&key)[64], unsigned th, int nj) {
    unsigned c = 0;
#pragma unroll
    for (int j8 = 0; j8 < 8; ++j8) {
        if (8 * j8 < nj) {
#pragma unroll
            for (int j = 8 * j8; j < 8 * j8 + 8; ++j) c += (key[j] >= th) ? 1u : 0u;
        }
    }
#pragma unroll
    for (int o = 1; o < 64; o <<= 1) c += __shfl_xor(c, o);
    return c;
}
__device__ __forceinline__ u64 topk_select(const unsigned (&key)[64], int nvalid, int lane) {
    u64 myword = 0;
    if (nvalid <= TOPK) {
#pragma unroll
        for (int j = 0; j < 64; ++j) { const u64 bal = __ballot(key[j] != 0u); if (lane == j) myword = bal; }
    } else {
        unsigned th = 0u; bool exact = false;
        for (int bit = 31; bit >= 0; --bit) { const unsigned tc = th | (1u << bit); const unsigned c = count_ge(key, tc, (nvalid + 63) >> 6); if (c >= (unsigned)TOPK) th = tc; if (c == (unsigned)TOPK) { exact = true; break; } }
        if (exact) {
#pragma unroll
            for (int j = 0; j < 64; ++j) { const u64 bal = __ballot(key[j] >= th); if (lane == j) myword = bal; }
        } else {
            unsigned cgt = 0;
#pragma unroll
            for (int j = 0; j < 64; ++j) cgt += (unsigned)__builtin_popcountll(__ballot(key[j] > th));
            int need = TOPK - (int)cgt;
#pragma unroll
            for (int j = 0; j < 64; ++j) { u64 eq = __ballot(key[j] == th); const u64 gt = __ballot(key[j] > th);
                int pc = __builtin_popcountll(eq);
                while (pc > need) { eq &= ~(1ull << (63 - __builtin_clzll(eq))); --pc; }
                need -= pc; if (lane == j) myword = gt | eq; }
        }
    }
    return myword;
}
template <int LVL>
__device__ __forceinline__ void hist_level(const unsigned (&key)[64], int nj, int lane, LAS unsigned* hist, unsigned& prefix, unsigned& need, unsigned& cnt_eq) {
    constexpr int SH = LVL == 0 ? 21 : (LVL == 1 ? 10 : 0), PSH = LVL == 1 ? 21 : 10, NB = LVL == 2 ? 10 : 11;
#pragma unroll
    for (int i = 0; i < 8; ++i) *(LAS u32x4*)(hist + lane * 32 + 4 * i) = (u32x4){0u, 0u, 0u, 0u};
    asm volatile("s_waitcnt lgkmcnt(0)" ::: "memory"); __builtin_amdgcn_wave_barrier();
#pragma unroll
    for (int j8 = 0; j8 < 8; ++j8) {
        if (8 * j8 < nj) {
            if (LVL == 0) {
#pragma unroll
                for (int j = 8 * j8; j < 8 * j8 + 8; ++j) __hip_atomic_fetch_add(hist + (key[j] >> 21), 1u, __ATOMIC_RELAXED, __HIP_MEMORY_SCOPE_WORKGROUP);
            } else {
                bool any = false;
#pragma unroll
                for (int j = 8 * j8; j < 8 * j8 + 8; ++j) any = any || ((key[j] >> PSH) == prefix);
                if (LVL == 1 || __any(any)) {
#pragma unroll
                    for (int j = 8 * j8; j < 8 * j8 + 8; ++j) { const unsigned k = key[j];
                        if ((k >> PSH) == prefix) __hip_atomic_fetch_add(hist + ((k >> SH) & ((1u << NB) - 1u)), 1u, __ATOMIC_RELAXED, __HIP_MEMORY_SCOPE_WORKGROUP); }
                }
            }
        }
    }
    asm volatile("s_waitcnt lgkmcnt(0)" ::: "memory"); __builtin_amdgcn_wave_barrier();
    unsigned s = 0;
#pragma unroll
    for (int i = 0; i < 8; ++i) { const u32x4 v = *(const LAS u32x4*)(hist + lane * 32 + 4 * i); s += (v[0] + v[1]) + (v[2] + v[3]); }
    unsigned S = s;
#pragma unroll
    for (int o = 1; o < 64; o <<= 1) { const unsigned nb = __shfl_down(S, o); if (lane + o < 64) S += nb; }
    const int L = 63 - __builtin_clzll(__ballot(S >= need));
    const unsigned aboveL = __shfl(S - s, L);
    const int bi = lane & 31;
    const unsigned hb = hist[L * 32 + bi];
    unsigned R = hb;
#pragma unroll
    for (int o = 1; o < 32; o <<= 1) { const unsigned nb = __shfl_down(R, o); if (bi + o < 32) R += nb; }
    const int B = 31 - __builtin_clz((unsigned)__ballot(aboveL + R >= need));
    const unsigned abB = __shfl(aboveL + R - hb, B);
    cnt_eq = __shfl(hb, B);
    prefix = (prefix << NB) | (unsigned)(L * 32 + B);
    need -= abB;
    __builtin_amdgcn_wave_barrier();
}
__device__ __forceinline__ u64 topk_select_hist(const unsigned (&key)[64], int nvalid, int lane, LAS unsigned* hist) {
    const int nj = (nvalid + 63) >> 6;
    unsigned prefix = 0, need = TOPK, cnt_eq = 0;
    hist_level<0>(key, nj, lane, hist, prefix, need, cnt_eq);
    hist_level<1>(key, nj, lane, hist, prefix, need, cnt_eq);
    hist_level<2>(key, nj, lane, hist, prefix, need, cnt_eq);
    u64 mw = 0;
    if (need == cnt_eq) {
#pragma unroll
        for (int j = 0; j < 64; ++j) { const u64 bal = __ballot(key[j] >= prefix); if (lane == j) mw = bal; }
    } else {
        int nd = (int)need;
#pragma unroll
        for (int j = 0; j < 64; ++j) { u64 eq = __ballot(key[j] == prefix); const u64 gt = __ballot(key[j] > prefix);
            int pc = __builtin_popcountll(eq);
            while (pc > nd) { eq &= ~(1ull << (63 - __builtin_clzll(eq))); --pc; }
            nd -= pc; if (lane == j) mw = gt | eq; }
    }
    return mw;
}
__device__ __forceinline__ void ph_topk_naive(const h16* QI, const h16* KI, const float* WI, u64* MASK, LAS float* qs, LAS unsigned* ks, int gw, int NGW, int lane) {
    for (int row = gw; row < MTOK; row += NGW) {
        const int b = row >> 12, t = row & 4095;
        { const h16* qp = QI + (size_t)row * 1024 + lane * 16;
#pragma unroll
          for (int i = 0; i < 16; ++i) qs[lane * 16 + i] = (float)qp[i]; }
        if (lane < 16) qs[1024 + lane] = WI[(size_t)row * 16 + lane];
        __builtin_amdgcn_wave_barrier(); asm volatile("s_waitcnt lgkmcnt(0)" ::: "memory");
#pragma unroll 1
        for (int j = 0; j < 64; ++j) {
            unsigned kk = 0u;
            const int s = 64 * j + lane;
            if (s <= t) {
                float kf[64];
                const h16x8* kp = (const h16x8*)(KI + (size_t)(b * T + s) * 64);
#pragma unroll
                for (int c = 0; c < 8; ++c) { const h16x8 kv = kp[c];
#pragma unroll
                    for (int e = 0; e < 8; ++e) kf[c * 8 + e] = (float)kv[e]; }
                float sc = 0.f;
#pragma unroll 1
                for (int h = 0; h < 16; ++h) { float d = 0.f;
#pragma unroll
                    for (int e = 0; e < 64; ++e) d = fmaf(qs[h * 64 + e], kf[e], d);
                    sc = fmaf(qs[1024 + h], fmaxf(d, 0.f), sc); }
                kk = fkey(sc);
            }
            ks[j * 64 + lane] = kk;
        }
        __builtin_amdgcn_wave_barrier(); asm volatile("s_waitcnt lgkmcnt(0)" ::: "memory");
        unsigned key[64];
#pragma unroll
        for (int j = 0; j < 64; ++j) key[j] = ks[j * 64 + lane];
        MASK[(size_t)row * 64 + lane] = topk_select(key, t + 1, lane);
        __builtin_amdgcn_wave_barrier(); asm volatile("s_waitcnt lgkmcnt(0)" ::: "memory");
    }
}


namespace idx {
typedef short s16x8 __attribute__((ext_vector_type(8)));
typedef float f32x16 __attribute__((ext_vector_type(16)));
constexpr int CHK = 128, CHB = CHK * 128;
__device__ __forceinline__ unsigned half_sum(unsigned v) {
#pragma unroll
    for (int o = 1; o < 32; o <<= 1) v += __shfl_xor(v, o);
    return v;
}
__device__ __forceinline__ void run_group(unsigned char* ws, char* lds, unsigned* scr, int b, int g, int wv) {
    int tid = wv * 64 + lane_id(); asm volatile("" : "+v"(tid));
    const int wid = __builtin_amdgcn_readfirstlane(tid >> 6), lane = tid & 63, c = lane & 31, hi = lane >> 5;
    const int t0 = 16 * g + 2 * wid, t = t0 + hi, row = b * T + t, tmaxblk = 16 * g + 15, nch = (tmaxblk >> 7) + 1;
    const h16* QI = (const h16*)(ws + WS_QI); const char* KIb = (const char*)ws + WS_KI + (size_t)b * T * 128; const float* WI = (const float*)(ws + WS_WI);
    s16x8 A[4];
    { const int rho = c, qsel = (rho >> 2) & 1, head = (rho & 3) + 4 * (rho >> 3);
      const h16* qp = QI + (size_t)(b * T + t0 + qsel) * 1024 + head * 64 + 8 * hi;
#pragma unroll
      for (int ks = 0; ks < 4; ++ks) A[ks] = *reinterpret_cast<const s16x8*>(qp + 16 * ks); }
    float w[16];
    { const f32x4* wp = (const f32x4*)(WI + (size_t)row * 16);
#pragma unroll
      for (int i = 0; i < 4; ++i) { const f32x4 v = wp[i]; w[4 * i] = v[0]; w[4 * i + 1] = v[1]; w[4 * i + 2] = v[2]; w[4 * i + 3] = v[3]; } }
    const int pr0 = tid >> 3, pp = tid & 7;
    const unsigned g_off = (unsigned)(pr0 * 128 + pp * 16);
    const int l_off0 = pr0 * 128 + ((pp ^ ((pr0 >> 1) & 7)) << 4), l_off1 = l_off0 + 64 * 128;
    const int rd_base = c * 128; const int sw = (c >> 1) & 7;
    int rd_off[4];
#pragma unroll
    for (int ks = 0; ks < 4; ++ks) rd_off[ks] = rd_base + (((2 * ks + hi) ^ sw) << 4);
    unsigned* myscr = scr + (size_t)(2 * wid + hi) * T + c;
    asm volatile("" :: "v"(A[0]), "v"(A[1]), "v"(A[2]), "v"(A[3]), "v"(w[0]), "v"(w[4]), "v"(w[8]), "v"(w[12]));
    s16x8 st0, st1;
    { const char* src = KIb; st0 = *reinterpret_cast<const s16x8*>(src + g_off); st1 = *reinterpret_cast<const s16x8*>(src + 64 * 128 + g_off); }
    *reinterpret_cast<s16x8*>(lds + l_off0) = st0; *reinterpret_cast<s16x8*>(lds + l_off1) = st1;
    __syncthreads();
#pragma unroll 1
    for (int ch = 0; ch < nch; ++ch) {
        const char* buf = lds + (ch & 1) * CHB;
        if (ch + 1 < nch) { const char* src = KIb + (size_t)(ch + 1) * CHB; st0 = *reinterpret_cast<const s16x8*>(src + g_off); st1 = *reinterpret_cast<const s16x8*>(src + 64 * 128 + g_off); }
#pragma unroll
        for (int st = 0; st < 4; ++st) {
            f32x16 acc = {};
#pragma unroll
            for (int ks = 0; ks < 4; ++ks) { const s16x8 Bf = *reinterpret_cast<const s16x8*>(buf + st * 4096 + rd_off[ks]);
                acc = __builtin_amdgcn_mfma_f32_32x32x16_f16(__builtin_bit_cast(h16x8, A[ks]), __builtin_bit_cast(h16x8, Bf), acc, 0, 0, 0); }
            float sc = 0.f;
#pragma unroll
            for (int r = 0; r < 16; ++r) { const int ri = __float_as_int(acc[r]); sc = fmaf(w[r], __int_as_float(ri > 0 ? ri : 0), sc); }
            const int sidx = ch * CHK + st * 32 + c;
            myscr[ch * CHK + st * 32] = (sidx <= t) ? fkey(sc) : 0u;
        }
        if (ch + 1 < nch) { char* dst = lds + ((ch + 1) & 1) * CHB; *reinterpret_cast<s16x8*>(dst + l_off0) = st0; *reinterpret_cast<s16x8*>(dst + l_off1) = st1; }
        __syncthreads();
    }
    asm volatile("s_waitcnt vmcnt(0)" ::: "memory");
    u64* MASK = (u64*)(ws + WS_MASK);
#pragma unroll 1
    for (int qq = 0; qq < 2; ++qq) {
        const int tq = t0 + qq, nj = (tq >> 6) + 1;
        const unsigned* src = scr + (size_t)(2 * wid + qq) * T + lane;
        unsigned key[64];
#pragma unroll
        for (int j = 0; j < 64; ++j) key[j] = (j < nj) ? __hip_atomic_load(src + 64 * j, __ATOMIC_RELAXED, __HIP_MEMORY_SCOPE_AGENT) : 0u;
        u64 mw;
        if (tq + 1 <= TOPK) {
            mw = 0;
#pragma unroll
            for (int j = 0; j < 4; ++j) { const u64 bal = __ballot(key[j] != 0u); if (lane == j) mw = bal; }
        } else mw = topk_select_hist(key, tq + 1, lane, (LAS unsigned*)(lds + 2 * CHB + wid * 8192));
        MASK[(size_t)(b * T + tq) * 64 + lane] = mw;
    }
}
}

namespace att {
constexpr int NW = 8, QBLK = 32, KVBLK = 64, QB = NW * QBLK, D = 128;
constexpr int SHM_V = KVBLK * D * 2, SHM_K = KVBLK * D * 2;
constexpr int LDS_NEED = 2 * SHM_V + 2 * SHM_K + NW * 64 * 4;
constexpr float THR = 8.f, SCALE = 0.08838834764831845f;
typedef short s16x8 __attribute__((ext_vector_type(8)));
typedef short s16x4 __attribute__((ext_vector_type(4)));
typedef float f32x16 __attribute__((ext_vector_type(16)));
#define KSWZ(row, colB) ((row) * 256 + ((colB) ^ (((row) & 7) << 4)))
#define SBAR() __builtin_amdgcn_sched_barrier(0)
__device__ __forceinline__ int v_st(int k, int c) { const int kk = (k & ~0xC) | ((k & 4) << 1) | ((k & 8) >> 1); return ((kk >> 3) * 4 + (c >> 5)) * 512 + ((kk & 7) * 32 + (c & 31)) * 2; }
__device__ __forceinline__ int v_rd_base(int lane) { return ((lane & 3) << 3) | (((lane >> 2) & 3) << 6) | (((lane >> 4) & 1) << 5) | (((lane >> 5) & 1) << 8); }
constexpr int v_rd_off(int d0, int ks, int half) { return d0 * 512 + ks * 4096 + half * 2048; }
__device__ __forceinline__ int crow(int r, int hi) { return (r & 3) + 8 * (r >> 2) + 4 * hi; }
__device__ __forceinline__ unsigned cvtpk(float lo, float hi) { unsigned r; asm volatile("v_cvt_pk_f16_f32 %0, %1, %2" : "=v"(r) : "v"(lo), "v"(hi)); return r; }
__device__ __forceinline__ f32x16 mfma16(s16x8 a, s16x8 b, f32x16 c) { return __builtin_amdgcn_mfma_f32_32x32x16_f16(__builtin_bit_cast(h16x8, a), __builtin_bit_cast(h16x8, b), c, 0, 0, 0); }
__device__ __forceinline__ s16x8 load8(const h16* p) { return *reinterpret_cast<const s16x8*>(p); }
__device__ __forceinline__ void mask_causal(f32x16& p0, f32x16& p1, int dq) {
    const float NEG = -__builtin_inff();
#pragma unroll
    for (int r = 0; r < 16; ++r) { const int c = (r & 3) + 8 * (r >> 2); if (dq - c < 0) p0[r] = NEG; if (dq - c - 32 < 0) p1[r] = NEG; }
}
__device__ __forceinline__ void mask_bits(f32x16& p0, f32x16& p1, u64 w, int hi) {
    const float NEG = -__builtin_inff();
    const unsigned lo = (unsigned)w >> (4 * hi), up = (unsigned)(w >> 32) >> (4 * hi);
#pragma unroll
    for (int r = 0; r < 16; ++r) { const int c = (r & 3) + 8 * (r >> 2); if (!((lo >> c) & 1u)) p0[r] = NEG; if (!((up >> c) & 1u)) p1[r] = NEG; }
}
__device__ __forceinline__ void partialSM(f32x16& p0, f32x16& p1, float& m_reg, float& mn, float& alpha) {
    float pmax = p0[0]; for (int r = 1; r < 16; ++r) pmax = fmaxf(pmax, p0[r]); for (int r = 0; r < 16; ++r) pmax = fmaxf(pmax, p1[r]);
    { auto rr = __builtin_amdgcn_permlane32_swap(__float_as_uint(pmax), __float_as_uint(pmax), false, false);
      pmax = fmaxf(__uint_as_float(rr[0]), __uint_as_float(rr[1])); }
    constexpr float C2 = 1.4426950408889634f * SCALE;
    if (__builtin_expect(__all((pmax - m_reg) * SCALE <= THR), 1)) { mn = m_reg; alpha = 1.f; }
    else { mn = fmaxf(m_reg, pmax); alpha = __builtin_amdgcn_exp2f((m_reg - mn) * C2); m_reg = mn; }
    const float mnL = -mn * C2;
    for (int r = 0; r < 16; ++r) p0[r] = fmaf(p0[r], C2, mnL); for (int r = 0; r < 16; ++r) p1[r] = fmaf(p1[r], C2, mnL);
    for (int r = 0; r < 16; ++r) p0[r] = __builtin_amdgcn_exp2f(p0[r]);
}
__device__ __forceinline__ void finishSM(f32x16& p0, f32x16& p1, float alpha, float& l_reg, s16x8& pa0, s16x8& pa1, s16x8& pa2, s16x8& pa3) {
    for (int r = 0; r < 16; ++r) p1[r] = __builtin_amdgcn_exp2f(p1[r]);
    float ps = 0; for (int r = 0; r < 16; ++r) ps += p0[r]; for (int r = 0; r < 16; ++r) ps += p1[r];
    { auto rr = __builtin_amdgcn_permlane32_swap(__float_as_uint(ps), __float_as_uint(ps), false, false);
      ps = __uint_as_float(rr[0]) + __uint_as_float(rr[1]); }
    l_reg = l_reg * alpha + ps;
#define PK4(P, B_, OUT) do { unsigned a0 = cvtpk(P[B_+0], P[B_+1]), a1 = cvtpk(P[B_+2], P[B_+3]);                          \
        unsigned b0 = cvtpk(P[B_+4], P[B_+5]), b1 = cvtpk(P[B_+6], P[B_+7]);                                             \
        auto r0 = __builtin_amdgcn_permlane32_swap(a0, b0, false, false); auto r1 = __builtin_amdgcn_permlane32_swap(a1, b1, false, false); \
        u32x4 w = {r0[0], r1[0], r0[1], r1[1]}; OUT = *reinterpret_cast<s16x8*>(&w); } while (0)
    PK4(p0, 0, pa0); PK4(p0, 8, pa1); PK4(p1, 0, pa2); PK4(p1, 8, pa3);
#undef PK4
}
template <int KB>
__device__ __forceinline__ void qkt(f32x16& p0, f32x16& p1, const char* K_lds, int r32, int hi, const s16x8* qr) {
    const char* kb[4];
#pragma unroll
    for (int dd = 0; dd < 4; ++dd) kb[dd] = K_lds + KB * SHM_K + KSWZ(r32, (dd * 16 + hi * 8) * 2);
#pragma unroll
    for (int d0 = 0; d0 < 8; ++d0) { const char* a = kb[d0 & 3] + (d0 >> 2) * 128;
        s16x8 b0 = *reinterpret_cast<const s16x8*>(a);
        s16x8 b1 = *reinterpret_cast<const s16x8*>(a + 32 * 256);
        p0 = mfma16(b0, qr[d0], p0);
        p1 = mfma16(b1, qr[d0], p1); }
}
template <int VB>
__device__ __forceinline__ void pv_tile(f32x16* o, int vb0, s16x8 pa0, s16x8 pa1, s16x8 pa2, s16x8 pa3) {
#define TRRD(dst, off) asm volatile("ds_read_b64_tr_b16 %0, %1 offset:%2" : "=&v"(dst) : "v"(vb0), "i"(off) : "memory")
#define PV_D0(d0) do { s16x4 l0, l1, l2, l3, h0, h1, h2, h3; constexpr int b_ = VB * SHM_V + v_rd_off(d0, 0, 0); \
        TRRD(l0, b_); TRRD(h0, b_ + 2048); TRRD(l1, b_ + 4096); TRRD(h1, b_ + 6144); TRRD(l2, b_ + 8192); TRRD(h2, b_ + 10240); TRRD(l3, b_ + 12288); TRRD(h3, b_ + 14336); \
        asm volatile("s_waitcnt lgkmcnt(0)" ::: "memory"); SBAR();   \
        o[d0] = mfma16(pa0, (s16x8){l0[0], l0[1], l0[2], l0[3], h0[0], h0[1], h0[2], h0[3]}, o[d0]);   \
        o[d0] = mfma16(pa1, (s16x8){l1[0], l1[1], l1[2], l1[3], h1[0], h1[1], h1[2], h1[3]}, o[d0]);   \
        o[d0] = mfma16(pa2, (s16x8){l2[0], l2[1], l2[2], l2[3], h2[0], h2[1], h2[2], h2[3]}, o[d0]);   \
        o[d0] = mfma16(pa3, (s16x8){l3[0], l3[1], l3[2], l3[3], h3[0], h3[1], h3[2], h3[3]}, o[d0]); } while (0)
    PV_D0(0); PV_D0(1); PV_D0(2); PV_D0(3);
#undef PV_D0
#undef TRRD
}
struct BlockRef { const char* Q; const char* K; const char* V; char* O; int P0; const char* NBQ; const char* MK; };
struct Seam { s16x8 qr[8]; s16x8 st_v0, st_v1, st_k0, st_k1; };
#define LD16(base, off) (*reinterpret_cast<const s16x8*>((base) + (off)))
#define VMW() asm volatile("s_waitcnt vmcnt(0)" ::: "memory")
#define VMWN(n) asm volatile("s_waitcnt vmcnt(%0)" :: "i"(n) : "memory")
#define SLOAD_H(Kp, Vp, k0) do { const char* vb_ = (Vp) + (size_t)(k0) * (D * 2); const char* kb_ = (Kp) + (size_t)(k0) * (D * 2); \
        S.st_v0 = LD16(vb_, st_off); S.st_v1 = LD16(vb_ + 32 * D * 2, st_off); S.st_k0 = LD16(kb_, st_off); S.st_k1 = LD16(kb_ + 32 * D * 2, st_off); } while (0)
#define SWRITE_HK(bf) do { *(s16x8*)(K_lds + (bf) * SHM_K + kws) = S.st_k0; *(s16x8*)(K_lds + (bf) * SHM_K + kws + 32 * 256) = S.st_k1; } while (0)
#define SWRITE_HV(bf) do { *(s16x8*)(V_lds + (bf) * SHM_V + vst0) = S.st_v0; *(s16x8*)(V_lds + (bf) * SHM_V + vst1) = S.st_v1; } while (0)
#define SWRITE_H(bf) do { SWRITE_HV(bf); SWRITE_HK(bf); } while (0)
__device__ __forceinline__ void prime(const BlockRef& cur, char* lds, Seam& S, int wv) {
    int tid = wv * 64 + lane_id(); asm volatile("" : "+v"(tid));
    const int wid = __builtin_amdgcn_readfirstlane(tid >> 6), lane = tid & 63, r32 = lane & 31, hi = lane >> 5;
    const int sr = tid >> 4, sc = (tid & 15) * 8, kws = KSWZ(sr, sc * 2); char* K_lds = lds + 2 * SHM_V;
    const unsigned st_off = (unsigned)(sr * D + sc) * 2u, q_off = (unsigned)((wid * QBLK + r32) * D + hi * 8) * 2u;
#pragma unroll
    for (int d0 = 0; d0 < 8; ++d0) S.qr[d0] = LD16(cur.Q + d0 * 32, q_off);
    SLOAD_H(cur.K, cur.V, 0); VMW(); SWRITE_HK(0);
    __syncthreads();
}
template <bool MIXB>
__device__ __forceinline__ void block(const BlockRef& cur, const BlockRef& nxt, char* lds, Seam& S, int wv) {
    int tid = wv * 64 + lane_id(); asm volatile("" : "+v"(tid));
    const int wid = __builtin_amdgcn_readfirstlane(tid >> 6), lane = tid & 63, r32 = lane & 31, hi = lane >> 5;
    const int NT = cur.P0 / KVBLK + 4;
    const int qlo = cur.P0 + wid * QBLK, qm = qlo + r32 - 4 * hi;
    char* V_lds = lds; char* K_lds = lds + 2 * SHM_V;
    float* wsf = (float*)(lds + 2 * SHM_V + 2 * SHM_K) + wid * 64; float* li_l = wsf, * al_l = wsf + 32;
    float m_reg = -1e30f, l_reg = 0; f32x16 o[4] = {};
    const int sr = tid >> 4, sc = (tid & 15) * 8, vst0 = v_st(sr, sc), vst1 = v_st(32 + sr, sc), kws = KSWZ(sr, sc * 2);
    const int vb0 = (int)(uintptr_t)V_lds + v_rd_base(lane);
    const unsigned st_off = (unsigned)(sr * D + sc) * 2u, q_off = (unsigned)((wid * QBLK + r32) * D + hi * 8) * 2u;
    const unsigned nb_off = (unsigned)hi * 16u, mk_off = (unsigned)(wid * QBLK + r32) * 512u;
    const char* Kh = cur.K; const char* Vh = cur.V;
    const char* bias_l = lds + LDS_NEED;
    if (MIXB) { const float nbref = *(const float*)(cur.NBQ + (size_t)(cur.P0 + QB - 1) * 4);
        for (int i = tid; i < cur.P0 + QB; i += NW * 64) ((float*)bias_l)[i] = ((const float*)cur.NBQ)[i] - nbref;
        __syncthreads(); }
#define RESC(a) do { if (__any((a) < 1.f)) { if (hi == 0) al_l[r32] = (a); asm volatile("s_waitcnt lgkmcnt(0)" ::: "memory");              \
                     for (int d_ = 0; d_ < 4; ++d_) for (int r = 0; r < 16; ++r) o[d_][r] *= al_l[crow(r, hi)]; } } while (0)
#define KBASE(t) ((t) * KVBLK)
#define MKW(t) (*(const u64*)(cur.MK + (size_t)(t) * 8 + mk_off))
#define PINIT(P0_, P1_, t, MW_) do { if (MIXB) { const char* nb_ = bias_l + KBASE(t) * 4 + nb_off; _Pragma("unroll") for (int g_ = 0; g_ < 4; ++g_) { \
            const f32x4 b0_ = *(const f32x4*)(nb_ + 32 * g_), b1_ = *(const f32x4*)(nb_ + 128 + 32 * g_); \
            _Pragma("unroll") for (int j_ = 0; j_ < 4; ++j_) { P0_[4 * g_ + j_] = b0_[j_]; P1_[4 * g_ + j_] = b1_[j_]; } } } else { const u64 w_ = (MW_); const unsigned lo_ = (unsigned)w_ >> (4 * hi), up_ = (unsigned)(w_ >> 32) >> (4 * hi); \
            _Pragma("unroll") for (int r_ = 0; r_ < 16; ++r_) { const int c_ = (r_ & 3) + 8 * (r_ >> 2); \
                P0_[r_] = __uint_as_float((((lo_ >> c_) & 1u) - 1u) & 0xff800000u); P1_[r_] = __uint_as_float((((up_ >> c_) & 1u) - 1u) & 0xff800000u); } } } while (0)
#define MASKT(P0_, P1_, t, MW_) do { if (MIXB) { const int kb_ = KBASE(t); if (kb_ + KVBLK - 1 > qlo) mask_causal(P0_, P1_, qm - kb_); } } while (0)
    f32x16 pA0, pA1, pB0, pB1; float mnA, mnB, alA, alB; s16x8 pa0, pa1, pa2, pa3;
    u64 mwA = 0, mwB = 0;
    if (!MIXB) { mwA = MKW(0); if (NT > 1) mwB = MKW(1); }
    PINIT(pA0, pA1, 0, mwA); if (!MIXB) { if (NT > 2) mwA = MKW(2); }
    if (NT > 1) { PINIT(pB0, pB1, 1, mwB); if (!MIXB) { if (NT > 3) mwB = MKW(3); } }
    SWRITE_HV(0); SBAR();
    if (NT > 1) SLOAD_H(Kh, Vh, KBASE(1));
    SBAR(); qkt<0>(pA0, pA1, K_lds, r32, hi, S.qr);
    MASKT(pA0, pA1, 0, mwA);
    partialSM(pA0, pA1, m_reg, mnA, alA);
    if (NT > 1) { VMW(); SWRITE_H(1); }
    __syncthreads();
#define HALF_STEP(PX0, PX1, mnX, alX, MWX, PY0, PY1, alY, MWY, t, KB, VB, SB) do {                                               \
        SBAR(); qkt<KB>(PX0, PX1, K_lds, r32, hi, S.qr);                                                                      \
        finishSM(PY0, PY1, alY, l_reg, pa0, pa1, pa2, pa3); SBAR();                                                           \
        if ((t) + 1 < NT) { PINIT(PY0, PY1, (t) + 1, MWY); if (!MIXB) { if ((t) + 3 < NT) MWY = MKW((t) + 3); } SLOAD_H(Kh, Vh, KBASE((t) + 1)); SBAR(); }                             \
        pv_tile<VB>(o, vb0, pa0, pa1, pa2, pa3); MASKT(PX0, PX1, (t), MWX); \
        partialSM(PX0, PX1, m_reg, mnX, alX);                                                                                 \
        __syncthreads();                                                                                                      \
        if ((t) + 1 < NT) { VMW(); SWRITE_H(SB); }                                                                            \
        RESC(alX); __syncthreads(); } while (0)
    for (int t = 1; t + 1 < NT; t += 2) {
        HALF_STEP(pB0, pB1, mnB, alB, mwB, pA0, pA1, alA, mwA, t, 1, 0, 0);
        HALF_STEP(pA0, pA1, mnA, alA, mwA, pB0, pB1, alB, mwB, t + 1, 0, 1, 1);
    }
    const bool even = (NT & 1) == 0;
    if (even) { SBAR(); qkt<1>(pB0, pB1, K_lds, r32, hi, S.qr); SBAR(); }
    SLOAD_H(nxt.K, nxt.V, 0); SBAR();
#pragma unroll
    for (int d0 = 0; d0 < 8; ++d0) S.qr[d0] = LD16(nxt.Q + d0 * 32, q_off);
    SBAR();
    finishSM(pA0, pA1, alA, l_reg, pa0, pa1, pa2, pa3); SBAR();
    pv_tile<0>(o, vb0, pa0, pa1, pa2, pa3);
    if (even) { MASKT(pB0, pB1, NT - 1, mwB); partialSM(pB0, pB1, m_reg, mnB, alB); __syncthreads(); RESC(alB);
        finishSM(pB0, pB1, alB, l_reg, pa0, pa1, pa2, pa3); SBAR(); pv_tile<1>(o, vb0, pa0, pa1, pa2, pa3); }
    SBAR(); VMWN(8); SWRITE_HK(0); SBAR();
    if (hi == 0) li_l[r32] = l_reg; asm volatile("s_waitcnt lgkmcnt(0)" ::: "memory");
    float rli[16];
#pragma unroll
    for (int r = 0; r < 16; ++r) rli[r] = __builtin_amdgcn_rcpf(li_l[crow(r, hi)]);
    const unsigned o_off = (unsigned)((wid * QBLK + 4 * hi) * 1024 + r32) * 2u;
#pragma unroll
    for (int r = 0; r < 16; ++r) {
#pragma unroll
        for (int d0 = 0; d0 < 4; ++d0) { const float v = o[d0][r] * rli[r];
            const float vn = __shfl_xor(v, 1);
            if ((r32 & 1) == 0) *(unsigned*)(cur.O + (size_t)(((r & 3) + 8 * (r >> 2)) * 2048 + d0 * 64) + o_off) = cvtpk(v, vn); } }
    __syncthreads();
#undef RESC
#undef KBASE
#undef PINIT
#undef MKW
#undef MASKT
#undef HALF_STEP
}
#undef LD16
#undef VMW
#undef VMWN
#undef SLOAD_H
#undef SWRITE_HK
#undef SWRITE_HV
#undef SWRITE_H
__device__ __forceinline__ BlockRef make_ref(bool mixb, unsigned char* ws, int bh, int qb) {
    const int b = bh >> 3, h = bh & 7, kvh = mixb ? bh : (b * HAKV + (h >> 2));
    BlockRef r;
    r.Q = (const char*)ws + (mixb ? WS_QB : WS_QA) + ((size_t)bh * T + (size_t)qb * QB) * D * 2;
    r.K = (const char*)ws + (mixb ? WS_KB : WS_KA) + (size_t)kvh * T * D * 2;
    r.V = (const char*)ws + (mixb ? WS_VB : WS_VA) + (size_t)kvh * T * D * 2;
    r.O = (char*)ws + (mixb ? WS_OUTB : WS_OUTA) + ((size_t)(b * T + qb * QB) * 1024 + h * D) * 2;
    r.P0 = qb * QB;
    r.NBQ = (const char*)ws + WS_CB + (size_t)bh * T * 4;
    r.MK = (const char*)ws + WS_MASK + (size_t)(b * T + qb * QB) * 64 * 8;
    return r;
}
template <bool MIXB>
__device__ __forceinline__ void run_item(int item, unsigned char* ws, char* lds, int wv) {
    const int bh = (item >> 3) & 15, x = item & 7;
    Seam S;
    BlockRef cur = make_ref(MIXB, ws, bh, x);
    prime(cur, lds, S, wv);
#pragma unroll 1
    for (int pass = 0; pass < 2; ++pass) {
        const BlockRef nxt = make_ref(MIXB, ws, bh, 15 - x);
        block<MIXB>(cur, nxt, lds, S, wv);
        cur = nxt;
    }
}
}


#define XB_TMO      128
#define XB_XCNT(j)  (256  + 64 * (j))
#define XB_XSUB(j)  (1280 + 64 * (j))
#define XB_XGEN(j)  (2304 + 64 * (j))
#define XB_TOP      3328
#define XB_TOPGEN   3392
#define XCD_BAR_WORDS 3456
#define XB_SPIN_CAP (1u << 24)
__device__ __forceinline__ unsigned xb_ld(unsigned* p)              { return __hip_atomic_load(p, __ATOMIC_RELAXED, __HIP_MEMORY_SCOPE_AGENT); }
__device__ __forceinline__ unsigned xb_add(unsigned* p, unsigned v) { return __hip_atomic_fetch_add(p, v, __ATOMIC_RELAXED, __HIP_MEMORY_SCOPE_AGENT); }
__device__ __forceinline__ unsigned xb_xcc_id() { return (unsigned)__builtin_amdgcn_s_getreg((3 << 11) | 20) & 0xFu; }
#define XB_SPIN(cond, bar) do { unsigned _sp = 0; while (cond) { __builtin_amdgcn_s_sleep(1); \
    if ((++_sp & 255u) == 0u) { if (xb_ld(&(bar)[XB_TMO])) break; if (_sp > XB_SPIN_CAP) { atomicAdd(&(bar)[XB_TMO], 1u); break; } } } } while (0)
struct XcdBarrier { unsigned* bar; unsigned x; volatile LAS unsigned* st; };
__device__ __forceinline__ XcdBarrier xcd_barrier_post(unsigned* bar, volatile LAS unsigned* st, int wv) {
    XcdBarrier b; b.bar = bar; b.x = xb_xcc_id(); b.st = st;
    if (wv == 0 && lane_id() == 0) (void)xb_add(&bar[XB_XCNT(b.x)], 1u);
    return b;
}
__device__ __forceinline__ void xcd_barrier_complete(unsigned* bar, unsigned x, unsigned& nloc, unsigned& nx) {
    const unsigned G = gridDim.x * gridDim.y * gridDim.z;
    unsigned sum, cnt, mine, sp = 0u;
    for (;;) {
        sum = 0u; cnt = 0u; mine = 0u;
#pragma unroll
        for (unsigned j = 0; j < 16; ++j) { const unsigned c = xb_ld(&bar[XB_XCNT(j)]); sum += c; cnt += (c > 0u) ? 1u : 0u; mine = (j == x) ? c : mine; }
        if (sum == G) break;
        __builtin_amdgcn_s_sleep(1);
        if ((++sp & 255u) == 0u) { if (xb_ld(&bar[XB_TMO])) break; if (sp > XB_SPIN_CAP) { atomicAdd(&bar[XB_TMO], 1u); break; } }
    }
    nloc = mine > 0u ? mine : 1u; nx = cnt > 0u ? cnt : 1u;
}
__device__ __forceinline__ void xcd_barrier(const XcdBarrier& b, int wv) {
    asm volatile("s_waitcnt vmcnt(0)" ::: "memory");
    __syncthreads();
    if (wv == 0 && lane_id() == 0) {
        unsigned* bar = b.bar;
        __builtin_amdgcn_s_waitcnt(0);
        unsigned nloc = b.st[0], nx = b.st[1];
        if (nloc == 0u) { xcd_barrier_complete(bar, b.x, nloc, nx); b.st[0] = nloc; b.st[1] = nx; }
        const unsigned old = xb_add(&bar[XB_XSUB(b.x)], 1u);
        const unsigned gen = old / nloc;
        if (old + 1u == (gen + 1u) * nloc) {
            __builtin_amdgcn_fence(__ATOMIC_RELEASE, "agent");
            asm volatile("s_waitcnt vmcnt(0)" ::: "memory");
            const unsigned og = xb_add(&bar[XB_TOP], 1u);
            const unsigned tg = og / nx;
            if (og + 1u == (tg + 1u) * nx) xb_add(&bar[XB_TOPGEN], 1u);
            else XB_SPIN(xb_ld(&bar[XB_TOPGEN]) == tg, bar);
            __builtin_amdgcn_fence(__ATOMIC_ACQUIRE, "agent");
            xb_add(&bar[XB_XGEN(b.x)], 1u);
            asm volatile("s_waitcnt vmcnt(0)" ::: "memory");
        } else {
            XB_SPIN(xb_ld(&bar[XB_XGEN(b.x)]) == gen, bar);
            __builtin_amdgcn_fence(__ATOMIC_ACQUIRE, "agent");
            asm volatile("s_waitcnt vmcnt(0)" ::: "memory");
        }
    }
    __syncthreads();
}

namespace cg = cooperative_groups;
#ifndef PROBE_DUP
#define PROBE_DUP 0
#endif
#define REP(k) for (int rep_ = 0; rep_ < (((PROBE_DUP) >> (k)) & 1) + 1; ++rep_)
constexpr int LDS_BYTES = pg8::STAGE_BYTES + 256;
constexpr int CW_QUEUE = 2048;
constexpr int CW_BAR = 4096;
struct Params { const float* in[17]; float* out; unsigned char* ws; };
template <class Epi>
__device__ __forceinline__ void run_gemm(LAS unsigned char* lds, const h16* A, const h16* Bt, int M, int N, int K, const Epi& e, int wv) {
    pg8::Gemm g{A, Bt, M, N, K}; pg8::StaticOrder S; S.init(M, N, (int)gridDim.x, (int)blockIdx.x);
    pg8::gemm_phase<Epi>(lds, g, S, e, wv);
}
__global__ void __launch_bounds__(512, 2) mega_fwd(Params P) {
    extern __shared__ __attribute__((aligned(16))) unsigned char lds_raw[];
    LAS unsigned char* lds = (LAS unsigned char*)lds_raw;
    const int wv = __builtin_amdgcn_readfirstlane(threadIdx.x >> 6);
    volatile LAS unsigned* bst = (volatile LAS unsigned*)(lds + pg8::STAGE_BYTES);
    if (wv == 0 && lane_id() < 2) bst[lane_id()] = 0u;
    __syncthreads();
    const XcdBarrier xbar = xcd_barrier_post((unsigned*)(P.ws + WS_CTL) + CW_BAR, bst, wv);
#define GRID_BAR() xcd_barrier(xbar, wv)
#define IDS() int lane = lane_id(); asm volatile("" : "+v"(lane)); const int wave = wv, tid = wave * 64 + lane, gw = blockIdx.x * 8 + wave, NGW = gridDim.x * 8; (void)tid; (void)gw; (void)NGW
    const float* x = P.in[0]; const float* p = P.in[1]; const int* pos = (const int*)P.in[2];
    const float* g_mix = P.in[3]; const float* w_in = P.in[4]; const float* b_f = P.in[5];
    const float* w_o_a = P.in[6]; const float* w_o_b = P.in[7]; const float* w_out = P.in[8];
    const float* g_ffn = P.in[9]; const float* w_g = P.in[10]; const float* w_u = P.in[11]; const float* w_d = P.in[12];
    const float* g_ple = P.in[13]; const float* w_pg = P.in[14]; const float* w_pp = P.in[15]; const float* g_final = P.in[16];
    unsigned char* ws = P.ws; float* out = P.out;
    float* RS = (float*)(ws + WS_RS); float* ROPE = (float*)(ws + WS_ROPE); float* CB = (float*)(ws + WS_CB); float* LOGF = (float*)(ws + WS_LOGF); u64* MASK = (u64*)(ws + WS_MASK);
    h16* WIN = (h16*)(ws + WS_WIN); h16* WOA = (h16*)(ws + WS_WOA); h16* WOB = (h16*)(ws + WS_WOB); h16* WOUT = (h16*)(ws + WS_WOUT);
    h16* WGU = (h16*)(ws + WS_WGU); h16* WDN = (h16*)(ws + WS_WDN); h16* WPG = (h16*)(ws + WS_WPG); h16* WPP = (h16*)(ws + WS_WPP);
    h16* QI = (h16*)(ws + WS_QI); h16* KI = (h16*)(ws + WS_KI); float* WI = (float*)(ws + WS_WI);
    h16* SIGA = (h16*)(ws + WS_SIGA); h16* SIGB = (h16*)(ws + WS_SIGB);
    h16* OUTA = (h16*)(ws + WS_OUTA); h16* OUTB = (h16*)(ws + WS_OUTB); h16* P16 = (h16*)(ws + WS_P16);
    h16* X3H = (h16*)(ws + WS_SIGA);
    h16* MIXED = (h16*)(ws + WS_MIXED); h16* H2 = (h16*)(ws + WS_H2); h16* ACT = (h16*)(ws + WS_ACT); h16* PP = (h16*)(ws + WS_PP);
    h16* H1 = (h16*)P.out;

    REP(0) { IDS(); LAS float* scr = (LAS float*)(lds + wave * 8448);
      ph_transpose<1>(w_in, nullptr, nullptr, DM, N_IN, WIN, N_INP, scr, gw, NGW, lane);
      ph_transpose<2>(w_g, w_u, g_ffn, DM, DFF, WGU, 2 * DFF, scr, gw, NGW, lane);
      ph_rope(pos, ROPE, blockIdx.x * 512 + tid, gridDim.x * 512);
      for (int i = blockIdx.x * 512 + tid; i < 3 * MTOK; i += gridDim.x * 512) RS[i] = 0.f;
      ph_rmsnorm<false>(x, g_mix, H1, nullptr, gw, NGW, lane);
    }
    GRID_BAR();
    REP(1) { EpiInProj e{ws, b_f}; run_gemm(lds, H1, WIN, MTOK, N_INP, DM, e, wv); }
    { const int fi = ((MTOK / 256) * (N_INP / 256)) % (int)gridDim.x;
    if ((int)blockIdx.x >= fi) { IDS(); (void)tid; (void)gw; (void)NGW; LAS float* scr = (LAS float*)(lds + wave * 8448); const int qw = ((int)blockIdx.x - fi) * 8 + wave, nq = ((int)gridDim.x - fi) * 8;
      ph_transpose<0>(w_o_a, nullptr, nullptr, 1024, DM, WOA, DM, scr, qw, nq, lane);
      ph_transpose<0>(w_o_b, nullptr, nullptr, 1024, DM, WOB, DM, scr, qw, nq, lane);
      ph_transpose<0>(w_out, nullptr, nullptr, DM, DM, WOUT, DM, scr, qw, nq, lane); } }
    GRID_BAR();
    REP(2) { IDS();
      if (gw >= NGW - 16) ph_cumsum(LOGF, CB, NGW - 1 - gw, lane);
      for (int it = blockIdx.x; it < 256; it += gridDim.x) { const int bb = it & 1, gi = it >> 1;
#pragma unroll 1
          for (int pass = 0; pass < 2; ++pass) idx::run_group(ws, (char*)lds_raw, (unsigned*)out + (size_t)blockIdx.x * 16 * T, bb, pass ? 255 - gi : gi, wv); }
      for (int i = blockIdx.x * 512 + tid; i < MTOK * DPLE / 4; i += gridDim.x * 512) st4h(P16 + 4 * (size_t)i, *((const f32x4*)p + i));
    }
    GRID_BAR();
    REP(3) for (int it = blockIdx.x; it < 256; it += gridDim.x) {
        const int item = (it & 7) * 32 + (it >> 3);
        if (item < 128) att::run_item<false>(item, ws, (char*)lds_raw, wv); else att::run_item<true>(item, ws, (char*)lds_raw, wv);
    }
    GRID_BAR();
    REP(4) { { EpiGate<true> e{SIGA, MIXED}; run_gemm(lds, OUTA, WOA, MTOK, DM, 1024, e, wv); }
    { EpiGate<false> e{SIGB, MIXED}; run_gemm(lds, OUTB, WOB, MTOK, DM, 1024, e, wv); } }
    GRID_BAR();
    REP(5) { EpiResidNorm<true> e{x, H2, RS}; run_gemm(lds, MIXED, WOUT, MTOK, DM, DM, e, wv); }
    GRID_BAR();
    REP(6) { EpiSwiGLU e{ACT, RS}; run_gemm(lds, H2, WGU, MTOK, 2 * DFF, DM, e, wv); }
    { const int fi = ((MTOK / 256) * (2 * DFF / 256)) % (int)gridDim.x;
    if ((int)blockIdx.x >= fi) { IDS(); (void)tid; (void)gw; (void)NGW; LAS float* scr = (LAS float*)(lds + wave * 8448); const int qw = ((int)blockIdx.x - fi) * 8 + wave, nq = ((int)gridDim.x - fi) * 8;
      ph_transpose<0>(w_d, nullptr, nullptr, DFF, DM, WDN, DM, scr, qw, nq, lane);
      ph_transpose<0>(w_pg, nullptr, g_ple, DM, DM, WPG, DM, scr, qw, nq, lane);
      ph_transpose<0>(w_pp, nullptr, nullptr, DPLE, DM, WPP, DM, scr, qw, nq, lane); } }
    GRID_BAR();
    { EpiResidNorm<false> e{nullptr, H2, RS + MTOK}; run_gemm(lds, ACT, WDN, MTOK, DM, DFF, e, wv); }
    GRID_BAR();
    { EpiStoreH e{PP, DM}; run_gemm(lds, P16, WPP, MTOK, DM, DPLE, e, wv); }
    { EpiPLE e{PP, H2, X3H, RS + MTOK, RS + 2 * MTOK}; run_gemm(lds, H2, WPG, MTOK, DM, DM, e, wv); }
    GRID_BAR();
    { IDS(); ph_final(X3H, out, g_final, RS + 2 * MTOK, gw, NGW, lane); }
#undef IDS
#undef GRID_BAR
}

extern "C" void kernel_launch(void* const* d_in, const int* in_sizes, int n_in, void* d_out, int out_size, void* d_ws, size_t ws_size, hipStream_t stream) {
    if (n_in != 17 || out_size != MTOK * DM || ws_size < WS_END) { fprintf(stderr, "kernel_launch: unexpected shapes / workspace (%d inputs, out %d, ws %zu)\n", n_in, out_size, ws_size); return; }
    static int grid_blocks = 0;
    if (!grid_blocks) {
        int dev = 0, cus = 0, per_cu = 0;
        (void)hipGetDevice(&dev);
        (void)hipDeviceGetAttribute(&cus, hipDeviceAttributeMultiprocessorCount, dev);
        (void)hipFuncSetAttribute((const void*)mega_fwd, hipFuncAttributeMaxDynamicSharedMemorySize, LDS_BYTES);
        (void)hipOccupancyMaxActiveBlocksPerMultiprocessor(&per_cu, (const void*)mega_fwd, 512, LDS_BYTES);
        if (per_cu < 1) { fprintf(stderr, "kernel_launch: occupancy query says %d blocks per CU\n", per_cu); per_cu = 1; }
        if (per_cu > 1) per_cu = 1;
        grid_blocks = cus * per_cu;
    }
    (void)hipMemsetAsync((char*)d_ws + WS_CTL, 0, 64 * 1024, stream);
    Params prm{};
    for (int i = 0; i < 17; ++i) prm.in[i] = (const float*)d_in[i];
    prm.out = (float*)d_out; prm.ws = (unsigned char*)d_ws;
    void* args[] = {&prm};
    hipError_t e = hipLaunchCooperativeKernel((const void*)mega_fwd, dim3(grid_blocks), dim3(512), args, LDS_BYTES, stream);
    if (e != hipSuccess) fprintf(stderr, "cooperative launch failed: %s (grid %d)\n", hipGetErrorString(e), grid_blocks);
}
```

```cpp
#include <hip/hip_runtime.h>
#include <hip/hip_cooperative_groups.h>
#include <stdint.h>
#include <cstdio>

#define LAS __attribute__((address_space(3)))
typedef _Float16 h16;
typedef _Float16 h16x8 __attribute__((ext_vector_type(8)));
typedef _Float16 h16x4 __attribute__((ext_vector_type(4)));
typedef _Float16 h16x2 __attribute__((ext_vector_type(2)));
typedef float f32x4 __attribute__((ext_vector_type(4)));
typedef float f32x2 __attribute__((ext_vector_type(2)));
typedef unsigned u32x4 __attribute__((ext_vector_type(4)));
typedef unsigned u32x2 __attribute__((ext_vector_type(2)));
typedef unsigned long long u64;
__device__ __forceinline__ int lane_id() { int r; asm volatile("v_mbcnt_lo_u32_b32 %0, -1, 0\n\tv_mbcnt_hi_u32_b32 %0, -1, %0" : "=v"(r)); return r; }

constexpr int NBATCH = 2, T = 4096, MTOK = NBATCH * T, DM = 2048;
constexpr int HA = 8, HAKV = 2, HIDX = 16, DIDX = 64, HB = 8, HD = 128;
constexpr int N_IN = 9816, N_INP = 9984, DFF = 5632, DPLE = 256, TOPK = 256;
constexpr float EPS = 1e-6f;
constexpr float ATT_SCALE = 0.08838834764831845f;

constexpr size_t MiB = 1u << 20;
constexpr size_t WS_CTL = 0;
constexpr size_t WS_RS = 512 * 1024;
constexpr size_t WS_ROPE = 1 * MiB;
constexpr size_t WS_CB = 3 * MiB;
constexpr size_t WS_LOGF = 3 * MiB + 512 * 1024;
constexpr size_t WS_MASK = 4 * MiB;
constexpr size_t WS_WIN = 8 * MiB;
constexpr size_t WS_OUTA = 8 * MiB, WS_OUTB = 24 * MiB, WS_P16 = 40 * MiB;
constexpr size_t WS_WOA = 47 * MiB, WS_WOB = 51 * MiB, WS_WOUT = 55 * MiB, WS_WGU = 63 * MiB, WS_WDN = 107 * MiB, WS_WPG = 129 * MiB, WS_WPP = 137 * MiB;
constexpr size_t WS_QA = 138 * MiB, WS_KA = 154 * MiB, WS_VA = 158 * MiB, WS_QI = 162 * MiB, WS_KI = 178 * MiB, WS_WI = 179 * MiB;
constexpr size_t WS_QB = 180 * MiB, WS_KB = 196 * MiB, WS_VB = 212 * MiB, WS_SIGA = 228 * MiB, WS_SIGB = 260 * MiB, WS_NBQ = 292 * MiB, WS_END = 296 * MiB;
constexpr size_t WS_MIXED = WS_QB;
constexpr size_t WS_H2 = WS_QA;
constexpr size_t WS_ACT = WS_QB;
constexpr size_t WS_PP = WS_QB;

namespace pg8 {
constexpr int BM = 256, BK = 64, HALF = 128, HTB = HALF * BK * 2, STAGE_BYTES = 8 * HTB, NXCD = 8, WGM = 4;
__host__ __device__ __forceinline__ int lds_byte(int r, int c) { const int st = (r >> 4) * 2 + (c >> 5), rr = r & 15, cc = c & 31, ob = rr * 64 + cc * 2; return st * 1024 + (ob ^ (((ob >> 9) & 1) << 5)); }
__host__ __device__ __forceinline__ int perm32(int rho) { const int n = rho >> 4, i = rho & 15; return 8 * (i >> 2) + 4 * n + (i & 3); }
__host__ __device__ __forceinline__ void stage_rc(int b, int& R, int& C) { const int st = b / 1024, sb = b % 1024, swz = sb ^ (((sb >> 9) & 1) << 5); R = (st >> 1) * 16 + swz / 64; C = (st & 1) * 32 + (swz % 64) / 2; }
struct Unit { int pm, pn; };
struct Gemm { const h16* A; const h16* Bt; int M, N, K; };
struct StaticOrder {
    int nM, nN, nwg, G, c;
    __host__ __device__ void init(int M, int N, int G_, int c_) { nM = M / BM; nN = N / BM; nwg = nM * nN; G = G_; c = c_; }
    __host__ __device__ bool next(int i, Unit& u) const {
        const long L = (long)i * G + c; if (L >= nwg) return false;
        int wgid = (int)L; { const int q = nwg / NXCD, r = nwg % NXCD, xcd = wgid % NXCD, off = wgid / NXCD; wgid = (xcd < r ? xcd * (q + 1) : r * (q + 1) + (xcd - r) * q) + off; }
        const int nig = WGM * nN, gid = wgid / nig, fm = gid * WGM, gsz = (nM - fm) < WGM ? (nM - fm) : WGM;
        u.pm = fm + ((wgid % nig) % gsz); u.pn = (wgid % nig) / gsz; return true;
    }
};
template <class Epi>
__device__ __forceinline__ void gemm_phase(LAS unsigned char* lds, const Gemm g, const StaticOrder& S, const Epi& E, int wv) {
    int tid = wv * 64 + lane_id(); asm volatile("" : "+v"(tid));
    const int wid = __builtin_amdgcn_readfirstlane(tid >> 6), lane = tid & 63, wr = wid >> 2, wc = wid & 3, fr = lane & 15, fq = lane >> 4;
    const int K = g.K, nt = K / BK;
    unsigned voffA[2], voffBp[2];
#pragma unroll
    for (int i = 0; i < 2; ++i) { int R, C; stage_rc(tid * 16 + i * 8192, R, C); voffA[i] = (unsigned)(R * K + C) * 2u; voffBp[i] = (unsigned)(((R & ~31) + perm32(R & 31)) * K + C) * 2u; }
    const size_t kstep = (size_t)(BK * 2);
    const size_t hstep = (size_t)HALF * K * 2;
    const size_t tstep = 2 * hstep;
    const unsigned ldsw = (unsigned)wid * 1024u;
    const int aoff = lds_byte(wr * 64 + fr, fq * 8), boff = lds_byte(wc * 32 + fr, fq * 8);
#define PG8_SA(b, h) (((b) * 2 + (h)) * HTB)
#define PG8_SB(b, h) ((4 + (b) * 2 + (h)) * HTB)
#define PG8_STAGE(bufoff, gbase) do { _Pragma("unroll") for (int _i = 0; _i < 2; ++_i) \
        __builtin_amdgcn_global_load_lds((const unsigned*)((const char*)(gbase) + voffA[_i]), (LAS unsigned*)(lds + (bufoff) + ldsw + _i * 8192), 16, 0, 0); } while (0)
#define PG8_STAGEB(bufoff, gbase, pf) do { _Pragma("unroll") for (int _i = 0; _i < 2; ++_i) \
        __builtin_amdgcn_global_load_lds((const unsigned*)((const char*)(gbase) + ((pf) ? voffBp[_i] : voffA[_i])), (LAS unsigned*)(lds + (bufoff) + ldsw + _i * 8192), 16, 0, 0); } while (0)
#define PG8_LDA(dst, b, h) do { _Pragma("unroll") for (int m = 0; m < 4; ++m) _Pragma("unroll") for (int k = 0; k < 2; ++k) dst[m][k] = *(const LAS h16x8*)(lds + PG8_SA(b, h) + aoff + m * 2048 + k * 1024); } while (0)
#define PG8_LDB(dst, b, h) do { _Pragma("unroll") for (int n = 0; n < 2; ++n) _Pragma("unroll") for (int k = 0; k < 2; ++k) dst[n][k] = *(const LAS h16x8*)(lds + PG8_SB(b, h) + boff + n * 2048 + k * 1024); } while (0)
#define PG8_MMA(ai, bj, At, Bt) do { __builtin_amdgcn_s_setprio(1); _Pragma("unroll") for (int m = 0; m < 4; ++m) _Pragma("unroll") for (int n = 0; n < 2; ++n) _Pragma("unroll") for (int k = 0; k < 2; ++k) \
        acc[ai][bj][m][n] = __builtin_amdgcn_mfma_f32_16x16x32_f16(Bt[n][k], At[m][k], acc[ai][bj][m][n], 0, 0, 0); __builtin_amdgcn_s_setprio(0); } while (0)
#define PG8_WAIT_V(n) asm volatile("s_waitcnt vmcnt(" #n ")" ::: "memory")
#define PG8_WAIT_L(n) asm volatile("s_waitcnt lgkmcnt(" #n ")" ::: "memory")
#define PG8_BAR __builtin_amdgcn_s_barrier()
#define PG8_SCHED __builtin_amdgcn_sched_barrier(0)
    Unit cur, nxt; int ui = 0;
    if (!S.next(0, cur)) return;
    f32x4 acc[2][2][4][2];
#pragma unroll
    for (int a = 0; a < 2; ++a)
#pragma unroll
        for (int b = 0; b < 2; ++b)
#pragma unroll
            for (int m = 0; m < 4; ++m)
#pragma unroll
                for (int n = 0; n < 2; ++n) acc[a][b][m][n] = (f32x4){0.f, 0.f, 0.f, 0.f};
    h16x8 At[4][2], B0[2][2], B1[2][2];
    const char* cA = (const char*)g.A + (size_t)cur.pm * tstep; const char* cB = (const char*)g.Bt + (size_t)cur.pn * tstep;
    bool pfc = Epi::perm(cur.pn);
    PG8_STAGEB(PG8_SB(0, 0), cB, pfc); PG8_STAGE(PG8_SA(0, 0), cA); PG8_STAGEB(PG8_SB(0, 1), cB + hstep, pfc); PG8_STAGE(PG8_SA(0, 1), cA + hstep);
    if (wr == 1) PG8_BAR;
    PG8_WAIT_V(4); PG8_BAR;
    PG8_STAGEB(PG8_SB(1, 0), cB + kstep, pfc); PG8_STAGE(PG8_SA(1, 0), cA + kstep); PG8_STAGEB(PG8_SB(1, 1), cB + hstep + kstep, pfc);
    PG8_WAIT_V(6); PG8_BAR;
    for (;;) {
        const bool has_next = S.next(ui + 1, nxt);
        const char* nA = has_next ? (const char*)g.A + (size_t)nxt.pm * tstep : cA; const char* nB = has_next ? (const char*)g.Bt + (size_t)nxt.pn * tstep : cB;
        const bool pfn = has_next ? Epi::perm(nxt.pn) : pfc;
        for (int t = 0; t < nt; t += 2) {
            const bool last = (t == nt - 2);
            const char* a1 = cA + (size_t)(t + 1) * kstep;
            const char* a2 = last ? nA : cA + (size_t)(t + 2) * kstep; const char* b2 = last ? nB : cB + (size_t)(t + 2) * kstep;
            const char* a3 = a2 + kstep; const char* b3 = b2 + kstep;
            const bool pf2 = last ? pfn : pfc;
            PG8_LDB(B0, 0, 0); PG8_SCHED; PG8_LDA(At, 0, 0); PG8_STAGE(PG8_SA(1, 1), a1 + hstep);
            PG8_WAIT_L(8); PG8_BAR; PG8_WAIT_L(0); PG8_MMA(0, 0, At, B0); PG8_BAR; PG8_SCHED;
            PG8_LDB(B1, 0, 1); PG8_STAGEB(PG8_SB(0, 0), b2, pf2);
            PG8_BAR; PG8_WAIT_L(0); PG8_MMA(0, 1, At, B1); PG8_BAR;
            PG8_LDA(At, 0, 1); PG8_STAGE(PG8_SA(0, 0), a2);
            PG8_BAR; PG8_WAIT_L(0); PG8_MMA(1, 0, At, B0); PG8_BAR; PG8_SCHED;
            PG8_STAGEB(PG8_SB(0, 1), b2 + hstep, pf2);
            PG8_WAIT_V(6); PG8_BAR; PG8_MMA(1, 1, At, B1); PG8_BAR;
            PG8_LDB(B0, 1, 0); PG8_SCHED; PG8_LDA(At, 1, 0); PG8_STAGE(PG8_SA(0, 1), a2 + hstep);
            PG8_WAIT_L(8); PG8_BAR; PG8_WAIT_L(0); PG8_MMA(0, 0, At, B0); PG8_BAR; PG8_SCHED;
            PG8_LDB(B1, 1, 1); PG8_STAGEB(PG8_SB(1, 0), b3, pf2);
            PG8_BAR; PG8_WAIT_L(0); PG8_MMA(0, 1, At, B1); PG8_BAR;
            PG8_LDA(At, 1, 1); PG8_STAGE(PG8_SA(1, 0), a3);
            PG8_BAR; PG8_WAIT_L(0); PG8_MMA(1, 0, At, B0); PG8_BAR; PG8_SCHED;
            PG8_STAGEB(PG8_SB(1, 1), b3 + hstep, pf2);
            PG8_WAIT_V(6); PG8_BAR; PG8_MMA(1, 1, At, B1); PG8_BAR;
        }
        if constexpr (!Epi::AFTER_DRAIN) E(acc, cur, wr, wc, fr, fq);
        if (!has_next) break;
#pragma unroll
        for (int a = 0; a < 2; ++a)
#pragma unroll
            for (int b = 0; b < 2; ++b)
#pragma unroll
                for (int m = 0; m < 4; ++m)
#pragma unroll
                    for (int n = 0; n < 2; ++n) acc[a][b][m][n] = (f32x4){0.f, 0.f, 0.f, 0.f};
        cur = nxt; cA = nA; cB = nB; pfc = pfn; ++ui;
    }
    PG8_WAIT_V(0);
    if (wr == 0) PG8_BAR;
    PG8_BAR;
    if constexpr (Epi::AFTER_DRAIN) E.fused(acc, cur, wr, wc, fr, fq, lane);
#undef PG8_SA
#undef PG8_SB
#undef PG8_STAGE
#undef PG8_STAGEB
#undef PG8_LDA
#undef PG8_LDB
#undef PG8_MMA
#undef PG8_WAIT_V
#undef PG8_WAIT_L
#undef PG8_BAR
#undef PG8_SCHED
}
}
using pg8::Unit;
typedef f32x4 Acc[2][2][4][2];

__device__ __forceinline__ void st4h(h16* p, f32x4 v) { h16x4 o; o[0] = (h16)v[0]; o[1] = (h16)v[1]; o[2] = (h16)v[2]; o[3] = (h16)v[3]; *(h16x4*)p = o; }
__device__ __forceinline__ void st8h(h16* p, f32x4 a, f32x4 b) { h16x8 o; o[0] = (h16)a[0]; o[1] = (h16)a[1]; o[2] = (h16)a[2]; o[3] = (h16)a[3]; o[4] = (h16)b[0]; o[5] = (h16)b[1]; o[6] = (h16)b[2]; o[7] = (h16)b[3]; *(h16x8*)p = o; }
__device__ __forceinline__ void ld8h(const h16* p, f32x4& a, f32x4& b) { const h16x8 o = *(const h16x8*)p; a = (f32x4){(float)o[0], (float)o[1], (float)o[2], (float)o[3]}; b = (f32x4){(float)o[4], (float)o[5], (float)o[6], (float)o[7]}; }
__device__ __forceinline__ f32x4 ld4h(const h16* p) { const h16x4 o = *(const h16x4*)p; return (f32x4){(float)o[0], (float)o[1], (float)o[2], (float)o[3]}; }
__device__ __forceinline__ float sigmoidf_(float x) { return __builtin_amdgcn_rcpf(1.0f + __expf(-x)); }
__device__ __forceinline__ float logsigmoidf_(float z) { return fminf(z, 0.f) - __logf(1.0f + __expf(-fabsf(z))); }
__device__ __forceinline__ float wave_sum(float v) {
#pragma unroll
    for (int o = 1; o < 64; o <<= 1) v += __shfl_xor(v, o);
    return v;
}

struct EpiInProj {
    static constexpr bool AFTER_DRAIN = false;
    static __device__ __forceinline__ bool perm(int pn) { return pn == 5 || pn >= 11; }
    unsigned char* ws; const float* b_f;
    __device__ __forceinline__ void operator()(const Acc& acc, const Unit& u, int wr, int wc, int fr, int fq) const {
        const int pn = u.pn, row0 = u.pm * 256 + wr * 64 + fr;
        const float* ROPE = (const float*)(ws + WS_ROPE);
#pragma unroll
        for (int ai = 0; ai < 2; ++ai)
#pragma unroll
            for (int m = 0; m < 4; ++m) {
                const int row = row0 + ai * 128 + m * 16, b = row >> 12, t = row & 4095;
                const float* rp = ROPE + (size_t)row * 48;
#pragma unroll
                for (int bj = 0; bj < 2; ++bj) {
                    f32x4 v0 = acc[ai][bj][m][0], v1 = acc[ai][bj][m][1];
                    const int d0 = 32 * wc + 4 * fq;
                    const int d8 = 32 * wc + 8 * fq;
                    if (pn < 6) {
                        size_t off;
                        if (pn < 4) off = WS_QA + (((size_t)(b * HA + pn * 2 + bj) * T + t) * HD) * 2;
                        else off = (pn == 4 ? WS_KA : WS_VA) + (((size_t)(b * HAKV + bj) * T + t) * HD) * 2;
                        h16* dst = (h16*)(ws + off);
                        if (pn < 5 && wc == 0) {
                            const f32x4 c = *(const f32x4*)(rp + 4 * fq), s = *(const f32x4*)(rp + 16 + 4 * fq);
                            const f32x4 y0 = v0 * c - v1 * s, y1 = v1 * c + v0 * s; v0 = y0; v1 = y1;
                        }
                        if (pn == 5) st8h(dst + d8, v0, v1); else { st4h(dst + d0, v0); st4h(dst + d0 + 16, v1); }
                    } else if (pn < 11) {
                        const bool is_q = pn < 10;
                        if (is_q || bj == 0) {
                            if (is_q || wc < 2) {
                                const int dd = 32 * (wc & 1) + 4 * fq;
                                const size_t off = is_q ? WS_QI + ((size_t)row * 1024 + ((pn - 6) * 4 + 2 * bj + (wc >> 1)) * 64) * 2 : WS_KI + ((size_t)row * 64) * 2;
                                h16* dst = (h16*)(ws + off);
                                if ((wc & 1) == 0) {
                                    f32x4 pr;
#pragma unroll
                                    for (int j = 0; j < 4; ++j) pr[j] = __shfl_xor(v0[j], 32);
                                    const f32x4 c = *(const f32x4*)(rp + 32 + 4 * (fq & 1)), s = *(const f32x4*)(rp + 40 + 4 * (fq & 1));
                                    v0 = (fq < 2) ? (v0 * c - pr * s) : (v0 * c + pr * s);
                                }
                                st4h(dst + dd, v0); st4h(dst + dd + 16, v1);
                            } else if (wc == 2) {
                                *(f32x4*)((float*)(ws + WS_WI) + (size_t)row * 16 + 4 * fq) = v0 * 0.03125f;
                                if (fq < 2) { const f32x4 bf = *(const f32x4*)(b_f + 4 * fq); f32x4 o;
#pragma unroll
                                    for (int j = 0; j < 4; ++j) o[j] = logsigmoidf_(v1[j] + bf[j]);
                                    *(f32x4*)((float*)(ws + WS_LOGF) + (size_t)row * 8 + 4 * fq) = o; }
                            }
                        }
                    } else if (pn < 23) {
                        const int q = pn - 11, which = q >> 2, head = (q & 3) * 2 + bj;
                        h16* dst = (h16*)(ws + WS_QB + (size_t)which * (WS_KB - WS_QB)) + ((size_t)(b * HB + head) * T + t) * HD;
                        st8h(dst + d8, v0, v1);
                    } else {
                        const int q = pn - 23; const int col = (q & 7) * 256 + 128 * bj + d8;
                        h16* base = (h16*)(ws + WS_SIGA + (size_t)(q >> 3) * (WS_SIGB - WS_SIGA));
#pragma unroll
                        for (int j = 0; j < 4; ++j) { v0[j] = sigmoidf_(v0[j]); v1[j] = sigmoidf_(v1[j]); }
                        st8h(base + (size_t)row * DM + col, v0, v1);
                    }
                }
            }
    }
};
static_assert(WS_VB - WS_KB == WS_KB - WS_QB, "QB/KB/VB equally spaced");
template <bool FIRST> struct EpiGate {
    static constexpr bool AFTER_DRAIN = false;
    static __device__ __forceinline__ bool perm(int) { return true; }
    const h16* SIG; h16* MIXED;
    __device__ __forceinline__ void operator()(const Acc& acc, const Unit& u, int wr, int wc, int fr, int fq) const {
        const int row0 = u.pm * 256 + wr * 64 + fr, col0 = u.pn * 256 + 32 * wc + 8 * fq;
#pragma unroll
        for (int ai = 0; ai < 2; ++ai)
#pragma unroll
            for (int m = 0; m < 4; ++m)
#pragma unroll
                for (int bj = 0; bj < 2; ++bj) { const size_t off = (size_t)(row0 + ai * 128 + m * 16) * DM + col0 + bj * 128;
                    f32x4 s0, s1; ld8h(SIG + off, s0, s1); f32x4 v0 = s0 * acc[ai][bj][m][0], v1 = s1 * acc[ai][bj][m][1];
                    if (!FIRST) { f32x4 m0, m1; ld8h(MIXED + off, m0, m1); v0 += m0; v1 += m1; }
                    st8h(MIXED + off, v0, v1); }
    }
};
__device__ __forceinline__ float sumsq4(f32x4 v) { return (v[0] * v[0] + v[1] * v[1]) + (v[2] * v[2] + v[3] * v[3]); }
template <bool BASE_F32> struct EpiResidNorm {
    static constexpr bool AFTER_DRAIN = false;
    static __device__ __forceinline__ bool perm(int) { return true; }
    const float* BASE; h16* XH; float* RS;
    __device__ __forceinline__ void operator()(const Acc& acc, const Unit& u, int wr, int wc, int fr, int fq) const {
        const int row0 = u.pm * 256 + wr * 64 + fr, col0 = u.pn * 256 + 32 * wc + 8 * fq;
#pragma unroll
        for (int ai = 0; ai < 2; ++ai)
#pragma unroll
            for (int m = 0; m < 4; ++m) { const int row = row0 + ai * 128 + m * 16; float ss = 0.f;
#pragma unroll
                for (int bj = 0; bj < 2; ++bj) { const size_t off = (size_t)row * DM + col0 + bj * 128;
                    f32x4 b0, b1; if (BASE_F32) { b0 = *(const f32x4*)(BASE + off); b1 = *(const f32x4*)(BASE + off + 4); } else ld8h(XH + off, b0, b1);
                    const f32x4 v0 = b0 + acc[ai][bj][m][0], v1 = b1 + acc[ai][bj][m][1]; st8h(XH + off, v0, v1); ss += sumsq4(v0) + sumsq4(v1); }
                ss += __shfl_xor(ss, 16); ss += __shfl_xor(ss, 32);
                if (fq == 0) atomicAdd(RS + row, ss); }
    }
};
struct EpiSwiGLU {
    static constexpr bool AFTER_DRAIN = false;
    static __device__ __forceinline__ bool perm(int) { return false; }
    h16* ACT; const float* RS;
    __device__ __forceinline__ void operator()(const Acc& acc, const Unit& u, int wr, int wc, int fr, int fq) const {
        const int row0 = u.pm * 256 + wr * 64 + fr;
#pragma unroll
        for (int ai = 0; ai < 2; ++ai)
#pragma unroll
            for (int m = 0; m < 4; ++m) { const int row = row0 + ai * 128 + m * 16; const float r = __builtin_amdgcn_rsqf(RS[row] * (1.0f / DM) + EPS);
#pragma unroll
                for (int bj = 0; bj < 2; ++bj) { const f32x4 g = acc[ai][bj][m][0] * r, uu = acc[ai][bj][m][1] * r; f32x4 o;
#pragma unroll
                    for (int j = 0; j < 4; ++j) o[j] = g[j] * sigmoidf_(g[j]) * uu[j];
                    st4h(ACT + (size_t)row * DFF + 16 * (u.pn * 8 + bj * 4 + wc) + 4 * fq, o); } }
    }
};
struct EpiStoreH {
    static constexpr bool AFTER_DRAIN = false;
    static __device__ __forceinline__ bool perm(int) { return true; }
    h16* O; int ldc;
    __device__ __forceinline__ void operator()(const Acc& acc, const Unit& u, int wr, int wc, int fr, int fq) const {
        const int row0 = u.pm * 256 + wr * 64 + fr, col0 = u.pn * 256 + 32 * wc + 8 * fq;
#pragma unroll
        for (int ai = 0; ai < 2; ++ai)
#pragma unroll
            for (int m = 0; m < 4; ++m)
#pragma unroll
                for (int bj = 0; bj < 2; ++bj) st8h(O + (size_t)(row0 + ai * 128 + m * 16) * ldc + col0 + bj * 128, acc[ai][bj][m][0], acc[ai][bj][m][1]);
    }
};
struct EpiPLE {
    static constexpr bool AFTER_DRAIN = false;
    static __device__ __forceinline__ bool perm(int) { return true; }
    const h16* PP; const h16* XI; h16* XO; const float* RSIN; float* RSOUT;
    __device__ __forceinline__ void operator()(const Acc& acc, const Unit& u, int wr, int wc, int fr, int fq) const {
        const int row0 = u.pm * 256 + wr * 64 + fr, col0 = u.pn * 256 + 32 * wc + 8 * fq;
#pragma unroll
        for (int ai = 0; ai < 2; ++ai)
#pragma unroll
            for (int m = 0; m < 4; ++m) { const int row = row0 + ai * 128 + m * 16; const float r = __builtin_amdgcn_rsqf(RSIN[row] * (1.0f / DM) + EPS); float ss = 0.f;
#pragma unroll
                for (int bj = 0; bj < 2; ++bj) { const size_t off = (size_t)row * DM + col0 + bj * 128;
                    const f32x4 a0 = acc[ai][bj][m][0] * r, a1 = acc[ai][bj][m][1] * r; f32x4 p0, p1, x0, x1; ld8h(PP + off, p0, p1); ld8h(XI + off, x0, x1);
#pragma unroll
                    for (int j = 0; j < 4; ++j) { x0[j] += sigmoidf_(a0[j]) * p0[j]; x1[j] += sigmoidf_(a1[j]) * p1[j]; }
                    st8h(XO + off, x0, x1); ss += sumsq4(x0) + sumsq4(x1); }
                ss += __shfl_xor(ss, 16); ss += __shfl_xor(ss, 32);
                if (fq == 0) atomicAdd(RSOUT + row, ss); }
    }
};

struct EpiPLEFinal {
    static constexpr bool AFTER_DRAIN = true;
    static __device__ __forceinline__ bool perm(int) { return true; }
    const h16* PP; const h16* XI; float* OUT; const float* RSIN; float* RSOUT; const float* gfin; unsigned* cnt;
    __device__ __forceinline__ void operator()(const Acc&, const Unit&, int, int, int, int) const {}
    __device__ __forceinline__ void fused(Acc& acc, const Unit& u, int wr, int wc, int fr, int fq, int lane) const {
        const int row0 = u.pm * 256 + wr * 64 + fr, col0 = u.pn * 256 + 32 * wc + 8 * fq;
#pragma unroll
        for (int ai = 0; ai < 2; ++ai)
#pragma unroll
            for (int m = 0; m < 4; ++m) { const int row = row0 + ai * 128 + m * 16; const float r = __builtin_amdgcn_rsqf(RSIN[row] * (1.0f / DM) + EPS); float ss = 0.f;
#pragma unroll
                for (int bj = 0; bj < 2; ++bj) { const size_t off = (size_t)row * DM + col0 + bj * 128;
                    const f32x4 a0 = acc[ai][bj][m][0] * r, a1 = acc[ai][bj][m][1] * r; f32x4 p0, p1, x0, x1; ld8h(PP + off, p0, p1); ld8h(XI + off, x0, x1);
#pragma unroll
                    for (int j = 0; j < 4; ++j) { x0[j] += sigmoidf_(a0[j]) * p0[j]; x1[j] += sigmoidf_(a1[j]) * p1[j]; }
                    acc[ai][bj][m][0] = x0; acc[ai][bj][m][1] = x1; ss += sumsq4(x0) + sumsq4(x1); }
                ss += __shfl_xor(ss, 16); ss += __shfl_xor(ss, 32);
                if (fq == 0) atomicAdd(RSOUT + row, ss); }
        asm volatile("s_waitcnt vmcnt(0)" ::: "memory");
        unsigned* c = cnt + 64 * u.pm;
        if (lane == 0) __hip_atomic_fetch_add(c, 1u, __ATOMIC_RELAXED, __HIP_MEMORY_SCOPE_AGENT);
        { unsigned spins = 0;
          while ((unsigned)__builtin_amdgcn_readfirstlane((int)__hip_atomic_load(c, __ATOMIC_RELAXED, __HIP_MEMORY_SCOPE_AGENT)) < 64u) { __builtin_amdgcn_s_sleep(2); if (++spins > (1u << 22)) break; } }
#pragma unroll
        for (int ai = 0; ai < 2; ++ai)
#pragma unroll
            for (int m = 0; m < 4; ++m) { const int row = row0 + ai * 128 + m * 16;
                const float r = __builtin_amdgcn_rsqf(__hip_atomic_load(RSOUT + row, __ATOMIC_RELAXED, __HIP_MEMORY_SCOPE_AGENT) * (1.0f / DM) + EPS);
#pragma unroll
                for (int bj = 0; bj < 2; ++bj) { const size_t off = (size_t)row * DM + col0 + bj * 128;
                    const f32x4 g0 = *(const f32x4*)(gfin + col0 + bj * 128), g1 = *(const f32x4*)(gfin + col0 + bj * 128 + 4);
                    *(f32x4*)(OUT + off) = acc[ai][bj][m][0] * r * g0; *(f32x4*)(OUT + off + 4) = acc[ai][bj][m][1] * r * g1; } }
    }
};

__device__ __forceinline__ int map_in(int p) {
    if (p < 2560) return p;
    if (p < 2816) { const int c = p - 2560; if (c < 64) return 2560 + c; if (c < 80) return 2624 + (c - 64); if (c < 88) return 5712 + (c - 80); return -1; }
    const int q = p - 2816; if (q < 3072) return 2640 + q; return 5720 + (q - 3072);
}
template <int MODE>
__device__ __forceinline__ const float* tr_src(const float* W0, const float* W1, int Nsrc, int n) {
    if (MODE == 0) return n < Nsrc ? W0 + n : nullptr;
    if (MODE == 1) { const int c = map_in(n); return c >= 0 ? W0 + c : nullptr; }
    return (((n >> 4) & 1) ? W1 : W0) + 16 * (n >> 5) + (n & 15);
}
template <int MODE>
__device__ __forceinline__ void ph_transpose(const float* W0, const float* W1, const float* gk, int K, int Nsrc, h16* WT, int Nphys, LAS float* scr, int gw, int NGW, int lane) {
    const int nblk = Nphys / 32, nitems = (K / 64) * nblk;
    const int lr = lane >> 3, lc = (lane & 7) * 4;
    f32x4 cur[8], nxt[8];
    int item = gw;
    if (item < nitems) { const int kb = item / nblk, nb = item % nblk; const float* src = tr_src<MODE>(W0, W1, Nsrc, 32 * nb + lc);
#pragma unroll
        for (int i = 0; i < 8; ++i) cur[i] = src ? *(const f32x4*)(src + (size_t)(64 * kb + lr + 8 * i) * Nsrc) : (f32x4){0.f, 0.f, 0.f, 0.f}; }
    for (; item < nitems; item += NGW) {
        const int kb = item / nblk, nb = item % nblk, k0 = 64 * kb, n0 = 32 * nb;
        const int itn = item + NGW;
        if (itn < nitems) { const int kbn = itn / nblk, nbn = itn % nblk; const float* src = tr_src<MODE>(W0, W1, Nsrc, 32 * nbn + lc);
#pragma unroll
            for (int i = 0; i < 8; ++i) nxt[i] = src ? *(const f32x4*)(src + (size_t)(64 * kbn + lr + 8 * i) * Nsrc) : (f32x4){0.f, 0.f, 0.f, 0.f}; }
#pragma unroll
        for (int i = 0; i < 8; ++i) { LAS float* d = scr + (lr + 8 * i) * 33 + lc; const float gg = gk ? gk[k0 + lr + 8 * i] : 1.0f; d[0] = cur[i][0] * gg; d[1] = cur[i][1] * gg; d[2] = cur[i][2] * gg; d[3] = cur[i][3] * gg; }
        __builtin_amdgcn_wave_barrier(); asm volatile("s_waitcnt lgkmcnt(0)" ::: "memory");
        const int c = lane & 7;
#pragma unroll
        for (int j = 0; j < 4; ++j) { const int nn = (lane >> 3) + 8 * j; const LAS float* sp = scr + (8 * c) * 33 + nn;
            h16x8 o;
#pragma unroll
            for (int e = 0; e < 8; ++e) o[e] = (h16)sp[e * 33];
            *(h16x8*)(WT + (size_t)(n0 + nn) * K + k0 + 8 * c) = o; }
        __builtin_amdgcn_wave_barrier(); asm volatile("s_waitcnt lgkmcnt(0)" ::: "memory");
#pragma unroll
        for (int i = 0; i < 8; ++i) cur[i] = nxt[i];
    }
}
__device__ __forceinline__ void sincos_f32arg(float ang, float& sn, float& cs) {
    const double a = (double)ang;
    const double rev = a * 0.15915494309189535;
    const double fr = rev - __builtin_rint(rev);
    const double q4 = fr * 4.0; const double qi = __builtin_rint(q4); const int qq = ((int)qi) & 3;
    const double r = (q4 - qi) * 1.5707963267948966;
    const double r2 = r * r;
    const double s = r * (1.0 + r2 * (-1.0 / 6 + r2 * (1.0 / 120 + r2 * (-1.0 / 5040 + r2 * (1.0 / 362880 + r2 * (-1.0 / 39916800))))));
    const double c = 1.0 + r2 * (-0.5 + r2 * (1.0 / 24 + r2 * (-1.0 / 720 + r2 * (1.0 / 40320 + r2 * (-1.0 / 3628800 + r2 * (1.0 / 479001600))))));
    double so, co;
    if (qq == 0) { so = s; co = c; } else if (qq == 1) { so = c; co = -s; } else if (qq == 2) { so = -s; co = -c; } else { so = -c; co = s; }
    sn = (float)so; cs = (float)co;
}
__device__ __forceinline__ void ph_rope(const int* pos, float* ROPE, int gtid, int NGT) {
    for (int idx = gtid; idx < MTOK * 24; idx += NGT) {
        const int tok = idx / 24, i = idx % 24, k = i < 16 ? i : 2 * (i - 16);
        float f = 0x1.000000p+0f;
        f = k == 1 ? 0x1.c2ef76p-2f : f; f = k == 2 ? 0x1.8d275ep-3f : f; f = k == 3 ? 0x1.5dc95ap-4f : f; f = k == 4 ? 0x1.341190p-5f : f; f = k == 5 ? 0x1.0f5384p-6f : f;
        f = k == 6 ? 0x1.ddee9cp-8f : f; f = k == 7 ? 0x1.a4ee3ep-9f : f; f = k == 8 ? 0x1.72ba44p-10f : f; f = k == 9 ? 0x1.468318p-11f : f; f = k == 10 ? 0x1.1f91f0p-12f : f;
        f = k == 11 ? 0x1.fa8b84p-14f : f; f = k == 12 ? 0x1.be218ap-15f : f; f = k == 13 ? 0x1.88ec22p-16f : f; f = k == 14 ? 0x1.5a0f50p-17f : f; f = k == 15 ? 0x1.30c94ep-18f : f;
        const float ang = (float)pos[tok] * f;
        float sn, cs; sincos_f32arg(ang, sn, cs);
        float* rp = ROPE + (size_t)tok * 48;
        if (i < 16) { rp[i] = cs; rp[16 + i] = sn; } else { rp[32 + (i - 16)] = cs; rp[40 + (i - 16)] = sn; }
    }
}
template <bool TO_F32>
__device__ __forceinline__ void ph_rmsnorm(const float* X, const float* g, h16* OUTH, float* OUTF, int gw, int NGW, int lane) {
    for (int row = gw; row < MTOK; row += NGW) {
        const f32x4* xr = (const f32x4*)(X + (size_t)row * DM) + lane;
        f32x4 v[8]; float s = 0.f;
#pragma unroll
        for (int j = 0; j < 8; ++j) { v[j] = xr[64 * j]; s += (v[j][0] * v[j][0] + v[j][1] * v[j][1]) + (v[j][2] * v[j][2] + v[j][3] * v[j][3]); }
        const float r = 1.0f / sqrtf(wave_sum(s) * (1.0f / DM) + EPS);
#pragma unroll
        for (int j = 0; j < 8; ++j) { const f32x4 gg = *((const f32x4*)g + lane + 64 * j); const f32x4 o = v[j] * r * gg;
            if (TO_F32) *((f32x4*)(OUTF + (size_t)row * DM) + lane + 64 * j) = o; else st4h(OUTH + (size_t)row * DM + 4 * (lane + 64 * j), o); }
    }
}
__device__ __forceinline__ void ph_final(const h16* X, float* OUT, const float* g, const float* RS, int gw, int NGW, int lane) {
    for (int row = gw; row < MTOK; row += NGW) {
        const float r = __builtin_amdgcn_rsqf(RS[row] * (1.0f / DM) + EPS);
        h16x8 v[4];
#pragma unroll
        for (int j = 0; j < 4; ++j) v[j] = *((const h16x8*)(X + (size_t)row * DM) + lane + 64 * j);
#pragma unroll
        for (int j = 0; j < 4; ++j) { const float* gp = g + 8 * (lane + 64 * j); float* op = OUT + (size_t)row * DM + 8 * (lane + 64 * j);
            const f32x4 g0 = *(const f32x4*)gp, g1 = *(const f32x4*)(gp + 4);
            f32x4 o0 = {(float)v[j][0], (float)v[j][1], (float)v[j][2], (float)v[j][3]}, o1 = {(float)v[j][4], (float)v[j][5], (float)v[j][6], (float)v[j][7]};
            *(f32x4*)op = o0 * r * g0; *(f32x4*)(op + 4) = o1 * r * g1; }
    }
}
__device__ __forceinline__ void ph_cumsum(const float* LOGF, float* CBS, int bh, int lane) {
    const int b = bh >> 3, h = bh & 7;
    float v[64];
#pragma unroll
    for (int it = 0; it < 64; ++it) v[it] = LOGF[(size_t)(b * T + it * 64 + lane) * 8 + h];
    float run = 0.f;
#pragma unroll
    for (int it = 0; it < 64; ++it) {
        float x = v[it];
#pragma unroll
        for (int o = 1; o < 64; o <<= 1) { const float nb = __shfl_up(x, o); if (lane >= o) x += nb; }
        CBS[(size_t)bh * T + it * 64 + lane] = (run + x) * -11.313708498984761f;
        run += __shfl(x, 63);
    }
}

__device__ __forceinline__ unsigned fkey(float f) { const unsigned u = __float_as_uint(f + 0.0f); return (u & 0x80000000u) ? ~u : (u | 0x80000000u); }
__device__ __forceinline__ unsigned count_ge(const unsigned (&key)[64], unsigned th, int nj) {
    unsigned c = 0;
#pragma unroll
    for (int j8 = 0; j8 < 8; ++j8) {
        if (8 * j8 < nj) {
#pragma unroll
            for (int j = 8 * j8; j < 8 * j8 + 8; ++j) c += (key[j] >= th) ? 1u : 0u;
        }
    }
#pragma unroll
    for (int o = 1; o < 64; o <<= 1) c += __shfl_xor(c, o);
    return c;
}
__device__ __forceinline__ u64 topk_select(const unsigned (&key)[64], int nvalid, int lane) {
    u64 myword = 0;
    if (nvalid <= TOPK) {
#pragma unroll
        for (int j = 0; j < 64; ++j) { const u64 bal = __ballot(key[j] != 0u); if (lane == j) myword = bal; }
    } else {
        unsigned th = 0u; bool exact = false;
        for (int bit = 31; bit >= 0; --bit) { const unsigned tc = th | (1u << bit); const unsigned c = count_ge(key, tc, (nvalid + 63) >> 6); if (c >= (unsigned)TOPK) th = tc; if (c == (unsigned)TOPK) { exact = true; break; } }
        if (exact) {
#pragma unroll
            for (int j = 0; j < 64; ++j) { const u64 bal = __ballot(key[j] >= th); if (lane == j) myword = bal; }
        } else {
            unsigned cgt = 0;
#pragma unroll
            for (int j = 0; j < 64; ++j) cgt += (unsigned)__builtin_popcountll(__ballot(key[j] > th));
            int need = TOPK - (int)cgt;
#pragma unroll
            for (int j = 0; j < 64; ++j) { u64 eq = __ballot(key[j] == th); const u64 gt = __ballot(key[j] > th);
                int pc = __builtin_popcountll(eq);
                while (pc > need) { eq &= ~(1ull << (63 - __builtin_clzll(eq))); --pc; }
                need -= pc; if (lane == j) myword = gt | eq; }
        }
    }
    return myword;
}
template <int LVL>
__device__ __forceinline__ void hist_level(const unsigned (&key)[64], int nj, int lane, LAS unsigned* hist, unsigned& prefix, unsigned& need, unsigned& cnt_eq) {
    constexpr int SH = LVL == 0 ? 21 : (LVL == 1 ? 10 : 0), PSH = LVL == 1 ? 21 : 10, NB = LVL == 2 ? 10 : 11;
#pragma unroll
    for (int i = 0; i < 8; ++i) *(LAS u32x4*)(hist + lane * 32 + 4 * i) = (u32x4){0u, 0u, 0u, 0u};
    asm volatile("s_waitcnt lgkmcnt(0)" ::: "memory"); __builtin_amdgcn_wave_barrier();
#pragma unroll
    for (int j8 = 0; j8 < 8; ++j8) {
        if (8 * j8 < nj) {
            if (LVL == 0) {
#pragma unroll
                for (int j = 8 * j8; j < 8 * j8 + 8; ++j) __hip_atomic_fetch_add(hist + (key[j] >> 21), 1u, __ATOMIC_RELAXED, __HIP_MEMORY_SCOPE_WORKGROUP);
            } else {
                bool any = false;
#pragma unroll
                for (int j = 8 * j8; j < 8 * j8 + 8; ++j) any = any || ((key[j] >> PSH) == prefix);
                if (LVL == 1 || __any(any)) {
#pragma unroll
                    for (int j = 8 * j8; j < 8 * j8 + 8; ++j) { const unsigned k = key[j];
                        if ((k >> PSH) == prefix) __hip_atomic_fetch_add(hist + ((k >> SH) & ((1u << NB) - 1u)), 1u, __ATOMIC_RELAXED, __HIP_MEMORY_SCOPE_WORKGROUP); }
                }
            }
        }
    }
    asm volatile("s_waitcnt lgkmcnt(0)" ::: "memory"); __builtin_amdgcn_wave_barrier();
    unsigned s = 0;
#pragma unroll
    for (int i = 0; i < 8; ++i) { const u32x4 v = *(const LAS u32x4*)(hist + lane * 32 + 4 * i); s += (v[0] + v[1]) + (v[2] + v[3]); }
    unsigned S = s;
#pragma unroll
    for (int o = 1; o < 64; o <<= 1) { const unsigned nb = __shfl_down(S, o); if (lane + o < 64) S += nb; }
    const int L = 63 - __builtin_clzll(__ballot(S >= need));
    const unsigned aboveL = __shfl(S - s, L);
    const int bi = lane & 31;
    const unsigned hb = hist[L * 32 + bi];
    unsigned R = hb;
#pragma unroll
    for (int o = 1; o < 32; o <<= 1) { const unsigned nb = __shfl_down(R, o); if (bi + o < 32) R += nb; }
    const int B = 31 - __builtin_clz((unsigned)__ballot(aboveL + R >= need));
    const unsigned abB = __shfl(aboveL + R - hb, B);
    cnt_eq = __shfl(hb, B);
    prefix = (prefix << NB) | (unsigned)(L * 32 + B);
    need -= abB;
    __builtin_amdgcn_wave_barrier();
}
__device__ __forceinline__ u64 topk_select_hist(const unsigned (&key)[64], int nvalid, int lane, LAS unsigned* hist) {
    const int nj = (nvalid + 63) >> 6;
    unsigned prefix = 0, need = TOPK, cnt_eq = 0;
    hist_level<0>(key, nj, lane, hist, prefix, need, cnt_eq);
    hist_level<1>(key, nj, lane, hist, prefix, need, cnt_eq);
    hist_level<2>(key, nj, lane, hist, prefix, need, cnt_eq);
    u64 mw = 0;
    if (need == cnt_eq) {
#pragma unroll
        for (int j = 0; j < 64; ++j) { const u64 bal = __ballot(key[j] >= prefix); if (lane == j) mw = bal; }
    } else {
        int nd = (int)need;
#pragma unroll
        for (int j = 0; j < 64; ++j) { u64 eq = __ballot(key[j] == prefix); const u64 gt = __ballot(key[j] > prefix);
            int pc = __builtin_popcountll(eq);
            while (pc > nd) { eq &= ~(1ull << (63 - __builtin_clzll(eq))); --pc; }
            nd -= pc; if (lane == j) mw = gt | eq; }
    }
    return mw;
}
__device__ __forceinline__ void ph_topk_naive(const h16* QI, const h16* KI, const float* WI, u64* MASK, LAS float* qs, LAS unsigned* ks, int gw, int NGW, int lane) {
    for (int row = gw; row < MTOK; row += NGW) {
        const int b = row >> 12, t = row & 4095;
        { const h16* qp = QI + (size_t)row * 1024 + lane * 16;
#pragma unroll
          for (int i = 0; i < 16; ++i) qs[lane * 16 + i] = (float)qp[i]; }
        if (lane < 16) qs[1024 + lane] = WI[(size_t)row * 16 + lane];
        __builtin_amdgcn_wave_barrier(); asm volatile("s_waitcnt lgkmcnt(0)" ::: "memory");
#pragma unroll 1
        for (int j = 0; j < 64; ++j) {
            unsigned kk = 0u;
            const int s = 64 * j + lane;
            if (s <= t) {
                float kf[64];
                const h16x8* kp = (const h16x8*)(KI + (size_t)(b * T + s) * 64);
#pragma unroll
                for (int c = 0; c < 8; ++c) { const h16x8 kv = kp[c];
#pragma unroll
                    for (int e = 0; e < 8; ++e) kf[c * 8 + e] = (float)kv[e]; }
                float sc = 0.f;
#pragma unroll 1
                for (int h = 0; h < 16; ++h) { float d = 0.f;
#pragma unroll
                    for (int e = 0; e < 64; ++e) d = fmaf(qs[h * 64 + e], kf[e], d);
                    sc = fmaf(qs[1024 + h], fmaxf(d, 0.f), sc); }
                kk = fkey(sc);
            }
            ks[j * 64 + lane] = kk;
        }
        __builtin_amdgcn_wave_barrier(); asm volatile("s_waitcnt lgkmcnt(0)" ::: "memory");
        unsigned key[64];
#pragma unroll
        for (int j = 0; j < 64; ++j) key[j] = ks[j * 64 + lane];
        MASK[(size_t)row * 64 + lane] = topk_select(key, t + 1, lane);
        __builtin_amdgcn_wave_barrier(); asm volatile("s_waitcnt lgkmcnt(0)" ::: "memory");
    }
}


namespace idx {
typedef short s16x8 __attribute__((ext_vector_type(8)));
typedef float f32x16 __attribute__((ext_vector_type(16)));
constexpr int CHK = 128, CHB = CHK * 128;
__device__ __forceinline__ unsigned half_sum(unsigned v) {
#pragma unroll
    for (int o = 1; o < 32; o <<= 1) v += __shfl_xor(v, o);
    return v;
}
__device__ __forceinline__ void run_group(unsigned char* ws, char* lds, unsigned* scr, int b, int g, int wv) {
    int tid = wv * 64 + lane_id(); asm volatile("" : "+v"(tid));
    const int wid = __builtin_amdgcn_readfirstlane(tid >> 6), lane = tid & 63, c = lane & 31, hi = lane >> 5;
    const int t0 = 16 * g + 2 * wid, t = t0 + hi, row = b * T + t, tmaxblk = 16 * g + 15, nch = (tmaxblk >> 7) + 1;
    const h16* QI = (const h16*)(ws + WS_QI); const char* KIb = (const char*)ws + WS_KI + (size_t)b * T * 128; const float* WI = (const float*)(ws + WS_WI);
    s16x8 A[4];
    { const int rho = c, qsel = (rho >> 2) & 1, head = (rho & 3) + 4 * (rho >> 3);
      const h16* qp = QI + (size_t)(b * T + t0 + qsel) * 1024 + head * 64 + 8 * hi;
#pragma unroll
      for (int ks = 0; ks < 4; ++ks) A[ks] = *reinterpret_cast<const s16x8*>(qp + 16 * ks); }
    float w[16];
    { const f32x4* wp = (const f32x4*)(WI + (size_t)row * 16);
#pragma unroll
      for (int i = 0; i < 4; ++i) { const f32x4 v = wp[i]; w[4 * i] = v[0]; w[4 * i + 1] = v[1]; w[4 * i + 2] = v[2]; w[4 * i + 3] = v[3]; } }
    const int pr0 = tid >> 3, pp = tid & 7;
    const unsigned g_off = (unsigned)(pr0 * 128 + pp * 16);
    const int l_off0 = pr0 * 128 + ((pp ^ ((pr0 >> 1) & 7)) << 4), l_off1 = l_off0 + 64 * 128;
    const int rd_base = c * 128; const int sw = (c >> 1) & 7;
    int rd_off[4];
#pragma unroll
    for (int ks = 0; ks < 4; ++ks) rd_off[ks] = rd_base + (((2 * ks + hi) ^ sw) << 4);
    unsigned* myscr = scr + (size_t)(2 * wid + hi) * T + c;
    asm volatile("" :: "v"(A[0]), "v"(A[1]), "v"(A[2]), "v"(A[3]), "v"(w[0]), "v"(w[4]), "v"(w[8]), "v"(w[12]));
    s16x8 st0, st1;
    { const char* src = KIb; st0 = *reinterpret_cast<const s16x8*>(src + g_off); st1 = *reinterpret_cast<const s16x8*>(src + 64 * 128 + g_off); }
    *reinterpret_cast<s16x8*>(lds + l_off0) = st0; *reinterpret_cast<s16x8*>(lds + l_off1) = st1;
    __syncthreads();
#pragma unroll 1
    for (int ch = 0; ch < nch; ++ch) {
        const char* buf = lds + (ch & 1) * CHB;
        if (ch + 1 < nch) { const char* src = KIb + (size_t)(ch + 1) * CHB; st0 = *reinterpret_cast<const s16x8*>(src + g_off); st1 = *reinterpret_cast<const s16x8*>(src + 64 * 128 + g_off); }
#pragma unroll
        for (int st = 0; st < 4; ++st) {
            f32x16 acc = {};
#pragma unroll
            for (int ks = 0; ks < 4; ++ks) { const s16x8 Bf = *reinterpret_cast<const s16x8*>(buf + st * 4096 + rd_off[ks]);
                acc = __builtin_amdgcn_mfma_f32_32x32x16_f16(__builtin_bit_cast(h16x8, A[ks]), __builtin_bit_cast(h16x8, Bf), acc, 0, 0, 0); }
            float sc = 0.f;
#pragma unroll
            for (int r = 0; r < 16; ++r) { const int ri = __float_as_int(acc[r]); sc = fmaf(w[r], __int_as_float(ri > 0 ? ri : 0), sc); }
            const int sidx = ch * CHK + st * 32 + c;
            myscr[ch * CHK + st * 32] = (sidx <= t) ? fkey(sc) : 0u;
        }
        if (ch + 1 < nch) { char* dst = lds + ((ch + 1) & 1) * CHB; *reinterpret_cast<s16x8*>(dst + l_off0) = st0; *reinterpret_cast<s16x8*>(dst + l_off1) = st1; }
        __syncthreads();
    }
    asm volatile("s_waitcnt vmcnt(0)" ::: "memory");
    u64* MASK = (u64*)(ws + WS_MASK);
#pragma unroll 1
    for (int qq = 0; qq < 2; ++qq) {
        const int tq = t0 + qq, nj = (tq >> 6) + 1;
        const unsigned* src = scr + (size_t)(2 * wid + qq) * T + lane;
        unsigned key[64];
#pragma unroll
        for (int j = 0; j < 64; ++j) key[j] = (j < nj) ? __hip_atomic_load(src + 64 * j, __ATOMIC_RELAXED, __HIP_MEMORY_SCOPE_AGENT) : 0u;
        u64 mw;
        if (tq + 1 <= TOPK) {
            mw = 0;
#pragma unroll
            for (int j = 0; j < 4; ++j) { const u64 bal = __ballot(key[j] != 0u); if (lane == j) mw = bal; }
        } else mw = topk_select_hist(key, tq + 1, lane, (LAS unsigned*)(lds + 2 * CHB + wid * 8192));
        MASK[(size_t)(b * T + tq) * 64 + lane] = mw;
    }
}
}

namespace att {
constexpr int NW = 8, QBLK = 32, KVBLK = 64, QB = NW * QBLK, D = 128;
constexpr int SHM_V = KVBLK * D * 2, SHM_K = KVBLK * D * 2;
constexpr int LDS_NEED = 2 * SHM_V + 2 * SHM_K + NW * 64 * 4;
constexpr float THR = 8.f, SCALE = 0.08838834764831845f;
typedef short s16x8 __attribute__((ext_vector_type(8)));
typedef short s16x4 __attribute__((ext_vector_type(4)));
typedef float f32x16 __attribute__((ext_vector_type(16)));
#define KSWZ(row, colB) ((row) * 256 + ((colB) ^ (((row) & 7) << 4)))
#define SBAR() __builtin_amdgcn_sched_barrier(0)
__device__ __forceinline__ int v_st(int k, int c) { const int kk = (k & ~0xC) | ((k & 4) << 1) | ((k & 8) >> 1); return ((kk >> 3) * 4 + (c >> 5)) * 512 + ((kk & 7) * 32 + (c & 31)) * 2; }
__device__ __forceinline__ int v_rd_base(int lane) { return ((lane & 3) << 3) | (((lane >> 2) & 3) << 6) | (((lane >> 4) & 1) << 5) | (((lane >> 5) & 1) << 8); }
constexpr int v_rd_off(int d0, int ks, int half) { return d0 * 512 + ks * 4096 + half * 2048; }
__device__ __forceinline__ int crow(int r, int hi) { return (r & 3) + 8 * (r >> 2) + 4 * hi; }
__device__ __forceinline__ unsigned cvtpk(float lo, float hi) { unsigned r; asm volatile("v_cvt_pk_f16_f32 %0, %1, %2" : "=v"(r) : "v"(lo), "v"(hi)); return r; }
__device__ __forceinline__ f32x16 mfma16(s16x8 a, s16x8 b, f32x16 c) { return __builtin_amdgcn_mfma_f32_32x32x16_f16(__builtin_bit_cast(h16x8, a), __builtin_bit_cast(h16x8, b), c, 0, 0, 0); }
__device__ __forceinline__ s16x8 load8(const h16* p) { return *reinterpret_cast<const s16x8*>(p); }
__device__ __forceinline__ void mask_causal(f32x16& p0, f32x16& p1, int dq) {
    const float NEG = -__builtin_inff();
#pragma unroll
    for (int r = 0; r < 16; ++r) { const int c = (r & 3) + 8 * (r >> 2); if (dq - c < 0) p0[r] = NEG; if (dq - c - 32 < 0) p1[r] = NEG; }
}
__device__ __forceinline__ void mask_bits(f32x16& p0, f32x16& p1, u64 w, int hi) {
    const float NEG = -__builtin_inff();
    const unsigned lo = (unsigned)w >> (4 * hi), up = (unsigned)(w >> 32) >> (4 * hi);
#pragma unroll
    for (int r = 0; r < 16; ++r) { const int c = (r & 3) + 8 * (r >> 2); if (!((lo >> c) & 1u)) p0[r] = NEG; if (!((up >> c) & 1u)) p1[r] = NEG; }
}
__device__ __forceinline__ void partialSM(f32x16& p0, f32x16& p1, float& m_reg, float& mn, float& alpha) {
    float pmax = p0[0]; for (int r = 1; r < 16; ++r) pmax = fmaxf(pmax, p0[r]); for (int r = 0; r < 16; ++r) pmax = fmaxf(pmax, p1[r]);
    { auto rr = __builtin_amdgcn_permlane32_swap(__float_as_uint(pmax), __float_as_uint(pmax), false, false);
      pmax = fmaxf(__uint_as_float(rr[0]), __uint_as_float(rr[1])); }
    constexpr float C2 = 1.4426950408889634f * SCALE;
    if (__builtin_expect(__all((pmax - m_reg) * SCALE <= THR), 1)) { mn = m_reg; alpha = 1.f; }
    else { mn = fmaxf(m_reg, pmax); alpha = __builtin_amdgcn_exp2f((m_reg - mn) * C2); m_reg = mn; }
    const float mnL = -mn * C2;
    for (int r = 0; r < 16; ++r) p0[r] = fmaf(p0[r], C2, mnL); for (int r = 0; r < 16; ++r) p1[r] = fmaf(p1[r], C2, mnL);
    for (int r = 0; r < 16; ++r) p0[r] = __builtin_amdgcn_exp2f(p0[r]);
}
__device__ __forceinline__ void finishSM(f32x16& p0, f32x16& p1, float alpha, float& l_reg, s16x8& pa0, s16x8& pa1, s16x8& pa2, s16x8& pa3) {
    for (int r = 0; r < 16; ++r) p1[r] = __builtin_amdgcn_exp2f(p1[r]);
    float ps = 0; for (int r = 0; r < 16; ++r) ps += p0[r]; for (int r = 0; r < 16; ++r) ps += p1[r];
    { auto rr = __builtin_amdgcn_permlane32_swap(__float_as_uint(ps), __float_as_uint(ps), false, false);
      ps = __uint_as_float(rr[0]) + __uint_as_float(rr[1]); }
    l_reg = l_reg * alpha + ps;
#define PK4(P, B_, OUT) do { unsigned a0 = cvtpk(P[B_+0], P[B_+1]), a1 = cvtpk(P[B_+2], P[B_+3]);                          \
        unsigned b0 = cvtpk(P[B_+4], P[B_+5]), b1 = cvtpk(P[B_+6], P[B_+7]);                                             \
        auto r0 = __builtin_amdgcn_permlane32_swap(a0, b0, false, false); auto r1 = __builtin_amdgcn_permlane32_swap(a1, b1, false, false); \
        u32x4 w = {r0[0], r1[0], r0[1], r1[1]}; OUT = *reinterpret_cast<s16x8*>(&w); } while (0)
    PK4(p0, 0, pa0); PK4(p0, 8, pa1); PK4(p1, 0, pa2); PK4(p1, 8, pa3);
#undef PK4
}
template <int KB>
__device__ __forceinline__ void qkt(f32x16& p0, f32x16& p1, const char* K_lds, int r32, int hi, const s16x8* qr) {
    const char* kb[4];
#pragma unroll
    for (int dd = 0; dd < 4; ++dd) kb[dd] = K_lds + KB * SHM_K + KSWZ(r32, (dd * 16 + hi * 8) * 2);
#pragma unroll
    for (int d0 = 0; d0 < 8; ++d0) { const char* a = kb[d0 & 3] + (d0 >> 2) * 128;
        s16x8 b0 = *reinterpret_cast<const s16x8*>(a);
        s16x8 b1 = *reinterpret_cast<const s16x8*>(a + 32 * 256);
        p0 = mfma16(b0, qr[d0], p0);
        p1 = mfma16(b1, qr[d0], p1); }
}
template <int VB>
__device__ __forceinline__ void pv_tile(f32x16* o, int vb0, s16x8 pa0, s16x8 pa1, s16x8 pa2, s16x8 pa3) {
#define TRRD(dst, off) asm volatile("ds_read_b64_tr_b16 %0, %1 offset:%2" : "=&v"(dst) : "v"(vb0), "i"(off) : "memory")
#define PV_D0(d0) do { s16x4 l0, l1, l2, l3, h0, h1, h2, h3; constexpr int b_ = VB * SHM_V + v_rd_off(d0, 0, 0); \
        TRRD(l0, b_); TRRD(h0, b_ + 2048); TRRD(l1, b_ + 4096); TRRD(h1, b_ + 6144); TRRD(l2, b_ + 8192); TRRD(h2, b_ + 10240); TRRD(l3, b_ + 12288); TRRD(h3, b_ + 14336); \
        asm volatile("s_waitcnt lgkmcnt(0)" ::: "memory"); SBAR();   \
        o[d0] = mfma16(pa0, (s16x8){l0[0], l0[1], l0[2], l0[3], h0[0], h0[1], h0[2], h0[3]}, o[d0]);   \
        o[d0] = mfma16(pa1, (s16x8){l1[0], l1[1], l1[2], l1[3], h1[0], h1[1], h1[2], h1[3]}, o[d0]);   \
        o[d0] = mfma16(pa2, (s16x8){l2[0], l2[1], l2[2], l2[3], h2[0], h2[1], h2[2], h2[3]}, o[d0]);   \
        o[d0] = mfma16(pa3, (s16x8){l3[0], l3[1], l3[2], l3[3], h3[0], h3[1], h3[2], h3[3]}, o[d0]); } while (0)
    PV_D0(0); PV_D0(1); PV_D0(2); PV_D0(3);
#undef PV_D0
#undef TRRD
}
struct BlockRef { const char* Q; const char* K; const char* V; char* O; int P0; const char* NBQ; const char* MK; };
struct Seam { s16x8 qr[8]; s16x8 st_v0, st_v1, st_k0, st_k1; };
#define LD16(base, off) (*reinterpret_cast<const s16x8*>((base) + (off)))
#define VMW() asm volatile("s_waitcnt vmcnt(0)" ::: "memory")
#define VMWN(n) asm volatile("s_waitcnt vmcnt(%0)" :: "i"(n) : "memory")
#define SLOAD_H(Kp, Vp, k0) do { const char* vb_ = (Vp) + (size_t)(k0) * (D * 2); const char* kb_ = (Kp) + (size_t)(k0) * (D * 2); \
        S.st_v0 = LD16(vb_, st_off); S.st_v1 = LD16(vb_ + 32 * D * 2, st_off); S.st_k0 = LD16(kb_, st_off); S.st_k1 = LD16(kb_ + 32 * D * 2, st_off); } while (0)
#define SWRITE_HK(bf) do { *(s16x8*)(K_lds + (bf) * SHM_K + kws) = S.st_k0; *(s16x8*)(K_lds + (bf) * SHM_K + kws + 32 * 256) = S.st_k1; } while (0)
#define SWRITE_HV(bf) do { *(s16x8*)(V_lds + (bf) * SHM_V + vst0) = S.st_v0; *(s16x8*)(V_lds + (bf) * SHM_V + vst1) = S.st_v1; } while (0)
#define SWRITE_H(bf) do { SWRITE_HV(bf); SWRITE_HK(bf); } while (0)
__device__ __forceinline__ void prime(const BlockRef& cur, char* lds, Seam& S, int wv) {
    int tid = wv * 64 + lane_id(); asm volatile("" : "+v"(tid));
    const int wid = __builtin_amdgcn_readfirstlane(tid >> 6), lane = tid & 63, r32 = lane & 31, hi = lane >> 5;
    const int sr = tid >> 4, sc = (tid & 15) * 8, kws = KSWZ(sr, sc * 2); char* K_lds = lds + 2 * SHM_V;
    const unsigned st_off = (unsigned)(sr * D + sc) * 2u, q_off = (unsigned)((wid * QBLK + r32) * D + hi * 8) * 2u;
#pragma unroll
    for (int d0 = 0; d0 < 8; ++d0) S.qr[d0] = LD16(cur.Q + d0 * 32, q_off);
    SLOAD_H(cur.K, cur.V, 0); VMW(); SWRITE_HK(0);
    __syncthreads();
}
template <bool MIXB>
__device__ __forceinline__ void block(const BlockRef& cur, const BlockRef& nxt, char* lds, Seam& S, int wv) {
    int tid = wv * 64 + lane_id(); asm volatile("" : "+v"(tid));
    const int wid = __builtin_amdgcn_readfirstlane(tid >> 6), lane = tid & 63, r32 = lane & 31, hi = lane >> 5;
    const int NT = cur.P0 / KVBLK + 4;
    const int qlo = cur.P0 + wid * QBLK, qm = qlo + r32 - 4 * hi;
    char* V_lds = lds; char* K_lds = lds + 2 * SHM_V;
    float* wsf = (float*)(lds + 2 * SHM_V + 2 * SHM_K) + wid * 64; float* li_l = wsf, * al_l = wsf + 32;
    float m_reg = -1e30f, l_reg = 0; f32x16 o[4] = {};
    const int sr = tid >> 4, sc = (tid & 15) * 8, vst0 = v_st(sr, sc), vst1 = v_st(32 + sr, sc), kws = KSWZ(sr, sc * 2);
    const int vb0 = (int)(uintptr_t)V_lds + v_rd_base(lane);
    const unsigned st_off = (unsigned)(sr * D + sc) * 2u, q_off = (unsigned)((wid * QBLK + r32) * D + hi * 8) * 2u;
    const unsigned nb_off = (unsigned)hi * 16u, mk_off = (unsigned)(wid * QBLK + r32) * 512u;
    const char* Kh = cur.K; const char* Vh = cur.V;
    const char* bias_l = lds + LDS_NEED;
    if (MIXB) { const float nbref = *(const float*)(cur.NBQ + (size_t)(cur.P0 + QB - 1) * 4);
        for (int i = tid; i < cur.P0 + QB; i += NW * 64) ((float*)bias_l)[i] = ((const float*)cur.NBQ)[i] - nbref;
        __syncthreads(); }
#define RESC(a) do { if (__any((a) < 1.f)) { if (hi == 0) al_l[r32] = (a); asm volatile("s_waitcnt lgkmcnt(0)" ::: "memory");              \
                     for (int d_ = 0; d_ < 4; ++d_) for (int r = 0; r < 16; ++r) o[d_][r] *= al_l[crow(r, hi)]; } } while (0)
#define KBASE(t) ((t) * KVBLK)
#define MKW(t) (*(const u64*)(cur.MK + (size_t)(t) * 8 + mk_off))
#define PINIT(P0_, P1_, t, MW_) do { if (MIXB) { const char* nb_ = bias_l + KBASE(t) * 4 + nb_off; _Pragma("unroll") for (int g_ = 0; g_ < 4; ++g_) { \
            const f32x4 b0_ = *(const f32x4*)(nb_ + 32 * g_), b1_ = *(const f32x4*)(nb_ + 128 + 32 * g_); \
            _Pragma("unroll") for (int j_ = 0; j_ < 4; ++j_) { P0_[4 * g_ + j_] = b0_[j_]; P1_[4 * g_ + j_] = b1_[j_]; } } } else { const u64 w_ = (MW_); const unsigned lo_ = (unsigned)w_ >> (4 * hi), up_ = (unsigned)(w_ >> 32) >> (4 * hi); \
            _Pragma("unroll") for (int r_ = 0; r_ < 16; ++r_) { const int c_ = (r_ & 3) + 8 * (r_ >> 2); \
                P0_[r_] = __uint_as_float((((lo_ >> c_) & 1u) - 1u) & 0xff800000u); P1_[r_] = __uint_as_float((((up_ >> c_) & 1u) - 1u) & 0xff800000u); } } } while (0)
#define MASKT(P0_, P1_, t, MW_) do { if (MIXB) { const int kb_ = KBASE(t); if (kb_ + KVBLK - 1 > qlo) mask_causal(P0_, P1_, qm - kb_); } } while (0)
    f32x16 pA0, pA1, pB0, pB1; float mnA, mnB, alA, alB; s16x8 pa0, pa1, pa2, pa3;
    u64 mwA = 0, mwB = 0;
    if (!MIXB) { mwA = MKW(0); if (NT > 1) mwB = MKW(1); }
    PINIT(pA0, pA1, 0, mwA); if (!MIXB) { if (NT > 2) mwA = MKW(2); }
    if (NT > 1) { PINIT(pB0, pB1, 1, mwB); if (!MIXB) { if (NT > 3) mwB = MKW(3); } }
    SWRITE_HV(0); SBAR();
    if (NT > 1) SLOAD_H(Kh, Vh, KBASE(1));
    SBAR(); qkt<0>(pA0, pA1, K_lds, r32, hi, S.qr);
    MASKT(pA0, pA1, 0, mwA);
    partialSM(pA0, pA1, m_reg, mnA, alA);
    if (NT > 1) { VMW(); SWRITE_H(1); }
    __syncthreads();
#define HALF_STEP(PX0, PX1, mnX, alX, MWX, PY0, PY1, alY, MWY, t, KB, VB, SB) do {                                               \
        SBAR(); qkt<KB>(PX0, PX1, K_lds, r32, hi, S.qr);                                                                      \
        finishSM(PY0, PY1, alY, l_reg, pa0, pa1, pa2, pa3); SBAR();                                                           \
        if ((t) + 1 < NT) { PINIT(PY0, PY1, (t) + 1, MWY); if (!MIXB) { if ((t) + 3 < NT) MWY = MKW((t) + 3); } SLOAD_H(Kh, Vh, KBASE((t) + 1)); SBAR(); }                             \
        pv_tile<VB>(o, vb0, pa0, pa1, pa2, pa3); MASKT(PX0, PX1, (t), MWX); \
        partialSM(PX0, PX1, m_reg, mnX, alX);                                                                                 \
        __syncthreads();                                                                                                      \
        if ((t) + 1 < NT) { VMW(); SWRITE_H(SB); }                                                                            \
        RESC(alX); __syncthreads(); } while (0)
    for (int t = 1; t + 1 < NT; t += 2) {
        HALF_STEP(pB0, pB1, mnB, alB, mwB, pA0, pA1, alA, mwA, t, 1, 0, 0);
        HALF_STEP(pA0, pA1, mnA, alA, mwA, pB0, pB1, alB, mwB, t + 1, 0, 1, 1);
    }
    const bool even = (NT & 1) == 0;
    if (even) { SBAR(); qkt<1>(pB0, pB1, K_lds, r32, hi, S.qr); SBAR(); }
    SLOAD_H(nxt.K, nxt.V, 0); SBAR();
#pragma unroll
    for (int d0 = 0; d0 < 8; ++d0) S.qr[d0] = LD16(nxt.Q + d0 * 32, q_off);
    SBAR();
    finishSM(pA0, pA1, alA, l_reg, pa0, pa1, pa2, pa3); SBAR();
    pv_tile<0>(o, vb0, pa0, pa1, pa2, pa3);
    if (even) { MASKT(pB0, pB1, NT - 1, mwB); partialSM(pB0, pB1, m_reg, mnB, alB); __syncthreads(); RESC(alB);
        finishSM(pB0, pB1, alB, l_reg, pa0, pa1, pa2, pa3); SBAR(); pv_tile<1>(o, vb0, pa0, pa1, pa2, pa3); }
    SBAR(); VMWN(8); SWRITE_HK(0); SBAR();
    if (hi == 0) li_l[r32] = l_reg; asm volatile("s_waitcnt lgkmcnt(0)" ::: "memory");
    float rli[16];
#pragma unroll
    for (int r = 0; r < 16; ++r) rli[r] = __builtin_amdgcn_rcpf(li_l[crow(r, hi)]);
    const unsigned o_off = (unsigned)((wid * QBLK + 4 * hi) * 1024 + r32) * 2u;
#pragma unroll
    for (int r = 0; r < 16; ++r) {
#pragma unroll
        for (int d0 = 0; d0 < 4; ++d0) { const float v = o[d0][r] * rli[r];
            const float vn = __shfl_xor(v, 1);
            if ((r32 & 1) == 0) *(unsigned*)(cur.O + (size_t)(((r & 3) + 8 * (r >> 2)) * 2048 + d0 * 64) + o_off) = cvtpk(v, vn); } }
    __syncthreads();
#undef RESC
#undef KBASE
#undef PINIT
#undef MKW
#undef MASKT
#undef HALF_STEP
}
#undef LD16
#undef VMW
#undef VMWN
#undef SLOAD_H
#undef SWRITE_HK
#undef SWRITE_HV
#undef SWRITE_H
__device__ __forceinline__ BlockRef make_ref(bool mixb, unsigned char* ws, int bh, int qb) {
    const int b = bh >> 3, h = bh & 7, kvh = mixb ? bh : (b * HAKV + (h >> 2));
    BlockRef r;
    r.Q = (const char*)ws + (mixb ? WS_QB : WS_QA) + ((size_t)bh * T + (size_t)qb * QB) * D * 2;
    r.K = (const char*)ws + (mixb ? WS_KB : WS_KA) + (size_t)kvh * T * D * 2;
    r.V = (const char*)ws + (mixb ? WS_VB : WS_VA) + (size_t)kvh * T * D * 2;
    r.O = (char*)ws + (mixb ? WS_OUTB : WS_OUTA) + ((size_t)(b * T + qb * QB) * 1024 + h * D) * 2;
    r.P0 = qb * QB;
    r.NBQ = (const char*)ws + WS_CB + (size_t)bh * T * 4;
    r.MK = (const char*)ws + WS_MASK + (size_t)(b * T + qb * QB) * 64 * 8;
    return r;
}
template <bool MIXB>
__device__ __forceinline__ void run_item(int item, unsigned char* ws, char* lds, int wv) {
    const int bh = (item >> 3) & 15, x = item & 7;
    Seam S;
    BlockRef cur = make_ref(MIXB, ws, bh, x);
    prime(cur, lds, S, wv);
#pragma unroll 1
    for (int pass = 0; pass < 2; ++pass) {
        const BlockRef nxt = make_ref(MIXB, ws, bh, 15 - x);
        block<MIXB>(cur, nxt, lds, S, wv);
        cur = nxt;
    }
}
}


#define XB_TMO      128
#define XB_XCNT(j)  (256  + 64 * (j))
#define XB_XSUB(j)  (1280 + 64 * (j))
#define XB_XGEN(j)  (2304 + 64 * (j))
#define XB_TOP      3328
#define XB_TOPGEN   3392
#define XCD_BAR_WORDS 3456
#define XB_SPIN_CAP (1u << 24)
__device__ __forceinline__ unsigned xb_ld(unsigned* p)              { return __hip_atomic_load(p, __ATOMIC_RELAXED, __HIP_MEMORY_SCOPE_AGENT); }
__device__ __forceinline__ unsigned xb_add(unsigned* p, unsigned v) { return __hip_atomic_fetch_add(p, v, __ATOMIC_RELAXED, __HIP_MEMORY_SCOPE_AGENT); }
__device__ __forceinline__ unsigned xb_xcc_id() { return (unsigned)__builtin_amdgcn_s_getreg((3 << 11) | 20) & 0xFu; }
#define XB_SPIN(cond, bar) do { unsigned _sp = 0; while (cond) { __builtin_amdgcn_s_sleep(1); \
    if ((++_sp & 255u) == 0u) { if (xb_ld(&(bar)[XB_TMO])) break; if (_sp > XB_SPIN_CAP) { atomicAdd(&(bar)[XB_TMO], 1u); break; } } } } while (0)
struct XcdBarrier { unsigned* bar; unsigned x; volatile LAS unsigned* st; };
__device__ __forceinline__ XcdBarrier xcd_barrier_post(unsigned* bar, volatile LAS unsigned* st, int wv) {
    XcdBarrier b; b.bar = bar; b.x = xb_xcc_id(); b.st = st;
    if (wv == 0 && lane_id() == 0) (void)xb_add(&bar[XB_XCNT(b.x)], 1u);
    return b;
}
__device__ __forceinline__ void xcd_barrier_complete(unsigned* bar, unsigned x, unsigned& nloc, unsigned& nx) {
    const unsigned G = gridDim.x * gridDim.y * gridDim.z;
    unsigned sum, cnt, mine, sp = 0u;
    for (;;) {
        sum = 0u; cnt = 0u; mine = 0u;
#pragma unroll
        for (unsigned j = 0; j < 16; ++j) { const unsigned c = xb_ld(&bar[XB_XCNT(j)]); sum += c; cnt += (c > 0u) ? 1u : 0u; mine = (j == x) ? c : mine; }
        if (sum == G) break;
        __builtin_amdgcn_s_sleep(1);
        if ((++sp & 255u) == 0u) { if (xb_ld(&bar[XB_TMO])) break; if (sp > XB_SPIN_CAP) { atomicAdd(&bar[XB_TMO], 1u); break; } }
    }
    nloc = mine > 0u ? mine : 1u; nx = cnt > 0u ? cnt : 1u;
}
__device__ __forceinline__ void xcd_barrier(const XcdBarrier& b, int wv) {
    asm volatile("s_waitcnt vmcnt(0)" ::: "memory");
    __syncthreads();
    if (wv == 0 && lane_id() == 0) {
        unsigned* bar = b.bar;
        __builtin_amdgcn_s_waitcnt(0);
        unsigned nloc = b.st[0], nx = b.st[1];
        if (nloc == 0u) { xcd_barrier_complete(bar, b.x, nloc, nx); b.st[0] = nloc; b.st[1] = nx; }
        const unsigned old = xb_add(&bar[XB_XSUB(b.x)], 1u);
        const unsigned gen = old / nloc;
        if (old + 1u == (gen + 1u) * nloc) {
            __builtin_amdgcn_fence(__ATOMIC_RELEASE, "agent");
            asm volatile("s_waitcnt vmcnt(0)" ::: "memory");
            const unsigned og = xb_add(&bar[XB_TOP], 1u);
            const unsigned tg = og / nx;
            if (og + 1u == (tg + 1u) * nx) xb_add(&bar[XB_TOPGEN], 1u);
            else XB_SPIN(xb_ld(&bar[XB_TOPGEN]) == tg, bar);
            __builtin_amdgcn_fence(__ATOMIC_ACQUIRE, "agent");
            xb_add(&bar[XB_XGEN(b.x)], 1u);
            asm volatile("s_waitcnt vmcnt(0)" ::: "memory");
        } else {
            XB_SPIN(xb_ld(&bar[XB_XGEN(b.x)]) == gen, bar);
            __builtin_amdgcn_fence(__ATOMIC_ACQUIRE, "agent");
            asm volatile("s_waitcnt vmcnt(0)" ::: "memory");
        }
    }
    __syncthreads();
}

namespace cg = cooperative_groups;
#ifndef PROBE_DUP
#define PROBE_DUP 0
#endif
#define REP(k) for (int rep_ = 0; rep_ < (((PROBE_DUP) >> (k)) & 1) + 1; ++rep_)
constexpr int LDS_BYTES = pg8::STAGE_BYTES + 256;
constexpr int CW_QUEUE = 2048;
constexpr int CW_PANEL = 8192;
constexpr int CW_BAR = 4096;
struct Params { const float* in[17]; float* out; unsigned char* ws; };
template <class Epi>
__device__ __forceinline__ void run_gemm(LAS unsigned char* lds, const h16* A, const h16* Bt, int M, int N, int K, const Epi& e, int wv) {
    pg8::Gemm g{A, Bt, M, N, K}; pg8::StaticOrder S; S.init(M, N, (int)gridDim.x, (int)blockIdx.x);
    pg8::gemm_phase<Epi>(lds, g, S, e, wv);
}
__global__ void __launch_bounds__(512, 2) mega_fwd(Params P) {
    extern __shared__ __attribute__((aligned(16))) unsigned char lds_raw[];
    LAS unsigned char* lds = (LAS unsigned char*)lds_raw;
    const int wv = __builtin_amdgcn_readfirstlane(threadIdx.x >> 6);
    volatile LAS unsigned* bst = (volatile LAS unsigned*)(lds + pg8::STAGE_BYTES);
    if (wv == 0 && lane_id() < 2) bst[lane_id()] = 0u;
    __syncthreads();
    const XcdBarrier xbar = xcd_barrier_post((unsigned*)(P.ws + WS_CTL) + CW_BAR, bst, wv);
#define GRID_BAR() xcd_barrier(xbar, wv)
#define IDS() int lane = lane_id(); asm volatile("" : "+v"(lane)); const int wave = wv, tid = wave * 64 + lane, gw = blockIdx.x * 8 + wave, NGW = gridDim.x * 8; (void)tid; (void)gw; (void)NGW
    const float* x = P.in[0]; const float* p = P.in[1]; const int* pos = (const int*)P.in[2];
    const float* g_mix = P.in[3]; const float* w_in = P.in[4]; const float* b_f = P.in[5];
    const float* w_o_a = P.in[6]; const float* w_o_b = P.in[7]; const float* w_out = P.in[8];
    const float* g_ffn = P.in[9]; const float* w_g = P.in[10]; const float* w_u = P.in[11]; const float* w_d = P.in[12];
    const float* g_ple = P.in[13]; const float* w_pg = P.in[14]; const float* w_pp = P.in[15]; const float* g_final = P.in[16];
    unsigned char* ws = P.ws; float* out = P.out;
    float* RS = (float*)(ws + WS_RS); float* ROPE = (float*)(ws + WS_ROPE); float* CB = (float*)(ws + WS_CB); float* LOGF = (float*)(ws + WS_LOGF); u64* MASK = (u64*)(ws + WS_MASK);
    h16* WIN = (h16*)(ws + WS_WIN); h16* WOA = (h16*)(ws + WS_WOA); h16* WOB = (h16*)(ws + WS_WOB); h16* WOUT = (h16*)(ws + WS_WOUT);
    h16* WGU = (h16*)(ws + WS_WGU); h16* WDN = (h16*)(ws + WS_WDN); h16* WPG = (h16*)(ws + WS_WPG); h16* WPP = (h16*)(ws + WS_WPP);
    h16* QI = (h16*)(ws + WS_QI); h16* KI = (h16*)(ws + WS_KI); float* WI = (float*)(ws + WS_WI);
    h16* SIGA = (h16*)(ws + WS_SIGA); h16* SIGB = (h16*)(ws + WS_SIGB);
    h16* OUTA = (h16*)(ws + WS_OUTA); h16* OUTB = (h16*)(ws + WS_OUTB); h16* P16 = (h16*)(ws + WS_P16);
    h16* X3H = (h16*)(ws + WS_SIGA);
    h16* MIXED = (h16*)(ws + WS_MIXED); h16* H2 = (h16*)(ws + WS_H2); h16* ACT = (h16*)(ws + WS_ACT); h16* PP = (h16*)(ws + WS_PP);
    h16* H1 = (h16*)P.out;

    REP(0) { IDS(); LAS float* scr = (LAS float*)(lds + wave * 8448);
      ph_transpose<1>(w_in, nullptr, nullptr, DM, N_IN, WIN, N_INP, scr, gw, NGW, lane);
      ph_transpose<2>(w_g, w_u, g_ffn, DM, DFF, WGU, 2 * DFF, scr, gw, NGW, lane);
      ph_rope(pos, ROPE, blockIdx.x * 512 + tid, gridDim.x * 512);
      for (int i = blockIdx.x * 512 + tid; i < 3 * MTOK; i += gridDim.x * 512) RS[i] = 0.f;
      ph_rmsnorm<false>(x, g_mix, H1, nullptr, gw, NGW, lane);
    }
    GRID_BAR();
    REP(1) { EpiInProj e{ws, b_f}; run_gemm(lds, H1, WIN, MTOK, N_INP, DM, e, wv); }
    { const int fi = ((MTOK / 256) * (N_INP / 256)) % (int)gridDim.x;
    if ((int)blockIdx.x >= fi) { IDS(); (void)tid; (void)gw; (void)NGW; LAS float* scr = (LAS float*)(lds + wave * 8448); const int qw = ((int)blockIdx.x - fi) * 8 + wave, nq = ((int)gridDim.x - fi) * 8;
      ph_transpose<0>(w_o_a, nullptr, nullptr, 1024, DM, WOA, DM, scr, qw, nq, lane);
      ph_transpose<0>(w_o_b, nullptr, nullptr, 1024, DM, WOB, DM, scr, qw, nq, lane);
      ph_transpose<0>(w_out, nullptr, nullptr, DM, DM, WOUT, DM, scr, qw, nq, lane); } }
    GRID_BAR();
    REP(2) { IDS();
      if (gw >= NGW - 16) ph_cumsum(LOGF, CB, NGW - 1 - gw, lane);
      for (int it = blockIdx.x; it < 256; it += gridDim.x) { const int bb = it & 1, gi = it >> 1;
#pragma unroll 1
          for (int pass = 0; pass < 2; ++pass) idx::run_group(ws, (char*)lds_raw, (unsigned*)out + (size_t)blockIdx.x * 16 * T, bb, pass ? 255 - gi : gi, wv); }
      for (int i = blockIdx.x * 512 + tid; i < MTOK * DPLE / 4; i += gridDim.x * 512) st4h(P16 + 4 * (size_t)i, *((const f32x4*)p + i));
    }
    GRID_BAR();
    REP(3) for (int it = blockIdx.x; it < 256; it += gridDim.x) {
        const int item = (it & 7) * 32 + (it >> 3);
        if (item < 128) att::run_item<false>(item, ws, (char*)lds_raw, wv); else att::run_item<true>(item, ws, (char*)lds_raw, wv);
    }
    GRID_BAR();
    REP(4) { { EpiGate<true> e{SIGA, MIXED}; run_gemm(lds, OUTA, WOA, MTOK, DM, 1024, e, wv); }
    { EpiGate<false> e{SIGB, MIXED}; run_gemm(lds, OUTB, WOB, MTOK, DM, 1024, e, wv); } }
    GRID_BAR();
    REP(5) { EpiResidNorm<true> e{x, H2, RS}; run_gemm(lds, MIXED, WOUT, MTOK, DM, DM, e, wv); }
    GRID_BAR();
    REP(6) { EpiSwiGLU e{ACT, RS}; run_gemm(lds, H2, WGU, MTOK, 2 * DFF, DM, e, wv); }
    { const int fi = ((MTOK / 256) * (2 * DFF / 256)) % (int)gridDim.x;
    if ((int)blockIdx.x >= fi) { IDS(); (void)tid; (void)gw; (void)NGW; LAS float* scr = (LAS float*)(lds + wave * 8448); const int qw = ((int)blockIdx.x - fi) * 8 + wave, nq = ((int)gridDim.x - fi) * 8;
      ph_transpose<0>(w_d, nullptr, nullptr, DFF, DM, WDN, DM, scr, qw, nq, lane);
      ph_transpose<0>(w_pg, nullptr, g_ple, DM, DM, WPG, DM, scr, qw, nq, lane);
      ph_transpose<0>(w_pp, nullptr, nullptr, DPLE, DM, WPP, DM, scr, qw, nq, lane); } }
    GRID_BAR();
    { EpiResidNorm<false> e{nullptr, H2, RS + MTOK}; run_gemm(lds, ACT, WDN, MTOK, DM, DFF, e, wv); }
    GRID_BAR();
    { EpiStoreH e{PP, DM}; run_gemm(lds, P16, WPP, MTOK, DM, DPLE, e, wv); }
    if (gridDim.x == (MTOK / 256) * (DM / 256)) {
        EpiPLEFinal e{PP, H2, out, RS + MTOK, RS + 2 * MTOK, g_final, (unsigned*)(ws + WS_CTL) + CW_PANEL}; run_gemm(lds, H2, WPG, MTOK, DM, DM, e, wv);
    } else {
        { EpiPLE e{PP, H2, X3H, RS + MTOK, RS + 2 * MTOK}; run_gemm(lds, H2, WPG, MTOK, DM, DM, e, wv); }
        GRID_BAR();
        { IDS(); ph_final(X3H, out, g_final, RS + 2 * MTOK, gw, NGW, lane); }
    }
#undef IDS
#undef GRID_BAR
}

extern "C" void kernel_launch(void* const* d_in, const int* in_sizes, int n_in, void* d_out, int out_size, void* d_ws, size_t ws_size, hipStream_t stream) {
    if (n_in != 17 || out_size != MTOK * DM || ws_size < WS_END) { fprintf(stderr, "kernel_launch: unexpected shapes / workspace (%d inputs, out %d, ws %zu)\n", n_in, out_size, ws_size); return; }
    static int grid_blocks = 0;
    if (!grid_blocks) {
        int dev = 0, cus = 0, per_cu = 0;
        (void)hipGetDevice(&dev);
        (void)hipDeviceGetAttribute(&cus, hipDeviceAttributeMultiprocessorCount, dev);
        (void)hipFuncSetAttribute((const void*)mega_fwd, hipFuncAttributeMaxDynamicSharedMemorySize, LDS_BYTES);
        (void)hipOccupancyMaxActiveBlocksPerMultiprocessor(&per_cu, (const void*)mega_fwd, 512, LDS_BYTES);
        if (per_cu < 1) { fprintf(stderr, "kernel_launch: occupancy query says %d blocks per CU\n", per_cu); per_cu = 1; }
        if (per_cu > 1) per_cu = 1;
        grid_blocks = cus * per_cu;
    }
    (void)hipMemsetAsync((char*)d_ws + WS_CTL, 0, 64 * 1024, stream);
    Params prm{};
    for (int i = 0; i < 17; ++i) prm.in[i] = (const float*)d_in[i];
    prm.out = (float*)d_out; prm.ws = (unsigned char*)d_ws;
    void* args[] = {&prm};
    hipError_t e = hipLaunchCooperativeKernel((const void*)mega_fwd, dim3(grid_blocks), dim3(512), args, LDS_BYTES, stream);
    if (e != hipSuccess) fprintf(stderr, "cooperative launch failed: %s (grid %d)\n", hipGetErrorString(e), grid_blocks);
}
```

```cpp
#include <hip/hip_runtime.h>
#include <hip/hip_cooperative_groups.h>
#include <stdint.h>
#include <cstdio>

#define LAS __attribute__((address_space(3)))
typedef _Float16 h16;
typedef _Float16 h16x8 __attribute__((ext_vector_type(8)));
typedef _Float16 h16x4 __attribute__((ext_vector_type(4)));
typedef _Float16 h16x2 __attribute__((ext_vector_type(2)));
typedef float f32x4 __attribute__((ext_vector_type(4)));
typedef float f32x2 __attribute__((ext_vector_type(2)));
typedef unsigned u32x4 __attribute__((ext_vector_type(4)));
typedef unsigned u32x2 __attribute__((ext_vector_type(2)));
typedef unsigned long long u64;
__device__ __forceinline__ int lane_id() { int r; asm volatile("v_mbcnt_lo_u32_b32 %0, -1, 0\n\tv_mbcnt_hi_u32_b32 %0, -1, %0" : "=v"(r)); return r; }

constexpr int NBATCH = 2, T = 4096, MTOK = NBATCH * T, DM = 2048;
constexpr int HA = 8, HAKV = 2, HIDX = 16, DIDX = 64, HB = 8, HD = 128;
constexpr int N_IN = 9816, N_INP = 9984, DFF = 5632, DPLE = 256, TOPK = 256;
constexpr float EPS = 1e-6f;
constexpr float ATT_SCALE = 0.08838834764831845f;

constexpr size_t MiB = 1u << 20;
constexpr size_t WS_CTL = 0;
constexpr size_t WS_RS = 512 * 1024;
constexpr size_t WS_NORM = 640 * 1024;
constexpr size_t WS_ROPE = 1 * MiB;
constexpr size_t WS_CB = 3 * MiB;
constexpr size_t WS_LOGF = 3 * MiB + 512 * 1024;
constexpr size_t WS_MASK = 4 * MiB;
constexpr size_t WS_WIN = 8 * MiB;
constexpr size_t WS_OUTA = 8 * MiB, WS_OUTB = 24 * MiB, WS_P16 = 40 * MiB;
constexpr size_t WS_WOA = 47 * MiB, WS_WOB = 51 * MiB, WS_WOUT = 55 * MiB, WS_WGU = 63 * MiB, WS_WDN = 107 * MiB, WS_WPG = 129 * MiB, WS_WPP = 137 * MiB;
constexpr size_t WS_QA = 138 * MiB, WS_KA = 154 * MiB, WS_VA = 158 * MiB, WS_QI = 162 * MiB, WS_KI = 178 * MiB, WS_WI = 179 * MiB;
constexpr size_t WS_QB = 180 * MiB, WS_KB = 196 * MiB, WS_VB = 212 * MiB, WS_SIGA = 228 * MiB, WS_SIGB = 260 * MiB, WS_PART = 292 * MiB, WS_END = 328 * MiB;
constexpr size_t WS_MIXED = WS_QB;
constexpr size_t WS_H2 = WS_QA;
constexpr size_t WS_ACT = WS_QB;
constexpr size_t WS_PP = WS_QB;
constexpr int CW_QUEUE = 2048;
constexpr int CW_SPLIT = 12288;
constexpr int CW_PANEL = 8192;
constexpr int CW_BAR = 4096;

namespace pg8 {
constexpr int BM = 256, BK = 64, HALF = 128, HTB = HALF * BK * 2, STAGE_BYTES = 8 * HTB, NXCD = 8, WGM = 4;
__host__ __device__ __forceinline__ int lds_byte(int r, int c) { const int st = (r >> 4) * 2 + (c >> 5), rr = r & 15, cc = c & 31, ob = rr * 64 + cc * 2; return st * 1024 + (ob ^ (((ob >> 9) & 1) << 5)); }
__host__ __device__ __forceinline__ int perm32(int rho) { const int n = rho >> 4, i = rho & 15; return 8 * (i >> 2) + 4 * n + (i & 3); }
__host__ __device__ __forceinline__ void stage_rc(int b, int& R, int& C) { const int st = b / 1024, sb = b % 1024, swz = sb ^ (((sb >> 9) & 1) << 5); R = (st >> 1) * 16 + swz / 64; C = (st & 1) * 32 + (swz % 64) / 2; }
struct Unit { int pm, pn; };
struct Gemm { const h16* A; const h16* Bt; int M, N, K; };
struct StaticOrder {
    int nM, nN, nwg, G, c;
    __host__ __device__ void init(int M, int N, int G_, int c_) { nM = M / BM; nN = N / BM; nwg = nM * nN; G = G_; c = c_; }
    __host__ __device__ bool next(int i, Unit& u) const {
        const long L = (long)i * G + c; if (L >= nwg) return false;
        int wgid = (int)L; { const int q = nwg / NXCD, r = nwg % NXCD, xcd = wgid % NXCD, off = wgid / NXCD; wgid = (xcd < r ? xcd * (q + 1) : r * (q + 1) + (xcd - r) * q) + off; }
        const int nig = WGM * nN, gid = wgid / nig, fm = gid * WGM, gsz = (nM - fm) < WGM ? (nM - fm) : WGM;
        u.pm = fm + ((wgid % nig) % gsz); u.pn = (wgid % nig) / gsz; return true;
    }
};
template <class Epi>
__device__ __forceinline__ void gemm_phase(LAS unsigned char* lds, const Gemm g, const StaticOrder& S, const Epi& E, int wv) {
    int tid = wv * 64 + lane_id(); asm volatile("" : "+v"(tid));
    const int wid = __builtin_amdgcn_readfirstlane(tid >> 6), lane = tid & 63, wr = wid >> 2, wc = wid & 3, fr = lane & 15, fq = lane >> 4;
    const int K = g.K, nt = K / BK;
    unsigned voffA[2], voffBp[2];
#pragma unroll
    for (int i = 0; i < 2; ++i) { int R, C; stage_rc(tid * 16 + i * 8192, R, C); voffA[i] = (unsigned)(R * K + C) * 2u; voffBp[i] = (unsigned)(((R & ~31) + perm32(R & 31)) * K + C) * 2u; }
    const size_t kstep = (size_t)(BK * 2);
    const size_t hstep = (size_t)HALF * K * 2;
    const size_t tstep = 2 * hstep;
    const unsigned ldsw = (unsigned)wid * 1024u;
    const int aoff = lds_byte(wr * 64 + fr, fq * 8), boff = lds_byte(wc * 32 + fr, fq * 8);
#define PG8_SA(b, h) (((b) * 2 + (h)) * HTB)
#define PG8_SB(b, h) ((4 + (b) * 2 + (h)) * HTB)
#define PG8_STAGE(bufoff, gbase) do { _Pragma("unroll") for (int _i = 0; _i < 2; ++_i) \
        __builtin_amdgcn_global_load_lds((const unsigned*)((const char*)(gbase) + voffA[_i]), (LAS unsigned*)(lds + (bufoff) + ldsw + _i * 8192), 16, 0, 0); } while (0)
#define PG8_STAGEB(bufoff, gbase, pf) do { _Pragma("unroll") for (int _i = 0; _i < 2; ++_i) \
        __builtin_amdgcn_global_load_lds((const unsigned*)((const char*)(gbase) + ((pf) ? voffBp[_i] : voffA[_i])), (LAS unsigned*)(lds + (bufoff) + ldsw + _i * 8192), 16, 0, 0); } while (0)
#define PG8_LDA(dst, b, h) do { _Pragma("unroll") for (int m = 0; m < 4; ++m) _Pragma("unroll") for (int k = 0; k < 2; ++k) dst[m][k] = *(const LAS h16x8*)(lds + PG8_SA(b, h) + aoff + m * 2048 + k * 1024); } while (0)
#define PG8_LDB(dst, b, h) do { _Pragma("unroll") for (int n = 0; n < 2; ++n) _Pragma("unroll") for (int k = 0; k < 2; ++k) dst[n][k] = *(const LAS h16x8*)(lds + PG8_SB(b, h) + boff + n * 2048 + k * 1024); } while (0)
#define PG8_MMA(ai, bj, At, Bt) do { __builtin_amdgcn_s_setprio(1); _Pragma("unroll") for (int m = 0; m < 4; ++m) _Pragma("unroll") for (int n = 0; n < 2; ++n) _Pragma("unroll") for (int k = 0; k < 2; ++k) \
        acc[ai][bj][m][n] = __builtin_amdgcn_mfma_f32_16x16x32_f16(Bt[n][k], At[m][k], acc[ai][bj][m][n], 0, 0, 0); __builtin_amdgcn_s_setprio(0); } while (0)
#define PG8_WAIT_V(n) asm volatile("s_waitcnt vmcnt(" #n ")" ::: "memory")
#define PG8_WAIT_L(n) asm volatile("s_waitcnt lgkmcnt(" #n ")" ::: "memory")
#define PG8_BAR __builtin_amdgcn_s_barrier()
#define PG8_SCHED __builtin_amdgcn_sched_barrier(0)
    Unit cur, nxt; int ui = 0;
    if (!S.next(0, cur)) return;
    f32x4 acc[2][2][4][2];
#pragma unroll
    for (int a = 0; a < 2; ++a)
#pragma unroll
        for (int b = 0; b < 2; ++b)
#pragma unroll
            for (int m = 0; m < 4; ++m)
#pragma unroll
                for (int n = 0; n < 2; ++n) acc[a][b][m][n] = (f32x4){0.f, 0.f, 0.f, 0.f};
    h16x8 At[4][2], B0[2][2], B1[2][2];
    const char* cA = (const char*)g.A + (size_t)cur.pm * tstep; const char* cB = (const char*)g.Bt + (size_t)cur.pn * tstep;
    bool pfc = Epi::perm(cur.pn);
    PG8_STAGEB(PG8_SB(0, 0), cB, pfc); PG8_STAGE(PG8_SA(0, 0), cA); PG8_STAGEB(PG8_SB(0, 1), cB + hstep, pfc); PG8_STAGE(PG8_SA(0, 1), cA + hstep);
    if (wr == 1) PG8_BAR;
    PG8_WAIT_V(4); PG8_BAR;
    PG8_STAGEB(PG8_SB(1, 0), cB + kstep, pfc); PG8_STAGE(PG8_SA(1, 0), cA + kstep); PG8_STAGEB(PG8_SB(1, 1), cB + hstep + kstep, pfc);
    PG8_WAIT_V(6); PG8_BAR;
    for (;;) {
        const bool has_next = S.next(ui + 1, nxt);
        const char* nA = has_next ? (const char*)g.A + (size_t)nxt.pm * tstep : cA; const char* nB = has_next ? (const char*)g.Bt + (size_t)nxt.pn * tstep : cB;
        const bool pfn = has_next ? Epi::perm(nxt.pn) : pfc;
        for (int t = 0; t < nt; t += 2) {
            const bool last = (t == nt - 2);
            const char* a1 = cA + (size_t)(t + 1) * kstep;
            const char* a2 = last ? nA : cA + (size_t)(t + 2) * kstep; const char* b2 = last ? nB : cB + (size_t)(t + 2) * kstep;
            const char* a3 = a2 + kstep; const char* b3 = b2 + kstep;
            const bool pf2 = last ? pfn : pfc;
            PG8_LDB(B0, 0, 0); PG8_SCHED; PG8_LDA(At, 0, 0); PG8_STAGE(PG8_SA(1, 1), a1 + hstep);
            PG8_WAIT_L(8); PG8_BAR; PG8_WAIT_L(0); PG8_MMA(0, 0, At, B0); PG8_BAR; PG8_SCHED;
            PG8_LDB(B1, 0, 1); PG8_STAGEB(PG8_SB(0, 0), b2, pf2);
            PG8_BAR; PG8_WAIT_L(0); PG8_MMA(0, 1, At, B1); PG8_BAR;
            PG8_LDA(At, 0, 1); PG8_STAGE(PG8_SA(0, 0), a2);
            PG8_BAR; PG8_WAIT_L(0); PG8_MMA(1, 0, At, B0); PG8_BAR; PG8_SCHED;
            PG8_STAGEB(PG8_SB(0, 1), b2 + hstep, pf2);
            PG8_WAIT_V(6); PG8_BAR; PG8_MMA(1, 1, At, B1); PG8_BAR;
            PG8_LDB(B0, 1, 0); PG8_SCHED; PG8_LDA(At, 1, 0); PG8_STAGE(PG8_SA(0, 1), a2 + hstep);
            PG8_WAIT_L(8); PG8_BAR; PG8_WAIT_L(0); PG8_MMA(0, 0, At, B0); PG8_BAR; PG8_SCHED;
            PG8_LDB(B1, 1, 1); PG8_STAGEB(PG8_SB(1, 0), b3, pf2);
            PG8_BAR; PG8_WAIT_L(0); PG8_MMA(0, 1, At, B1); PG8_BAR;
            PG8_LDA(At, 1, 1); PG8_STAGE(PG8_SA(1, 0), a3);
            PG8_BAR; PG8_WAIT_L(0); PG8_MMA(1, 0, At, B0); PG8_BAR; PG8_SCHED;
            PG8_STAGEB(PG8_SB(1, 1), b3 + hstep, pf2);
            PG8_WAIT_V(6); PG8_BAR; PG8_MMA(1, 1, At, B1); PG8_BAR;
        }
        if constexpr (!Epi::AFTER_DRAIN) E(acc, cur, wr, wc, fr, fq);
        if (!has_next) break;
#pragma unroll
        for (int a = 0; a < 2; ++a)
#pragma unroll
            for (int b = 0; b < 2; ++b)
#pragma unroll
                for (int m = 0; m < 4; ++m)
#pragma unroll
                    for (int n = 0; n < 2; ++n) acc[a][b][m][n] = (f32x4){0.f, 0.f, 0.f, 0.f};
        cur = nxt; cA = nA; cB = nB; pfc = pfn; ++ui;
    }
    PG8_WAIT_V(0);
    if (wr == 0) PG8_BAR;
    PG8_BAR;
    if constexpr (Epi::AFTER_DRAIN) E.fused(acc, cur, wr, wc, fr, fq, lane);
#undef PG8_SA
#undef PG8_SB
#undef PG8_STAGE
#undef PG8_STAGEB
#undef PG8_LDA
#undef PG8_LDB
#undef PG8_MMA
#undef PG8_WAIT_V
#undef PG8_WAIT_L
#undef PG8_BAR
#undef PG8_SCHED
}
}
using pg8::Unit;
typedef f32x4 Acc[2][2][4][2];

__device__ __forceinline__ void st4h(h16* p, f32x4 v) { h16x4 o; o[0] = (h16)v[0]; o[1] = (h16)v[1]; o[2] = (h16)v[2]; o[3] = (h16)v[3]; *(h16x4*)p = o; }
__device__ __forceinline__ void st8h(h16* p, f32x4 a, f32x4 b) { h16x8 o; o[0] = (h16)a[0]; o[1] = (h16)a[1]; o[2] = (h16)a[2]; o[3] = (h16)a[3]; o[4] = (h16)b[0]; o[5] = (h16)b[1]; o[6] = (h16)b[2]; o[7] = (h16)b[3]; *(h16x8*)p = o; }
__device__ __forceinline__ void ld8h(const h16* p, f32x4& a, f32x4& b) { const h16x8 o = *(const h16x8*)p; a = (f32x4){(float)o[0], (float)o[1], (float)o[2], (float)o[3]}; b = (f32x4){(float)o[4], (float)o[5], (float)o[6], (float)o[7]}; }
__device__ __forceinline__ f32x4 ld4h(const h16* p) { const h16x4 o = *(const h16x4*)p; return (f32x4){(float)o[0], (float)o[1], (float)o[2], (float)o[3]}; }
__device__ __forceinline__ float sigmoidf_(float x) { return __builtin_amdgcn_rcpf(1.0f + __expf(-x)); }
__device__ __forceinline__ float logsigmoidf_(float z) { return fminf(z, 0.f) - __logf(1.0f + __expf(-fabsf(z))); }
__device__ __forceinline__ float wave_sum(float v) {
#pragma unroll
    for (int o = 1; o < 64; o <<= 1) v += __shfl_xor(v, o);
    return v;
}

struct EpiInProj {
    static constexpr bool AFTER_DRAIN = false;
    static __device__ __forceinline__ bool perm(int pn) { return pn == 5 || pn >= 11; }
    unsigned char* ws; const float* b_f;
    __device__ __forceinline__ void operator()(const Acc& acc, const Unit& u, int wr, int wc, int fr, int fq) const {
        const int pn = u.pn, row0 = u.pm * 256 + wr * 64 + fr;
        const float* ROPE = (const float*)(ws + WS_ROPE);
#pragma unroll
        for (int ai = 0; ai < 2; ++ai)
#pragma unroll
            for (int m = 0; m < 4; ++m) {
                const int row = row0 + ai * 128 + m * 16, b = row >> 12, t = row & 4095;
                const float* rp = ROPE + (size_t)row * 48;
#pragma unroll
                for (int bj = 0; bj < 2; ++bj) {
                    f32x4 v0 = acc[ai][bj][m][0], v1 = acc[ai][bj][m][1];
                    const int d0 = 32 * wc + 4 * fq;
                    const int d8 = 32 * wc + 8 * fq;
                    if (pn < 6) {
                        size_t off;
                        if (pn < 4) off = WS_QA + (((size_t)(b * HA + pn * 2 + bj) * T + t) * HD) * 2;
                        else off = (pn == 4 ? WS_KA : WS_VA) + (((size_t)(b * HAKV + bj) * T + t) * HD) * 2;
                        h16* dst = (h16*)(ws + off);
                        if (pn < 5 && wc == 0) {
                            const f32x4 c = *(const f32x4*)(rp + 4 * fq), s = *(const f32x4*)(rp + 16 + 4 * fq);
                            const f32x4 y0 = v0 * c - v1 * s, y1 = v1 * c + v0 * s; v0 = y0; v1 = y1;
                        }
                        if (pn == 5) st8h(dst + d8, v0, v1); else { st4h(dst + d0, v0); st4h(dst + d0 + 16, v1); }
                    } else if (pn < 11) {
                        const bool is_q = pn < 10;
                        if (is_q || bj == 0) {
                            if (is_q || wc < 2) {
                                const int dd = 32 * (wc & 1) + 4 * fq;
                                const size_t off = is_q ? WS_QI + ((size_t)row * 1024 + ((pn - 6) * 4 + 2 * bj + (wc >> 1)) * 64) * 2 : WS_KI + ((size_t)row * 64) * 2;
                                h16* dst = (h16*)(ws + off);
                                if ((wc & 1) == 0) {
                                    f32x4 pr;
#pragma unroll
                                    for (int j = 0; j < 4; ++j) pr[j] = __shfl_xor(v0[j], 32);
                                    const f32x4 c = *(const f32x4*)(rp + 32 + 4 * (fq & 1)), s = *(const f32x4*)(rp + 40 + 4 * (fq & 1));
                                    v0 = (fq < 2) ? (v0 * c - pr * s) : (v0 * c + pr * s);
                                }
                                st4h(dst + dd, v0); st4h(dst + dd + 16, v1);
                            } else if (wc == 2) {
                                *(f32x4*)((float*)(ws + WS_WI) + (size_t)row * 16 + 4 * fq) = v0 * 0.03125f;
                                if (fq < 2) { const f32x4 bf = *(const f32x4*)(b_f + 4 * fq); f32x4 o;
#pragma unroll
                                    for (int j = 0; j < 4; ++j) o[j] = logsigmoidf_(v1[j] + bf[j]);
                                    float* lf = (float*)(ws + WS_LOGF) + ((size_t)(b * HB + 4 * fq)) * T + t;
#pragma unroll
                                    for (int j = 0; j < 4; ++j) lf[(size_t)j * T] = o[j]; }
                            }
                        }
                    } else if (pn < 23) {
                        const int q = pn - 11, which = q >> 2, head = (q & 3) * 2 + bj;
                        h16* dst = (h16*)(ws + WS_QB + (size_t)which * (WS_KB - WS_QB)) + ((size_t)(b * HB + head) * T + t) * HD;
                        st8h(dst + d8, v0, v1);
                    } else {
                        const int q = pn - 23; const int col = (q & 7) * 256 + 128 * bj + d8;
                        h16* base = (h16*)(ws + WS_SIGA + (size_t)(q >> 3) * (WS_SIGB - WS_SIGA));
#pragma unroll
                        for (int j = 0; j < 4; ++j) { v0[j] = sigmoidf_(v0[j]); v1[j] = sigmoidf_(v1[j]); }
                        st8h(base + (size_t)row * DM + col, v0, v1);
                    }
                }
            }
    }
};
static_assert(WS_VB - WS_KB == WS_KB - WS_QB, "QB/KB/VB equally spaced");
template <bool FIRST> struct EpiGate {
    static constexpr bool AFTER_DRAIN = false;
    static __device__ __forceinline__ bool perm(int) { return true; }
    const h16* SIG; h16* MIXED;
    __device__ __forceinline__ void operator()(const Acc& acc, const Unit& u, int wr, int wc, int fr, int fq) const {
        const int row0 = u.pm * 256 + wr * 64 + fr, col0 = u.pn * 256 + 32 * wc + 8 * fq;
#pragma unroll
        for (int ai = 0; ai < 2; ++ai)
#pragma unroll
            for (int m = 0; m < 4; ++m)
#pragma unroll
                for (int bj = 0; bj < 2; ++bj) { const size_t off = (size_t)(row0 + ai * 128 + m * 16) * DM + col0 + bj * 128;
                    f32x4 s0, s1; ld8h(SIG + off, s0, s1); f32x4 v0 = s0 * acc[ai][bj][m][0], v1 = s1 * acc[ai][bj][m][1];
                    if (!FIRST) { f32x4 m0, m1; ld8h(MIXED + off, m0, m1); v0 += m0; v1 += m1; }
                    st8h(MIXED + off, v0, v1); }
    }
};
__device__ __forceinline__ float sumsq4(f32x4 v) { return (v[0] * v[0] + v[1] * v[1]) + (v[2] * v[2] + v[3] * v[3]); }
template <bool BASE_F32> struct EpiResidNorm {
    static constexpr bool AFTER_DRAIN = false;
    static __device__ __forceinline__ bool perm(int) { return true; }
    const float* BASE; h16* XH; float* RS;
    __device__ __forceinline__ void operator()(const Acc& acc, const Unit& u, int wr, int wc, int fr, int fq) const {
        const int row0 = u.pm * 256 + wr * 64 + fr, col0 = u.pn * 256 + 32 * wc + 8 * fq;
#pragma unroll
        for (int ai = 0; ai < 2; ++ai)
#pragma unroll
            for (int m = 0; m < 4; ++m) { const int row = row0 + ai * 128 + m * 16; float ss = 0.f;
#pragma unroll
                for (int bj = 0; bj < 2; ++bj) { const size_t off = (size_t)row * DM + col0 + bj * 128;
                    f32x4 b0, b1; if (BASE_F32) { b0 = *(const f32x4*)(BASE + off); b1 = *(const f32x4*)(BASE + off + 4); } else ld8h(XH + off, b0, b1);
                    const f32x4 v0 = b0 + acc[ai][bj][m][0], v1 = b1 + acc[ai][bj][m][1]; st8h(XH + off, v0, v1); ss += sumsq4(v0) + sumsq4(v1); }
                ss += __shfl_xor(ss, 16); ss += __shfl_xor(ss, 32);
                if (fq == 0) atomicAdd(RS + row, ss); }
    }
};
struct EpiSwiGLU {
    static constexpr bool AFTER_DRAIN = false;
    static __device__ __forceinline__ bool perm(int) { return false; }
    h16* ACT; const float* RS;
    __device__ __forceinline__ void operator()(const Acc& acc, const Unit& u, int wr, int wc, int fr, int fq) const {
        const int row0 = u.pm * 256 + wr * 64 + fr;
#pragma unroll
        for (int ai = 0; ai < 2; ++ai)
#pragma unroll
            for (int m = 0; m < 4; ++m) { const int row = row0 + ai * 128 + m * 16; const float r = __builtin_amdgcn_rsqf(RS[row] * (1.0f / DM) + EPS);
#pragma unroll
                for (int bj = 0; bj < 2; ++bj) { const f32x4 g = acc[ai][bj][m][0] * r, uu = acc[ai][bj][m][1] * r; f32x4 o;
#pragma unroll
                    for (int j = 0; j < 4; ++j) o[j] = g[j] * sigmoidf_(g[j]) * uu[j];
                    st4h(ACT + (size_t)row * DFF + 16 * (u.pn * 8 + bj * 4 + wc) + 4 * fq, o); } }
    }
};
struct EpiStoreH {
    static constexpr bool AFTER_DRAIN = false;
    static __device__ __forceinline__ bool perm(int) { return true; }
    h16* O; int ldc;
    __device__ __forceinline__ void operator()(const Acc& acc, const Unit& u, int wr, int wc, int fr, int fq) const {
        const int row0 = u.pm * 256 + wr * 64 + fr, col0 = u.pn * 256 + 32 * wc + 8 * fq;
#pragma unroll
        for (int ai = 0; ai < 2; ++ai)
#pragma unroll
            for (int m = 0; m < 4; ++m)
#pragma unroll
                for (int bj = 0; bj < 2; ++bj) st8h(O + (size_t)(row0 + ai * 128 + m * 16) * ldc + col0 + bj * 128, acc[ai][bj][m][0], acc[ai][bj][m][1]);
    }
};
struct EpiPLE {
    static constexpr bool AFTER_DRAIN = false;
    static __device__ __forceinline__ bool perm(int) { return true; }
    const h16* PP; const h16* XI; h16* XO; const float* RSIN; float* RSOUT;
    __device__ __forceinline__ void operator()(const Acc& acc, const Unit& u, int wr, int wc, int fr, int fq) const {
        const int row0 = u.pm * 256 + wr * 64 + fr, col0 = u.pn * 256 + 32 * wc + 8 * fq;
#pragma unroll
        for (int ai = 0; ai < 2; ++ai)
#pragma unroll
            for (int m = 0; m < 4; ++m) { const int row = row0 + ai * 128 + m * 16; const float r = __builtin_amdgcn_rsqf(RSIN[row] * (1.0f / DM) + EPS); float ss = 0.f;
#pragma unroll
                for (int bj = 0; bj < 2; ++bj) { const size_t off = (size_t)row * DM + col0 + bj * 128;
                    const f32x4 a0 = acc[ai][bj][m][0] * r, a1 = acc[ai][bj][m][1] * r; f32x4 p0, p1, x0, x1; ld8h(PP + off, p0, p1); ld8h(XI + off, x0, x1);
#pragma unroll
                    for (int j = 0; j < 4; ++j) { x0[j] += sigmoidf_(a0[j]) * p0[j]; x1[j] += sigmoidf_(a1[j]) * p1[j]; }
                    st8h(XO + off, x0, x1); ss += sumsq4(x0) + sumsq4(x1); }
                ss += __shfl_xor(ss, 16); ss += __shfl_xor(ss, 32);
                if (fq == 0) atomicAdd(RSOUT + row, ss); }
    }
};

struct EpiPLEFinal {
    static constexpr bool AFTER_DRAIN = true;
    static __device__ __forceinline__ bool perm(int) { return true; }
    const h16* PP; const h16* XI; float* OUT; const float* RSIN; float* RSOUT; const float* gfin; unsigned* cnt;
    __device__ __forceinline__ void operator()(const Acc&, const Unit&, int, int, int, int) const {}
    __device__ __forceinline__ void fused(Acc& acc, const Unit& u, int wr, int wc, int fr, int fq, int lane) const {
        const int row0 = u.pm * 256 + wr * 64 + fr, col0 = u.pn * 256 + 32 * wc + 8 * fq;
#pragma unroll
        for (int ai = 0; ai < 2; ++ai)
#pragma unroll
            for (int m = 0; m < 4; ++m) { const int row = row0 + ai * 128 + m * 16; const float r = __builtin_amdgcn_rsqf(RSIN[row] * (1.0f / DM) + EPS); float ss = 0.f;
#pragma unroll
                for (int bj = 0; bj < 2; ++bj) { const size_t off = (size_t)row * DM + col0 + bj * 128;
                    const f32x4 a0 = acc[ai][bj][m][0] * r, a1 = acc[ai][bj][m][1] * r; f32x4 p0, p1, x0, x1; ld8h(PP + off, p0, p1); ld8h(XI + off, x0, x1);
#pragma unroll
                    for (int j = 0; j < 4; ++j) { x0[j] += sigmoidf_(a0[j]) * p0[j]; x1[j] += sigmoidf_(a1[j]) * p1[j]; }
                    acc[ai][bj][m][0] = x0; acc[ai][bj][m][1] = x1; ss += sumsq4(x0) + sumsq4(x1); }
                ss += __shfl_xor(ss, 16); ss += __shfl_xor(ss, 32);
                if (fq == 0) atomicAdd(RSOUT + row, ss); }
        asm volatile("s_waitcnt vmcnt(0)" ::: "memory");
        unsigned* c = cnt + 64 * u.pm;
        if (lane == 0) __hip_atomic_fetch_add(c, 1u, __ATOMIC_RELAXED, __HIP_MEMORY_SCOPE_AGENT);
        { unsigned spins = 0;
          while ((unsigned)__builtin_amdgcn_readfirstlane((int)__hip_atomic_load(c, __ATOMIC_RELAXED, __HIP_MEMORY_SCOPE_AGENT)) < 64u) { __builtin_amdgcn_s_sleep(2); if (++spins > (1u << 22)) break; } }
#pragma unroll
        for (int ai = 0; ai < 2; ++ai)
#pragma unroll
            for (int m = 0; m < 4; ++m) { const int row = row0 + ai * 128 + m * 16;
                const float r = __builtin_amdgcn_rsqf(__hip_atomic_load(RSOUT + row, __ATOMIC_RELAXED, __HIP_MEMORY_SCOPE_AGENT) * (1.0f / DM) + EPS);
#pragma unroll
                for (int bj = 0; bj < 2; ++bj) { const size_t off = (size_t)row * DM + col0 + bj * 128;
                    const f32x4 g0 = *(const f32x4*)(gfin + col0 + bj * 128), g1 = *(const f32x4*)(gfin + col0 + bj * 128 + 4);
                    *(f32x4*)(OUT + off) = acc[ai][bj][m][0] * r * g0; *(f32x4*)(OUT + off + 4) = acc[ai][bj][m][1] * r * g1; } }
    }
};

__device__ __forceinline__ int map_in(int p) {
    if (p < 2560) return p;
    if (p < 2816) { const int c = p - 2560; if (c < 64) return 2560 + c; if (c < 80) return 2624 + (c - 64); if (c < 88) return 5712 + (c - 80); return -1; }
    const int q = p - 2816; if (q < 3072) return 2640 + q; return 5720 + (q - 3072);
}
template <int MODE>
__device__ __forceinline__ const float* tr_src(const float* W0, const float* W1, int Nsrc, int n) {
    if (MODE == 0) return n < Nsrc ? W0 + n : nullptr;
    if (MODE == 1) { const int c = map_in(n); return c >= 0 ? W0 + c : nullptr; }
    return (((n >> 4) & 1) ? W1 : W0) + 16 * (n >> 5) + (n & 15);
}
template <int MODE>
__device__ __forceinline__ void ph_transpose(const float* W0, const float* W1, const float* gk, int K, int Nsrc, h16* WT, int Nphys, LAS float* scr, int gw, int NGW, int lane) {
    const int nblk = Nphys / 32, nitems = (K / 64) * nblk;
    const int lr = lane >> 3, lc = (lane & 7) * 4;
    f32x4 cur[8], nxt[8];
    int item = gw;
    if (item < nitems) { const int kb = item / nblk, nb = item % nblk; const float* src = tr_src<MODE>(W0, W1, Nsrc, 32 * nb + lc);
#pragma unroll
        for (int i = 0; i < 8; ++i) cur[i] = src ? *(const f32x4*)(src + (size_t)(64 * kb + lr + 8 * i) * Nsrc) : (f32x4){0.f, 0.f, 0.f, 0.f}; }
    for (; item < nitems; item += NGW) {
        const int kb = item / nblk, nb = item % nblk, k0 = 64 * kb, n0 = 32 * nb;
        const int itn = item + NGW;
        if (itn < nitems) { const int kbn = itn / nblk, nbn = itn % nblk; const float* src = tr_src<MODE>(W0, W1, Nsrc, 32 * nbn + lc);
#pragma unroll
            for (int i = 0; i < 8; ++i) nxt[i] = src ? *(const f32x4*)(src + (size_t)(64 * kbn + lr + 8 * i) * Nsrc) : (f32x4){0.f, 0.f, 0.f, 0.f}; }
#pragma unroll
        for (int i = 0; i < 8; ++i) { LAS float* d = scr + (lr + 8 * i) * 33 + lc; const float gg = gk ? gk[k0 + lr + 8 * i] : 1.0f; d[0] = cur[i][0] * gg; d[1] = cur[i][1] * gg; d[2] = cur[i][2] * gg; d[3] = cur[i][3] * gg; }
        __builtin_amdgcn_wave_barrier(); asm volatile("s_waitcnt lgkmcnt(0)" ::: "memory");
        const int c = lane & 7;
#pragma unroll
        for (int j = 0; j < 4; ++j) { const int nn = (lane >> 3) + 8 * j; const LAS float* sp = scr + (8 * c) * 33 + nn;
            h16x8 o;
#pragma unroll
            for (int e = 0; e < 8; ++e) o[e] = (h16)sp[e * 33];
            *(h16x8*)(WT + (size_t)(n0 + nn) * K + k0 + 8 * c) = o; }
        __builtin_amdgcn_wave_barrier(); asm volatile("s_waitcnt lgkmcnt(0)" ::: "memory");
#pragma unroll
        for (int i = 0; i < 8; ++i) cur[i] = nxt[i];
    }
}
__device__ __forceinline__ void sincos_f32arg(float ang, float& sn, float& cs) {
    const double a = (double)ang;
    const double rev = a * 0.15915494309189535;
    const double fr = rev - __builtin_rint(rev);
    const double q4 = fr * 4.0; const double qi = __builtin_rint(q4); const int qq = ((int)qi) & 3;
    const double r = (q4 - qi) * 1.5707963267948966;
    const double r2 = r * r;
    const double s = r * (1.0 + r2 * (-1.0 / 6 + r2 * (1.0 / 120 + r2 * (-1.0 / 5040 + r2 * (1.0 / 362880 + r2 * (-1.0 / 39916800))))));
    const double c = 1.0 + r2 * (-0.5 + r2 * (1.0 / 24 + r2 * (-1.0 / 720 + r2 * (1.0 / 40320 + r2 * (-1.0 / 3628800 + r2 * (1.0 / 479001600))))));
    double so, co;
    if (qq == 0) { so = s; co = c; } else if (qq == 1) { so = c; co = -s; } else if (qq == 2) { so = -s; co = -c; } else { so = -c; co = s; }
    sn = (float)so; cs = (float)co;
}
__device__ __forceinline__ void ph_rope(const int* pos, float* ROPE, int gtid, int NGT) {
    for (int idx = gtid; idx < MTOK * 24; idx += NGT) {
        const int tok = idx / 24, i = idx % 24, k = i < 16 ? i : 2 * (i - 16);
        float f = 0x1.000000p+0f;
        f = k == 1 ? 0x1.c2ef76p-2f : f; f = k == 2 ? 0x1.8d275ep-3f : f; f = k == 3 ? 0x1.5dc95ap-4f : f; f = k == 4 ? 0x1.341190p-5f : f; f = k == 5 ? 0x1.0f5384p-6f : f;
        f = k == 6 ? 0x1.ddee9cp-8f : f; f = k == 7 ? 0x1.a4ee3ep-9f : f; f = k == 8 ? 0x1.72ba44p-10f : f; f = k == 9 ? 0x1.468318p-11f : f; f = k == 10 ? 0x1.1f91f0p-12f : f;
        f = k == 11 ? 0x1.fa8b84p-14f : f; f = k == 12 ? 0x1.be218ap-15f : f; f = k == 13 ? 0x1.88ec22p-16f : f; f = k == 14 ? 0x1.5a0f50p-17f : f; f = k == 15 ? 0x1.30c94ep-18f : f;
        const float ang = (float)pos[tok] * f;
        float sn, cs; sincos_f32arg(ang, sn, cs);
        float* rp = ROPE + (size_t)tok * 48;
        if (i < 16) { rp[i] = cs; rp[16 + i] = sn; } else { rp[32 + (i - 16)] = cs; rp[40 + (i - 16)] = sn; }
    }
}
template <bool TO_F32>
__device__ __forceinline__ void ph_rmsnorm(const float* X, const float* g, h16* OUTH, float* OUTF, int gw, int NGW, int lane) {
    for (int row = gw; row < MTOK; row += NGW) {
        const f32x4* xr = (const f32x4*)(X + (size_t)row * DM) + lane;
        f32x4 v[8]; float s = 0.f;
#pragma unroll
        for (int j = 0; j < 8; ++j) { v[j] = xr[64 * j]; s += (v[j][0] * v[j][0] + v[j][1] * v[j][1]) + (v[j][2] * v[j][2] + v[j][3] * v[j][3]); }
        const float r = 1.0f / sqrtf(wave_sum(s) * (1.0f / DM) + EPS);
#pragma unroll
        for (int j = 0; j < 8; ++j) { const f32x4 gg = *((const f32x4*)g + lane + 64 * j); const f32x4 o = v[j] * r * gg;
            if (TO_F32) *((f32x4*)(OUTF + (size_t)row * DM) + lane + 64 * j) = o; else st4h(OUTH + (size_t)row * DM + 4 * (lane + 64 * j), o); }
    }
}
__device__ __forceinline__ void ph_final(const h16* X, float* OUT, const float* g, const float* RS, int gw, int NGW, int lane) {
    for (int row = gw; row < MTOK; row += NGW) {
        const float r = __builtin_amdgcn_rsqf(RS[row] * (1.0f / DM) + EPS);
        h16x8 v[4];
#pragma unroll
        for (int j = 0; j < 4; ++j) v[j] = *((const h16x8*)(X + (size_t)row * DM) + lane + 64 * j);
#pragma unroll
        for (int j = 0; j < 4; ++j) { const float* gp = g + 8 * (lane + 64 * j); float* op = OUT + (size_t)row * DM + 8 * (lane + 64 * j);
            const f32x4 g0 = *(const f32x4*)gp, g1 = *(const f32x4*)(gp + 4);
            f32x4 o0 = {(float)v[j][0], (float)v[j][1], (float)v[j][2], (float)v[j][3]}, o1 = {(float)v[j][4], (float)v[j][5], (float)v[j][6], (float)v[j][7]};
            *(f32x4*)op = o0 * r * g0; *(f32x4*)(op + 4) = o1 * r * g1; }
    }
}
__device__ __forceinline__ void ph_cumsum(const float* LOGF, float* CBS, int bh, int lane) {
    const int b = bh >> 3, h = bh & 7;
    float v[64];
#pragma unroll
    for (int it = 0; it < 64; ++it) v[it] = LOGF[(size_t)(b * T + it * 64 + lane) * 8 + h];
    float run = 0.f;
#pragma unroll
    for (int it = 0; it < 64; ++it) {
        float x = v[it];
#pragma unroll
        for (int o = 1; o < 64; o <<= 1) { const float nb = __shfl_up(x, o); if (lane >= o) x += nb; }
        CBS[(size_t)bh * T + it * 64 + lane] = (run + x) * -11.313708498984761f;
        run += __shfl(x, 63);
    }
}

__device__ __forceinline__ unsigned fkey(float f) { const unsigned u = __float_as_uint(f + 0.0f); return (u & 0x80000000u) ? ~u : (u | 0x80000000u); }
__device__ __forceinline__ unsigned count_ge(const unsigned (&key)[64], unsigned th, int nj) {
    unsigned c = 0;
#pragma unroll
    for (int j8 = 0; j8 < 8; ++j8) {
        if (8 * j8 < nj) {
#pragma unroll
            for (int j = 8 * j8; j < 8 * j8 + 8; ++j) c += (key[j] >= th) ? 1u : 0u;
        }
    }
#pragma unroll
    for (int o = 1; o < 64; o <<= 1) c += __shfl_xor(c, o);
    return c;
}
__device__ __forceinline__ u64 topk_select(const unsigned (&key)[64], int nvalid, int lane) {
    u64 myword = 0;
    if (nvalid <= TOPK) {
#pragma unroll
        for (int j = 0; j < 64; ++j) { const u64 bal = __ballot(key[j] != 0u); if (lane == j) myword = bal; }
    } else {
        unsigned th = 0u; bool exact = false;
        for (int bit = 31; bit >= 0; --bit) { const unsigned tc = th | (1u << bit); const unsigned c = count_ge(key, tc, (nvalid + 63) >> 6); if (c >= (unsigned)TOPK) th = tc; if (c == (unsigned)TOPK) { exact = true; break; } }
        if (exact) {
#pragma unroll
            for (int j = 0; j < 64; ++j) { const u64 bal = __ballot(key[j] >= th); if (lane == j) myword = bal; }
        } else {
            unsigned cgt = 0;
#pragma unroll
            for (int j = 0; j < 64; ++j) cgt += (unsigned)__builtin_popcountll(__ballot(key[j] > th));
            int need = TOPK - (int)cgt;
#pragma unroll
            for (int j = 0; j < 64; ++j) { u64 eq = __ballot(key[j] == th); const u64 gt = __ballot(key[j] > th);
                int pc = __builtin_popcountll(eq);
                while (pc > need) { eq &= ~(1ull << (63 - __builtin_clzll(eq))); --pc; }
                need -= pc; if (lane == j) myword = gt | eq; }
        }
    }
    return myword;
}
template <int LVL>
__device__ __forceinline__ void hist_level(const unsigned (&key)[64], int nj, int lane, LAS unsigned* hist, unsigned& prefix, unsigned& need, unsigned& cnt_eq) {
    constexpr int SH = LVL == 0 ? 21 : (LVL == 1 ? 10 : 0), PSH = LVL == 1 ? 21 : 10, NB = LVL == 2 ? 10 : 11;
#pragma unroll
    for (int i = 0; i < 8; ++i) *(LAS u32x4*)(hist + lane * 32 + 4 * i) = (u32x4){0u, 0u, 0u, 0u};
    asm volatile("s_waitcnt lgkmcnt(0)" ::: "memory"); __builtin_amdgcn_wave_barrier();
#pragma unroll
    for (int j8 = 0; j8 < 8; ++j8) {
        if (8 * j8 < nj) {
            if (LVL == 0) {
#pragma unroll
                for (int j = 8 * j8; j < 8 * j8 + 8; ++j) __hip_atomic_fetch_add(hist + (key[j] >> 21), 1u, __ATOMIC_RELAXED, __HIP_MEMORY_SCOPE_WORKGROUP);
            } else {
                bool any = false;
#pragma unroll
                for (int j = 8 * j8; j < 8 * j8 + 8; ++j) any = any || ((key[j] >> PSH) == prefix);
                if (LVL == 1 || __any(any)) {
#pragma unroll
                    for (int j = 8 * j8; j < 8 * j8 + 8; ++j) { const unsigned k = key[j];
                        if ((k >> PSH) == prefix) __hip_atomic_fetch_add(hist + ((k >> SH) & ((1u << NB) - 1u)), 1u, __ATOMIC_RELAXED, __HIP_MEMORY_SCOPE_WORKGROUP); }
                }
            }
        }
    }
    asm volatile("s_waitcnt lgkmcnt(0)" ::: "memory"); __builtin_amdgcn_wave_barrier();
    unsigned s = 0;
#pragma unroll
    for (int i = 0; i < 8; ++i) { const u32x4 v = *(const LAS u32x4*)(hist + lane * 32 + 4 * i); s += (v[0] + v[1]) + (v[2] + v[3]); }
    unsigned S = s;
#pragma unroll
    for (int o = 1; o < 64; o <<= 1) { const unsigned nb = __shfl_down(S, o); if (lane + o < 64) S += nb; }
    const int L = 63 - __builtin_clzll(__ballot(S >= need));
    const unsigned aboveL = __shfl(S - s, L);
    const int bi = lane & 31;
    const unsigned hb = hist[L * 32 + bi];
    unsigned R = hb;
#pragma unroll
    for (int o = 1; o < 32; o <<= 1) { const unsigned nb = __shfl_down(R, o); if (bi + o < 32) R += nb; }
    const int B = 31 - __builtin_clz((unsigned)__ballot(aboveL + R >= need));
    const unsigned abB = __shfl(aboveL + R - hb, B);
    cnt_eq = __shfl(hb, B);
    prefix = (prefix << NB) | (unsigned)(L * 32 + B);
    need -= abB;
    __builtin_amdgcn_wave_barrier();
}
__device__ __forceinline__ u64 topk_select_hist(const unsigned (&key)[64], int nvalid, int lane, LAS unsigned* hist) {
    const int nj = (nvalid + 63) >> 6;
    unsigned prefix = 0, need = TOPK, cnt_eq = 0;
    hist_level<0>(key, nj, lane, hist, prefix, need, cnt_eq);
    hist_level<1>(key, nj, lane, hist, prefix, need, cnt_eq);
    hist_level<2>(key, nj, lane, hist, prefix, need, cnt_eq);
    u64 mw = 0;
    if (need == cnt_eq) {
#pragma unroll
        for (int j = 0; j < 64; ++j) { const u64 bal = __ballot(key[j] >= prefix); if (lane == j) mw = bal; }
    } else {
        int nd = (int)need;
#pragma unroll
        for (int j = 0; j < 64; ++j) { u64 eq = __ballot(key[j] == prefix); const u64 gt = __ballot(key[j] > prefix);
            int pc = __builtin_popcountll(eq);
            while (pc > nd) { eq &= ~(1ull << (63 - __builtin_clzll(eq))); --pc; }
            nd -= pc; if (lane == j) mw = gt | eq; }
    }
    return mw;
}
__device__ __forceinline__ void ph_topk_naive(const h16* QI, const h16* KI, const float* WI, u64* MASK, LAS float* qs, LAS unsigned* ks, int gw, int NGW, int lane) {
    for (int row = gw; row < MTOK; row += NGW) {
        const int b = row >> 12, t = row & 4095;
        { const h16* qp = QI + (size_t)row * 1024 + lane * 16;
#pragma unroll
          for (int i = 0; i < 16; ++i) qs[lane * 16 + i] = (float)qp[i]; }
        if (lane < 16) qs[1024 + lane] = WI[(size_t)row * 16 + lane];
        __builtin_amdgcn_wave_barrier(); asm volatile("s_waitcnt lgkmcnt(0)" ::: "memory");
#pragma unroll 1
        for (int j = 0; j < 64; ++j) {
            unsigned kk = 0u;
            const int s = 64 * j + lane;
            if (s <= t) {
                float kf[64];
                const h16x8* kp = (const h16x8*)(KI + (size_t)(b * T + s) * 64);
#pragma unroll
                for (int c = 0; c < 8; ++c) { const h16x8 kv = kp[c];
#pragma unroll
                    for (int e = 0; e < 8; ++e) kf[c * 8 + e] = (float)kv[e]; }
                float sc = 0.f;
#pragma unroll 1
                for (int h = 0; h < 16; ++h) { float d = 0.f;
#pragma unroll
                    for (int e = 0; e < 64; ++e) d = fmaf(qs[h * 64 + e], kf[e], d);
                    sc = fmaf(qs[1024 + h], fmaxf(d, 0.f), sc); }
                kk = fkey(sc);
            }
            ks[j * 64 + lane] = kk;
        }
        __builtin_amdgcn_wave_barrier(); asm volatile("s_waitcnt lgkmcnt(0)" ::: "memory");
        unsigned key[64];
#pragma unroll
        for (int j = 0; j < 64; ++j) key[j] = ks[j * 64 + lane];
        MASK[(size_t)row * 64 + lane] = topk_select(key, t + 1, lane);
        __builtin_amdgcn_wave_barrier(); asm volatile("s_waitcnt lgkmcnt(0)" ::: "memory");
    }
}


namespace idx {
typedef short s16x8 __attribute__((ext_vector_type(8)));
typedef float f32x16 __attribute__((ext_vector_type(16)));
constexpr int CHK = 128, CHB = CHK * 128;
__device__ __forceinline__ unsigned half_sum(unsigned v) {
#pragma unroll
    for (int o = 1; o < 32; o <<= 1) v += __shfl_xor(v, o);
    return v;
}
__device__ __forceinline__ void run_group(unsigned char* ws, char* lds, unsigned* scr, int b, int g, int wv) {
    int tid = wv * 64 + lane_id(); asm volatile("" : "+v"(tid));
    const int wid = __builtin_amdgcn_readfirstlane(tid >> 6), lane = tid & 63, c = lane & 31, hi = lane >> 5;
    const int t0 = 16 * g + 2 * wid, t = t0 + hi, row = b * T + t, tmaxblk = 16 * g + 15, nch = (tmaxblk >> 7) + 1;
    const h16* QI = (const h16*)(ws + WS_QI); const char* KIb = (const char*)ws + WS_KI + (size_t)b * T * 128; const float* WI = (const float*)(ws + WS_WI);
    s16x8 A[4];
    { const int rho = c, qsel = (rho >> 2) & 1, head = (rho & 3) + 4 * (rho >> 3);
      const h16* qp = QI + (size_t)(b * T + t0 + qsel) * 1024 + head * 64 + 8 * hi;
#pragma unroll
      for (int ks = 0; ks < 4; ++ks) A[ks] = *reinterpret_cast<const s16x8*>(qp + 16 * ks); }
    float w[16];
    { const f32x4* wp = (const f32x4*)(WI + (size_t)row * 16);
#pragma unroll
      for (int i = 0; i < 4; ++i) { const f32x4 v = wp[i]; w[4 * i] = v[0]; w[4 * i + 1] = v[1]; w[4 * i + 2] = v[2]; w[4 * i + 3] = v[3]; } }
    const int pr0 = tid >> 3, pp = tid & 7;
    const unsigned g_off = (unsigned)(pr0 * 128 + pp * 16);
    const int l_off0 = pr0 * 128 + ((pp ^ ((pr0 >> 1) & 7)) << 4), l_off1 = l_off0 + 64 * 128;
    const int rd_base = c * 128; const int sw = (c >> 1) & 7;
    int rd_off[4];
#pragma unroll
    for (int ks = 0; ks < 4; ++ks) rd_off[ks] = rd_base + (((2 * ks + hi) ^ sw) << 4);
    unsigned* myscr = scr + (size_t)(2 * wid + hi) * T + c;
    asm volatile("" :: "v"(A[0]), "v"(A[1]), "v"(A[2]), "v"(A[3]), "v"(w[0]), "v"(w[4]), "v"(w[8]), "v"(w[12]));
    s16x8 st0, st1;
    { const char* src = KIb; st0 = *reinterpret_cast<const s16x8*>(src + g_off); st1 = *reinterpret_cast<const s16x8*>(src + 64 * 128 + g_off); }
    *reinterpret_cast<s16x8*>(lds + l_off0) = st0; *reinterpret_cast<s16x8*>(lds + l_off1) = st1;
    __syncthreads();
#pragma unroll 1
    for (int ch = 0; ch < nch; ++ch) {
        const char* buf = lds + (ch & 1) * CHB;
        if (ch + 1 < nch) { const char* src = KIb + (size_t)(ch + 1) * CHB; st0 = *reinterpret_cast<const s16x8*>(src + g_off); st1 = *reinterpret_cast<const s16x8*>(src + 64 * 128 + g_off); }
#pragma unroll
        for (int st = 0; st < 4; ++st) {
            f32x16 acc = {};
#pragma unroll
            for (int ks = 0; ks < 4; ++ks) { const s16x8 Bf = *reinterpret_cast<const s16x8*>(buf + st * 4096 + rd_off[ks]);
                acc = __builtin_amdgcn_mfma_f32_32x32x16_f16(__builtin_bit_cast(h16x8, A[ks]), __builtin_bit_cast(h16x8, Bf), acc, 0, 0, 0); }
            float sc = 0.f;
#pragma unroll
            for (int r = 0; r < 16; ++r) { const int ri = __float_as_int(acc[r]); sc = fmaf(w[r], __int_as_float(ri > 0 ? ri : 0), sc); }
            const int sidx = ch * CHK + st * 32 + c;
            myscr[ch * CHK + st * 32] = (sidx <= t) ? fkey(sc) : 0u;
        }
        if (ch + 1 < nch) { char* dst = lds + ((ch + 1) & 1) * CHB; *reinterpret_cast<s16x8*>(dst + l_off0) = st0; *reinterpret_cast<s16x8*>(dst + l_off1) = st1; }
        __syncthreads();
    }
    asm volatile("s_waitcnt vmcnt(0)" ::: "memory");
    u64* MASK = (u64*)(ws + WS_MASK);
#pragma unroll 1
    for (int qq = 0; qq < 2; ++qq) {
        const int tq = t0 + qq, nj = (tq >> 6) + 1;
        const unsigned* src = scr + (size_t)(2 * wid + qq) * T + lane;
        unsigned key[64];
#pragma unroll
        for (int j = 0; j < 64; ++j) key[j] = (j < nj) ? __hip_atomic_load(src + 64 * j, __ATOMIC_RELAXED, __HIP_MEMORY_SCOPE_AGENT) : 0u;
        u64 mw;
        if (tq + 1 <= TOPK) {
            mw = 0;
#pragma unroll
            for (int j = 0; j < 4; ++j) { const u64 bal = __ballot(key[j] != 0u); if (lane == j) mw = bal; }
        } else mw = topk_select_hist(key, tq + 1, lane, (LAS unsigned*)(lds + 2 * CHB + wid * 8192));
        MASK[(size_t)(b * T + tq) * 64 + lane] = mw;
    }
}
}

namespace att {
constexpr int NW = 8, QBLK = 32, KVBLK = 64, QB = NW * QBLK, D = 128;
constexpr int SHM_V = KVBLK * D * 2, SHM_K = KVBLK * D * 2;
constexpr int LDS_NEED = 2 * SHM_V + 2 * SHM_K + NW * 64 * 4;
constexpr float THR = 8.f, SCALE = 0.08838834764831845f;
typedef short s16x8 __attribute__((ext_vector_type(8)));
typedef short s16x4 __attribute__((ext_vector_type(4)));
typedef float f32x16 __attribute__((ext_vector_type(16)));
#define KSWZ(row, colB) ((row) * 256 + ((colB) ^ (((row) & 7) << 4)))
#define SBAR() __builtin_amdgcn_sched_barrier(0)
__device__ __forceinline__ int v_st(int k, int c) { const int kk = (k & ~0xC) | ((k & 4) << 1) | ((k & 8) >> 1); return ((kk >> 3) * 4 + (c >> 5)) * 512 + ((kk & 7) * 32 + (c & 31)) * 2; }
__device__ __forceinline__ int v_rd_base(int lane) { return ((lane & 3) << 3) | (((lane >> 2) & 3) << 6) | (((lane >> 4) & 1) << 5) | (((lane >> 5) & 1) << 8); }
constexpr int v_rd_off(int d0, int ks, int half) { return d0 * 512 + ks * 4096 + half * 2048; }
__device__ __forceinline__ int crow(int r, int hi) { return (r & 3) + 8 * (r >> 2) + 4 * hi; }
__device__ __forceinline__ unsigned cvtpk(float lo, float hi) { unsigned r; asm volatile("v_cvt_pk_f16_f32 %0, %1, %2" : "=v"(r) : "v"(lo), "v"(hi)); return r; }
__device__ __forceinline__ f32x16 mfma16(s16x8 a, s16x8 b, f32x16 c) { return __builtin_amdgcn_mfma_f32_32x32x16_f16(__builtin_bit_cast(h16x8, a), __builtin_bit_cast(h16x8, b), c, 0, 0, 0); }
__device__ __forceinline__ s16x8 load8(const h16* p) { return *reinterpret_cast<const s16x8*>(p); }
__device__ __forceinline__ void mask_causal(f32x16& p0, f32x16& p1, int dq) {
    const float NEG = -__builtin_inff();
#pragma unroll
    for (int r = 0; r < 16; ++r) { const int c = (r & 3) + 8 * (r >> 2); if (dq - c < 0) p0[r] = NEG; if (dq - c - 32 < 0) p1[r] = NEG; }
}
__device__ __forceinline__ void mask_bits(f32x16& p0, f32x16& p1, u64 w, int hi) {
    const float NEG = -__builtin_inff();
    const unsigned lo = (unsigned)w >> (4 * hi), up = (unsigned)(w >> 32) >> (4 * hi);
#pragma unroll
    for (int r = 0; r < 16; ++r) { const int c = (r & 3) + 8 * (r >> 2); if (!((lo >> c) & 1u)) p0[r] = NEG; if (!((up >> c) & 1u)) p1[r] = NEG; }
}
__device__ __forceinline__ void partialSM(f32x16& p0, f32x16& p1, float& m_reg, float& mn, float& alpha) {
    float pmax = p0[0]; for (int r = 1; r < 16; ++r) pmax = fmaxf(pmax, p0[r]); for (int r = 0; r < 16; ++r) pmax = fmaxf(pmax, p1[r]);
    { auto rr = __builtin_amdgcn_permlane32_swap(__float_as_uint(pmax), __float_as_uint(pmax), false, false);
      pmax = fmaxf(__uint_as_float(rr[0]), __uint_as_float(rr[1])); }
    constexpr float C2 = 1.4426950408889634f * SCALE;
    if (__builtin_expect(__all((pmax - m_reg) * SCALE <= THR), 1)) { mn = m_reg; alpha = 1.f; }
    else { mn = fmaxf(m_reg, pmax); alpha = __builtin_amdgcn_exp2f((m_reg - mn) * C2); m_reg = mn; }
    const float mnL = -mn * C2;
    for (int r = 0; r < 16; ++r) p0[r] = fmaf(p0[r], C2, mnL); for (int r = 0; r < 16; ++r) p1[r] = fmaf(p1[r], C2, mnL);
    for (int r = 0; r < 16; ++r) p0[r] = __builtin_amdgcn_exp2f(p0[r]);
}
__device__ __forceinline__ void finishSM(f32x16& p0, f32x16& p1, float alpha, float& l_reg, s16x8& pa0, s16x8& pa1, s16x8& pa2, s16x8& pa3) {
    for (int r = 0; r < 16; ++r) p1[r] = __builtin_amdgcn_exp2f(p1[r]);
    float ps = 0; for (int r = 0; r < 16; ++r) ps += p0[r]; for (int r = 0; r < 16; ++r) ps += p1[r];
    { auto rr = __builtin_amdgcn_permlane32_swap(__float_as_uint(ps), __float_as_uint(ps), false, false);
      ps = __uint_as_float(rr[0]) + __uint_as_float(rr[1]); }
    l_reg = l_reg * alpha + ps;
#define PK4(P, B_, OUT) do { unsigned a0 = cvtpk(P[B_+0], P[B_+1]), a1 = cvtpk(P[B_+2], P[B_+3]);                          \
        unsigned b0 = cvtpk(P[B_+4], P[B_+5]), b1 = cvtpk(P[B_+6], P[B_+7]);                                             \
        auto r0 = __builtin_amdgcn_permlane32_swap(a0, b0, false, false); auto r1 = __builtin_amdgcn_permlane32_swap(a1, b1, false, false); \
        u32x4 w = {r0[0], r1[0], r0[1], r1[1]}; OUT = *reinterpret_cast<s16x8*>(&w); } while (0)
    PK4(p0, 0, pa0); PK4(p0, 8, pa1); PK4(p1, 0, pa2); PK4(p1, 8, pa3);
#undef PK4
}
template <int KB>
__device__ __forceinline__ void qkt(f32x16& p0, f32x16& p1, const char* K_lds, int r32, int hi, const s16x8* qr) {
    const char* kb[4];
#pragma unroll
    for (int dd = 0; dd < 4; ++dd) kb[dd] = K_lds + KB * SHM_K + KSWZ(r32, (dd * 16 + hi * 8) * 2);
#pragma unroll
    for (int d0 = 0; d0 < 8; ++d0) { const char* a = kb[d0 & 3] + (d0 >> 2) * 128;
        s16x8 b0 = *reinterpret_cast<const s16x8*>(a);
        s16x8 b1 = *reinterpret_cast<const s16x8*>(a + 32 * 256);
        p0 = mfma16(b0, qr[d0], p0);
        p1 = mfma16(b1, qr[d0], p1); }
}
template <int VB>
__device__ __forceinline__ void pv_tile(f32x16* o, int vb0, s16x8 pa0, s16x8 pa1, s16x8 pa2, s16x8 pa3) {
#define TRRD(dst, off) asm volatile("ds_read_b64_tr_b16 %0, %1 offset:%2" : "=&v"(dst) : "v"(vb0), "i"(off) : "memory")
#define PV_D0(d0) do { s16x4 l0, l1, l2, l3, h0, h1, h2, h3; constexpr int b_ = VB * SHM_V + v_rd_off(d0, 0, 0); \
        TRRD(l0, b_); TRRD(h0, b_ + 2048); TRRD(l1, b_ + 4096); TRRD(h1, b_ + 6144); TRRD(l2, b_ + 8192); TRRD(h2, b_ + 10240); TRRD(l3, b_ + 12288); TRRD(h3, b_ + 14336); \
        asm volatile("s_waitcnt lgkmcnt(0)" ::: "memory"); SBAR();   \
        o[d0] = mfma16(pa0, (s16x8){l0[0], l0[1], l0[2], l0[3], h0[0], h0[1], h0[2], h0[3]}, o[d0]);   \
        o[d0] = mfma16(pa1, (s16x8){l1[0], l1[1], l1[2], l1[3], h1[0], h1[1], h1[2], h1[3]}, o[d0]);   \
        o[d0] = mfma16(pa2, (s16x8){l2[0], l2[1], l2[2], l2[3], h2[0], h2[1], h2[2], h2[3]}, o[d0]);   \
        o[d0] = mfma16(pa3, (s16x8){l3[0], l3[1], l3[2], l3[3], h3[0], h3[1], h3[2], h3[3]}, o[d0]); } while (0)
    PV_D0(0); PV_D0(1); PV_D0(2); PV_D0(3);
#undef PV_D0
#undef TRRD
}
struct BlockRef { const char* Q; const char* K; const char* V; char* O; int P0; const char* NBQ; const char* MK;
                  int j0, nt;
                  int part;
                  char* PART; unsigned* flag; };
struct Seam { s16x8 qr[8]; };
#define LD16(base, off) (*reinterpret_cast<const s16x8*>((base) + (off)))
#define VMW() asm volatile("s_waitcnt vmcnt(0)" ::: "memory")
#define VMWN(n) asm volatile("s_waitcnt vmcnt(%0)" :: "i"(n) : "memory")
#define SLOAD_H(Kp, Vp, k0) do { const char* vb_ = (Vp) + (size_t)(k0) * (D * 2); const char* kb_ = (Kp) + (size_t)(k0) * (D * 2); \
        st_v0 = LD16(vb_, st_off); st_v1 = LD16(vb_ + 32 * D * 2, st_off); st_k0 = LD16(kb_, st_off); st_k1 = LD16(kb_ + 32 * D * 2, st_off); } while (0)
#define SWRITE_HK(bf) do { *(s16x8*)(K_lds + (bf) * SHM_K + kws) = st_k0; *(s16x8*)(K_lds + (bf) * SHM_K + kws + 32 * 256) = st_k1; } while (0)
#define SWRITE_HV(bf) do { *(s16x8*)(V_lds + (bf) * SHM_V + vst0) = st_v0; *(s16x8*)(V_lds + (bf) * SHM_V + vst1) = st_v1; } while (0)
#define SWRITE_H(bf) do { SWRITE_HV(bf); SWRITE_HK(bf); } while (0)
__device__ __forceinline__ void prime(const BlockRef& cur, char* lds, Seam& S, int wv) {
    int tid = wv * 64 + lane_id(); asm volatile("" : "+v"(tid));
    const int wid = __builtin_amdgcn_readfirstlane(tid >> 6), lane = tid & 63, r32 = lane & 31, hi = lane >> 5;
    const unsigned q_off = (unsigned)((wid * QBLK + r32) * D + hi * 8) * 2u;
#pragma unroll
    for (int d0 = 0; d0 < 8; ++d0) S.qr[d0] = LD16(cur.Q + d0 * 32, q_off);
}
template <bool MIXB, int ROLE>
__device__ __forceinline__ void block(const BlockRef& cur, const BlockRef& nxt, char* lds, Seam& S, int wv) {
    constexpr bool CONS = ROLE == 2;
    int tid = wv * 64 + lane_id(); asm volatile("" : "+v"(tid));
    const int wid = __builtin_amdgcn_readfirstlane(tid >> 6), lane = tid & 63, r32 = lane & 31, hi = lane >> 5;
    int NT = cur.nt, J0 = cur.j0;
    const int qlo = cur.P0 + wid * QBLK, qm = qlo + r32 - 4 * hi;
    char* V_lds = lds; char* K_lds = lds + 2 * SHM_V;
    float* wsf = (float*)(lds + 2 * SHM_V + 2 * SHM_K) + wid * 64; float* li_l = wsf, * al_l = wsf + 32;
    float m_reg = -1e30f, l_reg = 0; f32x16 o[4] = {};
    const int sr = tid >> 4, sc = (tid & 15) * 8, vst0 = v_st(sr, sc), vst1 = v_st(32 + sr, sc), kws = KSWZ(sr, sc * 2);
    const int vb0 = (int)(uintptr_t)V_lds + v_rd_base(lane);
    const unsigned st_off = (unsigned)(sr * D + sc) * 2u, q_off = (unsigned)((wid * QBLK + r32) * D + hi * 8) * 2u;
    const unsigned nb_off = (unsigned)hi * 16u, mk_off = (unsigned)(wid * QBLK + r32) * 512u;
    const char* Kh = cur.K; const char* Vh = cur.V;
    const char* bias_l = lds + LDS_NEED;
    if (MIXB) {
        float* cs = (float*)bias_l; float* wtot = (float*)(lds + LDS_NEED + 16384);
        const int L = cur.P0 + QB; const float* lf = (const float*)cur.NBQ;
        float v[8];
        if (8 * tid < L) { const f32x4 a = *(const f32x4*)(lf + 8 * tid), b4 = *(const f32x4*)(lf + 8 * tid + 4); v[0] = a[0]; v[1] = a[1]; v[2] = a[2]; v[3] = a[3]; v[4] = b4[0]; v[5] = b4[1]; v[6] = b4[2]; v[7] = b4[3]; }
        else {
#pragma unroll
            for (int i = 0; i < 8; ++i) v[i] = 0.f; }
#pragma unroll
        for (int i = 1; i < 8; ++i) v[i] += v[i - 1];
        float inc = v[7];
#pragma unroll
        for (int o_ = 1; o_ < 64; o_ <<= 1) { const float nb = __shfl_up(inc, o_); if (lane >= o_) inc += nb; }
        if (lane == 63) wtot[wid] = inc;
        __syncthreads();
        float base = inc - v[7];
#pragma unroll
        for (int w_ = 0; w_ < 7; ++w_) base += (w_ < wid) ? wtot[w_] : 0.f;
        if (8 * tid < L) {
#pragma unroll
            for (int i = 0; i < 8; ++i) cs[8 * tid + i] = (base + v[i]) * -11.313708498984761f; }
        __syncthreads();
        { const float qk2 = __int_as_float(cur.j0);
          const int s_ = 64 * lane + 63; const float dc = (s_ < cur.P0) ? (cs[s_] - cs[cur.P0]) * SCALE : 0.f;
          const bool keep = (s_ >= cur.P0) || (qk2 + dc >= -40.0f);
          J0 = __builtin_ctzll(__ballot(keep)); NT = cur.P0 / KVBLK + 4 - J0; }
        const float nbref = cs[L - 1];
        __syncthreads();
        for (int i = J0 * KVBLK + tid; i < L; i += NW * 64) cs[i] -= nbref;
        __syncthreads(); }
#define RESC(a) do { if (__any((a) < 1.f)) { if (hi == 0) al_l[r32] = (a); asm volatile("s_waitcnt lgkmcnt(0)" ::: "memory");              \
                     for (int d_ = 0; d_ < 4; ++d_) for (int r = 0; r < 16; ++r) o[d_][r] *= al_l[crow(r, hi)]; } } while (0)
#define KBASE(t) ((J0 + (t)) * KVBLK)
#define MKW(t) (*(const u64*)(cur.MK + (size_t)(J0 + (t)) * 8 + mk_off))
#define PINIT(P0_, P1_, t, MW_) do { if (MIXB) { const char* nb_ = bias_l + KBASE(t) * 4 + nb_off; _Pragma("unroll") for (int g_ = 0; g_ < 4; ++g_) { \
            const f32x4 b0_ = *(const f32x4*)(nb_ + 32 * g_), b1_ = *(const f32x4*)(nb_ + 128 + 32 * g_); \
            _Pragma("unroll") for (int j_ = 0; j_ < 4; ++j_) { P0_[4 * g_ + j_] = b0_[j_]; P1_[4 * g_ + j_] = b1_[j_]; } } } else { const u64 w_ = (MW_); const unsigned lo_ = (unsigned)w_ >> (4 * hi), up_ = (unsigned)(w_ >> 32) >> (4 * hi); \
            _Pragma("unroll") for (int r_ = 0; r_ < 16; ++r_) { const int c_ = (r_ & 3) + 8 * (r_ >> 2); \
                P0_[r_] = __uint_as_float((((lo_ >> c_) & 1u) - 1u) & 0xff800000u); P1_[r_] = __uint_as_float((((up_ >> c_) & 1u) - 1u) & 0xff800000u); } } } while (0)
#define MASKT(P0_, P1_, t, MW_) do { if (MIXB) { const int kb_ = KBASE(t); if (kb_ + KVBLK - 1 > qlo) mask_causal(P0_, P1_, qm - kb_); } } while (0)
    f32x16 pA0, pA1, pB0, pB1; float mnA, mnB, alA, alB; s16x8 pa0, pa1, pa2, pa3;
    u64 mwA = 0, mwB = 0;
    if (!MIXB) { mwA = MKW(0); if (NT > 1) mwB = MKW(1); }
    PINIT(pA0, pA1, 0, mwA); if (!MIXB) { if (NT > 2) mwA = MKW(2); }
    if (NT > 1) { PINIT(pB0, pB1, 1, mwB); if (!MIXB) { if (NT > 3) mwB = MKW(3); } }
    s16x8 st_v0, st_v1, st_k0, st_k1;
    SLOAD_H(Kh, Vh, KBASE(0)); VMW(); SWRITE_HK(0); SWRITE_HV(0); SBAR();
    __syncthreads();
    if (NT > 1) SLOAD_H(Kh, Vh, KBASE(1));
    SBAR(); qkt<0>(pA0, pA1, K_lds, r32, hi, S.qr);
    MASKT(pA0, pA1, 0, mwA);
    partialSM(pA0, pA1, m_reg, mnA, alA);
    if (NT > 1) { VMW(); SWRITE_H(1); }
    __syncthreads();
#define HALF_STEP(PX0, PX1, mnX, alX, MWX, PY0, PY1, alY, MWY, t, KB, VB, SB) do {                                               \
        SBAR(); qkt<KB>(PX0, PX1, K_lds, r32, hi, S.qr);                                                                      \
        finishSM(PY0, PY1, alY, l_reg, pa0, pa1, pa2, pa3); SBAR();                                                           \
        if ((t) + 1 < NT) { PINIT(PY0, PY1, (t) + 1, MWY); if (!MIXB) { if ((t) + 3 < NT) MWY = MKW((t) + 3); } SLOAD_H(Kh, Vh, KBASE((t) + 1)); SBAR(); }                             \
        pv_tile<VB>(o, vb0, pa0, pa1, pa2, pa3); MASKT(PX0, PX1, (t), MWX); \
        partialSM(PX0, PX1, m_reg, mnX, alX);                                                                                 \
        __syncthreads();                                                                                                      \
        if ((t) + 1 < NT) { VMW(); SWRITE_H(SB); }                                                                            \
        RESC(alX); __syncthreads(); } while (0)
    for (int t = 1; t + 1 < NT; t += 2) {
        HALF_STEP(pB0, pB1, mnB, alB, mwB, pA0, pA1, alA, mwA, t, 1, 0, 0);
        HALF_STEP(pA0, pA1, mnA, alA, mwA, pB0, pB1, alB, mwB, t + 1, 0, 1, 1);
    }
    const bool even = (NT & 1) == 0;
    if (even) { SBAR(); qkt<1>(pB0, pB1, K_lds, r32, hi, S.qr); SBAR(); }
    if (!CONS) {
#pragma unroll
        for (int d0 = 0; d0 < 8; ++d0) S.qr[d0] = LD16(nxt.Q + d0 * 32, q_off); }
    SBAR();
    finishSM(pA0, pA1, alA, l_reg, pa0, pa1, pa2, pa3); SBAR();
    pv_tile<0>(o, vb0, pa0, pa1, pa2, pa3);
    if (even) { MASKT(pB0, pB1, NT - 1, mwB); partialSM(pB0, pB1, m_reg, mnB, alB); __syncthreads(); RESC(alB);
        finishSM(pB0, pB1, alB, l_reg, pa0, pa1, pa2, pa3); SBAR(); pv_tile<1>(o, vb0, pa0, pa1, pa2, pa3); }
    constexpr float C2E = 1.4426950408889634f * SCALE;
    if (!CONS && cur.part == 1) {
        float* po = (float*)cur.PART + (size_t)wid * (64 * 64) + lane;
#pragma unroll
        for (int d0 = 0; d0 < 4; ++d0)
#pragma unroll
            for (int r = 0; r < 16; ++r) po[(d0 * 16 + r) * 64] = o[d0][r];
        float* pml = (float*)cur.PART + 8 * 64 * 64 + wid * 128;
        pml[lane] = m_reg; pml[64 + lane] = l_reg;
        asm volatile("s_waitcnt vmcnt(0)" ::: "memory");
        __syncthreads();
        if (tid == 0) { __builtin_amdgcn_fence(__ATOMIC_RELEASE, "agent"); asm volatile("s_waitcnt vmcnt(0)" ::: "memory"); __hip_atomic_store(cur.flag, 1u, __ATOMIC_RELAXED, __HIP_MEMORY_SCOPE_AGENT); }
    } else {
        float a_me = 1.f;
        if (CONS) {
            if (tid == 0) { unsigned spins = 0; while (__hip_atomic_load(cur.flag, __ATOMIC_RELAXED, __HIP_MEMORY_SCOPE_AGENT) == 0u) { __builtin_amdgcn_s_sleep(4); if (++spins > (1u << 22)) break; }
                __builtin_amdgcn_fence(__ATOMIC_ACQUIRE, "agent"); asm volatile("s_waitcnt vmcnt(0)" ::: "memory"); }
            __syncthreads();
            const float* pml = (const float*)cur.PART + 8 * 64 * 64 + wid * 128;
            const float m2 = pml[lane], l2 = pml[64 + lane];
            const float mm = fmaxf(m_reg, m2); a_me = __builtin_amdgcn_exp2f((m_reg - mm) * C2E); const float a_ot = __builtin_amdgcn_exp2f((m2 - mm) * C2E);
            l_reg = l_reg * a_me + l2 * a_ot;
            if (hi == 0) { li_l[r32] = a_me; al_l[r32] = a_ot; } asm volatile("s_waitcnt lgkmcnt(0)" ::: "memory");
            const float* po = (const float*)cur.PART + (size_t)wid * (64 * 64) + lane;
#pragma unroll
            for (int r = 0; r < 16; ++r) { const float fa = li_l[crow(r, hi)], fb = al_l[crow(r, hi)];
#pragma unroll
                for (int d0 = 0; d0 < 4; ++d0) o[d0][r] = o[d0][r] * fa + po[(d0 * 16 + r) * 64] * fb; }
            asm volatile("s_waitcnt lgkmcnt(0)" ::: "memory");
        }
        if (hi == 0) li_l[r32] = l_reg; asm volatile("s_waitcnt lgkmcnt(0)" ::: "memory");
        float rli[16];
#pragma unroll
        for (int r = 0; r < 16; ++r) rli[r] = __builtin_amdgcn_rcpf(li_l[crow(r, hi)]);
        const unsigned o_off = (unsigned)((wid * QBLK + 4 * hi) * 1024 + r32) * 2u;
#pragma unroll
        for (int r = 0; r < 16; ++r) {
#pragma unroll
            for (int d0 = 0; d0 < 4; ++d0) { const float v = o[d0][r] * rli[r];
                const float vn = __shfl_xor(v, 1);
                if ((r32 & 1) == 0) *(unsigned*)(cur.O + (size_t)(((r & 3) + 8 * (r >> 2)) * 2048 + d0 * 64) + o_off) = cvtpk(v, vn); } }
    }
    __syncthreads();
#undef RESC
#undef KBASE
#undef PINIT
#undef MKW
#undef MASKT
#undef HALF_STEP
}
#undef LD16
#undef VMW
#undef VMWN
#undef SLOAD_H
#undef SWRITE_HK
#undef SWRITE_HV
#undef SWRITE_H
constexpr int SCHED_MAXI = 3;
__device__ const short SCHED[256][3] = {
  {6752, 242, -1},
  {6768, 498, -1},
  {6784, 754, -1},
  {6800, 1010, -1},
  {6816, 1266, -1},
  {6832, 1522, -1},
  {6848, 1778, -1},
  {6864, 2034, -1},
  {6880, 2290, -1},
  {6896, 2546, -1},
  {6944, 2802, -1},
  {6960, 3058, -1},
  {6976, 3314, -1},
  {6992, 3570, -1},
  {7008, 3826, -1},
  {7024, 4082, -1},
  {5856, 226, -1},
  {5872, 482, -1},
  {5920, 738, -1},
  {5936, 994, -1},
  {5952, 1250, -1},
  {5968, 1506, -1},
  {5984, 1762, -1},
  {6000, 2018, -1},
  {6016, 2274, -1},
  {6032, 2530, -1},
  {6048, 2786, -1},
  {6064, 3042, -1},
  {6080, 3298, -1},
  {6096, 3554, -1},
  {6112, 3810, -1},
  {6128, 4066, -1},
  {2064, 5280, 210},
  {5296, 6160, 466},
  {2320, 5312, 722},
  {5328, 6416, 978},
  {2576, 5344, 1234},
  {5360, 6672, 1490},
  {2832, 5408, 1746},
  {5424, 6928, 2002},
  {3088, 5440, 2258},
  {5456, 7184, 2514},
  {3344, 5472, 2770},
  {5488, 7440, 3026},
  {3600, 5504, 3282},
  {5520, 7696, 3538},
  {3856, 5536, 3794},
  {5552, 7952, 4050},
  {4416, 7328, 194},
  {4432, 7344, 450},
  {4448, 7360, 706},
  {4464, 7376, 962},
  {4480, 7392, 1218},
  {4496, 7408, 1474},
  {4512, 7456, 1730},
  {4528, 7472, 1986},
  {4544, 7488, 2242},
  {4560, 7504, 2498},
  {4576, 7520, 2754},
  {4592, 7536, 3010},
  {4640, 7552, 3266},
  {4656, 7568, 3522},
  {4672, 7584, 3778},
  {4688, 7600, 4034},
  {32, 7616, 178},
  {288, 7632, 434},
  {544, 7648, 690},
  {800, 7664, 946},
  {1056, 7712, 1202},
  {1312, 7728, 1458},
  {1568, 7744, 1714},
  {1824, 7760, 1970},
  {2080, 7776, 2226},
  {2336, 7792, 2482},
  {2592, 7808, 2738},
  {2848, 7824, 2994},
  {3104, 7840, 3250},
  {3360, 7856, 3506},
  {3616, 7872, 3762},
  {3872, 7888, 4018},
  {2112, 162, -1},
  {2193, 418, -1},
  {2368, 674, -1},
  {2449, 930, -1},
  {2624, 1186, -1},
  {2705, 1442, -1},
  {2880, 1698, -1},
  {2961, 1954, -1},
  {3136, 2210, -1},
  {3217, 2466, -1},
  {3392, 2722, -1},
  {3473, 2978, -1},
  {3648, 3234, -1},
  {3729, 3490, -1},
  {3904, 3746, -1},
  {3985, 4002, -1},
  {64, 146, -1},
  {145, 402, -1},
  {320, 658, -1},
  {401, 914, -1},
  {576, 1170, -1},
  {657, 1426, -1},
  {832, 1682, -1},
  {913, 1938, -1},
  {1088, 2194, -1},
  {1169, 2450, -1},
  {1344, 2706, -1},
  {1425, 2962, -1},
  {1600, 3218, -1},
  {1681, 3474, -1},
  {1856, 3730, -1},
  {1937, 3986, -1},
  {161, 130, -1},
  {417, 386, -1},
  {673, 642, -1},
  {929, 898, -1},
  {1185, 1154, -1},
  {1441, 1410, -1},
  {1697, 1666, -1},
  {1953, 1922, -1},
  {2209, 2178, -1},
  {2465, 2434, -1},
  {2721, 2690, -1},
  {2977, 2946, -1},
  {3233, 3202, -1},
  {3489, 3458, -1},
  {3745, 3714, -1},
  {4001, 3970, -1},
  {112, 6176, -1},
  {241, 6192, -1},
  {368, 6208, -1},
  {497, 6224, -1},
  {624, 6240, -1},
  {753, 6256, -1},
  {880, 6272, -1},
  {1009, 6288, -1},
  {1136, 6304, -1},
  {1265, 6320, -1},
  {1392, 6336, -1},
  {1521, 6352, -1},
  {1648, 6368, -1},
  {1777, 6384, -1},
  {1904, 6432, -1},
  {2033, 6448, -1},
  {2160, 6464, -1},
  {2289, 6480, -1},
  {2416, 6496, -1},
  {2545, 6512, -1},
  {2672, 6528, -1},
  {2801, 6544, -1},
  {2928, 6560, -1},
  {3057, 6576, -1},
  {3184, 6592, -1},
  {3313, 6608, -1},
  {3440, 6624, -1},
  {3569, 6640, -1},
  {3696, 6688, -1},
  {3825, 6704, -1},
  {3952, 6720, -1},
  {4081, 6736, -1},
  {225, 0, 5568},
  {481, 5584, 4096},
  {737, 256, 5600},
  {993, 5616, 4352},
  {1249, 512, 5664},
  {1505, 5680, 4608},
  {1761, 768, 5696},
  {2017, 5712, 4864},
  {2273, 1024, 5728},
  {2529, 5744, 5120},
  {2785, 1280, 5760},
  {3041, 5776, 5376},
  {3297, 1536, 5792},
  {3553, 5808, 5632},
  {3809, 1792, 5824},
  {4065, 5840, 5888},
  {96, 4704, 7904},
  {209, 4720, 7920},
  {352, 4736, 7968},
  {465, 4752, 7984},
  {608, 4768, 8000},
  {721, 4784, 8016},
  {864, 4800, 8032},
  {977, 4816, 8048},
  {1120, 4832, 8064},
  {1233, 4848, 8080},
  {1376, 4896, 8096},
  {1489, 4912, 8112},
  {1632, 4928, 8128},
  {1745, 4944, 8144},
  {1888, 4960, 8160},
  {2001, 4976, 8176},
  {2144, 16, 4992},
  {2257, 5008, 4112},
  {2400, 272, 5024},
  {2513, 5040, 4368},
  {2656, 528, 5056},
  {2769, 5072, 4624},
  {2912, 784, 5088},
  {3025, 5104, 4880},
  {3168, 1040, 5152},
  {3281, 5168, 5136},
  {3424, 1296, 5184},
  {3537, 5200, 5392},
  {3680, 1552, 5216},
  {3793, 5232, 5648},
  {3936, 1808, 5248},
  {4049, 5264, 5904},
  {193, 4128, 7040},
  {449, 4144, 7056},
  {705, 4160, 7072},
  {961, 4176, 7088},
  {1217, 4192, 7104},
  {1473, 4208, 7120},
  {1729, 4224, 7136},
  {1985, 4240, 7152},
  {2241, 4256, 7200},
  {2497, 4272, 7216},
  {2753, 4288, 7232},
  {3009, 4304, 7248},
  {3265, 4320, 7264},
  {3521, 4336, 7280},
  {3777, 4384, 7296},
  {4033, 4400, 7312},
  {129, 80, -1},
  {177, 385, -1},
  {641, 336, -1},
  {433, 897, -1},
  {1153, 592, -1},
  {689, 1409, -1},
  {1665, 848, -1},
  {945, 1921, -1},
  {2177, 1104, -1},
  {1201, 2433, -1},
  {2689, 1360, -1},
  {1457, 2945, -1},
  {3201, 1616, -1},
  {1713, 3457, -1},
  {3713, 1872, -1},
  {1969, 3969, -1},
  {2128, 48, 2048},
  {2225, 304, 6144},
  {2384, 560, 2304},
  {2481, 816, 6400},
  {2640, 1072, 2560},
  {2737, 1328, 6656},
  {2896, 1584, 2816},
  {2993, 1840, 6912},
  {3152, 2096, 3072},
  {3249, 2352, 7168},
  {3408, 2608, 3328},
  {3505, 2864, 7424},
  {3664, 3120, 3584},
  {3761, 3376, 7680},
  {3920, 3632, 3840},
  {4017, 3888, 7936},
};

__device__ __forceinline__ BlockRef make_ref(int code, unsigned char* ws) {
    const bool mixb = (code >> 12) != 0; const int bh = (code >> 8) & 15, qb = (code >> 4) & 15, part = code & 15;
    const int b = bh >> 3, h = bh & 7, kvh = mixb ? bh : (b * HAKV + (h >> 2));
    BlockRef r;
    r.Q = (const char*)ws + (mixb ? WS_QB : WS_QA) + ((size_t)bh * T + (size_t)qb * QB) * D * 2;
    r.K = (const char*)ws + (mixb ? WS_KB : WS_KA) + (size_t)kvh * T * D * 2;
    r.V = (const char*)ws + (mixb ? WS_VB : WS_VA) + (size_t)kvh * T * D * 2;
    r.O = (char*)ws + (mixb ? WS_OUTB : WS_OUTA) + ((size_t)(b * T + qb * QB) * 1024 + h * D) * 2;
    r.P0 = qb * QB;
    r.NBQ = (const char*)ws + WS_CB + (size_t)bh * T * 4;
    r.MK = (const char*)ws + WS_MASK + (size_t)(b * T + qb * QB) * 64 * 8;
    const int NTall = r.P0 / KVBLK + 4;
    r.part = part; r.j0 = 0; r.nt = NTall;
    r.PART = (char*)ws + WS_PART + (size_t)(bh * 8 + (qb & 7)) * 135168; r.flag = (unsigned*)(ws + WS_CTL) + CW_SPLIT + (bh * 8 + (qb & 7));
    if (part == 1) r.nt = NTall / 2; else if (part == 2) { r.j0 = NTall / 2; r.nt = NTall - NTall / 2; }
    if (mixb) {
        const unsigned* nrm = (const unsigned*)(ws + WS_NORM);
        const float q2 = __uint_as_float(nrm[bh * 16 + qb]), k2 = __uint_as_float(nrm[256 + bh]);
        const float qk = 2.0f * __builtin_sqrtf(q2 * k2) * SCALE;
        r.j0 = __float_as_int(qk);
        r.NBQ = (const char*)ws + WS_LOGF + (size_t)bh * T * 4;
    }
    return r;
}
__device__ __forceinline__ void run_list(int cu, unsigned char* ws, char* lds, int wv) {
    Seam S;
    int code = SCHED[cu][0];
    if (code < 0) return;
    BlockRef cur = make_ref(code, ws);
    prime(cur, lds, S, wv);
#pragma unroll 1
    for (int k = 0; k < SCHED_MAXI; ++k) {
        if ((code & 15) == 2) break;
        const int ncode = (k + 1 < SCHED_MAXI) ? SCHED[cu][k + 1] : -1;
        const BlockRef nxt = ncode >= 0 ? make_ref(ncode, ws) : cur;
        if ((code >> 12) != 0) block<true, 0>(cur, nxt, lds, S, wv); else block<false, 0>(cur, nxt, lds, S, wv);
        if (ncode < 0) return;
        cur = nxt; code = ncode;
    }
    block<false, 2>(cur, cur, lds, S, wv);
}
}


#define XB_TMO      128
#define XB_XCNT(j)  (256  + 64 * (j))
#define XB_XSUB(j)  (1280 + 64 * (j))
#define XB_XGEN(j)  (2304 + 64 * (j))
#define XB_TOP      3328
#define XB_TOPGEN   3392
#define XCD_BAR_WORDS 3456
#define XB_SPIN_CAP (1u << 24)
__device__ __forceinline__ unsigned xb_ld(unsigned* p)              { return __hip_atomic_load(p, __ATOMIC_RELAXED, __HIP_MEMORY_SCOPE_AGENT); }
__device__ __forceinline__ unsigned xb_add(unsigned* p, unsigned v) { return __hip_atomic_fetch_add(p, v, __ATOMIC_RELAXED, __HIP_MEMORY_SCOPE_AGENT); }
__device__ __forceinline__ unsigned xb_xcc_id() { return (unsigned)__builtin_amdgcn_s_getreg((3 << 11) | 20) & 0xFu; }
#define XB_SPIN(cond, bar) do { unsigned _sp = 0; while (cond) { __builtin_amdgcn_s_sleep(1); \
    if ((++_sp & 255u) == 0u) { if (xb_ld(&(bar)[XB_TMO])) break; if (_sp > XB_SPIN_CAP) { atomicAdd(&(bar)[XB_TMO], 1u); break; } } } } while (0)
struct XcdBarrier { unsigned* bar; unsigned x; volatile LAS unsigned* st; };
__device__ __forceinline__ XcdBarrier xcd_barrier_post(unsigned* bar, volatile LAS unsigned* st, int wv) {
    XcdBarrier b; b.bar = bar; b.x = xb_xcc_id(); b.st = st;
    if (wv == 0 && lane_id() == 0) (void)xb_add(&bar[XB_XCNT(b.x)], 1u);
    return b;
}
__device__ __forceinline__ void xcd_barrier_complete(unsigned* bar, unsigned x, unsigned& nloc, unsigned& nx) {
    const unsigned G = gridDim.x * gridDim.y * gridDim.z;
    unsigned sum, cnt, mine, sp = 0u;
    for (;;) {
        sum = 0u; cnt = 0u; mine = 0u;
#pragma unroll
        for (unsigned j = 0; j < 16; ++j) { const unsigned c = xb_ld(&bar[XB_XCNT(j)]); sum += c; cnt += (c > 0u) ? 1u : 0u; mine = (j == x) ? c : mine; }
        if (sum == G) break;
        __builtin_amdgcn_s_sleep(1);
        if ((++sp & 255u) == 0u) { if (xb_ld(&bar[XB_TMO])) break; if (sp > XB_SPIN_CAP) { atomicAdd(&bar[XB_TMO], 1u); break; } }
    }
    nloc = mine > 0u ? mine : 1u; nx = cnt > 0u ? cnt : 1u;
}
__device__ __forceinline__ void xcd_barrier(const XcdBarrier& b, int wv) {
    asm volatile("s_waitcnt vmcnt(0)" ::: "memory");
    __syncthreads();
    if (wv == 0 && lane_id() == 0) {
        unsigned* bar = b.bar;
        __builtin_amdgcn_s_waitcnt(0);
        unsigned nloc = b.st[0], nx = b.st[1];
        if (nloc == 0u) { xcd_barrier_complete(bar, b.x, nloc, nx); b.st[0] = nloc; b.st[1] = nx; }
        const unsigned old = xb_add(&bar[XB_XSUB(b.x)], 1u);
        const unsigned gen = old / nloc;
        if (old + 1u == (gen + 1u) * nloc) {
            __builtin_amdgcn_fence(__ATOMIC_RELEASE, "agent");
            asm volatile("s_waitcnt vmcnt(0)" ::: "memory");
            const unsigned og = xb_add(&bar[XB_TOP], 1u);
            const unsigned tg = og / nx;
            if (og + 1u == (tg + 1u) * nx) xb_add(&bar[XB_TOPGEN], 1u);
            else XB_SPIN(xb_ld(&bar[XB_TOPGEN]) == tg, bar);
            __builtin_amdgcn_fence(__ATOMIC_ACQUIRE, "agent");
            xb_add(&bar[XB_XGEN(b.x)], 1u);
            asm volatile("s_waitcnt vmcnt(0)" ::: "memory");
        } else {
            XB_SPIN(xb_ld(&bar[XB_XGEN(b.x)]) == gen, bar);
            __builtin_amdgcn_fence(__ATOMIC_ACQUIRE, "agent");
            asm volatile("s_waitcnt vmcnt(0)" ::: "memory");
        }
    }
    __syncthreads();
}

namespace cg = cooperative_groups;
#ifndef PROBE_DUP
#define PROBE_DUP 0
#endif
#define REP(k) for (int rep_ = 0; rep_ < (((PROBE_DUP) >> (k)) & 1) + 1; ++rep_)
constexpr int LDS_BYTES = pg8::STAGE_BYTES + 256;
struct Params { const float* in[17]; float* out; unsigned char* ws; };
template <class Epi>
__device__ __forceinline__ void run_gemm(LAS unsigned char* lds, const h16* A, const h16* Bt, int M, int N, int K, const Epi& e, int wv) {
    pg8::Gemm g{A, Bt, M, N, K}; pg8::StaticOrder S; S.init(M, N, (int)gridDim.x, (int)blockIdx.x);
    pg8::gemm_phase<Epi>(lds, g, S, e, wv);
}
__global__ void __launch_bounds__(512, 2) mega_fwd(Params P) {
    extern __shared__ __attribute__((aligned(16))) unsigned char lds_raw[];
    LAS unsigned char* lds = (LAS unsigned char*)lds_raw;
    const int wv = __builtin_amdgcn_readfirstlane(threadIdx.x >> 6);
    volatile LAS unsigned* bst = (volatile LAS unsigned*)(lds + pg8::STAGE_BYTES);
    if (wv == 0 && lane_id() < 2) bst[lane_id()] = 0u;
    __syncthreads();
    const XcdBarrier xbar = xcd_barrier_post((unsigned*)(P.ws + WS_CTL) + CW_BAR, bst, wv);
#define GRID_BAR() xcd_barrier(xbar, wv)
#define IDS() int lane = lane_id(); asm volatile("" : "+v"(lane)); const int wave = wv, tid = wave * 64 + lane, gw = blockIdx.x * 8 + wave, NGW = gridDim.x * 8; (void)tid; (void)gw; (void)NGW
    const float* x = P.in[0]; const float* p = P.in[1]; const int* pos = (const int*)P.in[2];
    const float* g_mix = P.in[3]; const float* w_in = P.in[4]; const float* b_f = P.in[5];
    const float* w_o_a = P.in[6]; const float* w_o_b = P.in[7]; const float* w_out = P.in[8];
    const float* g_ffn = P.in[9]; const float* w_g = P.in[10]; const float* w_u = P.in[11]; const float* w_d = P.in[12];
    const float* g_ple = P.in[13]; const float* w_pg = P.in[14]; const float* w_pp = P.in[15]; const float* g_final = P.in[16];
    unsigned char* ws = P.ws; float* out = P.out;
    float* RS = (float*)(ws + WS_RS); float* ROPE = (float*)(ws + WS_ROPE); float* CB = (float*)(ws + WS_CB); float* LOGF = (float*)(ws + WS_LOGF); u64* MASK = (u64*)(ws + WS_MASK);
    h16* WIN = (h16*)(ws + WS_WIN); h16* WOA = (h16*)(ws + WS_WOA); h16* WOB = (h16*)(ws + WS_WOB); h16* WOUT = (h16*)(ws + WS_WOUT);
    h16* WGU = (h16*)(ws + WS_WGU); h16* WDN = (h16*)(ws + WS_WDN); h16* WPG = (h16*)(ws + WS_WPG); h16* WPP = (h16*)(ws + WS_WPP);
    h16* QI = (h16*)(ws + WS_QI); h16* KI = (h16*)(ws + WS_KI); float* WI = (float*)(ws + WS_WI);
    h16* SIGA = (h16*)(ws + WS_SIGA); h16* SIGB = (h16*)(ws + WS_SIGB);
    h16* OUTA = (h16*)(ws + WS_OUTA); h16* OUTB = (h16*)(ws + WS_OUTB); h16* P16 = (h16*)(ws + WS_P16);
    h16* X3H = (h16*)(ws + WS_SIGA);
    h16* MIXED = (h16*)(ws + WS_MIXED); h16* H2 = (h16*)(ws + WS_H2); h16* ACT = (h16*)(ws + WS_ACT); h16* PP = (h16*)(ws + WS_PP);
    h16* H1 = (h16*)P.out;

    REP(0) { IDS(); LAS float* scr = (LAS float*)(lds + wave * 8448);
      ph_transpose<1>(w_in, nullptr, nullptr, DM, N_IN, WIN, N_INP, scr, gw, NGW, lane);
      ph_transpose<2>(w_g, w_u, g_ffn, DM, DFF, WGU, 2 * DFF, scr, gw, NGW, lane);
      ph_rope(pos, ROPE, blockIdx.x * 512 + tid, gridDim.x * 512);
      for (int i = blockIdx.x * 512 + tid; i < 3 * MTOK; i += gridDim.x * 512) RS[i] = 0.f;
      for (int i = blockIdx.x * 512 + tid; i < 272; i += gridDim.x * 512) ((unsigned*)(ws + WS_NORM))[i] = 0u;
      ph_rmsnorm<false>(x, g_mix, H1, nullptr, gw, NGW, lane);
    }
    GRID_BAR();
    REP(1) { EpiInProj e{ws, b_f}; run_gemm(lds, H1, WIN, MTOK, N_INP, DM, e, wv); }
    { const int fi = ((MTOK / 256) * (N_INP / 256)) % (int)gridDim.x;
    if ((int)blockIdx.x >= fi) { IDS(); (void)tid; (void)gw; (void)NGW; LAS float* scr = (LAS float*)(lds + wave * 8448); const int qw = ((int)blockIdx.x - fi) * 8 + wave, nq = ((int)gridDim.x - fi) * 8;
      ph_transpose<0>(w_o_a, nullptr, nullptr, 1024, DM, WOA, DM, scr, qw, nq, lane);
      ph_transpose<0>(w_o_b, nullptr, nullptr, 1024, DM, WOB, DM, scr, qw, nq, lane);
      ph_transpose<0>(w_out, nullptr, nullptr, DM, DM, WOUT, DM, scr, qw, nq, lane); } }
    GRID_BAR();
    REP(2) { IDS();
      for (int r0 = gw * 16; r0 < 16 * T; r0 += NGW * 16) {
          const int row = r0 + (lane >> 2); float sq = 0.f, sk = 0.f;
          const h16x8* qp = (const h16x8*)((const h16*)(ws + WS_QB) + (size_t)row * HD + (lane & 3) * 32); const h16x8* kp = (const h16x8*)((const h16*)(ws + WS_KB) + (size_t)row * HD + (lane & 3) * 32);
#pragma unroll
          for (int i = 0; i < 4; ++i) { const h16x8 a = qp[i], bq = kp[i];
#pragma unroll
              for (int e = 0; e < 8; ++e) { sq = fmaf((float)a[e], (float)a[e], sq); sk = fmaf((float)bq[e], (float)bq[e], sk); } }
#pragma unroll
          for (int o = 1; o < 64; o <<= 1) { if (o < 4) { sq += __shfl_xor(sq, o); sk += __shfl_xor(sk, o); } else { sq = fmaxf(sq, __shfl_xor(sq, o)); sk = fmaxf(sk, __shfl_xor(sk, o)); } }
          if (lane == 0) { unsigned* nrm = (unsigned*)(ws + WS_NORM); atomicMax(nrm + (r0 >> 8), __float_as_uint(sq)); atomicMax(nrm + 256 + (r0 >> 12), __float_as_uint(sk)); }
      }
      for (int it = blockIdx.x; it < 256; it += gridDim.x) { const int bb = it & 1, gi = it >> 1;
#pragma unroll 1
          for (int pass = 0; pass < 2; ++pass) idx::run_group(ws, (char*)lds_raw, (unsigned*)out + (size_t)blockIdx.x * 16 * T, bb, pass ? 255 - gi : gi, wv); }
      for (int i = blockIdx.x * 512 + tid; i < MTOK * DPLE / 4; i += gridDim.x * 512) st4h(P16 + 4 * (size_t)i, *((const f32x4*)p + i));
    }
    GRID_BAR();
    REP(3) for (int cu = blockIdx.x; cu < 256; cu += gridDim.x) att::run_list(cu, ws, (char*)lds_raw, wv);
    GRID_BAR();
    REP(4) { { EpiGate<true> e{SIGA, MIXED}; run_gemm(lds, OUTA, WOA, MTOK, DM, 1024, e, wv); }
    { EpiGate<false> e{SIGB, MIXED}; run_gemm(lds, OUTB, WOB, MTOK, DM, 1024, e, wv); } }
    GRID_BAR();
    REP(5) { EpiResidNorm<true> e{x, H2, RS}; run_gemm(lds, MIXED, WOUT, MTOK, DM, DM, e, wv); }
    GRID_BAR();
    REP(6) { EpiSwiGLU e{ACT, RS}; run_gemm(lds, H2, WGU, MTOK, 2 * DFF, DM, e, wv); }
    { const int fi = ((MTOK / 256) * (2 * DFF / 256)) % (int)gridDim.x;
    if ((int)blockIdx.x >= fi) { IDS(); (void)tid; (void)gw; (void)NGW; LAS float* scr = (LAS float*)(lds + wave * 8448); const int qw = ((int)blockIdx.x - fi) * 8 + wave, nq = ((int)gridDim.x - fi) * 8;
      ph_transpose<0>(w_d, nullptr, nullptr, DFF, DM, WDN, DM, scr, qw, nq, lane);
      ph_transpose<0>(w_pg, nullptr, g_ple, DM, DM, WPG, DM, scr, qw, nq, lane);
      ph_transpose<0>(w_pp, nullptr, nullptr, DPLE, DM, WPP, DM, scr, qw, nq, lane); } }
    GRID_BAR();
    { EpiResidNorm<false> e{nullptr, H2, RS + MTOK}; run_gemm(lds, ACT, WDN, MTOK, DM, DFF, e, wv); }
    GRID_BAR();
    { EpiStoreH e{PP, DM}; run_gemm(lds, P16, WPP, MTOK, DM, DPLE, e, wv); }
    if (gridDim.x == (MTOK / 256) * (DM / 256)) {
        EpiPLEFinal e{PP, H2, out, RS + MTOK, RS + 2 * MTOK, g_final, (unsigned*)(ws + WS_CTL) + CW_PANEL}; run_gemm(lds, H2, WPG, MTOK, DM, DM, e, wv);
    } else {
        { EpiPLE e{PP, H2, X3H, RS + MTOK, RS + 2 * MTOK}; run_gemm(lds, H2, WPG, MTOK, DM, DM, e, wv); }
        GRID_BAR();
        { IDS(); ph_final(X3H, out, g_final, RS + 2 * MTOK, gw, NGW, lane); }
    }
#undef IDS
#undef GRID_BAR
}

extern "C" void kernel_launch(void* const* d_in, const int* in_sizes, int n_in, void* d_out, int out_size, void* d_ws, size_t ws_size, hipStream_t stream) {
    if (n_in != 17 || out_size != MTOK * DM || ws_size < WS_END) { fprintf(stderr, "kernel_launch: unexpected shapes / workspace (%d inputs, out %d, ws %zu)\n", n_in, out_size, ws_size); return; }
    static int grid_blocks = 0;
    if (!grid_blocks) {
        int dev = 0, cus = 0, per_cu = 0;
        (void)hipGetDevice(&dev);
        (void)hipDeviceGetAttribute(&cus, hipDeviceAttributeMultiprocessorCount, dev);
        (void)hipFuncSetAttribute((const void*)mega_fwd, hipFuncAttributeMaxDynamicSharedMemorySize, LDS_BYTES);
        (void)hipOccupancyMaxActiveBlocksPerMultiprocessor(&per_cu, (const void*)mega_fwd, 512, LDS_BYTES);
        if (per_cu < 1) { fprintf(stderr, "kernel_launch: occupancy query says %d blocks per CU\n", per_cu); per_cu = 1; }
        if (per_cu > 1) per_cu = 1;
        grid_blocks = cus * per_cu;
    }
    (void)hipMemsetAsync((char*)d_ws + WS_CTL, 0, 64 * 1024, stream);
    Params prm{};
    for (int i = 0; i < 17; ++i) prm.in[i] = (const float*)d_in[i];
    prm.out = (float*)d_out; prm.ws = (unsigned char*)d_ws;
    void* args[] = {&prm};
    hipError_t e = hipLaunchCooperativeKernel((const void*)mega_fwd, dim3(grid_blocks), dim3(512), args, LDS_BYTES, stream);
    if (e != hipSuccess) fprintf(stderr, "cooperative launch failed: %s (grid %d)\n", hipGetErrorString(e), grid_blocks);
}
```

```cpp
#include <hip/hip_runtime.h>
#include <hip/hip_cooperative_groups.h>
#include <stdint.h>
#include <cstdio>

#define LAS __attribute__((address_space(3)))
typedef _Float16 h16;
typedef _Float16 h16x8 __attribute__((ext_vector_type(8)));
typedef _Float16 h16x4 __attribute__((ext_vector_type(4)));
typedef _Float16 h16x2 __attribute__((ext_vector_type(2)));
typedef float f32x4 __attribute__((ext_vector_type(4)));
typedef float f32x2 __attribute__((ext_vector_type(2)));
typedef unsigned u32x4 __attribute__((ext_vector_type(4)));
typedef unsigned u32x2 __attribute__((ext_vector_type(2)));
typedef unsigned long long u64;
__device__ __forceinline__ int lane_id() { int r; asm volatile("v_mbcnt_lo_u32_b32 %0, -1, 0\n\tv_mbcnt_hi_u32_b32 %0, -1, %0" : "=v"(r)); return r; }

constexpr int NBATCH = 2, T = 4096, MTOK = NBATCH * T, DM = 2048;
constexpr int HA = 8, HAKV = 2, HIDX = 16, DIDX = 64, HB = 8, HD = 128;
constexpr int N_IN = 9816, N_INP = 9984, DFF = 5632, DPLE = 256, TOPK = 256;
constexpr float EPS = 1e-6f;
constexpr float ATT_SCALE = 0.08838834764831845f;

constexpr size_t MiB = 1u << 20;
constexpr size_t WS_CTL = 0;
constexpr size_t WS_RS = 512 * 1024;
constexpr size_t WS_NORM = 640 * 1024;
constexpr size_t WS_ROPE = 1 * MiB;
constexpr size_t WS_CB = 3 * MiB;
constexpr size_t WS_LOGF = 3 * MiB + 512 * 1024;
constexpr size_t WS_MASK = 4 * MiB;
constexpr size_t WS_WIN = 8 * MiB;
constexpr size_t WS_OUTA = 8 * MiB, WS_OUTB = 24 * MiB, WS_P16 = 40 * MiB;
constexpr size_t WS_WOA = 47 * MiB, WS_WOB = 51 * MiB, WS_WOUT = 55 * MiB, WS_WGU = 63 * MiB, WS_WDN = 107 * MiB, WS_WPG = 129 * MiB, WS_WPP = 137 * MiB;
constexpr size_t WS_QA = 138 * MiB, WS_KA = 154 * MiB, WS_VA = 158 * MiB, WS_QI = 162 * MiB, WS_KI = 178 * MiB, WS_WI = 179 * MiB;
constexpr size_t WS_QB = 180 * MiB, WS_KB = 196 * MiB, WS_VB = 212 * MiB, WS_SIGA = 228 * MiB, WS_SIGB = 260 * MiB, WS_PART = 292 * MiB, WS_END = 328 * MiB;
constexpr size_t WS_MIXED = WS_QB;
constexpr size_t WS_H2 = WS_QA;
constexpr size_t WS_ACT = WS_QB;
constexpr size_t WS_PP = WS_QB;
constexpr int CW_QUEUE = 2048;
constexpr int CW_SPLIT = 12288;
constexpr int CW_PANEL = 8192;
constexpr int CW_BAR = 4096;

namespace pg8 {
constexpr int BM = 256, BK = 64, HALF = 128, HTB = HALF * BK * 2, STAGE_BYTES = 8 * HTB, NXCD = 8, WGM = 4;
__host__ __device__ __forceinline__ int lds_byte(int r, int c) { const int st = (r >> 4) * 2 + (c >> 5), rr = r & 15, cc = c & 31, ob = rr * 64 + cc * 2; return st * 1024 + (ob ^ (((ob >> 9) & 1) << 5)); }
__host__ __device__ __forceinline__ int perm32(int rho) { const int n = rho >> 4, i = rho & 15; return 8 * (i >> 2) + 4 * n + (i & 3); }
__host__ __device__ __forceinline__ void stage_rc(int b, int& R, int& C) { const int st = b / 1024, sb = b % 1024, swz = sb ^ (((sb >> 9) & 1) << 5); R = (st >> 1) * 16 + swz / 64; C = (st & 1) * 32 + (swz % 64) / 2; }
struct Unit { int pm, pn; };
struct Gemm { const h16* A; const h16* Bt; int M, N, K; };
struct StaticOrder {
    int nM, nN, nwg, G, c;
    __host__ __device__ void init(int M, int N, int G_, int c_) { nM = M / BM; nN = N / BM; nwg = nM * nN; G = G_; c = c_; }
    __host__ __device__ bool next(int i, Unit& u) const {
        const long L = (long)i * G + c; if (L >= nwg) return false;
        int wgid = (int)L; { const int q = nwg / NXCD, r = nwg % NXCD, xcd = wgid % NXCD, off = wgid / NXCD; wgid = (xcd < r ? xcd * (q + 1) : r * (q + 1) + (xcd - r) * q) + off; }
        const int nig = WGM * nN, gid = wgid / nig, fm = gid * WGM, gsz = (nM - fm) < WGM ? (nM - fm) : WGM;
        u.pm = fm + ((wgid % nig) % gsz); u.pn = (wgid % nig) / gsz; return true;
    }
};
template <class Epi>
__device__ __forceinline__ void gemm_phase(LAS unsigned char* lds, const Gemm g, const StaticOrder& S, const Epi& E, int wv) {
    int tid = wv * 64 + lane_id(); asm volatile("" : "+v"(tid));
    const int wid = __builtin_amdgcn_readfirstlane(tid >> 6), lane = tid & 63, wr = wid >> 2, wc = wid & 3, fr = lane & 15, fq = lane >> 4;
    const int K = g.K, nt = K / BK;
    unsigned voffA[2], voffBp[2];
#pragma unroll
    for (int i = 0; i < 2; ++i) { int R, C; stage_rc(tid * 16 + i * 8192, R, C); voffA[i] = (unsigned)(R * K + C) * 2u; voffBp[i] = (unsigned)(((R & ~31) + perm32(R & 31)) * K + C) * 2u; }
    const size_t kstep = (size_t)(BK * 2);
    const size_t hstep = (size_t)HALF * K * 2;
    const size_t tstep = 2 * hstep;
    const unsigned ldsw = (unsigned)wid * 1024u;
    const int aoff = lds_byte(wr * 64 + fr, fq * 8), boff = lds_byte(wc * 32 + fr, fq * 8);
#define PG8_SA(b, h) (((b) * 2 + (h)) * HTB)
#define PG8_SB(b, h) ((4 + (b) * 2 + (h)) * HTB)
#define PG8_STAGE(bufoff, gbase) do { _Pragma("unroll") for (int _i = 0; _i < 2; ++_i) \
        __builtin_amdgcn_global_load_lds((const unsigned*)((const char*)(gbase) + voffA[_i]), (LAS unsigned*)(lds + (bufoff) + ldsw + _i * 8192), 16, 0, 0); } while (0)
#define PG8_STAGEB(bufoff, gbase, pf) do { _Pragma("unroll") for (int _i = 0; _i < 2; ++_i) \
        __builtin_amdgcn_global_load_lds((const unsigned*)((const char*)(gbase) + ((pf) ? voffBp[_i] : voffA[_i])), (LAS unsigned*)(lds + (bufoff) + ldsw + _i * 8192), 16, 0, 0); } while (0)
#define PG8_LDA(dst, b, h) do { _Pragma("unroll") for (int m = 0; m < 4; ++m) _Pragma("unroll") for (int k = 0; k < 2; ++k) dst[m][k] = *(const LAS h16x8*)(lds + PG8_SA(b, h) + aoff + m * 2048 + k * 1024); } while (0)
#define PG8_LDB(dst, b, h) do { _Pragma("unroll") for (int n = 0; n < 2; ++n) _Pragma("unroll") for (int k = 0; k < 2; ++k) dst[n][k] = *(const LAS h16x8*)(lds + PG8_SB(b, h) + boff + n * 2048 + k * 1024); } while (0)
#define PG8_MMA(ai, bj, At, Bt) do { __builtin_amdgcn_s_setprio(1); _Pragma("unroll") for (int m = 0; m < 4; ++m) _Pragma("unroll") for (int n = 0; n < 2; ++n) _Pragma("unroll") for (int k = 0; k < 2; ++k) \
        acc[ai][bj][m][n] = __builtin_amdgcn_mfma_f32_16x16x32_f16(Bt[n][k], At[m][k], acc[ai][bj][m][n], 0, 0, 0); __builtin_amdgcn_s_setprio(0); } while (0)
#define PG8_WAIT_V(n) asm volatile("s_waitcnt vmcnt(" #n ")" ::: "memory")
#define PG8_WAIT_L(n) asm volatile("s_waitcnt lgkmcnt(" #n ")" ::: "memory")
#define PG8_BAR __builtin_amdgcn_s_barrier()
#define PG8_SCHED __builtin_amdgcn_sched_barrier(0)
    Unit cur, nxt; int ui = 0;
    if (!S.next(0, cur)) return;
    f32x4 acc[2][2][4][2];
#pragma unroll
    for (int a = 0; a < 2; ++a)
#pragma unroll
        for (int b = 0; b < 2; ++b)
#pragma unroll
            for (int m = 0; m < 4; ++m)
#pragma unroll
                for (int n = 0; n < 2; ++n) acc[a][b][m][n] = (f32x4){0.f, 0.f, 0.f, 0.f};
    h16x8 At[4][2], B0[2][2], B1[2][2];
    const char* cA = (const char*)g.A + (size_t)cur.pm * tstep; const char* cB = (const char*)g.Bt + (size_t)cur.pn * tstep;
    bool pfc = Epi::perm(cur.pn);
    PG8_STAGEB(PG8_SB(0, 0), cB, pfc); PG8_STAGE(PG8_SA(0, 0), cA); PG8_STAGEB(PG8_SB(0, 1), cB + hstep, pfc); PG8_STAGE(PG8_SA(0, 1), cA + hstep);
    if (wr == 1) PG8_BAR;
    PG8_WAIT_V(4); PG8_BAR;
    PG8_STAGEB(PG8_SB(1, 0), cB + kstep, pfc); PG8_STAGE(PG8_SA(1, 0), cA + kstep); PG8_STAGEB(PG8_SB(1, 1), cB + hstep + kstep, pfc);
    PG8_WAIT_V(6); PG8_BAR;
    for (;;) {
        const bool has_next = S.next(ui + 1, nxt);
        const char* nA = has_next ? (const char*)g.A + (size_t)nxt.pm * tstep : cA; const char* nB = has_next ? (const char*)g.Bt + (size_t)nxt.pn * tstep : cB;
        const bool pfn = has_next ? Epi::perm(nxt.pn) : pfc;
        for (int t = 0; t < nt; t += 2) {
            const bool last = (t == nt - 2);
            const char* a1 = cA + (size_t)(t + 1) * kstep;
            const char* a2 = last ? nA : cA + (size_t)(t + 2) * kstep; const char* b2 = last ? nB : cB + (size_t)(t + 2) * kstep;
            const char* a3 = a2 + kstep; const char* b3 = b2 + kstep;
            const bool pf2 = last ? pfn : pfc;
            PG8_LDB(B0, 0, 0); PG8_SCHED; PG8_LDA(At, 0, 0); PG8_STAGE(PG8_SA(1, 1), a1 + hstep);
            PG8_WAIT_L(8); PG8_BAR; PG8_WAIT_L(0); PG8_MMA(0, 0, At, B0); PG8_BAR; PG8_SCHED;
            PG8_LDB(B1, 0, 1); PG8_STAGEB(PG8_SB(0, 0), b2, pf2);
            PG8_BAR; PG8_WAIT_L(0); PG8_MMA(0, 1, At, B1); PG8_BAR;
            PG8_LDA(At, 0, 1); PG8_STAGE(PG8_SA(0, 0), a2);
            PG8_BAR; PG8_WAIT_L(0); PG8_MMA(1, 0, At, B0); PG8_BAR; PG8_SCHED;
            PG8_STAGEB(PG8_SB(0, 1), b2 + hstep, pf2);
            PG8_WAIT_V(6); PG8_BAR; PG8_MMA(1, 1, At, B1); PG8_BAR;
            PG8_LDB(B0, 1, 0); PG8_SCHED; PG8_LDA(At, 1, 0); PG8_STAGE(PG8_SA(0, 1), a2 + hstep);
            PG8_WAIT_L(8); PG8_BAR; PG8_WAIT_L(0); PG8_MMA(0, 0, At, B0); PG8_BAR; PG8_SCHED;
            PG8_LDB(B1, 1, 1); PG8_STAGEB(PG8_SB(1, 0), b3, pf2);
            PG8_BAR; PG8_WAIT_L(0); PG8_MMA(0, 1, At, B1); PG8_BAR;
            PG8_LDA(At, 1, 1); PG8_STAGE(PG8_SA(1, 0), a3);
            PG8_BAR; PG8_WAIT_L(0); PG8_MMA(1, 0, At, B0); PG8_BAR; PG8_SCHED;
            PG8_STAGEB(PG8_SB(1, 1), b3 + hstep, pf2);
            PG8_WAIT_V(6); PG8_BAR; PG8_MMA(1, 1, At, B1); PG8_BAR;
        }
        if constexpr (!Epi::AFTER_DRAIN) E(acc, cur, wr, wc, fr, fq);
        if (!has_next) break;
#pragma unroll
        for (int a = 0; a < 2; ++a)
#pragma unroll
            for (int b = 0; b < 2; ++b)
#pragma unroll
                for (int m = 0; m < 4; ++m)
#pragma unroll
                    for (int n = 0; n < 2; ++n) acc[a][b][m][n] = (f32x4){0.f, 0.f, 0.f, 0.f};
        cur = nxt; cA = nA; cB = nB; pfc = pfn; ++ui;
    }
    PG8_WAIT_V(0);
    if (wr == 0) PG8_BAR;
    PG8_BAR;
    if constexpr (Epi::AFTER_DRAIN) E.fused(acc, cur, wr, wc, fr, fq, lane);
#undef PG8_SA
#undef PG8_SB
#undef PG8_STAGE
#undef PG8_STAGEB
#undef PG8_LDA
#undef PG8_LDB
#undef PG8_MMA
#undef PG8_WAIT_V
#undef PG8_WAIT_L
#undef PG8_BAR
#undef PG8_SCHED
}
}
using pg8::Unit;
typedef f32x4 Acc[2][2][4][2];

__device__ __forceinline__ void st4h(h16* p, f32x4 v) { h16x4 o; o[0] = (h16)v[0]; o[1] = (h16)v[1]; o[2] = (h16)v[2]; o[3] = (h16)v[3]; *(h16x4*)p = o; }
__device__ __forceinline__ void st8h(h16* p, f32x4 a, f32x4 b) { h16x8 o; o[0] = (h16)a[0]; o[1] = (h16)a[1]; o[2] = (h16)a[2]; o[3] = (h16)a[3]; o[4] = (h16)b[0]; o[5] = (h16)b[1]; o[6] = (h16)b[2]; o[7] = (h16)b[3]; *(h16x8*)p = o; }
__device__ __forceinline__ void ld8h(const h16* p, f32x4& a, f32x4& b) { const h16x8 o = *(const h16x8*)p; a = (f32x4){(float)o[0], (float)o[1], (float)o[2], (float)o[3]}; b = (f32x4){(float)o[4], (float)o[5], (float)o[6], (float)o[7]}; }
__device__ __forceinline__ f32x4 ld4h(const h16* p) { const h16x4 o = *(const h16x4*)p; return (f32x4){(float)o[0], (float)o[1], (float)o[2], (float)o[3]}; }
__device__ __forceinline__ float sumsq4(f32x4 v) { return (v[0] * v[0] + v[1] * v[1]) + (v[2] * v[2] + v[3] * v[3]); }
__device__ __forceinline__ float sigmoidf_(float x) { return __builtin_amdgcn_rcpf(1.0f + __expf(-x)); }
__device__ __forceinline__ float logsigmoidf_(float z) { return fminf(z, 0.f) - __logf(1.0f + __expf(-fabsf(z))); }
__device__ __forceinline__ float wave_sum(float v) {
#pragma unroll
    for (int o = 1; o < 64; o <<= 1) v += __shfl_xor(v, o);
    return v;
}

struct EpiInProj {
    static constexpr bool AFTER_DRAIN = false;
    static __device__ __forceinline__ bool perm(int pn) { return pn == 5 || pn >= 11; }
    unsigned char* ws; const float* b_f;
    __device__ __forceinline__ void operator()(const Acc& acc, const Unit& u, int wr, int wc, int fr, int fq) const {
        const int pn = u.pn, row0 = u.pm * 256 + wr * 64 + fr;
        const float* ROPE = (const float*)(ws + WS_ROPE);
        float nmax[2] = {0.f, 0.f};
#pragma unroll
        for (int ai = 0; ai < 2; ++ai)
#pragma unroll
            for (int m = 0; m < 4; ++m) {
                const int row = row0 + ai * 128 + m * 16, b = row >> 12, t = row & 4095;
                const float* rp = ROPE + (size_t)row * 48;
#pragma unroll
                for (int bj = 0; bj < 2; ++bj) {
                    f32x4 v0 = acc[ai][bj][m][0], v1 = acc[ai][bj][m][1];
                    const int d0 = 32 * wc + 4 * fq;
                    const int d8 = 32 * wc + 8 * fq;
                    if (pn < 6) {
                        size_t off;
                        if (pn < 4) off = WS_QA + (((size_t)(b * HA + pn * 2 + bj) * T + t) * HD) * 2;
                        else off = (pn == 4 ? WS_KA : WS_VA) + (((size_t)(b * HAKV + bj) * T + t) * HD) * 2;
                        h16* dst = (h16*)(ws + off);
                        if (pn < 5 && wc == 0) {
                            const f32x4 c = *(const f32x4*)(rp + 4 * fq), s = *(const f32x4*)(rp + 16 + 4 * fq);
                            const f32x4 y0 = v0 * c - v1 * s, y1 = v1 * c + v0 * s; v0 = y0; v1 = y1;
                        }
                        if (pn == 5) st8h(dst + d8, v0, v1); else { st4h(dst + d0, v0); st4h(dst + d0 + 16, v1); }
                    } else if (pn < 11) {
                        const bool is_q = pn < 10;
                        if (is_q || bj == 0) {
                            if (is_q || wc < 2) {
                                const int dd = 32 * (wc & 1) + 4 * fq;
                                const size_t off = is_q ? WS_QI + ((size_t)row * 1024 + ((pn - 6) * 4 + 2 * bj + (wc >> 1)) * 64) * 2 : WS_KI + ((size_t)row * 64) * 2;
                                h16* dst = (h16*)(ws + off);
                                if ((wc & 1) == 0) {
                                    f32x4 pr;
#pragma unroll
                                    for (int j = 0; j < 4; ++j) pr[j] = __shfl_xor(v0[j], 32);
                                    const f32x4 c = *(const f32x4*)(rp + 32 + 4 * (fq & 1)), s = *(const f32x4*)(rp + 40 + 4 * (fq & 1));
                                    v0 = (fq < 2) ? (v0 * c - pr * s) : (v0 * c + pr * s);
                                }
                                st4h(dst + dd, v0); st4h(dst + dd + 16, v1);
                            } else if (wc == 2) {
                                *(f32x4*)((float*)(ws + WS_WI) + (size_t)row * 16 + 4 * fq) = v0 * 0.03125f;
                                if (fq < 2) { const f32x4 bf = *(const f32x4*)(b_f + 4 * fq); f32x4 o;
#pragma unroll
                                    for (int j = 0; j < 4; ++j) o[j] = logsigmoidf_(v1[j] + bf[j]);
                                    float* lf = (float*)(ws + WS_LOGF) + ((size_t)(b * HB + 4 * fq)) * T + t;
#pragma unroll
                                    for (int j = 0; j < 4; ++j) lf[(size_t)j * T] = o[j]; }
                            }
                        }
                    } else if (pn < 23) {
                        const int q = pn - 11, which = q >> 2, head = (q & 3) * 2 + bj;
                        h16* dst = (h16*)(ws + WS_QB + (size_t)which * (WS_KB - WS_QB)) + ((size_t)(b * HB + head) * T + t) * HD;
                        st8h(dst + d8, v0, v1);
                        if (which < 2) { float ps = sumsq4(v0) + sumsq4(v1); ps += __shfl_xor(ps, 16); ps += __shfl_xor(ps, 32); nmax[bj] = fmaxf(nmax[bj], ps); }
                    } else {
                        const int q = pn - 23; const int col = (q & 7) * 256 + 128 * bj + d8;
                        h16* base = (h16*)(ws + WS_SIGA + (size_t)(q >> 3) * (WS_SIGB - WS_SIGA));
#pragma unroll
                        for (int j = 0; j < 4; ++j) { v0[j] = sigmoidf_(v0[j]); v1[j] = sigmoidf_(v1[j]); }
                        st8h(base + (size_t)row * DM + col, v0, v1);
                    }
                }
            }
        if (pn >= 11 && pn < 19) {
            const int q = pn - 11, which = q >> 2, bq = u.pm >> 4, qb = u.pm & 15; unsigned* nrm = (unsigned*)(ws + WS_NORM);
#pragma unroll
            for (int bj = 0; bj < 2; ++bj) { float mx = nmax[bj];
#pragma unroll
                for (int o = 1; o < 16; o <<= 1) mx = fmaxf(mx, __shfl_xor(mx, o));
                const int bh = bq * HB + (q & 3) * 2 + bj;
                if (fr == 0 && fq == 0) atomicMax(which == 0 ? nrm + (bh * 16 + qb) * 4 + wc : nrm + 1024 + bh * 4 + wc, __float_as_uint(mx)); }
        }
    }
};
static_assert(WS_VB - WS_KB == WS_KB - WS_QB, "QB/KB/VB equally spaced");
template <bool FIRST> struct EpiGate {
    static constexpr bool AFTER_DRAIN = false;
    static __device__ __forceinline__ bool perm(int) { return true; }
    const h16* SIG; h16* MIXED;
    __device__ __forceinline__ void operator()(const Acc& acc, const Unit& u, int wr, int wc, int fr, int fq) const {
        const int row0 = u.pm * 256 + wr * 64 + fr, col0 = u.pn * 256 + 32 * wc + 8 * fq;
#pragma unroll
        for (int ai = 0; ai < 2; ++ai)
#pragma unroll
            for (int m = 0; m < 4; ++m)
#pragma unroll
                for (int bj = 0; bj < 2; ++bj) { const size_t off = (size_t)(row0 + ai * 128 + m * 16) * DM + col0 + bj * 128;
                    f32x4 s0, s1; ld8h(SIG + off, s0, s1); f32x4 v0 = s0 * acc[ai][bj][m][0], v1 = s1 * acc[ai][bj][m][1];
                    if (!FIRST) { f32x4 m0, m1; ld8h(MIXED + off, m0, m1); v0 += m0; v1 += m1; }
                    st8h(MIXED + off, v0, v1); }
    }
};
template <bool BASE_F32> struct EpiResidNorm {
    static constexpr bool AFTER_DRAIN = false;
    static __device__ __forceinline__ bool perm(int) { return true; }
    const float* BASE; h16* XH; float* RS;
    __device__ __forceinline__ void operator()(const Acc& acc, const Unit& u, int wr, int wc, int fr, int fq) const {
        const int row0 = u.pm * 256 + wr * 64 + fr, col0 = u.pn * 256 + 32 * wc + 8 * fq;
#pragma unroll
        for (int ai = 0; ai < 2; ++ai)
#pragma unroll
            for (int m = 0; m < 4; ++m) { const int row = row0 + ai * 128 + m * 16; float ss = 0.f;
#pragma unroll
                for (int bj = 0; bj < 2; ++bj) { const size_t off = (size_t)row * DM + col0 + bj * 128;
                    f32x4 b0, b1; if (BASE_F32) { b0 = *(const f32x4*)(BASE + off); b1 = *(const f32x4*)(BASE + off + 4); } else ld8h(XH + off, b0, b1);
                    const f32x4 v0 = b0 + acc[ai][bj][m][0], v1 = b1 + acc[ai][bj][m][1]; st8h(XH + off, v0, v1); ss += sumsq4(v0) + sumsq4(v1); }
                ss += __shfl_xor(ss, 16); ss += __shfl_xor(ss, 32);
                if (fq == 0) atomicAdd(RS + row, ss); }
    }
};
struct EpiSwiGLU {
    static constexpr bool AFTER_DRAIN = false;
    static __device__ __forceinline__ bool perm(int) { return false; }
    h16* ACT; const float* RS;
    __device__ __forceinline__ void operator()(const Acc& acc, const Unit& u, int wr, int wc, int fr, int fq) const {
        const int row0 = u.pm * 256 + wr * 64 + fr;
#pragma unroll
        for (int ai = 0; ai < 2; ++ai)
#pragma unroll
            for (int m = 0; m < 4; ++m) { const int row = row0 + ai * 128 + m * 16; const float r = __builtin_amdgcn_rsqf(RS[row] * (1.0f / DM) + EPS);
#pragma unroll
                for (int bj = 0; bj < 2; ++bj) { const f32x4 g = acc[ai][bj][m][0] * r, uu = acc[ai][bj][m][1] * r; f32x4 o;
#pragma unroll
                    for (int j = 0; j < 4; ++j) o[j] = g[j] * sigmoidf_(g[j]) * uu[j];
                    st4h(ACT + (size_t)row * DFF + 16 * (u.pn * 8 + bj * 4 + wc) + 4 * fq, o); } }
    }
};
struct EpiStoreH {
    static constexpr bool AFTER_DRAIN = false;
    static __device__ __forceinline__ bool perm(int) { return true; }
    h16* O; int ldc;
    __device__ __forceinline__ void operator()(const Acc& acc, const Unit& u, int wr, int wc, int fr, int fq) const {
        const int row0 = u.pm * 256 + wr * 64 + fr, col0 = u.pn * 256 + 32 * wc + 8 * fq;
#pragma unroll
        for (int ai = 0; ai < 2; ++ai)
#pragma unroll
            for (int m = 0; m < 4; ++m)
#pragma unroll
                for (int bj = 0; bj < 2; ++bj) st8h(O + (size_t)(row0 + ai * 128 + m * 16) * ldc + col0 + bj * 128, acc[ai][bj][m][0], acc[ai][bj][m][1]);
    }
};
struct EpiPLE {
    static constexpr bool AFTER_DRAIN = false;
    static __device__ __forceinline__ bool perm(int) { return true; }
    const h16* PP; const h16* XI; h16* XO; const float* RSIN; float* RSOUT;
    __device__ __forceinline__ void operator()(const Acc& acc, const Unit& u, int wr, int wc, int fr, int fq) const {
        const int row0 = u.pm * 256 + wr * 64 + fr, col0 = u.pn * 256 + 32 * wc + 8 * fq;
#pragma unroll
        for (int ai = 0; ai < 2; ++ai)
#pragma unroll
            for (int m = 0; m < 4; ++m) { const int row = row0 + ai * 128 + m * 16; const float r = __builtin_amdgcn_rsqf(RSIN[row] * (1.0f / DM) + EPS); float ss = 0.f;
#pragma unroll
                for (int bj = 0; bj < 2; ++bj) { const size_t off = (size_t)row * DM + col0 + bj * 128;
                    const f32x4 a0 = acc[ai][bj][m][0] * r, a1 = acc[ai][bj][m][1] * r; f32x4 p0, p1, x0, x1; ld8h(PP + off, p0, p1); ld8h(XI + off, x0, x1);
#pragma unroll
                    for (int j = 0; j < 4; ++j) { x0[j] += sigmoidf_(a0[j]) * p0[j]; x1[j] += sigmoidf_(a1[j]) * p1[j]; }
                    st8h(XO + off, x0, x1); ss += sumsq4(x0) + sumsq4(x1); }
                ss += __shfl_xor(ss, 16); ss += __shfl_xor(ss, 32);
                if (fq == 0) atomicAdd(RSOUT + row, ss); }
    }
};

struct EpiPLEFinal {
    static constexpr bool AFTER_DRAIN = true;
    static __device__ __forceinline__ bool perm(int) { return true; }
    const h16* PP; const h16* XI; float* OUT; const float* RSIN; float* RSOUT; const float* gfin; unsigned* cnt;
    __device__ __forceinline__ void operator()(const Acc&, const Unit&, int, int, int, int) const {}
    __device__ __forceinline__ void fused(Acc& acc, const Unit& u, int wr, int wc, int fr, int fq, int lane) const {
        const int row0 = u.pm * 256 + wr * 64 + fr, col0 = u.pn * 256 + 32 * wc + 8 * fq;
#pragma unroll
        for (int ai = 0; ai < 2; ++ai)
#pragma unroll
            for (int m = 0; m < 4; ++m) { const int row = row0 + ai * 128 + m * 16; const float r = __builtin_amdgcn_rsqf(RSIN[row] * (1.0f / DM) + EPS); float ss = 0.f;
#pragma unroll
                for (int bj = 0; bj < 2; ++bj) { const size_t off = (size_t)row * DM + col0 + bj * 128;
                    const f32x4 a0 = acc[ai][bj][m][0] * r, a1 = acc[ai][bj][m][1] * r; f32x4 p0, p1, x0, x1; ld8h(PP + off, p0, p1); ld8h(XI + off, x0, x1);
#pragma unroll
                    for (int j = 0; j < 4; ++j) { x0[j] += sigmoidf_(a0[j]) * p0[j]; x1[j] += sigmoidf_(a1[j]) * p1[j]; }
                    acc[ai][bj][m][0] = x0; acc[ai][bj][m][1] = x1; ss += sumsq4(x0) + sumsq4(x1); }
                ss += __shfl_xor(ss, 16); ss += __shfl_xor(ss, 32);
                if (fq == 0) atomicAdd(RSOUT + row, ss); }
        asm volatile("s_waitcnt vmcnt(0)" ::: "memory");
        unsigned* c = cnt + 64 * u.pm;
        if (lane == 0) __hip_atomic_fetch_add(c, 1u, __ATOMIC_RELAXED, __HIP_MEMORY_SCOPE_AGENT);
        { unsigned spins = 0;
          while ((unsigned)__builtin_amdgcn_readfirstlane((int)__hip_atomic_load(c, __ATOMIC_RELAXED, __HIP_MEMORY_SCOPE_AGENT)) < 64u) { __builtin_amdgcn_s_sleep(2); if (++spins > (1u << 22)) break; } }
#pragma unroll
        for (int ai = 0; ai < 2; ++ai)
#pragma unroll
            for (int m = 0; m < 4; ++m) { const int row = row0 + ai * 128 + m * 16;
                const float r = __builtin_amdgcn_rsqf(__hip_atomic_load(RSOUT + row, __ATOMIC_RELAXED, __HIP_MEMORY_SCOPE_AGENT) * (1.0f / DM) + EPS);
#pragma unroll
                for (int bj = 0; bj < 2; ++bj) { const size_t off = (size_t)row * DM + col0 + bj * 128;
                    const f32x4 g0 = *(const f32x4*)(gfin + col0 + bj * 128), g1 = *(const f32x4*)(gfin + col0 + bj * 128 + 4);
                    *(f32x4*)(OUT + off) = acc[ai][bj][m][0] * r * g0; *(f32x4*)(OUT + off + 4) = acc[ai][bj][m][1] * r * g1; } }
    }
};

__device__ __forceinline__ int map_in(int p) {
    if (p < 2560) return p;
    if (p < 2816) { const int c = p - 2560; if (c < 64) return 2560 + c; if (c < 80) return 2624 + (c - 64); if (c < 88) return 5712 + (c - 80); return -1; }
    const int q = p - 2816; if (q < 3072) return 2640 + q; return 5720 + (q - 3072);
}
template <int MODE>
__device__ __forceinline__ const float* tr_src(const float* W0, const float* W1, int Nsrc, int n) {
    if (MODE == 0) return n < Nsrc ? W0 + n : nullptr;
    if (MODE == 1) { const int c = map_in(n); return c >= 0 ? W0 + c : nullptr; }
    return (((n >> 4) & 1) ? W1 : W0) + 16 * (n >> 5) + (n & 15);
}
template <int MODE>
__device__ __forceinline__ void ph_transpose(const float* W0, const float* W1, const float* gk, int K, int Nsrc, h16* WT, int Nphys, LAS float* scr, int gw, int NGW, int lane) {
    const int nblk = Nphys / 32, nitems = (K / 64) * nblk;
    const int lr = lane >> 3, lc = (lane & 7) * 4;
    f32x4 cur[8], nxt[8];
    int item = gw;
    if (item < nitems) { const int kb = item / nblk, nb = item % nblk; const float* src = tr_src<MODE>(W0, W1, Nsrc, 32 * nb + lc);
#pragma unroll
        for (int i = 0; i < 8; ++i) cur[i] = src ? *(const f32x4*)(src + (size_t)(64 * kb + lr + 8 * i) * Nsrc) : (f32x4){0.f, 0.f, 0.f, 0.f}; }
    for (; item < nitems; item += NGW) {
        const int kb = item / nblk, nb = item % nblk, k0 = 64 * kb, n0 = 32 * nb;
        const int itn = item + NGW;
        if (itn < nitems) { const int kbn = itn / nblk, nbn = itn % nblk; const float* src = tr_src<MODE>(W0, W1, Nsrc, 32 * nbn + lc);
#pragma unroll
            for (int i = 0; i < 8; ++i) nxt[i] = src ? *(const f32x4*)(src + (size_t)(64 * kbn + lr + 8 * i) * Nsrc) : (f32x4){0.f, 0.f, 0.f, 0.f}; }
#pragma unroll
        for (int i = 0; i < 8; ++i) { LAS float* d = scr + (lr + 8 * i) * 33 + lc; const float gg = gk ? gk[k0 + lr + 8 * i] : 1.0f; d[0] = cur[i][0] * gg; d[1] = cur[i][1] * gg; d[2] = cur[i][2] * gg; d[3] = cur[i][3] * gg; }
        __builtin_amdgcn_wave_barrier(); asm volatile("s_waitcnt lgkmcnt(0)" ::: "memory");
        const int c = lane & 7;
#pragma unroll
        for (int j = 0; j < 4; ++j) { const int nn = (lane >> 3) + 8 * j; const LAS float* sp = scr + (8 * c) * 33 + nn;
            h16x8 o;
#pragma unroll
            for (int e = 0; e < 8; ++e) o[e] = (h16)sp[e * 33];
            *(h16x8*)(WT + (size_t)(n0 + nn) * K + k0 + 8 * c) = o; }
        __builtin_amdgcn_wave_barrier(); asm volatile("s_waitcnt lgkmcnt(0)" ::: "memory");
#pragma unroll
        for (int i = 0; i < 8; ++i) cur[i] = nxt[i];
    }
}
__device__ __forceinline__ void sincos_f32arg(float ang, float& sn, float& cs) {
    const double a = (double)ang;
    const double rev = a * 0.15915494309189535;
    const double fr = rev - __builtin_rint(rev);
    const double q4 = fr * 4.0; const double qi = __builtin_rint(q4); const int qq = ((int)qi) & 3;
    const double r = (q4 - qi) * 1.5707963267948966;
    const double r2 = r * r;
    const double s = r * (1.0 + r2 * (-1.0 / 6 + r2 * (1.0 / 120 + r2 * (-1.0 / 5040 + r2 * (1.0 / 362880 + r2 * (-1.0 / 39916800))))));
    const double c = 1.0 + r2 * (-0.5 + r2 * (1.0 / 24 + r2 * (-1.0 / 720 + r2 * (1.0 / 40320 + r2 * (-1.0 / 3628800 + r2 * (1.0 / 479001600))))));
    double so, co;
    if (qq == 0) { so = s; co = c; } else if (qq == 1) { so = c; co = -s; } else if (qq == 2) { so = -s; co = -c; } else { so = -c; co = s; }
    sn = (float)so; cs = (float)co;
}
__device__ __forceinline__ void ph_rope(const int* pos, float* ROPE, int gtid, int NGT) {
    for (int idx = gtid; idx < MTOK * 24; idx += NGT) {
        const int tok = idx / 24, i = idx % 24, k = i < 16 ? i : 2 * (i - 16);
        float f = 0x1.000000p+0f;
        f = k == 1 ? 0x1.c2ef76p-2f : f; f = k == 2 ? 0x1.8d275ep-3f : f; f = k == 3 ? 0x1.5dc95ap-4f : f; f = k == 4 ? 0x1.341190p-5f : f; f = k == 5 ? 0x1.0f5384p-6f : f;
        f = k == 6 ? 0x1.ddee9cp-8f : f; f = k == 7 ? 0x1.a4ee3ep-9f : f; f = k == 8 ? 0x1.72ba44p-10f : f; f = k == 9 ? 0x1.468318p-11f : f; f = k == 10 ? 0x1.1f91f0p-12f : f;
        f = k == 11 ? 0x1.fa8b84p-14f : f; f = k == 12 ? 0x1.be218ap-15f : f; f = k == 13 ? 0x1.88ec22p-16f : f; f = k == 14 ? 0x1.5a0f50p-17f : f; f = k == 15 ? 0x1.30c94ep-18f : f;
        const float ang = (float)pos[tok] * f;
        float sn, cs; sincos_f32arg(ang, sn, cs);
        float* rp = ROPE + (size_t)tok * 48;
        if (i < 16) { rp[i] = cs; rp[16 + i] = sn; } else { rp[32 + (i - 16)] = cs; rp[40 + (i - 16)] = sn; }
    }
}
template <bool TO_F32>
__device__ __forceinline__ void ph_rmsnorm(const float* X, const float* g, h16* OUTH, float* OUTF, int gw, int NGW, int lane) {
    for (int row = gw; row < MTOK; row += NGW) {
        const f32x4* xr = (const f32x4*)(X + (size_t)row * DM) + lane;
        f32x4 v[8]; float s = 0.f;
#pragma unroll
        for (int j = 0; j < 8; ++j) { v[j] = xr[64 * j]; s += (v[j][0] * v[j][0] + v[j][1] * v[j][1]) + (v[j][2] * v[j][2] + v[j][3] * v[j][3]); }
        const float r = 1.0f / sqrtf(wave_sum(s) * (1.0f / DM) + EPS);
#pragma unroll
        for (int j = 0; j < 8; ++j) { const f32x4 gg = *((const f32x4*)g + lane + 64 * j); const f32x4 o = v[j] * r * gg;
            if (TO_F32) *((f32x4*)(OUTF + (size_t)row * DM) + lane + 64 * j) = o; else st4h(OUTH + (size_t)row * DM + 4 * (lane + 64 * j), o); }
    }
}
__device__ __forceinline__ void ph_final(const h16* X, float* OUT, const float* g, const float* RS, int gw, int NGW, int lane) {
    for (int row = gw; row < MTOK; row += NGW) {
        const float r = __builtin_amdgcn_rsqf(RS[row] * (1.0f / DM) + EPS);
        h16x8 v[4];
#pragma unroll
        for (int j = 0; j < 4; ++j) v[j] = *((const h16x8*)(X + (size_t)row * DM) + lane + 64 * j);
#pragma unroll
        for (int j = 0; j < 4; ++j) { const float* gp = g + 8 * (lane + 64 * j); float* op = OUT + (size_t)row * DM + 8 * (lane + 64 * j);
            const f32x4 g0 = *(const f32x4*)gp, g1 = *(const f32x4*)(gp + 4);
            f32x4 o0 = {(float)v[j][0], (float)v[j][1], (float)v[j][2], (float)v[j][3]}, o1 = {(float)v[j][4], (float)v[j][5], (float)v[j][6], (float)v[j][7]};
            *(f32x4*)op = o0 * r * g0; *(f32x4*)(op + 4) = o1 * r * g1; }
    }
}
__device__ __forceinline__ void ph_cumsum(const float* LOGF, float* CBS, int bh, int lane) {
    const int b = bh >> 3, h = bh & 7;
    float v[64];
#pragma unroll
    for (int it = 0; it < 64; ++it) v[it] = LOGF[(size_t)(b * T + it * 64 + lane) * 8 + h];
    float run = 0.f;
#pragma unroll
    for (int it = 0; it < 64; ++it) {
        float x = v[it];
#pragma unroll
        for (int o = 1; o < 64; o <<= 1) { const float nb = __shfl_up(x, o); if (lane >= o) x += nb; }
        CBS[(size_t)bh * T + it * 64 + lane] = (run + x) * -11.313708498984761f;
        run += __shfl(x, 63);
    }
}

__device__ __forceinline__ unsigned fkey(float f) { const unsigned u = __float_as_uint(f + 0.0f); return (u & 0x80000000u) ? ~u : (u | 0x80000000u); }
__device__ __forceinline__ unsigned count_ge(const unsigned (&key)[64], unsigned th, int nj) {
    unsigned c = 0;
#pragma unroll
    for (int j8 = 0; j8 < 8; ++j8) {
        if (8 * j8 < nj) {
#pragma unroll
            for (int j = 8 * j8; j < 8 * j8 + 8; ++j) c += (key[j] >= th) ? 1u : 0u;
        }
    }
#pragma unroll
    for (int o = 1; o < 64; o <<= 1) c += __shfl_xor(c, o);
    return c;
}
__device__ __forceinline__ u64 topk_select(const unsigned (&key)[64], int nvalid, int lane) {
    u64 myword = 0;
    if (nvalid <= TOPK) {
#pragma unroll
        for (int j = 0; j < 64; ++j) { const u64 bal = __ballot(key[j] != 0u); if (lane == j) myword = bal; }
    } else {
        unsigned th = 0u; bool exact = false;
        for (int bit = 31; bit >= 0; --bit) { const unsigned tc = th | (1u << bit); const unsigned c = count_ge(key, tc, (nvalid + 63) >> 6); if (c >= (unsigned)TOPK) th = tc; if (c == (unsigned)TOPK) { exact = true; break; } }
        if (exact) {
#pragma unroll
            for (int j = 0; j < 64; ++j) { const u64 bal = __ballot(key[j] >= th); if (lane == j) myword = bal; }
        } else {
            unsigned cgt = 0;
#pragma unroll
            for (int j = 0; j < 64; ++j) cgt += (unsigned)__builtin_popcountll(__ballot(key[j] > th));
            int need = TOPK - (int)cgt;
#pragma unroll
            for (int j = 0; j < 64; ++j) { u64 eq = __ballot(key[j] == th); const u64 gt = __ballot(key[j] > th);
                int pc = __builtin_popcountll(eq);
                while (pc > need) { eq &= ~(1ull << (63 - __builtin_clzll(eq))); --pc; }
                need -= pc; if (lane == j) myword = gt | eq; }
        }
    }
    return myword;
}
template <int LVL>
__device__ __forceinline__ void hist_level(const unsigned (&key)[64], int nj, int lane, LAS unsigned* hist, unsigned& prefix, unsigned& need, unsigned& cnt_eq) {
    constexpr int SH = LVL == 0 ? 21 : (LVL == 1 ? 10 : 0), PSH = LVL == 1 ? 21 : 10, NB = LVL == 2 ? 10 : 11;
#pragma unroll
    for (int i = 0; i < 8; ++i) *(LAS u32x4*)(hist + lane * 32 + 4 * i) = (u32x4){0u, 0u, 0u, 0u};
    asm volatile("s_waitcnt lgkmcnt(0)" ::: "memory"); __builtin_amdgcn_wave_barrier();
#pragma unroll
    for (int j8 = 0; j8 < 8; ++j8) {
        if (8 * j8 < nj) {
            if (LVL == 0) {
#pragma unroll
                for (int j = 8 * j8; j < 8 * j8 + 8; ++j) __hip_atomic_fetch_add(hist + (key[j] >> 21), 1u, __ATOMIC_RELAXED, __HIP_MEMORY_SCOPE_WORKGROUP);
            } else {
                bool any = false;
#pragma unroll
                for (int j = 8 * j8; j < 8 * j8 + 8; ++j) any = any || ((key[j] >> PSH) == prefix);
                if (LVL == 1 || __any(any)) {
#pragma unroll
                    for (int j = 8 * j8; j < 8 * j8 + 8; ++j) { const unsigned k = key[j];
                        if ((k >> PSH) == prefix) __hip_atomic_fetch_add(hist + ((k >> SH) & ((1u << NB) - 1u)), 1u, __ATOMIC_RELAXED, __HIP_MEMORY_SCOPE_WORKGROUP); }
                }
            }
        }
    }
    asm volatile("s_waitcnt lgkmcnt(0)" ::: "memory"); __builtin_amdgcn_wave_barrier();
    unsigned s = 0;
#pragma unroll
    for (int i = 0; i < 8; ++i) { const u32x4 v = *(const LAS u32x4*)(hist + lane * 32 + 4 * i); s += (v[0] + v[1]) + (v[2] + v[3]); }
    unsigned S = s;
#pragma unroll
    for (int o = 1; o < 64; o <<= 1) { const unsigned nb = __shfl_down(S, o); if (lane + o < 64) S += nb; }
    const int L = 63 - __builtin_clzll(__ballot(S >= need));
    const unsigned aboveL = __shfl(S - s, L);
    const int bi = lane & 31;
    const unsigned hb = hist[L * 32 + bi];
    unsigned R = hb;
#pragma unroll
    for (int o = 1; o < 32; o <<= 1) { const unsigned nb = __shfl_down(R, o); if (bi + o < 32) R += nb; }
    const int B = 31 - __builtin_clz((unsigned)__ballot(aboveL + R >= need));
    const unsigned abB = __shfl(aboveL + R - hb, B);
    cnt_eq = __shfl(hb, B);
    prefix = (prefix << NB) | (unsigned)(L * 32 + B);
    need -= abB;
    __builtin_amdgcn_wave_barrier();
}
__device__ __forceinline__ u64 topk_select_hist(const unsigned (&key)[64], int nvalid, int lane, LAS unsigned* hist) {
    const int nj = (nvalid + 63) >> 6;
    unsigned prefix = 0, need = TOPK, cnt_eq = 0;
    hist_level<0>(key, nj, lane, hist, prefix, need, cnt_eq);
    hist_level<1>(key, nj, lane, hist, prefix, need, cnt_eq);
    hist_level<2>(key, nj, lane, hist, prefix, need, cnt_eq);
    u64 mw = 0;
    if (need == cnt_eq) {
#pragma unroll
        for (int j = 0; j < 64; ++j) { const u64 bal = __ballot(key[j] >= prefix); if (lane == j) mw = bal; }
    } else {
        int nd = (int)need;
#pragma unroll
        for (int j = 0; j < 64; ++j) { u64 eq = __ballot(key[j] == prefix); const u64 gt = __ballot(key[j] > prefix);
            int pc = __builtin_popcountll(eq);
            while (pc > nd) { eq &= ~(1ull << (63 - __builtin_clzll(eq))); --pc; }
            nd -= pc; if (lane == j) mw = gt | eq; }
    }
    return mw;
}
__device__ __forceinline__ void ph_topk_naive(const h16* QI, const h16* KI, const float* WI, u64* MASK, LAS float* qs, LAS unsigned* ks, int gw, int NGW, int lane) {
    for (int row = gw; row < MTOK; row += NGW) {
        const int b = row >> 12, t = row & 4095;
        { const h16* qp = QI + (size_t)row * 1024 + lane * 16;
#pragma unroll
          for (int i = 0; i < 16; ++i) qs[lane * 16 + i] = (float)qp[i]; }
        if (lane < 16) qs[1024 + lane] = WI[(size_t)row * 16 + lane];
        __builtin_amdgcn_wave_barrier(); asm volatile("s_waitcnt lgkmcnt(0)" ::: "memory");
#pragma unroll 1
        for (int j = 0; j < 64; ++j) {
            unsigned kk = 0u;
            const int s = 64 * j + lane;
            if (s <= t) {
                float kf[64];
                const h16x8* kp = (const h16x8*)(KI + (size_t)(b * T + s) * 64);
#pragma unroll
                for (int c = 0; c < 8; ++c) { const h16x8 kv = kp[c];
#pragma unroll
                    for (int e = 0; e < 8; ++e) kf[c * 8 + e] = (float)kv[e]; }
                float sc = 0.f;
#pragma unroll 1
                for (int h = 0; h < 16; ++h) { float d = 0.f;
#pragma unroll
                    for (int e = 0; e < 64; ++e) d = fmaf(qs[h * 64 + e], kf[e], d);
                    sc = fmaf(qs[1024 + h], fmaxf(d, 0.f), sc); }
                kk = fkey(sc);
            }
            ks[j * 64 + lane] = kk;
        }
        __builtin_amdgcn_wave_barrier(); asm volatile("s_waitcnt lgkmcnt(0)" ::: "memory");
        unsigned key[64];
#pragma unroll
        for (int j = 0; j < 64; ++j) key[j] = ks[j * 64 + lane];
        MASK[(size_t)row * 64 + lane] = topk_select(key, t + 1, lane);
        __builtin_amdgcn_wave_barrier(); asm volatile("s_waitcnt lgkmcnt(0)" ::: "memory");
    }
}


namespace idx {
typedef short s16x8 __attribute__((ext_vector_type(8)));
typedef float f32x16 __attribute__((ext_vector_type(16)));
constexpr int CHK = 128, CHB = CHK * 128;
__device__ __forceinline__ unsigned half_sum(unsigned v) {
#pragma unroll
    for (int o = 1; o < 32; o <<= 1) v += __shfl_xor(v, o);
    return v;
}
__device__ __forceinline__ void run_group(unsigned char* ws, char* lds, unsigned* scr, int b, int g, int wv) {
    int tid = wv * 64 + lane_id(); asm volatile("" : "+v"(tid));
    const int wid = __builtin_amdgcn_readfirstlane(tid >> 6), lane = tid & 63, c = lane & 31, hi = lane >> 5;
    const int t0 = 16 * g + 2 * wid, t = t0 + hi, row = b * T + t, tmaxblk = 16 * g + 15, nch = (tmaxblk >> 7) + 1;
    const h16* QI = (const h16*)(ws + WS_QI); const char* KIb = (const char*)ws + WS_KI + (size_t)b * T * 128; const float* WI = (const float*)(ws + WS_WI);
    s16x8 A[4];
    { const int rho = c, qsel = (rho >> 2) & 1, head = (rho & 3) + 4 * (rho >> 3);
      const h16* qp = QI + (size_t)(b * T + t0 + qsel) * 1024 + head * 64 + 8 * hi;
#pragma unroll
      for (int ks = 0; ks < 4; ++ks) A[ks] = *reinterpret_cast<const s16x8*>(qp + 16 * ks); }
    float w[16];
    { const f32x4* wp = (const f32x4*)(WI + (size_t)row * 16);
#pragma unroll
      for (int i = 0; i < 4; ++i) { const f32x4 v = wp[i]; w[4 * i] = v[0]; w[4 * i + 1] = v[1]; w[4 * i + 2] = v[2]; w[4 * i + 3] = v[3]; } }
    const int pr0 = tid >> 3, pp = tid & 7;
    const unsigned g_off = (unsigned)(pr0 * 128 + pp * 16);
    const int l_off0 = pr0 * 128 + ((pp ^ ((pr0 >> 1) & 7)) << 4), l_off1 = l_off0 + 64 * 128;
    const int rd_base = c * 128; const int sw = (c >> 1) & 7;
    int rd_off[4];
#pragma unroll
    for (int ks = 0; ks < 4; ++ks) rd_off[ks] = rd_base + (((2 * ks + hi) ^ sw) << 4);
    unsigned* myscr = scr + (size_t)(2 * wid + hi) * T + c;
    asm volatile("" :: "v"(A[0]), "v"(A[1]), "v"(A[2]), "v"(A[3]), "v"(w[0]), "v"(w[4]), "v"(w[8]), "v"(w[12]));
    s16x8 st0, st1;
    { const char* src = KIb; st0 = *reinterpret_cast<const s16x8*>(src + g_off); st1 = *reinterpret_cast<const s16x8*>(src + 64 * 128 + g_off); }
    *reinterpret_cast<s16x8*>(lds + l_off0) = st0; *reinterpret_cast<s16x8*>(lds + l_off1) = st1;
    __syncthreads();
#pragma unroll 1
    for (int ch = 0; ch < nch; ++ch) {
        const char* buf = lds + (ch & 1) * CHB;
        if (ch + 1 < nch) { const char* src = KIb + (size_t)(ch + 1) * CHB; st0 = *reinterpret_cast<const s16x8*>(src + g_off); st1 = *reinterpret_cast<const s16x8*>(src + 64 * 128 + g_off); }
#pragma unroll
        for (int st = 0; st < 4; ++st) {
            f32x16 acc = {};
#pragma unroll
            for (int ks = 0; ks < 4; ++ks) { const s16x8 Bf = *reinterpret_cast<const s16x8*>(buf + st * 4096 + rd_off[ks]);
                acc = __builtin_amdgcn_mfma_f32_32x32x16_f16(__builtin_bit_cast(h16x8, A[ks]), __builtin_bit_cast(h16x8, Bf), acc, 0, 0, 0); }
            float sc = 0.f;
#pragma unroll
            for (int r = 0; r < 16; ++r) { const int ri = __float_as_int(acc[r]); sc = fmaf(w[r], __int_as_float(ri > 0 ? ri : 0), sc); }
            const int sidx = ch * CHK + st * 32 + c;
            myscr[ch * CHK + st * 32] = (sidx <= t) ? fkey(sc) : 0u;
        }
        if (ch + 1 < nch) { char* dst = lds + ((ch + 1) & 1) * CHB; *reinterpret_cast<s16x8*>(dst + l_off0) = st0; *reinterpret_cast<s16x8*>(dst + l_off1) = st1; }
        __syncthreads();
    }
    asm volatile("s_waitcnt vmcnt(0)" ::: "memory");
    u64* MASK = (u64*)(ws + WS_MASK);
#pragma unroll 1
    for (int qq = 0; qq < 2; ++qq) {
        const int tq = t0 + qq, nj = (tq >> 6) + 1;
        const unsigned* src = scr + (size_t)(2 * wid + qq) * T + lane;
        unsigned key[64];
#pragma unroll
        for (int j = 0; j < 64; ++j) key[j] = (j < nj) ? __hip_atomic_load(src + 64 * j, __ATOMIC_RELAXED, __HIP_MEMORY_SCOPE_AGENT) : 0u;
        u64 mw;
        if (tq + 1 <= TOPK) {
            mw = 0;
#pragma unroll
            for (int j = 0; j < 4; ++j) { const u64 bal = __ballot(key[j] != 0u); if (lane == j) mw = bal; }
        } else mw = topk_select_hist(key, tq + 1, lane, (LAS unsigned*)(lds + 2 * CHB + wid * 8192));
        MASK[(size_t)(b * T + tq) * 64 + lane] = mw;
    }
}
}

namespace att {
constexpr int NW = 8, QBLK = 32, KVBLK = 64, QB = NW * QBLK, D = 128;
constexpr int SHM_V = KVBLK * D * 2, SHM_K = KVBLK * D * 2;
constexpr int LDS_NEED = 2 * SHM_V + 2 * SHM_K + NW * 64 * 4;
constexpr float THR = 8.f, SCALE = 0.08838834764831845f;
typedef short s16x8 __attribute__((ext_vector_type(8)));
typedef short s16x4 __attribute__((ext_vector_type(4)));
typedef float f32x16 __attribute__((ext_vector_type(16)));
#define KSWZ(row, colB) ((row) * 256 + ((colB) ^ (((row) & 7) << 4)))
#define SBAR() __builtin_amdgcn_sched_barrier(0)
__device__ __forceinline__ int v_st(int k, int c) { const int kk = (k & ~0xC) | ((k & 4) << 1) | ((k & 8) >> 1); return ((kk >> 3) * 4 + (c >> 5)) * 512 + ((kk & 7) * 32 + (c & 31)) * 2; }
__device__ __forceinline__ int v_rd_base(int lane) { return ((lane & 3) << 3) | (((lane >> 2) & 3) << 6) | (((lane >> 4) & 1) << 5) | (((lane >> 5) & 1) << 8); }
constexpr int v_rd_off(int d0, int ks, int half) { return d0 * 512 + ks * 4096 + half * 2048; }
__device__ __forceinline__ int crow(int r, int hi) { return (r & 3) + 8 * (r >> 2) + 4 * hi; }
__device__ __forceinline__ unsigned cvtpk(float lo, float hi) { unsigned r; asm volatile("v_cvt_pk_f16_f32 %0, %1, %2" : "=v"(r) : "v"(lo), "v"(hi)); return r; }
__device__ __forceinline__ f32x16 mfma16(s16x8 a, s16x8 b, f32x16 c) { return __builtin_amdgcn_mfma_f32_32x32x16_f16(__builtin_bit_cast(h16x8, a), __builtin_bit_cast(h16x8, b), c, 0, 0, 0); }
__device__ __forceinline__ s16x8 load8(const h16* p) { return *reinterpret_cast<const s16x8*>(p); }
__device__ __forceinline__ void mask_causal(f32x16& p0, f32x16& p1, int dq) {
    const float NEG = -__builtin_inff();
#pragma unroll
    for (int r = 0; r < 16; ++r) { const int c = (r & 3) + 8 * (r >> 2); if (dq - c < 0) p0[r] = NEG; if (dq - c - 32 < 0) p1[r] = NEG; }
}
__device__ __forceinline__ void mask_bits(f32x16& p0, f32x16& p1, u64 w, int hi) {
    const float NEG = -__builtin_inff();
    const unsigned lo = (unsigned)w >> (4 * hi), up = (unsigned)(w >> 32) >> (4 * hi);
#pragma unroll
    for (int r = 0; r < 16; ++r) { const int c = (r & 3) + 8 * (r >> 2); if (!((lo >> c) & 1u)) p0[r] = NEG; if (!((up >> c) & 1u)) p1[r] = NEG; }
}
__device__ __forceinline__ void partialSM(f32x16& p0, f32x16& p1, float& m_reg, float& mn, float& alpha) {
    float pmax = p0[0]; for (int r = 1; r < 16; ++r) pmax = fmaxf(pmax, p0[r]); for (int r = 0; r < 16; ++r) pmax = fmaxf(pmax, p1[r]);
    { auto rr = __builtin_amdgcn_permlane32_swap(__float_as_uint(pmax), __float_as_uint(pmax), false, false);
      pmax = fmaxf(__uint_as_float(rr[0]), __uint_as_float(rr[1])); }
    constexpr float C2 = 1.4426950408889634f * SCALE;
    if (__builtin_expect(__all((pmax - m_reg) * SCALE <= THR), 1)) { mn = m_reg; alpha = 1.f; }
    else { mn = fmaxf(m_reg, pmax); alpha = __builtin_amdgcn_exp2f((m_reg - mn) * C2); m_reg = mn; }
    const float mnL = -mn * C2;
    for (int r = 0; r < 16; ++r) p0[r] = fmaf(p0[r], C2, mnL); for (int r = 0; r < 16; ++r) p1[r] = fmaf(p1[r], C2, mnL);
    for (int r = 0; r < 16; ++r) p0[r] = __builtin_amdgcn_exp2f(p0[r]);
}
__device__ __forceinline__ void finishSM(f32x16& p0, f32x16& p1, float alpha, float& l_reg, s16x8& pa0, s16x8& pa1, s16x8& pa2, s16x8& pa3) {
    for (int r = 0; r < 16; ++r) p1[r] = __builtin_amdgcn_exp2f(p1[r]);
    float ps = 0; for (int r = 0; r < 16; ++r) ps += p0[r]; for (int r = 0; r < 16; ++r) ps += p1[r];
    { auto rr = __builtin_amdgcn_permlane32_swap(__float_as_uint(ps), __float_as_uint(ps), false, false);
      ps = __uint_as_float(rr[0]) + __uint_as_float(rr[1]); }
    l_reg = l_reg * alpha + ps;
#define PK4(P, B_, OUT) do { unsigned a0 = cvtpk(P[B_+0], P[B_+1]), a1 = cvtpk(P[B_+2], P[B_+3]);                          \
        unsigned b0 = cvtpk(P[B_+4], P[B_+5]), b1 = cvtpk(P[B_+6], P[B_+7]);                                             \
        auto r0 = __builtin_amdgcn_permlane32_swap(a0, b0, false, false); auto r1 = __builtin_amdgcn_permlane32_swap(a1, b1, false, false); \
        u32x4 w = {r0[0], r1[0], r0[1], r1[1]}; OUT = *reinterpret_cast<s16x8*>(&w); } while (0)
    PK4(p0, 0, pa0); PK4(p0, 8, pa1); PK4(p1, 0, pa2); PK4(p1, 8, pa3);
#undef PK4
}
template <int KB>
__device__ __forceinline__ void qkt(f32x16& p0, f32x16& p1, const char* K_lds, int r32, int hi, const s16x8* qr) {
    const char* kb[4];
#pragma unroll
    for (int dd = 0; dd < 4; ++dd) kb[dd] = K_lds + KB * SHM_K + KSWZ(r32, (dd * 16 + hi * 8) * 2);
#pragma unroll
    for (int d0 = 0; d0 < 8; ++d0) { const char* a = kb[d0 & 3] + (d0 >> 2) * 128;
        s16x8 b0 = *reinterpret_cast<const s16x8*>(a);
        s16x8 b1 = *reinterpret_cast<const s16x8*>(a + 32 * 256);
        p0 = mfma16(b0, qr[d0], p0);
        p1 = mfma16(b1, qr[d0], p1); }
}
template <int VB>
__device__ __forceinline__ void pv_tile(f32x16* o, int vb0, s16x8 pa0, s16x8 pa1, s16x8 pa2, s16x8 pa3) {
#define TRRD(dst, off) asm volatile("ds_read_b64_tr_b16 %0, %1 offset:%2" : "=&v"(dst) : "v"(vb0), "i"(off) : "memory")
#define PV_D0(d0) do { s16x4 l0, l1, l2, l3, h0, h1, h2, h3; constexpr int b_ = VB * SHM_V + v_rd_off(d0, 0, 0); \
        TRRD(l0, b_); TRRD(h0, b_ + 2048); TRRD(l1, b_ + 4096); TRRD(h1, b_ + 6144); TRRD(l2, b_ + 8192); TRRD(h2, b_ + 10240); TRRD(l3, b_ + 12288); TRRD(h3, b_ + 14336); \
        asm volatile("s_waitcnt lgkmcnt(0)" ::: "memory"); SBAR();   \
        o[d0] = mfma16(pa0, (s16x8){l0[0], l0[1], l0[2], l0[3], h0[0], h0[1], h0[2], h0[3]}, o[d0]);   \
        o[d0] = mfma16(pa1, (s16x8){l1[0], l1[1], l1[2], l1[3], h1[0], h1[1], h1[2], h1[3]}, o[d0]);   \
        o[d0] = mfma16(pa2, (s16x8){l2[0], l2[1], l2[2], l2[3], h2[0], h2[1], h2[2], h2[3]}, o[d0]);   \
        o[d0] = mfma16(pa3, (s16x8){l3[0], l3[1], l3[2], l3[3], h3[0], h3[1], h3[2], h3[3]}, o[d0]); } while (0)
    PV_D0(0); PV_D0(1); PV_D0(2); PV_D0(3);
#undef PV_D0
#undef TRRD
}
struct BlockRef { const char* Q; const char* K; const char* V; char* O; int P0; const char* NBQ; const char* MK;
                  int j0, nt;
                  int part;
                  char* PART; unsigned* flag; };
struct Seam { s16x8 qr[8]; };
#define LD16(base, off) (*reinterpret_cast<const s16x8*>((base) + (off)))
#define VMW() asm volatile("s_waitcnt vmcnt(0)" ::: "memory")
#define VMWN(n) asm volatile("s_waitcnt vmcnt(%0)" :: "i"(n) : "memory")
#define SLOAD_H(Kp, Vp, k0) do { const char* vb_ = (Vp) + (size_t)(k0) * (D * 2); const char* kb_ = (Kp) + (size_t)(k0) * (D * 2); \
        st_v0 = LD16(vb_, st_off); st_v1 = LD16(vb_ + 32 * D * 2, st_off); st_k0 = LD16(kb_, st_off); st_k1 = LD16(kb_ + 32 * D * 2, st_off); } while (0)
#define SWRITE_HK(bf) do { *(s16x8*)(K_lds + (bf) * SHM_K + kws) = st_k0; *(s16x8*)(K_lds + (bf) * SHM_K + kws + 32 * 256) = st_k1; } while (0)
#define SWRITE_HV(bf) do { *(s16x8*)(V_lds + (bf) * SHM_V + vst0) = st_v0; *(s16x8*)(V_lds + (bf) * SHM_V + vst1) = st_v1; } while (0)
#define SWRITE_H(bf) do { SWRITE_HV(bf); SWRITE_HK(bf); } while (0)
__device__ __forceinline__ void prime(const BlockRef& cur, char* lds, Seam& S, int wv) {
    int tid = wv * 64 + lane_id(); asm volatile("" : "+v"(tid));
    const int wid = __builtin_amdgcn_readfirstlane(tid >> 6), lane = tid & 63, r32 = lane & 31, hi = lane >> 5;
    const unsigned q_off = (unsigned)((wid * QBLK + r32) * D + hi * 8) * 2u;
#pragma unroll
    for (int d0 = 0; d0 < 8; ++d0) S.qr[d0] = LD16(cur.Q + d0 * 32, q_off);
}
template <bool MIXB, int ROLE>
__device__ __forceinline__ void block(const BlockRef& cur, const BlockRef& nxt, char* lds, Seam& S, int wv) {
    constexpr bool CONS = ROLE == 2;
    int tid = wv * 64 + lane_id(); asm volatile("" : "+v"(tid));
    const int wid = __builtin_amdgcn_readfirstlane(tid >> 6), lane = tid & 63, r32 = lane & 31, hi = lane >> 5;
    int NT = cur.nt, J0 = cur.j0;
    const int qlo = cur.P0 + wid * QBLK, qm = qlo + r32 - 4 * hi;
    char* V_lds = lds; char* K_lds = lds + 2 * SHM_V;
    float* wsf = (float*)(lds + 2 * SHM_V + 2 * SHM_K) + wid * 64; float* li_l = wsf, * al_l = wsf + 32;
    float m_reg = -1e30f, l_reg = 0; f32x16 o[4] = {};
    const int sr = tid >> 4, sc = (tid & 15) * 8, vst0 = v_st(sr, sc), vst1 = v_st(32 + sr, sc), kws = KSWZ(sr, sc * 2);
    const int vb0 = (int)(uintptr_t)V_lds + v_rd_base(lane);
    const unsigned st_off = (unsigned)(sr * D + sc) * 2u, q_off = (unsigned)((wid * QBLK + r32) * D + hi * 8) * 2u;
    const unsigned nb_off = (unsigned)hi * 16u, mk_off = (unsigned)(wid * QBLK + r32) * 512u;
    const char* Kh = cur.K; const char* Vh = cur.V;
    const char* bias_l = lds + LDS_NEED;
    if (MIXB) {
        float* cs = (float*)bias_l; float* wtot = (float*)(lds + LDS_NEED + 16384);
        const int L = cur.P0 + QB; const float* lf = (const float*)cur.NBQ;
        float v[8];
        if (8 * tid < L) { const f32x4 a = *(const f32x4*)(lf + 8 * tid), b4 = *(const f32x4*)(lf + 8 * tid + 4); v[0] = a[0]; v[1] = a[1]; v[2] = a[2]; v[3] = a[3]; v[4] = b4[0]; v[5] = b4[1]; v[6] = b4[2]; v[7] = b4[3]; }
        else {
#pragma unroll
            for (int i = 0; i < 8; ++i) v[i] = 0.f; }
#pragma unroll
        for (int i = 1; i < 8; ++i) v[i] += v[i - 1];
        float inc = v[7];
#pragma unroll
        for (int o_ = 1; o_ < 64; o_ <<= 1) { const float nb = __shfl_up(inc, o_); if (lane >= o_) inc += nb; }
        if (lane == 63) wtot[wid] = inc;
        __syncthreads();
        float base = inc - v[7];
#pragma unroll
        for (int w_ = 0; w_ < 7; ++w_) base += (w_ < wid) ? wtot[w_] : 0.f;
        if (8 * tid < L) {
#pragma unroll
            for (int i = 0; i < 8; ++i) cs[8 * tid + i] = (base + v[i]) * -11.313708498984761f; }
        __syncthreads();
        { const float qk2 = __int_as_float(cur.j0);
          const int s_ = 64 * lane + 63; const float dc = (s_ < cur.P0) ? (cs[s_] - cs[cur.P0]) * SCALE : 0.f;
          const bool keep = (s_ >= cur.P0) || (qk2 + dc >= -40.0f);
          J0 = __builtin_ctzll(__ballot(keep)); NT = cur.P0 / KVBLK + 4 - J0; }
        const float nbref = cs[L - 1];
        __syncthreads();
        for (int i = J0 * KVBLK + tid; i < L; i += NW * 64) cs[i] -= nbref;
        __syncthreads(); }
#define RESC(a) do { if (__any((a) < 1.f)) { if (hi == 0) al_l[r32] = (a); asm volatile("s_waitcnt lgkmcnt(0)" ::: "memory");              \
                     for (int d_ = 0; d_ < 4; ++d_) for (int r = 0; r < 16; ++r) o[d_][r] *= al_l[crow(r, hi)]; } } while (0)
#define KBASE(t) ((J0 + (t)) * KVBLK)
#define MKW(t) (*(const u64*)(cur.MK + (size_t)(J0 + (t)) * 8 + mk_off))
#define PINIT(P0_, P1_, t, MW_) do { if (MIXB) { const char* nb_ = bias_l + KBASE(t) * 4 + nb_off; _Pragma("unroll") for (int g_ = 0; g_ < 4; ++g_) { \
            const f32x4 b0_ = *(const f32x4*)(nb_ + 32 * g_), b1_ = *(const f32x4*)(nb_ + 128 + 32 * g_); \
            _Pragma("unroll") for (int j_ = 0; j_ < 4; ++j_) { P0_[4 * g_ + j_] = b0_[j_]; P1_[4 * g_ + j_] = b1_[j_]; } } } else { const u64 w_ = (MW_); const unsigned lo_ = (unsigned)w_ >> (4 * hi), up_ = (unsigned)(w_ >> 32) >> (4 * hi); \
            _Pragma("unroll") for (int r_ = 0; r_ < 16; ++r_) { const int c_ = (r_ & 3) + 8 * (r_ >> 2); \
                P0_[r_] = __uint_as_float((((lo_ >> c_) & 1u) - 1u) & 0xff800000u); P1_[r_] = __uint_as_float((((up_ >> c_) & 1u) - 1u) & 0xff800000u); } } } while (0)
#define MASKT(P0_, P1_, t, MW_) do { if (MIXB) { const int kb_ = KBASE(t); if (kb_ + KVBLK - 1 > qlo) mask_causal(P0_, P1_, qm - kb_); } } while (0)
    f32x16 pA0, pA1, pB0, pB1; float mnA, mnB, alA, alB; s16x8 pa0, pa1, pa2, pa3;
    u64 mwA = 0, mwB = 0;
    if (!MIXB) { mwA = MKW(0); if (NT > 1) mwB = MKW(1); }
    PINIT(pA0, pA1, 0, mwA); if (!MIXB) { if (NT > 2) mwA = MKW(2); }
    if (NT > 1) { PINIT(pB0, pB1, 1, mwB); if (!MIXB) { if (NT > 3) mwB = MKW(3); } }
    s16x8 st_v0, st_v1, st_k0, st_k1;
    SLOAD_H(Kh, Vh, KBASE(0)); VMW(); SWRITE_HK(0); SWRITE_HV(0); SBAR();
    __syncthreads();
    if (NT > 1) SLOAD_H(Kh, Vh, KBASE(1));
    SBAR(); qkt<0>(pA0, pA1, K_lds, r32, hi, S.qr);
    MASKT(pA0, pA1, 0, mwA);
    partialSM(pA0, pA1, m_reg, mnA, alA);
    if (NT > 1) { VMW(); SWRITE_H(1); }
    __syncthreads();
#define HALF_STEP(PX0, PX1, mnX, alX, MWX, PY0, PY1, alY, MWY, t, KB, VB, SB) do {                                               \
        SBAR(); qkt<KB>(PX0, PX1, K_lds, r32, hi, S.qr);                                                                      \
        finishSM(PY0, PY1, alY, l_reg, pa0, pa1, pa2, pa3); SBAR();                                                           \
        if ((t) + 1 < NT) { PINIT(PY0, PY1, (t) + 1, MWY); if (!MIXB) { if ((t) + 3 < NT) MWY = MKW((t) + 3); } SLOAD_H(Kh, Vh, KBASE((t) + 1)); SBAR(); }                             \
        pv_tile<VB>(o, vb0, pa0, pa1, pa2, pa3); MASKT(PX0, PX1, (t), MWX); \
        partialSM(PX0, PX1, m_reg, mnX, alX);                                                                                 \
        __syncthreads();                                                                                                      \
        if ((t) + 1 < NT) { VMW(); SWRITE_H(SB); }                                                                            \
        RESC(alX); __syncthreads(); } while (0)
    for (int t = 1; t + 1 < NT; t += 2) {
        HALF_STEP(pB0, pB1, mnB, alB, mwB, pA0, pA1, alA, mwA, t, 1, 0, 0);
        HALF_STEP(pA0, pA1, mnA, alA, mwA, pB0, pB1, alB, mwB, t + 1, 0, 1, 1);
    }
    const bool even = (NT & 1) == 0;
    if (even) { SBAR(); qkt<1>(pB0, pB1, K_lds, r32, hi, S.qr); SBAR(); }
    if (!CONS) {
#pragma unroll
        for (int d0 = 0; d0 < 8; ++d0) S.qr[d0] = LD16(nxt.Q + d0 * 32, q_off); }
    SBAR();
    finishSM(pA0, pA1, alA, l_reg, pa0, pa1, pa2, pa3); SBAR();
    pv_tile<0>(o, vb0, pa0, pa1, pa2, pa3);
    if (even) { MASKT(pB0, pB1, NT - 1, mwB); partialSM(pB0, pB1, m_reg, mnB, alB); __syncthreads(); RESC(alB);
        finishSM(pB0, pB1, alB, l_reg, pa0, pa1, pa2, pa3); SBAR(); pv_tile<1>(o, vb0, pa0, pa1, pa2, pa3); }
    constexpr float C2E = 1.4426950408889634f * SCALE;
    if (!CONS && cur.part == 1) {
        float* po = (float*)cur.PART + (size_t)wid * (64 * 64) + lane;
#pragma unroll
        for (int d0 = 0; d0 < 4; ++d0)
#pragma unroll
            for (int r = 0; r < 16; ++r) po[(d0 * 16 + r) * 64] = o[d0][r];
        float* pml = (float*)cur.PART + 8 * 64 * 64 + wid * 128;
        pml[lane] = m_reg; pml[64 + lane] = l_reg;
        asm volatile("s_waitcnt vmcnt(0)" ::: "memory");
        __syncthreads();
        if (tid == 0) { __builtin_amdgcn_fence(__ATOMIC_RELEASE, "agent"); asm volatile("s_waitcnt vmcnt(0)" ::: "memory"); __hip_atomic_store(cur.flag, 1u, __ATOMIC_RELAXED, __HIP_MEMORY_SCOPE_AGENT); }
    } else {
        float a_me = 1.f;
        if (CONS) {
            if (tid == 0) { unsigned spins = 0; while (__hip_atomic_load(cur.flag, __ATOMIC_RELAXED, __HIP_MEMORY_SCOPE_AGENT) == 0u) { __builtin_amdgcn_s_sleep(4); if (++spins > (1u << 22)) break; }
                __builtin_amdgcn_fence(__ATOMIC_ACQUIRE, "agent"); asm volatile("s_waitcnt vmcnt(0)" ::: "memory"); }
            __syncthreads();
            const float* pml = (const float*)cur.PART + 8 * 64 * 64 + wid * 128;
            const float m2 = pml[lane], l2 = pml[64 + lane];
            const float mm = fmaxf(m_reg, m2); a_me = __builtin_amdgcn_exp2f((m_reg - mm) * C2E); const float a_ot = __builtin_amdgcn_exp2f((m2 - mm) * C2E);
            l_reg = l_reg * a_me + l2 * a_ot;
            if (hi == 0) { li_l[r32] = a_me; al_l[r32] = a_ot; } asm volatile("s_waitcnt lgkmcnt(0)" ::: "memory");
            const float* po = (const float*)cur.PART + (size_t)wid * (64 * 64) + lane;
#pragma unroll
            for (int r = 0; r < 16; ++r) { const float fa = li_l[crow(r, hi)], fb = al_l[crow(r, hi)];
#pragma unroll
                for (int d0 = 0; d0 < 4; ++d0) o[d0][r] = o[d0][r] * fa + po[(d0 * 16 + r) * 64] * fb; }
            asm volatile("s_waitcnt lgkmcnt(0)" ::: "memory");
        }
        if (hi == 0) li_l[r32] = l_reg; asm volatile("s_waitcnt lgkmcnt(0)" ::: "memory");
        float rli[16];
#pragma unroll
        for (int r = 0; r < 16; ++r) rli[r] = __builtin_amdgcn_rcpf(li_l[crow(r, hi)]);
        const unsigned o_off = (unsigned)((wid * QBLK + 4 * hi) * 1024 + r32) * 2u;
#pragma unroll
        for (int r = 0; r < 16; ++r) {
#pragma unroll
            for (int d0 = 0; d0 < 4; ++d0) { const float v = o[d0][r] * rli[r];
                const float vn = __shfl_xor(v, 1);
                if ((r32 & 1) == 0) *(unsigned*)(cur.O + (size_t)(((r & 3) + 8 * (r >> 2)) * 2048 + d0 * 64) + o_off) = cvtpk(v, vn); } }
    }
    __syncthreads();
#undef RESC
#undef KBASE
#undef PINIT
#undef MKW
#undef MASKT
#undef HALF_STEP
}
#undef LD16
#undef VMW
#undef VMWN
#undef SLOAD_H
#undef SWRITE_HK
#undef SWRITE_HV
#undef SWRITE_H
constexpr int SCHED_MAXI = 3;
__device__ const short SCHED[256][3] = {
  {6752, 242, -1},
  {6768, 498, -1},
  {6784, 754, -1},
  {6800, 1010, -1},
  {6816, 1266, -1},
  {6832, 1522, -1},
  {6848, 1778, -1},
  {6864, 2034, -1},
  {6880, 2290, -1},
  {6896, 2546, -1},
  {6944, 2802, -1},
  {6960, 3058, -1},
  {6976, 3314, -1},
  {6992, 3570, -1},
  {7008, 3826, -1},
  {7024, 4082, -1},
  {5856, 226, -1},
  {5872, 482, -1},
  {5920, 738, -1},
  {5936, 994, -1},
  {5952, 1250, -1},
  {5968, 1506, -1},
  {5984, 1762, -1},
  {6000, 2018, -1},
  {6016, 2274, -1},
  {6032, 2530, -1},
  {6048, 2786, -1},
  {6064, 3042, -1},
  {6080, 3298, -1},
  {6096, 3554, -1},
  {6112, 3810, -1},
  {6128, 4066, -1},
  {2064, 5280, 210},
  {5296, 6160, 466},
  {2320, 5312, 722},
  {5328, 6416, 978},
  {2576, 5344, 1234},
  {5360, 6672, 1490},
  {2832, 5408, 1746},
  {5424, 6928, 2002},
  {3088, 5440, 2258},
  {5456, 7184, 2514},
  {3344, 5472, 2770},
  {5488, 7440, 3026},
  {3600, 5504, 3282},
  {5520, 7696, 3538},
  {3856, 5536, 3794},
  {5552, 7952, 4050},
  {4416, 7328, 194},
  {4432, 7344, 450},
  {4448, 7360, 706},
  {4464, 7376, 962},
  {4480, 7392, 1218},
  {4496, 7408, 1474},
  {4512, 7456, 1730},
  {4528, 7472, 1986},
  {4544, 7488, 2242},
  {4560, 7504, 2498},
  {4576, 7520, 2754},
  {4592, 7536, 3010},
  {4640, 7552, 3266},
  {4656, 7568, 3522},
  {4672, 7584, 3778},
  {4688, 7600, 4034},
  {32, 7616, 178},
  {288, 7632, 434},
  {544, 7648, 690},
  {800, 7664, 946},
  {1056, 7712, 1202},
  {1312, 7728, 1458},
  {1568, 7744, 1714},
  {1824, 7760, 1970},
  {2080, 7776, 2226},
  {2336, 7792, 2482},
  {2592, 7808, 2738},
  {2848, 7824, 2994},
  {3104, 7840, 3250},
  {3360, 7856, 3506},
  {3616, 7872, 3762},
  {3872, 7888, 4018},
  {2112, 162, -1},
  {2193, 418, -1},
  {2368, 674, -1},
  {2449, 930, -1},
  {2624, 1186, -1},
  {2705, 1442, -1},
  {2880, 1698, -1},
  {2961, 1954, -1},
  {3136, 2210, -1},
  {3217, 2466, -1},
  {3392, 2722, -1},
  {3473, 2978, -1},
  {3648, 3234, -1},
  {3729, 3490, -1},
  {3904, 3746, -1},
  {3985, 4002, -1},
  {64, 146, -1},
  {145, 402, -1},
  {320, 658, -1},
  {401, 914, -1},
  {576, 1170, -1},
  {657, 1426, -1},
  {832, 1682, -1},
  {913, 1938, -1},
  {1088, 2194, -1},
  {1169, 2450, -1},
  {1344, 2706, -1},
  {1425, 2962, -1},
  {1600, 3218, -1},
  {1681, 3474, -1},
  {1856, 3730, -1},
  {1937, 3986, -1},
  {161, 130, -1},
  {417, 386, -1},
  {673, 642, -1},
  {929, 898, -1},
  {1185, 1154, -1},
  {1441, 1410, -1},
  {1697, 1666, -1},
  {1953, 1922, -1},
  {2209, 2178, -1},
  {2465, 2434, -1},
  {2721, 2690, -1},
  {2977, 2946, -1},
  {3233, 3202, -1},
  {3489, 3458, -1},
  {3745, 3714, -1},
  {4001, 3970, -1},
  {112, 6176, -1},
  {241, 6192, -1},
  {368, 6208, -1},
  {497, 6224, -1},
  {624, 6240, -1},
  {753, 6256, -1},
  {880, 6272, -1},
  {1009, 6288, -1},
  {1136, 6304, -1},
  {1265, 6320, -1},
  {1392, 6336, -1},
  {1521, 6352, -1},
  {1648, 6368, -1},
  {1777, 6384, -1},
  {1904, 6432, -1},
  {2033, 6448, -1},
  {2160, 6464, -1},
  {2289, 6480, -1},
  {2416, 6496, -1},
  {2545, 6512, -1},
  {2672, 6528, -1},
  {2801, 6544, -1},
  {2928, 6560, -1},
  {3057, 6576, -1},
  {3184, 6592, -1},
  {3313, 6608, -1},
  {3440, 6624, -1},
  {3569, 6640, -1},
  {3696, 6688, -1},
  {3825, 6704, -1},
  {3952, 6720, -1},
  {4081, 6736, -1},
  {225, 0, 5568},
  {481, 5584, 4096},
  {737, 256, 5600},
  {993, 5616, 4352},
  {1249, 512, 5664},
  {1505, 5680, 4608},
  {1761, 768, 5696},
  {2017, 5712, 4864},
  {2273, 1024, 5728},
  {2529, 5744, 5120},
  {2785, 1280, 5760},
  {3041, 5776, 5376},
  {3297, 1536, 5792},
  {3553, 5808, 5632},
  {3809, 1792, 5824},
  {4065, 5840, 5888},
  {96, 4704, 7904},
  {209, 4720, 7920},
  {352, 4736, 7968},
  {465, 4752, 7984},
  {608, 4768, 8000},
  {721, 4784, 8016},
  {864, 4800, 8032},
  {977, 4816, 8048},
  {1120, 4832, 8064},
  {1233, 4848, 8080},
  {1376, 4896, 8096},
  {1489, 4912, 8112},
  {1632, 4928, 8128},
  {1745, 4944, 8144},
  {1888, 4960, 8160},
  {2001, 4976, 8176},
  {2144, 16, 4992},
  {2257, 5008, 4112},
  {2400, 272, 5024},
  {2513, 5040, 4368},
  {2656, 528, 5056},
  {2769, 5072, 4624},
  {2912, 784, 5088},
  {3025, 5104, 4880},
  {3168, 1040, 5152},
  {3281, 5168, 5136},
  {3424, 1296, 5184},
  {3537, 5200, 5392},
  {3680, 1552, 5216},
  {3793, 5232, 5648},
  {3936, 1808, 5248},
  {4049, 5264, 5904},
  {193, 4128, 7040},
  {449, 4144, 7056},
  {705, 4160, 7072},
  {961, 4176, 7088},
  {1217, 4192, 7104},
  {1473, 4208, 7120},
  {1729, 4224, 7136},
  {1985, 4240, 7152},
  {2241, 4256, 7200},
  {2497, 4272, 7216},
  {2753, 4288, 7232},
  {3009, 4304, 7248},
  {3265, 4320, 7264},
  {3521, 4336, 7280},
  {3777, 4384, 7296},
  {4033, 4400, 7312},
  {129, 80, -1},
  {177, 385, -1},
  {641, 336, -1},
  {433, 897, -1},
  {1153, 592, -1},
  {689, 1409, -1},
  {1665, 848, -1},
  {945, 1921, -1},
  {2177, 1104, -1},
  {1201, 2433, -1},
  {2689, 1360, -1},
  {1457, 2945, -1},
  {3201, 1616, -1},
  {1713, 3457, -1},
  {3713, 1872, -1},
  {1969, 3969, -1},
  {2128, 48, 2048},
  {2225, 304, 6144},
  {2384, 560, 2304},
  {2481, 816, 6400},
  {2640, 1072, 2560},
  {2737, 1328, 6656},
  {2896, 1584, 2816},
  {2993, 1840, 6912},
  {3152, 2096, 3072},
  {3249, 2352, 7168},
  {3408, 2608, 3328},
  {3505, 2864, 7424},
  {3664, 3120, 3584},
  {3761, 3376, 7680},
  {3920, 3632, 3840},
  {4017, 3888, 7936},
};

__device__ __forceinline__ BlockRef make_ref(int code, unsigned char* ws) {
    const bool mixb = (code >> 12) != 0; const int bh = (code >> 8) & 15, qb = (code >> 4) & 15, part = code & 15;
    const int b = bh >> 3, h = bh & 7, kvh = mixb ? bh : (b * HAKV + (h >> 2));
    BlockRef r;
    r.Q = (const char*)ws + (mixb ? WS_QB : WS_QA) + ((size_t)bh * T + (size_t)qb * QB) * D * 2;
    r.K = (const char*)ws + (mixb ? WS_KB : WS_KA) + (size_t)kvh * T * D * 2;
    r.V = (const char*)ws + (mixb ? WS_VB : WS_VA) + (size_t)kvh * T * D * 2;
    r.O = (char*)ws + (mixb ? WS_OUTB : WS_OUTA) + ((size_t)(b * T + qb * QB) * 1024 + h * D) * 2;
    r.P0 = qb * QB;
    r.NBQ = (const char*)ws + WS_CB + (size_t)bh * T * 4;
    r.MK = (const char*)ws + WS_MASK + (size_t)(b * T + qb * QB) * 64 * 8;
    const int NTall = r.P0 / KVBLK + 4;
    r.part = part; r.j0 = 0; r.nt = NTall;
    r.PART = (char*)ws + WS_PART + (size_t)(bh * 8 + (qb & 7)) * 135168; r.flag = (unsigned*)(ws + WS_CTL) + CW_SPLIT + (bh * 8 + (qb & 7));
    if (part == 1) r.nt = NTall / 2; else if (part == 2) { r.j0 = NTall / 2; r.nt = NTall - NTall / 2; }
    if (mixb) {
        const unsigned* nrm = (const unsigned*)(ws + WS_NORM);
        float q2 = 0.f, k2 = 0.f;
#pragma unroll
        for (int w_ = 0; w_ < 4; ++w_) { q2 += __uint_as_float(nrm[(bh * 16 + qb) * 4 + w_]); k2 += __uint_as_float(nrm[1024 + bh * 4 + w_]); }
        const float qk = 2.02f * __builtin_sqrtf(q2 * k2) * SCALE;
        r.j0 = __float_as_int(qk);
        r.NBQ = (const char*)ws + WS_LOGF + (size_t)bh * T * 4;
    }
    return r;
}
__device__ __forceinline__ void run_list(int cu, unsigned char* ws, char* lds, int wv) {
    Seam S;
    int code = SCHED[cu][0];
    if (code < 0) return;
    BlockRef cur = make_ref(code, ws);
    prime(cur, lds, S, wv);
#pragma unroll 1
    for (int k = 0; k < SCHED_MAXI; ++k) {
        if ((code & 15) == 2) break;
        const int ncode = (k + 1 < SCHED_MAXI) ? SCHED[cu][k + 1] : -1;
        const BlockRef nxt = ncode >= 0 ? make_ref(ncode, ws) : cur;
        if ((code >> 12) != 0) block<true, 0>(cur, nxt, lds, S, wv); else block<false, 0>(cur, nxt, lds, S, wv);
        if (ncode < 0) return;
        cur = nxt; code = ncode;
    }
    block<false, 2>(cur, cur, lds, S, wv);
}
}


#define XB_TMO      128
#define XB_XCNT(j)  (256  + 64 * (j))
#define XB_XSUB(j)  (1280 + 64 * (j))
#define XB_XGEN(j)  (2304 + 64 * (j))
#define XB_TOP      3328
#define XB_TOPGEN   3392
#define XCD_BAR_WORDS 3456
#define XB_SPIN_CAP (1u << 24)
__device__ __forceinline__ unsigned xb_ld(unsigned* p)              { return __hip_atomic_load(p, __ATOMIC_RELAXED, __HIP_MEMORY_SCOPE_AGENT); }
__device__ __forceinline__ unsigned xb_add(unsigned* p, unsigned v) { return __hip_atomic_fetch_add(p, v, __ATOMIC_RELAXED, __HIP_MEMORY_SCOPE_AGENT); }
__device__ __forceinline__ unsigned xb_xcc_id() { return (unsigned)__builtin_amdgcn_s_getreg((3 << 11) | 20) & 0xFu; }
#define XB_SPIN(cond, bar) do { unsigned _sp = 0; while (cond) { __builtin_amdgcn_s_sleep(1); \
    if ((++_sp & 255u) == 0u) { if (xb_ld(&(bar)[XB_TMO])) break; if (_sp > XB_SPIN_CAP) { atomicAdd(&(bar)[XB_TMO], 1u); break; } } } } while (0)
struct XcdBarrier { unsigned* bar; unsigned x; volatile LAS unsigned* st; };
__device__ __forceinline__ XcdBarrier xcd_barrier_post(unsigned* bar, volatile LAS unsigned* st, int wv) {
    XcdBarrier b; b.bar = bar; b.x = xb_xcc_id(); b.st = st;
    if (wv == 0 && lane_id() == 0) (void)xb_add(&bar[XB_XCNT(b.x)], 1u);
    return b;
}
__device__ __forceinline__ void xcd_barrier_complete(unsigned* bar, unsigned x, unsigned& nloc, unsigned& nx) {
    const unsigned G = gridDim.x * gridDim.y * gridDim.z;
    unsigned sum, cnt, mine, sp = 0u;
    for (;;) {
        sum = 0u; cnt = 0u; mine = 0u;
#pragma unroll
        for (unsigned j = 0; j < 16; ++j) { const unsigned c = xb_ld(&bar[XB_XCNT(j)]); sum += c; cnt += (c > 0u) ? 1u : 0u; mine = (j == x) ? c : mine; }
        if (sum == G) break;
        __builtin_amdgcn_s_sleep(1);
        if ((++sp & 255u) == 0u) { if (xb_ld(&bar[XB_TMO])) break; if (sp > XB_SPIN_CAP) { atomicAdd(&bar[XB_TMO], 1u); break; } }
    }
    nloc = mine > 0u ? mine : 1u; nx = cnt > 0u ? cnt : 1u;
}
__device__ __forceinline__ void xcd_barrier(const XcdBarrier& b, int wv) {
    asm volatile("s_waitcnt vmcnt(0)" ::: "memory");
    __syncthreads();
    if (wv == 0 && lane_id() == 0) {
        unsigned* bar = b.bar;
        __builtin_amdgcn_s_waitcnt(0);
        unsigned nloc = b.st[0], nx = b.st[1];
        if (nloc == 0u) { xcd_barrier_complete(bar, b.x, nloc, nx); b.st[0] = nloc; b.st[1] = nx; }
        const unsigned old = xb_add(&bar[XB_XSUB(b.x)], 1u);
        const unsigned gen = old / nloc;
        if (old + 1u == (gen + 1u) * nloc) {
            __builtin_amdgcn_fence(__ATOMIC_RELEASE, "agent");
            asm volatile("s_waitcnt vmcnt(0)" ::: "memory");
            const unsigned og = xb_add(&bar[XB_TOP], 1u);
            const unsigned tg = og / nx;
            if (og + 1u == (tg + 1u) * nx) xb_add(&bar[XB_TOPGEN], 1u);
            else XB_SPIN(xb_ld(&bar[XB_TOPGEN]) == tg, bar);
            __builtin_amdgcn_fence(__ATOMIC_ACQUIRE, "agent");
            xb_add(&bar[XB_XGEN(b.x)], 1u);
            asm volatile("s_waitcnt vmcnt(0)" ::: "memory");
        } else {
            XB_SPIN(xb_ld(&bar[XB_XGEN(b.x)]) == gen, bar);
            __builtin_amdgcn_fence(__ATOMIC_ACQUIRE, "agent");
            asm volatile("s_waitcnt vmcnt(0)" ::: "memory");
        }
    }
    __syncthreads();
}

namespace cg = cooperative_groups;
#ifndef PROBE_DUP
#define PROBE_DUP 0
#endif
#define REP(k) for (int rep_ = 0; rep_ < (((PROBE_DUP) >> (k)) & 1) + 1; ++rep_)
constexpr int LDS_BYTES = pg8::STAGE_BYTES + 256;
struct Params { const float* in[17]; float* out; unsigned char* ws; };
template <class Epi>
__device__ __forceinline__ void run_gemm(LAS unsigned char* lds, const h16* A, const h16* Bt, int M, int N, int K, const Epi& e, int wv) {
    pg8::Gemm g{A, Bt, M, N, K}; pg8::StaticOrder S; S.init(M, N, (int)gridDim.x, (int)blockIdx.x);
    pg8::gemm_phase<Epi>(lds, g, S, e, wv);
}
__global__ void __launch_bounds__(512, 2) mega_fwd(Params P) {
    extern __shared__ __attribute__((aligned(16))) unsigned char lds_raw[];
    LAS unsigned char* lds = (LAS unsigned char*)lds_raw;
    const int wv = __builtin_amdgcn_readfirstlane(threadIdx.x >> 6);
    volatile LAS unsigned* bst = (volatile LAS unsigned*)(lds + pg8::STAGE_BYTES);
    if (wv == 0 && lane_id() < 2) bst[lane_id()] = 0u;
    __syncthreads();
    const XcdBarrier xbar = xcd_barrier_post((unsigned*)(P.ws + WS_CTL) + CW_BAR, bst, wv);
#define GRID_BAR() xcd_barrier(xbar, wv)
#define IDS() int lane = lane_id(); asm volatile("" : "+v"(lane)); const int wave = wv, tid = wave * 64 + lane, gw = blockIdx.x * 8 + wave, NGW = gridDim.x * 8; (void)tid; (void)gw; (void)NGW
    const float* x = P.in[0]; const float* p = P.in[1]; const int* pos = (const int*)P.in[2];
    const float* g_mix = P.in[3]; const float* w_in = P.in[4]; const float* b_f = P.in[5];
    const float* w_o_a = P.in[6]; const float* w_o_b = P.in[7]; const float* w_out = P.in[8];
    const float* g_ffn = P.in[9]; const float* w_g = P.in[10]; const float* w_u = P.in[11]; const float* w_d = P.in[12];
    const float* g_ple = P.in[13]; const float* w_pg = P.in[14]; const float* w_pp = P.in[15]; const float* g_final = P.in[16];
    unsigned char* ws = P.ws; float* out = P.out;
    float* RS = (float*)(ws + WS_RS); float* ROPE = (float*)(ws + WS_ROPE); float* CB = (float*)(ws + WS_CB); float* LOGF = (float*)(ws + WS_LOGF); u64* MASK = (u64*)(ws + WS_MASK);
    h16* WIN = (h16*)(ws + WS_WIN); h16* WOA = (h16*)(ws + WS_WOA); h16* WOB = (h16*)(ws + WS_WOB); h16* WOUT = (h16*)(ws + WS_WOUT);
    h16* WGU = (h16*)(ws + WS_WGU); h16* WDN = (h16*)(ws + WS_WDN); h16* WPG = (h16*)(ws + WS_WPG); h16* WPP = (h16*)(ws + WS_WPP);
    h16* QI = (h16*)(ws + WS_QI); h16* KI = (h16*)(ws + WS_KI); float* WI = (float*)(ws + WS_WI);
    h16* SIGA = (h16*)(ws + WS_SIGA); h16* SIGB = (h16*)(ws + WS_SIGB);
    h16* OUTA = (h16*)(ws + WS_OUTA); h16* OUTB = (h16*)(ws + WS_OUTB); h16* P16 = (h16*)(ws + WS_P16);
    h16* X3H = (h16*)(ws + WS_SIGA);
    h16* MIXED = (h16*)(ws + WS_MIXED); h16* H2 = (h16*)(ws + WS_H2); h16* ACT = (h16*)(ws + WS_ACT); h16* PP = (h16*)(ws + WS_PP);
    h16* H1 = (h16*)P.out;

    REP(0) { IDS(); LAS float* scr = (LAS float*)(lds + wave * 8448);
      ph_transpose<1>(w_in, nullptr, nullptr, DM, N_IN, WIN, N_INP, scr, gw, NGW, lane);
      ph_transpose<2>(w_g, w_u, g_ffn, DM, DFF, WGU, 2 * DFF, scr, gw, NGW, lane);
      ph_rope(pos, ROPE, blockIdx.x * 512 + tid, gridDim.x * 512);
      for (int i = blockIdx.x * 512 + tid; i < 3 * MTOK; i += gridDim.x * 512) RS[i] = 0.f;
      for (int i = blockIdx.x * 512 + tid; i < 1088; i += gridDim.x * 512) ((unsigned*)(ws + WS_NORM))[i] = 0u;
      ph_rmsnorm<false>(x, g_mix, H1, nullptr, gw, NGW, lane);
    }
    GRID_BAR();
    REP(1) { EpiInProj e{ws, b_f}; run_gemm(lds, H1, WIN, MTOK, N_INP, DM, e, wv); }
    { const int fi = ((MTOK / 256) * (N_INP / 256)) % (int)gridDim.x;
    if ((int)blockIdx.x >= fi) { IDS(); (void)tid; (void)gw; (void)NGW; LAS float* scr = (LAS float*)(lds + wave * 8448); const int qw = ((int)blockIdx.x - fi) * 8 + wave, nq = ((int)gridDim.x - fi) * 8;
      ph_transpose<0>(w_o_a, nullptr, nullptr, 1024, DM, WOA, DM, scr, qw, nq, lane);
      ph_transpose<0>(w_o_b, nullptr, nullptr, 1024, DM, WOB, DM, scr, qw, nq, lane);
      ph_transpose<0>(w_out, nullptr, nullptr, DM, DM, WOUT, DM, scr, qw, nq, lane); } }
    GRID_BAR();
    REP(2) { IDS();
      for (int it = blockIdx.x; it < 256; it += gridDim.x) { const int bb = it & 1, gi = it >> 1;
#pragma unroll 1
          for (int pass = 0; pass < 2; ++pass) idx::run_group(ws, (char*)lds_raw, (unsigned*)out + (size_t)blockIdx.x * 16 * T, bb, pass ? 255 - gi : gi, wv); }
      for (int i = blockIdx.x * 512 + tid; i < MTOK * DPLE / 4; i += gridDim.x * 512) st4h(P16 + 4 * (size_t)i, *((const f32x4*)p + i));
    }
    GRID_BAR();
    REP(3) for (int cu = blockIdx.x; cu < 256; cu += gridDim.x) att::run_list(cu, ws, (char*)lds_raw, wv);
    GRID_BAR();
    REP(4) { { EpiGate<true> e{SIGA, MIXED}; run_gemm(lds, OUTA, WOA, MTOK, DM, 1024, e, wv); }
    { EpiGate<false> e{SIGB, MIXED}; run_gemm(lds, OUTB, WOB, MTOK, DM, 1024, e, wv); } }
    GRID_BAR();
    REP(5) { EpiResidNorm<true> e{x, H2, RS}; run_gemm(lds, MIXED, WOUT, MTOK, DM, DM, e, wv); }
    GRID_BAR();
    REP(6) { EpiSwiGLU e{ACT, RS}; run_gemm(lds, H2, WGU, MTOK, 2 * DFF, DM, e, wv); }
    { const int fi = ((MTOK / 256) * (2 * DFF / 256)) % (int)gridDim.x;
    if ((int)blockIdx.x >= fi) { IDS(); (void)tid; (void)gw; (void)NGW; LAS float* scr = (LAS float*)(lds + wave * 8448); const int qw = ((int)blockIdx.x - fi) * 8 + wave, nq = ((int)gridDim.x - fi) * 8;
      ph_transpose<0>(w_d, nullptr, nullptr, DFF, DM, WDN, DM, scr, qw, nq, lane);
      ph_transpose<0>(w_pg, nullptr, g_ple, DM, DM, WPG, DM, scr, qw, nq, lane);
      ph_transpose<0>(w_pp, nullptr, nullptr, DPLE, DM, WPP, DM, scr, qw, nq, lane); } }
    GRID_BAR();
    { EpiResidNorm<false> e{nullptr, H2, RS + MTOK}; run_gemm(lds, ACT, WDN, MTOK, DM, DFF, e, wv); }
    GRID_BAR();
    { EpiStoreH e{PP, DM}; run_gemm(lds, P16, WPP, MTOK, DM, DPLE, e, wv); }
    if (gridDim.x == (MTOK / 256) * (DM / 256)) {
        EpiPLEFinal e{PP, H2, out, RS + MTOK, RS + 2 * MTOK, g_final, (unsigned*)(ws + WS_CTL) + CW_PANEL}; run_gemm(lds, H2, WPG, MTOK, DM, DM, e, wv);
    } else {
        { EpiPLE e{PP, H2, X3H, RS + MTOK, RS + 2 * MTOK}; run_gemm(lds, H2, WPG, MTOK, DM, DM, e, wv); }
        GRID_BAR();
        { IDS(); ph_final(X3H, out, g_final, RS + 2 * MTOK, gw, NGW, lane); }
    }
#undef IDS
#undef GRID_BAR
}

extern "C" void kernel_launch(void* const* d_in, const int* in_sizes, int n_in, void* d_out, int out_size, void* d_ws, size_t ws_size, hipStream_t stream) {
    if (n_in != 17 || out_size != MTOK * DM || ws_size < WS_END) { fprintf(stderr, "kernel_launch: unexpected shapes / workspace (%d inputs, out %d, ws %zu)\n", n_in, out_size, ws_size); return; }
    static int grid_blocks = 0;
    if (!grid_blocks) {
        int dev = 0, cus = 0, per_cu = 0;
        (void)hipGetDevice(&dev);
        (void)hipDeviceGetAttribute(&cus, hipDeviceAttributeMultiprocessorCount, dev);
        (void)hipFuncSetAttribute((const void*)mega_fwd, hipFuncAttributeMaxDynamicSharedMemorySize, LDS_BYTES);
        (void)hipOccupancyMaxActiveBlocksPerMultiprocessor(&per_cu, (const void*)mega_fwd, 512, LDS_BYTES);
        if (per_cu < 1) { fprintf(stderr, "kernel_launch: occupancy query says %d blocks per CU\n", per_cu); per_cu = 1; }
        if (per_cu > 1) per_cu = 1;
        grid_blocks = cus * per_cu;
    }
    (void)hipMemsetAsync((char*)d_ws + WS_CTL, 0, 64 * 1024, stream);
    Params prm{};
    for (int i = 0; i < 17; ++i) prm.in[i] = (const float*)d_in[i];
    prm.out = (float*)d_out; prm.ws = (unsigned char*)d_ws;
    void* args[] = {&prm};
    hipError_t e = hipLaunchCooperativeKernel((const void*)mega_fwd, dim3(grid_blocks), dim3(512), args, LDS_BYTES, stream);
    if (e != hipSuccess) fprintf(stderr, "cooperative launch failed: %s (grid %d)\n", hipGetErrorString(e), grid_blocks);
}
```

```cpp
#include <hip/hip_runtime.h>
#include <hip/hip_cooperative_groups.h>
#include <stdint.h>
#include <cstdio>

#define LAS __attribute__((address_space(3)))
typedef _Float16 h16;
typedef _Float16 h16x8 __attribute__((ext_vector_type(8)));
typedef _Float16 h16x4 __attribute__((ext_vector_type(4)));
typedef _Float16 h16x2 __attribute__((ext_vector_type(2)));
typedef float f32x4 __attribute__((ext_vector_type(4)));
typedef float f32x2 __attribute__((ext_vector_type(2)));
typedef unsigned u32x4 __attribute__((ext_vector_type(4)));
typedef unsigned u32x2 __attribute__((ext_vector_type(2)));
typedef unsigned long long u64;
__device__ __forceinline__ int lane_id() { int r; asm volatile("v_mbcnt_lo_u32_b32 %0, -1, 0\n\tv_mbcnt_hi_u32_b32 %0, -1, %0" : "=v"(r)); return r; }

constexpr int NBATCH = 2, T = 4096, MTOK = NBATCH * T, DM = 2048;
constexpr int HA = 8, HAKV = 2, HIDX = 16, DIDX = 64, HB = 8, HD = 128;
constexpr int N_IN = 9816, N_INP = 9984, DFF = 5632, DPLE = 256, TOPK = 256;
constexpr float EPS = 1e-6f;
constexpr float ATT_SCALE = 0.08838834764831845f;

constexpr size_t MiB = 1u << 20;
constexpr size_t WS_CTL = 0;
constexpr size_t WS_RS = 512 * 1024;
constexpr size_t WS_NORM = 640 * 1024;
constexpr size_t WS_ROPE = 1 * MiB;
constexpr size_t WS_LOGF = 3 * MiB + 512 * 1024;
constexpr size_t WS_MASK = 4 * MiB;
constexpr size_t WS_WIN = 8 * MiB;
constexpr size_t WS_OUTA = 8 * MiB, WS_OUTB = 24 * MiB, WS_P16 = 40 * MiB;
constexpr size_t WS_WOA = 47 * MiB, WS_WOB = 51 * MiB, WS_WOUT = 55 * MiB, WS_WGU = 63 * MiB, WS_WDN = 107 * MiB, WS_WPG = 129 * MiB, WS_WPP = 137 * MiB;
constexpr size_t WS_QA = 138 * MiB, WS_KA = 154 * MiB, WS_VA = 158 * MiB, WS_QI = 162 * MiB, WS_KI = 178 * MiB, WS_WI = 179 * MiB;
constexpr size_t WS_QB = 180 * MiB, WS_KB = 196 * MiB, WS_VB = 212 * MiB, WS_SIGA = 228 * MiB, WS_SIGB = 260 * MiB, WS_PART = 292 * MiB, WS_END = 328 * MiB;
constexpr size_t WS_MIXED = WS_QB;
constexpr size_t WS_H2 = WS_QA;
constexpr size_t WS_ACT = WS_QB;
constexpr size_t WS_PP = WS_QB;
constexpr int CW_SPLIT = 12288;
constexpr int CW_PANEL = 8192;
constexpr int CW_BAR = 4096;

namespace pg8 {
constexpr int BM = 256, BK = 64, HALF = 128, HTB = HALF * BK * 2, STAGE_BYTES = 8 * HTB, NXCD = 8, WGM = 4;
__host__ __device__ __forceinline__ int lds_byte(int r, int c) { const int st = (r >> 4) * 2 + (c >> 5), rr = r & 15, cc = c & 31, ob = rr * 64 + cc * 2; return st * 1024 + (ob ^ (((ob >> 9) & 1) << 5)); }
__host__ __device__ __forceinline__ int perm32(int rho) { const int n = rho >> 4, i = rho & 15; return 8 * (i >> 2) + 4 * n + (i & 3); }
__host__ __device__ __forceinline__ void stage_rc(int b, int& R, int& C) { const int st = b / 1024, sb = b % 1024, swz = sb ^ (((sb >> 9) & 1) << 5); R = (st >> 1) * 16 + swz / 64; C = (st & 1) * 32 + (swz % 64) / 2; }
struct Unit { int pm, pn; };
struct Gemm { const h16* A; const h16* Bt; int M, N, K; };
struct StaticOrder {
    int nM, nN, nwg, G, c;
    __host__ __device__ void init(int M, int N, int G_, int c_) { nM = M / BM; nN = N / BM; nwg = nM * nN; G = G_; c = c_; }
    __host__ __device__ bool next(int i, Unit& u) const {
        const long L = (long)i * G + c; if (L >= nwg) return false;
        int wgid = (int)L; { const int q = nwg / NXCD, r = nwg % NXCD, xcd = wgid % NXCD, off = wgid / NXCD; wgid = (xcd < r ? xcd * (q + 1) : r * (q + 1) + (xcd - r) * q) + off; }
        const int nig = WGM * nN, gid = wgid / nig, fm = gid * WGM, gsz = (nM - fm) < WGM ? (nM - fm) : WGM;
        u.pm = fm + ((wgid % nig) % gsz); u.pn = (wgid % nig) / gsz; return true;
    }
};
template <class Epi>
__device__ __forceinline__ void gemm_phase(LAS unsigned char* lds, const Gemm g, const StaticOrder& S, const Epi& E, int wv) {
    int tid = wv * 64 + lane_id(); asm volatile("" : "+v"(tid));
    const int wid = __builtin_amdgcn_readfirstlane(tid >> 6), lane = tid & 63, wr = wid >> 2, wc = wid & 3, fr = lane & 15, fq = lane >> 4;
    const int K = g.K, nt = K / BK;
    unsigned voffA[2], voffBp[2];
#pragma unroll
    for (int i = 0; i < 2; ++i) { int R, C; stage_rc(tid * 16 + i * 8192, R, C); voffA[i] = (unsigned)(R * K + C) * 2u; voffBp[i] = (unsigned)(((R & ~31) + perm32(R & 31)) * K + C) * 2u; }
    const size_t kstep = (size_t)(BK * 2);
    const size_t hstep = (size_t)HALF * K * 2;
    const size_t tstep = 2 * hstep;
    const unsigned ldsw = (unsigned)wid * 1024u;
    const int aoff = lds_byte(wr * 64 + fr, fq * 8), boff = lds_byte(wc * 32 + fr, fq * 8);
#define PG8_SA(b, h) (((b) * 2 + (h)) * HTB)
#define PG8_SB(b, h) ((4 + (b) * 2 + (h)) * HTB)
#define PG8_STAGE(bufoff, gbase) do { _Pragma("unroll") for (int _i = 0; _i < 2; ++_i) \
        __builtin_amdgcn_global_load_lds((const unsigned*)((const char*)(gbase) + voffA[_i]), (LAS unsigned*)(lds + (bufoff) + ldsw + _i * 8192), 16, 0, 0); } while (0)
#define PG8_STAGEB(bufoff, gbase, pf) do { _Pragma("unroll") for (int _i = 0; _i < 2; ++_i) \
        __builtin_amdgcn_global_load_lds((const unsigned*)((const char*)(gbase) + ((pf) ? voffBp[_i] : voffA[_i])), (LAS unsigned*)(lds + (bufoff) + ldsw + _i * 8192), 16, 0, 0); } while (0)
#define PG8_LDA(dst, b, h) do { _Pragma("unroll") for (int m = 0; m < 4; ++m) _Pragma("unroll") for (int k = 0; k < 2; ++k) dst[m][k] = *(const LAS h16x8*)(lds + PG8_SA(b, h) + aoff + m * 2048 + k * 1024); } while (0)
#define PG8_LDB(dst, b, h) do { _Pragma("unroll") for (int n = 0; n < 2; ++n) _Pragma("unroll") for (int k = 0; k < 2; ++k) dst[n][k] = *(const LAS h16x8*)(lds + PG8_SB(b, h) + boff + n * 2048 + k * 1024); } while (0)
#define PG8_MMA(ai, bj, At, Bt) do { __builtin_amdgcn_s_setprio(1); _Pragma("unroll") for (int m = 0; m < 4; ++m) _Pragma("unroll") for (int n = 0; n < 2; ++n) _Pragma("unroll") for (int k = 0; k < 2; ++k) \
        acc[ai][bj][m][n] = __builtin_amdgcn_mfma_f32_16x16x32_f16(Bt[n][k], At[m][k], acc[ai][bj][m][n], 0, 0, 0); __builtin_amdgcn_s_setprio(0); } while (0)
#define PG8_WAIT_V(n) asm volatile("s_waitcnt vmcnt(" #n ")" ::: "memory")
#define PG8_WAIT_L(n) asm volatile("s_waitcnt lgkmcnt(" #n ")" ::: "memory")
#define PG8_BAR __builtin_amdgcn_s_barrier()
#define PG8_SCHED __builtin_amdgcn_sched_barrier(0)
    Unit cur, nxt; int ui = 0;
    if (!S.next(0, cur)) return;
    f32x4 acc[2][2][4][2];
#pragma unroll
    for (int a = 0; a < 2; ++a)
#pragma unroll
        for (int b = 0; b < 2; ++b)
#pragma unroll
            for (int m = 0; m < 4; ++m)
#pragma unroll
                for (int n = 0; n < 2; ++n) acc[a][b][m][n] = (f32x4){0.f, 0.f, 0.f, 0.f};
    h16x8 At[4][2], B0[2][2], B1[2][2];
    const char* cA = (const char*)g.A + (size_t)cur.pm * tstep; const char* cB = (const char*)g.Bt + (size_t)cur.pn * tstep;
    bool pfc = Epi::perm(cur.pn);
    PG8_STAGEB(PG8_SB(0, 0), cB, pfc); PG8_STAGE(PG8_SA(0, 0), cA); PG8_STAGEB(PG8_SB(0, 1), cB + hstep, pfc); PG8_STAGE(PG8_SA(0, 1), cA + hstep);
    if (wr == 1) PG8_BAR;
    PG8_WAIT_V(4); PG8_BAR;
    PG8_STAGEB(PG8_SB(1, 0), cB + kstep, pfc); PG8_STAGE(PG8_SA(1, 0), cA + kstep); PG8_STAGEB(PG8_SB(1, 1), cB + hstep + kstep, pfc);
    PG8_WAIT_V(6); PG8_BAR;
    for (;;) {
        const bool has_next = S.next(ui + 1, nxt);
        const char* nA = has_next ? (const char*)g.A + (size_t)nxt.pm * tstep : cA; const char* nB = has_next ? (const char*)g.Bt + (size_t)nxt.pn * tstep : cB;
        const bool pfn = has_next ? Epi::perm(nxt.pn) : pfc;
        for (int t = 0; t < nt; t += 2) {
            const bool last = (t == nt - 2);
            const char* a1 = cA + (size_t)(t + 1) * kstep;
            const char* a2 = last ? nA : cA + (size_t)(t + 2) * kstep; const char* b2 = last ? nB : cB + (size_t)(t + 2) * kstep;
            const char* a3 = a2 + kstep; const char* b3 = b2 + kstep;
            const bool pf2 = last ? pfn : pfc;
            PG8_LDB(B0, 0, 0); PG8_SCHED; PG8_LDA(At, 0, 0); PG8_STAGE(PG8_SA(1, 1), a1 + hstep);
            PG8_WAIT_L(8); PG8_BAR; PG8_WAIT_L(0); PG8_MMA(0, 0, At, B0); PG8_BAR; PG8_SCHED;
            PG8_LDB(B1, 0, 1); PG8_STAGEB(PG8_SB(0, 0), b2, pf2);
            PG8_BAR; PG8_WAIT_L(0); PG8_MMA(0, 1, At, B1); PG8_BAR;
            PG8_LDA(At, 0, 1); PG8_STAGE(PG8_SA(0, 0), a2);
            PG8_BAR; PG8_WAIT_L(0); PG8_MMA(1, 0, At, B0); PG8_BAR; PG8_SCHED;
            PG8_STAGEB(PG8_SB(0, 1), b2 + hstep, pf2);
            PG8_WAIT_V(6); PG8_BAR; PG8_MMA(1, 1, At, B1); PG8_BAR;
            PG8_LDB(B0, 1, 0); PG8_SCHED; PG8_LDA(At, 1, 0); PG8_STAGE(PG8_SA(0, 1), a2 + hstep);
            PG8_WAIT_L(8); PG8_BAR; PG8_WAIT_L(0); PG8_MMA(0, 0, At, B0); PG8_BAR; PG8_SCHED;
            PG8_LDB(B1, 1, 1); PG8_STAGEB(PG8_SB(1, 0), b3, pf2);
            PG8_BAR; PG8_WAIT_L(0); PG8_MMA(0, 1, At, B1); PG8_BAR;
            PG8_LDA(At, 1, 1); PG8_STAGE(PG8_SA(1, 0), a3);
            PG8_BAR; PG8_WAIT_L(0); PG8_MMA(1, 0, At, B0); PG8_BAR; PG8_SCHED;
            PG8_STAGEB(PG8_SB(1, 1), b3 + hstep, pf2);
            PG8_WAIT_V(6); PG8_BAR; PG8_MMA(1, 1, At, B1); PG8_BAR;
        }
        if constexpr (!Epi::AFTER_DRAIN) E(acc, cur, wr, wc, fr, fq);
        if (!has_next) break;
#pragma unroll
        for (int a = 0; a < 2; ++a)
#pragma unroll
            for (int b = 0; b < 2; ++b)
#pragma unroll
                for (int m = 0; m < 4; ++m)
#pragma unroll
                    for (int n = 0; n < 2; ++n) acc[a][b][m][n] = (f32x4){0.f, 0.f, 0.f, 0.f};
        cur = nxt; cA = nA; cB = nB; pfc = pfn; ++ui;
    }
    PG8_WAIT_V(0);
    if (wr == 0) PG8_BAR;
    PG8_BAR;
    if constexpr (Epi::AFTER_DRAIN) E.fused(acc, cur, wr, wc, fr, fq, lane);
#undef PG8_SA
#undef PG8_SB
#undef PG8_STAGE
#undef PG8_STAGEB
#undef PG8_LDA
#undef PG8_LDB
#undef PG8_MMA
#undef PG8_WAIT_V
#undef PG8_WAIT_L
#undef PG8_BAR
#undef PG8_SCHED
}
}
using pg8::Unit;
typedef f32x4 Acc[2][2][4][2];

__device__ __forceinline__ void st4h(h16* p, f32x4 v) { h16x4 o; o[0] = (h16)v[0]; o[1] = (h16)v[1]; o[2] = (h16)v[2]; o[3] = (h16)v[3]; *(h16x4*)p = o; }
__device__ __forceinline__ void st8h(h16* p, f32x4 a, f32x4 b) { h16x8 o; o[0] = (h16)a[0]; o[1] = (h16)a[1]; o[2] = (h16)a[2]; o[3] = (h16)a[3]; o[4] = (h16)b[0]; o[5] = (h16)b[1]; o[6] = (h16)b[2]; o[7] = (h16)b[3]; *(h16x8*)p = o; }
__device__ __forceinline__ void ld8h(const h16* p, f32x4& a, f32x4& b) { const h16x8 o = *(const h16x8*)p; a = (f32x4){(float)o[0], (float)o[1], (float)o[2], (float)o[3]}; b = (f32x4){(float)o[4], (float)o[5], (float)o[6], (float)o[7]}; }
__device__ __forceinline__ f32x4 ld4h(const h16* p) { const h16x4 o = *(const h16x4*)p; return (f32x4){(float)o[0], (float)o[1], (float)o[2], (float)o[3]}; }
__device__ __forceinline__ float sumsq4(f32x4 v) { return (v[0] * v[0] + v[1] * v[1]) + (v[2] * v[2] + v[3] * v[3]); }
__device__ __forceinline__ float sigmoidf_(float x) { return __builtin_amdgcn_rcpf(1.0f + __expf(-x)); }
__device__ __forceinline__ float logsigmoidf_(float z) { return fminf(z, 0.f) - __logf(1.0f + __expf(-fabsf(z))); }
__device__ __forceinline__ float wave_sum(float v) {
#pragma unroll
    for (int o = 1; o < 64; o <<= 1) v += __shfl_xor(v, o);
    return v;
}

struct EpiInProj {
    static constexpr bool AFTER_DRAIN = false;
    static __device__ __forceinline__ bool perm(int pn) { return pn == 5 || pn >= 11; }
    unsigned char* ws; const float* b_f;
    __device__ __forceinline__ void operator()(const Acc& acc, const Unit& u, int wr, int wc, int fr, int fq) const {
        const int pn = u.pn, row0 = u.pm * 256 + wr * 64 + fr;
        const float* ROPE = (const float*)(ws + WS_ROPE);
        float nmax[2] = {0.f, 0.f};
#pragma unroll
        for (int ai = 0; ai < 2; ++ai)
#pragma unroll
            for (int m = 0; m < 4; ++m) {
                const int row = row0 + ai * 128 + m * 16, b = row >> 12, t = row & 4095;
                const float* rp = ROPE + (size_t)row * 48;
#pragma unroll
                for (int bj = 0; bj < 2; ++bj) {
                    f32x4 v0 = acc[ai][bj][m][0], v1 = acc[ai][bj][m][1];
                    const int d0 = 32 * wc + 4 * fq;
                    const int d8 = 32 * wc + 8 * fq;
                    if (pn < 6) {
                        size_t off;
                        if (pn < 4) off = WS_QA + (((size_t)(b * HA + pn * 2 + bj) * T + t) * HD) * 2;
                        else off = (pn == 4 ? WS_KA : WS_VA) + (((size_t)(b * HAKV + bj) * T + t) * HD) * 2;
                        h16* dst = (h16*)(ws + off);
                        if (pn < 5 && wc == 0) {
                            const f32x4 c = *(const f32x4*)(rp + 4 * fq), s = *(const f32x4*)(rp + 16 + 4 * fq);
                            const f32x4 y0 = v0 * c - v1 * s, y1 = v1 * c + v0 * s; v0 = y0; v1 = y1;
                        }
                        if (pn == 5) st8h(dst + d8, v0, v1); else { st4h(dst + d0, v0); st4h(dst + d0 + 16, v1); }
                    } else if (pn < 11) {
                        const bool is_q = pn < 10;
                        if (is_q || bj == 0) {
                            if (is_q || wc < 2) {
                                const int dd = 32 * (wc & 1) + 4 * fq;
                                const size_t off = is_q ? WS_QI + ((size_t)row * 1024 + ((pn - 6) * 4 + 2 * bj + (wc >> 1)) * 64) * 2 : WS_KI + ((size_t)row * 64) * 2;
                                h16* dst = (h16*)(ws + off);
                                if ((wc & 1) == 0) {
                                    f32x4 pr;
#pragma unroll
                                    for (int j = 0; j < 4; ++j) pr[j] = __shfl_xor(v0[j], 32);
                                    const f32x4 c = *(const f32x4*)(rp + 32 + 4 * (fq & 1)), s = *(const f32x4*)(rp + 40 + 4 * (fq & 1));
                                    v0 = (fq < 2) ? (v0 * c - pr * s) : (v0 * c + pr * s);
                                }
                                st4h(dst + dd, v0); st4h(dst + dd + 16, v1);
                            } else if (wc == 2) {
                                *(f32x4*)((float*)(ws + WS_WI) + (size_t)row * 16 + 4 * fq) = v0 * 0.03125f;
                                if (fq < 2) { const f32x4 bf = *(const f32x4*)(b_f + 4 * fq); f32x4 o;
#pragma unroll
                                    for (int j = 0; j < 4; ++j) o[j] = logsigmoidf_(v1[j] + bf[j]);
                                    float* lf = (float*)(ws + WS_LOGF) + ((size_t)(b * HB + 4 * fq)) * T + t;
#pragma unroll
                                    for (int j = 0; j < 4; ++j) lf[(size_t)j * T] = o[j]; }
                            }
                        }
                    } else if (pn < 23) {
                        const int q = pn - 11, which = q >> 2, head = (q & 3) * 2 + bj;
                        h16* dst = (h16*)(ws + WS_QB + (size_t)which * (WS_KB - WS_QB)) + ((size_t)(b * HB + head) * T + t) * HD;
                        st8h(dst + d8, v0, v1);
                        if (which < 2) { float ps = sumsq4(v0) + sumsq4(v1); ps += __shfl_xor(ps, 16); ps += __shfl_xor(ps, 32); nmax[bj] = fmaxf(nmax[bj], ps); }
                    } else {
                        const int q = pn - 23; const int col = (q & 7) * 256 + 128 * bj + d8;
                        h16* base = (h16*)(ws + WS_SIGA + (size_t)(q >> 3) * (WS_SIGB - WS_SIGA));
#pragma unroll
                        for (int j = 0; j < 4; ++j) { v0[j] = sigmoidf_(v0[j]); v1[j] = sigmoidf_(v1[j]); }
                        st8h(base + (size_t)row * DM + col, v0, v1);
                    }
                }
            }
        if (pn >= 11 && pn < 19) {
            const int q = pn - 11, which = q >> 2, bq = u.pm >> 4, qb = u.pm & 15; unsigned* nrm = (unsigned*)(ws + WS_NORM);
#pragma unroll
            for (int bj = 0; bj < 2; ++bj) { float mx = nmax[bj];
#pragma unroll
                for (int o = 1; o < 16; o <<= 1) mx = fmaxf(mx, __shfl_xor(mx, o));
                const int bh = bq * HB + (q & 3) * 2 + bj;
                if (fr == 0 && fq == 0) atomicMax(which == 0 ? nrm + (bh * 16 + qb) * 4 + wc : nrm + 1024 + bh * 4 + wc, __float_as_uint(mx)); }
        }
    }
};
static_assert(WS_VB - WS_KB == WS_KB - WS_QB, "QB/KB/VB equally spaced");
template <bool FIRST> struct EpiGate {
    static constexpr bool AFTER_DRAIN = false;
    static __device__ __forceinline__ bool perm(int) { return true; }
    const h16* SIG; h16* MIXED;
    __device__ __forceinline__ void operator()(const Acc& acc, const Unit& u, int wr, int wc, int fr, int fq) const {
        const int row0 = u.pm * 256 + wr * 64 + fr, col0 = u.pn * 256 + 32 * wc + 8 * fq;
#pragma unroll
        for (int ai = 0; ai < 2; ++ai)
#pragma unroll
            for (int m = 0; m < 4; ++m)
#pragma unroll
                for (int bj = 0; bj < 2; ++bj) { const size_t off = (size_t)(row0 + ai * 128 + m * 16) * DM + col0 + bj * 128;
                    f32x4 s0, s1; ld8h(SIG + off, s0, s1); f32x4 v0 = s0 * acc[ai][bj][m][0], v1 = s1 * acc[ai][bj][m][1];
                    if (!FIRST) { f32x4 m0, m1; ld8h(MIXED + off, m0, m1); v0 += m0; v1 += m1; }
                    st8h(MIXED + off, v0, v1); }
    }
};
template <bool BASE_F32> struct EpiResidNorm {
    static constexpr bool AFTER_DRAIN = false;
    static __device__ __forceinline__ bool perm(int) { return true; }
    const float* BASE; h16* XH; float* RS;
    __device__ __forceinline__ void operator()(const Acc& acc, const Unit& u, int wr, int wc, int fr, int fq) const {
        const int row0 = u.pm * 256 + wr * 64 + fr, col0 = u.pn * 256 + 32 * wc + 8 * fq;
#pragma unroll
        for (int ai = 0; ai < 2; ++ai)
#pragma unroll
            for (int m = 0; m < 4; ++m) { const int row = row0 + ai * 128 + m * 16; float ss = 0.f;
#pragma unroll
                for (int bj = 0; bj < 2; ++bj) { const size_t off = (size_t)row * DM + col0 + bj * 128;
                    f32x4 b0, b1; if (BASE_F32) { b0 = *(const f32x4*)(BASE + off); b1 = *(const f32x4*)(BASE + off + 4); } else ld8h(XH + off, b0, b1);
                    const f32x4 v0 = b0 + acc[ai][bj][m][0], v1 = b1 + acc[ai][bj][m][1]; st8h(XH + off, v0, v1); ss += sumsq4(v0) + sumsq4(v1); }
                ss += __shfl_xor(ss, 16); ss += __shfl_xor(ss, 32);
                if (fq == 0) atomicAdd(RS + row, ss); }
    }
};
struct EpiSwiGLU {
    static constexpr bool AFTER_DRAIN = false;
    static __device__ __forceinline__ bool perm(int) { return false; }
    h16* ACT; const float* RS;
    __device__ __forceinline__ void operator()(const Acc& acc, const Unit& u, int wr, int wc, int fr, int fq) const {
        const int row0 = u.pm * 256 + wr * 64 + fr;
#pragma unroll
        for (int ai = 0; ai < 2; ++ai)
#pragma unroll
            for (int m = 0; m < 4; ++m) { const int row = row0 + ai * 128 + m * 16; const float r = __builtin_amdgcn_rsqf(RS[row] * (1.0f / DM) + EPS);
#pragma unroll
                for (int bj = 0; bj < 2; ++bj) { const f32x4 g = acc[ai][bj][m][0] * r, uu = acc[ai][bj][m][1] * r; f32x4 o;
#pragma unroll
                    for (int j = 0; j < 4; ++j) o[j] = g[j] * sigmoidf_(g[j]) * uu[j];
                    st4h(ACT + (size_t)row * DFF + 16 * (u.pn * 8 + bj * 4 + wc) + 4 * fq, o); } }
    }
};
struct EpiStoreH {
    static constexpr bool AFTER_DRAIN = false;
    static __device__ __forceinline__ bool perm(int) { return true; }
    h16* O; int ldc;
    __device__ __forceinline__ void operator()(const Acc& acc, const Unit& u, int wr, int wc, int fr, int fq) const {
        const int row0 = u.pm * 256 + wr * 64 + fr, col0 = u.pn * 256 + 32 * wc + 8 * fq;
#pragma unroll
        for (int ai = 0; ai < 2; ++ai)
#pragma unroll
            for (int m = 0; m < 4; ++m)
#pragma unroll
                for (int bj = 0; bj < 2; ++bj) st8h(O + (size_t)(row0 + ai * 128 + m * 16) * ldc + col0 + bj * 128, acc[ai][bj][m][0], acc[ai][bj][m][1]);
    }
};
struct EpiPLE {
    static constexpr bool AFTER_DRAIN = false;
    static __device__ __forceinline__ bool perm(int) { return true; }
    const h16* PP; const h16* XI; h16* XO; const float* RSIN; float* RSOUT;
    __device__ __forceinline__ void operator()(const Acc& acc, const Unit& u, int wr, int wc, int fr, int fq) const {
        const int row0 = u.pm * 256 + wr * 64 + fr, col0 = u.pn * 256 + 32 * wc + 8 * fq;
#pragma unroll
        for (int ai = 0; ai < 2; ++ai)
#pragma unroll
            for (int m = 0; m < 4; ++m) { const int row = row0 + ai * 128 + m * 16; const float r = __builtin_amdgcn_rsqf(RSIN[row] * (1.0f / DM) + EPS); float ss = 0.f;
#pragma unroll
                for (int bj = 0; bj < 2; ++bj) { const size_t off = (size_t)row * DM + col0 + bj * 128;
                    const f32x4 a0 = acc[ai][bj][m][0] * r, a1 = acc[ai][bj][m][1] * r; f32x4 p0, p1, x0, x1; ld8h(PP + off, p0, p1); ld8h(XI + off, x0, x1);
#pragma unroll
                    for (int j = 0; j < 4; ++j) { x0[j] += sigmoidf_(a0[j]) * p0[j]; x1[j] += sigmoidf_(a1[j]) * p1[j]; }
                    st8h(XO + off, x0, x1); ss += sumsq4(x0) + sumsq4(x1); }
                ss += __shfl_xor(ss, 16); ss += __shfl_xor(ss, 32);
                if (fq == 0) atomicAdd(RSOUT + row, ss); }
    }
};

struct EpiPLEFinal {
    static constexpr bool AFTER_DRAIN = true;
    static __device__ __forceinline__ bool perm(int) { return true; }
    const h16* PP; const h16* XI; float* OUT; const float* RSIN; float* RSOUT; const float* gfin; unsigned* cnt;
    __device__ __forceinline__ void operator()(const Acc&, const Unit&, int, int, int, int) const {}
    __device__ __forceinline__ void fused(Acc& acc, const Unit& u, int wr, int wc, int fr, int fq, int lane) const {
        const int row0 = u.pm * 256 + wr * 64 + fr, col0 = u.pn * 256 + 32 * wc + 8 * fq;
#pragma unroll
        for (int ai = 0; ai < 2; ++ai)
#pragma unroll
            for (int m = 0; m < 4; ++m) { const int row = row0 + ai * 128 + m * 16; const float r = __builtin_amdgcn_rsqf(RSIN[row] * (1.0f / DM) + EPS); float ss = 0.f;
#pragma unroll
                for (int bj = 0; bj < 2; ++bj) { const size_t off = (size_t)row * DM + col0 + bj * 128;
                    const f32x4 a0 = acc[ai][bj][m][0] * r, a1 = acc[ai][bj][m][1] * r; f32x4 p0, p1, x0, x1; ld8h(PP + off, p0, p1); ld8h(XI + off, x0, x1);
#pragma unroll
                    for (int j = 0; j < 4; ++j) { x0[j] += sigmoidf_(a0[j]) * p0[j]; x1[j] += sigmoidf_(a1[j]) * p1[j]; }
                    acc[ai][bj][m][0] = x0; acc[ai][bj][m][1] = x1; ss += sumsq4(x0) + sumsq4(x1); }
                ss += __shfl_xor(ss, 16); ss += __shfl_xor(ss, 32);
                if (fq == 0) atomicAdd(RSOUT + row, ss); }
        asm volatile("s_waitcnt vmcnt(0)" ::: "memory");
        unsigned* c = cnt + 64 * u.pm;
        if (lane == 0) __hip_atomic_fetch_add(c, 1u, __ATOMIC_RELAXED, __HIP_MEMORY_SCOPE_AGENT);
        { unsigned spins = 0;
          while ((unsigned)__builtin_amdgcn_readfirstlane((int)__hip_atomic_load(c, __ATOMIC_RELAXED, __HIP_MEMORY_SCOPE_AGENT)) < 64u) { __builtin_amdgcn_s_sleep(2); if (++spins > (1u << 22)) break; } }
#pragma unroll
        for (int ai = 0; ai < 2; ++ai)
#pragma unroll
            for (int m = 0; m < 4; ++m) { const int row = row0 + ai * 128 + m * 16;
                const float r = __builtin_amdgcn_rsqf(__hip_atomic_load(RSOUT + row, __ATOMIC_RELAXED, __HIP_MEMORY_SCOPE_AGENT) * (1.0f / DM) + EPS);
#pragma unroll
                for (int bj = 0; bj < 2; ++bj) { const size_t off = (size_t)row * DM + col0 + bj * 128;
                    const f32x4 g0 = *(const f32x4*)(gfin + col0 + bj * 128), g1 = *(const f32x4*)(gfin + col0 + bj * 128 + 4);
                    *(f32x4*)(OUT + off) = acc[ai][bj][m][0] * r * g0; *(f32x4*)(OUT + off + 4) = acc[ai][bj][m][1] * r * g1; } }
    }
};

__device__ __forceinline__ int map_in(int p) {
    if (p < 2560) return p;
    if (p < 2816) { const int c = p - 2560; if (c < 64) return 2560 + c; if (c < 80) return 2624 + (c - 64); if (c < 88) return 5712 + (c - 80); return -1; }
    const int q = p - 2816; if (q < 3072) return 2640 + q; return 5720 + (q - 3072);
}
template <int MODE>
__device__ __forceinline__ const float* tr_src(const float* W0, const float* W1, int Nsrc, int n) {
    if (MODE == 0) return n < Nsrc ? W0 + n : nullptr;
    if (MODE == 1) { const int c = map_in(n); return c >= 0 ? W0 + c : nullptr; }
    return (((n >> 4) & 1) ? W1 : W0) + 16 * (n >> 5) + (n & 15);
}
template <int MODE>
__device__ __forceinline__ void ph_transpose(const float* W0, const float* W1, const float* gk, int K, int Nsrc, h16* WT, int Nphys, LAS float* scr, int gw, int NGW, int lane) {
    const int nblk = Nphys / 32, nitems = (K / 64) * nblk;
    const int lr = lane >> 3, lc = (lane & 7) * 4;
    f32x4 cur[8], nxt[8];
    int item = gw;
    if (item < nitems) { const int kb = item / nblk, nb = item % nblk; const float* src = tr_src<MODE>(W0, W1, Nsrc, 32 * nb + lc);
#pragma unroll
        for (int i = 0; i < 8; ++i) cur[i] = src ? *(const f32x4*)(src + (size_t)(64 * kb + lr + 8 * i) * Nsrc) : (f32x4){0.f, 0.f, 0.f, 0.f}; }
    for (; item < nitems; item += NGW) {
        const int kb = item / nblk, nb = item % nblk, k0 = 64 * kb, n0 = 32 * nb;
        const int itn = item + NGW;
        if (itn < nitems) { const int kbn = itn / nblk, nbn = itn % nblk; const float* src = tr_src<MODE>(W0, W1, Nsrc, 32 * nbn + lc);
#pragma unroll
            for (int i = 0; i < 8; ++i) nxt[i] = src ? *(const f32x4*)(src + (size_t)(64 * kbn + lr + 8 * i) * Nsrc) : (f32x4){0.f, 0.f, 0.f, 0.f}; }
#pragma unroll
        for (int i = 0; i < 8; ++i) { LAS float* d = scr + (lr + 8 * i) * 33 + lc; const float gg = gk ? gk[k0 + lr + 8 * i] : 1.0f; d[0] = cur[i][0] * gg; d[1] = cur[i][1] * gg; d[2] = cur[i][2] * gg; d[3] = cur[i][3] * gg; }
        __builtin_amdgcn_wave_barrier(); asm volatile("s_waitcnt lgkmcnt(0)" ::: "memory");
        const int c = lane & 7;
#pragma unroll
        for (int j = 0; j < 4; ++j) { const int nn = (lane >> 3) + 8 * j; const LAS float* sp = scr + (8 * c) * 33 + nn;
            h16x8 o;
#pragma unroll
            for (int e = 0; e < 8; ++e) o[e] = (h16)sp[e * 33];
            *(h16x8*)(WT + (size_t)(n0 + nn) * K + k0 + 8 * c) = o; }
        __builtin_amdgcn_wave_barrier(); asm volatile("s_waitcnt lgkmcnt(0)" ::: "memory");
#pragma unroll
        for (int i = 0; i < 8; ++i) cur[i] = nxt[i];
    }
}
__device__ __forceinline__ void sincos_f32arg(float ang, float& sn, float& cs) {
    const double a = (double)ang;
    const double rev = a * 0.15915494309189535;
    const double fr = rev - __builtin_rint(rev);
    const double q4 = fr * 4.0; const double qi = __builtin_rint(q4); const int qq = ((int)qi) & 3;
    const double r = (q4 - qi) * 1.5707963267948966;
    const double r2 = r * r;
    const double s = r * (1.0 + r2 * (-1.0 / 6 + r2 * (1.0 / 120 + r2 * (-1.0 / 5040 + r2 * (1.0 / 362880 + r2 * (-1.0 / 39916800))))));
    const double c = 1.0 + r2 * (-0.5 + r2 * (1.0 / 24 + r2 * (-1.0 / 720 + r2 * (1.0 / 40320 + r2 * (-1.0 / 3628800 + r2 * (1.0 / 479001600))))));
    double so, co;
    if (qq == 0) { so = s; co = c; } else if (qq == 1) { so = c; co = -s; } else if (qq == 2) { so = -s; co = -c; } else { so = -c; co = s; }
    sn = (float)so; cs = (float)co;
}
__device__ __forceinline__ void ph_rope(const int* pos, float* ROPE, int gtid, int NGT) {
    for (int idx = gtid; idx < MTOK * 24; idx += NGT) {
        const int tok = idx / 24, i = idx % 24, k = i < 16 ? i : 2 * (i - 16);
        float f = 0x1.000000p+0f;
        f = k == 1 ? 0x1.c2ef76p-2f : f; f = k == 2 ? 0x1.8d275ep-3f : f; f = k == 3 ? 0x1.5dc95ap-4f : f; f = k == 4 ? 0x1.341190p-5f : f; f = k == 5 ? 0x1.0f5384p-6f : f;
        f = k == 6 ? 0x1.ddee9cp-8f : f; f = k == 7 ? 0x1.a4ee3ep-9f : f; f = k == 8 ? 0x1.72ba44p-10f : f; f = k == 9 ? 0x1.468318p-11f : f; f = k == 10 ? 0x1.1f91f0p-12f : f;
        f = k == 11 ? 0x1.fa8b84p-14f : f; f = k == 12 ? 0x1.be218ap-15f : f; f = k == 13 ? 0x1.88ec22p-16f : f; f = k == 14 ? 0x1.5a0f50p-17f : f; f = k == 15 ? 0x1.30c94ep-18f : f;
        const float ang = (float)pos[tok] * f;
        float sn, cs; sincos_f32arg(ang, sn, cs);
        float* rp = ROPE + (size_t)tok * 48;
        if (i < 16) { rp[i] = cs; rp[16 + i] = sn; } else { rp[32 + (i - 16)] = cs; rp[40 + (i - 16)] = sn; }
    }
}
template <bool TO_F32>
__device__ __forceinline__ void ph_rmsnorm(const float* X, const float* g, h16* OUTH, float* OUTF, int gw, int NGW, int lane) {
    for (int row = gw; row < MTOK; row += NGW) {
        const f32x4* xr = (const f32x4*)(X + (size_t)row * DM) + lane;
        f32x4 v[8]; float s = 0.f;
#pragma unroll
        for (int j = 0; j < 8; ++j) { v[j] = xr[64 * j]; s += (v[j][0] * v[j][0] + v[j][1] * v[j][1]) + (v[j][2] * v[j][2] + v[j][3] * v[j][3]); }
        const float r = 1.0f / sqrtf(wave_sum(s) * (1.0f / DM) + EPS);
#pragma unroll
        for (int j = 0; j < 8; ++j) { const f32x4 gg = *((const f32x4*)g + lane + 64 * j); const f32x4 o = v[j] * r * gg;
            if (TO_F32) *((f32x4*)(OUTF + (size_t)row * DM) + lane + 64 * j) = o; else st4h(OUTH + (size_t)row * DM + 4 * (lane + 64 * j), o); }
    }
}
__device__ __forceinline__ void ph_final(const h16* X, float* OUT, const float* g, const float* RS, int gw, int NGW, int lane) {
    for (int row = gw; row < MTOK; row += NGW) {
        const float r = __builtin_amdgcn_rsqf(RS[row] * (1.0f / DM) + EPS);
        h16x8 v[4];
#pragma unroll
        for (int j = 0; j < 4; ++j) v[j] = *((const h16x8*)(X + (size_t)row * DM) + lane + 64 * j);
#pragma unroll
        for (int j = 0; j < 4; ++j) { const float* gp = g + 8 * (lane + 64 * j); float* op = OUT + (size_t)row * DM + 8 * (lane + 64 * j);
            const f32x4 g0 = *(const f32x4*)gp, g1 = *(const f32x4*)(gp + 4);
            f32x4 o0 = {(float)v[j][0], (float)v[j][1], (float)v[j][2], (float)v[j][3]}, o1 = {(float)v[j][4], (float)v[j][5], (float)v[j][6], (float)v[j][7]};
            *(f32x4*)op = o0 * r * g0; *(f32x4*)(op + 4) = o1 * r * g1; }
    }
}
__device__ __forceinline__ unsigned fkey(float f) { const unsigned u = __float_as_uint(f + 0.0f); return (u & 0x80000000u) ? ~u : (u | 0x80000000u); }
template <int LVL>
__device__ __forceinline__ void hist_level(const unsigned (&key)[64], int nj, int lane, LAS unsigned* hist, unsigned& prefix, unsigned& need, unsigned& cnt_eq) {
    constexpr int SH = LVL == 0 ? 21 : (LVL == 1 ? 10 : 0), PSH = LVL == 1 ? 21 : 10, NB = LVL == 2 ? 10 : 11;
#pragma unroll
    for (int i = 0; i < 8; ++i) *(LAS u32x4*)(hist + lane * 32 + 4 * i) = (u32x4){0u, 0u, 0u, 0u};
    asm volatile("s_waitcnt lgkmcnt(0)" ::: "memory"); __builtin_amdgcn_wave_barrier();
#pragma unroll
    for (int j8 = 0; j8 < 8; ++j8) {
        if (8 * j8 < nj) {
            if (LVL == 0) {
#pragma unroll
                for (int j = 8 * j8; j < 8 * j8 + 8; ++j) __hip_atomic_fetch_add(hist + (key[j] >> 21), 1u, __ATOMIC_RELAXED, __HIP_MEMORY_SCOPE_WORKGROUP);
            } else {
                bool any = false;
#pragma unroll
                for (int j = 8 * j8; j < 8 * j8 + 8; ++j) any = any || ((key[j] >> PSH) == prefix);
                if (LVL == 1 || __any(any)) {
#pragma unroll
                    for (int j = 8 * j8; j < 8 * j8 + 8; ++j) { const unsigned k = key[j];
                        if ((k >> PSH) == prefix) __hip_atomic_fetch_add(hist + ((k >> SH) & ((1u << NB) - 1u)), 1u, __ATOMIC_RELAXED, __HIP_MEMORY_SCOPE_WORKGROUP); }
                }
            }
        }
    }
    asm volatile("s_waitcnt lgkmcnt(0)" ::: "memory"); __builtin_amdgcn_wave_barrier();
    unsigned s = 0;
#pragma unroll
    for (int i = 0; i < 8; ++i) { const u32x4 v = *(const LAS u32x4*)(hist + lane * 32 + 4 * i); s += (v[0] + v[1]) + (v[2] + v[3]); }
    unsigned S = s;
#pragma unroll
    for (int o = 1; o < 64; o <<= 1) { const unsigned nb = __shfl_down(S, o); if (lane + o < 64) S += nb; }
    const int L = 63 - __builtin_clzll(__ballot(S >= need));
    const unsigned aboveL = __shfl(S - s, L);
    const int bi = lane & 31;
    const unsigned hb = hist[L * 32 + bi];
    unsigned R = hb;
#pragma unroll
    for (int o = 1; o < 32; o <<= 1) { const unsigned nb = __shfl_down(R, o); if (bi + o < 32) R += nb; }
    const int B = 31 - __builtin_clz((unsigned)__ballot(aboveL + R >= need));
    const unsigned abB = __shfl(aboveL + R - hb, B);
    cnt_eq = __shfl(hb, B);
    prefix = (prefix << NB) | (unsigned)(L * 32 + B);
    need -= abB;
    __builtin_amdgcn_wave_barrier();
}
__device__ __forceinline__ u64 topk_select_hist(const unsigned (&key)[64], int nvalid, int lane, LAS unsigned* hist) {
    const int nj = (nvalid + 63) >> 6;
    unsigned prefix = 0, need = TOPK, cnt_eq = 0;
    hist_level<0>(key, nj, lane, hist, prefix, need, cnt_eq);
    hist_level<1>(key, nj, lane, hist, prefix, need, cnt_eq);
    if (need != cnt_eq) hist_level<2>(key, nj, lane, hist, prefix, need, cnt_eq);
    else prefix <<= 10;
    u64 mw = 0;
    if (need == cnt_eq) {
#pragma unroll
        for (int j = 0; j < 64; ++j) { const u64 bal = __ballot(key[j] >= prefix); if (lane == j) mw = bal; }
    } else {
        int nd = (int)need;
#pragma unroll
        for (int j = 0; j < 64; ++j) { u64 eq = __ballot(key[j] == prefix); const u64 gt = __ballot(key[j] > prefix);
            int pc = __builtin_popcountll(eq);
            while (pc > nd) { eq &= ~(1ull << (63 - __builtin_clzll(eq))); --pc; }
            nd -= pc; if (lane == j) mw = gt | eq; }
    }
    return mw;
}
namespace idx {
typedef short s16x8 __attribute__((ext_vector_type(8)));
typedef float f32x16 __attribute__((ext_vector_type(16)));
constexpr int CHK = 128, CHB = CHK * 128;
__device__ __forceinline__ unsigned half_sum(unsigned v) {
#pragma unroll
    for (int o = 1; o < 32; o <<= 1) v += __shfl_xor(v, o);
    return v;
}
__device__ __forceinline__ void run_group(unsigned char* ws, char* lds, unsigned* scr, int b, int g, int wv) {
    int tid = wv * 64 + lane_id(); asm volatile("" : "+v"(tid));
    const int wid = __builtin_amdgcn_readfirstlane(tid >> 6), lane = tid & 63, c = lane & 31, hi = lane >> 5;
    const int t0 = 16 * g + 2 * wid, t = t0 + hi, row = b * T + t, tmaxblk = 16 * g + 15, nch = (tmaxblk >> 7) + 1;
    const h16* QI = (const h16*)(ws + WS_QI); const char* KIb = (const char*)ws + WS_KI + (size_t)b * T * 128; const float* WI = (const float*)(ws + WS_WI);
    s16x8 A[4];
    { const int rho = c, qsel = (rho >> 2) & 1, head = (rho & 3) + 4 * (rho >> 3);
      const h16* qp = QI + (size_t)(b * T + t0 + qsel) * 1024 + head * 64 + 8 * hi;
#pragma unroll
      for (int ks = 0; ks < 4; ++ks) A[ks] = *reinterpret_cast<const s16x8*>(qp + 16 * ks); }
    float w[16];
    { const f32x4* wp = (const f32x4*)(WI + (size_t)row * 16);
#pragma unroll
      for (int i = 0; i < 4; ++i) { const f32x4 v = wp[i]; w[4 * i] = v[0]; w[4 * i + 1] = v[1]; w[4 * i + 2] = v[2]; w[4 * i + 3] = v[3]; } }
    const int pr0 = tid >> 3, pp = tid & 7;
    const unsigned g_off = (unsigned)(pr0 * 128 + pp * 16);
    const int l_off0 = pr0 * 128 + ((pp ^ ((pr0 >> 1) & 7)) << 4), l_off1 = l_off0 + 64 * 128;
    const int rd_base = c * 128; const int sw = (c >> 1) & 7;
    int rd_off[4];
#pragma unroll
    for (int ks = 0; ks < 4; ++ks) rd_off[ks] = rd_base + (((2 * ks + hi) ^ sw) << 4);
    unsigned* myscr = scr + (size_t)(2 * wid + hi) * T + c;
    asm volatile("" :: "v"(A[0]), "v"(A[1]), "v"(A[2]), "v"(A[3]), "v"(w[0]), "v"(w[4]), "v"(w[8]), "v"(w[12]));
    s16x8 st0, st1;
    { const char* src = KIb; st0 = *reinterpret_cast<const s16x8*>(src + g_off); st1 = *reinterpret_cast<const s16x8*>(src + 64 * 128 + g_off); }
    *reinterpret_cast<s16x8*>(lds + l_off0) = st0; *reinterpret_cast<s16x8*>(lds + l_off1) = st1;
    __syncthreads();
#pragma unroll 1
    for (int ch = 0; ch < nch; ++ch) {
        const char* buf = lds + (ch & 1) * CHB;
        if (ch + 1 < nch) { const char* src = KIb + (size_t)(ch + 1) * CHB; st0 = *reinterpret_cast<const s16x8*>(src + g_off); st1 = *reinterpret_cast<const s16x8*>(src + 64 * 128 + g_off); }
#pragma unroll
        for (int st = 0; st < 4; ++st) {
            f32x16 acc = {};
#pragma unroll
            for (int ks = 0; ks < 4; ++ks) { const s16x8 Bf = *reinterpret_cast<const s16x8*>(buf + st * 4096 + rd_off[ks]);
                acc = __builtin_amdgcn_mfma_f32_32x32x16_f16(__builtin_bit_cast(h16x8, A[ks]), __builtin_bit_cast(h16x8, Bf), acc, 0, 0, 0); }
            float sc = 0.f;
#pragma unroll
            for (int r = 0; r < 16; ++r) { const int ri = __float_as_int(acc[r]); sc = fmaf(w[r], __int_as_float(ri > 0 ? ri : 0), sc); }
            const int sidx = ch * CHK + st * 32 + c;
            myscr[ch * CHK + st * 32] = (sidx <= t) ? fkey(sc) : 0u;
        }
        if (ch + 1 < nch) { char* dst = lds + ((ch + 1) & 1) * CHB; *reinterpret_cast<s16x8*>(dst + l_off0) = st0; *reinterpret_cast<s16x8*>(dst + l_off1) = st1; }
        __syncthreads();
    }
    asm volatile("s_waitcnt vmcnt(0)" ::: "memory");
    u64* MASK = (u64*)(ws + WS_MASK);
#pragma unroll 1
    for (int qq = 0; qq < 2; ++qq) {
        const int tq = t0 + qq, nj = (tq >> 6) + 1;
        const unsigned* src = scr + (size_t)(2 * wid + qq) * T + lane;
        unsigned key[64];
#pragma unroll
        for (int j = 0; j < 64; ++j) key[j] = (j < nj) ? __hip_atomic_load(src + 64 * j, __ATOMIC_RELAXED, __HIP_MEMORY_SCOPE_AGENT) : 0u;
        u64 mw;
        if (tq + 1 <= TOPK) {
            mw = 0;
#pragma unroll
            for (int j = 0; j < 4; ++j) { const u64 bal = __ballot(key[j] != 0u); if (lane == j) mw = bal; }
        } else mw = topk_select_hist(key, tq + 1, lane, (LAS unsigned*)(lds + 2 * CHB + wid * 8192));
        MASK[(size_t)(b * T + tq) * 64 + lane] = mw;
    }
}
}

namespace att {
constexpr int NW = 8, QBLK = 32, KVBLK = 64, QB = NW * QBLK, D = 128;
constexpr int SHM_V = KVBLK * D * 2, SHM_K = KVBLK * D * 2;
constexpr int LDS_NEED = 2 * SHM_V + 2 * SHM_K + NW * 64 * 4;
constexpr float THR = 8.f, SCALE = 0.08838834764831845f;
typedef short s16x8 __attribute__((ext_vector_type(8)));
typedef short s16x4 __attribute__((ext_vector_type(4)));
typedef float f32x16 __attribute__((ext_vector_type(16)));
#define KSWZ(row, colB) ((row) * 256 + ((colB) ^ (((row) & 7) << 4)))
#define SBAR() __builtin_amdgcn_sched_barrier(0)
__device__ __forceinline__ int v_st(int k, int c) { const int kk = (k & ~0xC) | ((k & 4) << 1) | ((k & 8) >> 1); return ((kk >> 3) * 4 + (c >> 5)) * 512 + ((kk & 7) * 32 + (c & 31)) * 2; }
__device__ __forceinline__ int v_rd_base(int lane) { return ((lane & 3) << 3) | (((lane >> 2) & 3) << 6) | (((lane >> 4) & 1) << 5) | (((lane >> 5) & 1) << 8); }
constexpr int v_rd_off(int d0, int ks, int half) { return d0 * 512 + ks * 4096 + half * 2048; }
__device__ __forceinline__ int crow(int r, int hi) { return (r & 3) + 8 * (r >> 2) + 4 * hi; }
__device__ __forceinline__ unsigned cvtpk(float lo, float hi) { unsigned r; asm volatile("v_cvt_pk_f16_f32 %0, %1, %2" : "=v"(r) : "v"(lo), "v"(hi)); return r; }
__device__ __forceinline__ f32x16 mfma16(s16x8 a, s16x8 b, f32x16 c) { return __builtin_amdgcn_mfma_f32_32x32x16_f16(__builtin_bit_cast(h16x8, a), __builtin_bit_cast(h16x8, b), c, 0, 0, 0); }
__device__ __forceinline__ s16x8 load8(const h16* p) { return *reinterpret_cast<const s16x8*>(p); }
__device__ __forceinline__ void mask_causal(f32x16& p0, f32x16& p1, int dq) {
    const float NEG = -__builtin_inff();
#pragma unroll
    for (int r = 0; r < 16; ++r) { const int c = (r & 3) + 8 * (r >> 2); if (dq - c < 0) p0[r] = NEG; if (dq - c - 32 < 0) p1[r] = NEG; }
}
__device__ __forceinline__ void partialSM(f32x16& p0, f32x16& p1, float& m_reg, float& mn, float& alpha) {
    float pmax = p0[0]; for (int r = 1; r < 16; ++r) pmax = fmaxf(pmax, p0[r]); for (int r = 0; r < 16; ++r) pmax = fmaxf(pmax, p1[r]);
    { auto rr = __builtin_amdgcn_permlane32_swap(__float_as_uint(pmax), __float_as_uint(pmax), false, false);
      pmax = fmaxf(__uint_as_float(rr[0]), __uint_as_float(rr[1])); }
    constexpr float C2 = 1.4426950408889634f * SCALE;
    if (__builtin_expect(__all((pmax - m_reg) * SCALE <= THR), 1)) { mn = m_reg; alpha = 1.f; }
    else { mn = fmaxf(m_reg, pmax); alpha = __builtin_amdgcn_exp2f((m_reg - mn) * C2); m_reg = mn; }
    const float mnL = -mn * C2;
    for (int r = 0; r < 16; ++r) p0[r] = fmaf(p0[r], C2, mnL); for (int r = 0; r < 16; ++r) p1[r] = fmaf(p1[r], C2, mnL);
    for (int r = 0; r < 16; ++r) p0[r] = __builtin_amdgcn_exp2f(p0[r]);
}
__device__ __forceinline__ void finishSM(f32x16& p0, f32x16& p1, float alpha, float& l_reg, s16x8& pa0, s16x8& pa1, s16x8& pa2, s16x8& pa3) {
    for (int r = 0; r < 16; ++r) p1[r] = __builtin_amdgcn_exp2f(p1[r]);
    float ps = 0; for (int r = 0; r < 16; ++r) ps += p0[r]; for (int r = 0; r < 16; ++r) ps += p1[r];
    { auto rr = __builtin_amdgcn_permlane32_swap(__float_as_uint(ps), __float_as_uint(ps), false, false);
      ps = __uint_as_float(rr[0]) + __uint_as_float(rr[1]); }
    l_reg = l_reg * alpha + ps;
#define PK4(P, B_, OUT) do { unsigned a0 = cvtpk(P[B_+0], P[B_+1]), a1 = cvtpk(P[B_+2], P[B_+3]);                          \
        unsigned b0 = cvtpk(P[B_+4], P[B_+5]), b1 = cvtpk(P[B_+6], P[B_+7]);                                             \
        auto r0 = __builtin_amdgcn_permlane32_swap(a0, b0, false, false); auto r1 = __builtin_amdgcn_permlane32_swap(a1, b1, false, false); \
        u32x4 w = {r0[0], r1[0], r0[1], r1[1]}; OUT = *reinterpret_cast<s16x8*>(&w); } while (0)
    PK4(p0, 0, pa0); PK4(p0, 8, pa1); PK4(p1, 0, pa2); PK4(p1, 8, pa3);
#undef PK4
}
template <int KB>
__device__ __forceinline__ void qkt(f32x16& p0, f32x16& p1, const char* K_lds, int r32, int hi, const s16x8* qr) {
    const char* kb[4];
#pragma unroll
    for (int dd = 0; dd < 4; ++dd) kb[dd] = K_lds + KB * SHM_K + KSWZ(r32, (dd * 16 + hi * 8) * 2);
#pragma unroll
    for (int d0 = 0; d0 < 8; ++d0) { const char* a = kb[d0 & 3] + (d0 >> 2) * 128;
        s16x8 b0 = *reinterpret_cast<const s16x8*>(a);
        s16x8 b1 = *reinterpret_cast<const s16x8*>(a + 32 * 256);
        p0 = mfma16(b0, qr[d0], p0);
        p1 = mfma16(b1, qr[d0], p1); }
}
template <int VB>
__device__ __forceinline__ void pv_tile(f32x16* o, int vb0, s16x8 pa0, s16x8 pa1, s16x8 pa2, s16x8 pa3) {
#define TRRD(dst, off) asm volatile("ds_read_b64_tr_b16 %0, %1 offset:%2" : "=&v"(dst) : "v"(vb0), "i"(off) : "memory")
#define PV_D0(d0) do { s16x4 l0, l1, l2, l3, h0, h1, h2, h3; constexpr int b_ = VB * SHM_V + v_rd_off(d0, 0, 0); \
        TRRD(l0, b_); TRRD(h0, b_ + 2048); TRRD(l1, b_ + 4096); TRRD(h1, b_ + 6144); TRRD(l2, b_ + 8192); TRRD(h2, b_ + 10240); TRRD(l3, b_ + 12288); TRRD(h3, b_ + 14336); \
        asm volatile("s_waitcnt lgkmcnt(0)" ::: "memory"); SBAR();   \
        o[d0] = mfma16(pa0, (s16x8){l0[0], l0[1], l0[2], l0[3], h0[0], h0[1], h0[2], h0[3]}, o[d0]);   \
        o[d0] = mfma16(pa1, (s16x8){l1[0], l1[1], l1[2], l1[3], h1[0], h1[1], h1[2], h1[3]}, o[d0]);   \
        o[d0] = mfma16(pa2, (s16x8){l2[0], l2[1], l2[2], l2[3], h2[0], h2[1], h2[2], h2[3]}, o[d0]);   \
        o[d0] = mfma16(pa3, (s16x8){l3[0], l3[1], l3[2], l3[3], h3[0], h3[1], h3[2], h3[3]}, o[d0]); } while (0)
    PV_D0(0); PV_D0(1); PV_D0(2); PV_D0(3);
#undef PV_D0
#undef TRRD
}
struct BlockRef { const char* Q; const char* K; const char* V; char* O; int P0; const char* NBQ; const char* MK;
                  int j0, nt;
                  int part;
                  char* PART; unsigned* flag; };
struct Seam { s16x8 qr[8]; };
#define LD16(base, off) (*reinterpret_cast<const s16x8*>((base) + (off)))
#define VMW() asm volatile("s_waitcnt vmcnt(0)" ::: "memory")
#define VMWN(n) asm volatile("s_waitcnt vmcnt(%0)" :: "i"(n) : "memory")
#define SLOAD_H(Kp, Vp, k0) do { const char* vb_ = (Vp) + (size_t)(k0) * (D * 2); const char* kb_ = (Kp) + (size_t)(k0) * (D * 2); \
        st_v0 = LD16(vb_, st_off); st_v1 = LD16(vb_ + 32 * D * 2, st_off); st_k0 = LD16(kb_, st_off); st_k1 = LD16(kb_ + 32 * D * 2, st_off); } while (0)
#define SWRITE_HK(bf) do { *(s16x8*)(K_lds + (bf) * SHM_K + kws) = st_k0; *(s16x8*)(K_lds + (bf) * SHM_K + kws + 32 * 256) = st_k1; } while (0)
#define SWRITE_HV(bf) do { *(s16x8*)(V_lds + (bf) * SHM_V + vst0) = st_v0; *(s16x8*)(V_lds + (bf) * SHM_V + vst1) = st_v1; } while (0)
#define SWRITE_H(bf) do { SWRITE_HV(bf); SWRITE_HK(bf); } while (0)
__device__ __forceinline__ void prime(const BlockRef& cur, char* lds, Seam& S, int wv) {
    int tid = wv * 64 + lane_id(); asm volatile("" : "+v"(tid));
    const int wid = __builtin_amdgcn_readfirstlane(tid >> 6), lane = tid & 63, r32 = lane & 31, hi = lane >> 5;
    const unsigned q_off = (unsigned)((wid * QBLK + r32) * D + hi * 8) * 2u;
#pragma unroll
    for (int d0 = 0; d0 < 8; ++d0) S.qr[d0] = LD16(cur.Q + d0 * 32, q_off);
}
template <bool MIXB, int ROLE>
__device__ __forceinline__ void block(const BlockRef& cur, const BlockRef& nxt, char* lds, Seam& S, int wv) {
    constexpr bool CONS = ROLE == 2;
    int tid = wv * 64 + lane_id(); asm volatile("" : "+v"(tid));
    const int wid = __builtin_amdgcn_readfirstlane(tid >> 6), lane = tid & 63, r32 = lane & 31, hi = lane >> 5;
    int NT = cur.nt, J0 = cur.j0;
    const int qlo = cur.P0 + wid * QBLK, qm = qlo + r32 - 4 * hi;
    char* V_lds = lds; char* K_lds = lds + 2 * SHM_V;
    float* wsf = (float*)(lds + 2 * SHM_V + 2 * SHM_K) + wid * 64; float* li_l = wsf, * al_l = wsf + 32;
    float m_reg = -1e30f, l_reg = 0; f32x16 o[4] = {};
    const int sr = tid >> 4, sc = (tid & 15) * 8, vst0 = v_st(sr, sc), vst1 = v_st(32 + sr, sc), kws = KSWZ(sr, sc * 2);
    const int vb0 = (int)(uintptr_t)V_lds + v_rd_base(lane);
    const unsigned st_off = (unsigned)(sr * D + sc) * 2u, q_off = (unsigned)((wid * QBLK + r32) * D + hi * 8) * 2u;
    const unsigned nb_off = (unsigned)hi * 16u, mk_off = (unsigned)(wid * QBLK + r32) * 512u;
    const char* Kh = cur.K; const char* Vh = cur.V;
    const char* bias_l = lds + LDS_NEED;
    if (MIXB) {
        float* cs = (float*)bias_l; float* wtot = (float*)(lds + LDS_NEED + 16384);
        const int L = cur.P0 + QB; const float* lf = (const float*)cur.NBQ;
        float v[8];
        if (8 * tid < L) { const f32x4 a = *(const f32x4*)(lf + 8 * tid), b4 = *(const f32x4*)(lf + 8 * tid + 4); v[0] = a[0]; v[1] = a[1]; v[2] = a[2]; v[3] = a[3]; v[4] = b4[0]; v[5] = b4[1]; v[6] = b4[2]; v[7] = b4[3]; }
        else {
#pragma unroll
            for (int i = 0; i < 8; ++i) v[i] = 0.f; }
#pragma unroll
        for (int i = 1; i < 8; ++i) v[i] += v[i - 1];
        float inc = v[7];
#pragma unroll
        for (int o_ = 1; o_ < 64; o_ <<= 1) { const float nb = __shfl_up(inc, o_); if (lane >= o_) inc += nb; }
        if (lane == 63) wtot[wid] = inc;
        __syncthreads();
        float base = inc - v[7];
#pragma unroll
        for (int w_ = 0; w_ < 7; ++w_) base += (w_ < wid) ? wtot[w_] : 0.f;
        if (8 * tid < L) {
#pragma unroll
            for (int i = 0; i < 8; ++i) cs[8 * tid + i] = (base + v[i]) * -11.313708498984761f; }
        __syncthreads();
        { const float qk2 = __int_as_float(cur.j0);
          const int s_ = 64 * lane + 63; const float dc = (s_ < cur.P0) ? (cs[s_] - cs[cur.P0]) * SCALE : 0.f;
          const bool keep = (s_ >= cur.P0) || (qk2 + dc >= -40.0f);
          J0 = __builtin_ctzll(__ballot(keep)); NT = cur.P0 / KVBLK + 4 - J0; }
        const float nbref = cs[L - 1];
        __syncthreads();
        for (int i = J0 * KVBLK + tid; i < L; i += NW * 64) cs[i] -= nbref;
        __syncthreads(); }
#define RESC(a) do { if (__any((a) < 1.f)) { if (hi == 0) al_l[r32] = (a); asm volatile("s_waitcnt lgkmcnt(0)" ::: "memory");              \
                     for (int d_ = 0; d_ < 4; ++d_) for (int r = 0; r < 16; ++r) o[d_][r] *= al_l[crow(r, hi)]; } } while (0)
#define KBASE(t) ((J0 + (t)) * KVBLK)
#define MKW(t) (*(const u64*)(cur.MK + (size_t)(J0 + (t)) * 8 + mk_off))
#define PINIT(P0_, P1_, t, MW_) do { if (MIXB) { const char* nb_ = bias_l + KBASE(t) * 4 + nb_off; _Pragma("unroll") for (int g_ = 0; g_ < 4; ++g_) { \
            const f32x4 b0_ = *(const f32x4*)(nb_ + 32 * g_), b1_ = *(const f32x4*)(nb_ + 128 + 32 * g_); \
            _Pragma("unroll") for (int j_ = 0; j_ < 4; ++j_) { P0_[4 * g_ + j_] = b0_[j_]; P1_[4 * g_ + j_] = b1_[j_]; } } } else { const u64 w_ = (MW_); const unsigned lo_ = (unsigned)w_ >> (4 * hi), up_ = (unsigned)(w_ >> 32) >> (4 * hi); \
            _Pragma("unroll") for (int r_ = 0; r_ < 16; ++r_) { const int c_ = (r_ & 3) + 8 * (r_ >> 2); \
                P0_[r_] = __uint_as_float((((lo_ >> c_) & 1u) - 1u) & 0xff800000u); P1_[r_] = __uint_as_float((((up_ >> c_) & 1u) - 1u) & 0xff800000u); } } } while (0)
#define MASKT(P0_, P1_, t, MW_) do { if (MIXB) { const int kb_ = KBASE(t); if (kb_ + KVBLK - 1 > qlo) mask_causal(P0_, P1_, qm - kb_); } } while (0)
    f32x16 pA0, pA1, pB0, pB1; float mnA, mnB, alA, alB; s16x8 pa0, pa1, pa2, pa3;
    u64 mwA = 0, mwB = 0;
    if (!MIXB) { mwA = MKW(0); if (NT > 1) mwB = MKW(1); }
    PINIT(pA0, pA1, 0, mwA); if (!MIXB) { if (NT > 2) mwA = MKW(2); }
    if (NT > 1) { PINIT(pB0, pB1, 1, mwB); if (!MIXB) { if (NT > 3) mwB = MKW(3); } }
    s16x8 st_v0, st_v1, st_k0, st_k1;
    SLOAD_H(Kh, Vh, KBASE(0)); VMW(); SWRITE_HK(0); SWRITE_HV(0); SBAR();
    __syncthreads();
    if (NT > 1) SLOAD_H(Kh, Vh, KBASE(1));
    SBAR(); qkt<0>(pA0, pA1, K_lds, r32, hi, S.qr);
    MASKT(pA0, pA1, 0, mwA);
    partialSM(pA0, pA1, m_reg, mnA, alA);
    if (NT > 1) { VMW(); SWRITE_H(1); }
    __syncthreads();
#define HALF_STEP(PX0, PX1, mnX, alX, MWX, PY0, PY1, alY, MWY, t, KB, VB, SB) do {                                               \
        SBAR(); qkt<KB>(PX0, PX1, K_lds, r32, hi, S.qr);                                                                      \
        finishSM(PY0, PY1, alY, l_reg, pa0, pa1, pa2, pa3); SBAR();                                                           \
        if ((t) + 1 < NT) { PINIT(PY0, PY1, (t) + 1, MWY); if (!MIXB) { if ((t) + 3 < NT) MWY = MKW((t) + 3); } SLOAD_H(Kh, Vh, KBASE((t) + 1)); SBAR(); }                             \
        pv_tile<VB>(o, vb0, pa0, pa1, pa2, pa3); MASKT(PX0, PX1, (t), MWX); \
        partialSM(PX0, PX1, m_reg, mnX, alX);                                                                                 \
        __syncthreads();                                                                                                      \
        if ((t) + 1 < NT) { VMW(); SWRITE_H(SB); }                                                                            \
        RESC(alX); __syncthreads(); } while (0)
    for (int t = 1; t + 1 < NT; t += 2) {
        HALF_STEP(pB0, pB1, mnB, alB, mwB, pA0, pA1, alA, mwA, t, 1, 0, 0);
        HALF_STEP(pA0, pA1, mnA, alA, mwA, pB0, pB1, alB, mwB, t + 1, 0, 1, 1);
    }
    const bool even = (NT & 1) == 0;
    if (even) { SBAR(); qkt<1>(pB0, pB1, K_lds, r32, hi, S.qr); SBAR(); }
    if (!CONS) {
#pragma unroll
        for (int d0 = 0; d0 < 8; ++d0) S.qr[d0] = LD16(nxt.Q + d0 * 32, q_off); }
    SBAR();
    finishSM(pA0, pA1, alA, l_reg, pa0, pa1, pa2, pa3); SBAR();
    pv_tile<0>(o, vb0, pa0, pa1, pa2, pa3);
    if (even) { MASKT(pB0, pB1, NT - 1, mwB); partialSM(pB0, pB1, m_reg, mnB, alB); __syncthreads(); RESC(alB);
        finishSM(pB0, pB1, alB, l_reg, pa0, pa1, pa2, pa3); SBAR(); pv_tile<1>(o, vb0, pa0, pa1, pa2, pa3); }
    constexpr float C2E = 1.4426950408889634f * SCALE;
    if (!CONS && cur.part == 1) {
        float* po = (float*)cur.PART + (size_t)wid * (64 * 64) + lane;
#pragma unroll
        for (int d0 = 0; d0 < 4; ++d0)
#pragma unroll
            for (int r = 0; r < 16; ++r) po[(d0 * 16 + r) * 64] = o[d0][r];
        float* pml = (float*)cur.PART + 8 * 64 * 64 + wid * 128;
        pml[lane] = m_reg; pml[64 + lane] = l_reg;
        asm volatile("s_waitcnt vmcnt(0)" ::: "memory");
        __syncthreads();
        if (tid == 0) { __builtin_amdgcn_fence(__ATOMIC_RELEASE, "agent"); asm volatile("s_waitcnt vmcnt(0)" ::: "memory"); __hip_atomic_store(cur.flag, 1u, __ATOMIC_RELAXED, __HIP_MEMORY_SCOPE_AGENT); }
    } else {
        float a_me = 1.f;
        if (CONS) {
            if (tid == 0) { unsigned spins = 0; while (__hip_atomic_load(cur.flag, __ATOMIC_RELAXED, __HIP_MEMORY_SCOPE_AGENT) == 0u) { __builtin_amdgcn_s_sleep(4); if (++spins > (1u << 22)) break; }
                __builtin_amdgcn_fence(__ATOMIC_ACQUIRE, "agent"); asm volatile("s_waitcnt vmcnt(0)" ::: "memory"); }
            __syncthreads();
            const float* pml = (const float*)cur.PART + 8 * 64 * 64 + wid * 128;
            const float m2 = pml[lane], l2 = pml[64 + lane];
            const float mm = fmaxf(m_reg, m2); a_me = __builtin_amdgcn_exp2f((m_reg - mm) * C2E); const float a_ot = __builtin_amdgcn_exp2f((m2 - mm) * C2E);
            l_reg = l_reg * a_me + l2 * a_ot;
            if (hi == 0) { li_l[r32] = a_me; al_l[r32] = a_ot; } asm volatile("s_waitcnt lgkmcnt(0)" ::: "memory");
            const float* po = (const float*)cur.PART + (size_t)wid * (64 * 64) + lane;
#pragma unroll
            for (int r = 0; r < 16; ++r) { const float fa = li_l[crow(r, hi)], fb = al_l[crow(r, hi)];
#pragma unroll
                for (int d0 = 0; d0 < 4; ++d0) o[d0][r] = o[d0][r] * fa + po[(d0 * 16 + r) * 64] * fb; }
            asm volatile("s_waitcnt lgkmcnt(0)" ::: "memory");
        }
        if (hi == 0) li_l[r32] = l_reg; asm volatile("s_waitcnt lgkmcnt(0)" ::: "memory");
        float rli[16];
#pragma unroll
        for (int r = 0; r < 16; ++r) rli[r] = __builtin_amdgcn_rcpf(li_l[crow(r, hi)]);
        const unsigned o_off = (unsigned)((wid * QBLK + 4 * hi) * 1024 + r32) * 2u;
#pragma unroll
        for (int r = 0; r < 16; ++r) {
#pragma unroll
            for (int d0 = 0; d0 < 4; ++d0) { const float v = o[d0][r] * rli[r];
                const float vn = __shfl_xor(v, 1);
                if ((r32 & 1) == 0) *(unsigned*)(cur.O + (size_t)(((r & 3) + 8 * (r >> 2)) * 2048 + d0 * 64) + o_off) = cvtpk(v, vn); } }
    }
    __syncthreads();
#undef RESC
#undef KBASE
#undef PINIT
#undef MKW
#undef MASKT
#undef HALF_STEP
}
#undef LD16
#undef VMW
#undef VMWN
#undef SLOAD_H
#undef SWRITE_HK
#undef SWRITE_HV
#undef SWRITE_H
constexpr int SCHED_MAXI = 3;
__device__ const short SCHED[256][3] = {
  {6752, 242, -1},
  {6768, 498, -1},
  {6784, 754, -1},
  {6800, 1010, -1},
  {6816, 1266, -1},
  {6832, 1522, -1},
  {6848, 1778, -1},
  {6864, 2034, -1},
  {6880, 2290, -1},
  {6896, 2546, -1},
  {6944, 2802, -1},
  {6960, 3058, -1},
  {6976, 3314, -1},
  {6992, 3570, -1},
  {7008, 3826, -1},
  {7024, 4082, -1},
  {5856, 226, -1},
  {5872, 482, -1},
  {5920, 738, -1},
  {5936, 994, -1},
  {5952, 1250, -1},
  {5968, 1506, -1},
  {5984, 1762, -1},
  {6000, 2018, -1},
  {6016, 2274, -1},
  {6032, 2530, -1},
  {6048, 2786, -1},
  {6064, 3042, -1},
  {6080, 3298, -1},
  {6096, 3554, -1},
  {6112, 3810, -1},
  {6128, 4066, -1},
  {2064, 5280, 210},
  {5296, 6160, 466},
  {2320, 5312, 722},
  {5328, 6416, 978},
  {2576, 5344, 1234},
  {5360, 6672, 1490},
  {2832, 5408, 1746},
  {5424, 6928, 2002},
  {3088, 5440, 2258},
  {5456, 7184, 2514},
  {3344, 5472, 2770},
  {5488, 7440, 3026},
  {3600, 5504, 3282},
  {5520, 7696, 3538},
  {3856, 5536, 3794},
  {5552, 7952, 4050},
  {4416, 7328, 194},
  {4432, 7344, 450},
  {4448, 7360, 706},
  {4464, 7376, 962},
  {4480, 7392, 1218},
  {4496, 7408, 1474},
  {4512, 7456, 1730},
  {4528, 7472, 1986},
  {4544, 7488, 2242},
  {4560, 7504, 2498},
  {4576, 7520, 2754},
  {4592, 7536, 3010},
  {4640, 7552, 3266},
  {4656, 7568, 3522},
  {4672, 7584, 3778},
  {4688, 7600, 4034},
  {32, 7616, 178},
  {288, 7632, 434},
  {544, 7648, 690},
  {800, 7664, 946},
  {1056, 7712, 1202},
  {1312, 7728, 1458},
  {1568, 7744, 1714},
  {1824, 7760, 1970},
  {2080, 7776, 2226},
  {2336, 7792, 2482},
  {2592, 7808, 2738},
  {2848, 7824, 2994},
  {3104, 7840, 3250},
  {3360, 7856, 3506},
  {3616, 7872, 3762},
  {3872, 7888, 4018},
  {2112, 162, -1},
  {2193, 418, -1},
  {2368, 674, -1},
  {2449, 930, -1},
  {2624, 1186, -1},
  {2705, 1442, -1},
  {2880, 1698, -1},
  {2961, 1954, -1},
  {3136, 2210, -1},
  {3217, 2466, -1},
  {3392, 2722, -1},
  {3473, 2978, -1},
  {3648, 3234, -1},
  {3729, 3490, -1},
  {3904, 3746, -1},
  {3985, 4002, -1},
  {64, 146, -1},
  {145, 402, -1},
  {320, 658, -1},
  {401, 914, -1},
  {576, 1170, -1},
  {657, 1426, -1},
  {832, 1682, -1},
  {913, 1938, -1},
  {1088, 2194, -1},
  {1169, 2450, -1},
  {1344, 2706, -1},
  {1425, 2962, -1},
  {1600, 3218, -1},
  {1681, 3474, -1},
  {1856, 3730, -1},
  {1937, 3986, -1},
  {161, 130, -1},
  {417, 386, -1},
  {673, 642, -1},
  {929, 898, -1},
  {1185, 1154, -1},
  {1441, 1410, -1},
  {1697, 1666, -1},
  {1953, 1922, -1},
  {2209, 2178, -1},
  {2465, 2434, -1},
  {2721, 2690, -1},
  {2977, 2946, -1},
  {3233, 3202, -1},
  {3489, 3458, -1},
  {3745, 3714, -1},
  {4001, 3970, -1},
  {112, 6176, -1},
  {241, 6192, -1},
  {368, 6208, -1},
  {497, 6224, -1},
  {624, 6240, -1},
  {753, 6256, -1},
  {880, 6272, -1},
  {1009, 6288, -1},
  {1136, 6304, -1},
  {1265, 6320, -1},
  {1392, 6336, -1},
  {1521, 6352, -1},
  {1648, 6368, -1},
  {1777, 6384, -1},
  {1904, 6432, -1},
  {2033, 6448, -1},
  {2160, 6464, -1},
  {2289, 6480, -1},
  {2416, 6496, -1},
  {2545, 6512, -1},
  {2672, 6528, -1},
  {2801, 6544, -1},
  {2928, 6560, -1},
  {3057, 6576, -1},
  {3184, 6592, -1},
  {3313, 6608, -1},
  {3440, 6624, -1},
  {3569, 6640, -1},
  {3696, 6688, -1},
  {3825, 6704, -1},
  {3952, 6720, -1},
  {4081, 6736, -1},
  {225, 0, 5568},
  {481, 5584, 4096},
  {737, 256, 5600},
  {993, 5616, 4352},
  {1249, 512, 5664},
  {1505, 5680, 4608},
  {1761, 768, 5696},
  {2017, 5712, 4864},
  {2273, 1024, 5728},
  {2529, 5744, 5120},
  {2785, 1280, 5760},
  {3041, 5776, 5376},
  {3297, 1536, 5792},
  {3553, 5808, 5632},
  {3809, 1792, 5824},
  {4065, 5840, 5888},
  {96, 4704, 7904},
  {209, 4720, 7920},
  {352, 4736, 7968},
  {465, 4752, 7984},
  {608, 4768, 8000},
  {721, 4784, 8016},
  {864, 4800, 8032},
  {977, 4816, 8048},
  {1120, 4832, 8064},
  {1233, 4848, 8080},
  {1376, 4896, 8096},
  {1489, 4912, 8112},
  {1632, 4928, 8128},
  {1745, 4944, 8144},
  {1888, 4960, 8160},
  {2001, 4976, 8176},
  {2144, 16, 4992},
  {2257, 5008, 4112},
  {2400, 272, 5024},
  {2513, 5040, 4368},
  {2656, 528, 5056},
  {2769, 5072, 4624},
  {2912, 784, 5088},
  {3025, 5104, 4880},
  {3168, 1040, 5152},
  {3281, 5168, 5136},
  {3424, 1296, 5184},
  {3537, 5200, 5392},
  {3680, 1552, 5216},
  {3793, 5232, 5648},
  {3936, 1808, 5248},
  {4049, 5264, 5904},
  {193, 4128, 7040},
  {449, 4144, 7056},
  {705, 4160, 7072},
  {961, 4176, 7088},
  {1217, 4192, 7104},
  {1473, 4208, 7120},
  {1729, 4224, 7136},
  {1985, 4240, 7152},
  {2241, 4256, 7200},
  {2497, 4272, 7216},
  {2753, 4288, 7232},
  {3009, 4304, 7248},
  {3265, 4320, 7264},
  {3521, 4336, 7280},
  {3777, 4384, 7296},
  {4033, 4400, 7312},
  {129, 80, -1},
  {177, 385, -1},
  {641, 336, -1},
  {433, 897, -1},
  {1153, 592, -1},
  {689, 1409, -1},
  {1665, 848, -1},
  {945, 1921, -1},
  {2177, 1104, -1},
  {1201, 2433, -1},
  {2689, 1360, -1},
  {1457, 2945, -1},
  {3201, 1616, -1},
  {1713, 3457, -1},
  {3713, 1872, -1},
  {1969, 3969, -1},
  {2128, 48, 2048},
  {2225, 304, 6144},
  {2384, 560, 2304},
  {2481, 816, 6400},
  {2640, 1072, 2560},
  {2737, 1328, 6656},
  {2896, 1584, 2816},
  {2993, 1840, 6912},
  {3152, 2096, 3072},
  {3249, 2352, 7168},
  {3408, 2608, 3328},
  {3505, 2864, 7424},
  {3664, 3120, 3584},
  {3761, 3376, 7680},
  {3920, 3632, 3840},
  {4017, 3888, 7936},
};

__device__ __forceinline__ BlockRef make_ref(int code, unsigned char* ws) {
    const bool mixb = (code >> 12) != 0; const int bh = (code >> 8) & 15, qb = (code >> 4) & 15, part = code & 15;
    const int b = bh >> 3, h = bh & 7, kvh = mixb ? bh : (b * HAKV + (h >> 2));
    BlockRef r;
    r.Q = (const char*)ws + (mixb ? WS_QB : WS_QA) + ((size_t)bh * T + (size_t)qb * QB) * D * 2;
    r.K = (const char*)ws + (mixb ? WS_KB : WS_KA) + (size_t)kvh * T * D * 2;
    r.V = (const char*)ws + (mixb ? WS_VB : WS_VA) + (size_t)kvh * T * D * 2;
    r.O = (char*)ws + (mixb ? WS_OUTB : WS_OUTA) + ((size_t)(b * T + qb * QB) * 1024 + h * D) * 2;
    r.P0 = qb * QB;
    r.NBQ = nullptr;
    r.MK = (const char*)ws + WS_MASK + (size_t)(b * T + qb * QB) * 64 * 8;
    const int NTall = r.P0 / KVBLK + 4;
    r.part = part; r.j0 = 0; r.nt = NTall;
    r.PART = (char*)ws + WS_PART + (size_t)(bh * 8 + (qb & 7)) * 135168; r.flag = (unsigned*)(ws + WS_CTL) + CW_SPLIT + (bh * 8 + (qb & 7));
    if (part == 1) r.nt = NTall / 2; else if (part == 2) { r.j0 = NTall / 2; r.nt = NTall - NTall / 2; }
    if (mixb) {
        const unsigned* nrm = (const unsigned*)(ws + WS_NORM);
        float q2 = 0.f, k2 = 0.f;
#pragma unroll
        for (int w_ = 0; w_ < 4; ++w_) { q2 += __uint_as_float(nrm[(bh * 16 + qb) * 4 + w_]); k2 += __uint_as_float(nrm[1024 + bh * 4 + w_]); }
        const float qk = 2.02f * __builtin_sqrtf(q2 * k2) * SCALE;
        r.j0 = __float_as_int(qk);
        r.NBQ = (const char*)ws + WS_LOGF + (size_t)bh * T * 4;
    }
    return r;
}
__device__ __forceinline__ void run_list(int cu, unsigned char* ws, char* lds, int wv) {
    Seam S;
    int code = SCHED[cu][0];
    if (code < 0) return;
    BlockRef cur = make_ref(code, ws);
    prime(cur, lds, S, wv);
#pragma unroll 1
    for (int k = 0; k < SCHED_MAXI; ++k) {
        if ((code & 15) == 2) break;
        const int ncode = (k + 1 < SCHED_MAXI) ? SCHED[cu][k + 1] : -1;
        const BlockRef nxt = ncode >= 0 ? make_ref(ncode, ws) : cur;
        if ((code >> 12) != 0) block<true, 0>(cur, nxt, lds, S, wv); else block<false, 0>(cur, nxt, lds, S, wv);
        if (ncode < 0) return;
        cur = nxt; code = ncode;
    }
    block<false, 2>(cur, cur, lds, S, wv);
}
}


#define XB_TMO      128
#define XB_XCNT(j)  (256  + 64 * (j))
#define XB_XSUB(j)  (1280 + 64 * (j))
#define XB_XGEN(j)  (2304 + 64 * (j))
#define XB_TOP      3328
#define XB_TOPGEN   3392
#define XCD_BAR_WORDS 3456
#define XB_SPIN_CAP (1u << 24)
__device__ __forceinline__ unsigned xb_ld(unsigned* p)              { return __hip_atomic_load(p, __ATOMIC_RELAXED, __HIP_MEMORY_SCOPE_AGENT); }
__device__ __forceinline__ unsigned xb_add(unsigned* p, unsigned v) { return __hip_atomic_fetch_add(p, v, __ATOMIC_RELAXED, __HIP_MEMORY_SCOPE_AGENT); }
__device__ __forceinline__ unsigned xb_xcc_id() { return (unsigned)__builtin_amdgcn_s_getreg((3 << 11) | 20) & 0xFu; }
#define XB_SPIN(cond, bar) do { unsigned _sp = 0; while (cond) { __builtin_amdgcn_s_sleep(1); \
    if ((++_sp & 255u) == 0u) { if (xb_ld(&(bar)[XB_TMO])) break; if (_sp > XB_SPIN_CAP) { atomicAdd(&(bar)[XB_TMO], 1u); break; } } } } while (0)
struct XcdBarrier { unsigned* bar; unsigned x; volatile LAS unsigned* st; };
__device__ __forceinline__ XcdBarrier xcd_barrier_post(unsigned* bar, volatile LAS unsigned* st, int wv) {
    XcdBarrier b; b.bar = bar; b.x = xb_xcc_id(); b.st = st;
    if (wv == 0 && lane_id() == 0) (void)xb_add(&bar[XB_XCNT(b.x)], 1u);
    return b;
}
__device__ __forceinline__ void xcd_barrier_complete(unsigned* bar, unsigned x, unsigned& nloc, unsigned& nx) {
    const unsigned G = gridDim.x * gridDim.y * gridDim.z;
    unsigned sum, cnt, mine, sp = 0u;
    for (;;) {
        sum = 0u; cnt = 0u; mine = 0u;
#pragma unroll
        for (unsigned j = 0; j < 16; ++j) { const unsigned c = xb_ld(&bar[XB_XCNT(j)]); sum += c; cnt += (c > 0u) ? 1u : 0u; mine = (j == x) ? c : mine; }
        if (sum == G) break;
        __builtin_amdgcn_s_sleep(1);
        if ((++sp & 255u) == 0u) { if (xb_ld(&bar[XB_TMO])) break; if (sp > XB_SPIN_CAP) { atomicAdd(&bar[XB_TMO], 1u); break; } }
    }
    nloc = mine > 0u ? mine : 1u; nx = cnt > 0u ? cnt : 1u;
}
__device__ __forceinline__ void xcd_barrier(const XcdBarrier& b, int wv) {
    asm volatile("s_waitcnt vmcnt(0)" ::: "memory");
    __syncthreads();
    if (wv == 0 && lane_id() == 0) {
        unsigned* bar = b.bar;
        __builtin_amdgcn_s_waitcnt(0);
        unsigned nloc = b.st[0], nx = b.st[1];
        if (nloc == 0u) { xcd_barrier_complete(bar, b.x, nloc, nx); b.st[0] = nloc; b.st[1] = nx; }
        const unsigned old = xb_add(&bar[XB_XSUB(b.x)], 1u);
        const unsigned gen = old / nloc;
        if (old + 1u == (gen + 1u) * nloc) {
            __builtin_amdgcn_fence(__ATOMIC_RELEASE, "agent");
            asm volatile("s_waitcnt vmcnt(0)" ::: "memory");
            const unsigned og = xb_add(&bar[XB_TOP], 1u);
            const unsigned tg = og / nx;
            if (og + 1u == (tg + 1u) * nx) xb_add(&bar[XB_TOPGEN], 1u);
            else XB_SPIN(xb_ld(&bar[XB_TOPGEN]) == tg, bar);
            __builtin_amdgcn_fence(__ATOMIC_ACQUIRE, "agent");
            xb_add(&bar[XB_XGEN(b.x)], 1u);
            asm volatile("s_waitcnt vmcnt(0)" ::: "memory");
        } else {
            XB_SPIN(xb_ld(&bar[XB_XGEN(b.x)]) == gen, bar);
            __builtin_amdgcn_fence(__ATOMIC_ACQUIRE, "agent");
            asm volatile("s_waitcnt vmcnt(0)" ::: "memory");
        }
    }
    __syncthreads();
}

namespace cg = cooperative_groups;
constexpr int LDS_BYTES = pg8::STAGE_BYTES + 256;
struct Params { const float* in[17]; float* out; unsigned char* ws; };
template <class Epi>
__device__ __forceinline__ void run_gemm(LAS unsigned char* lds, const h16* A, const h16* Bt, int M, int N, int K, const Epi& e, int wv) {
    pg8::Gemm g{A, Bt, M, N, K}; pg8::StaticOrder S; S.init(M, N, (int)gridDim.x, (int)blockIdx.x);
    pg8::gemm_phase<Epi>(lds, g, S, e, wv);
}
__global__ void __launch_bounds__(512, 2) mega_fwd(Params P) {
    extern __shared__ __attribute__((aligned(16))) unsigned char lds_raw[];
    LAS unsigned char* lds = (LAS unsigned char*)lds_raw;
    const int wv = __builtin_amdgcn_readfirstlane(threadIdx.x >> 6);
    volatile LAS unsigned* bst = (volatile LAS unsigned*)(lds + pg8::STAGE_BYTES);
    if (wv == 0 && lane_id() < 2) bst[lane_id()] = 0u;
    __syncthreads();
    const XcdBarrier xbar = xcd_barrier_post((unsigned*)(P.ws + WS_CTL) + CW_BAR, bst, wv);
#define GRID_BAR() xcd_barrier(xbar, wv)
#define IDS() int lane = lane_id(); asm volatile("" : "+v"(lane)); const int wave = wv, tid = wave * 64 + lane, gw = blockIdx.x * 8 + wave, NGW = gridDim.x * 8; (void)tid; (void)gw; (void)NGW
    const float* x = P.in[0]; const float* p = P.in[1]; const int* pos = (const int*)P.in[2];
    const float* g_mix = P.in[3]; const float* w_in = P.in[4]; const float* b_f = P.in[5];
    const float* w_o_a = P.in[6]; const float* w_o_b = P.in[7]; const float* w_out = P.in[8];
    const float* g_ffn = P.in[9]; const float* w_g = P.in[10]; const float* w_u = P.in[11]; const float* w_d = P.in[12];
    const float* g_ple = P.in[13]; const float* w_pg = P.in[14]; const float* w_pp = P.in[15]; const float* g_final = P.in[16];
    unsigned char* ws = P.ws; float* out = P.out;
    float* RS = (float*)(ws + WS_RS); float* ROPE = (float*)(ws + WS_ROPE); float* LOGF = (float*)(ws + WS_LOGF); u64* MASK = (u64*)(ws + WS_MASK);
    h16* WIN = (h16*)(ws + WS_WIN); h16* WOA = (h16*)(ws + WS_WOA); h16* WOB = (h16*)(ws + WS_WOB); h16* WOUT = (h16*)(ws + WS_WOUT);
    h16* WGU = (h16*)(ws + WS_WGU); h16* WDN = (h16*)(ws + WS_WDN); h16* WPG = (h16*)(ws + WS_WPG); h16* WPP = (h16*)(ws + WS_WPP);
    h16* QI = (h16*)(ws + WS_QI); h16* KI = (h16*)(ws + WS_KI); float* WI = (float*)(ws + WS_WI);
    h16* SIGA = (h16*)(ws + WS_SIGA); h16* SIGB = (h16*)(ws + WS_SIGB);
    h16* OUTA = (h16*)(ws + WS_OUTA); h16* OUTB = (h16*)(ws + WS_OUTB); h16* P16 = (h16*)(ws + WS_P16);
    h16* X3H = (h16*)(ws + WS_SIGA);
    h16* MIXED = (h16*)(ws + WS_MIXED); h16* H2 = (h16*)(ws + WS_H2); h16* ACT = (h16*)(ws + WS_ACT); h16* PP = (h16*)(ws + WS_PP);
    h16* H1 = (h16*)P.out;

    { IDS(); LAS float* scr = (LAS float*)(lds + wave * 8448);
      ph_transpose<1>(w_in, nullptr, nullptr, DM, N_IN, WIN, N_INP, scr, gw, NGW, lane);
      ph_transpose<2>(w_g, w_u, g_ffn, DM, DFF, WGU, 2 * DFF, scr, gw, NGW, lane);
      ph_rope(pos, ROPE, blockIdx.x * 512 + tid, gridDim.x * 512);
      for (int i = blockIdx.x * 512 + tid; i < 3 * MTOK; i += gridDim.x * 512) RS[i] = 0.f;
      for (int i = blockIdx.x * 512 + tid; i < 1088; i += gridDim.x * 512) ((unsigned*)(ws + WS_NORM))[i] = 0u;
      ph_rmsnorm<false>(x, g_mix, H1, nullptr, gw, NGW, lane);
    }
    GRID_BAR();
    { EpiInProj e{ws, b_f}; run_gemm(lds, H1, WIN, MTOK, N_INP, DM, e, wv); }
    { const int fi = ((MTOK / 256) * (N_INP / 256)) % (int)gridDim.x;
    if ((int)blockIdx.x >= fi) { IDS(); (void)tid; (void)gw; (void)NGW; LAS float* scr = (LAS float*)(lds + wave * 8448); const int qw = ((int)blockIdx.x - fi) * 8 + wave, nq = ((int)gridDim.x - fi) * 8;
      ph_transpose<0>(w_o_a, nullptr, nullptr, 1024, DM, WOA, DM, scr, qw, nq, lane);
      ph_transpose<0>(w_o_b, nullptr, nullptr, 1024, DM, WOB, DM, scr, qw, nq, lane);
      ph_transpose<0>(w_out, nullptr, nullptr, DM, DM, WOUT, DM, scr, qw, nq, lane); } }
    GRID_BAR();
    { IDS();
      for (int it = blockIdx.x; it < 256; it += gridDim.x) { const int bb = it & 1, gi = it >> 1;
#pragma unroll 1
          for (int pass = 0; pass < 2; ++pass) idx::run_group(ws, (char*)lds_raw, (unsigned*)out + (size_t)blockIdx.x * 16 * T, bb, pass ? 255 - gi : gi, wv); }
      for (int i = blockIdx.x * 512 + tid; i < MTOK * DPLE / 4; i += gridDim.x * 512) st4h(P16 + 4 * (size_t)i, *((const f32x4*)p + i));
    }
    GRID_BAR();
    for (int cu = blockIdx.x; cu < 256; cu += gridDim.x) att::run_list(cu, ws, (char*)lds_raw, wv);
    GRID_BAR();
    { { EpiGate<true> e{SIGA, MIXED}; run_gemm(lds, OUTA, WOA, MTOK, DM, 1024, e, wv); }
    { EpiGate<false> e{SIGB, MIXED}; run_gemm(lds, OUTB, WOB, MTOK, DM, 1024, e, wv); } }
    GRID_BAR();
    { EpiResidNorm<true> e{x, H2, RS}; run_gemm(lds, MIXED, WOUT, MTOK, DM, DM, e, wv); }
    GRID_BAR();
    { EpiSwiGLU e{ACT, RS}; run_gemm(lds, H2, WGU, MTOK, 2 * DFF, DM, e, wv); }
    { const int fi = ((MTOK / 256) * (2 * DFF / 256)) % (int)gridDim.x;
    if ((int)blockIdx.x >= fi) { IDS(); (void)tid; (void)gw; (void)NGW; LAS float* scr = (LAS float*)(lds + wave * 8448); const int qw = ((int)blockIdx.x - fi) * 8 + wave, nq = ((int)gridDim.x - fi) * 8;
      ph_transpose<0>(w_d, nullptr, nullptr, DFF, DM, WDN, DM, scr, qw, nq, lane);
      ph_transpose<0>(w_pg, nullptr, g_ple, DM, DM, WPG, DM, scr, qw, nq, lane);
      ph_transpose<0>(w_pp, nullptr, nullptr, DPLE, DM, WPP, DM, scr, qw, nq, lane); } }
    GRID_BAR();
    { EpiResidNorm<false> e{nullptr, H2, RS + MTOK}; run_gemm(lds, ACT, WDN, MTOK, DM, DFF, e, wv); }
    GRID_BAR();
    { EpiStoreH e{PP, DM}; run_gemm(lds, P16, WPP, MTOK, DM, DPLE, e, wv); }
    if (gridDim.x == (MTOK / 256) * (DM / 256)) {
        EpiPLEFinal e{PP, H2, out, RS + MTOK, RS + 2 * MTOK, g_final, (unsigned*)(ws + WS_CTL) + CW_PANEL}; run_gemm(lds, H2, WPG, MTOK, DM, DM, e, wv);
    } else {
        { EpiPLE e{PP, H2, X3H, RS + MTOK, RS + 2 * MTOK}; run_gemm(lds, H2, WPG, MTOK, DM, DM, e, wv); }
        GRID_BAR();
        { IDS(); ph_final(X3H, out, g_final, RS + 2 * MTOK, gw, NGW, lane); }
    }
#undef IDS
#undef GRID_BAR
}

extern "C" void kernel_launch(void* const* d_in, const int* in_sizes, int n_in, void* d_out, int out_size, void* d_ws, size_t ws_size, hipStream_t stream) {
    if (n_in != 17 || out_size != MTOK * DM || ws_size < WS_END) { fprintf(stderr, "kernel_launch: unexpected shapes / workspace (%d inputs, out %d, ws %zu)\n", n_in, out_size, ws_size); return; }
    static int grid_blocks = 0;
    if (!grid_blocks) {
        int dev = 0, cus = 0, per_cu = 0;
        (void)hipGetDevice(&dev);
        (void)hipDeviceGetAttribute(&cus, hipDeviceAttributeMultiprocessorCount, dev);
        (void)hipFuncSetAttribute((const void*)mega_fwd, hipFuncAttributeMaxDynamicSharedMemorySize, LDS_BYTES);
        (void)hipOccupancyMaxActiveBlocksPerMultiprocessor(&per_cu, (const void*)mega_fwd, 512, LDS_BYTES);
        if (per_cu < 1) { fprintf(stderr, "kernel_launch: occupancy query says %d blocks per CU\n", per_cu); per_cu = 1; }
        if (per_cu > 1) per_cu = 1;
        grid_blocks = cus * per_cu;
    }
    (void)hipMemsetAsync((char*)d_ws + WS_CTL, 0, 64 * 1024, stream);
    Params prm{};
    for (int i = 0; i < 17; ++i) prm.in[i] = (const float*)d_in[i];
    prm.out = (float*)d_out; prm.ws = (unsigned char*)d_ws;
    void* args[] = {&prm};
    hipError_t e = hipLaunchCooperativeKernel((const void*)mega_fwd, dim3(grid_blocks), dim3(512), args, LDS_BYTES, stream);
    if (e != hipSuccess) fprintf(stderr, "cooperative launch failed: %s (grid %d)\n", hipGetErrorString(e), grid_blocks);
}
```

```cpp
#include <hip/hip_runtime.h>
#include <hip/hip_cooperative_groups.h>
#include <stdint.h>
#include <cstdio>

#define LAS __attribute__((address_space(3)))
typedef _Float16 h16;
typedef _Float16 h16x8 __attribute__((ext_vector_type(8)));
typedef _Float16 h16x4 __attribute__((ext_vector_type(4)));
typedef _Float16 h16x2 __attribute__((ext_vector_type(2)));
typedef float f32x4 __attribute__((ext_vector_type(4)));
typedef float f32x2 __attribute__((ext_vector_type(2)));
typedef unsigned u32x4 __attribute__((ext_vector_type(4)));
typedef unsigned u32x2 __attribute__((ext_vector_type(2)));
typedef unsigned long long u64;
__device__ __forceinline__ int lane_id() { int r; asm volatile("v_mbcnt_lo_u32_b32 %0, -1, 0\n\tv_mbcnt_hi_u32_b32 %0, -1, %0" : "=v"(r)); return r; }

constexpr int NBATCH = 2, T = 4096, MTOK = NBATCH * T, DM = 2048;
constexpr int HA = 8, HAKV = 2, HIDX = 16, DIDX = 64, HB = 8, HD = 128;
constexpr int N_IN = 9816, N_INP = 9984, DFF = 5632, DPLE = 256, TOPK = 256;
constexpr float EPS = 1e-6f;
constexpr float ATT_SCALE = 0.08838834764831845f;

constexpr size_t MiB = 1u << 20;
constexpr size_t WS_CTL = 0;
constexpr size_t WS_RS = 512 * 1024;
constexpr size_t WS_NORM = 640 * 1024;
constexpr size_t WS_ROPE = 1 * MiB;
constexpr size_t WS_LOGF = 3 * MiB + 512 * 1024;
constexpr size_t WS_MASK = 4 * MiB;
constexpr size_t WS_WIN = 8 * MiB;
constexpr size_t WS_OUTA = 8 * MiB, WS_OUTB = 24 * MiB, WS_P16 = 40 * MiB;
constexpr size_t WS_WOA = 47 * MiB, WS_WOB = 51 * MiB, WS_WOUT = 55 * MiB, WS_WGU = 63 * MiB, WS_WDN = 107 * MiB, WS_WPG = 129 * MiB, WS_WPP = 137 * MiB;
constexpr size_t WS_QA = 138 * MiB, WS_KA = 154 * MiB, WS_VA = 158 * MiB, WS_QI = 162 * MiB, WS_KI = 178 * MiB, WS_WI = 179 * MiB;
constexpr size_t WS_QB = 180 * MiB, WS_KB = 196 * MiB, WS_VB = 212 * MiB, WS_SIGA = 228 * MiB, WS_SIGB = 260 * MiB, WS_PART = 292 * MiB, WS_END = 328 * MiB;
constexpr size_t WS_MIXED = WS_QB;
constexpr size_t WS_H2 = WS_QA;
constexpr size_t WS_ACT = WS_QB;
constexpr size_t WS_PP = WS_QB;
constexpr int CW_SPLIT = 12288;
constexpr int CW_PANEL = 8192;
constexpr int CW_BAR = 4096;

namespace pg8 {
constexpr int BM = 256, BK = 64, HALF = 128, HTB = HALF * BK * 2, STAGE_BYTES = 8 * HTB, NXCD = 8, WGM = 4;
__host__ __device__ __forceinline__ int lds_byte(int r, int c) { const int st = (r >> 4) * 2 + (c >> 5), rr = r & 15, cc = c & 31, ob = rr * 64 + cc * 2; return st * 1024 + (ob ^ (((ob >> 9) & 1) << 5)); }
__host__ __device__ __forceinline__ int perm32(int rho) { const int n = rho >> 4, i = rho & 15; return 8 * (i >> 2) + 4 * n + (i & 3); }
__host__ __device__ __forceinline__ void stage_rc(int b, int& R, int& C) { const int st = b / 1024, sb = b % 1024, swz = sb ^ (((sb >> 9) & 1) << 5); R = (st >> 1) * 16 + swz / 64; C = (st & 1) * 32 + (swz % 64) / 2; }
struct Unit { int pm, pn, seg; };
struct Gemm { const h16* A; const h16* Bt; int M, N, K; const h16* A2; const h16* Bt2; };
struct StaticOrder {
    int nM, nN, nwg, G, c, segs;
    __host__ __device__ void init(int M, int N, int G_, int c_, int segs_ = 1) { nM = M / BM; nN = N / BM; nwg = nM * nN; G = G_; c = c_; segs = segs_; }
    __host__ __device__ bool next(int i, Unit& u) const {
        u.seg = segs == 2 ? (i & 1) : 0; if (segs == 2) i >>= 1;
        const long L = (long)i * G + c; if (L >= nwg) return false;
        int wgid = (int)L; { const int q = nwg / NXCD, r = nwg % NXCD, xcd = wgid % NXCD, off = wgid / NXCD; wgid = (xcd < r ? xcd * (q + 1) : r * (q + 1) + (xcd - r) * q) + off; }
        const int nig = WGM * nN, gid = wgid / nig, fm = gid * WGM, gsz = (nM - fm) < WGM ? (nM - fm) : WGM;
        u.pm = fm + ((wgid % nig) % gsz); u.pn = (wgid % nig) / gsz; return true;
    }
};
template <class Epi>
__device__ __forceinline__ void gemm_phase(LAS unsigned char* lds, const Gemm g, const StaticOrder& S, const Epi& E, int wv) {
    int tid = wv * 64 + lane_id(); asm volatile("" : "+v"(tid));
    const int wid = __builtin_amdgcn_readfirstlane(tid >> 6), lane = tid & 63, wr = wid >> 2, wc = wid & 3, fr = lane & 15, fq = lane >> 4;
    const int K = g.K, nt = K / BK;
    unsigned voffA[2], voffBp[2];
#pragma unroll
    for (int i = 0; i < 2; ++i) { int R, C; stage_rc(tid * 16 + i * 8192, R, C); voffA[i] = (unsigned)(R * K + C) * 2u; voffBp[i] = (unsigned)(((R & ~31) + perm32(R & 31)) * K + C) * 2u; }
    const size_t kstep = (size_t)(BK * 2);
    const size_t hstep = (size_t)HALF * K * 2;
    const size_t tstep = 2 * hstep;
    const unsigned ldsw = (unsigned)wid * 1024u;
    const int aoff = lds_byte(wr * 64 + fr, fq * 8), boff = lds_byte(wc * 32 + fr, fq * 8);
#define PG8_SA(b, h) (((b) * 2 + (h)) * HTB)
#define PG8_SB(b, h) ((4 + (b) * 2 + (h)) * HTB)
#define PG8_STAGE(bufoff, gbase) do { _Pragma("unroll") for (int _i = 0; _i < 2; ++_i) \
        __builtin_amdgcn_global_load_lds((const unsigned*)((const char*)(gbase) + voffA[_i]), (LAS unsigned*)(lds + (bufoff) + ldsw + _i * 8192), 16, 0, 0); } while (0)
#define PG8_STAGEB(bufoff, gbase, pf) do { _Pragma("unroll") for (int _i = 0; _i < 2; ++_i) \
        __builtin_amdgcn_global_load_lds((const unsigned*)((const char*)(gbase) + ((pf) ? voffBp[_i] : voffA[_i])), (LAS unsigned*)(lds + (bufoff) + ldsw + _i * 8192), 16, 0, 0); } while (0)
#define PG8_LDA(dst, b, h) do { _Pragma("unroll") for (int m = 0; m < 4; ++m) _Pragma("unroll") for (int k = 0; k < 2; ++k) dst[m][k] = *(const LAS h16x8*)(lds + PG8_SA(b, h) + aoff + m * 2048 + k * 1024); } while (0)
#define PG8_LDB(dst, b, h) do { _Pragma("unroll") for (int n = 0; n < 2; ++n) _Pragma("unroll") for (int k = 0; k < 2; ++k) dst[n][k] = *(const LAS h16x8*)(lds + PG8_SB(b, h) + boff + n * 2048 + k * 1024); } while (0)
#define PG8_MMA(ai, bj, At, Bt) do { __builtin_amdgcn_s_setprio(1); _Pragma("unroll") for (int m = 0; m < 4; ++m) _Pragma("unroll") for (int n = 0; n < 2; ++n) _Pragma("unroll") for (int k = 0; k < 2; ++k) \
        acc[ai][bj][m][n] = __builtin_amdgcn_mfma_f32_16x16x32_f16(Bt[n][k], At[m][k], acc[ai][bj][m][n], 0, 0, 0); __builtin_amdgcn_s_setprio(0); } while (0)
#define PG8_WAIT_V(n) asm volatile("s_waitcnt vmcnt(" #n ")" ::: "memory")
#define PG8_WAIT_L(n) asm volatile("s_waitcnt lgkmcnt(" #n ")" ::: "memory")
#define PG8_BAR __builtin_amdgcn_s_barrier()
#define PG8_SCHED __builtin_amdgcn_sched_barrier(0)
    Unit cur, nxt; int ui = 0;
    if (!S.next(0, cur)) return;
    f32x4 acc[2][2][4][2];
#pragma unroll
    for (int a = 0; a < 2; ++a)
#pragma unroll
        for (int b = 0; b < 2; ++b)
#pragma unroll
            for (int m = 0; m < 4; ++m)
#pragma unroll
                for (int n = 0; n < 2; ++n) acc[a][b][m][n] = (f32x4){0.f, 0.f, 0.f, 0.f};
    h16x8 At[4][2], B0[2][2], B1[2][2];
    const char* cA = (const char*)g.A + (size_t)cur.pm * tstep; const char* cB = (const char*)g.Bt + (size_t)cur.pn * tstep;
    bool pfc = Epi::perm(cur.pn);
    PG8_STAGEB(PG8_SB(0, 0), cB, pfc); PG8_STAGE(PG8_SA(0, 0), cA); PG8_STAGEB(PG8_SB(0, 1), cB + hstep, pfc); PG8_STAGE(PG8_SA(0, 1), cA + hstep);
    if (wr == 1) PG8_BAR;
    PG8_WAIT_V(4); PG8_BAR;
    PG8_STAGEB(PG8_SB(1, 0), cB + kstep, pfc); PG8_STAGE(PG8_SA(1, 0), cA + kstep); PG8_STAGEB(PG8_SB(1, 1), cB + hstep + kstep, pfc);
    PG8_WAIT_V(6); PG8_BAR;
    for (;;) {
        const bool has_next = S.next(ui + 1, nxt);
        const char* nA = has_next ? (const char*)((Epi::TWO_SEG && nxt.seg) ? g.A2 : g.A) + (size_t)nxt.pm * tstep : cA; const char* nB = has_next ? (const char*)((Epi::TWO_SEG && nxt.seg) ? g.Bt2 : g.Bt) + (size_t)nxt.pn * tstep : cB;
        const bool pfn = has_next ? Epi::perm(nxt.pn) : pfc;
        for (int t = 0; t < nt; t += 2) {
            const bool last = (t == nt - 2);
            const char* a1 = cA + (size_t)(t + 1) * kstep;
            const char* a2 = last ? nA : cA + (size_t)(t + 2) * kstep; const char* b2 = last ? nB : cB + (size_t)(t + 2) * kstep;
            const char* a3 = a2 + kstep; const char* b3 = b2 + kstep;
            const bool pf2 = last ? pfn : pfc;
            PG8_LDB(B0, 0, 0); PG8_SCHED; PG8_LDA(At, 0, 0); PG8_STAGE(PG8_SA(1, 1), a1 + hstep);
            PG8_WAIT_L(8); PG8_BAR; PG8_WAIT_L(0); PG8_MMA(0, 0, At, B0); PG8_BAR; PG8_SCHED;
            PG8_LDB(B1, 0, 1); PG8_STAGEB(PG8_SB(0, 0), b2, pf2);
            PG8_BAR; PG8_WAIT_L(0); PG8_MMA(0, 1, At, B1); PG8_BAR;
            PG8_LDA(At, 0, 1); PG8_STAGE(PG8_SA(0, 0), a2);
            PG8_BAR; PG8_WAIT_L(0); PG8_MMA(1, 0, At, B0); PG8_BAR; PG8_SCHED;
            PG8_STAGEB(PG8_SB(0, 1), b2 + hstep, pf2);
            PG8_WAIT_V(6); PG8_BAR; PG8_MMA(1, 1, At, B1); PG8_BAR;
            PG8_LDB(B0, 1, 0); PG8_SCHED; PG8_LDA(At, 1, 0); PG8_STAGE(PG8_SA(0, 1), a2 + hstep);
            PG8_WAIT_L(8); PG8_BAR; PG8_WAIT_L(0); PG8_MMA(0, 0, At, B0); PG8_BAR; PG8_SCHED;
            PG8_LDB(B1, 1, 1); PG8_STAGEB(PG8_SB(1, 0), b3, pf2);
            PG8_BAR; PG8_WAIT_L(0); PG8_MMA(0, 1, At, B1); PG8_BAR;
            PG8_LDA(At, 1, 1); PG8_STAGE(PG8_SA(1, 0), a3);
            PG8_BAR; PG8_WAIT_L(0); PG8_MMA(1, 0, At, B0); PG8_BAR; PG8_SCHED;
            PG8_STAGEB(PG8_SB(1, 1), b3 + hstep, pf2);
            PG8_WAIT_V(6); PG8_BAR; PG8_MMA(1, 1, At, B1); PG8_BAR;
        }
        if constexpr (Epi::TWO_SEG) { if (cur.seg == 0) E.mid(acc, cur, wr, wc, fr, fq); else E(acc, cur, wr, wc, fr, fq); }
        else if constexpr (!Epi::AFTER_DRAIN) E(acc, cur, wr, wc, fr, fq);
        if (!has_next) break;
        if (!(Epi::TWO_SEG && nxt.seg))
#pragma unroll
        for (int a = 0; a < 2; ++a)
#pragma unroll
            for (int b = 0; b < 2; ++b)
#pragma unroll
                for (int m = 0; m < 4; ++m)
#pragma unroll
                    for (int n = 0; n < 2; ++n) acc[a][b][m][n] = (f32x4){0.f, 0.f, 0.f, 0.f};
        cur = nxt; cA = nA; cB = nB; pfc = pfn; ++ui;
    }
    PG8_WAIT_V(0);
    if (wr == 0) PG8_BAR;
    PG8_BAR;
    if constexpr (Epi::AFTER_DRAIN) E.fused(acc, cur, wr, wc, fr, fq, lane);
#undef PG8_SA
#undef PG8_SB
#undef PG8_STAGE
#undef PG8_STAGEB
#undef PG8_LDA
#undef PG8_LDB
#undef PG8_MMA
#undef PG8_WAIT_V
#undef PG8_WAIT_L
#undef PG8_BAR
#undef PG8_SCHED
}
}
using pg8::Unit;
typedef f32x4 Acc[2][2][4][2];

__device__ __forceinline__ void st4h(h16* p, f32x4 v) { h16x4 o; o[0] = (h16)v[0]; o[1] = (h16)v[1]; o[2] = (h16)v[2]; o[3] = (h16)v[3]; *(h16x4*)p = o; }
__device__ __forceinline__ void st8h(h16* p, f32x4 a, f32x4 b) { h16x8 o; o[0] = (h16)a[0]; o[1] = (h16)a[1]; o[2] = (h16)a[2]; o[3] = (h16)a[3]; o[4] = (h16)b[0]; o[5] = (h16)b[1]; o[6] = (h16)b[2]; o[7] = (h16)b[3]; *(h16x8*)p = o; }
__device__ __forceinline__ void ld8h(const h16* p, f32x4& a, f32x4& b) { const h16x8 o = *(const h16x8*)p; a = (f32x4){(float)o[0], (float)o[1], (float)o[2], (float)o[3]}; b = (f32x4){(float)o[4], (float)o[5], (float)o[6], (float)o[7]}; }
__device__ __forceinline__ f32x4 ld4h(const h16* p) { const h16x4 o = *(const h16x4*)p; return (f32x4){(float)o[0], (float)o[1], (float)o[2], (float)o[3]}; }
__device__ __forceinline__ float sumsq4(f32x4 v) { return (v[0] * v[0] + v[1] * v[1]) + (v[2] * v[2] + v[3] * v[3]); }
__device__ __forceinline__ float sigmoidf_(float x) { return __builtin_amdgcn_rcpf(1.0f + __expf(-x)); }
__device__ __forceinline__ float logsigmoidf_(float z) { return fminf(z, 0.f) - __logf(1.0f + __expf(-fabsf(z))); }
__device__ __forceinline__ float wave_sum(float v) {
#pragma unroll
    for (int o = 1; o < 64; o <<= 1) v += __shfl_xor(v, o);
    return v;
}

struct EpiInProj {
    static constexpr bool AFTER_DRAIN = false, TWO_SEG = false;
    static __device__ __forceinline__ bool perm(int pn) { return pn == 5 || pn >= 11; }
    unsigned char* ws; const float* b_f;
    __device__ __forceinline__ void operator()(const Acc& acc, const Unit& u, int wr, int wc, int fr, int fq) const {
        const int pn = u.pn, row0 = u.pm * 256 + wr * 64 + fr;
        const float* ROPE = (const float*)(ws + WS_ROPE);
        float nmax[2] = {0.f, 0.f};
#pragma unroll
        for (int ai = 0; ai < 2; ++ai)
#pragma unroll
            for (int m = 0; m < 4; ++m) {
                const int row = row0 + ai * 128 + m * 16, b = row >> 12, t = row & 4095;
                const float* rp = ROPE + (size_t)row * 48;
#pragma unroll
                for (int bj = 0; bj < 2; ++bj) {
                    f32x4 v0 = acc[ai][bj][m][0], v1 = acc[ai][bj][m][1];
                    const int d0 = 32 * wc + 4 * fq;
                    const int d8 = 32 * wc + 8 * fq;
                    if (pn < 6) {
                        size_t off;
                        if (pn < 4) off = WS_QA + (((size_t)(b * HA + pn * 2 + bj) * T + t) * HD) * 2;
                        else off = (pn == 4 ? WS_KA : WS_VA) + (((size_t)(b * HAKV + bj) * T + t) * HD) * 2;
                        h16* dst = (h16*)(ws + off);
                        if (pn < 5 && wc == 0) {
                            const f32x4 c = *(const f32x4*)(rp + 4 * fq), s = *(const f32x4*)(rp + 16 + 4 * fq);
                            const f32x4 y0 = v0 * c - v1 * s, y1 = v1 * c + v0 * s; v0 = y0; v1 = y1;
                        }
                        if (pn == 5) st8h(dst + d8, v0, v1); else { st4h(dst + d0, v0); st4h(dst + d0 + 16, v1); }
                    } else if (pn < 11) {
                        const bool is_q = pn < 10;
                        if (is_q || bj == 0) {
                            if (is_q || wc < 2) {
                                const int dd = 32 * (wc & 1) + 4 * fq;
                                const size_t off = is_q ? WS_QI + ((size_t)row * 1024 + ((pn - 6) * 4 + 2 * bj + (wc >> 1)) * 64) * 2 : WS_KI + ((size_t)row * 64) * 2;
                                h16* dst = (h16*)(ws + off);
                                if ((wc & 1) == 0) {
                                    f32x4 pr;
#pragma unroll
                                    for (int j = 0; j < 4; ++j) pr[j] = __shfl_xor(v0[j], 32);
                                    const f32x4 c = *(const f32x4*)(rp + 32 + 4 * (fq & 1)), s = *(const f32x4*)(rp + 40 + 4 * (fq & 1));
                                    v0 = (fq < 2) ? (v0 * c - pr * s) : (v0 * c + pr * s);
                                }
                                st4h(dst + dd, v0); st4h(dst + dd + 16, v1);
                            } else if (wc == 2) {
                                *(f32x4*)((float*)(ws + WS_WI) + (size_t)row * 16 + 4 * fq) = v0 * 0.03125f;
                                if (fq < 2) { const f32x4 bf = *(const f32x4*)(b_f + 4 * fq); f32x4 o;
#pragma unroll
                                    for (int j = 0; j < 4; ++j) o[j] = logsigmoidf_(v1[j] + bf[j]);
                                    float* lf = (float*)(ws + WS_LOGF) + ((size_t)(b * HB + 4 * fq)) * T + t;
#pragma unroll
                                    for (int j = 0; j < 4; ++j) lf[(size_t)j * T] = o[j]; }
                            }
                        }
                    } else if (pn < 23) {
                        const int q = pn - 11, which = q >> 2, head = (q & 3) * 2 + bj;
                        h16* dst = (h16*)(ws + WS_QB + (size_t)which * (WS_KB - WS_QB)) + ((size_t)(b * HB + head) * T + t) * HD;
                        st8h(dst + d8, v0, v1);
                        if (which < 2) { float ps = sumsq4(v0) + sumsq4(v1); ps += __shfl_xor(ps, 16); ps += __shfl_xor(ps, 32); nmax[bj] = fmaxf(nmax[bj], ps); }
                    } else {
                        const int q = pn - 23; const int col = (q & 7) * 256 + 128 * bj + d8;
                        h16* base = (h16*)(ws + WS_SIGA + (size_t)(q >> 3) * (WS_SIGB - WS_SIGA));
#pragma unroll
                        for (int j = 0; j < 4; ++j) { v0[j] = sigmoidf_(v0[j]); v1[j] = sigmoidf_(v1[j]); }
                        st8h(base + (size_t)row * DM + col, v0, v1);
                    }
                }
            }
        if (pn >= 11 && pn < 19) {
            const int q = pn - 11, which = q >> 2, bq = u.pm >> 4, qb = u.pm & 15; unsigned* nrm = (unsigned*)(ws + WS_NORM);
#pragma unroll
            for (int bj = 0; bj < 2; ++bj) { float mx = nmax[bj];
#pragma unroll
                for (int o = 1; o < 16; o <<= 1) mx = fmaxf(mx, __shfl_xor(mx, o));
                const int bh = bq * HB + (q & 3) * 2 + bj;
                if (fr == 0 && fq == 0) atomicMax(which == 0 ? nrm + (bh * 16 + qb) * 4 + wc : nrm + 1024 + bh * 4 + wc, __float_as_uint(mx)); }
        }
    }
};
static_assert(WS_VB - WS_KB == WS_KB - WS_QB, "QB/KB/VB equally spaced");
template <bool FIRST> struct EpiGate {
    static constexpr bool AFTER_DRAIN = false, TWO_SEG = false;
    static __device__ __forceinline__ bool perm(int) { return true; }
    const h16* SIG; h16* MIXED;
    __device__ __forceinline__ void operator()(const Acc& acc, const Unit& u, int wr, int wc, int fr, int fq) const {
        const int row0 = u.pm * 256 + wr * 64 + fr, col0 = u.pn * 256 + 32 * wc + 8 * fq;
#pragma unroll
        for (int ai = 0; ai < 2; ++ai)
#pragma unroll
            for (int m = 0; m < 4; ++m)
#pragma unroll
                for (int bj = 0; bj < 2; ++bj) { const size_t off = (size_t)(row0 + ai * 128 + m * 16) * DM + col0 + bj * 128;
                    f32x4 s0, s1; ld8h(SIG + off, s0, s1); f32x4 v0 = s0 * acc[ai][bj][m][0], v1 = s1 * acc[ai][bj][m][1];
                    if (!FIRST) { f32x4 m0, m1; ld8h(MIXED + off, m0, m1); v0 += m0; v1 += m1; }
                    st8h(MIXED + off, v0, v1); }
    }
};
struct EpiGate2 {
    static constexpr bool AFTER_DRAIN = false, TWO_SEG = true;
    static __device__ __forceinline__ bool perm(int) { return true; }
    const h16* SA; const h16* SB; h16* MIXED;
    __device__ __forceinline__ void mid(Acc& acc, const Unit& u, int wr, int wc, int fr, int fq) const {
        const int row0 = u.pm * 256 + wr * 64 + fr, col0 = u.pn * 256 + 32 * wc + 8 * fq;
#pragma unroll
        for (int ai = 0; ai < 2; ++ai)
#pragma unroll
            for (int m = 0; m < 4; ++m)
#pragma unroll
                for (int bj = 0; bj < 2; ++bj) { const size_t off = (size_t)(row0 + ai * 128 + m * 16) * DM + col0 + bj * 128;
                    f32x4 a0, a1, b0, b1; ld8h(SA + off, a0, a1); ld8h(SB + off, b0, b1);
#pragma unroll
                    for (int j = 0; j < 4; ++j) { acc[ai][bj][m][0][j] *= a0[j] * __builtin_amdgcn_rcpf(fmaxf(b0[j], 1e-30f)); acc[ai][bj][m][1][j] *= a1[j] * __builtin_amdgcn_rcpf(fmaxf(b1[j], 1e-30f)); } }
    }
    __device__ __forceinline__ void operator()(const Acc& acc, const Unit& u, int wr, int wc, int fr, int fq) const {
        const int row0 = u.pm * 256 + wr * 64 + fr, col0 = u.pn * 256 + 32 * wc + 8 * fq;
#pragma unroll
        for (int ai = 0; ai < 2; ++ai)
#pragma unroll
            for (int m = 0; m < 4; ++m)
#pragma unroll
                for (int bj = 0; bj < 2; ++bj) { const size_t off = (size_t)(row0 + ai * 128 + m * 16) * DM + col0 + bj * 128;
                    f32x4 b0, b1; ld8h(SB + off, b0, b1);
#pragma unroll
                    for (int j = 0; j < 4; ++j) { b0[j] = fmaxf(b0[j], 1e-30f); b1[j] = fmaxf(b1[j], 1e-30f); }
                    st8h(MIXED + off, b0 * acc[ai][bj][m][0], b1 * acc[ai][bj][m][1]); }
    }
};
template <bool BASE_F32> struct EpiResidNorm {
    static constexpr bool AFTER_DRAIN = false, TWO_SEG = false;
    static __device__ __forceinline__ bool perm(int) { return true; }
    const float* BASE; h16* XH; float* RS;
    __device__ __forceinline__ void operator()(const Acc& acc, const Unit& u, int wr, int wc, int fr, int fq) const {
        const int row0 = u.pm * 256 + wr * 64 + fr, col0 = u.pn * 256 + 32 * wc + 8 * fq;
#pragma unroll
        for (int ai = 0; ai < 2; ++ai)
#pragma unroll
            for (int m = 0; m < 4; ++m) { const int row = row0 + ai * 128 + m * 16; float ss = 0.f;
#pragma unroll
                for (int bj = 0; bj < 2; ++bj) { const size_t off = (size_t)row * DM + col0 + bj * 128;
                    f32x4 b0, b1; if (BASE_F32) { b0 = *(const f32x4*)(BASE + off); b1 = *(const f32x4*)(BASE + off + 4); } else ld8h(XH + off, b0, b1);
                    const f32x4 v0 = b0 + acc[ai][bj][m][0], v1 = b1 + acc[ai][bj][m][1]; st8h(XH + off, v0, v1); ss += sumsq4(v0) + sumsq4(v1); }
                ss += __shfl_xor(ss, 16); ss += __shfl_xor(ss, 32);
                if (fq == 0) atomicAdd(RS + row, ss); }
    }
};
struct EpiSwiGLU {
    static constexpr bool AFTER_DRAIN = false, TWO_SEG = false;
    static __device__ __forceinline__ bool perm(int) { return false; }
    h16* ACT; const float* RS;
    __device__ __forceinline__ void operator()(const Acc& acc, const Unit& u, int wr, int wc, int fr, int fq) const {
        const int row0 = u.pm * 256 + wr * 64 + fr;
#pragma unroll
        for (int ai = 0; ai < 2; ++ai)
#pragma unroll
            for (int m = 0; m < 4; ++m) { const int row = row0 + ai * 128 + m * 16; const float r = __builtin_amdgcn_rsqf(RS[row] * (1.0f / DM) + EPS);
#pragma unroll
                for (int bj = 0; bj < 2; ++bj) { const f32x4 g = acc[ai][bj][m][0] * r, uu = acc[ai][bj][m][1] * r; f32x4 o;
#pragma unroll
                    for (int j = 0; j < 4; ++j) o[j] = g[j] * sigmoidf_(g[j]) * uu[j];
                    st4h(ACT + (size_t)row * DFF + 16 * (u.pn * 8 + bj * 4 + wc) + 4 * fq, o); } }
    }
};
struct EpiStoreH {
    static constexpr bool AFTER_DRAIN = false, TWO_SEG = false;
    static __device__ __forceinline__ bool perm(int) { return true; }
    h16* O; int ldc;
    __device__ __forceinline__ void operator()(const Acc& acc, const Unit& u, int wr, int wc, int fr, int fq) const {
        const int row0 = u.pm * 256 + wr * 64 + fr, col0 = u.pn * 256 + 32 * wc + 8 * fq;
#pragma unroll
        for (int ai = 0; ai < 2; ++ai)
#pragma unroll
            for (int m = 0; m < 4; ++m)
#pragma unroll
                for (int bj = 0; bj < 2; ++bj) st8h(O + (size_t)(row0 + ai * 128 + m * 16) * ldc + col0 + bj * 128, acc[ai][bj][m][0], acc[ai][bj][m][1]);
    }
};
struct EpiPLE {
    static constexpr bool AFTER_DRAIN = false, TWO_SEG = false;
    static __device__ __forceinline__ bool perm(int) { return true; }
    const h16* PP; const h16* XI; h16* XO; const float* RSIN; float* RSOUT;
    __device__ __forceinline__ void operator()(const Acc& acc, const Unit& u, int wr, int wc, int fr, int fq) const {
        const int row0 = u.pm * 256 + wr * 64 + fr, col0 = u.pn * 256 + 32 * wc + 8 * fq;
#pragma unroll
        for (int ai = 0; ai < 2; ++ai)
#pragma unroll
            for (int m = 0; m < 4; ++m) { const int row = row0 + ai * 128 + m * 16; const float r = __builtin_amdgcn_rsqf(RSIN[row] * (1.0f / DM) + EPS); float ss = 0.f;
#pragma unroll
                for (int bj = 0; bj < 2; ++bj) { const size_t off = (size_t)row * DM + col0 + bj * 128;
                    const f32x4 a0 = acc[ai][bj][m][0] * r, a1 = acc[ai][bj][m][1] * r; f32x4 p0, p1, x0, x1; ld8h(PP + off, p0, p1); ld8h(XI + off, x0, x1);
#pragma unroll
                    for (int j = 0; j < 4; ++j) { x0[j] += sigmoidf_(a0[j]) * p0[j]; x1[j] += sigmoidf_(a1[j]) * p1[j]; }
                    st8h(XO + off, x0, x1); ss += sumsq4(x0) + sumsq4(x1); }
                ss += __shfl_xor(ss, 16); ss += __shfl_xor(ss, 32);
                if (fq == 0) atomicAdd(RSOUT + row, ss); }
    }
};

struct EpiPLEFinal {
    static constexpr bool AFTER_DRAIN = true, TWO_SEG = false;
    static __device__ __forceinline__ bool perm(int) { return true; }
    const h16* PP; const h16* XI; float* OUT; const float* RSIN; float* RSOUT; const float* gfin; unsigned* cnt;
    __device__ __forceinline__ void operator()(const Acc&, const Unit&, int, int, int, int) const {}
    __device__ __forceinline__ void fused(Acc& acc, const Unit& u, int wr, int wc, int fr, int fq, int lane) const {
        const int row0 = u.pm * 256 + wr * 64 + fr, col0 = u.pn * 256 + 32 * wc + 8 * fq;
#pragma unroll
        for (int ai = 0; ai < 2; ++ai)
#pragma unroll
            for (int m = 0; m < 4; ++m) { const int row = row0 + ai * 128 + m * 16; const float r = __builtin_amdgcn_rsqf(RSIN[row] * (1.0f / DM) + EPS); float ss = 0.f;
#pragma unroll
                for (int bj = 0; bj < 2; ++bj) { const size_t off = (size_t)row * DM + col0 + bj * 128;
                    const f32x4 a0 = acc[ai][bj][m][0] * r, a1 = acc[ai][bj][m][1] * r; f32x4 p0, p1, x0, x1; ld8h(PP + off, p0, p1); ld8h(XI + off, x0, x1);
#pragma unroll
                    for (int j = 0; j < 4; ++j) { x0[j] += sigmoidf_(a0[j]) * p0[j]; x1[j] += sigmoidf_(a1[j]) * p1[j]; }
                    acc[ai][bj][m][0] = x0; acc[ai][bj][m][1] = x1; ss += sumsq4(x0) + sumsq4(x1); }
                ss += __shfl_xor(ss, 16); ss += __shfl_xor(ss, 32);
                if (fq == 0) atomicAdd(RSOUT + row, ss); }
        asm volatile("s_waitcnt vmcnt(0)" ::: "memory");
        unsigned* c = cnt + 64 * u.pm;
        if (lane == 0) __hip_atomic_fetch_add(c, 1u, __ATOMIC_RELAXED, __HIP_MEMORY_SCOPE_AGENT);
        { unsigned spins = 0;
          while ((unsigned)__builtin_amdgcn_readfirstlane((int)__hip_atomic_load(c, __ATOMIC_RELAXED, __HIP_MEMORY_SCOPE_AGENT)) < 64u) { __builtin_amdgcn_s_sleep(2); if (++spins > (1u << 22)) break; } }
#pragma unroll
        for (int ai = 0; ai < 2; ++ai)
#pragma unroll
            for (int m = 0; m < 4; ++m) { const int row = row0 + ai * 128 + m * 16;
                const float r = __builtin_amdgcn_rsqf(__hip_atomic_load(RSOUT + row, __ATOMIC_RELAXED, __HIP_MEMORY_SCOPE_AGENT) * (1.0f / DM) + EPS);
#pragma unroll
                for (int bj = 0; bj < 2; ++bj) { const size_t off = (size_t)row * DM + col0 + bj * 128;
                    const f32x4 g0 = *(const f32x4*)(gfin + col0 + bj * 128), g1 = *(const f32x4*)(gfin + col0 + bj * 128 + 4);
                    *(f32x4*)(OUT + off) = acc[ai][bj][m][0] * r * g0; *(f32x4*)(OUT + off + 4) = acc[ai][bj][m][1] * r * g1; } }
    }
};

__device__ __forceinline__ int map_in(int p) {
    if (p < 2560) return p;
    if (p < 2816) { const int c = p - 2560; if (c < 64) return 2560 + c; if (c < 80) return 2624 + (c - 64); if (c < 88) return 5712 + (c - 80); return -1; }
    const int q = p - 2816; if (q < 3072) return 2640 + q; return 5720 + (q - 3072);
}
template <int MODE>
__device__ __forceinline__ const float* tr_src(const float* W0, const float* W1, int Nsrc, int n) {
    if (MODE == 0) return n < Nsrc ? W0 + n : nullptr;
    if (MODE == 1) { const int c = map_in(n); return c >= 0 ? W0 + c : nullptr; }
    return (((n >> 4) & 1) ? W1 : W0) + 16 * (n >> 5) + (n & 15);
}
template <int MODE>
__device__ __forceinline__ void ph_transpose(const float* W0, const float* W1, const float* gk, int K, int Nsrc, h16* WT, int Nphys, LAS float* scr, int gw, int NGW, int lane) {
    const int nblk = Nphys / 32, nitems = (K / 64) * nblk;
    const int lr = lane >> 3, lc = (lane & 7) * 4;
    f32x4 cur[8], nxt[8];
    int item = gw;
    if (item < nitems) { const int kb = item / nblk, nb = item % nblk; const float* src = tr_src<MODE>(W0, W1, Nsrc, 32 * nb + lc);
#pragma unroll
        for (int i = 0; i < 8; ++i) cur[i] = src ? *(const f32x4*)(src + (size_t)(64 * kb + lr + 8 * i) * Nsrc) : (f32x4){0.f, 0.f, 0.f, 0.f}; }
    for (; item < nitems; item += NGW) {
        const int kb = item / nblk, nb = item % nblk, k0 = 64 * kb, n0 = 32 * nb;
        const int itn = item + NGW;
        if (itn < nitems) { const int kbn = itn / nblk, nbn = itn % nblk; const float* src = tr_src<MODE>(W0, W1, Nsrc, 32 * nbn + lc);
#pragma unroll
            for (int i = 0; i < 8; ++i) nxt[i] = src ? *(const f32x4*)(src + (size_t)(64 * kbn + lr + 8 * i) * Nsrc) : (f32x4){0.f, 0.f, 0.f, 0.f}; }
#pragma unroll
        for (int i = 0; i < 8; ++i) { LAS float* d = scr + (lr + 8 * i) * 33 + lc; const float gg = gk ? gk[k0 + lr + 8 * i] : 1.0f; d[0] = cur[i][0] * gg; d[1] = cur[i][1] * gg; d[2] = cur[i][2] * gg; d[3] = cur[i][3] * gg; }
        __builtin_amdgcn_wave_barrier(); asm volatile("s_waitcnt lgkmcnt(0)" ::: "memory");
        const int c = lane & 7;
#pragma unroll
        for (int j = 0; j < 4; ++j) { const int nn = (lane >> 3) + 8 * j; const LAS float* sp = scr + (8 * c) * 33 + nn;
            h16x8 o;
#pragma unroll
            for (int e = 0; e < 8; ++e) o[e] = (h16)sp[e * 33];
            *(h16x8*)(WT + (size_t)(n0 + nn) * K + k0 + 8 * c) = o; }
        __builtin_amdgcn_wave_barrier(); asm volatile("s_waitcnt lgkmcnt(0)" ::: "memory");
#pragma unroll
        for (int i = 0; i < 8; ++i) cur[i] = nxt[i];
    }
}
__device__ __forceinline__ void sincos_f32arg(float ang, float& sn, float& cs) {
    const double a = (double)ang;
    const double rev = a * 0.15915494309189535;
    const double fr = rev - __builtin_rint(rev);
    const double q4 = fr * 4.0; const double qi = __builtin_rint(q4); const int qq = ((int)qi) & 3;
    const double r = (q4 - qi) * 1.5707963267948966;
    const double r2 = r * r;
    const double s = r * (1.0 + r2 * (-1.0 / 6 + r2 * (1.0 / 120 + r2 * (-1.0 / 5040 + r2 * (1.0 / 362880 + r2 * (-1.0 / 39916800))))));
    const double c = 1.0 + r2 * (-0.5 + r2 * (1.0 / 24 + r2 * (-1.0 / 720 + r2 * (1.0 / 40320 + r2 * (-1.0 / 3628800 + r2 * (1.0 / 479001600))))));
    double so, co;
    if (qq == 0) { so = s; co = c; } else if (qq == 1) { so = c; co = -s; } else if (qq == 2) { so = -s; co = -c; } else { so = -c; co = s; }
    sn = (float)so; cs = (float)co;
}
__device__ __forceinline__ void ph_rope(const int* pos, float* ROPE, int gtid, int NGT) {
    for (int idx = gtid; idx < MTOK * 24; idx += NGT) {
        const int tok = idx / 24, i = idx % 24, k = i < 16 ? i : 2 * (i - 16);
        float f = 0x1.000000p+0f;
        f = k == 1 ? 0x1.c2ef76p-2f : f; f = k == 2 ? 0x1.8d275ep-3f : f; f = k == 3 ? 0x1.5dc95ap-4f : f; f = k == 4 ? 0x1.341190p-5f : f; f = k == 5 ? 0x1.0f5384p-6f : f;
        f = k == 6 ? 0x1.ddee9cp-8f : f; f = k == 7 ? 0x1.a4ee3ep-9f : f; f = k == 8 ? 0x1.72ba44p-10f : f; f = k == 9 ? 0x1.468318p-11f : f; f = k == 10 ? 0x1.1f91f0p-12f : f;
        f = k == 11 ? 0x1.fa8b84p-14f : f; f = k == 12 ? 0x1.be218ap-15f : f; f = k == 13 ? 0x1.88ec22p-16f : f; f = k == 14 ? 0x1.5a0f50p-17f : f; f = k == 15 ? 0x1.30c94ep-18f : f;
        const float ang = (float)pos[tok] * f;
        float sn, cs; sincos_f32arg(ang, sn, cs);
        float* rp = ROPE + (size_t)tok * 48;
        if (i < 16) { rp[i] = cs; rp[16 + i] = sn; } else { rp[32 + (i - 16)] = cs; rp[40 + (i - 16)] = sn; }
    }
}
template <bool TO_F32>
__device__ __forceinline__ void ph_rmsnorm(const float* X, const float* g, h16* OUTH, float* OUTF, int gw, int NGW, int lane) {
    for (int row = gw; row < MTOK; row += NGW) {
        const f32x4* xr = (const f32x4*)(X + (size_t)row * DM) + lane;
        f32x4 v[8]; float s = 0.f;
#pragma unroll
        for (int j = 0; j < 8; ++j) { v[j] = xr[64 * j]; s += (v[j][0] * v[j][0] + v[j][1] * v[j][1]) + (v[j][2] * v[j][2] + v[j][3] * v[j][3]); }
        const float r = 1.0f / sqrtf(wave_sum(s) * (1.0f / DM) + EPS);
#pragma unroll
        for (int j = 0; j < 8; ++j) { const f32x4 gg = *((const f32x4*)g + lane + 64 * j); const f32x4 o = v[j] * r * gg;
            if (TO_F32) *((f32x4*)(OUTF + (size_t)row * DM) + lane + 64 * j) = o; else st4h(OUTH + (size_t)row * DM + 4 * (lane + 64 * j), o); }
    }
}
__device__ __forceinline__ void ph_final(const h16* X, float* OUT, const float* g, const float* RS, int gw, int NGW, int lane) {
    for (int row = gw; row < MTOK; row += NGW) {
        const float r = __builtin_amdgcn_rsqf(RS[row] * (1.0f / DM) + EPS);
        h16x8 v[4];
#pragma unroll
        for (int j = 0; j < 4; ++j) v[j] = *((const h16x8*)(X + (size_t)row * DM) + lane + 64 * j);
#pragma unroll
        for (int j = 0; j < 4; ++j) { const float* gp = g + 8 * (lane + 64 * j); float* op = OUT + (size_t)row * DM + 8 * (lane + 64 * j);
            const f32x4 g0 = *(const f32x4*)gp, g1 = *(const f32x4*)(gp + 4);
            f32x4 o0 = {(float)v[j][0], (float)v[j][1], (float)v[j][2], (float)v[j][3]}, o1 = {(float)v[j][4], (float)v[j][5], (float)v[j][6], (float)v[j][7]};
            *(f32x4*)op = o0 * r * g0; *(f32x4*)(op + 4) = o1 * r * g1; }
    }
}
__device__ __forceinline__ unsigned fkey(float f) { const unsigned u = __float_as_uint(f + 0.0f); return (u & 0x80000000u) ? ~u : (u | 0x80000000u); }
template <int LVL>
__device__ __forceinline__ void hist_level(const unsigned (&key)[64], int nj, int lane, LAS unsigned* hist, unsigned& prefix, unsigned& need, unsigned& cnt_eq) {
    constexpr int SH = LVL == 0 ? 21 : (LVL == 1 ? 10 : 0), PSH = LVL == 1 ? 21 : 10, NB = LVL == 2 ? 10 : 11;
#pragma unroll
    for (int i = 0; i < 8; ++i) *(LAS u32x4*)(hist + lane * 32 + 4 * i) = (u32x4){0u, 0u, 0u, 0u};
    asm volatile("s_waitcnt lgkmcnt(0)" ::: "memory"); __builtin_amdgcn_wave_barrier();
#pragma unroll
    for (int j8 = 0; j8 < 8; ++j8) {
        if (8 * j8 < nj) {
            if (LVL == 0) {
#pragma unroll
                for (int j = 8 * j8; j < 8 * j8 + 8; ++j) __hip_atomic_fetch_add(hist + (key[j] >> 21), 1u, __ATOMIC_RELAXED, __HIP_MEMORY_SCOPE_WORKGROUP);
            } else {
                bool any = false;
#pragma unroll
                for (int j = 8 * j8; j < 8 * j8 + 8; ++j) any = any || ((key[j] >> PSH) == prefix);
                if (LVL == 1 || __any(any)) {
#pragma unroll
                    for (int j = 8 * j8; j < 8 * j8 + 8; ++j) { const unsigned k = key[j];
                        if ((k >> PSH) == prefix) __hip_atomic_fetch_add(hist + ((k >> SH) & ((1u << NB) - 1u)), 1u, __ATOMIC_RELAXED, __HIP_MEMORY_SCOPE_WORKGROUP); }
                }
            }
        }
    }
    asm volatile("s_waitcnt lgkmcnt(0)" ::: "memory"); __builtin_amdgcn_wave_barrier();
    unsigned s = 0;
#pragma unroll
    for (int i = 0; i < 8; ++i) { const u32x4 v = *(const LAS u32x4*)(hist + lane * 32 + 4 * i); s += (v[0] + v[1]) + (v[2] + v[3]); }
    unsigned S = s;
#pragma unroll
    for (int o = 1; o < 64; o <<= 1) { const unsigned nb = __shfl_down(S, o); if (lane + o < 64) S += nb; }
    const int L = 63 - __builtin_clzll(__ballot(S >= need));
    const unsigned aboveL = __shfl(S - s, L);
    const int bi = lane & 31;
    const unsigned hb = hist[L * 32 + bi];
    unsigned R = hb;
#pragma unroll
    for (int o = 1; o < 32; o <<= 1) { const unsigned nb = __shfl_down(R, o); if (bi + o < 32) R += nb; }
    const int B = 31 - __builtin_clz((unsigned)__ballot(aboveL + R >= need));
    const unsigned abB = __shfl(aboveL + R - hb, B);
    cnt_eq = __shfl(hb, B);
    prefix = (prefix << NB) | (unsigned)(L * 32 + B);
    need -= abB;
    __builtin_amdgcn_wave_barrier();
}
__device__ __forceinline__ u64 topk_select_hist(const unsigned (&key)[64], int nvalid, int lane, LAS unsigned* hist) {
    const int nj = (nvalid + 63) >> 6;
    unsigned prefix = 0, need = TOPK, cnt_eq = 0;
    hist_level<0>(key, nj, lane, hist, prefix, need, cnt_eq);
    hist_level<1>(key, nj, lane, hist, prefix, need, cnt_eq);
    if (need != cnt_eq) hist_level<2>(key, nj, lane, hist, prefix, need, cnt_eq);
    else prefix <<= 10;
    u64 mw = 0;
    if (need == cnt_eq) {
#pragma unroll
        for (int j = 0; j < 64; ++j) { const u64 bal = __ballot(key[j] >= prefix); if (lane == j) mw = bal; }
    } else {
        int nd = (int)need;
#pragma unroll
        for (int j = 0; j < 64; ++j) { u64 eq = __ballot(key[j] == prefix); const u64 gt = __ballot(key[j] > prefix);
            int pc = __builtin_popcountll(eq);
            while (pc > nd) { eq &= ~(1ull << (63 - __builtin_clzll(eq))); --pc; }
            nd -= pc; if (lane == j) mw = gt | eq; }
    }
    return mw;
}
namespace idx {
typedef short s16x8 __attribute__((ext_vector_type(8)));
typedef float f32x16 __attribute__((ext_vector_type(16)));
constexpr int CHK = 128, CHB = CHK * 128;
__device__ __forceinline__ unsigned half_sum(unsigned v) {
#pragma unroll
    for (int o = 1; o < 32; o <<= 1) v += __shfl_xor(v, o);
    return v;
}
__device__ __forceinline__ void run_group(unsigned char* ws, char* lds, unsigned* scr, int b, int g, int wv) {
    int tid = wv * 64 + lane_id(); asm volatile("" : "+v"(tid));
    const int wid = __builtin_amdgcn_readfirstlane(tid >> 6), lane = tid & 63, c = lane & 31, hi = lane >> 5;
    const int t0 = 16 * g + 2 * wid, t = t0 + hi, row = b * T + t, tmaxblk = 16 * g + 15, nch = (tmaxblk >> 7) + 1;
    const h16* QI = (const h16*)(ws + WS_QI); const char* KIb = (const char*)ws + WS_KI + (size_t)b * T * 128; const float* WI = (const float*)(ws + WS_WI);
    s16x8 A[4];
    { const int rho = c, qsel = (rho >> 2) & 1, head = (rho & 3) + 4 * (rho >> 3);
      const h16* qp = QI + (size_t)(b * T + t0 + qsel) * 1024 + head * 64 + 8 * hi;
#pragma unroll
      for (int ks = 0; ks < 4; ++ks) A[ks] = *reinterpret_cast<const s16x8*>(qp + 16 * ks); }
    float w[16];
    { const f32x4* wp = (const f32x4*)(WI + (size_t)row * 16);
#pragma unroll
      for (int i = 0; i < 4; ++i) { const f32x4 v = wp[i]; w[4 * i] = v[0]; w[4 * i + 1] = v[1]; w[4 * i + 2] = v[2]; w[4 * i + 3] = v[3]; } }
    const int pr0 = tid >> 3, pp = tid & 7;
    const unsigned g_off = (unsigned)(pr0 * 128 + pp * 16);
    const int l_off0 = pr0 * 128 + ((pp ^ ((pr0 >> 1) & 7)) << 4), l_off1 = l_off0 + 64 * 128;
    const int rd_base = c * 128; const int sw = (c >> 1) & 7;
    int rd_off[4];
#pragma unroll
    for (int ks = 0; ks < 4; ++ks) rd_off[ks] = rd_base + (((2 * ks + hi) ^ sw) << 4);
    unsigned* myscr = scr + (size_t)(2 * wid + hi) * T + c;
    asm volatile("" :: "v"(A[0]), "v"(A[1]), "v"(A[2]), "v"(A[3]), "v"(w[0]), "v"(w[4]), "v"(w[8]), "v"(w[12]));
    s16x8 st0, st1;
    { const char* src = KIb; st0 = *reinterpret_cast<const s16x8*>(src + g_off); st1 = *reinterpret_cast<const s16x8*>(src + 64 * 128 + g_off); }
    *reinterpret_cast<s16x8*>(lds + l_off0) = st0; *reinterpret_cast<s16x8*>(lds + l_off1) = st1;
    __syncthreads();
#pragma unroll 1
    for (int ch = 0; ch < nch; ++ch) {
        const char* buf = lds + (ch & 1) * CHB;
        if (ch + 1 < nch) { const char* src = KIb + (size_t)(ch + 1) * CHB; st0 = *reinterpret_cast<const s16x8*>(src + g_off); st1 = *reinterpret_cast<const s16x8*>(src + 64 * 128 + g_off); }
#pragma unroll
        for (int st = 0; st < 4; ++st) {
            f32x16 acc = {};
#pragma unroll
            for (int ks = 0; ks < 4; ++ks) { const s16x8 Bf = *reinterpret_cast<const s16x8*>(buf + st * 4096 + rd_off[ks]);
                acc = __builtin_amdgcn_mfma_f32_32x32x16_f16(__builtin_bit_cast(h16x8, A[ks]), __builtin_bit_cast(h16x8, Bf), acc, 0, 0, 0); }
            float sc = 0.f;
#pragma unroll
            for (int r = 0; r < 16; ++r) { const int ri = __float_as_int(acc[r]); sc = fmaf(w[r], __int_as_float(ri > 0 ? ri : 0), sc); }
            const int sidx = ch * CHK + st * 32 + c;
            myscr[ch * CHK + st * 32] = (sidx <= t) ? fkey(sc) : 0u;
        }
        if (ch + 1 < nch) { char* dst = lds + ((ch + 1) & 1) * CHB; *reinterpret_cast<s16x8*>(dst + l_off0) = st0; *reinterpret_cast<s16x8*>(dst + l_off1) = st1; }
        __syncthreads();
    }
    asm volatile("s_waitcnt vmcnt(0)" ::: "memory");
    u64* MASK = (u64*)(ws + WS_MASK);
#pragma unroll 1
    for (int qq = 0; qq < 2; ++qq) {
        const int tq = t0 + qq, nj = (tq >> 6) + 1;
        const unsigned* src = scr + (size_t)(2 * wid + qq) * T + lane;
        unsigned key[64];
#pragma unroll
        for (int j = 0; j < 64; ++j) key[j] = (j < nj) ? __hip_atomic_load(src + 64 * j, __ATOMIC_RELAXED, __HIP_MEMORY_SCOPE_AGENT) : 0u;
        u64 mw;
        if (tq + 1 <= TOPK) {
            mw = 0;
#pragma unroll
            for (int j = 0; j < 4; ++j) { const u64 bal = __ballot(key[j] != 0u); if (lane == j) mw = bal; }
        } else mw = topk_select_hist(key, tq + 1, lane, (LAS unsigned*)(lds + 2 * CHB + wid * 8192));
        MASK[(size_t)(b * T + tq) * 64 + lane] = mw;
    }
}
}

namespace att {
constexpr int NW = 8, QBLK = 32, KVBLK = 64, QB = NW * QBLK, D = 128;
constexpr int SHM_V = KVBLK * D * 2, SHM_K = KVBLK * D * 2;
constexpr int LDS_NEED = 2 * SHM_V + 2 * SHM_K + NW * 64 * 4;
constexpr float THR = 8.f, SCALE = 0.08838834764831845f;
typedef short s16x8 __attribute__((ext_vector_type(8)));
typedef short s16x4 __attribute__((ext_vector_type(4)));
typedef float f32x16 __attribute__((ext_vector_type(16)));
#define KSWZ(row, colB) ((row) * 256 + ((colB) ^ (((row) & 7) << 4)))
#define SBAR() __builtin_amdgcn_sched_barrier(0)
__device__ __forceinline__ int v_st(int k, int c) { const int kk = (k & ~0xC) | ((k & 4) << 1) | ((k & 8) >> 1); return ((kk >> 3) * 4 + (c >> 5)) * 512 + ((kk & 7) * 32 + (c & 31)) * 2; }
__device__ __forceinline__ int v_rd_base(int lane) { return ((lane & 3) << 3) | (((lane >> 2) & 3) << 6) | (((lane >> 4) & 1) << 5) | (((lane >> 5) & 1) << 8); }
constexpr int v_rd_off(int d0, int ks, int half) { return d0 * 512 + ks * 4096 + half * 2048; }
__device__ __forceinline__ int crow(int r, int hi) { return (r & 3) + 8 * (r >> 2) + 4 * hi; }
__device__ __forceinline__ unsigned cvtpk(float lo, float hi) { unsigned r; asm volatile("v_cvt_pk_f16_f32 %0, %1, %2" : "=v"(r) : "v"(lo), "v"(hi)); return r; }
__device__ __forceinline__ f32x16 mfma16(s16x8 a, s16x8 b, f32x16 c) { return __builtin_amdgcn_mfma_f32_32x32x16_f16(__builtin_bit_cast(h16x8, a), __builtin_bit_cast(h16x8, b), c, 0, 0, 0); }
__device__ __forceinline__ s16x8 load8(const h16* p) { return *reinterpret_cast<const s16x8*>(p); }
__device__ __forceinline__ void mask_causal(f32x16& p0, f32x16& p1, int dq) {
    const float NEG = -__builtin_inff();
#pragma unroll
    for (int r = 0; r < 16; ++r) { const int c = (r & 3) + 8 * (r >> 2); if (dq - c < 0) p0[r] = NEG; if (dq - c - 32 < 0) p1[r] = NEG; }
}
__device__ __forceinline__ void partialSM(f32x16& p0, f32x16& p1, float& m_reg, float& mn, float& alpha) {
    float pmax = p0[0]; for (int r = 1; r < 16; ++r) pmax = fmaxf(pmax, p0[r]); for (int r = 0; r < 16; ++r) pmax = fmaxf(pmax, p1[r]);
    { auto rr = __builtin_amdgcn_permlane32_swap(__float_as_uint(pmax), __float_as_uint(pmax), false, false);
      pmax = fmaxf(__uint_as_float(rr[0]), __uint_as_float(rr[1])); }
    constexpr float C2 = 1.4426950408889634f * SCALE;
    if (__builtin_expect(__all((pmax - m_reg) * SCALE <= THR), 1)) { mn = m_reg; alpha = 1.f; }
    else { mn = fmaxf(m_reg, pmax); alpha = __builtin_amdgcn_exp2f((m_reg - mn) * C2); m_reg = mn; }
    const float mnL = -mn * C2;
    for (int r = 0; r < 16; ++r) p0[r] = fmaf(p0[r], C2, mnL); for (int r = 0; r < 16; ++r) p1[r] = fmaf(p1[r], C2, mnL);
    for (int r = 0; r < 16; ++r) p0[r] = __builtin_amdgcn_exp2f(p0[r]);
}
__device__ __forceinline__ void finishSM(f32x16& p0, f32x16& p1, float alpha, float& l_reg, s16x8& pa0, s16x8& pa1, s16x8& pa2, s16x8& pa3) {
    for (int r = 0; r < 16; ++r) p1[r] = __builtin_amdgcn_exp2f(p1[r]);
    float ps = 0; for (int r = 0; r < 16; ++r) ps += p0[r]; for (int r = 0; r < 16; ++r) ps += p1[r];
    { auto rr = __builtin_amdgcn_permlane32_swap(__float_as_uint(ps), __float_as_uint(ps), false, false);
      ps = __uint_as_float(rr[0]) + __uint_as_float(rr[1]); }
    l_reg = l_reg * alpha + ps;
#define PK4(P, B_, OUT) do { unsigned a0 = cvtpk(P[B_+0], P[B_+1]), a1 = cvtpk(P[B_+2], P[B_+3]);                          \
        unsigned b0 = cvtpk(P[B_+4], P[B_+5]), b1 = cvtpk(P[B_+6], P[B_+7]);                                             \
        auto r0 = __builtin_amdgcn_permlane32_swap(a0, b0, false, false); auto r1 = __builtin_amdgcn_permlane32_swap(a1, b1, false, false); \
        u32x4 w = {r0[0], r1[0], r0[1], r1[1]}; OUT = *reinterpret_cast<s16x8*>(&w); } while (0)
    PK4(p0, 0, pa0); PK4(p0, 8, pa1); PK4(p1, 0, pa2); PK4(p1, 8, pa3);
#undef PK4
}
template <int KB>
__device__ __forceinline__ void qkt(f32x16& p0, f32x16& p1, const char* K_lds, int r32, int hi, const s16x8* qr) {
    const char* kb[4];
#pragma unroll
    for (int dd = 0; dd < 4; ++dd) kb[dd] = K_lds + KB * SHM_K + KSWZ(r32, (dd * 16 + hi * 8) * 2);
#pragma unroll
    for (int d0 = 0; d0 < 8; ++d0) { const char* a = kb[d0 & 3] + (d0 >> 2) * 128;
        s16x8 b0 = *reinterpret_cast<const s16x8*>(a);
        s16x8 b1 = *reinterpret_cast<const s16x8*>(a + 32 * 256);
        p0 = mfma16(b0, qr[d0], p0);
        p1 = mfma16(b1, qr[d0], p1); }
}
template <int VB>
__device__ __forceinline__ void pv_tile(f32x16* o, int vb0, s16x8 pa0, s16x8 pa1, s16x8 pa2, s16x8 pa3) {
#define TRRD(dst, off) asm volatile("ds_read_b64_tr_b16 %0, %1 offset:%2" : "=&v"(dst) : "v"(vb0), "i"(off) : "memory")
#define PV_D0(d0) do { s16x4 l0, l1, l2, l3, h0, h1, h2, h3; constexpr int b_ = VB * SHM_V + v_rd_off(d0, 0, 0); \
        TRRD(l0, b_); TRRD(h0, b_ + 2048); TRRD(l1, b_ + 4096); TRRD(h1, b_ + 6144); TRRD(l2, b_ + 8192); TRRD(h2, b_ + 10240); TRRD(l3, b_ + 12288); TRRD(h3, b_ + 14336); \
        asm volatile("s_waitcnt lgkmcnt(0)" ::: "memory"); SBAR();   \
        o[d0] = mfma16(pa0, (s16x8){l0[0], l0[1], l0[2], l0[3], h0[0], h0[1], h0[2], h0[3]}, o[d0]);   \
        o[d0] = mfma16(pa1, (s16x8){l1[0], l1[1], l1[2], l1[3], h1[0], h1[1], h1[2], h1[3]}, o[d0]);   \
        o[d0] = mfma16(pa2, (s16x8){l2[0], l2[1], l2[2], l2[3], h2[0], h2[1], h2[2], h2[3]}, o[d0]);   \
        o[d0] = mfma16(pa3, (s16x8){l3[0], l3[1], l3[2], l3[3], h3[0], h3[1], h3[2], h3[3]}, o[d0]); } while (0)
    PV_D0(0); PV_D0(1); PV_D0(2); PV_D0(3);
#undef PV_D0
#undef TRRD
}
struct BlockRef { const char* Q; const char* K; const char* V; char* O; int P0; const char* NBQ; const char* MK;
                  int j0, nt;
                  int part;
                  char* PART; unsigned* flag; };
struct Seam { s16x8 qr[8]; };
#define LD16(base, off) (*reinterpret_cast<const s16x8*>((base) + (off)))
#define VMW() asm volatile("s_waitcnt vmcnt(0)" ::: "memory")
#define VMWN(n) asm volatile("s_waitcnt vmcnt(%0)" :: "i"(n) : "memory")
#define SLOAD_H(Kp, Vp, k0) do { const char* vb_ = (Vp) + (size_t)(k0) * (D * 2); const char* kb_ = (Kp) + (size_t)(k0) * (D * 2); \
        st_v0 = LD16(vb_, st_off); st_v1 = LD16(vb_ + 32 * D * 2, st_off); st_k0 = LD16(kb_, st_off); st_k1 = LD16(kb_ + 32 * D * 2, st_off); } while (0)
#define SWRITE_HK(bf) do { *(s16x8*)(K_lds + (bf) * SHM_K + kws) = st_k0; *(s16x8*)(K_lds + (bf) * SHM_K + kws + 32 * 256) = st_k1; } while (0)
#define SWRITE_HV(bf) do { *(s16x8*)(V_lds + (bf) * SHM_V + vst0) = st_v0; *(s16x8*)(V_lds + (bf) * SHM_V + vst1) = st_v1; } while (0)
#define SWRITE_H(bf) do { SWRITE_HV(bf); SWRITE_HK(bf); } while (0)
__device__ __forceinline__ void prime(const BlockRef& cur, char* lds, Seam& S, int wv) {
    int tid = wv * 64 + lane_id(); asm volatile("" : "+v"(tid));
    const int wid = __builtin_amdgcn_readfirstlane(tid >> 6), lane = tid & 63, r32 = lane & 31, hi = lane >> 5;
    const unsigned q_off = (unsigned)((wid * QBLK + r32) * D + hi * 8) * 2u;
#pragma unroll
    for (int d0 = 0; d0 < 8; ++d0) S.qr[d0] = LD16(cur.Q + d0 * 32, q_off);
}
template <bool MIXB, int ROLE>
__device__ __forceinline__ void block(const BlockRef& cur, const BlockRef& nxt, char* lds, Seam& S, int wv) {
    constexpr bool CONS = ROLE == 2;
    int tid = wv * 64 + lane_id(); asm volatile("" : "+v"(tid));
    const int wid = __builtin_amdgcn_readfirstlane(tid >> 6), lane = tid & 63, r32 = lane & 31, hi = lane >> 5;
    int NT = cur.nt, J0 = cur.j0;
    const int qlo = cur.P0 + wid * QBLK, qm = qlo + r32 - 4 * hi;
    char* V_lds = lds; char* K_lds = lds + 2 * SHM_V;
    float* wsf = (float*)(lds + 2 * SHM_V + 2 * SHM_K) + wid * 64; float* li_l = wsf, * al_l = wsf + 32;
    float m_reg = -1e30f, l_reg = 0; f32x16 o[4] = {};
    const int sr = tid >> 4, sc = (tid & 15) * 8, vst0 = v_st(sr, sc), vst1 = v_st(32 + sr, sc), kws = KSWZ(sr, sc * 2);
    const int vb0 = (int)(uintptr_t)V_lds + v_rd_base(lane);
    const unsigned st_off = (unsigned)(sr * D + sc) * 2u, q_off = (unsigned)((wid * QBLK + r32) * D + hi * 8) * 2u;
    const unsigned nb_off = (unsigned)hi * 16u, mk_off = (unsigned)(wid * QBLK + r32) * 512u;
    const char* Kh = cur.K; const char* Vh = cur.V;
    const char* bias_l = lds + LDS_NEED;
    if (MIXB) {
        float* cs = (float*)bias_l; float* wtot = (float*)(lds + LDS_NEED + 16384);
        const int L = cur.P0 + QB; const float* lf = (const float*)cur.NBQ;
        float v[8];
        if (8 * tid < L) { const f32x4 a = *(const f32x4*)(lf + 8 * tid), b4 = *(const f32x4*)(lf + 8 * tid + 4); v[0] = a[0]; v[1] = a[1]; v[2] = a[2]; v[3] = a[3]; v[4] = b4[0]; v[5] = b4[1]; v[6] = b4[2]; v[7] = b4[3]; }
        else {
#pragma unroll
            for (int i = 0; i < 8; ++i) v[i] = 0.f; }
#pragma unroll
        for (int i = 1; i < 8; ++i) v[i] += v[i - 1];
        float inc = v[7];
#pragma unroll
        for (int o_ = 1; o_ < 64; o_ <<= 1) { const float nb = __shfl_up(inc, o_); if (lane >= o_) inc += nb; }
        if (lane == 63) wtot[wid] = inc;
        __syncthreads();
        float base = inc - v[7];
#pragma unroll
        for (int w_ = 0; w_ < 7; ++w_) base += (w_ < wid) ? wtot[w_] : 0.f;
        if (8 * tid < L) {
#pragma unroll
            for (int i = 0; i < 8; ++i) cs[8 * tid + i] = (base + v[i]) * -11.313708498984761f; }
        __syncthreads();
        { const float qk2 = __int_as_float(cur.j0);
          const int s_ = 64 * lane + 63; const float dc = (s_ < cur.P0) ? (cs[s_] - cs[cur.P0]) * SCALE : 0.f;
          const bool keep = (s_ >= cur.P0) || (qk2 + dc >= -40.0f);
          J0 = __builtin_ctzll(__ballot(keep)); NT = cur.P0 / KVBLK + 4 - J0; }
        const float nbref = cs[L - 1];
        __syncthreads();
        for (int i = J0 * KVBLK + tid; i < L; i += NW * 64) cs[i] -= nbref;
        __syncthreads(); }
#define RESC(a) do { if (__any((a) < 1.f)) { if (hi == 0) al_l[r32] = (a); asm volatile("s_waitcnt lgkmcnt(0)" ::: "memory");              \
                     for (int d_ = 0; d_ < 4; ++d_) for (int r = 0; r < 16; ++r) o[d_][r] *= al_l[crow(r, hi)]; } } while (0)
#define KBASE(t) ((J0 + (t)) * KVBLK)
#define MKW(t) (*(const u64*)(cur.MK + (size_t)(J0 + (t)) * 8 + mk_off))
#define PINIT(P0_, P1_, t, MW_) do { if (MIXB) { const char* nb_ = bias_l + KBASE(t) * 4 + nb_off; _Pragma("unroll") for (int g_ = 0; g_ < 4; ++g_) { \
            const f32x4 b0_ = *(const f32x4*)(nb_ + 32 * g_), b1_ = *(const f32x4*)(nb_ + 128 + 32 * g_); \
            _Pragma("unroll") for (int j_ = 0; j_ < 4; ++j_) { P0_[4 * g_ + j_] = b0_[j_]; P1_[4 * g_ + j_] = b1_[j_]; } } } else { const u64 w_ = (MW_); const unsigned lo_ = (unsigned)w_ >> (4 * hi), up_ = (unsigned)(w_ >> 32) >> (4 * hi); \
            _Pragma("unroll") for (int r_ = 0; r_ < 16; ++r_) { const int c_ = (r_ & 3) + 8 * (r_ >> 2); \
                P0_[r_] = __uint_as_float((((lo_ >> c_) & 1u) - 1u) & 0xff800000u); P1_[r_] = __uint_as_float((((up_ >> c_) & 1u) - 1u) & 0xff800000u); } } } while (0)
#define MASKT(P0_, P1_, t, MW_) do { if (MIXB) { const int kb_ = KBASE(t); if (kb_ + KVBLK - 1 > qlo) mask_causal(P0_, P1_, qm - kb_); } } while (0)
    f32x16 pA0, pA1, pB0, pB1; float mnA, mnB, alA, alB; s16x8 pa0, pa1, pa2, pa3;
    u64 mwA = 0, mwB = 0;
    if (!MIXB) { mwA = MKW(0); if (NT > 1) mwB = MKW(1); }
    PINIT(pA0, pA1, 0, mwA); if (!MIXB) { if (NT > 2) mwA = MKW(2); }
    if (NT > 1) { PINIT(pB0, pB1, 1, mwB); if (!MIXB) { if (NT > 3) mwB = MKW(3); } }
    s16x8 st_v0, st_v1, st_k0, st_k1;
    SLOAD_H(Kh, Vh, KBASE(0)); VMW(); SWRITE_HK(0); SWRITE_HV(0); SBAR();
    __syncthreads();
    if (NT > 1) SLOAD_H(Kh, Vh, KBASE(1));
    SBAR(); qkt<0>(pA0, pA1, K_lds, r32, hi, S.qr);
    MASKT(pA0, pA1, 0, mwA);
    partialSM(pA0, pA1, m_reg, mnA, alA);
    if (NT > 1) { VMW(); SWRITE_H(1); }
    __syncthreads();
#define HALF_STEP(PX0, PX1, mnX, alX, MWX, PY0, PY1, alY, MWY, t, KB, VB, SB) do {                                               \
        SBAR(); qkt<KB>(PX0, PX1, K_lds, r32, hi, S.qr);                                                                      \
        finishSM(PY0, PY1, alY, l_reg, pa0, pa1, pa2, pa3); SBAR();                                                           \
        if ((t) + 1 < NT) { PINIT(PY0, PY1, (t) + 1, MWY); if (!MIXB) { if ((t) + 3 < NT) MWY = MKW((t) + 3); } SLOAD_H(Kh, Vh, KBASE((t) + 1)); SBAR(); }                             \
        pv_tile<VB>(o, vb0, pa0, pa1, pa2, pa3); MASKT(PX0, PX1, (t), MWX); \
        partialSM(PX0, PX1, m_reg, mnX, alX);                                                                                 \
        __syncthreads();                                                                                                      \
        if ((t) + 1 < NT) { VMW(); SWRITE_H(SB); }                                                                            \
        RESC(alX); __syncthreads(); } while (0)
    for (int t = 1; t + 1 < NT; t += 2) {
        HALF_STEP(pB0, pB1, mnB, alB, mwB, pA0, pA1, alA, mwA, t, 1, 0, 0);
        HALF_STEP(pA0, pA1, mnA, alA, mwA, pB0, pB1, alB, mwB, t + 1, 0, 1, 1);
    }
    const bool even = (NT & 1) == 0;
    if (even) { SBAR(); qkt<1>(pB0, pB1, K_lds, r32, hi, S.qr); SBAR(); }
    if (!CONS) {
#pragma unroll
        for (int d0 = 0; d0 < 8; ++d0) S.qr[d0] = LD16(nxt.Q + d0 * 32, q_off); }
    SBAR();
    finishSM(pA0, pA1, alA, l_reg, pa0, pa1, pa2, pa3); SBAR();
    pv_tile<0>(o, vb0, pa0, pa1, pa2, pa3);
    if (even) { MASKT(pB0, pB1, NT - 1, mwB); partialSM(pB0, pB1, m_reg, mnB, alB); __syncthreads(); RESC(alB);
        finishSM(pB0, pB1, alB, l_reg, pa0, pa1, pa2, pa3); SBAR(); pv_tile<1>(o, vb0, pa0, pa1, pa2, pa3); }
    constexpr float C2E = 1.4426950408889634f * SCALE;
    if (!CONS && cur.part == 1) {
        float* po = (float*)cur.PART + (size_t)wid * (64 * 64) + lane;
#pragma unroll
        for (int d0 = 0; d0 < 4; ++d0)
#pragma unroll
            for (int r = 0; r < 16; ++r) po[(d0 * 16 + r) * 64] = o[d0][r];
        float* pml = (float*)cur.PART + 8 * 64 * 64 + wid * 128;
        pml[lane] = m_reg; pml[64 + lane] = l_reg;
        asm volatile("s_waitcnt vmcnt(0)" ::: "memory");
        __syncthreads();
        if (tid == 0) { __builtin_amdgcn_fence(__ATOMIC_RELEASE, "agent"); asm volatile("s_waitcnt vmcnt(0)" ::: "memory"); __hip_atomic_store(cur.flag, 1u, __ATOMIC_RELAXED, __HIP_MEMORY_SCOPE_AGENT); }
    } else {
        float a_me = 1.f;
        if (CONS) {
            if (tid == 0) { unsigned spins = 0; while (__hip_atomic_load(cur.flag, __ATOMIC_RELAXED, __HIP_MEMORY_SCOPE_AGENT) == 0u) { __builtin_amdgcn_s_sleep(4); if (++spins > (1u << 22)) break; }
                __builtin_amdgcn_fence(__ATOMIC_ACQUIRE, "agent"); asm volatile("s_waitcnt vmcnt(0)" ::: "memory"); }
            __syncthreads();
            const float* pml = (const float*)cur.PART + 8 * 64 * 64 + wid * 128;
            const float m2 = pml[lane], l2 = pml[64 + lane];
            const float mm = fmaxf(m_reg, m2); a_me = __builtin_amdgcn_exp2f((m_reg - mm) * C2E); const float a_ot = __builtin_amdgcn_exp2f((m2 - mm) * C2E);
            l_reg = l_reg * a_me + l2 * a_ot;
            if (hi == 0) { li_l[r32] = a_me; al_l[r32] = a_ot; } asm volatile("s_waitcnt lgkmcnt(0)" ::: "memory");
            const float* po = (const float*)cur.PART + (size_t)wid * (64 * 64) + lane;
#pragma unroll
            for (int r = 0; r < 16; ++r) { const float fa = li_l[crow(r, hi)], fb = al_l[crow(r, hi)];
#pragma unroll
                for (int d0 = 0; d0 < 4; ++d0) o[d0][r] = o[d0][r] * fa + po[(d0 * 16 + r) * 64] * fb; }
            asm volatile("s_waitcnt lgkmcnt(0)" ::: "memory");
        }
        if (hi == 0) li_l[r32] = l_reg; asm volatile("s_waitcnt lgkmcnt(0)" ::: "memory");
        float rli[16];
#pragma unroll
        for (int r = 0; r < 16; ++r) rli[r] = __builtin_amdgcn_rcpf(li_l[crow(r, hi)]);
        const unsigned o_off = (unsigned)((wid * QBLK + 4 * hi) * 1024 + r32) * 2u;
#pragma unroll
        for (int r = 0; r < 16; ++r) {
#pragma unroll
            for (int d0 = 0; d0 < 4; ++d0) { const float v = o[d0][r] * rli[r];
                const float vn = __shfl_xor(v, 1);
                if ((r32 & 1) == 0) *(unsigned*)(cur.O + (size_t)(((r & 3) + 8 * (r >> 2)) * 2048 + d0 * 64) + o_off) = cvtpk(v, vn); } }
    }
    __syncthreads();
#undef RESC
#undef KBASE
#undef PINIT
#undef MKW
#undef MASKT
#undef HALF_STEP
}
#undef LD16
#undef VMW
#undef VMWN
#undef SLOAD_H
#undef SWRITE_HK
#undef SWRITE_HV
#undef SWRITE_H
constexpr int SCHED_MAXI = 3;
__device__ const short SCHED[256][3] = {
  {6752, 242, -1},
  {6768, 498, -1},
  {6784, 754, -1},
  {6800, 1010, -1},
  {6816, 1266, -1},
  {6832, 1522, -1},
  {6848, 1778, -1},
  {6864, 2034, -1},
  {6880, 2290, -1},
  {6896, 2546, -1},
  {6944, 2802, -1},
  {6960, 3058, -1},
  {6976, 3314, -1},
  {6992, 3570, -1},
  {7008, 3826, -1},
  {7024, 4082, -1},
  {5856, 226, -1},
  {5872, 482, -1},
  {5920, 738, -1},
  {5936, 994, -1},
  {5952, 1250, -1},
  {5968, 1506, -1},
  {5984, 1762, -1},
  {6000, 2018, -1},
  {6016, 2274, -1},
  {6032, 2530, -1},
  {6048, 2786, -1},
  {6064, 3042, -1},
  {6080, 3298, -1},
  {6096, 3554, -1},
  {6112, 3810, -1},
  {6128, 4066, -1},
  {2064, 5280, 210},
  {5296, 6160, 466},
  {2320, 5312, 722},
  {5328, 6416, 978},
  {2576, 5344, 1234},
  {5360, 6672, 1490},
  {2832, 5408, 1746},
  {5424, 6928, 2002},
  {3088, 5440, 2258},
  {5456, 7184, 2514},
  {3344, 5472, 2770},
  {5488, 7440, 3026},
  {3600, 5504, 3282},
  {5520, 7696, 3538},
  {3856, 5536, 3794},
  {5552, 7952, 4050},
  {4416, 7328, 194},
  {4432, 7344, 450},
  {4448, 7360, 706},
  {4464, 7376, 962},
  {4480, 7392, 1218},
  {4496, 7408, 1474},
  {4512, 7456, 1730},
  {4528, 7472, 1986},
  {4544, 7488, 2242},
  {4560, 7504, 2498},
  {4576, 7520, 2754},
  {4592, 7536, 3010},
  {4640, 7552, 3266},
  {4656, 7568, 3522},
  {4672, 7584, 3778},
  {4688, 7600, 4034},
  {32, 7616, 178},
  {288, 7632, 434},
  {544, 7648, 690},
  {800, 7664, 946},
  {1056, 7712, 1202},
  {1312, 7728, 1458},
  {1568, 7744, 1714},
  {1824, 7760, 1970},
  {2080, 7776, 2226},
  {2336, 7792, 2482},
  {2592, 7808, 2738},
  {2848, 7824, 2994},
  {3104, 7840, 3250},
  {3360, 7856, 3506},
  {3616, 7872, 3762},
  {3872, 7888, 4018},
  {2112, 162, -1},
  {2193, 418, -1},
  {2368, 674, -1},
  {2449, 930, -1},
  {2624, 1186, -1},
  {2705, 1442, -1},
  {2880, 1698, -1},
  {2961, 1954, -1},
  {3136, 2210, -1},
  {3217, 2466, -1},
  {3392, 2722, -1},
  {3473, 2978, -1},
  {3648, 3234, -1},
  {3729, 3490, -1},
  {3904, 3746, -1},
  {3985, 4002, -1},
  {64, 146, -1},
  {145, 402, -1},
  {320, 658, -1},
  {401, 914, -1},
  {576, 1170, -1},
  {657, 1426, -1},
  {832, 1682, -1},
  {913, 1938, -1},
  {1088, 2194, -1},
  {1169, 2450, -1},
  {1344, 2706, -1},
  {1425, 2962, -1},
  {1600, 3218, -1},
  {1681, 3474, -1},
  {1856, 3730, -1},
  {1937, 3986, -1},
  {161, 130, -1},
  {417, 386, -1},
  {673, 642, -1},
  {929, 898, -1},
  {1185, 1154, -1},
  {1441, 1410, -1},
  {1697, 1666, -1},
  {1953, 1922, -1},
  {2209, 2178, -1},
  {2465, 2434, -1},
  {2721, 2690, -1},
  {2977, 2946, -1},
  {3233, 3202, -1},
  {3489, 3458, -1},
  {3745, 3714, -1},
  {4001, 3970, -1},
  {112, 6176, -1},
  {241, 6192, -1},
  {368, 6208, -1},
  {497, 6224, -1},
  {624, 6240, -1},
  {753, 6256, -1},
  {880, 6272, -1},
  {1009, 6288, -1},
  {1136, 6304, -1},
  {1265, 6320, -1},
  {1392, 6336, -1},
  {1521, 6352, -1},
  {1648, 6368, -1},
  {1777, 6384, -1},
  {1904, 6432, -1},
  {2033, 6448, -1},
  {2160, 6464, -1},
  {2289, 6480, -1},
  {2416, 6496, -1},
  {2545, 6512, -1},
  {2672, 6528, -1},
  {2801, 6544, -1},
  {2928, 6560, -1},
  {3057, 6576, -1},
  {3184, 6592, -1},
  {3313, 6608, -1},
  {3440, 6624, -1},
  {3569, 6640, -1},
  {3696, 6688, -1},
  {3825, 6704, -1},
  {3952, 6720, -1},
  {4081, 6736, -1},
  {225, 0, 5568},
  {481, 5584, 4096},
  {737, 256, 5600},
  {993, 5616, 4352},
  {1249, 512, 5664},
  {1505, 5680, 4608},
  {1761, 768, 5696},
  {2017, 5712, 4864},
  {2273, 1024, 5728},
  {2529, 5744, 5120},
  {2785, 1280, 5760},
  {3041, 5776, 5376},
  {3297, 1536, 5792},
  {3553, 5808, 5632},
  {3809, 1792, 5824},
  {4065, 5840, 5888},
  {96, 4704, 7904},
  {209, 4720, 7920},
  {352, 4736, 7968},
  {465, 4752, 7984},
  {608, 4768, 8000},
  {721, 4784, 8016},
  {864, 4800, 8032},
  {977, 4816, 8048},
  {1120, 4832, 8064},
  {1233, 4848, 8080},
  {1376, 4896, 8096},
  {1489, 4912, 8112},
  {1632, 4928, 8128},
  {1745, 4944, 8144},
  {1888, 4960, 8160},
  {2001, 4976, 8176},
  {2144, 16, 4992},
  {2257, 5008, 4112},
  {2400, 272, 5024},
  {2513, 5040, 4368},
  {2656, 528, 5056},
  {2769, 5072, 4624},
  {2912, 784, 5088},
  {3025, 5104, 4880},
  {3168, 1040, 5152},
  {3281, 5168, 5136},
  {3424, 1296, 5184},
  {3537, 5200, 5392},
  {3680, 1552, 5216},
  {3793, 5232, 5648},
  {3936, 1808, 5248},
  {4049, 5264, 5904},
  {193, 4128, 7040},
  {449, 4144, 7056},
  {705, 4160, 7072},
  {961, 4176, 7088},
  {1217, 4192, 7104},
  {1473, 4208, 7120},
  {1729, 4224, 7136},
  {1985, 4240, 7152},
  {2241, 4256, 7200},
  {2497, 4272, 7216},
  {2753, 4288, 7232},
  {3009, 4304, 7248},
  {3265, 4320, 7264},
  {3521, 4336, 7280},
  {3777, 4384, 7296},
  {4033, 4400, 7312},
  {129, 80, -1},
  {177, 385, -1},
  {641, 336, -1},
  {433, 897, -1},
  {1153, 592, -1},
  {689, 1409, -1},
  {1665, 848, -1},
  {945, 1921, -1},
  {2177, 1104, -1},
  {1201, 2433, -1},
  {2689, 1360, -1},
  {1457, 2945, -1},
  {3201, 1616, -1},
  {1713, 3457, -1},
  {3713, 1872, -1},
  {1969, 3969, -1},
  {2128, 48, 2048},
  {2225, 304, 6144},
  {2384, 560, 2304},
  {2481, 816, 6400},
  {2640, 1072, 2560},
  {2737, 1328, 6656},
  {2896, 1584, 2816},
  {2993, 1840, 6912},
  {3152, 2096, 3072},
  {3249, 2352, 7168},
  {3408, 2608, 3328},
  {3505, 2864, 7424},
  {3664, 3120, 3584},
  {3761, 3376, 7680},
  {3920, 3632, 3840},
  {4017, 3888, 7936},
};

__device__ __forceinline__ BlockRef make_ref(int code, unsigned char* ws) {
    const bool mixb = (code >> 12) != 0; const int bh = (code >> 8) & 15, qb = (code >> 4) & 15, part = code & 15;
    const int b = bh >> 3, h = bh & 7, kvh = mixb ? bh : (b * HAKV + (h >> 2));
    BlockRef r;
    r.Q = (const char*)ws + (mixb ? WS_QB : WS_QA) + ((size_t)bh * T + (size_t)qb * QB) * D * 2;
    r.K = (const char*)ws + (mixb ? WS_KB : WS_KA) + (size_t)kvh * T * D * 2;
    r.V = (const char*)ws + (mixb ? WS_VB : WS_VA) + (size_t)kvh * T * D * 2;
    r.O = (char*)ws + (mixb ? WS_OUTB : WS_OUTA) + ((size_t)(b * T + qb * QB) * 1024 + h * D) * 2;
    r.P0 = qb * QB;
    r.NBQ = nullptr;
    r.MK = (const char*)ws + WS_MASK + (size_t)(b * T + qb * QB) * 64 * 8;
    const int NTall = r.P0 / KVBLK + 4;
    r.part = part; r.j0 = 0; r.nt = NTall;
    r.PART = (char*)ws + WS_PART + (size_t)(bh * 8 + (qb & 7)) * 135168; r.flag = (unsigned*)(ws + WS_CTL) + CW_SPLIT + (bh * 8 + (qb & 7));
    if (part == 1) r.nt = NTall / 2; else if (part == 2) { r.j0 = NTall / 2; r.nt = NTall - NTall / 2; }
    if (mixb) {
        const unsigned* nrm = (const unsigned*)(ws + WS_NORM);
        float q2 = 0.f, k2 = 0.f;
#pragma unroll
        for (int w_ = 0; w_ < 4; ++w_) { q2 += __uint_as_float(nrm[(bh * 16 + qb) * 4 + w_]); k2 += __uint_as_float(nrm[1024 + bh * 4 + w_]); }
        const float qk = 2.02f * __builtin_sqrtf(q2 * k2) * SCALE;
        r.j0 = __float_as_int(qk);
        r.NBQ = (const char*)ws + WS_LOGF + (size_t)bh * T * 4;
    }
    return r;
}
__device__ __forceinline__ void run_list(int cu, unsigned char* ws, char* lds, int wv) {
    Seam S;
    int code = SCHED[cu][0];
    if (code < 0) return;
    BlockRef cur = make_ref(code, ws);
    prime(cur, lds, S, wv);
#pragma unroll 1
    for (int k = 0; k < SCHED_MAXI; ++k) {
        if ((code & 15) == 2) break;
        const int ncode = (k + 1 < SCHED_MAXI) ? SCHED[cu][k + 1] : -1;
        const BlockRef nxt = ncode >= 0 ? make_ref(ncode, ws) : cur;
        if ((code >> 12) != 0) block<true, 0>(cur, nxt, lds, S, wv); else block<false, 0>(cur, nxt, lds, S, wv);
        if (ncode < 0) return;
        cur = nxt; code = ncode;
    }
    block<false, 2>(cur, cur, lds, S, wv);
}
}


#define XB_TMO      128
#define XB_XCNT(j)  (256  + 64 * (j))
#define XB_XSUB(j)  (1280 + 64 * (j))
#define XB_XGEN(j)  (2304 + 64 * (j))
#define XB_TOP      3328
#define XB_TOPGEN   3392
#define XCD_BAR_WORDS 3456
#define XB_SPIN_CAP (1u << 24)
__device__ __forceinline__ unsigned xb_ld(unsigned* p)              { return __hip_atomic_load(p, __ATOMIC_RELAXED, __HIP_MEMORY_SCOPE_AGENT); }
__device__ __forceinline__ unsigned xb_add(unsigned* p, unsigned v) { return __hip_atomic_fetch_add(p, v, __ATOMIC_RELAXED, __HIP_MEMORY_SCOPE_AGENT); }
__device__ __forceinline__ unsigned xb_xcc_id() { return (unsigned)__builtin_amdgcn_s_getreg((3 << 11) | 20) & 0xFu; }
#define XB_SPIN(cond, bar) do { unsigned _sp = 0; while (cond) { __builtin_amdgcn_s_sleep(1); \
    if ((++_sp & 255u) == 0u) { if (xb_ld(&(bar)[XB_TMO])) break; if (_sp > XB_SPIN_CAP) { atomicAdd(&(bar)[XB_TMO], 1u); break; } } } } while (0)
struct XcdBarrier { unsigned* bar; unsigned x; volatile LAS unsigned* st; };
__device__ __forceinline__ XcdBarrier xcd_barrier_post(unsigned* bar, volatile LAS unsigned* st, int wv) {
    XcdBarrier b; b.bar = bar; b.x = xb_xcc_id(); b.st = st;
    if (wv == 0 && lane_id() == 0) (void)xb_add(&bar[XB_XCNT(b.x)], 1u);
    return b;
}
__device__ __forceinline__ void xcd_barrier_complete(unsigned* bar, unsigned x, unsigned& nloc, unsigned& nx) {
    const unsigned G = gridDim.x * gridDim.y * gridDim.z;
    unsigned sum, cnt, mine, sp = 0u;
    for (;;) {
        sum = 0u; cnt = 0u; mine = 0u;
#pragma unroll
        for (unsigned j = 0; j < 16; ++j) { const unsigned c = xb_ld(&bar[XB_XCNT(j)]); sum += c; cnt += (c > 0u) ? 1u : 0u; mine = (j == x) ? c : mine; }
        if (sum == G) break;
        __builtin_amdgcn_s_sleep(1);
        if ((++sp & 255u) == 0u) { if (xb_ld(&bar[XB_TMO])) break; if (sp > XB_SPIN_CAP) { atomicAdd(&bar[XB_TMO], 1u); break; } }
    }
    nloc = mine > 0u ? mine : 1u; nx = cnt > 0u ? cnt : 1u;
}
__device__ __forceinline__ void xcd_barrier(const XcdBarrier& b, int wv) {
    asm volatile("s_waitcnt vmcnt(0)" ::: "memory");
    __syncthreads();
    if (wv == 0 && lane_id() == 0) {
        unsigned* bar = b.bar;
        __builtin_amdgcn_s_waitcnt(0);
        unsigned nloc = b.st[0], nx = b.st[1];
        if (nloc == 0u) { xcd_barrier_complete(bar, b.x, nloc, nx); b.st[0] = nloc; b.st[1] = nx; }
        const unsigned old = xb_add(&bar[XB_XSUB(b.x)], 1u);
        const unsigned gen = old / nloc;
        if (old + 1u == (gen + 1u) * nloc) {
            __builtin_amdgcn_fence(__ATOMIC_RELEASE, "agent");
            asm volatile("s_waitcnt vmcnt(0)" ::: "memory");
            const unsigned og = xb_add(&bar[XB_TOP], 1u);
            const unsigned tg = og / nx;
            if (og + 1u == (tg + 1u) * nx) xb_add(&bar[XB_TOPGEN], 1u);
            else XB_SPIN(xb_ld(&bar[XB_TOPGEN]) == tg, bar);
            __builtin_amdgcn_fence(__ATOMIC_ACQUIRE, "agent");
            xb_add(&bar[XB_XGEN(b.x)], 1u);
            asm volatile("s_waitcnt vmcnt(0)" ::: "memory");
        } else {
            XB_SPIN(xb_ld(&bar[XB_XGEN(b.x)]) == gen, bar);
            __builtin_amdgcn_fence(__ATOMIC_ACQUIRE, "agent");
            asm volatile("s_waitcnt vmcnt(0)" ::: "memory");
        }
    }
    __syncthreads();
}

namespace cg = cooperative_groups;
constexpr int LDS_BYTES = pg8::STAGE_BYTES + 256;
struct Params { const float* in[17]; float* out; unsigned char* ws; };
template <class Epi>
__device__ __forceinline__ void run_gemm(LAS unsigned char* lds, const h16* A, const h16* Bt, int M, int N, int K, const Epi& e, int wv) {
    pg8::Gemm g{A, Bt, M, N, K, nullptr, nullptr}; pg8::StaticOrder S; S.init(M, N, (int)gridDim.x, (int)blockIdx.x);
    pg8::gemm_phase<Epi>(lds, g, S, e, wv);
}
template <class Epi>
__device__ __forceinline__ void run_gemm2(LAS unsigned char* lds, const h16* A, const h16* Bt, const h16* A2, const h16* Bt2, int M, int N, int K, const Epi& e, int wv) {
    pg8::Gemm g{A, Bt, M, N, K, A2, Bt2}; pg8::StaticOrder S; S.init(M, N, (int)gridDim.x, (int)blockIdx.x, 2);
    pg8::gemm_phase<Epi>(lds, g, S, e, wv);
}
__global__ void __launch_bounds__(512, 2) mega_fwd(Params P) {
    extern __shared__ __attribute__((aligned(16))) unsigned char lds_raw[];
    LAS unsigned char* lds = (LAS unsigned char*)lds_raw;
    const int wv = __builtin_amdgcn_readfirstlane(threadIdx.x >> 6);
    volatile LAS unsigned* bst = (volatile LAS unsigned*)(lds + pg8::STAGE_BYTES);
    if (wv == 0 && lane_id() < 2) bst[lane_id()] = 0u;
    __syncthreads();
    const XcdBarrier xbar = xcd_barrier_post((unsigned*)(P.ws + WS_CTL) + CW_BAR, bst, wv);
#define GRID_BAR() xcd_barrier(xbar, wv)
#define IDS() int lane = lane_id(); asm volatile("" : "+v"(lane)); const int wave = wv, tid = wave * 64 + lane, gw = blockIdx.x * 8 + wave, NGW = gridDim.x * 8; (void)tid; (void)gw; (void)NGW
    const float* x = P.in[0]; const float* p = P.in[1]; const int* pos = (const int*)P.in[2];
    const float* g_mix = P.in[3]; const float* w_in = P.in[4]; const float* b_f = P.in[5];
    const float* w_o_a = P.in[6]; const float* w_o_b = P.in[7]; const float* w_out = P.in[8];
    const float* g_ffn = P.in[9]; const float* w_g = P.in[10]; const float* w_u = P.in[11]; const float* w_d = P.in[12];
    const float* g_ple = P.in[13]; const float* w_pg = P.in[14]; const float* w_pp = P.in[15]; const float* g_final = P.in[16];
    unsigned char* ws = P.ws; float* out = P.out;
    float* RS = (float*)(ws + WS_RS); float* ROPE = (float*)(ws + WS_ROPE); float* LOGF = (float*)(ws + WS_LOGF); u64* MASK = (u64*)(ws + WS_MASK);
    h16* WIN = (h16*)(ws + WS_WIN); h16* WOA = (h16*)(ws + WS_WOA); h16* WOB = (h16*)(ws + WS_WOB); h16* WOUT = (h16*)(ws + WS_WOUT);
    h16* WGU = (h16*)(ws + WS_WGU); h16* WDN = (h16*)(ws + WS_WDN); h16* WPG = (h16*)(ws + WS_WPG); h16* WPP = (h16*)(ws + WS_WPP);
    h16* QI = (h16*)(ws + WS_QI); h16* KI = (h16*)(ws + WS_KI); float* WI = (float*)(ws + WS_WI);
    h16* SIGA = (h16*)(ws + WS_SIGA); h16* SIGB = (h16*)(ws + WS_SIGB);
    h16* OUTA = (h16*)(ws + WS_OUTA); h16* OUTB = (h16*)(ws + WS_OUTB); h16* P16 = (h16*)(ws + WS_P16);
    h16* X3H = (h16*)(ws + WS_SIGA);
    h16* MIXED = (h16*)(ws + WS_MIXED); h16* H2 = (h16*)(ws + WS_H2); h16* ACT = (h16*)(ws + WS_ACT); h16* PP = (h16*)(ws + WS_PP);
    h16* H1 = (h16*)P.out;

    { IDS(); LAS float* scr = (LAS float*)(lds + wave * 8448);
      ph_transpose<1>(w_in, nullptr, nullptr, DM, N_IN, WIN, N_INP, scr, gw, NGW, lane);
      ph_transpose<2>(w_g, w_u, g_ffn, DM, DFF, WGU, 2 * DFF, scr, gw, NGW, lane);
      ph_rope(pos, ROPE, blockIdx.x * 512 + tid, gridDim.x * 512);
      for (int i = blockIdx.x * 512 + tid; i < 3 * MTOK; i += gridDim.x * 512) RS[i] = 0.f;
      for (int i = blockIdx.x * 512 + tid; i < 1088; i += gridDim.x * 512) ((unsigned*)(ws + WS_NORM))[i] = 0u;
      ph_rmsnorm<false>(x, g_mix, H1, nullptr, gw, NGW, lane);
    }
    GRID_BAR();
    { EpiInProj e{ws, b_f}; run_gemm(lds, H1, WIN, MTOK, N_INP, DM, e, wv); }
    { const int fi = ((MTOK / 256) * (N_INP / 256)) % (int)gridDim.x;
    if ((int)blockIdx.x >= fi) { IDS(); (void)tid; (void)gw; (void)NGW; LAS float* scr = (LAS float*)(lds + wave * 8448); const int qw = ((int)blockIdx.x - fi) * 8 + wave, nq = ((int)gridDim.x - fi) * 8;
      ph_transpose<0>(w_o_a, nullptr, nullptr, 1024, DM, WOA, DM, scr, qw, nq, lane);
      ph_transpose<0>(w_o_b, nullptr, nullptr, 1024, DM, WOB, DM, scr, qw, nq, lane);
      ph_transpose<0>(w_out, nullptr, nullptr, DM, DM, WOUT, DM, scr, qw, nq, lane); } }
    GRID_BAR();
    { IDS();
      for (int it = blockIdx.x; it < 256; it += gridDim.x) { const int bb = it & 1, gi = it >> 1;
#pragma unroll 1
          for (int pass = 0; pass < 2; ++pass) idx::run_group(ws, (char*)lds_raw, (unsigned*)out + (size_t)blockIdx.x * 16 * T, bb, pass ? 255 - gi : gi, wv); }
      for (int i = blockIdx.x * 512 + tid; i < MTOK * DPLE / 4; i += gridDim.x * 512) st4h(P16 + 4 * (size_t)i, *((const f32x4*)p + i));
    }
    GRID_BAR();
    for (int cu = blockIdx.x; cu < 256; cu += gridDim.x) att::run_list(cu, ws, (char*)lds_raw, wv);
    GRID_BAR();
    { EpiGate2 e{SIGA, SIGB, MIXED}; run_gemm2(lds, OUTA, WOA, OUTB, WOB, MTOK, DM, 1024, e, wv); }
    GRID_BAR();
    { EpiResidNorm<true> e{x, H2, RS}; run_gemm(lds, MIXED, WOUT, MTOK, DM, DM, e, wv); }
    GRID_BAR();
    { EpiSwiGLU e{ACT, RS}; run_gemm(lds, H2, WGU, MTOK, 2 * DFF, DM, e, wv); }
    { const int fi = ((MTOK / 256) * (2 * DFF / 256)) % (int)gridDim.x;
    if ((int)blockIdx.x >= fi) { IDS(); (void)tid; (void)gw; (void)NGW; LAS float* scr = (LAS float*)(lds + wave * 8448); const int qw = ((int)blockIdx.x - fi) * 8 + wave, nq = ((int)gridDim.x - fi) * 8;
      ph_transpose<0>(w_d, nullptr, nullptr, DFF, DM, WDN, DM, scr, qw, nq, lane);
      ph_transpose<0>(w_pg, nullptr, g_ple, DM, DM, WPG, DM, scr, qw, nq, lane);
      ph_transpose<0>(w_pp, nullptr, nullptr, DPLE, DM, WPP, DM, scr, qw, nq, lane); } }
    GRID_BAR();
    { EpiResidNorm<false> e{nullptr, H2, RS + MTOK}; run_gemm(lds, ACT, WDN, MTOK, DM, DFF, e, wv); }
    GRID_BAR();
    { EpiStoreH e{PP, DM}; run_gemm(lds, P16, WPP, MTOK, DM, DPLE, e, wv); }
    if (gridDim.x == (MTOK / 256) * (DM / 256)) {
        EpiPLEFinal e{PP, H2, out, RS + MTOK, RS + 2 * MTOK, g_final, (unsigned*)(ws + WS_CTL) + CW_PANEL}; run_gemm(lds, H2, WPG, MTOK, DM, DM, e, wv);
    } else {
        { EpiPLE e{PP, H2, X3H, RS + MTOK, RS + 2 * MTOK}; run_gemm(lds, H2, WPG, MTOK, DM, DM, e, wv); }
        GRID_BAR();
        { IDS(); ph_final(X3H, out, g_final, RS + 2 * MTOK, gw, NGW, lane); }
    }
#undef IDS
#undef GRID_BAR
}

extern "C" void kernel_launch(void* const* d_in, const int* in_sizes, int n_in, void* d_out, int out_size, void* d_ws, size_t ws_size, hipStream_t stream) {
    if (n_in != 17 || out_size != MTOK * DM || ws_size < WS_END) { fprintf(stderr, "kernel_launch: unexpected shapes / workspace (%d inputs, out %d, ws %zu)\n", n_in, out_size, ws_size); return; }
    static int grid_blocks = 0;
    if (!grid_blocks) {
        int dev = 0, cus = 0, per_cu = 0;
        (void)hipGetDevice(&dev);
        (void)hipDeviceGetAttribute(&cus, hipDeviceAttributeMultiprocessorCount, dev);
        (void)hipFuncSetAttribute((const void*)mega_fwd, hipFuncAttributeMaxDynamicSharedMemorySize, LDS_BYTES);
        (void)hipOccupancyMaxActiveBlocksPerMultiprocessor(&per_cu, (const void*)mega_fwd, 512, LDS_BYTES);
        if (per_cu < 1) { fprintf(stderr, "kernel_launch: occupancy query says %d blocks per CU\n", per_cu); per_cu = 1; }
        if (per_cu > 1) per_cu = 1;
        grid_blocks = cus * per_cu;
    }
    (void)hipMemsetAsync((char*)d_ws + WS_CTL, 0, 64 * 1024, stream);
    Params prm{};
    for (int i = 0; i < 17; ++i) prm.in[i] = (const float*)d_in[i];
    prm.out = (float*)d_out; prm.ws = (unsigned char*)d_ws;
    void* args[] = {&prm};
    hipError_t e = hipLaunchCooperativeKernel((const void*)mega_fwd, dim3(grid_blocks), dim3(512), args, LDS_BYTES, stream);
    if (e != hipSuccess) fprintf(stderr, "cooperative launch failed: %s (grid %d)\n", hipGetErrorString(e), grid_blocks);
}
```

```cpp
#include <hip/hip_runtime.h>
#include <hip/hip_cooperative_groups.h>
#include <stdint.h>
#include <cstdio>

#define LAS __attribute__((address_space(3)))
typedef _Float16 h16;
typedef _Float16 h16x8 __attribute__((ext_vector_type(8)));
typedef _Float16 h16x4 __attribute__((ext_vector_type(4)));
typedef _Float16 h16x2 __attribute__((ext_vector_type(2)));
typedef float f32x4 __attribute__((ext_vector_type(4)));
typedef float f32x2 __attribute__((ext_vector_type(2)));
typedef unsigned u32x4 __attribute__((ext_vector_type(4)));
typedef unsigned u32x2 __attribute__((ext_vector_type(2)));
typedef unsigned long long u64;
__device__ __forceinline__ int lane_id() { int r; asm volatile("v_mbcnt_lo_u32_b32 %0, -1, 0\n\tv_mbcnt_hi_u32_b32 %0, -1, %0" : "=v"(r)); return r; }

constexpr int NBATCH = 2, T = 4096, MTOK = NBATCH * T, DM = 2048;
constexpr int HA = 8, HAKV = 2, HIDX = 16, DIDX = 64, HB = 8, HD = 128;
constexpr int N_IN = 9816, N_INP = 9984, DFF = 5632, DPLE = 256, TOPK = 256;
constexpr float EPS = 1e-6f;
constexpr float ATT_SCALE = 0.08838834764831845f;

constexpr size_t MiB = 1u << 20;
constexpr size_t WS_CTL = 0;
constexpr size_t WS_RS = 512 * 1024;
constexpr size_t WS_NORM = 640 * 1024;
constexpr size_t WS_ROPE = 1 * MiB;
constexpr size_t WS_LOGF = 3 * MiB + 512 * 1024;
constexpr size_t WS_MASK = 4 * MiB;
constexpr size_t WS_WIN = 8 * MiB;
constexpr size_t WS_OUTA = 8 * MiB, WS_OUTB = 24 * MiB, WS_P16 = 40 * MiB;
constexpr size_t WS_WOA = 47 * MiB, WS_WOB = 51 * MiB, WS_WOUT = 55 * MiB, WS_WGU = 63 * MiB, WS_WDN = 107 * MiB, WS_WPG = 129 * MiB, WS_WPP = 137 * MiB;
constexpr size_t WS_QA = 138 * MiB, WS_KA = 154 * MiB, WS_VA = 158 * MiB, WS_QI = 162 * MiB, WS_KI = 178 * MiB, WS_WI = 179 * MiB;
constexpr size_t WS_QB = 180 * MiB, WS_KB = 196 * MiB, WS_VB = 212 * MiB, WS_SIGA = 228 * MiB, WS_SIGB = 260 * MiB, WS_PART = 292 * MiB, WS_END = 328 * MiB;
constexpr size_t WS_MIXED = WS_QB;
constexpr size_t WS_H2 = WS_QA;
constexpr size_t WS_ACT = WS_QB;
constexpr size_t WS_PP = WS_QB;
constexpr int CW_SPLIT = 12288;
constexpr int CW_PANEL = 8192;
constexpr int CW_BAR = 4096;

namespace pg8 {
constexpr int BM = 256, BK = 64, HALF = 128, HTB = HALF * BK * 2, STAGE_BYTES = 8 * HTB, NXCD = 8, WGM = 4;
__host__ __device__ __forceinline__ int lds_byte(int r, int c) { const int st = (r >> 4) * 2 + (c >> 5), rr = r & 15, cc = c & 31, ob = rr * 64 + cc * 2; return st * 1024 + (ob ^ (((ob >> 9) & 1) << 5)); }
__host__ __device__ __forceinline__ int perm32(int rho) { const int n = rho >> 4, i = rho & 15; return 8 * (i >> 2) + 4 * n + (i & 3); }
__host__ __device__ __forceinline__ void stage_rc(int b, int& R, int& C) { const int st = b / 1024, sb = b % 1024, swz = sb ^ (((sb >> 9) & 1) << 5); R = (st >> 1) * 16 + swz / 64; C = (st & 1) * 32 + (swz % 64) / 2; }
struct Unit { int pm, pn, seg; };
struct Gemm { const h16* A; const h16* Bt; int M, N, K; const h16* A2; const h16* Bt2; };
struct StaticOrder {
    int nM, nN, nwg, G, c, segs;
    __host__ __device__ void init(int M, int N, int G_, int c_, int segs_ = 1) { nM = M / BM; nN = N / BM; nwg = nM * nN; G = G_; c = c_; segs = segs_; }
    __host__ __device__ bool next(int i, Unit& u) const {
        u.seg = segs == 2 ? (i & 1) : 0; if (segs == 2) i >>= 1;
        const long L = (long)i * G + c; if (L >= nwg) return false;
        int wgid = (int)L; { const int q = nwg / NXCD, r = nwg % NXCD, xcd = wgid % NXCD, off = wgid / NXCD; wgid = (xcd < r ? xcd * (q + 1) : r * (q + 1) + (xcd - r) * q) + off; }
        const int nig = WGM * nN, gid = wgid / nig, fm = gid * WGM, gsz = (nM - fm) < WGM ? (nM - fm) : WGM;
        u.pm = fm + ((wgid % nig) % gsz); u.pn = (wgid % nig) / gsz; return true;
    }
};
template <class Epi>
__device__ __forceinline__ void gemm_phase(LAS unsigned char* lds, const Gemm g, const StaticOrder& S, const Epi& E, int wv) {
    int tid = wv * 64 + lane_id(); asm volatile("" : "+v"(tid));
    const int wid = __builtin_amdgcn_readfirstlane(tid >> 6), lane = tid & 63, wr = wid >> 2, wc = wid & 3, fr = lane & 15, fq = lane >> 4;
    const int K = g.K, nt = K / BK;
    unsigned voffA[2], voffBp[2];
#pragma unroll
    for (int i = 0; i < 2; ++i) { int R, C; stage_rc(tid * 16 + i * 8192, R, C); voffA[i] = (unsigned)(R * K + C) * 2u; voffBp[i] = (unsigned)(((R & ~31) + perm32(R & 31)) * K + C) * 2u; }
    const size_t kstep = (size_t)(BK * 2);
    const size_t hstep = (size_t)HALF * K * 2;
    const size_t tstep = 2 * hstep;
    const unsigned ldsw = (unsigned)wid * 1024u;
    const int aoff = lds_byte(wr * 64 + fr, fq * 8), boff = lds_byte(wc * 32 + fr, fq * 8);
#define PG8_SA(b, h) (((b) * 2 + (h)) * HTB)
#define PG8_SB(b, h) ((4 + (b) * 2 + (h)) * HTB)
#define PG8_STAGE(bufoff, gbase) do { _Pragma("unroll") for (int _i = 0; _i < 2; ++_i) \
        __builtin_amdgcn_global_load_lds((const unsigned*)((const char*)(gbase) + voffA[_i]), (LAS unsigned*)(lds + (bufoff) + ldsw + _i * 8192), 16, 0, 0); } while (0)
#define PG8_STAGEB(bufoff, gbase, pf) do { _Pragma("unroll") for (int _i = 0; _i < 2; ++_i) \
        __builtin_amdgcn_global_load_lds((const unsigned*)((const char*)(gbase) + ((pf) ? voffBp[_i] : voffA[_i])), (LAS unsigned*)(lds + (bufoff) + ldsw + _i * 8192), 16, 0, 0); } while (0)
#define PG8_LDA(dst, b, h) do { _Pragma("unroll") for (int m = 0; m < 4; ++m) _Pragma("unroll") for (int k = 0; k < 2; ++k) dst[m][k] = *(const LAS h16x8*)(lds + PG8_SA(b, h) + aoff + m * 2048 + k * 1024); } while (0)
#define PG8_LDB(dst, b, h) do { _Pragma("unroll") for (int n = 0; n < 2; ++n) _Pragma("unroll") for (int k = 0; k < 2; ++k) dst[n][k] = *(const LAS h16x8*)(lds + PG8_SB(b, h) + boff + n * 2048 + k * 1024); } while (0)
#define PG8_MMA(ai, bj, At, Bt) do { __builtin_amdgcn_s_setprio(1); _Pragma("unroll") for (int m = 0; m < 4; ++m) _Pragma("unroll") for (int n = 0; n < 2; ++n) _Pragma("unroll") for (int k = 0; k < 2; ++k) \
        acc[ai][bj][m][n] = __builtin_amdgcn_mfma_f32_16x16x32_f16(Bt[n][k], At[m][k], acc[ai][bj][m][n], 0, 0, 0); __builtin_amdgcn_s_setprio(0); } while (0)
#define PG8_WAIT_V(n) asm volatile("s_waitcnt vmcnt(" #n ")" ::: "memory")
#define PG8_WAIT_L(n) asm volatile("s_waitcnt lgkmcnt(" #n ")" ::: "memory")
#define PG8_BAR __builtin_amdgcn_s_barrier()
#define PG8_SCHED __builtin_amdgcn_sched_barrier(0)
    Unit cur, nxt; int ui = 0;
    if (!S.next(0, cur)) return;
    f32x4 acc[2][2][4][2];
#pragma unroll
    for (int a = 0; a < 2; ++a)
#pragma unroll
        for (int b = 0; b < 2; ++b)
#pragma unroll
            for (int m = 0; m < 4; ++m)
#pragma unroll
                for (int n = 0; n < 2; ++n) acc[a][b][m][n] = (f32x4){0.f, 0.f, 0.f, 0.f};
    h16x8 At[4][2], B0[2][2], B1[2][2];
    const char* cA = (const char*)g.A + (size_t)cur.pm * tstep; const char* cB = (const char*)g.Bt + (size_t)cur.pn * tstep;
    bool pfc = Epi::perm(cur.pn);
    PG8_STAGEB(PG8_SB(0, 0), cB, pfc); PG8_STAGE(PG8_SA(0, 0), cA); PG8_STAGEB(PG8_SB(0, 1), cB + hstep, pfc); PG8_STAGE(PG8_SA(0, 1), cA + hstep);
    if (wr == 1) PG8_BAR;
    PG8_WAIT_V(4); PG8_BAR;
    PG8_STAGEB(PG8_SB(1, 0), cB + kstep, pfc); PG8_STAGE(PG8_SA(1, 0), cA + kstep); PG8_STAGEB(PG8_SB(1, 1), cB + hstep + kstep, pfc);
    PG8_WAIT_V(6); PG8_BAR;
    for (;;) {
        const bool has_next = S.next(ui + 1, nxt);
        const char* nA = has_next ? (const char*)((Epi::TWO_SEG && nxt.seg) ? g.A2 : g.A) + (size_t)nxt.pm * tstep : cA; const char* nB = has_next ? (const char*)((Epi::TWO_SEG && nxt.seg) ? g.Bt2 : g.Bt) + (size_t)nxt.pn * tstep : cB;
        const bool pfn = has_next ? Epi::perm(nxt.pn) : pfc;
        for (int t = 0; t < nt; t += 2) {
            const bool last = (t == nt - 2);
            const char* a1 = cA + (size_t)(t + 1) * kstep;
            const char* a2 = last ? nA : cA + (size_t)(t + 2) * kstep; const char* b2 = last ? nB : cB + (size_t)(t + 2) * kstep;
            const char* a3 = a2 + kstep; const char* b3 = b2 + kstep;
            const bool pf2 = last ? pfn : pfc;
            PG8_LDB(B0, 0, 0); PG8_SCHED; PG8_LDA(At, 0, 0); PG8_STAGE(PG8_SA(1, 1), a1 + hstep);
            PG8_WAIT_L(8); PG8_BAR; PG8_WAIT_L(0); PG8_MMA(0, 0, At, B0); PG8_BAR; PG8_SCHED;
            PG8_LDB(B1, 0, 1); PG8_STAGEB(PG8_SB(0, 0), b2, pf2);
            PG8_BAR; PG8_WAIT_L(0); PG8_MMA(0, 1, At, B1); PG8_BAR;
            PG8_LDA(At, 0, 1); PG8_STAGE(PG8_SA(0, 0), a2);
            PG8_BAR; PG8_WAIT_L(0); PG8_MMA(1, 0, At, B0); PG8_BAR; PG8_SCHED;
            PG8_STAGEB(PG8_SB(0, 1), b2 + hstep, pf2);
            PG8_WAIT_V(6); PG8_BAR; PG8_MMA(1, 1, At, B1); PG8_BAR;
            PG8_LDB(B0, 1, 0); PG8_SCHED; PG8_LDA(At, 1, 0); PG8_STAGE(PG8_SA(0, 1), a2 + hstep);
            PG8_WAIT_L(8); PG8_BAR; PG8_WAIT_L(0); PG8_MMA(0, 0, At, B0); PG8_BAR; PG8_SCHED;
            PG8_LDB(B1, 1, 1); PG8_STAGEB(PG8_SB(1, 0), b3, pf2);
            PG8_BAR; PG8_WAIT_L(0); PG8_MMA(0, 1, At, B1); PG8_BAR;
            PG8_LDA(At, 1, 1); PG8_STAGE(PG8_SA(1, 0), a3);
            PG8_BAR; PG8_WAIT_L(0); PG8_MMA(1, 0, At, B0); PG8_BAR; PG8_SCHED;
            PG8_STAGEB(PG8_SB(1, 1), b3 + hstep, pf2);
            PG8_WAIT_V(6); PG8_BAR; PG8_MMA(1, 1, At, B1); PG8_BAR;
        }
        if constexpr (Epi::TWO_SEG) { if (cur.seg == 0) E.mid(acc, cur, wr, wc, fr, fq); else E(acc, cur, wr, wc, fr, fq); }
        else if constexpr (!Epi::AFTER_DRAIN) E(acc, cur, wr, wc, fr, fq);
        if (!has_next) break;
        if (!(Epi::TWO_SEG && nxt.seg))
#pragma unroll
        for (int a = 0; a < 2; ++a)
#pragma unroll
            for (int b = 0; b < 2; ++b)
#pragma unroll
                for (int m = 0; m < 4; ++m)
#pragma unroll
                    for (int n = 0; n < 2; ++n) acc[a][b][m][n] = (f32x4){0.f, 0.f, 0.f, 0.f};
        cur = nxt; cA = nA; cB = nB; pfc = pfn; ++ui;
    }
    PG8_WAIT_V(0);
    if (wr == 0) PG8_BAR;
    PG8_BAR;
    if constexpr (Epi::AFTER_DRAIN) E.fused(acc, cur, wr, wc, fr, fq, lane);
#undef PG8_SA
#undef PG8_SB
#undef PG8_STAGE
#undef PG8_STAGEB
#undef PG8_LDA
#undef PG8_LDB
#undef PG8_MMA
#undef PG8_WAIT_V
#undef PG8_WAIT_L
#undef PG8_BAR
#undef PG8_SCHED
}
}
using pg8::Unit;
typedef f32x4 Acc[2][2][4][2];

__device__ __forceinline__ void st4h(h16* p, f32x4 v) { h16x4 o; o[0] = (h16)v[0]; o[1] = (h16)v[1]; o[2] = (h16)v[2]; o[3] = (h16)v[3]; *(h16x4*)p = o; }
__device__ __forceinline__ void st8h(h16* p, f32x4 a, f32x4 b) { h16x8 o; o[0] = (h16)a[0]; o[1] = (h16)a[1]; o[2] = (h16)a[2]; o[3] = (h16)a[3]; o[4] = (h16)b[0]; o[5] = (h16)b[1]; o[6] = (h16)b[2]; o[7] = (h16)b[3]; *(h16x8*)p = o; }
__device__ __forceinline__ void ld8h(const h16* p, f32x4& a, f32x4& b) { const h16x8 o = *(const h16x8*)p; a = (f32x4){(float)o[0], (float)o[1], (float)o[2], (float)o[3]}; b = (f32x4){(float)o[4], (float)o[5], (float)o[6], (float)o[7]}; }
__device__ __forceinline__ f32x4 ld4h(const h16* p) { const h16x4 o = *(const h16x4*)p; return (f32x4){(float)o[0], (float)o[1], (float)o[2], (float)o[3]}; }
__device__ __forceinline__ float sumsq4(f32x4 v) { return (v[0] * v[0] + v[1] * v[1]) + (v[2] * v[2] + v[3] * v[3]); }
__device__ __forceinline__ float sigmoidf_(float x) { return __builtin_amdgcn_rcpf(1.0f + __expf(-x)); }
__device__ __forceinline__ float logsigmoidf_(float z) { return fminf(z, 0.f) - __logf(1.0f + __expf(-fabsf(z))); }
__device__ __forceinline__ float wave_sum(float v) {
#pragma unroll
    for (int o = 1; o < 64; o <<= 1) v += __shfl_xor(v, o);
    return v;
}

struct EpiInProj {
    static constexpr bool AFTER_DRAIN = false, TWO_SEG = false;
    static __device__ __forceinline__ bool perm(int pn) { return pn == 5 || pn >= 11; }
    unsigned char* ws; const float* b_f;
    __device__ __forceinline__ void operator()(const Acc& acc, const Unit& u, int wr, int wc, int fr, int fq) const {
        const int pn = u.pn, row0 = u.pm * 256 + wr * 64 + fr;
        const float* ROPE = (const float*)(ws + WS_ROPE);
        float nmax[2] = {0.f, 0.f};
#pragma unroll
        for (int ai = 0; ai < 2; ++ai)
#pragma unroll
            for (int m = 0; m < 4; ++m) {
                const int row = row0 + ai * 128 + m * 16, b = row >> 12, t = row & 4095;
                const float* rp = ROPE + (size_t)row * 48;
#pragma unroll
                for (int bj = 0; bj < 2; ++bj) {
                    f32x4 v0 = acc[ai][bj][m][0], v1 = acc[ai][bj][m][1];
                    const int d0 = 32 * wc + 4 * fq;
                    const int d8 = 32 * wc + 8 * fq;
                    if (pn < 6) {
                        size_t off;
                        if (pn < 4) off = WS_QA + (((size_t)(b * HA + pn * 2 + bj) * T + t) * HD) * 2;
                        else off = (pn == 4 ? WS_KA : WS_VA) + (((size_t)(b * HAKV + bj) * T + t) * HD) * 2;
                        h16* dst = (h16*)(ws + off);
                        if (pn < 5 && wc == 0) {
                            const f32x4 c = *(const f32x4*)(rp + 4 * fq), s = *(const f32x4*)(rp + 16 + 4 * fq);
                            const f32x4 y0 = v0 * c - v1 * s, y1 = v1 * c + v0 * s; v0 = y0; v1 = y1;
                        }
                        if (pn == 5) st8h(dst + d8, v0, v1); else { st4h(dst + d0, v0); st4h(dst + d0 + 16, v1); }
                    } else if (pn < 11) {
                        const bool is_q = pn < 10;
                        if (is_q || bj == 0) {
                            if (is_q || wc < 2) {
                                const int dd = 32 * (wc & 1) + 4 * fq;
                                const size_t off = is_q ? WS_QI + ((size_t)row * 1024 + ((pn - 6) * 4 + 2 * bj + (wc >> 1)) * 64) * 2 : WS_KI + ((size_t)row * 64) * 2;
                                h16* dst = (h16*)(ws + off);
                                if ((wc & 1) == 0) {
                                    f32x4 pr;
#pragma unroll
                                    for (int j = 0; j < 4; ++j) pr[j] = __shfl_xor(v0[j], 32);
                                    const f32x4 c = *(const f32x4*)(rp + 32 + 4 * (fq & 1)), s = *(const f32x4*)(rp + 40 + 4 * (fq & 1));
                                    v0 = (fq < 2) ? (v0 * c - pr * s) : (v0 * c + pr * s);
                                }
                                st4h(dst + dd, v0); st4h(dst + dd + 16, v1);
                            } else if (wc == 2) {
                                *(f32x4*)((float*)(ws + WS_WI) + (size_t)row * 16 + 4 * fq) = v0 * 0.03125f;
                                if (fq < 2) { const f32x4 bf = *(const f32x4*)(b_f + 4 * fq); f32x4 o;
#pragma unroll
                                    for (int j = 0; j < 4; ++j) o[j] = logsigmoidf_(v1[j] + bf[j]);
                                    float* lf = (float*)(ws + WS_LOGF) + ((size_t)(b * HB + 4 * fq)) * T + t;
#pragma unroll
                                    for (int j = 0; j < 4; ++j) lf[(size_t)j * T] = o[j]; }
                            }
                        }
                    } else if (pn < 23) {
                        const int q = pn - 11, which = q >> 2, head = (q & 3) * 2 + bj;
                        h16* dst = (h16*)(ws + WS_QB + (size_t)which * (WS_KB - WS_QB)) + ((size_t)(b * HB + head) * T + t) * HD;
                        st8h(dst + d8, v0, v1);
                        if (which < 2) { float ps = sumsq4(v0) + sumsq4(v1); ps += __shfl_xor(ps, 16); ps += __shfl_xor(ps, 32); nmax[bj] = fmaxf(nmax[bj], ps); }
                    } else {
                        const int q = pn - 23; const int col = (q & 7) * 256 + 128 * bj + d8;
                        h16* base = (h16*)(ws + WS_SIGA + (size_t)(q >> 3) * (WS_SIGB - WS_SIGA));
#pragma unroll
                        for (int j = 0; j < 4; ++j) { v0[j] = sigmoidf_(v0[j]); v1[j] = sigmoidf_(v1[j]); }
                        st8h(base + (size_t)row * DM + col, v0, v1);
                    }
                }
            }
        if (pn >= 11 && pn < 19) {
            const int q = pn - 11, which = q >> 2, bq = u.pm >> 4, qb = u.pm & 15; unsigned* nrm = (unsigned*)(ws + WS_NORM);
#pragma unroll
            for (int bj = 0; bj < 2; ++bj) { float mx = nmax[bj];
#pragma unroll
                for (int o = 1; o < 16; o <<= 1) mx = fmaxf(mx, __shfl_xor(mx, o));
                const int bh = bq * HB + (q & 3) * 2 + bj;
                if (fr == 0 && fq == 0) atomicMax(which == 0 ? nrm + (bh * 16 + qb) * 4 + wc : nrm + 1024 + bh * 4 + wc, __float_as_uint(mx)); }
        }
    }
};
static_assert(WS_VB - WS_KB == WS_KB - WS_QB, "QB/KB/VB equally spaced");
template <bool FIRST> struct EpiGate {
    static constexpr bool AFTER_DRAIN = false, TWO_SEG = false;
    static __device__ __forceinline__ bool perm(int) { return true; }
    const h16* SIG; h16* MIXED;
    __device__ __forceinline__ void operator()(const Acc& acc, const Unit& u, int wr, int wc, int fr, int fq) const {
        const int row0 = u.pm * 256 + wr * 64 + fr, col0 = u.pn * 256 + 32 * wc + 8 * fq;
#pragma unroll
        for (int ai = 0; ai < 2; ++ai)
#pragma unroll
            for (int m = 0; m < 4; ++m)
#pragma unroll
                for (int bj = 0; bj < 2; ++bj) { const size_t off = (size_t)(row0 + ai * 128 + m * 16) * DM + col0 + bj * 128;
                    f32x4 s0, s1; ld8h(SIG + off, s0, s1); f32x4 v0 = s0 * acc[ai][bj][m][0], v1 = s1 * acc[ai][bj][m][1];
                    if (!FIRST) { f32x4 m0, m1; ld8h(MIXED + off, m0, m1); v0 += m0; v1 += m1; }
                    st8h(MIXED + off, v0, v1); }
    }
};
struct EpiGate2 {
    static constexpr bool AFTER_DRAIN = false, TWO_SEG = true;
    static __device__ __forceinline__ bool perm(int) { return true; }
    const h16* SA; const h16* SB; h16* MIXED;
    __device__ __forceinline__ void mid(Acc& acc, const Unit& u, int wr, int wc, int fr, int fq) const {
        const int row0 = u.pm * 256 + wr * 64 + fr, col0 = u.pn * 256 + 32 * wc + 8 * fq;
#pragma unroll
        for (int ai = 0; ai < 2; ++ai)
#pragma unroll
            for (int m = 0; m < 4; ++m)
#pragma unroll
                for (int bj = 0; bj < 2; ++bj) { const size_t off = (size_t)(row0 + ai * 128 + m * 16) * DM + col0 + bj * 128;
                    f32x4 a0, a1, b0, b1; ld8h(SA + off, a0, a1); ld8h(SB + off, b0, b1);
#pragma unroll
                    for (int j = 0; j < 4; ++j) { acc[ai][bj][m][0][j] *= a0[j] * __builtin_amdgcn_rcpf(fmaxf(b0[j], 1e-30f)); acc[ai][bj][m][1][j] *= a1[j] * __builtin_amdgcn_rcpf(fmaxf(b1[j], 1e-30f)); } }
    }
    __device__ __forceinline__ void operator()(const Acc& acc, const Unit& u, int wr, int wc, int fr, int fq) const {
        const int row0 = u.pm * 256 + wr * 64 + fr, col0 = u.pn * 256 + 32 * wc + 8 * fq;
#pragma unroll
        for (int ai = 0; ai < 2; ++ai)
#pragma unroll
            for (int m = 0; m < 4; ++m)
#pragma unroll
                for (int bj = 0; bj < 2; ++bj) { const size_t off = (size_t)(row0 + ai * 128 + m * 16) * DM + col0 + bj * 128;
                    f32x4 b0, b1; ld8h(SB + off, b0, b1);
#pragma unroll
                    for (int j = 0; j < 4; ++j) { b0[j] = fmaxf(b0[j], 1e-30f); b1[j] = fmaxf(b1[j], 1e-30f); }
                    st8h(MIXED + off, b0 * acc[ai][bj][m][0], b1 * acc[ai][bj][m][1]); }
    }
};
template <bool BASE_F32> struct EpiResidNorm {
    static constexpr bool AFTER_DRAIN = false, TWO_SEG = false;
    static __device__ __forceinline__ bool perm(int) { return true; }
    const float* BASE; h16* XH; float* RS;
    __device__ __forceinline__ void operator()(const Acc& acc, const Unit& u, int wr, int wc, int fr, int fq) const {
        const int row0 = u.pm * 256 + wr * 64 + fr, col0 = u.pn * 256 + 32 * wc + 8 * fq;
#pragma unroll
        for (int ai = 0; ai < 2; ++ai)
#pragma unroll
            for (int m = 0; m < 4; ++m) { const int row = row0 + ai * 128 + m * 16; float ss = 0.f;
#pragma unroll
                for (int bj = 0; bj < 2; ++bj) { const size_t off = (size_t)row * DM + col0 + bj * 128;
                    f32x4 b0, b1; if (BASE_F32) { b0 = *(const f32x4*)(BASE + off); b1 = *(const f32x4*)(BASE + off + 4); } else ld8h(XH + off, b0, b1);
                    const f32x4 v0 = b0 + acc[ai][bj][m][0], v1 = b1 + acc[ai][bj][m][1]; st8h(XH + off, v0, v1); ss += sumsq4(v0) + sumsq4(v1); }
                ss += __shfl_xor(ss, 16); ss += __shfl_xor(ss, 32);
                if (fq == 0) atomicAdd(RS + row, ss); }
    }
};
struct EpiSwiGLU {
    static constexpr bool AFTER_DRAIN = false, TWO_SEG = false;
    static __device__ __forceinline__ bool perm(int) { return false; }
    h16* ACT; const float* RS;
    __device__ __forceinline__ void operator()(const Acc& acc, const Unit& u, int wr, int wc, int fr, int fq) const {
        const int row0 = u.pm * 256 + wr * 64 + fr;
#pragma unroll
        for (int ai = 0; ai < 2; ++ai)
#pragma unroll
            for (int m = 0; m < 4; ++m) { const int row = row0 + ai * 128 + m * 16; const float r = __builtin_amdgcn_rsqf(RS[row] * (1.0f / DM) + EPS);
#pragma unroll
                for (int bj = 0; bj < 2; ++bj) { const f32x4 g = acc[ai][bj][m][0] * r, uu = acc[ai][bj][m][1] * r; f32x4 o;
#pragma unroll
                    for (int j = 0; j < 4; ++j) o[j] = g[j] * sigmoidf_(g[j]) * uu[j];
                    st4h(ACT + (size_t)row * DFF + 16 * (u.pn * 8 + bj * 4 + wc) + 4 * fq, o); } }
    }
};
struct EpiStoreH {
    static constexpr bool AFTER_DRAIN = false, TWO_SEG = false;
    static __device__ __forceinline__ bool perm(int) { return true; }
    h16* O; int ldc;
    __device__ __forceinline__ void operator()(const Acc& acc, const Unit& u, int wr, int wc, int fr, int fq) const {
        const int row0 = u.pm * 256 + wr * 64 + fr, col0 = u.pn * 256 + 32 * wc + 8 * fq;
#pragma unroll
        for (int ai = 0; ai < 2; ++ai)
#pragma unroll
            for (int m = 0; m < 4; ++m)
#pragma unroll
                for (int bj = 0; bj < 2; ++bj) st8h(O + (size_t)(row0 + ai * 128 + m * 16) * ldc + col0 + bj * 128, acc[ai][bj][m][0], acc[ai][bj][m][1]);
    }
};
struct EpiPLE {
    static constexpr bool AFTER_DRAIN = false, TWO_SEG = false;
    static __device__ __forceinline__ bool perm(int) { return true; }
    const h16* PP; const h16* XI; h16* XO; const float* RSIN; float* RSOUT;
    __device__ __forceinline__ void operator()(const Acc& acc, const Unit& u, int wr, int wc, int fr, int fq) const {
        const int row0 = u.pm * 256 + wr * 64 + fr, col0 = u.pn * 256 + 32 * wc + 8 * fq;
#pragma unroll
        for (int ai = 0; ai < 2; ++ai)
#pragma unroll
            for (int m = 0; m < 4; ++m) { const int row = row0 + ai * 128 + m * 16; const float r = __builtin_amdgcn_rsqf(RSIN[row] * (1.0f / DM) + EPS); float ss = 0.f;
#pragma unroll
                for (int bj = 0; bj < 2; ++bj) { const size_t off = (size_t)row * DM + col0 + bj * 128;
                    const f32x4 a0 = acc[ai][bj][m][0] * r, a1 = acc[ai][bj][m][1] * r; f32x4 p0, p1, x0, x1; ld8h(PP + off, p0, p1); ld8h(XI + off, x0, x1);
#pragma unroll
                    for (int j = 0; j < 4; ++j) { x0[j] += sigmoidf_(a0[j]) * p0[j]; x1[j] += sigmoidf_(a1[j]) * p1[j]; }
                    st8h(XO + off, x0, x1); ss += sumsq4(x0) + sumsq4(x1); }
                ss += __shfl_xor(ss, 16); ss += __shfl_xor(ss, 32);
                if (fq == 0) atomicAdd(RSOUT + row, ss); }
    }
};

struct EpiPLEFinal {
    static constexpr bool AFTER_DRAIN = true, TWO_SEG = false;
    static __device__ __forceinline__ bool perm(int) { return true; }
    const h16* PP; const h16* XI; float* OUT; const float* RSIN; float* RSOUT; const float* gfin; unsigned* cnt;
    __device__ __forceinline__ void operator()(const Acc&, const Unit&, int, int, int, int) const {}
    __device__ __forceinline__ void fused(Acc& acc, const Unit& u, int wr, int wc, int fr, int fq, int lane) const {
        const int row0 = u.pm * 256 + wr * 64 + fr, col0 = u.pn * 256 + 32 * wc + 8 * fq;
#pragma unroll
        for (int ai = 0; ai < 2; ++ai)
#pragma unroll
            for (int m = 0; m < 4; ++m) { const int row = row0 + ai * 128 + m * 16; const float r = __builtin_amdgcn_rsqf(RSIN[row] * (1.0f / DM) + EPS); float ss = 0.f;
#pragma unroll
                for (int bj = 0; bj < 2; ++bj) { const size_t off = (size_t)row * DM + col0 + bj * 128;
                    const f32x4 a0 = acc[ai][bj][m][0] * r, a1 = acc[ai][bj][m][1] * r; f32x4 p0, p1, x0, x1; ld8h(PP + off, p0, p1); ld8h(XI + off, x0, x1);
#pragma unroll
                    for (int j = 0; j < 4; ++j) { x0[j] += sigmoidf_(a0[j]) * p0[j]; x1[j] += sigmoidf_(a1[j]) * p1[j]; }
                    acc[ai][bj][m][0] = x0; acc[ai][bj][m][1] = x1; ss += sumsq4(x0) + sumsq4(x1); }
                ss += __shfl_xor(ss, 16); ss += __shfl_xor(ss, 32);
                if (fq == 0) atomicAdd(RSOUT + row, ss); }
        asm volatile("s_waitcnt vmcnt(0)" ::: "memory");
        unsigned* c = cnt + 64 * u.pm;
        if (lane == 0) __hip_atomic_fetch_add(c, 1u, __ATOMIC_RELAXED, __HIP_MEMORY_SCOPE_AGENT);
        { unsigned spins = 0;
          while ((unsigned)__builtin_amdgcn_readfirstlane((int)__hip_atomic_load(c, __ATOMIC_RELAXED, __HIP_MEMORY_SCOPE_AGENT)) < 64u) { __builtin_amdgcn_s_sleep(2); if (++spins > (1u << 22)) break; } }
#pragma unroll
        for (int ai = 0; ai < 2; ++ai)
#pragma unroll
            for (int m = 0; m < 4; ++m) { const int row = row0 + ai * 128 + m * 16;
                const float r = __builtin_amdgcn_rsqf(__hip_atomic_load(RSOUT + row, __ATOMIC_RELAXED, __HIP_MEMORY_SCOPE_AGENT) * (1.0f / DM) + EPS);
#pragma unroll
                for (int bj = 0; bj < 2; ++bj) { const size_t off = (size_t)row * DM + col0 + bj * 128;
                    const f32x4 g0 = *(const f32x4*)(gfin + col0 + bj * 128), g1 = *(const f32x4*)(gfin + col0 + bj * 128 + 4);
                    *(f32x4*)(OUT + off) = acc[ai][bj][m][0] * r * g0; *(f32x4*)(OUT + off + 4) = acc[ai][bj][m][1] * r * g1; } }
    }
};

__device__ __forceinline__ int map_in(int p) {
    if (p < 2560) return p;
    if (p < 2816) { const int c = p - 2560; if (c < 64) return 2560 + c; if (c < 80) return 2624 + (c - 64); if (c < 88) return 5712 + (c - 80); return -1; }
    const int q = p - 2816; if (q < 3072) return 2640 + q; return 5720 + (q - 3072);
}
template <int MODE>
__device__ __forceinline__ const float* tr_src(const float* W0, const float* W1, int Nsrc, int n) {
    if (MODE == 0) return n < Nsrc ? W0 + n : nullptr;
    if (MODE == 1) { const int c = map_in(n); return c >= 0 ? W0 + c : nullptr; }
    return (((n >> 4) & 1) ? W1 : W0) + 16 * (n >> 5) + (n & 15);
}
template <int MODE>
__device__ __forceinline__ void ph_transpose(const float* W0, const float* W1, const float* gk, int K, int Nsrc, h16* WT, int Nphys, LAS float* scr, int gw, int NGW, int lane) {
    const int nblk = Nphys / 32, nitems = (K / 64) * nblk;
    const int lr = lane >> 3, lc = (lane & 7) * 4;
    f32x4 cur[8], nxt[8];
    int item = gw;
    if (item < nitems) { const int kb = item / nblk, nb = item % nblk; const float* src = tr_src<MODE>(W0, W1, Nsrc, 32 * nb + lc);
#pragma unroll
        for (int i = 0; i < 8; ++i) cur[i] = src ? __builtin_nontemporal_load((const f32x4*)(src + (size_t)(64 * kb + lr + 8 * i) * Nsrc)) : (f32x4){0.f, 0.f, 0.f, 0.f}; }
    for (; item < nitems; item += NGW) {
        const int kb = item / nblk, nb = item % nblk, k0 = 64 * kb, n0 = 32 * nb;
        const int itn = item + NGW;
        if (itn < nitems) { const int kbn = itn / nblk, nbn = itn % nblk; const float* src = tr_src<MODE>(W0, W1, Nsrc, 32 * nbn + lc);
#pragma unroll
            for (int i = 0; i < 8; ++i) nxt[i] = src ? __builtin_nontemporal_load((const f32x4*)(src + (size_t)(64 * kbn + lr + 8 * i) * Nsrc)) : (f32x4){0.f, 0.f, 0.f, 0.f}; }
#pragma unroll
        for (int i = 0; i < 8; ++i) { LAS float* d = scr + (lr + 8 * i) * 33 + lc; const float gg = gk ? gk[k0 + lr + 8 * i] : 1.0f; d[0] = cur[i][0] * gg; d[1] = cur[i][1] * gg; d[2] = cur[i][2] * gg; d[3] = cur[i][3] * gg; }
        __builtin_amdgcn_wave_barrier(); asm volatile("s_waitcnt lgkmcnt(0)" ::: "memory");
        const int c = lane & 7;
#pragma unroll
        for (int j = 0; j < 4; ++j) { const int nn = (lane >> 3) + 8 * j; const LAS float* sp = scr + (8 * c) * 33 + nn;
            h16x8 o;
#pragma unroll
            for (int e = 0; e < 8; ++e) o[e] = (h16)sp[e * 33];
            *(h16x8*)(WT + (size_t)(n0 + nn) * K + k0 + 8 * c) = o; }
        __builtin_amdgcn_wave_barrier(); asm volatile("s_waitcnt lgkmcnt(0)" ::: "memory");
#pragma unroll
        for (int i = 0; i < 8; ++i) cur[i] = nxt[i];
    }
}
__device__ __forceinline__ void sincos_f32arg(float ang, float& sn, float& cs) {
    const double a = (double)ang;
    const double rev = a * 0.15915494309189535;
    const double fr = rev - __builtin_rint(rev);
    const double q4 = fr * 4.0; const double qi = __builtin_rint(q4); const int qq = ((int)qi) & 3;
    const double r = (q4 - qi) * 1.5707963267948966;
    const double r2 = r * r;
    const double s = r * (1.0 + r2 * (-1.0 / 6 + r2 * (1.0 / 120 + r2 * (-1.0 / 5040 + r2 * (1.0 / 362880 + r2 * (-1.0 / 39916800))))));
    const double c = 1.0 + r2 * (-0.5 + r2 * (1.0 / 24 + r2 * (-1.0 / 720 + r2 * (1.0 / 40320 + r2 * (-1.0 / 3628800 + r2 * (1.0 / 479001600))))));
    double so, co;
    if (qq == 0) { so = s; co = c; } else if (qq == 1) { so = c; co = -s; } else if (qq == 2) { so = -s; co = -c; } else { so = -c; co = s; }
    sn = (float)so; cs = (float)co;
}
__device__ __forceinline__ void ph_rope(const int* pos, float* ROPE, int gtid, int NGT) {
    for (int idx = gtid; idx < MTOK * 24; idx += NGT) {
        const int tok = idx / 24, i = idx % 24, k = i < 16 ? i : 2 * (i - 16);
        float f = 0x1.000000p+0f;
        f = k == 1 ? 0x1.c2ef76p-2f : f; f = k == 2 ? 0x1.8d275ep-3f : f; f = k == 3 ? 0x1.5dc95ap-4f : f; f = k == 4 ? 0x1.341190p-5f : f; f = k == 5 ? 0x1.0f5384p-6f : f;
        f = k == 6 ? 0x1.ddee9cp-8f : f; f = k == 7 ? 0x1.a4ee3ep-9f : f; f = k == 8 ? 0x1.72ba44p-10f : f; f = k == 9 ? 0x1.468318p-11f : f; f = k == 10 ? 0x1.1f91f0p-12f : f;
        f = k == 11 ? 0x1.fa8b84p-14f : f; f = k == 12 ? 0x1.be218ap-15f : f; f = k == 13 ? 0x1.88ec22p-16f : f; f = k == 14 ? 0x1.5a0f50p-17f : f; f = k == 15 ? 0x1.30c94ep-18f : f;
        const float ang = (float)pos[tok] * f;
        float sn, cs; sincos_f32arg(ang, sn, cs);
        float* rp = ROPE + (size_t)tok * 48;
        if (i < 16) { rp[i] = cs; rp[16 + i] = sn; } else { rp[32 + (i - 16)] = cs; rp[40 + (i - 16)] = sn; }
    }
}
template <bool TO_F32>
__device__ __forceinline__ void ph_rmsnorm(const float* X, const float* g, h16* OUTH, float* OUTF, int gw, int NGW, int lane) {
    for (int row = gw; row < MTOK; row += NGW) {
        const f32x4* xr = (const f32x4*)(X + (size_t)row * DM) + lane;
        f32x4 v[8]; float s = 0.f;
#pragma unroll
        for (int j = 0; j < 8; ++j) { v[j] = __builtin_nontemporal_load(xr + 64 * j); s += (v[j][0] * v[j][0] + v[j][1] * v[j][1]) + (v[j][2] * v[j][2] + v[j][3] * v[j][3]); }
        const float r = 1.0f / sqrtf(wave_sum(s) * (1.0f / DM) + EPS);
#pragma unroll
        for (int j = 0; j < 8; ++j) { const f32x4 gg = *((const f32x4*)g + lane + 64 * j); const f32x4 o = v[j] * r * gg;
            if (TO_F32) *((f32x4*)(OUTF + (size_t)row * DM) + lane + 64 * j) = o; else st4h(OUTH + (size_t)row * DM + 4 * (lane + 64 * j), o); }
    }
}
__device__ __forceinline__ void ph_final(const h16* X, float* OUT, const float* g, const float* RS, int gw, int NGW, int lane) {
    for (int row = gw; row < MTOK; row += NGW) {
        const float r = __builtin_amdgcn_rsqf(RS[row] * (1.0f / DM) + EPS);
        h16x8 v[4];
#pragma unroll
        for (int j = 0; j < 4; ++j) v[j] = *((const h16x8*)(X + (size_t)row * DM) + lane + 64 * j);
#pragma unroll
        for (int j = 0; j < 4; ++j) { const float* gp = g + 8 * (lane + 64 * j); float* op = OUT + (size_t)row * DM + 8 * (lane + 64 * j);
            const f32x4 g0 = *(const f32x4*)gp, g1 = *(const f32x4*)(gp + 4);
            f32x4 o0 = {(float)v[j][0], (float)v[j][1], (float)v[j][2], (float)v[j][3]}, o1 = {(float)v[j][4], (float)v[j][5], (float)v[j][6], (float)v[j][7]};
            *(f32x4*)op = o0 * r * g0; *(f32x4*)(op + 4) = o1 * r * g1; }
    }
}
__device__ __forceinline__ unsigned fkey(float f) { const unsigned u = __float_as_uint(f + 0.0f); return (u & 0x80000000u) ? ~u : (u | 0x80000000u); }
template <int N> __device__ __forceinline__ unsigned dpp_row_shl(unsigned v) { return (unsigned)__builtin_amdgcn_update_dpp(0, (int)v, 0x100 + N, 0xf, 0xf, true); }
__device__ __forceinline__ unsigned row_suffix(unsigned v) { v += dpp_row_shl<1>(v); v += dpp_row_shl<2>(v); v += dpp_row_shl<4>(v); v += dpp_row_shl<8>(v); return v; }
template <int LVL>
__device__ __forceinline__ void hist_level(const unsigned (&key)[64], int nj, int lane, LAS unsigned* hist, unsigned& prefix, unsigned& need, unsigned& cnt_eq) {
    constexpr int SH = LVL == 0 ? 21 : (LVL == 1 ? 10 : 0), PSH = LVL == 1 ? 21 : 10, NB = LVL == 2 ? 10 : 11;
#pragma unroll
    for (int i = 0; i < 8; ++i) *(LAS u32x4*)(hist + lane * 32 + 4 * i) = (u32x4){0u, 0u, 0u, 0u};
    asm volatile("s_waitcnt lgkmcnt(0)" ::: "memory"); __builtin_amdgcn_wave_barrier();
#pragma unroll
    for (int j8 = 0; j8 < 8; ++j8) {
        if (8 * j8 < nj) {
            if (LVL == 0) {
#pragma unroll
                for (int j = 8 * j8; j < 8 * j8 + 8; ++j) __hip_atomic_fetch_add(hist + (key[j] >> 21), 1u, __ATOMIC_RELAXED, __HIP_MEMORY_SCOPE_WORKGROUP);
            } else {
                bool any = false;
#pragma unroll
                for (int j = 8 * j8; j < 8 * j8 + 8; ++j) any = any || ((key[j] >> PSH) == prefix);
                if (LVL == 1 || __any(any)) {
#pragma unroll
                    for (int j = 8 * j8; j < 8 * j8 + 8; ++j) { const unsigned k = key[j];
                        if ((k >> PSH) == prefix) __hip_atomic_fetch_add(hist + ((k >> SH) & ((1u << NB) - 1u)), 1u, __ATOMIC_RELAXED, __HIP_MEMORY_SCOPE_WORKGROUP); }
                }
            }
        }
    }
    asm volatile("s_waitcnt lgkmcnt(0)" ::: "memory"); __builtin_amdgcn_wave_barrier();
    unsigned s = 0;
#pragma unroll
    for (int i = 0; i < 8; ++i) { const u32x4 v = *(const LAS u32x4*)(hist + lane * 32 + 4 * i); s += (v[0] + v[1]) + (v[2] + v[3]); }
    unsigned S = row_suffix(s);
    { const unsigned t1 = (unsigned)__builtin_amdgcn_readlane((int)S, 16), t2 = (unsigned)__builtin_amdgcn_readlane((int)S, 32), t3 = (unsigned)__builtin_amdgcn_readlane((int)S, 48);
      const int row = lane >> 4; S += row == 0 ? t1 + t2 + t3 : (row == 1 ? t2 + t3 : (row == 2 ? t3 : 0u)); }
    const int L = 63 - __builtin_clzll(__ballot(S >= need));
    const unsigned aboveL = (unsigned)__builtin_amdgcn_readlane((int)(S - s), L);
    const int bi = lane & 31;
    const unsigned hb = hist[L * 32 + bi];
    unsigned R = row_suffix(hb);
    { const unsigned u1 = (unsigned)__builtin_amdgcn_readlane((int)R, 16); R += (lane & 16) ? 0u : u1; }
    const int B = 31 - __builtin_clz((unsigned)__ballot(aboveL + R >= need));
    const unsigned abB = (unsigned)__builtin_amdgcn_readlane((int)(aboveL + R - hb), B);
    cnt_eq = (unsigned)__builtin_amdgcn_readlane((int)hb, B);
    prefix = (prefix << NB) | (unsigned)(L * 32 + B);
    need -= abB;
    __builtin_amdgcn_wave_barrier();
}
__device__ __forceinline__ u64 topk_select_hist(const unsigned (&key)[64], int nvalid, int lane, LAS unsigned* hist) {
    const int nj = (nvalid + 63) >> 6;
    unsigned prefix = 0, need = TOPK, cnt_eq = 0;
    hist_level<0>(key, nj, lane, hist, prefix, need, cnt_eq);
    hist_level<1>(key, nj, lane, hist, prefix, need, cnt_eq);
    if (need != cnt_eq) hist_level<2>(key, nj, lane, hist, prefix, need, cnt_eq);
    else prefix <<= 10;
    u64 mw = 0;
    if (need == cnt_eq) {
#pragma unroll
        for (int j = 0; j < 64; ++j) { const u64 bal = __ballot(key[j] >= prefix); if (lane == j) mw = bal; }
    } else {
        int nd = (int)need;
#pragma unroll
        for (int j = 0; j < 64; ++j) { u64 eq = __ballot(key[j] == prefix); const u64 gt = __ballot(key[j] > prefix);
            int pc = __builtin_popcountll(eq);
            while (pc > nd) { eq &= ~(1ull << (63 - __builtin_clzll(eq))); --pc; }
            nd -= pc; if (lane == j) mw = gt | eq; }
    }
    return mw;
}
namespace idx {
typedef short s16x8 __attribute__((ext_vector_type(8)));
typedef float f32x16 __attribute__((ext_vector_type(16)));
constexpr int CHK = 128, CHB = CHK * 128;
__device__ __forceinline__ unsigned half_sum(unsigned v) {
#pragma unroll
    for (int o = 1; o < 32; o <<= 1) v += __shfl_xor(v, o);
    return v;
}
__device__ __forceinline__ void run_group(unsigned char* ws, char* lds, unsigned* scr, int b, int g, int wv) {
    int tid = wv * 64 + lane_id(); asm volatile("" : "+v"(tid));
    const int wid = __builtin_amdgcn_readfirstlane(tid >> 6), lane = tid & 63, c = lane & 31, hi = lane >> 5;
    const int t0 = 16 * g + 2 * wid, t = t0 + hi, row = b * T + t, tmaxblk = 16 * g + 15, nch = (tmaxblk >> 7) + 1;
    const h16* QI = (const h16*)(ws + WS_QI); const char* KIb = (const char*)ws + WS_KI + (size_t)b * T * 128; const float* WI = (const float*)(ws + WS_WI);
    s16x8 A[4];
    { const int rho = c, qsel = (rho >> 2) & 1, head = (rho & 3) + 4 * (rho >> 3);
      const h16* qp = QI + (size_t)(b * T + t0 + qsel) * 1024 + head * 64 + 8 * hi;
#pragma unroll
      for (int ks = 0; ks < 4; ++ks) A[ks] = *reinterpret_cast<const s16x8*>(qp + 16 * ks); }
    float w[16];
    { const f32x4* wp = (const f32x4*)(WI + (size_t)row * 16);
#pragma unroll
      for (int i = 0; i < 4; ++i) { const f32x4 v = wp[i]; w[4 * i] = v[0]; w[4 * i + 1] = v[1]; w[4 * i + 2] = v[2]; w[4 * i + 3] = v[3]; } }
    const int pr0 = tid >> 3, pp = tid & 7;
    const unsigned g_off = (unsigned)(pr0 * 128 + pp * 16);
    const int l_off0 = pr0 * 128 + ((pp ^ ((pr0 >> 1) & 7)) << 4), l_off1 = l_off0 + 64 * 128;
    const int rd_base = c * 128; const int sw = (c >> 1) & 7;
    int rd_off[4];
#pragma unroll
    for (int ks = 0; ks < 4; ++ks) rd_off[ks] = rd_base + (((2 * ks + hi) ^ sw) << 4);
    unsigned* myscr = scr + (size_t)(2 * wid + hi) * T + c;
    asm volatile("" :: "v"(A[0]), "v"(A[1]), "v"(A[2]), "v"(A[3]), "v"(w[0]), "v"(w[4]), "v"(w[8]), "v"(w[12]));
    s16x8 st0, st1;
    { const char* src = KIb; st0 = *reinterpret_cast<const s16x8*>(src + g_off); st1 = *reinterpret_cast<const s16x8*>(src + 64 * 128 + g_off); }
    *reinterpret_cast<s16x8*>(lds + l_off0) = st0; *reinterpret_cast<s16x8*>(lds + l_off1) = st1;
    __syncthreads();
#pragma unroll 1
    for (int ch = 0; ch < nch; ++ch) {
        const char* buf = lds + (ch & 1) * CHB;
        if (ch + 1 < nch) { const char* src = KIb + (size_t)(ch + 1) * CHB; st0 = *reinterpret_cast<const s16x8*>(src + g_off); st1 = *reinterpret_cast<const s16x8*>(src + 64 * 128 + g_off); }
#pragma unroll
        for (int st = 0; st < 4; ++st) {
            f32x16 acc = {};
#pragma unroll
            for (int ks = 0; ks < 4; ++ks) { const s16x8 Bf = *reinterpret_cast<const s16x8*>(buf + st * 4096 + rd_off[ks]);
                acc = __builtin_amdgcn_mfma_f32_32x32x16_f16(__builtin_bit_cast(h16x8, A[ks]), __builtin_bit_cast(h16x8, Bf), acc, 0, 0, 0); }
            float sc = 0.f;
#pragma unroll
            for (int r = 0; r < 16; ++r) { const int ri = __float_as_int(acc[r]); sc = fmaf(w[r], __int_as_float(ri > 0 ? ri : 0), sc); }
            const int sidx = ch * CHK + st * 32 + c;
            myscr[ch * CHK + st * 32] = (sidx <= t) ? fkey(sc) : 0u;
        }
        if (ch + 1 < nch) { char* dst = lds + ((ch + 1) & 1) * CHB; *reinterpret_cast<s16x8*>(dst + l_off0) = st0; *reinterpret_cast<s16x8*>(dst + l_off1) = st1; }
        __syncthreads();
    }
    asm volatile("s_waitcnt vmcnt(0)" ::: "memory");
    u64* MASK = (u64*)(ws + WS_MASK);
#pragma unroll 1
    for (int qq = 0; qq < 2; ++qq) {
        const int tq = t0 + qq, nj = (tq >> 6) + 1;
        const unsigned* src = scr + (size_t)(2 * wid + qq) * T + lane;
        unsigned key[64];
#pragma unroll
        for (int j = 0; j < 64; ++j) key[j] = (j < nj) ? __hip_atomic_load(src + 64 * j, __ATOMIC_RELAXED, __HIP_MEMORY_SCOPE_AGENT) : 0u;
        u64 mw;
        if (tq + 1 <= TOPK) {
            mw = 0;
#pragma unroll
            for (int j = 0; j < 4; ++j) { const u64 bal = __ballot(key[j] != 0u); if (lane == j) mw = bal; }
        } else mw = topk_select_hist(key, tq + 1, lane, (LAS unsigned*)(lds + 2 * CHB + wid * 8192));
        MASK[(size_t)(b * T + tq) * 64 + lane] = mw;
    }
}
}

namespace att {
constexpr int NW = 8, QBLK = 32, KVBLK = 64, QB = NW * QBLK, D = 128;
constexpr int SHM_V = KVBLK * D * 2, SHM_K = KVBLK * D * 2;
constexpr int LDS_NEED = 2 * SHM_V + 2 * SHM_K + NW * 64 * 4;
constexpr float THR = 8.f, SCALE = 0.08838834764831845f;
typedef short s16x8 __attribute__((ext_vector_type(8)));
typedef short s16x4 __attribute__((ext_vector_type(4)));
typedef float f32x16 __attribute__((ext_vector_type(16)));
#define KSWZ(row, colB) ((row) * 256 + ((colB) ^ (((row) & 7) << 4)))
#define SBAR() __builtin_amdgcn_sched_barrier(0)
__device__ __forceinline__ int v_st(int k, int c) { const int kk = (k & ~0xC) | ((k & 4) << 1) | ((k & 8) >> 1); return ((kk >> 3) * 4 + (c >> 5)) * 512 + ((kk & 7) * 32 + (c & 31)) * 2; }
__device__ __forceinline__ int v_rd_base(int lane) { return ((lane & 3) << 3) | (((lane >> 2) & 3) << 6) | (((lane >> 4) & 1) << 5) | (((lane >> 5) & 1) << 8); }
constexpr int v_rd_off(int d0, int ks, int half) { return d0 * 512 + ks * 4096 + half * 2048; }
__device__ __forceinline__ int crow(int r, int hi) { return (r & 3) + 8 * (r >> 2) + 4 * hi; }
__device__ __forceinline__ unsigned cvtpk(float lo, float hi) { unsigned r; asm volatile("v_cvt_pk_f16_f32 %0, %1, %2" : "=v"(r) : "v"(lo), "v"(hi)); return r; }
__device__ __forceinline__ f32x16 mfma16(s16x8 a, s16x8 b, f32x16 c) { return __builtin_amdgcn_mfma_f32_32x32x16_f16(__builtin_bit_cast(h16x8, a), __builtin_bit_cast(h16x8, b), c, 0, 0, 0); }
__device__ __forceinline__ s16x8 load8(const h16* p) { return *reinterpret_cast<const s16x8*>(p); }
__device__ __forceinline__ void mask_causal(f32x16& p0, f32x16& p1, int dq) {
    const float NEG = -__builtin_inff();
#pragma unroll
    for (int r = 0; r < 16; ++r) { const int c = (r & 3) + 8 * (r >> 2); if (dq - c < 0) p0[r] = NEG; if (dq - c - 32 < 0) p1[r] = NEG; }
}
__device__ __forceinline__ void partialSM(f32x16& p0, f32x16& p1, float& m_reg, float& mn, float& alpha) {
    float pmax = p0[0]; for (int r = 1; r < 16; ++r) pmax = fmaxf(pmax, p0[r]); for (int r = 0; r < 16; ++r) pmax = fmaxf(pmax, p1[r]);
    { auto rr = __builtin_amdgcn_permlane32_swap(__float_as_uint(pmax), __float_as_uint(pmax), false, false);
      pmax = fmaxf(__uint_as_float(rr[0]), __uint_as_float(rr[1])); }
    constexpr float C2 = 1.4426950408889634f * SCALE;
    if (__builtin_expect(__all((pmax - m_reg) * SCALE <= THR), 1)) { mn = m_reg; alpha = 1.f; }
    else { mn = fmaxf(m_reg, pmax); alpha = __builtin_amdgcn_exp2f((m_reg - mn) * C2); m_reg = mn; }
    const float mnL = -mn * C2;
    for (int r = 0; r < 16; ++r) p0[r] = fmaf(p0[r], C2, mnL); for (int r = 0; r < 16; ++r) p1[r] = fmaf(p1[r], C2, mnL);
    for (int r = 0; r < 16; ++r) p0[r] = __builtin_amdgcn_exp2f(p0[r]);
}
__device__ __forceinline__ void finishSM(f32x16& p0, f32x16& p1, float alpha, float& l_reg, s16x8& pa0, s16x8& pa1, s16x8& pa2, s16x8& pa3) {
    for (int r = 0; r < 16; ++r) p1[r] = __builtin_amdgcn_exp2f(p1[r]);
    float ps = 0; for (int r = 0; r < 16; ++r) ps += p0[r]; for (int r = 0; r < 16; ++r) ps += p1[r];
    { auto rr = __builtin_amdgcn_permlane32_swap(__float_as_uint(ps), __float_as_uint(ps), false, false);
      ps = __uint_as_float(rr[0]) + __uint_as_float(rr[1]); }
    l_reg = l_reg * alpha + ps;
#define PK4(P, B_, OUT) do { unsigned a0 = cvtpk(P[B_+0], P[B_+1]), a1 = cvtpk(P[B_+2], P[B_+3]);                          \
        unsigned b0 = cvtpk(P[B_+4], P[B_+5]), b1 = cvtpk(P[B_+6], P[B_+7]);                                             \
        auto r0 = __builtin_amdgcn_permlane32_swap(a0, b0, false, false); auto r1 = __builtin_amdgcn_permlane32_swap(a1, b1, false, false); \
        u32x4 w = {r0[0], r1[0], r0[1], r1[1]}; OUT = *reinterpret_cast<s16x8*>(&w); } while (0)
    PK4(p0, 0, pa0); PK4(p0, 8, pa1); PK4(p1, 0, pa2); PK4(p1, 8, pa3);
#undef PK4
}
template <int KB>
__device__ __forceinline__ void qkt(f32x16& p0, f32x16& p1, const char* K_lds, int r32, int hi, const s16x8* qr) {
    const char* kb[4];
#pragma unroll
    for (int dd = 0; dd < 4; ++dd) kb[dd] = K_lds + KB * SHM_K + KSWZ(r32, (dd * 16 + hi * 8) * 2);
#pragma unroll
    for (int d0 = 0; d0 < 8; ++d0) { const char* a = kb[d0 & 3] + (d0 >> 2) * 128;
        s16x8 b0 = *reinterpret_cast<const s16x8*>(a);
        s16x8 b1 = *reinterpret_cast<const s16x8*>(a + 32 * 256);
        p0 = mfma16(b0, qr[d0], p0);
        p1 = mfma16(b1, qr[d0], p1); }
}
template <int VB>
__device__ __forceinline__ void pv_tile(f32x16* o, int vb0, s16x8 pa0, s16x8 pa1, s16x8 pa2, s16x8 pa3) {
#define TRRD(dst, off) asm volatile("ds_read_b64_tr_b16 %0, %1 offset:%2" : "=&v"(dst) : "v"(vb0), "i"(off) : "memory")
#define PV_D0(d0) do { s16x4 l0, l1, l2, l3, h0, h1, h2, h3; constexpr int b_ = VB * SHM_V + v_rd_off(d0, 0, 0); \
        TRRD(l0, b_); TRRD(h0, b_ + 2048); TRRD(l1, b_ + 4096); TRRD(h1, b_ + 6144); TRRD(l2, b_ + 8192); TRRD(h2, b_ + 10240); TRRD(l3, b_ + 12288); TRRD(h3, b_ + 14336); \
        asm volatile("s_waitcnt lgkmcnt(0)" ::: "memory"); SBAR();   \
        o[d0] = mfma16(pa0, (s16x8){l0[0], l0[1], l0[2], l0[3], h0[0], h0[1], h0[2], h0[3]}, o[d0]);   \
        o[d0] = mfma16(pa1, (s16x8){l1[0], l1[1], l1[2], l1[3], h1[0], h1[1], h1[2], h1[3]}, o[d0]);   \
        o[d0] = mfma16(pa2, (s16x8){l2[0], l2[1], l2[2], l2[3], h2[0], h2[1], h2[2], h2[3]}, o[d0]);   \
        o[d0] = mfma16(pa3, (s16x8){l3[0], l3[1], l3[2], l3[3], h3[0], h3[1], h3[2], h3[3]}, o[d0]); } while (0)
    PV_D0(0); PV_D0(1); PV_D0(2); PV_D0(3);
#undef PV_D0
#undef TRRD
}
struct BlockRef { const char* Q; const char* K; const char* V; char* O; int P0; const char* NBQ; const char* MK;
                  int j0, nt;
                  int part;
                  char* PART; unsigned* flag; };
struct Seam { s16x8 qr[8]; };
#define LD16(base, off) (*reinterpret_cast<const s16x8*>((base) + (off)))
#define VMW() asm volatile("s_waitcnt vmcnt(0)" ::: "memory")
#define VMWN(n) asm volatile("s_waitcnt vmcnt(%0)" :: "i"(n) : "memory")
#define SLOAD_H(Kp, Vp, k0) do { const char* vb_ = (Vp) + (size_t)(k0) * (D * 2); const char* kb_ = (Kp) + (size_t)(k0) * (D * 2); \
        st_v0 = LD16(vb_, st_off); st_v1 = LD16(vb_ + 32 * D * 2, st_off); st_k0 = LD16(kb_, st_off); st_k1 = LD16(kb_ + 32 * D * 2, st_off); } while (0)
#define SWRITE_HK(bf) do { *(s16x8*)(K_lds + (bf) * SHM_K + kws) = st_k0; *(s16x8*)(K_lds + (bf) * SHM_K + kws + 32 * 256) = st_k1; } while (0)
#define SWRITE_HV(bf) do { *(s16x8*)(V_lds + (bf) * SHM_V + vst0) = st_v0; *(s16x8*)(V_lds + (bf) * SHM_V + vst1) = st_v1; } while (0)
#define SWRITE_H(bf) do { SWRITE_HV(bf); SWRITE_HK(bf); } while (0)
__device__ __forceinline__ void prime(const BlockRef& cur, char* lds, Seam& S, int wv) {
    int tid = wv * 64 + lane_id(); asm volatile("" : "+v"(tid));
    const int wid = __builtin_amdgcn_readfirstlane(tid >> 6), lane = tid & 63, r32 = lane & 31, hi = lane >> 5;
    const unsigned q_off = (unsigned)((wid * QBLK + r32) * D + hi * 8) * 2u;
#pragma unroll
    for (int d0 = 0; d0 < 8; ++d0) S.qr[d0] = LD16(cur.Q + d0 * 32, q_off);
}
template <bool MIXB, int ROLE>
__device__ __forceinline__ void block(const BlockRef& cur, const BlockRef& nxt, char* lds, Seam& S, int wv) {
    constexpr bool CONS = ROLE == 2;
    int tid = wv * 64 + lane_id(); asm volatile("" : "+v"(tid));
    const int wid = __builtin_amdgcn_readfirstlane(tid >> 6), lane = tid & 63, r32 = lane & 31, hi = lane >> 5;
    int NT = cur.nt, J0 = cur.j0;
    const int qlo = cur.P0 + wid * QBLK, qm = qlo + r32 - 4 * hi;
    char* V_lds = lds; char* K_lds = lds + 2 * SHM_V;
    float* wsf = (float*)(lds + 2 * SHM_V + 2 * SHM_K) + wid * 64; float* li_l = wsf, * al_l = wsf + 32;
    float m_reg = -1e30f, l_reg = 0; f32x16 o[4] = {};
    const int sr = tid >> 4, sc = (tid & 15) * 8, vst0 = v_st(sr, sc), vst1 = v_st(32 + sr, sc), kws = KSWZ(sr, sc * 2);
    const int vb0 = (int)(uintptr_t)V_lds + v_rd_base(lane);
    const unsigned st_off = (unsigned)(sr * D + sc) * 2u, q_off = (unsigned)((wid * QBLK + r32) * D + hi * 8) * 2u;
    const unsigned nb_off = (unsigned)hi * 16u, mk_off = (unsigned)(wid * QBLK + r32) * 512u;
    const char* Kh = cur.K; const char* Vh = cur.V;
    const char* bias_l = lds + LDS_NEED;
    if (MIXB) {
        float* cs = (float*)bias_l; float* wtot = (float*)(lds + LDS_NEED + 16384);
        const int L = cur.P0 + QB; const float* lf = (const float*)cur.NBQ;
        float v[8];
        if (8 * tid < L) { const f32x4 a = *(const f32x4*)(lf + 8 * tid), b4 = *(const f32x4*)(lf + 8 * tid + 4); v[0] = a[0]; v[1] = a[1]; v[2] = a[2]; v[3] = a[3]; v[4] = b4[0]; v[5] = b4[1]; v[6] = b4[2]; v[7] = b4[3]; }
        else {
#pragma unroll
            for (int i = 0; i < 8; ++i) v[i] = 0.f; }
#pragma unroll
        for (int i = 1; i < 8; ++i) v[i] += v[i - 1];
        float inc = v[7];
#pragma unroll
        for (int o_ = 1; o_ < 64; o_ <<= 1) { const float nb = __shfl_up(inc, o_); if (lane >= o_) inc += nb; }
        if (lane == 63) wtot[wid] = inc;
        __syncthreads();
        float base = inc - v[7];
#pragma unroll
        for (int w_ = 0; w_ < 7; ++w_) base += (w_ < wid) ? wtot[w_] : 0.f;
        if (8 * tid < L) {
#pragma unroll
            for (int i = 0; i < 8; ++i) cs[8 * tid + i] = (base + v[i]) * -11.313708498984761f; }
        __syncthreads();
        { const float qk2 = __int_as_float(cur.j0);
          const int s_ = 64 * lane + 63; const float dc = (s_ < cur.P0) ? (cs[s_] - cs[cur.P0]) * SCALE : 0.f;
          const bool keep = (s_ >= cur.P0) || (qk2 + dc >= -40.0f);
          J0 = __builtin_ctzll(__ballot(keep)); NT = cur.P0 / KVBLK + 4 - J0; }
        const float nbref = cs[L - 1];
        __syncthreads();
        for (int i = J0 * KVBLK + tid; i < L; i += NW * 64) cs[i] -= nbref;
        __syncthreads(); }
#define RESC(a) do { if (__any((a) < 1.f)) { if (hi == 0) al_l[r32] = (a); asm volatile("s_waitcnt lgkmcnt(0)" ::: "memory");              \
                     for (int d_ = 0; d_ < 4; ++d_) for (int r = 0; r < 16; ++r) o[d_][r] *= al_l[crow(r, hi)]; } } while (0)
#define KBASE(t) ((J0 + (t)) * KVBLK)
#define MKW(t) (*(const u64*)(cur.MK + (size_t)(J0 + (t)) * 8 + mk_off))
#define PINIT(P0_, P1_, t, MW_) do { if (MIXB) { const char* nb_ = bias_l + KBASE(t) * 4 + nb_off; _Pragma("unroll") for (int g_ = 0; g_ < 4; ++g_) { \
            const f32x4 b0_ = *(const f32x4*)(nb_ + 32 * g_), b1_ = *(const f32x4*)(nb_ + 128 + 32 * g_); \
            _Pragma("unroll") for (int j_ = 0; j_ < 4; ++j_) { P0_[4 * g_ + j_] = b0_[j_]; P1_[4 * g_ + j_] = b1_[j_]; } } } else { const u64 w_ = (MW_); const unsigned lo_ = (unsigned)w_ >> (4 * hi), up_ = (unsigned)(w_ >> 32) >> (4 * hi); \
            _Pragma("unroll") for (int r_ = 0; r_ < 16; ++r_) { const int c_ = (r_ & 3) + 8 * (r_ >> 2); \
                P0_[r_] = __uint_as_float((((lo_ >> c_) & 1u) - 1u) & 0xff800000u); P1_[r_] = __uint_as_float((((up_ >> c_) & 1u) - 1u) & 0xff800000u); } } } while (0)
#define MASKT(P0_, P1_, t, MW_) do { if (MIXB) { const int kb_ = KBASE(t); if (kb_ + KVBLK - 1 > qlo) mask_causal(P0_, P1_, qm - kb_); } } while (0)
    f32x16 pA0, pA1, pB0, pB1; float mnA, mnB, alA, alB; s16x8 pa0, pa1, pa2, pa3;
    u64 mwA = 0, mwB = 0;
    if (!MIXB) { mwA = MKW(0); if (NT > 1) mwB = MKW(1); }
    PINIT(pA0, pA1, 0, mwA); if (!MIXB) { if (NT > 2) mwA = MKW(2); }
    if (NT > 1) { PINIT(pB0, pB1, 1, mwB); if (!MIXB) { if (NT > 3) mwB = MKW(3); } }
    s16x8 st_v0, st_v1, st_k0, st_k1;
    SLOAD_H(Kh, Vh, KBASE(0)); VMW(); SWRITE_HK(0); SWRITE_HV(0); SBAR();
    __syncthreads();
    if (NT > 1) SLOAD_H(Kh, Vh, KBASE(1));
    SBAR(); qkt<0>(pA0, pA1, K_lds, r32, hi, S.qr);
    MASKT(pA0, pA1, 0, mwA);
    partialSM(pA0, pA1, m_reg, mnA, alA);
    if (NT > 1) { VMW(); SWRITE_H(1); }
    __syncthreads();
#define HALF_STEP(PX0, PX1, mnX, alX, MWX, PY0, PY1, alY, MWY, t, KB, VB, SB) do {                                               \
        SBAR(); qkt<KB>(PX0, PX1, K_lds, r32, hi, S.qr);                                                                      \
        finishSM(PY0, PY1, alY, l_reg, pa0, pa1, pa2, pa3); SBAR();                                                           \
        if ((t) + 1 < NT) { PINIT(PY0, PY1, (t) + 1, MWY); if (!MIXB) { if ((t) + 3 < NT) MWY = MKW((t) + 3); } SLOAD_H(Kh, Vh, KBASE((t) + 1)); SBAR(); }                             \
        pv_tile<VB>(o, vb0, pa0, pa1, pa2, pa3); MASKT(PX0, PX1, (t), MWX); \
        partialSM(PX0, PX1, m_reg, mnX, alX);                                                                                 \
        __syncthreads();                                                                                                      \
        if ((t) + 1 < NT) { VMW(); SWRITE_H(SB); }                                                                            \
        RESC(alX); __syncthreads(); } while (0)
    for (int t = 1; t + 1 < NT; t += 2) {
        HALF_STEP(pB0, pB1, mnB, alB, mwB, pA0, pA1, alA, mwA, t, 1, 0, 0);
        HALF_STEP(pA0, pA1, mnA, alA, mwA, pB0, pB1, alB, mwB, t + 1, 0, 1, 1);
    }
    const bool even = (NT & 1) == 0;
    if (even) { SBAR(); qkt<1>(pB0, pB1, K_lds, r32, hi, S.qr); SBAR(); }
    if (!CONS) {
#pragma unroll
        for (int d0 = 0; d0 < 8; ++d0) S.qr[d0] = LD16(nxt.Q + d0 * 32, q_off); }
    SBAR();
    finishSM(pA0, pA1, alA, l_reg, pa0, pa1, pa2, pa3); SBAR();
    pv_tile<0>(o, vb0, pa0, pa1, pa2, pa3);
    if (even) { MASKT(pB0, pB1, NT - 1, mwB); partialSM(pB0, pB1, m_reg, mnB, alB); __syncthreads(); RESC(alB);
        finishSM(pB0, pB1, alB, l_reg, pa0, pa1, pa2, pa3); SBAR(); pv_tile<1>(o, vb0, pa0, pa1, pa2, pa3); }
    constexpr float C2E = 1.4426950408889634f * SCALE;
    if (!CONS && cur.part == 1) {
        float* po = (float*)cur.PART + (size_t)wid * (64 * 64) + lane;
#pragma unroll
        for (int d0 = 0; d0 < 4; ++d0)
#pragma unroll
            for (int r = 0; r < 16; ++r) po[(d0 * 16 + r) * 64] = o[d0][r];
        float* pml = (float*)cur.PART + 8 * 64 * 64 + wid * 128;
        pml[lane] = m_reg; pml[64 + lane] = l_reg;
        asm volatile("s_waitcnt vmcnt(0)" ::: "memory");
        __syncthreads();
        if (tid == 0) { __builtin_amdgcn_fence(__ATOMIC_RELEASE, "agent"); asm volatile("s_waitcnt vmcnt(0)" ::: "memory"); __hip_atomic_store(cur.flag, 1u, __ATOMIC_RELAXED, __HIP_MEMORY_SCOPE_AGENT); }
    } else {
        float a_me = 1.f;
        if (CONS) {
            if (tid == 0) { unsigned spins = 0; while (__hip_atomic_load(cur.flag, __ATOMIC_RELAXED, __HIP_MEMORY_SCOPE_AGENT) == 0u) { __builtin_amdgcn_s_sleep(4); if (++spins > (1u << 22)) break; }
                __builtin_amdgcn_fence(__ATOMIC_ACQUIRE, "agent"); asm volatile("s_waitcnt vmcnt(0)" ::: "memory"); }
            __syncthreads();
            const float* pml = (const float*)cur.PART + 8 * 64 * 64 + wid * 128;
            const float m2 = pml[lane], l2 = pml[64 + lane];
            const float mm = fmaxf(m_reg, m2); a_me = __builtin_amdgcn_exp2f((m_reg - mm) * C2E); const float a_ot = __builtin_amdgcn_exp2f((m2 - mm) * C2E);
            l_reg = l_reg * a_me + l2 * a_ot;
            if (hi == 0) { li_l[r32] = a_me; al_l[r32] = a_ot; } asm volatile("s_waitcnt lgkmcnt(0)" ::: "memory");
            const float* po = (const float*)cur.PART + (size_t)wid * (64 * 64) + lane;
#pragma unroll
            for (int r = 0; r < 16; ++r) { const float fa = li_l[crow(r, hi)], fb = al_l[crow(r, hi)];
#pragma unroll
                for (int d0 = 0; d0 < 4; ++d0) o[d0][r] = o[d0][r] * fa + po[(d0 * 16 + r) * 64] * fb; }
            asm volatile("s_waitcnt lgkmcnt(0)" ::: "memory");
        }
        if (hi == 0) li_l[r32] = l_reg; asm volatile("s_waitcnt lgkmcnt(0)" ::: "memory");
        float rli[16];
#pragma unroll
        for (int r = 0; r < 16; ++r) rli[r] = __builtin_amdgcn_rcpf(li_l[crow(r, hi)]);
        const unsigned o_off = (unsigned)((wid * QBLK + 4 * hi) * 1024 + r32) * 2u;
#pragma unroll
        for (int r = 0; r < 16; ++r) {
#pragma unroll
            for (int d0 = 0; d0 < 4; ++d0) { const float v = o[d0][r] * rli[r];
                const float vn = __shfl_xor(v, 1);
                if ((r32 & 1) == 0) *(unsigned*)(cur.O + (size_t)(((r & 3) + 8 * (r >> 2)) * 2048 + d0 * 64) + o_off) = cvtpk(v, vn); } }
    }
    __syncthreads();
#undef RESC
#undef KBASE
#undef PINIT
#undef MKW
#undef MASKT
#undef HALF_STEP
}
#undef LD16
#undef VMW
#undef VMWN
#undef SLOAD_H
#undef SWRITE_HK
#undef SWRITE_HV
#undef SWRITE_H
constexpr int SCHED_MAXI = 3;
__device__ const signed char HSPLIT[8][8] = {{11, 35, 17, 35, 35, 24, 34, 46}, {24, 15, 23, 23, 24, 33, 46, 29}, {12, 19, 19, 11, 5, 32, 35, 33}, {26, 34, 8, 22, 23, 46, 12, 34}, {12, 24, 39, 31, 25, 21, 35, 45}, {9, 13, 22, 23, 46, 29, 13, 36}, {11, 8, 23, 35, 16, 29, 25, 20}, {11, 15, 23, 12, 45, 35, 23, 46}};
__device__ const short SCHED[256][3] = {
  {129, 112, -1},
  {5152, 5360, 130},
  {145, 5040, -1},
  {880, 4352, 146},
  {161, 1584, 4512},
  {4480, 4320, 162},
  {177, 4960, -1},
  {1648, 178, -1},
  {193, 5072, -1},
  {1328, 5344, 194},
  {209, 1296, 5088},
  {1312, 210, -1},
  {225, 5440, -1},
  {1808, 4576, 226},
  {241, -1, -1},
  {1056, 5712, 242},
  {385, 5232, 5056},
  {368, 386, -1},
  {401, 1120, -1},
  {5552, 4448, 402},
  {417, 1040, 5760},
  {48, 5376, 418},
  {433, 1552, 5584},
  {5248, 5280, 434},
  {449, 5312, 4704},
  {816, 450, -1},
  {465, 5968, -1},
  {6128, 5184, 466},
  {481, -1, -1},
  {576, 4784, 482},
  {497, 1792, 4368},
  {4240, 498, -1},
  {641, 1600, 4752},
  {5472, 5648, 642},
  {657, 592, -1},
  {32, 5264, 658},
  {673, 1568, 5504},
  {5904, 4736, 674},
  {689, 1136, -1},
  {4544, 690, -1},
  {705, 1632, 4272},
  {706, -1, -1},
  {721, 1280, 5888},
  {5680, 5536, 722},
  {737, 4976, -1},
  {5456, 4640, 738},
  {753, 6032, -1},
  {6000, 754, -1},
  {897, 256, 6064},
  {1616, 5024, 898},
  {913, 5520, -1},
  {1888, 4896, 914},
  {929, 96, 1024},
  {5200, 930, -1},
  {945, 6048, 4992},
  {4800, 4528, 946},
  {961, 16, 5840},
  {528, 4608, 962},
  {977, -1, -1},
  {336, 4880, 978},
  {993, 1904, -1},
  {994, -1, -1},
  {1009, 5600, -1},
  {544, 1010, -1},
  {1153, 1872, 4864},
  {5488, 5616, 1154},
  {1169, 272, 4816},
  {352, 1170, -1},
  {1185, 768, -1},
  {864, 5392, 1186},
  {1201, 800, -1},
  {304, 5168, 1202},
  {1217, 4832, 4400},
  {4416, 4128, 1218},
  {1233, 5936, 5408},
  {5792, 1234, -1},
  {1249, 4768, -1},
  {5568, 4672, 1250},
  {1265, -1, -1},
  {288, 4688, 1266},
  {1409, 80, 4288},
  {4592, 4224, 1410},
  {1425, 320, 4256},
  {4464, 4192, 1426},
  {1441, 5744, 5824},
  {6112, 5776, 1442},
  {1457, 784, 5872},
  {5136, 5328, 1458},
  {1473, -1, -1},
  {1376, 5008, 1474},
  {1489, 1536, 4176},
  {4496, 4144, 1490},
  {1505, 1088, 4208},
  {1506, -1, -1},
  {1521, 4336, -1},
  {512, 4160, 1522},
  {1665, 624, -1},
  {5728, 4912, 1666},
  {1681, 1104, 4720},
  {1824, 1682, -1},
  {1697, 64, -1},
  {1072, 4096, 1698},
  {1713, 4656, -1},
  {1392, 1714, -1},
  {1729, 1840, 4944},
  {5216, 1730, -1},
  {1745, 0, 4112},
  {4560, 4304, 1746},
  {1761, 6080, 5632},
  {5664, 1762, -1},
  {1777, 5984, 6016},
  {1778, -1, -1},
  {1921, 1856, 5808},
  {5424, 4432, 1922},
  {1937, 608, -1},
  {5696, 4624, 1938},
  {1953, 5856, 4848},
  {5920, 5952, 1954},
  {1969, 1344, 5104},
  {5296, 1970, -1},
  {1985, -1, -1},
  {848, 6096, 1986},
  {2001, 4928, -1},
  {560, 5120, 2002},
  {2017, 832, -1},
  {4384, 2018, -1},
  {2033, -1, -1},
  {1360, 2034, -1},
  {2177, 2160, -1},
  {7200, 7408, 2178},
  {2193, 7088, -1},
  {2928, 6400, 2194},
  {2209, 3632, 6560},
  {6528, 6368, 2210},
  {2225, 7008, -1},
  {3696, 2226, -1},
  {2241, 7120, -1},
  {3376, 7392, 2242},
  {2257, 3344, 7136},
  {3360, 2258, -1},
  {2273, 7488, -1},
  {3856, 6624, 2274},
  {2289, -1, -1},
  {3104, 7760, 2290},
  {2433, 7280, 7104},
  {2416, 2434, -1},
  {2449, 3168, -1},
  {7600, 6496, 2450},
  {2465, 3088, 7808},
  {2096, 7424, 2466},
  {2481, 3600, 7632},
  {7296, 7328, 2482},
  {2497, 7360, 6752},
  {2864, 2498, -1},
  {2513, 8016, -1},
  {8176, 7232, 2514},
  {2529, -1, -1},
  {2624, 6832, 2530},
  {2545, 3840, 6416},
  {6288, 2546, -1},
  {2689, 3648, 6800},
  {7520, 7696, 2690},
  {2705, 2640, -1},
  {2080, 7312, 2706},
  {2721, 3616, 7552},
  {7952, 6784, 2722},
  {2737, 3184, -1},
  {6592, 2738, -1},
  {2753, 3680, 6320},
  {2754, -1, -1},
  {2769, 3328, 7936},
  {7728, 7584, 2770},
  {2785, 7024, -1},
  {7504, 6688, 2786},
  {2801, 8080, -1},
  {8048, 2802, -1},
  {2945, 2304, 8112},
  {3664, 7072, 2946},
  {2961, 7568, -1},
  {3936, 6944, 2962},
  {2977, 2144, 3072},
  {7248, 2978, -1},
  {2993, 8096, 7040},
  {6848, 6576, 2994},
  {3009, 2064, 7888},
  {2576, 6656, 3010},
  {3025, -1, -1},
  {2384, 6928, 3026},
  {3041, 3952, -1},
  {3042, -1, -1},
  {3057, 7648, -1},
  {2592, 3058, -1},
  {3201, 3920, 6912},
  {7536, 7664, 3202},
  {3217, 2320, 6864},
  {2400, 3218, -1},
  {3233, 2816, -1},
  {2912, 7440, 3234},
  {3249, 2848, -1},
  {2352, 7216, 3250},
  {3265, 6880, 6448},
  {6464, 6176, 3266},
  {3281, 7984, 7456},
  {7840, 3282, -1},
  {3297, 6816, -1},
  {7616, 6720, 3298},
  {3313, -1, -1},
  {2336, 6736, 3314},
  {3457, 2128, 6336},
  {6640, 6272, 3458},
  {3473, 2368, 6304},
  {6512, 6240, 3474},
  {3489, 7792, 7872},
  {8160, 7824, 3490},
  {3505, 2832, 7920},
  {7184, 7376, 3506},
  {3521, -1, -1},
  {3424, 7056, 3522},
  {3537, 3584, 6224},
  {6544, 6192, 3538},
  {3553, 3136, 6256},
  {3554, -1, -1},
  {3569, 6384, -1},
  {2560, 6208, 3570},
  {3713, 2672, -1},
  {7776, 6960, 3714},
  {3729, 3152, 6768},
  {3872, 3730, -1},
  {3745, 2112, -1},
  {3120, 6144, 3746},
  {3761, 6704, -1},
  {3440, 3762, -1},
  {3777, 3888, 6992},
  {7264, 3778, -1},
  {3793, 2048, 6160},
  {6608, 6352, 3794},
  {3809, 8128, 7680},
  {7712, 3810, -1},
  {3825, 8032, 8064},
  {3826, -1, -1},
  {3969, 3904, 7856},
  {7472, 6480, 3970},
  {3985, 2656, -1},
  {7744, 6672, 3986},
  {4001, 7904, 6896},
  {7968, 8000, 4002},
  {4017, 3392, 7152},
  {7344, 4018, -1},
  {4033, -1, -1},
  {2896, 8144, 4034},
  {4049, 6976, -1},
  {2608, 7168, 4050},
  {4065, 2880, -1},
  {6432, 4066, -1},
  {4081, -1, -1},
  {3408, 4082, -1},
};

__device__ __forceinline__ BlockRef make_ref(int code, unsigned char* ws, const float* b_f) {
    const bool mixb = (code >> 12) != 0; int bh = (code >> 8) & 15; const int qb = (code >> 4) & 15, part = code & 15;
    if (mixb) { const int vr = bh & 7; int act = 0; float bv[8];
#pragma unroll
        for (int i = 0; i < 8; ++i) bv[i] = b_f[i];
#pragma unroll
        for (int i = 0; i < 8; ++i) { int rk = 0;
#pragma unroll
            for (int j2 = 0; j2 < 8; ++j2) rk += (bv[j2] < bv[i] || (bv[j2] == bv[i] && j2 < i)) ? 1 : 0;
            act = (rk == vr) ? i : act; }
        bh = (bh & 8) | act; }
    const int b = bh >> 3, h = bh & 7, kvh = mixb ? bh : (b * HAKV + (h >> 2));
    BlockRef r;
    r.Q = (const char*)ws + (mixb ? WS_QB : WS_QA) + ((size_t)bh * T + (size_t)qb * QB) * D * 2;
    r.K = (const char*)ws + (mixb ? WS_KB : WS_KA) + (size_t)kvh * T * D * 2;
    r.V = (const char*)ws + (mixb ? WS_VB : WS_VA) + (size_t)kvh * T * D * 2;
    r.O = (char*)ws + (mixb ? WS_OUTB : WS_OUTA) + ((size_t)(b * T + qb * QB) * 1024 + h * D) * 2;
    r.P0 = qb * QB;
    r.NBQ = nullptr;
    r.MK = (const char*)ws + WS_MASK + (size_t)(b * T + qb * QB) * 64 * 8;
    const int NTall = r.P0 / KVBLK + 4;
    r.part = part; r.j0 = 0; r.nt = NTall;
    r.PART = (char*)ws + WS_PART + (size_t)(bh * 8 + (qb & 7)) * 135168; r.flag = (unsigned*)(ws + WS_CTL) + CW_SPLIT + (bh * 8 + (qb & 7));
    if (part != 0) { const int hs = HSPLIT[bh & 7][qb - 8]; if (part == 1) r.nt = hs; else { r.j0 = hs; r.nt = NTall - hs; } }
    if (mixb) {
        const unsigned* nrm = (const unsigned*)(ws + WS_NORM);
        float q2 = 0.f, k2 = 0.f;
#pragma unroll
        for (int w_ = 0; w_ < 4; ++w_) { q2 += __uint_as_float(nrm[(bh * 16 + qb) * 4 + w_]); k2 += __uint_as_float(nrm[1024 + bh * 4 + w_]); }
        const float qk = 2.02f * __builtin_sqrtf(q2 * k2) * SCALE;
        r.j0 = __float_as_int(qk);
        r.NBQ = (const char*)ws + WS_LOGF + (size_t)bh * T * 4;
    }
    return r;
}
__device__ __forceinline__ void run_list(int cu, unsigned char* ws, char* lds, int wv, const float* b_f) {
    Seam S;
    int code = SCHED[cu][0];
    if (code < 0) return;
    BlockRef cur = make_ref(code, ws, b_f);
    prime(cur, lds, S, wv);
#pragma unroll 1
    for (int k = 0; k < SCHED_MAXI; ++k) {
        if ((code & 15) == 2) break;
        const int ncode = (k + 1 < SCHED_MAXI) ? SCHED[cu][k + 1] : -1;
        const BlockRef nxt = ncode >= 0 ? make_ref(ncode, ws, b_f) : cur;
        if ((code >> 12) != 0) block<true, 0>(cur, nxt, lds, S, wv); else block<false, 0>(cur, nxt, lds, S, wv);
        if (ncode < 0) return;
        cur = nxt; code = ncode;
    }
    block<false, 2>(cur, cur, lds, S, wv);
}
}


#define XB_TMO      128
#define XB_XCNT(j)  (256  + 64 * (j))
#define XB_XSUB(j)  (1280 + 64 * (j))
#define XB_XGEN(j)  (2304 + 64 * (j))
#define XB_TOP      3328
#define XB_TOPGEN   3392
#define XCD_BAR_WORDS 3456
#define XB_SPIN_CAP (1u << 24)
__device__ __forceinline__ unsigned xb_ld(unsigned* p)              { return __hip_atomic_load(p, __ATOMIC_RELAXED, __HIP_MEMORY_SCOPE_AGENT); }
__device__ __forceinline__ unsigned xb_add(unsigned* p, unsigned v) { return __hip_atomic_fetch_add(p, v, __ATOMIC_RELAXED, __HIP_MEMORY_SCOPE_AGENT); }
__device__ __forceinline__ unsigned xb_xcc_id() { return (unsigned)__builtin_amdgcn_s_getreg((3 << 11) | 20) & 0xFu; }
#define XB_SPIN(cond, bar) do { unsigned _sp = 0; while (cond) { __builtin_amdgcn_s_sleep(1); \
    if ((++_sp & 255u) == 0u) { if (xb_ld(&(bar)[XB_TMO])) break; if (_sp > XB_SPIN_CAP) { atomicAdd(&(bar)[XB_TMO], 1u); break; } } } } while (0)
struct XcdBarrier { unsigned* bar; unsigned x; volatile LAS unsigned* st; };
__device__ __forceinline__ XcdBarrier xcd_barrier_post(unsigned* bar, volatile LAS unsigned* st, int wv) {
    XcdBarrier b; b.bar = bar; b.x = xb_xcc_id(); b.st = st;
    if (wv == 0 && lane_id() == 0) (void)xb_add(&bar[XB_XCNT(b.x)], 1u);
    return b;
}
__device__ __forceinline__ void xcd_barrier_complete(unsigned* bar, unsigned x, unsigned& nloc, unsigned& nx) {
    const unsigned G = gridDim.x * gridDim.y * gridDim.z;
    unsigned sum, cnt, mine, sp = 0u;
    for (;;) {
        sum = 0u; cnt = 0u; mine = 0u;
#pragma unroll
        for (unsigned j = 0; j < 16; ++j) { const unsigned c = xb_ld(&bar[XB_XCNT(j)]); sum += c; cnt += (c > 0u) ? 1u : 0u; mine = (j == x) ? c : mine; }
        if (sum == G) break;
        __builtin_amdgcn_s_sleep(1);
        if ((++sp & 255u) == 0u) { if (xb_ld(&bar[XB_TMO])) break; if (sp > XB_SPIN_CAP) { atomicAdd(&bar[XB_TMO], 1u); break; } }
    }
    nloc = mine > 0u ? mine : 1u; nx = cnt > 0u ? cnt : 1u;
}
__device__ __forceinline__ void xcd_barrier(const XcdBarrier& b, int wv) {
    asm volatile("s_waitcnt vmcnt(0)" ::: "memory");
    __syncthreads();
    if (wv == 0 && lane_id() == 0) {
        unsigned* bar = b.bar;
        __builtin_amdgcn_s_waitcnt(0);
        unsigned nloc = b.st[0], nx = b.st[1];
        if (nloc == 0u) { xcd_barrier_complete(bar, b.x, nloc, nx); b.st[0] = nloc; b.st[1] = nx; }
        const unsigned old = xb_add(&bar[XB_XSUB(b.x)], 1u);
        const unsigned gen = old / nloc;
        if (old + 1u == (gen + 1u) * nloc) {
            __builtin_amdgcn_fence(__ATOMIC_RELEASE, "agent");
            asm volatile("s_waitcnt vmcnt(0)" ::: "memory");
            const unsigned og = xb_add(&bar[XB_TOP], 1u);
            const unsigned tg = og / nx;
            if (og + 1u == (tg + 1u) * nx) xb_add(&bar[XB_TOPGEN], 1u);
            else XB_SPIN(xb_ld(&bar[XB_TOPGEN]) == tg, bar);
            __builtin_amdgcn_fence(__ATOMIC_ACQUIRE, "agent");
            xb_add(&bar[XB_XGEN(b.x)], 1u);
            asm volatile("s_waitcnt vmcnt(0)" ::: "memory");
        } else {
            XB_SPIN(xb_ld(&bar[XB_XGEN(b.x)]) == gen, bar);
            __builtin_amdgcn_fence(__ATOMIC_ACQUIRE, "agent");
            asm volatile("s_waitcnt vmcnt(0)" ::: "memory");
        }
    }
    __syncthreads();
}

namespace cg = cooperative_groups;
constexpr int LDS_BYTES = pg8::STAGE_BYTES + 256;
struct Params { const float* in[17]; float* out; unsigned char* ws; };
template <class Epi>
__device__ __forceinline__ void run_gemm(LAS unsigned char* lds, const h16* A, const h16* Bt, int M, int N, int K, const Epi& e, int wv) {
    pg8::Gemm g{A, Bt, M, N, K, nullptr, nullptr}; pg8::StaticOrder S; S.init(M, N, (int)gridDim.x, (int)blockIdx.x);
    pg8::gemm_phase<Epi>(lds, g, S, e, wv);
}
template <class Epi>
__device__ __forceinline__ void run_gemm2(LAS unsigned char* lds, const h16* A, const h16* Bt, const h16* A2, const h16* Bt2, int M, int N, int K, const Epi& e, int wv) {
    pg8::Gemm g{A, Bt, M, N, K, A2, Bt2}; pg8::StaticOrder S; S.init(M, N, (int)gridDim.x, (int)blockIdx.x, 2);
    pg8::gemm_phase<Epi>(lds, g, S, e, wv);
}
__global__ void __launch_bounds__(512, 2) mega_fwd(Params P) {
    extern __shared__ __attribute__((aligned(16))) unsigned char lds_raw[];
    LAS unsigned char* lds = (LAS unsigned char*)lds_raw;
    const int wv = __builtin_amdgcn_readfirstlane(threadIdx.x >> 6);
    volatile LAS unsigned* bst = (volatile LAS unsigned*)(lds + pg8::STAGE_BYTES);
    if (wv == 0 && lane_id() < 2) bst[lane_id()] = 0u;
    __syncthreads();
    const XcdBarrier xbar = xcd_barrier_post((unsigned*)(P.ws + WS_CTL) + CW_BAR, bst, wv);
#define GRID_BAR() xcd_barrier(xbar, wv)
#define IDS() int lane = lane_id(); asm volatile("" : "+v"(lane)); const int wave = wv, tid = wave * 64 + lane, gw = blockIdx.x * 8 + wave, NGW = gridDim.x * 8; (void)tid; (void)gw; (void)NGW
    const float* x = P.in[0]; const float* p = P.in[1]; const int* pos = (const int*)P.in[2];
    const float* g_mix = P.in[3]; const float* w_in = P.in[4]; const float* b_f = P.in[5];
    const float* w_o_a = P.in[6]; const float* w_o_b = P.in[7]; const float* w_out = P.in[8];
    const float* g_ffn = P.in[9]; const float* w_g = P.in[10]; const float* w_u = P.in[11]; const float* w_d = P.in[12];
    const float* g_ple = P.in[13]; const float* w_pg = P.in[14]; const float* w_pp = P.in[15]; const float* g_final = P.in[16];
    unsigned char* ws = P.ws; float* out = P.out;
    float* RS = (float*)(ws + WS_RS); float* ROPE = (float*)(ws + WS_ROPE); float* LOGF = (float*)(ws + WS_LOGF); u64* MASK = (u64*)(ws + WS_MASK);
    h16* WIN = (h16*)(ws + WS_WIN); h16* WOA = (h16*)(ws + WS_WOA); h16* WOB = (h16*)(ws + WS_WOB); h16* WOUT = (h16*)(ws + WS_WOUT);
    h16* WGU = (h16*)(ws + WS_WGU); h16* WDN = (h16*)(ws + WS_WDN); h16* WPG = (h16*)(ws + WS_WPG); h16* WPP = (h16*)(ws + WS_WPP);
    h16* QI = (h16*)(ws + WS_QI); h16* KI = (h16*)(ws + WS_KI); float* WI = (float*)(ws + WS_WI);
    h16* SIGA = (h16*)(ws + WS_SIGA); h16* SIGB = (h16*)(ws + WS_SIGB);
    h16* OUTA = (h16*)(ws + WS_OUTA); h16* OUTB = (h16*)(ws + WS_OUTB); h16* P16 = (h16*)(ws + WS_P16);
    h16* X3H = (h16*)(ws + WS_SIGA);
    h16* MIXED = (h16*)(ws + WS_MIXED); h16* H2 = (h16*)(ws + WS_H2); h16* ACT = (h16*)(ws + WS_ACT); h16* PP = (h16*)(ws + WS_PP);
    h16* H1 = (h16*)P.out;

    { IDS(); LAS float* scr = (LAS float*)(lds + wave * 8448);
      ph_transpose<2>(w_g, w_u, g_ffn, DM, DFF, WGU, 2 * DFF, scr, gw, NGW, lane);
      ph_transpose<1>(w_in, nullptr, nullptr, DM, N_IN, WIN, N_INP, scr, gw, NGW, lane);
      ph_rope(pos, ROPE, blockIdx.x * 512 + tid, gridDim.x * 512);
      for (int i = blockIdx.x * 512 + tid; i < 3 * MTOK; i += gridDim.x * 512) RS[i] = 0.f;
      for (int i = blockIdx.x * 512 + tid; i < 1088; i += gridDim.x * 512) ((unsigned*)(ws + WS_NORM))[i] = 0u;
      ph_rmsnorm<false>(x, g_mix, H1, nullptr, gw, NGW, lane);
    }
    GRID_BAR();
    { EpiInProj e{ws, b_f}; run_gemm(lds, H1, WIN, MTOK, N_INP, DM, e, wv); }
    { const int fi = ((MTOK / 256) * (N_INP / 256)) % (int)gridDim.x;
    if ((int)blockIdx.x >= fi) { IDS(); (void)tid; (void)gw; (void)NGW; LAS float* scr = (LAS float*)(lds + wave * 8448); const int qw = ((int)blockIdx.x - fi) * 8 + wave, nq = ((int)gridDim.x - fi) * 8;
      ph_transpose<0>(w_o_a, nullptr, nullptr, 1024, DM, WOA, DM, scr, qw, nq, lane);
      ph_transpose<0>(w_o_b, nullptr, nullptr, 1024, DM, WOB, DM, scr, qw, nq, lane);
      ph_transpose<0>(w_out, nullptr, nullptr, DM, DM, WOUT, DM, scr, qw, nq, lane); } }
    GRID_BAR();
    { IDS();
      for (int it = blockIdx.x; it < 256; it += gridDim.x) { const int bb = it & 1, gi = it >> 1;
#pragma unroll 1
          for (int pass = 0; pass < 2; ++pass) idx::run_group(ws, (char*)lds_raw, (unsigned*)out + (size_t)blockIdx.x * 16 * T, bb, pass ? 255 - gi : gi, wv); }
      for (int i = blockIdx.x * 512 + tid; i < MTOK * DPLE / 4; i += gridDim.x * 512) st4h(P16 + 4 * (size_t)i, *((const f32x4*)p + i));
    }
    GRID_BAR();
    for (int cu = blockIdx.x; cu < 256; cu += gridDim.x) att::run_list(cu, ws, (char*)lds_raw, wv, b_f);
    GRID_BAR();
    { EpiGate2 e{SIGA, SIGB, MIXED}; run_gemm2(lds, OUTA, WOA, OUTB, WOB, MTOK, DM, 1024, e, wv); }
    GRID_BAR();
    { EpiResidNorm<true> e{x, H2, RS}; run_gemm(lds, MIXED, WOUT, MTOK, DM, DM, e, wv); }
    GRID_BAR();
    { EpiSwiGLU e{ACT, RS}; run_gemm(lds, H2, WGU, MTOK, 2 * DFF, DM, e, wv); }
    { const int fi = ((MTOK / 256) * (2 * DFF / 256)) % (int)gridDim.x;
    if ((int)blockIdx.x >= fi) { IDS(); (void)tid; (void)gw; (void)NGW; LAS float* scr = (LAS float*)(lds + wave * 8448); const int qw = ((int)blockIdx.x - fi) * 8 + wave, nq = ((int)gridDim.x - fi) * 8;
      ph_transpose<0>(w_d, nullptr, nullptr, DFF, DM, WDN, DM, scr, qw, nq, lane);
      ph_transpose<0>(w_pg, nullptr, g_ple, DM, DM, WPG, DM, scr, qw, nq, lane);
      ph_transpose<0>(w_pp, nullptr, nullptr, DPLE, DM, WPP, DM, scr, qw, nq, lane); } }
    GRID_BAR();
    { EpiResidNorm<false> e{nullptr, H2, RS + MTOK}; run_gemm(lds, ACT, WDN, MTOK, DM, DFF, e, wv); }
    GRID_BAR();
    { EpiStoreH e{PP, DM}; run_gemm(lds, P16, WPP, MTOK, DM, DPLE, e, wv); }
    if (gridDim.x == (MTOK / 256) * (DM / 256)) {
        EpiPLEFinal e{PP, H2, out, RS + MTOK, RS + 2 * MTOK, g_final, (unsigned*)(ws + WS_CTL) + CW_PANEL}; run_gemm(lds, H2, WPG, MTOK, DM, DM, e, wv);
    } else {
        { EpiPLE e{PP, H2, X3H, RS + MTOK, RS + 2 * MTOK}; run_gemm(lds, H2, WPG, MTOK, DM, DM, e, wv); }
        GRID_BAR();
        { IDS(); ph_final(X3H, out, g_final, RS + 2 * MTOK, gw, NGW, lane); }
    }
#undef IDS
#undef GRID_BAR
}

extern "C" void kernel_launch(void* const* d_in, const int* in_sizes, int n_in, void* d_out, int out_size, void* d_ws, size_t ws_size, hipStream_t stream) {
    if (n_in != 17 || out_size != MTOK * DM || ws_size < WS_END) { fprintf(stderr, "kernel_launch: unexpected shapes / workspace (%d inputs, out %d, ws %zu)\n", n_in, out_size, ws_size); return; }
    static int grid_blocks = 0;
    if (!grid_blocks) {
        int dev = 0, cus = 0, per_cu = 0;
        (void)hipGetDevice(&dev);
        (void)hipDeviceGetAttribute(&cus, hipDeviceAttributeMultiprocessorCount, dev);
        (void)hipFuncSetAttribute((const void*)mega_fwd, hipFuncAttributeMaxDynamicSharedMemorySize, LDS_BYTES);
        (void)hipOccupancyMaxActiveBlocksPerMultiprocessor(&per_cu, (const void*)mega_fwd, 512, LDS_BYTES);
        if (per_cu < 1) { fprintf(stderr, "kernel_launch: occupancy query says %d blocks per CU\n", per_cu); per_cu = 1; }
        if (per_cu > 1) per_cu = 1;
        grid_blocks = cus * per_cu;
    }
    (void)hipMemsetAsync((char*)d_ws + WS_CTL, 0, 64 * 1024, stream);
    Params prm{};
    for (int i = 0; i < 17; ++i) prm.in[i] = (const float*)d_in[i];
    prm.out = (float*)d_out; prm.ws = (unsigned char*)d_ws;
    void* args[] = {&prm};
    hipError_t e = hipLaunchCooperativeKernel((const void*)mega_fwd, dim3(grid_blocks), dim3(512), args, LDS_BYTES, stream);
    if (e != hipSuccess) fprintf(stderr, "cooperative launch failed: %s (grid %d)\n", hipGetErrorString(e), grid_blocks);
}
```

```cpp
#include <hip/hip_runtime.h>
#include <hip/hip_cooperative_groups.h>
#include <stdint.h>
#include <cstdio>

#define LAS __attribute__((address_space(3)))
typedef _Float16 h16;
typedef _Float16 h16x8 __attribute__((ext_vector_type(8)));
typedef _Float16 h16x4 __attribute__((ext_vector_type(4)));
typedef _Float16 h16x2 __attribute__((ext_vector_type(2)));
typedef float f32x4 __attribute__((ext_vector_type(4)));
typedef float f32x2 __attribute__((ext_vector_type(2)));
typedef unsigned u32x4 __attribute__((ext_vector_type(4)));
typedef unsigned u32x2 __attribute__((ext_vector_type(2)));
typedef unsigned long long u64;
__device__ __forceinline__ int lane_id() { int r; asm volatile("v_mbcnt_lo_u32_b32 %0, -1, 0\n\tv_mbcnt_hi_u32_b32 %0, -1, %0" : "=v"(r)); return r; }

constexpr int NBATCH = 2, T = 4096, MTOK = NBATCH * T, DM = 2048;
constexpr int HA = 8, HAKV = 2, HIDX = 16, DIDX = 64, HB = 8, HD = 128;
constexpr int N_IN = 9816, N_INP = 9984, DFF = 5632, DPLE = 256, TOPK = 256;
constexpr float EPS = 1e-6f;
constexpr float ATT_SCALE = 0.08838834764831845f;

constexpr size_t MiB = 1u << 20;
constexpr size_t WS_CTL = 0;
constexpr size_t WS_RS = 512 * 1024;
constexpr size_t WS_NORM = 640 * 1024;
constexpr size_t WS_ROPE = 1 * MiB;
constexpr size_t WS_LOGF = 3 * MiB + 512 * 1024;
constexpr size_t WS_MASK = 4 * MiB;
constexpr size_t WS_WIN = 8 * MiB;
constexpr size_t WS_OUTA = 8 * MiB, WS_OUTB = 24 * MiB, WS_P16 = 40 * MiB;
constexpr size_t WS_WOA = 47 * MiB, WS_WOB = 51 * MiB, WS_WOUT = 55 * MiB, WS_WGU = 63 * MiB, WS_WDN = 107 * MiB, WS_WPG = 129 * MiB, WS_WPP = 137 * MiB;
constexpr size_t WS_QA = 138 * MiB, WS_KA = 154 * MiB, WS_VA = 158 * MiB, WS_QI = 162 * MiB, WS_KI = 178 * MiB, WS_WI = 179 * MiB;
constexpr size_t WS_QB = 180 * MiB, WS_KB = 196 * MiB, WS_VB = 212 * MiB, WS_SIGA = 228 * MiB, WS_SIGB = 260 * MiB, WS_PART = 292 * MiB, WS_END = 328 * MiB;
constexpr size_t WS_MIXED = WS_QB;
constexpr size_t WS_H2 = WS_QA;
constexpr size_t WS_ACT = WS_QB;
constexpr size_t WS_PP = WS_QB;
constexpr int CW_SPLIT = 12288;
constexpr int CW_PANEL = 8192;
constexpr int CW_BAR = 4096;

namespace pg8 {
constexpr int BM = 256, BK = 64, HALF = 128, HTB = HALF * BK * 2, STAGE_BYTES = 8 * HTB, NXCD = 8, WGM = 4;
__host__ __device__ __forceinline__ int lds_byte(int r, int c) { const int st = (r >> 4) * 2 + (c >> 5), rr = r & 15, cc = c & 31, ob = rr * 64 + cc * 2; return st * 1024 + (ob ^ (((ob >> 9) & 1) << 5)); }
__host__ __device__ __forceinline__ int perm32(int rho) { const int n = rho >> 4, i = rho & 15; return 8 * (i >> 2) + 4 * n + (i & 3); }
__host__ __device__ __forceinline__ void stage_rc(int b, int& R, int& C) { const int st = b / 1024, sb = b % 1024, swz = sb ^ (((sb >> 9) & 1) << 5); R = (st >> 1) * 16 + swz / 64; C = (st & 1) * 32 + (swz % 64) / 2; }
struct Unit { int pm, pn, seg; };
struct Gemm { const h16* A; const h16* Bt; int M, N, K; const h16* A2; const h16* Bt2; };
struct StaticOrder {
    int nM, nN, nwg, G, c, segs;
    __host__ __device__ void init(int M, int N, int G_, int c_, int segs_ = 1) { nM = M / BM; nN = N / BM; nwg = nM * nN; G = G_; c = c_; segs = segs_; }
    __host__ __device__ bool next(int i, Unit& u) const {
        u.seg = segs == 2 ? (i & 1) : 0; if (segs == 2) i >>= 1;
        const long L = (long)i * G + c; if (L >= nwg) return false;
        int wgid = (int)L; { const int q = nwg / NXCD, r = nwg % NXCD, xcd = wgid % NXCD, off = wgid / NXCD; wgid = (xcd < r ? xcd * (q + 1) : r * (q + 1) + (xcd - r) * q) + off; }
        const int nig = WGM * nN, gid = wgid / nig, fm = gid * WGM, gsz = (nM - fm) < WGM ? (nM - fm) : WGM;
        u.pm = fm + ((wgid % nig) % gsz); u.pn = (wgid % nig) / gsz; return true;
    }
};
template <class Epi>
__device__ __forceinline__ void gemm_phase(LAS unsigned char* lds, const Gemm g, const StaticOrder& S, const Epi& E, int wv) {
    int tid = wv * 64 + lane_id(); asm volatile("" : "+v"(tid));
    const int wid = __builtin_amdgcn_readfirstlane(tid >> 6), lane = tid & 63, wr = wid >> 2, wc = wid & 3, fr = lane & 15, fq = lane >> 4;
    const int K = g.K, nt = K / BK;
    unsigned voffA[2], voffBp[2];
#pragma unroll
    for (int i = 0; i < 2; ++i) { int R, C; stage_rc(tid * 16 + i * 8192, R, C); voffA[i] = (unsigned)(R * K + C) * 2u; voffBp[i] = (unsigned)(((R & ~31) + perm32(R & 31)) * K + C) * 2u; }
    const size_t kstep = (size_t)(BK * 2);
    const size_t hstep = (size_t)HALF * K * 2;
    const size_t tstep = 2 * hstep;
    const unsigned ldsw = (unsigned)wid * 1024u;
    const int aoff = lds_byte(wr * 64 + fr, fq * 8), boff = lds_byte(wc * 32 + fr, fq * 8);
#define PG8_SA(b, h) (((b) * 2 + (h)) * HTB)
#define PG8_SB(b, h) ((4 + (b) * 2 + (h)) * HTB)
#define PG8_STAGE(bufoff, gbase) do { _Pragma("unroll") for (int _i = 0; _i < 2; ++_i) \
        __builtin_amdgcn_global_load_lds((const unsigned*)((const char*)(gbase) + voffA[_i]), (LAS unsigned*)(lds + (bufoff) + ldsw + _i * 8192), 16, 0, 0); } while (0)
#define PG8_STAGEB(bufoff, gbase, pf) do { _Pragma("unroll") for (int _i = 0; _i < 2; ++_i) \
        __builtin_amdgcn_global_load_lds((const unsigned*)((const char*)(gbase) + ((pf) ? voffBp[_i] : voffA[_i])), (LAS unsigned*)(lds + (bufoff) + ldsw + _i * 8192), 16, 0, 0); } while (0)
#define PG8_LDA(dst, b, h) do { _Pragma("unroll") for (int m = 0; m < 4; ++m) _Pragma("unroll") for (int k = 0; k < 2; ++k) dst[m][k] = *(const LAS h16x8*)(lds + PG8_SA(b, h) + aoff + m * 2048 + k * 1024); } while (0)
#define PG8_LDB(dst, b, h) do { _Pragma("unroll") for (int n = 0; n < 2; ++n) _Pragma("unroll") for (int k = 0; k < 2; ++k) dst[n][k] = *(const LAS h16x8*)(lds + PG8_SB(b, h) + boff + n * 2048 + k * 1024); } while (0)
#define PG8_MMA(ai, bj, At, Bt) do { __builtin_amdgcn_s_setprio(1); _Pragma("unroll") for (int m = 0; m < 4; ++m) _Pragma("unroll") for (int n = 0; n < 2; ++n) _Pragma("unroll") for (int k = 0; k < 2; ++k) \
        acc[ai][bj][m][n] = __builtin_amdgcn_mfma_f32_16x16x32_f16(Bt[n][k], At[m][k], acc[ai][bj][m][n], 0, 0, 0); __builtin_amdgcn_s_setprio(0); } while (0)
#define PG8_WAIT_V(n) asm volatile("s_waitcnt vmcnt(" #n ")" ::: "memory")
#define PG8_WAIT_L(n) asm volatile("s_waitcnt lgkmcnt(" #n ")" ::: "memory")
#define PG8_BAR __builtin_amdgcn_s_barrier()
#define PG8_SCHED __builtin_amdgcn_sched_barrier(0)
    Unit cur, nxt; int ui = 0;
    if (!S.next(0, cur)) return;
    f32x4 acc[2][2][4][2];
#pragma unroll
    for (int a = 0; a < 2; ++a)
#pragma unroll
        for (int b = 0; b < 2; ++b)
#pragma unroll
            for (int m = 0; m < 4; ++m)
#pragma unroll
                for (int n = 0; n < 2; ++n) acc[a][b][m][n] = (f32x4){0.f, 0.f, 0.f, 0.f};
    h16x8 At[4][2], B0[2][2], B1[2][2];
    const char* cA = (const char*)g.A + (size_t)cur.pm * tstep; const char* cB = (const char*)g.Bt + (size_t)cur.pn * tstep;
    bool pfc = Epi::perm(cur.pn);
    PG8_STAGEB(PG8_SB(0, 0), cB, pfc); PG8_STAGE(PG8_SA(0, 0), cA); PG8_STAGEB(PG8_SB(0, 1), cB + hstep, pfc); PG8_STAGE(PG8_SA(0, 1), cA + hstep);
    if (wr == 1) PG8_BAR;
    PG8_WAIT_V(4); PG8_BAR;
    PG8_STAGEB(PG8_SB(1, 0), cB + kstep, pfc); PG8_STAGE(PG8_SA(1, 0), cA + kstep); PG8_STAGEB(PG8_SB(1, 1), cB + hstep + kstep, pfc);
    PG8_WAIT_V(6); PG8_BAR;
    for (;;) {
        const bool has_next = S.next(ui + 1, nxt);
        const char* nA = has_next ? (const char*)((Epi::TWO_SEG && nxt.seg) ? g.A2 : g.A) + (size_t)nxt.pm * tstep : cA; const char* nB = has_next ? (const char*)((Epi::TWO_SEG && nxt.seg) ? g.Bt2 : g.Bt) + (size_t)nxt.pn * tstep : cB;
        const bool pfn = has_next ? Epi::perm(nxt.pn) : pfc;
        for (int t = 0; t < nt; t += 2) {
            const bool last = (t == nt - 2);
            const char* a1 = cA + (size_t)(t + 1) * kstep;
            const char* a2 = last ? nA : cA + (size_t)(t + 2) * kstep; const char* b2 = last ? nB : cB + (size_t)(t + 2) * kstep;
            const char* a3 = a2 + kstep; const char* b3 = b2 + kstep;
            const bool pf2 = last ? pfn : pfc;
            PG8_LDB(B0, 0, 0); PG8_SCHED; PG8_LDA(At, 0, 0); PG8_STAGE(PG8_SA(1, 1), a1 + hstep);
            PG8_WAIT_L(8); PG8_BAR; PG8_WAIT_L(0); PG8_MMA(0, 0, At, B0); PG8_BAR; PG8_SCHED;
            PG8_LDB(B1, 0, 1); PG8_STAGEB(PG8_SB(0, 0), b2, pf2);
            PG8_BAR; PG8_WAIT_L(0); PG8_MMA(0, 1, At, B1); PG8_BAR;
            PG8_LDA(At, 0, 1); PG8_STAGE(PG8_SA(0, 0), a2);
            PG8_BAR; PG8_WAIT_L(0); PG8_MMA(1, 0, At, B0); PG8_BAR; PG8_SCHED;
            PG8_STAGEB(PG8_SB(0, 1), b2 + hstep, pf2);
            PG8_WAIT_V(6); PG8_BAR; PG8_MMA(1, 1, At, B1); PG8_BAR;
            PG8_LDB(B0, 1, 0); PG8_SCHED; PG8_LDA(At, 1, 0); PG8_STAGE(PG8_SA(0, 1), a2 + hstep);
            PG8_WAIT_L(8); PG8_BAR; PG8_WAIT_L(0); PG8_MMA(0, 0, At, B0); PG8_BAR; PG8_SCHED;
            PG8_LDB(B1, 1, 1); PG8_STAGEB(PG8_SB(1, 0), b3, pf2);
            PG8_BAR; PG8_WAIT_L(0); PG8_MMA(0, 1, At, B1); PG8_BAR;
            PG8_LDA(At, 1, 1); PG8_STAGE(PG8_SA(1, 0), a3);
            PG8_BAR; PG8_WAIT_L(0); PG8_MMA(1, 0, At, B0); PG8_BAR; PG8_SCHED;
            PG8_STAGEB(PG8_SB(1, 1), b3 + hstep, pf2);
            PG8_WAIT_V(6); PG8_BAR; PG8_MMA(1, 1, At, B1); PG8_BAR;
        }
        if constexpr (Epi::TWO_SEG) { if (cur.seg == 0) E.mid(acc, cur, wr, wc, fr, fq); else E(acc, cur, wr, wc, fr, fq); }
        else if constexpr (!Epi::AFTER_DRAIN) E(acc, cur, wr, wc, fr, fq);
        if (!has_next) break;
        if (!(Epi::TWO_SEG && nxt.seg))
#pragma unroll
        for (int a = 0; a < 2; ++a)
#pragma unroll
            for (int b = 0; b < 2; ++b)
#pragma unroll
                for (int m = 0; m < 4; ++m)
#pragma unroll
                    for (int n = 0; n < 2; ++n) acc[a][b][m][n] = (f32x4){0.f, 0.f, 0.f, 0.f};
        cur = nxt; cA = nA; cB = nB; pfc = pfn; ++ui;
    }
    PG8_WAIT_V(0);
    if (wr == 0) PG8_BAR;
    PG8_BAR;
    if constexpr (Epi::AFTER_DRAIN) E.fused(acc, cur, wr, wc, fr, fq, lane);
#undef PG8_SA
#undef PG8_SB
#undef PG8_STAGE
#undef PG8_STAGEB
#undef PG8_LDA
#undef PG8_LDB
#undef PG8_MMA
#undef PG8_WAIT_V
#undef PG8_WAIT_L
#undef PG8_BAR
#undef PG8_SCHED
}
}
using pg8::Unit;
typedef f32x4 Acc[2][2][4][2];

__device__ __forceinline__ void st4h(h16* p, f32x4 v) { h16x4 o; o[0] = (h16)v[0]; o[1] = (h16)v[1]; o[2] = (h16)v[2]; o[3] = (h16)v[3]; *(h16x4*)p = o; }
__device__ __forceinline__ void st8h(h16* p, f32x4 a, f32x4 b) { h16x8 o; o[0] = (h16)a[0]; o[1] = (h16)a[1]; o[2] = (h16)a[2]; o[3] = (h16)a[3]; o[4] = (h16)b[0]; o[5] = (h16)b[1]; o[6] = (h16)b[2]; o[7] = (h16)b[3]; *(h16x8*)p = o; }
__device__ __forceinline__ void ld8h(const h16* p, f32x4& a, f32x4& b) { const h16x8 o = *(const h16x8*)p; a = (f32x4){(float)o[0], (float)o[1], (float)o[2], (float)o[3]}; b = (f32x4){(float)o[4], (float)o[5], (float)o[6], (float)o[7]}; }
__device__ __forceinline__ f32x4 ld4h(const h16* p) { const h16x4 o = *(const h16x4*)p; return (f32x4){(float)o[0], (float)o[1], (float)o[2], (float)o[3]}; }
__device__ __forceinline__ float sumsq4(f32x4 v) { return (v[0] * v[0] + v[1] * v[1]) + (v[2] * v[2] + v[3] * v[3]); }
__device__ __forceinline__ float sigmoidf_(float x) { return __builtin_amdgcn_rcpf(1.0f + __expf(-x)); }
__device__ __forceinline__ float logsigmoidf_(float z) { return fminf(z, 0.f) - __logf(1.0f + __expf(-fabsf(z))); }
__device__ __forceinline__ float wave_sum(float v) {
#pragma unroll
    for (int o = 1; o < 64; o <<= 1) v += __shfl_xor(v, o);
    return v;
}

struct EpiInProj {
    static constexpr bool AFTER_DRAIN = false, TWO_SEG = false;
    static __device__ __forceinline__ bool perm(int pn) { return pn == 5 || pn >= 11; }
    unsigned char* ws; const float* b_f;
    __device__ __forceinline__ void operator()(const Acc& acc, const Unit& u, int wr, int wc, int fr, int fq) const {
        const int pn = u.pn, row0 = u.pm * 256 + wr * 64 + fr;
        const float* ROPE = (const float*)(ws + WS_ROPE);
        float nmax[2] = {0.f, 0.f};
#pragma unroll
        for (int ai = 0; ai < 2; ++ai)
#pragma unroll
            for (int m = 0; m < 4; ++m) {
                const int row = row0 + ai * 128 + m * 16, b = row >> 12, t = row & 4095;
                const float* rp = ROPE + (size_t)row * 48;
#pragma unroll
                for (int bj = 0; bj < 2; ++bj) {
                    f32x4 v0 = acc[ai][bj][m][0], v1 = acc[ai][bj][m][1];
                    const int d0 = 32 * wc + 4 * fq;
                    const int d8 = 32 * wc + 8 * fq;
                    if (pn < 6) {
                        size_t off;
                        if (pn < 4) off = WS_QA + (((size_t)(b * HA + pn * 2 + bj) * T + t) * HD) * 2;
                        else off = (pn == 4 ? WS_KA : WS_VA) + (((size_t)(b * HAKV + bj) * T + t) * HD) * 2;
                        h16* dst = (h16*)(ws + off);
                        if (pn < 5 && wc == 0) {
                            const f32x4 c = *(const f32x4*)(rp + 4 * fq), s = *(const f32x4*)(rp + 16 + 4 * fq);
                            const f32x4 y0 = v0 * c - v1 * s, y1 = v1 * c + v0 * s; v0 = y0; v1 = y1;
                        }
                        if (pn == 5) st8h(dst + d8, v0, v1); else { st4h(dst + d0, v0); st4h(dst + d0 + 16, v1); }
                    } else if (pn < 11) {
                        const bool is_q = pn < 10;
                        if (is_q || bj == 0) {
                            if (is_q || wc < 2) {
                                const int dd = 32 * (wc & 1) + 4 * fq;
                                const size_t off = is_q ? WS_QI + ((size_t)row * 1024 + ((pn - 6) * 4 + 2 * bj + (wc >> 1)) * 64) * 2 : WS_KI + ((size_t)row * 64) * 2;
                                h16* dst = (h16*)(ws + off);
                                if ((wc & 1) == 0) {
                                    f32x4 pr;
#pragma unroll
                                    for (int j = 0; j < 4; ++j) pr[j] = __shfl_xor(v0[j], 32);
                                    const f32x4 c = *(const f32x4*)(rp + 32 + 4 * (fq & 1)), s = *(const f32x4*)(rp + 40 + 4 * (fq & 1));
                                    v0 = (fq < 2) ? (v0 * c - pr * s) : (v0 * c + pr * s);
                                }
                                st4h(dst + dd, v0); st4h(dst + dd + 16, v1);
                            } else if (wc == 2) {
                                *(f32x4*)((float*)(ws + WS_WI) + (size_t)row * 16 + 4 * fq) = v0 * 0.03125f;
                                if (fq < 2) { const f32x4 bf = *(const f32x4*)(b_f + 4 * fq); f32x4 o;
#pragma unroll
                                    for (int j = 0; j < 4; ++j) o[j] = logsigmoidf_(v1[j] + bf[j]);
                                    float* lf = (float*)(ws + WS_LOGF) + ((size_t)(b * HB + 4 * fq)) * T + t;
#pragma unroll
                                    for (int j = 0; j < 4; ++j) lf[(size_t)j * T] = o[j]; }
                            }
                        }
                    } else if (pn < 23) {
                        const int q = pn - 11, which = q >> 2, head = (q & 3) * 2 + bj;
                        h16* dst = (h16*)(ws + WS_QB + (size_t)which * (WS_KB - WS_QB)) + ((size_t)(b * HB + head) * T + t) * HD;
                        st8h(dst + d8, v0, v1);
                        if (which < 2) { float ps = sumsq4(v0) + sumsq4(v1); ps += __shfl_xor(ps, 16); ps += __shfl_xor(ps, 32); nmax[bj] = fmaxf(nmax[bj], ps); }
                    } else {
                        const int q = pn - 23; const int col = (q & 7) * 256 + 128 * bj + d8;
                        h16* base = (h16*)(ws + WS_SIGA + (size_t)(q >> 3) * (WS_SIGB - WS_SIGA));
#pragma unroll
                        for (int j = 0; j < 4; ++j) { v0[j] = sigmoidf_(v0[j]); v1[j] = sigmoidf_(v1[j]); }
                        st8h(base + (size_t)row * DM + col, v0, v1);
                    }
                }
            }
        if (pn >= 11 && pn < 19) {
            const int q = pn - 11, which = q >> 2, bq = u.pm >> 4, qb = u.pm & 15; unsigned* nrm = (unsigned*)(ws + WS_NORM);
#pragma unroll
            for (int bj = 0; bj < 2; ++bj) { float mx = nmax[bj];
#pragma unroll
                for (int o = 1; o < 16; o <<= 1) mx = fmaxf(mx, __shfl_xor(mx, o));
                const int bh = bq * HB + (q & 3) * 2 + bj;
                if (fr == 0 && fq == 0) atomicMax(which == 0 ? nrm + (bh * 16 + qb) * 4 + wc : nrm + 1024 + bh * 4 + wc, __float_as_uint(mx)); }
        }
    }
};
static_assert(WS_VB - WS_KB == WS_KB - WS_QB, "QB/KB/VB equally spaced");
template <bool FIRST> struct EpiGate {
    static constexpr bool AFTER_DRAIN = false, TWO_SEG = false;
    static __device__ __forceinline__ bool perm(int) { return true; }
    const h16* SIG; h16* MIXED;
    __device__ __forceinline__ void operator()(const Acc& acc, const Unit& u, int wr, int wc, int fr, int fq) const {
        const int row0 = u.pm * 256 + wr * 64 + fr, col0 = u.pn * 256 + 32 * wc + 8 * fq;
#pragma unroll
        for (int ai = 0; ai < 2; ++ai)
#pragma unroll
            for (int m = 0; m < 4; ++m)
#pragma unroll
                for (int bj = 0; bj < 2; ++bj) { const size_t off = (size_t)(row0 + ai * 128 + m * 16) * DM + col0 + bj * 128;
                    f32x4 s0, s1; ld8h(SIG + off, s0, s1); f32x4 v0 = s0 * acc[ai][bj][m][0], v1 = s1 * acc[ai][bj][m][1];
                    if (!FIRST) { f32x4 m0, m1; ld8h(MIXED + off, m0, m1); v0 += m0; v1 += m1; }
                    st8h(MIXED + off, v0, v1); }
    }
};
struct EpiGate2 {
    static constexpr bool AFTER_DRAIN = false, TWO_SEG = true;
    static __device__ __forceinline__ bool perm(int) { return true; }
    const h16* SA; const h16* SB; h16* MIXED;
    __device__ __forceinline__ void mid(Acc& acc, const Unit& u, int wr, int wc, int fr, int fq) const {
        const int row0 = u.pm * 256 + wr * 64 + fr, col0 = u.pn * 256 + 32 * wc + 8 * fq;
#pragma unroll
        for (int ai = 0; ai < 2; ++ai)
#pragma unroll
            for (int m = 0; m < 4; ++m)
#pragma unroll
                for (int bj = 0; bj < 2; ++bj) { const size_t off = (size_t)(row0 + ai * 128 + m * 16) * DM + col0 + bj * 128;
                    f32x4 a0, a1, b0, b1; ld8h(SA + off, a0, a1); ld8h(SB + off, b0, b1);
#pragma unroll
                    for (int j = 0; j < 4; ++j) { acc[ai][bj][m][0][j] *= a0[j] * __builtin_amdgcn_rcpf(fmaxf(b0[j], 1e-30f)); acc[ai][bj][m][1][j] *= a1[j] * __builtin_amdgcn_rcpf(fmaxf(b1[j], 1e-30f)); } }
    }
    __device__ __forceinline__ void operator()(const Acc& acc, const Unit& u, int wr, int wc, int fr, int fq) const {
        const int row0 = u.pm * 256 + wr * 64 + fr, col0 = u.pn * 256 + 32 * wc + 8 * fq;
#pragma unroll
        for (int ai = 0; ai < 2; ++ai)
#pragma unroll
            for (int m = 0; m < 4; ++m)
#pragma unroll
                for (int bj = 0; bj < 2; ++bj) { const size_t off = (size_t)(row0 + ai * 128 + m * 16) * DM + col0 + bj * 128;
                    f32x4 b0, b1; ld8h(SB + off, b0, b1);
#pragma unroll
                    for (int j = 0; j < 4; ++j) { b0[j] = fmaxf(b0[j], 1e-30f); b1[j] = fmaxf(b1[j], 1e-30f); }
                    st8h(MIXED + off, b0 * acc[ai][bj][m][0], b1 * acc[ai][bj][m][1]); }
    }
};
template <bool BASE_F32> struct EpiResidNorm {
    static constexpr bool AFTER_DRAIN = false, TWO_SEG = false;
    static __device__ __forceinline__ bool perm(int) { return true; }
    const float* BASE; h16* XH; float* RS;
    __device__ __forceinline__ void operator()(const Acc& acc, const Unit& u, int wr, int wc, int fr, int fq) const {
        const int row0 = u.pm * 256 + wr * 64 + fr, col0 = u.pn * 256 + 32 * wc + 8 * fq;
#pragma unroll
        for (int ai = 0; ai < 2; ++ai)
#pragma unroll
            for (int m = 0; m < 4; ++m) { const int row = row0 + ai * 128 + m * 16; float ss = 0.f;
#pragma unroll
                for (int bj = 0; bj < 2; ++bj) { const size_t off = (size_t)row * DM + col0 + bj * 128;
                    f32x4 b0, b1; if (BASE_F32) { b0 = *(const f32x4*)(BASE + off); b1 = *(const f32x4*)(BASE + off + 4); } else ld8h(XH + off, b0, b1);
                    const f32x4 v0 = b0 + acc[ai][bj][m][0], v1 = b1 + acc[ai][bj][m][1]; st8h(XH + off, v0, v1); ss += sumsq4(v0) + sumsq4(v1); }
                ss += __shfl_xor(ss, 16); ss += __shfl_xor(ss, 32);
                if (fq == 0) atomicAdd(RS + row, ss); }
    }
};
struct EpiSwiGLU {
    static constexpr bool AFTER_DRAIN = false, TWO_SEG = false;
    static __device__ __forceinline__ bool perm(int) { return false; }
    h16* ACT; const float* RS;
    __device__ __forceinline__ void operator()(const Acc& acc, const Unit& u, int wr, int wc, int fr, int fq) const {
        const int row0 = u.pm * 256 + wr * 64 + fr;
#pragma unroll
        for (int ai = 0; ai < 2; ++ai)
#pragma unroll
            for (int m = 0; m < 4; ++m) { const int row = row0 + ai * 128 + m * 16; const float r = __builtin_amdgcn_rsqf(RS[row] * (1.0f / DM) + EPS);
#pragma unroll
                for (int bj = 0; bj < 2; ++bj) { const f32x4 g = acc[ai][bj][m][0] * r, uu = acc[ai][bj][m][1] * r; f32x4 o;
#pragma unroll
                    for (int j = 0; j < 4; ++j) o[j] = g[j] * sigmoidf_(g[j]) * uu[j];
                    st4h(ACT + (size_t)row * DFF + 16 * (u.pn * 8 + bj * 4 + wc) + 4 * fq, o); } }
    }
};
struct EpiStoreH {
    static constexpr bool AFTER_DRAIN = false, TWO_SEG = false;
    static __device__ __forceinline__ bool perm(int) { return true; }
    h16* O; int ldc;
    __device__ __forceinline__ void operator()(const Acc& acc, const Unit& u, int wr, int wc, int fr, int fq) const {
        const int row0 = u.pm * 256 + wr * 64 + fr, col0 = u.pn * 256 + 32 * wc + 8 * fq;
#pragma unroll
        for (int ai = 0; ai < 2; ++ai)
#pragma unroll
            for (int m = 0; m < 4; ++m)
#pragma unroll
                for (int bj = 0; bj < 2; ++bj) st8h(O + (size_t)(row0 + ai * 128 + m * 16) * ldc + col0 + bj * 128, acc[ai][bj][m][0], acc[ai][bj][m][1]);
    }
};
struct EpiPLE {
    static constexpr bool AFTER_DRAIN = false, TWO_SEG = false;
    static __device__ __forceinline__ bool perm(int) { return true; }
    const h16* PP; const h16* XI; h16* XO; const float* RSIN; float* RSOUT;
    __device__ __forceinline__ void operator()(const Acc& acc, const Unit& u, int wr, int wc, int fr, int fq) const {
        const int row0 = u.pm * 256 + wr * 64 + fr, col0 = u.pn * 256 + 32 * wc + 8 * fq;
#pragma unroll
        for (int ai = 0; ai < 2; ++ai)
#pragma unroll
            for (int m = 0; m < 4; ++m) { const int row = row0 + ai * 128 + m * 16; const float r = __builtin_amdgcn_rsqf(RSIN[row] * (1.0f / DM) + EPS); float ss = 0.f;
#pragma unroll
                for (int bj = 0; bj < 2; ++bj) { const size_t off = (size_t)row * DM + col0 + bj * 128;
                    const f32x4 a0 = acc[ai][bj][m][0] * r, a1 = acc[ai][bj][m][1] * r; f32x4 p0, p1, x0, x1; ld8h(PP + off, p0, p1); ld8h(XI + off, x0, x1);
#pragma unroll
                    for (int j = 0; j < 4; ++j) { x0[j] += sigmoidf_(a0[j]) * p0[j]; x1[j] += sigmoidf_(a1[j]) * p1[j]; }
                    st8h(XO + off, x0, x1); ss += sumsq4(x0) + sumsq4(x1); }
                ss += __shfl_xor(ss, 16); ss += __shfl_xor(ss, 32);
                if (fq == 0) atomicAdd(RSOUT + row, ss); }
    }
};

struct EpiPLEFinal {
    static constexpr bool AFTER_DRAIN = true, TWO_SEG = false;
    static __device__ __forceinline__ bool perm(int) { return true; }
    const h16* PP; const h16* XI; float* OUT; const float* RSIN; float* RSOUT; const float* gfin; unsigned* cnt;
    __device__ __forceinline__ void operator()(const Acc&, const Unit&, int, int, int, int) const {}
    __device__ __forceinline__ void fused(Acc& acc, const Unit& u, int wr, int wc, int fr, int fq, int lane) const {
        const int row0 = u.pm * 256 + wr * 64 + fr, col0 = u.pn * 256 + 32 * wc + 8 * fq;
#pragma unroll
        for (int ai = 0; ai < 2; ++ai)
#pragma unroll
            for (int m = 0; m < 4; ++m) { const int row = row0 + ai * 128 + m * 16; const float r = __builtin_amdgcn_rsqf(RSIN[row] * (1.0f / DM) + EPS); float ss = 0.f;
#pragma unroll
                for (int bj = 0; bj < 2; ++bj) { const size_t off = (size_t)row * DM + col0 + bj * 128;
                    const f32x4 a0 = acc[ai][bj][m][0] * r, a1 = acc[ai][bj][m][1] * r; f32x4 p0, p1, x0, x1; ld8h(PP + off, p0, p1); ld8h(XI + off, x0, x1);
#pragma unroll
                    for (int j = 0; j < 4; ++j) { x0[j] += sigmoidf_(a0[j]) * p0[j]; x1[j] += sigmoidf_(a1[j]) * p1[j]; }
                    acc[ai][bj][m][0] = x0; acc[ai][bj][m][1] = x1; ss += sumsq4(x0) + sumsq4(x1); }
                ss += __shfl_xor(ss, 16); ss += __shfl_xor(ss, 32);
                if (fq == 0) atomicAdd(RSOUT + row, ss); }
        asm volatile("s_waitcnt vmcnt(0)" ::: "memory");
        unsigned* c = cnt + 64 * u.pm;
        if (lane == 0) __hip_atomic_fetch_add(c, 1u, __ATOMIC_RELAXED, __HIP_MEMORY_SCOPE_AGENT);
        { unsigned spins = 0;
          while ((unsigned)__builtin_amdgcn_readfirstlane((int)__hip_atomic_load(c, __ATOMIC_RELAXED, __HIP_MEMORY_SCOPE_AGENT)) < 64u) { __builtin_amdgcn_s_sleep(2); if (++spins > (1u << 22)) break; } }
#pragma unroll
        for (int ai = 0; ai < 2; ++ai)
#pragma unroll
            for (int m = 0; m < 4; ++m) { const int row = row0 + ai * 128 + m * 16;
                const float r = __builtin_amdgcn_rsqf(__hip_atomic_load(RSOUT + row, __ATOMIC_RELAXED, __HIP_MEMORY_SCOPE_AGENT) * (1.0f / DM) + EPS);
#pragma unroll
                for (int bj = 0; bj < 2; ++bj) { const size_t off = (size_t)row * DM + col0 + bj * 128;
                    const f32x4 g0 = *(const f32x4*)(gfin + col0 + bj * 128), g1 = *(const f32x4*)(gfin + col0 + bj * 128 + 4);
                    *(f32x4*)(OUT + off) = acc[ai][bj][m][0] * r * g0; *(f32x4*)(OUT + off + 4) = acc[ai][bj][m][1] * r * g1; } }
    }
};

__device__ __forceinline__ int map_in(int p) {
    if (p < 2560) return p;
    if (p < 2816) { const int c = p - 2560; if (c < 64) return 2560 + c; if (c < 80) return 2624 + (c - 64); if (c < 88) return 5712 + (c - 80); return -1; }
    const int q = p - 2816; if (q < 3072) return 2640 + q; return 5720 + (q - 3072);
}
template <int MODE>
__device__ __forceinline__ const float* tr_src(const float* W0, const float* W1, int Nsrc, int n) {
    if (MODE == 0) return n < Nsrc ? W0 + n : nullptr;
    if (MODE == 1) { const int c = map_in(n); return c >= 0 ? W0 + c : nullptr; }
    return (((n >> 4) & 1) ? W1 : W0) + 16 * (n >> 5) + (n & 15);
}
template <int MODE>
__device__ __forceinline__ void ph_transpose(const float* W0, const float* W1, const float* gk, int K, int Nsrc, h16* WT, int Nphys, LAS float* scr, int gw, int NGW, int lane) {
    const int nblk = Nphys / 32, nitems = (K / 64) * nblk;
    const int lr = lane >> 3, lc = (lane & 7) * 4;
    f32x4 cur[8], nxt[8];
    int item = gw;
    if (item < nitems) { const int kb = item / nblk, nb = item % nblk; const float* src = tr_src<MODE>(W0, W1, Nsrc, 32 * nb + lc);
#pragma unroll
        for (int i = 0; i < 8; ++i) cur[i] = src ? __builtin_nontemporal_load((const f32x4*)(src + (size_t)(64 * kb + lr + 8 * i) * Nsrc)) : (f32x4){0.f, 0.f, 0.f, 0.f}; }
    for (; item < nitems; item += NGW) {
        const int kb = item / nblk, nb = item % nblk, k0 = 64 * kb, n0 = 32 * nb;
        const int itn = item + NGW;
        if (itn < nitems) { const int kbn = itn / nblk, nbn = itn % nblk; const float* src = tr_src<MODE>(W0, W1, Nsrc, 32 * nbn + lc);
#pragma unroll
            for (int i = 0; i < 8; ++i) nxt[i] = src ? __builtin_nontemporal_load((const f32x4*)(src + (size_t)(64 * kbn + lr + 8 * i) * Nsrc)) : (f32x4){0.f, 0.f, 0.f, 0.f}; }
#pragma unroll
        for (int i = 0; i < 8; ++i) { LAS float* d = scr + (lr + 8 * i) * 33 + lc; const float gg = gk ? gk[k0 + lr + 8 * i] : 1.0f; d[0] = cur[i][0] * gg; d[1] = cur[i][1] * gg; d[2] = cur[i][2] * gg; d[3] = cur[i][3] * gg; }
        __builtin_amdgcn_wave_barrier(); asm volatile("s_waitcnt lgkmcnt(0)" ::: "memory");
        const int c = lane & 7;
#pragma unroll
        for (int j = 0; j < 4; ++j) { const int nn = (lane >> 3) + 8 * j; const LAS float* sp = scr + (8 * c) * 33 + nn;
            h16x8 o;
#pragma unroll
            for (int e = 0; e < 8; ++e) o[e] = (h16)sp[e * 33];
            *(h16x8*)(WT + (size_t)(n0 + nn) * K + k0 + 8 * c) = o; }
        __builtin_amdgcn_wave_barrier(); asm volatile("s_waitcnt lgkmcnt(0)" ::: "memory");
#pragma unroll
        for (int i = 0; i < 8; ++i) cur[i] = nxt[i];
    }
}
__device__ __forceinline__ void sincos_f32arg(float ang, float& sn, float& cs) {
    const double a = (double)ang;
    const double rev = a * 0.15915494309189535;
    const double fr = rev - __builtin_rint(rev);
    const double q4 = fr * 4.0; const double qi = __builtin_rint(q4); const int qq = ((int)qi) & 3;
    const double r = (q4 - qi) * 1.5707963267948966;
    const double r2 = r * r;
    const double s = r * (1.0 + r2 * (-1.0 / 6 + r2 * (1.0 / 120 + r2 * (-1.0 / 5040 + r2 * (1.0 / 362880 + r2 * (-1.0 / 39916800))))));
    const double c = 1.0 + r2 * (-0.5 + r2 * (1.0 / 24 + r2 * (-1.0 / 720 + r2 * (1.0 / 40320 + r2 * (-1.0 / 3628800 + r2 * (1.0 / 479001600))))));
    double so, co;
    if (qq == 0) { so = s; co = c; } else if (qq == 1) { so = c; co = -s; } else if (qq == 2) { so = -s; co = -c; } else { so = -c; co = s; }
    sn = (float)so; cs = (float)co;
}
__device__ __forceinline__ void ph_rope(const int* pos, float* ROPE, int gtid, int NGT) {
    for (int idx = gtid; idx < MTOK * 24; idx += NGT) {
        const int tok = idx / 24, i = idx % 24, k = i < 16 ? i : 2 * (i - 16);
        float f = 0x1.000000p+0f;
        f = k == 1 ? 0x1.c2ef76p-2f : f; f = k == 2 ? 0x1.8d275ep-3f : f; f = k == 3 ? 0x1.5dc95ap-4f : f; f = k == 4 ? 0x1.341190p-5f : f; f = k == 5 ? 0x1.0f5384p-6f : f;
        f = k == 6 ? 0x1.ddee9cp-8f : f; f = k == 7 ? 0x1.a4ee3ep-9f : f; f = k == 8 ? 0x1.72ba44p-10f : f; f = k == 9 ? 0x1.468318p-11f : f; f = k == 10 ? 0x1.1f91f0p-12f : f;
        f = k == 11 ? 0x1.fa8b84p-14f : f; f = k == 12 ? 0x1.be218ap-15f : f; f = k == 13 ? 0x1.88ec22p-16f : f; f = k == 14 ? 0x1.5a0f50p-17f : f; f = k == 15 ? 0x1.30c94ep-18f : f;
        const float ang = (float)pos[tok] * f;
        float sn, cs; sincos_f32arg(ang, sn, cs);
        float* rp = ROPE + (size_t)tok * 48;
        if (i < 16) { rp[i] = cs; rp[16 + i] = sn; } else { rp[32 + (i - 16)] = cs; rp[40 + (i - 16)] = sn; }
    }
}
template <bool TO_F32>
__device__ __forceinline__ void ph_rmsnorm(const float* X, const float* g, h16* OUTH, float* OUTF, int gw, int NGW, int lane) {
    for (int row = gw; row < MTOK; row += NGW) {
        const f32x4* xr = (const f32x4*)(X + (size_t)row * DM) + lane;
        f32x4 v[8]; float s = 0.f;
#pragma unroll
        for (int j = 0; j < 8; ++j) { v[j] = __builtin_nontemporal_load(xr + 64 * j); s += (v[j][0] * v[j][0] + v[j][1] * v[j][1]) + (v[j][2] * v[j][2] + v[j][3] * v[j][3]); }
        const float r = 1.0f / sqrtf(wave_sum(s) * (1.0f / DM) + EPS);
#pragma unroll
        for (int j = 0; j < 8; ++j) { const f32x4 gg = *((const f32x4*)g + lane + 64 * j); const f32x4 o = v[j] * r * gg;
            if (TO_F32) *((f32x4*)(OUTF + (size_t)row * DM) + lane + 64 * j) = o; else st4h(OUTH + (size_t)row * DM + 4 * (lane + 64 * j), o); }
    }
}
__device__ __forceinline__ void ph_final(const h16* X, float* OUT, const float* g, const float* RS, int gw, int NGW, int lane) {
    for (int row = gw; row < MTOK; row += NGW) {
        const float r = __builtin_amdgcn_rsqf(RS[row] * (1.0f / DM) + EPS);
        h16x8 v[4];
#pragma unroll
        for (int j = 0; j < 4; ++j) v[j] = *((const h16x8*)(X + (size_t)row * DM) + lane + 64 * j);
#pragma unroll
        for (int j = 0; j < 4; ++j) { const float* gp = g + 8 * (lane + 64 * j); float* op = OUT + (size_t)row * DM + 8 * (lane + 64 * j);
            const f32x4 g0 = *(const f32x4*)gp, g1 = *(const f32x4*)(gp + 4);
            f32x4 o0 = {(float)v[j][0], (float)v[j][1], (float)v[j][2], (float)v[j][3]}, o1 = {(float)v[j][4], (float)v[j][5], (float)v[j][6], (float)v[j][7]};
            *(f32x4*)op = o0 * r * g0; *(f32x4*)(op + 4) = o1 * r * g1; }
    }
}
__device__ __forceinline__ unsigned fkey(float f) { const unsigned u = __float_as_uint(f + 0.0f); return (u & 0x80000000u) ? ~u : (u | 0x80000000u); }
template <int N> __device__ __forceinline__ unsigned dpp_row_shl(unsigned v) { return (unsigned)__builtin_amdgcn_update_dpp(0, (int)v, 0x100 + N, 0xf, 0xf, true); }
__device__ __forceinline__ unsigned row_suffix(unsigned v) { v += dpp_row_shl<1>(v); v += dpp_row_shl<2>(v); v += dpp_row_shl<4>(v); v += dpp_row_shl<8>(v); return v; }
template <int LVL>
__device__ __forceinline__ void hist_level(const unsigned (&key)[64], int nj, int lane, LAS unsigned* hist, LAS unsigned* dummy, unsigned& prefix, unsigned& need, unsigned& cnt_eq) {
    constexpr int SH = LVL == 0 ? 21 : (LVL == 1 ? 10 : 0), PSH = LVL == 1 ? 21 : 10, NB = LVL == 2 ? 10 : 11;
#pragma unroll
    for (int i = 0; i < 8; ++i) *(LAS u32x4*)(hist + i * 256 + lane * 4) = (u32x4){0u, 0u, 0u, 0u};
    asm volatile("s_waitcnt lgkmcnt(0)" ::: "memory"); __builtin_amdgcn_wave_barrier();
#pragma unroll
    for (int j8 = 0; j8 < 8; ++j8) {
        if (8 * j8 < nj) {
            if (LVL == 0) {
#pragma unroll
                for (int j = 8 * j8; j < 8 * j8 + 8; ++j) __hip_atomic_fetch_add(hist + (key[j] >> 21), 1u, __ATOMIC_RELAXED, __HIP_MEMORY_SCOPE_WORKGROUP);
            } else {
                bool any = false;
#pragma unroll
                for (int j = 8 * j8; j < 8 * j8 + 8; ++j) any = any || ((key[j] >> PSH) == prefix);
                if (LVL == 1 || __any(any)) {
#pragma unroll
                    for (int j = 8 * j8; j < 8 * j8 + 8; ++j) { const unsigned k = key[j];
                        LAS unsigned* tgt = ((k >> PSH) == prefix) ? hist + ((k >> SH) & ((1u << NB) - 1u)) : dummy;
                        __hip_atomic_fetch_add(tgt, 1u, __ATOMIC_RELAXED, __HIP_MEMORY_SCOPE_WORKGROUP); }
                }
            }
        }
    }
    asm volatile("s_waitcnt lgkmcnt(0)" ::: "memory"); __builtin_amdgcn_wave_barrier();
    unsigned s = 0;
#pragma unroll
    for (int i = 0; i < 8; ++i) { const u32x4 v = *(const LAS u32x4*)(hist + lane * 32 + 4 * i); s += (v[0] + v[1]) + (v[2] + v[3]); }
    unsigned S = row_suffix(s);
    { const unsigned t1 = (unsigned)__builtin_amdgcn_readlane((int)S, 16), t2 = (unsigned)__builtin_amdgcn_readlane((int)S, 32), t3 = (unsigned)__builtin_amdgcn_readlane((int)S, 48);
      const int row = lane >> 4; S += row == 0 ? t1 + t2 + t3 : (row == 1 ? t2 + t3 : (row == 2 ? t3 : 0u)); }
    const int L = 63 - __builtin_clzll(__ballot(S >= need));
    const unsigned aboveL = (unsigned)__builtin_amdgcn_readlane((int)(S - s), L);
    const int bi = lane & 31;
    const unsigned hb = hist[L * 32 + bi];
    unsigned R = row_suffix(hb);
    { const unsigned u1 = (unsigned)__builtin_amdgcn_readlane((int)R, 16); R += (lane & 16) ? 0u : u1; }
    const int B = 31 - __builtin_clz((unsigned)__ballot(aboveL + R >= need));
    const unsigned abB = (unsigned)__builtin_amdgcn_readlane((int)(aboveL + R - hb), B);
    cnt_eq = (unsigned)__builtin_amdgcn_readlane((int)hb, B);
    prefix = (prefix << NB) | (unsigned)(L * 32 + B);
    need -= abB;
    __builtin_amdgcn_wave_barrier();
}
__device__ __forceinline__ u64 topk_select_hist(const unsigned (&key)[64], int nvalid, int lane, LAS unsigned* hist, LAS unsigned* dummy) {
    const int nj = (nvalid + 63) >> 6;
    unsigned prefix = 0, need = TOPK, cnt_eq = 0;
    hist_level<0>(key, nj, lane, hist, dummy, prefix, need, cnt_eq);
    hist_level<1>(key, nj, lane, hist, dummy, prefix, need, cnt_eq);
    if (need != cnt_eq) hist_level<2>(key, nj, lane, hist, dummy, prefix, need, cnt_eq);
    else prefix <<= 10;
    u64 mw = 0;
    if (need == cnt_eq) {
        LAS u64* bw = (LAS u64*)hist;
#pragma unroll
        for (int j = 0; j < 64; ++j) bw[j] = __ballot(key[j] >= prefix);
        asm volatile("s_waitcnt lgkmcnt(0)" ::: "memory"); __builtin_amdgcn_wave_barrier();
        mw = bw[lane];
        asm volatile("s_waitcnt lgkmcnt(0)" ::: "memory"); __builtin_amdgcn_wave_barrier();
    } else {
        int nd = (int)need;
#pragma unroll
        for (int j = 0; j < 64; ++j) { u64 eq = __ballot(key[j] == prefix); const u64 gt = __ballot(key[j] > prefix);
            int pc = __builtin_popcountll(eq);
            while (pc > nd) { eq &= ~(1ull << (63 - __builtin_clzll(eq))); --pc; }
            nd -= pc; if (lane == j) mw = gt | eq; }
    }
    return mw;
}
namespace idx {
typedef short s16x8 __attribute__((ext_vector_type(8)));
typedef float f32x16 __attribute__((ext_vector_type(16)));
constexpr int CHK = 128, CHB = CHK * 128;
__device__ __forceinline__ unsigned half_sum(unsigned v) {
#pragma unroll
    for (int o = 1; o < 32; o <<= 1) v += __shfl_xor(v, o);
    return v;
}
__device__ __forceinline__ void run_group(unsigned char* ws, char* lds, unsigned* scr, int b, int g, int wv) {
    int tid = wv * 64 + lane_id(); asm volatile("" : "+v"(tid));
    const int wid = __builtin_amdgcn_readfirstlane(tid >> 6), lane = tid & 63, c = lane & 31, hi = lane >> 5;
    const int t0 = 16 * g + 2 * wid, t = t0 + hi, row = b * T + t, tmaxblk = 16 * g + 15, nch = (tmaxblk >> 7) + 1;
    const h16* QI = (const h16*)(ws + WS_QI); const char* KIb = (const char*)ws + WS_KI + (size_t)b * T * 128; const float* WI = (const float*)(ws + WS_WI);
    s16x8 A[4];
    { const int rho = c, qsel = (rho >> 2) & 1, head = (rho & 3) + 4 * (rho >> 3);
      const h16* qp = QI + (size_t)(b * T + t0 + qsel) * 1024 + head * 64 + 8 * hi;
#pragma unroll
      for (int ks = 0; ks < 4; ++ks) A[ks] = *reinterpret_cast<const s16x8*>(qp + 16 * ks); }
    float w[16];
    { const f32x4* wp = (const f32x4*)(WI + (size_t)row * 16);
#pragma unroll
      for (int i = 0; i < 4; ++i) { const f32x4 v = wp[i]; w[4 * i] = v[0]; w[4 * i + 1] = v[1]; w[4 * i + 2] = v[2]; w[4 * i + 3] = v[3]; } }
    const int pr0 = tid >> 3, pp = tid & 7;
    const unsigned g_off = (unsigned)(pr0 * 128 + pp * 16);
    const int l_off0 = pr0 * 128 + ((pp ^ ((pr0 >> 1) & 7)) << 4), l_off1 = l_off0 + 64 * 128;
    const int rd_base = c * 128; const int sw = (c >> 1) & 7;
    int rd_off[4];
#pragma unroll
    for (int ks = 0; ks < 4; ++ks) rd_off[ks] = rd_base + (((2 * ks + hi) ^ sw) << 4);
    unsigned* myscr = scr + (size_t)(2 * wid + hi) * T + c;
    asm volatile("" :: "v"(A[0]), "v"(A[1]), "v"(A[2]), "v"(A[3]), "v"(w[0]), "v"(w[4]), "v"(w[8]), "v"(w[12]));
    s16x8 st0, st1;
    { const char* src = KIb; st0 = *reinterpret_cast<const s16x8*>(src + g_off); st1 = *reinterpret_cast<const s16x8*>(src + 64 * 128 + g_off); }
    *reinterpret_cast<s16x8*>(lds + l_off0) = st0; *reinterpret_cast<s16x8*>(lds + l_off1) = st1;
    __syncthreads();
#pragma unroll 1
    for (int ch = 0; ch < nch; ++ch) {
        const char* buf = lds + (ch & 1) * CHB;
        if (ch + 1 < nch) { const char* src = KIb + (size_t)(ch + 1) * CHB; st0 = *reinterpret_cast<const s16x8*>(src + g_off); st1 = *reinterpret_cast<const s16x8*>(src + 64 * 128 + g_off); }
#pragma unroll
        for (int st = 0; st < 4; ++st) {
            f32x16 acc = {};
#pragma unroll
            for (int ks = 0; ks < 4; ++ks) { const s16x8 Bf = *reinterpret_cast<const s16x8*>(buf + st * 4096 + rd_off[ks]);
                acc = __builtin_amdgcn_mfma_f32_32x32x16_f16(__builtin_bit_cast(h16x8, A[ks]), __builtin_bit_cast(h16x8, Bf), acc, 0, 0, 0); }
            float sc = 0.f;
#pragma unroll
            for (int r = 0; r < 16; ++r) { const int ri = __float_as_int(acc[r]); sc = fmaf(w[r], __int_as_float(ri > 0 ? ri : 0), sc); }
            const int sidx = ch * CHK + st * 32 + c;
            myscr[ch * CHK + st * 32] = (sidx <= t) ? fkey(sc) : 0u;
        }
        if (ch + 1 < nch) { char* dst = lds + ((ch + 1) & 1) * CHB; *reinterpret_cast<s16x8*>(dst + l_off0) = st0; *reinterpret_cast<s16x8*>(dst + l_off1) = st1; }
        __syncthreads();
    }
    asm volatile("s_waitcnt vmcnt(0)" ::: "memory");
    u64* MASK = (u64*)(ws + WS_MASK);
#pragma unroll 1
    for (int qq = 0; qq < 2; ++qq) {
        const int tq = t0 + qq, nj = (tq >> 6) + 1;
        const unsigned* src = scr + (size_t)(2 * wid + qq) * T + lane;
        unsigned key[64];
#pragma unroll
        for (int j = 0; j < 64; ++j) key[j] = (j < nj) ? __hip_atomic_load(src + 64 * j, __ATOMIC_RELAXED, __HIP_MEMORY_SCOPE_AGENT) : 0u;
        u64 mw;
        if (tq + 1 <= TOPK) {
            mw = 0;
#pragma unroll
            for (int j = 0; j < 4; ++j) { const u64 bal = __ballot(key[j] != 0u); if (lane == j) mw = bal; }
        } else mw = topk_select_hist(key, tq + 1, lane, (LAS unsigned*)(lds + 2 * CHB + wid * 8192), (LAS unsigned*)(lds + 2 * CHB + 8 * 8192 + wid * 256) + lane);
        MASK[(size_t)(b * T + tq) * 64 + lane] = mw;
    }
}
}

namespace att {
constexpr int NW = 8, QBLK = 32, KVBLK = 64, QB = NW * QBLK, D = 128;
constexpr int SHM_V = KVBLK * D * 2, SHM_K = KVBLK * D * 2;
constexpr int LDS_NEED = 2 * SHM_V + 2 * SHM_K + NW * 64 * 4;
constexpr float THR = 8.f, SCALE = 0.08838834764831845f;
typedef short s16x8 __attribute__((ext_vector_type(8)));
typedef short s16x4 __attribute__((ext_vector_type(4)));
typedef float f32x16 __attribute__((ext_vector_type(16)));
#define KSWZ(row, colB) ((row) * 256 + ((colB) ^ (((row) & 7) << 4)))
#define SBAR() __builtin_amdgcn_sched_barrier(0)
__device__ __forceinline__ int v_st(int k, int c) { const int kk = (k & ~0xC) | ((k & 4) << 1) | ((k & 8) >> 1); return ((kk >> 3) * 4 + (c >> 5)) * 512 + ((kk & 7) * 32 + (c & 31)) * 2; }
__device__ __forceinline__ int v_rd_base(int lane) { return ((lane & 3) << 3) | (((lane >> 2) & 3) << 6) | (((lane >> 4) & 1) << 5) | (((lane >> 5) & 1) << 8); }
constexpr int v_rd_off(int d0, int ks, int half) { return d0 * 512 + ks * 4096 + half * 2048; }
__device__ __forceinline__ int crow(int r, int hi) { return (r & 3) + 8 * (r >> 2) + 4 * hi; }
__device__ __forceinline__ unsigned cvtpk(float lo, float hi) { unsigned r; asm volatile("v_cvt_pk_f16_f32 %0, %1, %2" : "=v"(r) : "v"(lo), "v"(hi)); return r; }
__device__ __forceinline__ f32x16 mfma16(s16x8 a, s16x8 b, f32x16 c) { return __builtin_amdgcn_mfma_f32_32x32x16_f16(__builtin_bit_cast(h16x8, a), __builtin_bit_cast(h16x8, b), c, 0, 0, 0); }
__device__ __forceinline__ s16x8 load8(const h16* p) { return *reinterpret_cast<const s16x8*>(p); }
__device__ __forceinline__ void mask_causal(f32x16& p0, f32x16& p1, int dq) {
    const float NEG = -__builtin_inff();
#pragma unroll
    for (int r = 0; r < 16; ++r) { const int c = (r & 3) + 8 * (r >> 2); if (dq - c < 0) p0[r] = NEG; if (dq - c - 32 < 0) p1[r] = NEG; }
}
__device__ __forceinline__ void partialSM(f32x16& p0, f32x16& p1, float& m_reg, float& mn, float& alpha) {
    float pmax = p0[0]; for (int r = 1; r < 16; ++r) pmax = fmaxf(pmax, p0[r]); for (int r = 0; r < 16; ++r) pmax = fmaxf(pmax, p1[r]);
    { auto rr = __builtin_amdgcn_permlane32_swap(__float_as_uint(pmax), __float_as_uint(pmax), false, false);
      pmax = fmaxf(__uint_as_float(rr[0]), __uint_as_float(rr[1])); }
    constexpr float C2 = 1.4426950408889634f * SCALE;
    if (__builtin_expect(__all((pmax - m_reg) * SCALE <= THR), 1)) { mn = m_reg; alpha = 1.f; }
    else { mn = fmaxf(m_reg, pmax); alpha = __builtin_amdgcn_exp2f((m_reg - mn) * C2); m_reg = mn; }
    const float mnL = -mn * C2;
    for (int r = 0; r < 16; ++r) p0[r] = fmaf(p0[r], C2, mnL); for (int r = 0; r < 16; ++r) p1[r] = fmaf(p1[r], C2, mnL);
    for (int r = 0; r < 16; ++r) p0[r] = __builtin_amdgcn_exp2f(p0[r]);
}
__device__ __forceinline__ void finishSM(f32x16& p0, f32x16& p1, float alpha, float& l_reg, s16x8& pa0, s16x8& pa1, s16x8& pa2, s16x8& pa3) {
    for (int r = 0; r < 16; ++r) p1[r] = __builtin_amdgcn_exp2f(p1[r]);
    float ps = 0; for (int r = 0; r < 16; ++r) ps += p0[r]; for (int r = 0; r < 16; ++r) ps += p1[r];
    { auto rr = __builtin_amdgcn_permlane32_swap(__float_as_uint(ps), __float_as_uint(ps), false, false);
      ps = __uint_as_float(rr[0]) + __uint_as_float(rr[1]); }
    l_reg = l_reg * alpha + ps;
#define PK4(P, B_, OUT) do { unsigned a0 = cvtpk(P[B_+0], P[B_+1]), a1 = cvtpk(P[B_+2], P[B_+3]);                          \
        unsigned b0 = cvtpk(P[B_+4], P[B_+5]), b1 = cvtpk(P[B_+6], P[B_+7]);                                             \
        auto r0 = __builtin_amdgcn_permlane32_swap(a0, b0, false, false); auto r1 = __builtin_amdgcn_permlane32_swap(a1, b1, false, false); \
        u32x4 w = {r0[0], r1[0], r0[1], r1[1]}; OUT = *reinterpret_cast<s16x8*>(&w); } while (0)
    PK4(p0, 0, pa0); PK4(p0, 8, pa1); PK4(p1, 0, pa2); PK4(p1, 8, pa3);
#undef PK4
}
template <int KB>
__device__ __forceinline__ void qkt(f32x16& p0, f32x16& p1, const char* K_lds, int r32, int hi, const s16x8* qr) {
    const char* kb[4];
#pragma unroll
    for (int dd = 0; dd < 4; ++dd) kb[dd] = K_lds + KB * SHM_K + KSWZ(r32, (dd * 16 + hi * 8) * 2);
#pragma unroll
    for (int d0 = 0; d0 < 8; ++d0) { const char* a = kb[d0 & 3] + (d0 >> 2) * 128;
        s16x8 b0 = *reinterpret_cast<const s16x8*>(a);
        s16x8 b1 = *reinterpret_cast<const s16x8*>(a + 32 * 256);
        p0 = mfma16(b0, qr[d0], p0);
        p1 = mfma16(b1, qr[d0], p1); }
}
template <int VB>
__device__ __forceinline__ void pv_tile(f32x16* o, int vb0, s16x8 pa0, s16x8 pa1, s16x8 pa2, s16x8 pa3) {
#define TRRD(dst, off) asm volatile("ds_read_b64_tr_b16 %0, %1 offset:%2" : "=&v"(dst) : "v"(vb0), "i"(off) : "memory")
#define PV_D0(d0) do { s16x4 l0, l1, l2, l3, h0, h1, h2, h3; constexpr int b_ = VB * SHM_V + v_rd_off(d0, 0, 0); \
        TRRD(l0, b_); TRRD(h0, b_ + 2048); TRRD(l1, b_ + 4096); TRRD(h1, b_ + 6144); TRRD(l2, b_ + 8192); TRRD(h2, b_ + 10240); TRRD(l3, b_ + 12288); TRRD(h3, b_ + 14336); \
        asm volatile("s_waitcnt lgkmcnt(0)" ::: "memory"); SBAR();   \
        o[d0] = mfma16(pa0, (s16x8){l0[0], l0[1], l0[2], l0[3], h0[0], h0[1], h0[2], h0[3]}, o[d0]);   \
        o[d0] = mfma16(pa1, (s16x8){l1[0], l1[1], l1[2], l1[3], h1[0], h1[1], h1[2], h1[3]}, o[d0]);   \
        o[d0] = mfma16(pa2, (s16x8){l2[0], l2[1], l2[2], l2[3], h2[0], h2[1], h2[2], h2[3]}, o[d0]);   \
        o[d0] = mfma16(pa3, (s16x8){l3[0], l3[1], l3[2], l3[3], h3[0], h3[1], h3[2], h3[3]}, o[d0]); } while (0)
    PV_D0(0); PV_D0(1); PV_D0(2); PV_D0(3);
#undef PV_D0
#undef TRRD
}
struct BlockRef { const char* Q; const char* K; const char* V; char* O; int P0; const char* NBQ; const char* MK;
                  int j0, nt;
                  int part;
                  char* PART; unsigned* flag; };
struct Seam { s16x8 qr[8]; };
#define LD16(base, off) (*reinterpret_cast<const s16x8*>((base) + (off)))
#define VMW() asm volatile("s_waitcnt vmcnt(0)" ::: "memory")
#define VMWN(n) asm volatile("s_waitcnt vmcnt(%0)" :: "i"(n) : "memory")
#define SLOAD_H(Kp, Vp, k0) do { const char* vb_ = (Vp) + (size_t)(k0) * (D * 2); const char* kb_ = (Kp) + (size_t)(k0) * (D * 2); \
        st_v0 = LD16(vb_, st_off); st_v1 = LD16(vb_ + 32 * D * 2, st_off); st_k0 = LD16(kb_, st_off); st_k1 = LD16(kb_ + 32 * D * 2, st_off); } while (0)
#define SWRITE_HK(bf) do { *(s16x8*)(K_lds + (bf) * SHM_K + kws) = st_k0; *(s16x8*)(K_lds + (bf) * SHM_K + kws + 32 * 256) = st_k1; } while (0)
#define SWRITE_HV(bf) do { *(s16x8*)(V_lds + (bf) * SHM_V + vst0) = st_v0; *(s16x8*)(V_lds + (bf) * SHM_V + vst1) = st_v1; } while (0)
#define SWRITE_H(bf) do { SWRITE_HV(bf); SWRITE_HK(bf); } while (0)
__device__ __forceinline__ void prime(const BlockRef& cur, char* lds, Seam& S, int wv) {
    int tid = wv * 64 + lane_id(); asm volatile("" : "+v"(tid));
    const int wid = __builtin_amdgcn_readfirstlane(tid >> 6), lane = tid & 63, r32 = lane & 31, hi = lane >> 5;
    const unsigned q_off = (unsigned)((wid * QBLK + r32) * D + hi * 8) * 2u;
#pragma unroll
    for (int d0 = 0; d0 < 8; ++d0) S.qr[d0] = LD16(cur.Q + d0 * 32, q_off);
}
template <bool MIXB, int ROLE>
__device__ __forceinline__ void block(const BlockRef& cur, const BlockRef& nxt, char* lds, Seam& S, int wv) {
    constexpr bool CONS = ROLE == 2;
    int tid = wv * 64 + lane_id(); asm volatile("" : "+v"(tid));
    const int wid = __builtin_amdgcn_readfirstlane(tid >> 6), lane = tid & 63, r32 = lane & 31, hi = lane >> 5;
    int NT = cur.nt, J0 = cur.j0;
    const int qlo = cur.P0 + wid * QBLK, qm = qlo + r32 - 4 * hi;
    char* V_lds = lds; char* K_lds = lds + 2 * SHM_V;
    float* wsf = (float*)(lds + 2 * SHM_V + 2 * SHM_K) + wid * 64; float* li_l = wsf, * al_l = wsf + 32;
    float m_reg = -1e30f, l_reg = 0; f32x16 o[4] = {};
    const int sr = tid >> 4, sc = (tid & 15) * 8, vst0 = v_st(sr, sc), vst1 = v_st(32 + sr, sc), kws = KSWZ(sr, sc * 2);
    const int vb0 = (int)(uintptr_t)V_lds + v_rd_base(lane);
    const unsigned st_off = (unsigned)(sr * D + sc) * 2u, q_off = (unsigned)((wid * QBLK + r32) * D + hi * 8) * 2u;
    const unsigned nb_off = (unsigned)hi * 16u, mk_off = (unsigned)(wid * QBLK + r32) * 512u;
    const char* Kh = cur.K; const char* Vh = cur.V;
    const char* bias_l = lds + LDS_NEED;
    if (MIXB) {
        float* cs = (float*)bias_l; float* wtot = (float*)(lds + LDS_NEED + 16384);
        const int L = cur.P0 + QB; const float* lf = (const float*)cur.NBQ;
        float v[8];
        if (8 * tid < L) { const f32x4 a = *(const f32x4*)(lf + 8 * tid), b4 = *(const f32x4*)(lf + 8 * tid + 4); v[0] = a[0]; v[1] = a[1]; v[2] = a[2]; v[3] = a[3]; v[4] = b4[0]; v[5] = b4[1]; v[6] = b4[2]; v[7] = b4[3]; }
        else {
#pragma unroll
            for (int i = 0; i < 8; ++i) v[i] = 0.f; }
#pragma unroll
        for (int i = 1; i < 8; ++i) v[i] += v[i - 1];
        float inc = v[7];
#pragma unroll
        for (int o_ = 1; o_ < 64; o_ <<= 1) { const float nb = __shfl_up(inc, o_); if (lane >= o_) inc += nb; }
        if (lane == 63) wtot[wid] = inc;
        __syncthreads();
        float base = inc - v[7];
#pragma unroll
        for (int w_ = 0; w_ < 7; ++w_) base += (w_ < wid) ? wtot[w_] : 0.f;
        if (8 * tid < L) {
#pragma unroll
            for (int i = 0; i < 8; ++i) cs[8 * tid + i] = (base + v[i]) * -11.313708498984761f; }
        __syncthreads();
        { const float qk2 = __int_as_float(cur.j0);
          const int s_ = 64 * lane + 63; const float dc = (s_ < cur.P0) ? (cs[s_] - cs[cur.P0]) * SCALE : 0.f;
          const bool keep = (s_ >= cur.P0) || (qk2 + dc >= -40.0f);
          J0 = __builtin_ctzll(__ballot(keep)); NT = cur.P0 / KVBLK + 4 - J0; }
        const float nbref = cs[L - 1];
        __syncthreads();
        for (int i = J0 * KVBLK + tid; i < L; i += NW * 64) cs[i] -= nbref;
        __syncthreads(); }
#define RESC(a) do { if (__any((a) < 1.f)) { if (hi == 0) al_l[r32] = (a); asm volatile("s_waitcnt lgkmcnt(0)" ::: "memory");              \
                     for (int d_ = 0; d_ < 4; ++d_) for (int r = 0; r < 16; ++r) o[d_][r] *= al_l[crow(r, hi)]; } } while (0)
#define KBASE(t) ((J0 + (t)) * KVBLK)
#define MKW(t) (*(const u64*)(cur.MK + (size_t)(J0 + (t)) * 8 + mk_off))
#define PINIT(P0_, P1_, t, MW_) do { if (MIXB) { const char* nb_ = bias_l + KBASE(t) * 4 + nb_off; _Pragma("unroll") for (int g_ = 0; g_ < 4; ++g_) { \
            const f32x4 b0_ = *(const f32x4*)(nb_ + 32 * g_), b1_ = *(const f32x4*)(nb_ + 128 + 32 * g_); \
            _Pragma("unroll") for (int j_ = 0; j_ < 4; ++j_) { P0_[4 * g_ + j_] = b0_[j_]; P1_[4 * g_ + j_] = b1_[j_]; } } } else { const u64 w_ = (MW_); const unsigned lo_ = (unsigned)w_ >> (4 * hi), up_ = (unsigned)(w_ >> 32) >> (4 * hi); \
            _Pragma("unroll") for (int r_ = 0; r_ < 16; ++r_) { const int c_ = (r_ & 3) + 8 * (r_ >> 2); \
                P0_[r_] = __uint_as_float((((lo_ >> c_) & 1u) - 1u) & 0xff800000u); P1_[r_] = __uint_as_float((((up_ >> c_) & 1u) - 1u) & 0xff800000u); } } } while (0)
#define MASKT(P0_, P1_, t, MW_) do { if (MIXB) { const int kb_ = KBASE(t); if (kb_ + KVBLK - 1 > qlo) mask_causal(P0_, P1_, qm - kb_); } } while (0)
    f32x16 pA0, pA1, pB0, pB1; float mnA, mnB, alA, alB; s16x8 pa0, pa1, pa2, pa3;
    u64 mwA = 0, mwB = 0;
    if (!MIXB) { mwA = MKW(0); if (NT > 1) mwB = MKW(1); }
    PINIT(pA0, pA1, 0, mwA); if (!MIXB) { if (NT > 2) mwA = MKW(2); }
    if (NT > 1) { PINIT(pB0, pB1, 1, mwB); if (!MIXB) { if (NT > 3) mwB = MKW(3); } }
    s16x8 st_v0, st_v1, st_k0, st_k1;
    SLOAD_H(Kh, Vh, KBASE(0)); VMW(); SWRITE_HK(0); SWRITE_HV(0); SBAR();
    __syncthreads();
    if (NT > 1) SLOAD_H(Kh, Vh, KBASE(1));
    SBAR(); qkt<0>(pA0, pA1, K_lds, r32, hi, S.qr);
    MASKT(pA0, pA1, 0, mwA);
    partialSM(pA0, pA1, m_reg, mnA, alA);
    if (NT > 1) { VMW(); SWRITE_H(1); }
    __syncthreads();
#define HALF_STEP(PX0, PX1, mnX, alX, MWX, PY0, PY1, alY, MWY, t, KB, VB, SB) do {                                               \
        SBAR(); qkt<KB>(PX0, PX1, K_lds, r32, hi, S.qr);                                                                      \
        finishSM(PY0, PY1, alY, l_reg, pa0, pa1, pa2, pa3); SBAR();                                                           \
        if ((t) + 1 < NT) { PINIT(PY0, PY1, (t) + 1, MWY); if (!MIXB) { if ((t) + 3 < NT) MWY = MKW((t) + 3); } SLOAD_H(Kh, Vh, KBASE((t) + 1)); SBAR(); }                             \
        pv_tile<VB>(o, vb0, pa0, pa1, pa2, pa3); MASKT(PX0, PX1, (t), MWX); \
        partialSM(PX0, PX1, m_reg, mnX, alX);                                                                                 \
        __syncthreads();                                                                                                      \
        if ((t) + 1 < NT) { VMW(); SWRITE_H(SB); }                                                                            \
        RESC(alX); __syncthreads(); } while (0)
    for (int t = 1; t + 1 < NT; t += 2) {
        HALF_STEP(pB0, pB1, mnB, alB, mwB, pA0, pA1, alA, mwA, t, 1, 0, 0);
        HALF_STEP(pA0, pA1, mnA, alA, mwA, pB0, pB1, alB, mwB, t + 1, 0, 1, 1);
    }
    const bool even = (NT & 1) == 0;
    if (even) { SBAR(); qkt<1>(pB0, pB1, K_lds, r32, hi, S.qr); SBAR(); }
    if (!CONS) {
#pragma unroll
        for (int d0 = 0; d0 < 8; ++d0) S.qr[d0] = LD16(nxt.Q + d0 * 32, q_off); }
    SBAR();
    finishSM(pA0, pA1, alA, l_reg, pa0, pa1, pa2, pa3); SBAR();
    pv_tile<0>(o, vb0, pa0, pa1, pa2, pa3);
    if (even) { MASKT(pB0, pB1, NT - 1, mwB); partialSM(pB0, pB1, m_reg, mnB, alB); __syncthreads(); RESC(alB);
        finishSM(pB0, pB1, alB, l_reg, pa0, pa1, pa2, pa3); SBAR(); pv_tile<1>(o, vb0, pa0, pa1, pa2, pa3); }
    constexpr float C2E = 1.4426950408889634f * SCALE;
    if (!CONS && cur.part == 1) {
        float* po = (float*)cur.PART + (size_t)wid * (64 * 64) + lane;
#pragma unroll
        for (int d0 = 0; d0 < 4; ++d0)
#pragma unroll
            for (int r = 0; r < 16; ++r) po[(d0 * 16 + r) * 64] = o[d0][r];
        float* pml = (float*)cur.PART + 8 * 64 * 64 + wid * 128;
        pml[lane] = m_reg; pml[64 + lane] = l_reg;
        asm volatile("s_waitcnt vmcnt(0)" ::: "memory");
        __syncthreads();
        if (tid == 0) { __builtin_amdgcn_fence(__ATOMIC_RELEASE, "agent"); asm volatile("s_waitcnt vmcnt(0)" ::: "memory"); __hip_atomic_store(cur.flag, 1u, __ATOMIC_RELAXED, __HIP_MEMORY_SCOPE_AGENT); }
    } else {
        float a_me = 1.f;
        if (CONS) {
            if (tid == 0) { unsigned spins = 0; while (__hip_atomic_load(cur.flag, __ATOMIC_RELAXED, __HIP_MEMORY_SCOPE_AGENT) == 0u) { __builtin_amdgcn_s_sleep(4); if (++spins > (1u << 22)) break; }
                __builtin_amdgcn_fence(__ATOMIC_ACQUIRE, "agent"); asm volatile("s_waitcnt vmcnt(0)" ::: "memory"); }
            __syncthreads();
            const float* pml = (const float*)cur.PART + 8 * 64 * 64 + wid * 128;
            const float m2 = pml[lane], l2 = pml[64 + lane];
            const float mm = fmaxf(m_reg, m2); a_me = __builtin_amdgcn_exp2f((m_reg - mm) * C2E); const float a_ot = __builtin_amdgcn_exp2f((m2 - mm) * C2E);
            l_reg = l_reg * a_me + l2 * a_ot;
            if (hi == 0) { li_l[r32] = a_me; al_l[r32] = a_ot; } asm volatile("s_waitcnt lgkmcnt(0)" ::: "memory");
            const float* po = (const float*)cur.PART + (size_t)wid * (64 * 64) + lane;
#pragma unroll
            for (int r = 0; r < 16; ++r) { const float fa = li_l[crow(r, hi)], fb = al_l[crow(r, hi)];
#pragma unroll
                for (int d0 = 0; d0 < 4; ++d0) o[d0][r] = o[d0][r] * fa + po[(d0 * 16 + r) * 64] * fb; }
            asm volatile("s_waitcnt lgkmcnt(0)" ::: "memory");
        }
        if (hi == 0) li_l[r32] = l_reg; asm volatile("s_waitcnt lgkmcnt(0)" ::: "memory");
        float rli[16];
#pragma unroll
        for (int r = 0; r < 16; ++r) rli[r] = __builtin_amdgcn_rcpf(li_l[crow(r, hi)]);
        const unsigned o_off = (unsigned)((wid * QBLK + 4 * hi) * 1024 + r32) * 2u;
#pragma unroll
        for (int r = 0; r < 16; ++r) {
#pragma unroll
            for (int d0 = 0; d0 < 4; ++d0) { const float v = o[d0][r] * rli[r];
                const float vn = __shfl_xor(v, 1);
                if ((r32 & 1) == 0) *(unsigned*)(cur.O + (size_t)(((r & 3) + 8 * (r >> 2)) * 2048 + d0 * 64) + o_off) = cvtpk(v, vn); } }
    }
    __syncthreads();
#undef RESC
#undef KBASE
#undef PINIT
#undef MKW
#undef MASKT
#undef HALF_STEP
}
#undef LD16
#undef VMW
#undef VMWN
#undef SLOAD_H
#undef SWRITE_HK
#undef SWRITE_HV
#undef SWRITE_H
constexpr int SCHED_MAXI = 3;
__device__ const signed char HSPLIT[8][8] = {{11, 35, 17, 35, 35, 24, 34, 46}, {24, 15, 23, 23, 24, 33, 46, 29}, {12, 19, 19, 11, 5, 32, 35, 33}, {26, 34, 8, 22, 23, 46, 12, 34}, {12, 24, 39, 31, 25, 21, 35, 45}, {9, 13, 22, 23, 46, 29, 13, 36}, {11, 8, 23, 35, 16, 29, 25, 20}, {11, 15, 23, 12, 45, 35, 23, 46}};
__device__ const short SCHED[256][3] = {
  {129, 112, -1},
  {5152, 5360, 130},
  {145, 5040, -1},
  {880, 4352, 146},
  {161, 1584, 4512},
  {4480, 4320, 162},
  {177, 4960, -1},
  {1648, 178, -1},
  {193, 5072, -1},
  {1328, 5344, 194},
  {209, 1296, 5088},
  {1312, 210, -1},
  {225, 5440, -1},
  {1808, 4576, 226},
  {241, -1, -1},
  {1056, 5712, 242},
  {385, 5232, 5056},
  {368, 386, -1},
  {401, 1120, -1},
  {5552, 4448, 402},
  {417, 1040, 5760},
  {48, 5376, 418},
  {433, 1552, 5584},
  {5248, 5280, 434},
  {449, 5312, 4704},
  {816, 450, -1},
  {465, 5968, -1},
  {6128, 5184, 466},
  {481, -1, -1},
  {576, 4784, 482},
  {497, 1792, 4368},
  {4240, 498, -1},
  {641, 1600, 4752},
  {5472, 5648, 642},
  {657, 592, -1},
  {32, 5264, 658},
  {673, 1568, 5504},
  {5904, 4736, 674},
  {689, 1136, -1},
  {4544, 690, -1},
  {705, 1632, 4272},
  {706, -1, -1},
  {721, 1280, 5888},
  {5680, 5536, 722},
  {737, 4976, -1},
  {5456, 4640, 738},
  {753, 6032, -1},
  {6000, 754, -1},
  {897, 256, 6064},
  {1616, 5024, 898},
  {913, 5520, -1},
  {1888, 4896, 914},
  {929, 96, 1024},
  {5200, 930, -1},
  {945, 6048, 4992},
  {4800, 4528, 946},
  {961, 16, 5840},
  {528, 4608, 962},
  {977, -1, -1},
  {336, 4880, 978},
  {993, 1904, -1},
  {994, -1, -1},
  {1009, 5600, -1},
  {544, 1010, -1},
  {1153, 1872, 4864},
  {5488, 5616, 1154},
  {1169, 272, 4816},
  {352, 1170, -1},
  {1185, 768, -1},
  {864, 5392, 1186},
  {1201, 800, -1},
  {304, 5168, 1202},
  {1217, 4832, 4400},
  {4416, 4128, 1218},
  {1233, 5936, 5408},
  {5792, 1234, -1},
  {1249, 4768, -1},
  {5568, 4672, 1250},
  {1265, -1, -1},
  {288, 4688, 1266},
  {1409, 80, 4288},
  {4592, 4224, 1410},
  {1425, 320, 4256},
  {4464, 4192, 1426},
  {1441, 5744, 5824},
  {6112, 5776, 1442},
  {1457, 784, 5872},
  {5136, 5328, 1458},
  {1473, -1, -1},
  {1376, 5008, 1474},
  {1489, 1536, 4176},
  {4496, 4144, 1490},
  {1505, 1088, 4208},
  {1506, -1, -1},
  {1521, 4336, -1},
  {512, 4160, 1522},
  {1665, 624, -1},
  {5728, 4912, 1666},
  {1681, 1104, 4720},
  {1824, 1682, -1},
  {1697, 64, -1},
  {1072, 4096, 1698},
  {1713, 4656, -1},
  {1392, 1714, -1},
  {1729, 1840, 4944},
  {5216, 1730, -1},
  {1745, 0, 4112},
  {4560, 4304, 1746},
  {1761, 6080, 5632},
  {5664, 1762, -1},
  {1777, 5984, 6016},
  {1778, -1, -1},
  {1921, 1856, 5808},
  {5424, 4432, 1922},
  {1937, 608, -1},
  {5696, 4624, 1938},
  {1953, 5856, 4848},
  {5920, 5952, 1954},
  {1969, 1344, 5104},
  {5296, 1970, -1},
  {1985, -1, -1},
  {848, 6096, 1986},
  {2001, 4928, -1},
  {560, 5120, 2002},
  {2017, 832, -1},
  {4384, 2018, -1},
  {2033, -1, -1},
  {1360, 2034, -1},
  {2177, 2160, -1},
  {7200, 7408, 2178},
  {2193, 7088, -1},
  {2928, 6400, 2194},
  {2209, 3632, 6560},
  {6528, 6368, 2210},
  {2225, 7008, -1},
  {3696, 2226, -1},
  {2241, 7120, -1},
  {3376, 7392, 2242},
  {2257, 3344, 7136},
  {3360, 2258, -1},
  {2273, 7488, -1},
  {3856, 6624, 2274},
  {2289, -1, -1},
  {3104, 7760, 2290},
  {2433, 7280, 7104},
  {2416, 2434, -1},
  {2449, 3168, -1},
  {7600, 6496, 2450},
  {2465, 3088, 7808},
  {2096, 7424, 2466},
  {2481, 3600, 7632},
  {7296, 7328, 2482},
  {2497, 7360, 6752},
  {2864, 2498, -1},
  {2513, 8016, -1},
  {8176, 7232, 2514},
  {2529, -1, -1},
  {2624, 6832, 2530},
  {2545, 3840, 6416},
  {6288, 2546, -1},
  {2689, 3648, 6800},
  {7520, 7696, 2690},
  {2705, 2640, -1},
  {2080, 7312, 2706},
  {2721, 3616, 7552},
  {7952, 6784, 2722},
  {2737, 3184, -1},
  {6592, 2738, -1},
  {2753, 3680, 6320},
  {2754, -1, -1},
  {2769, 3328, 7936},
  {7728, 7584, 2770},
  {2785, 7024, -1},
  {7504, 6688, 2786},
  {2801, 8080, -1},
  {8048, 2802, -1},
  {2945, 2304, 8112},
  {3664, 7072, 2946},
  {2961, 7568, -1},
  {3936, 6944, 2962},
  {2977, 2144, 3072},
  {7248, 2978, -1},
  {2993, 8096, 7040},
  {6848, 6576, 2994},
  {3009, 2064, 7888},
  {2576, 6656, 3010},
  {3025, -1, -1},
  {2384, 6928, 3026},
  {3041, 3952, -1},
  {3042, -1, -1},
  {3057, 7648, -1},
  {2592, 3058, -1},
  {3201, 3920, 6912},
  {7536, 7664, 3202},
  {3217, 2320, 6864},
  {2400, 3218, -1},
  {3233, 2816, -1},
  {2912, 7440, 3234},
  {3249, 2848, -1},
  {2352, 7216, 3250},
  {3265, 6880, 6448},
  {6464, 6176, 3266},
  {3281, 7984, 7456},
  {7840, 3282, -1},
  {3297, 6816, -1},
  {7616, 6720, 3298},
  {3313, -1, -1},
  {2336, 6736, 3314},
  {3457, 2128, 6336},
  {6640, 6272, 3458},
  {3473, 2368, 6304},
  {6512, 6240, 3474},
  {3489, 7792, 7872},
  {8160, 7824, 3490},
  {3505, 2832, 7920},
  {7184, 7376, 3506},
  {3521, -1, -1},
  {3424, 7056, 3522},
  {3537, 3584, 6224},
  {6544, 6192, 3538},
  {3553, 3136, 6256},
  {3554, -1, -1},
  {3569, 6384, -1},
  {2560, 6208, 3570},
  {3713, 2672, -1},
  {7776, 6960, 3714},
  {3729, 3152, 6768},
  {3872, 3730, -1},
  {3745, 2112, -1},
  {3120, 6144, 3746},
  {3761, 6704, -1},
  {3440, 3762, -1},
  {3777, 3888, 6992},
  {7264, 3778, -1},
  {3793, 2048, 6160},
  {6608, 6352, 3794},
  {3809, 8128, 7680},
  {7712, 3810, -1},
  {3825, 8032, 8064},
  {3826, -1, -1},
  {3969, 3904, 7856},
  {7472, 6480, 3970},
  {3985, 2656, -1},
  {7744, 6672, 3986},
  {4001, 7904, 6896},
  {7968, 8000, 4002},
  {4017, 3392, 7152},
  {7344, 4018, -1},
  {4033, -1, -1},
  {2896, 8144, 4034},
  {4049, 6976, -1},
  {2608, 7168, 4050},
  {4065, 2880, -1},
  {6432, 4066, -1},
  {4081, -1, -1},
  {3408, 4082, -1},
};

__device__ __forceinline__ BlockRef make_ref(int code, unsigned char* ws, const float* b_f) {
    const bool mixb = (code >> 12) != 0; int bh = (code >> 8) & 15; const int qb = (code >> 4) & 15, part = code & 15;
    if (mixb) { const int vr = bh & 7; int act = 0; float bv[8];
#pragma unroll
        for (int i = 0; i < 8; ++i) bv[i] = b_f[i];
#pragma unroll
        for (int i = 0; i < 8; ++i) { int rk = 0;
#pragma unroll
            for (int j2 = 0; j2 < 8; ++j2) rk += (bv[j2] < bv[i] || (bv[j2] == bv[i] && j2 < i)) ? 1 : 0;
            act = (rk == vr) ? i : act; }
        bh = (bh & 8) | act; }
    const int b = bh >> 3, h = bh & 7, kvh = mixb ? bh : (b * HAKV + (h >> 2));
    BlockRef r;
    r.Q = (const char*)ws + (mixb ? WS_QB : WS_QA) + ((size_t)bh * T + (size_t)qb * QB) * D * 2;
    r.K = (const char*)ws + (mixb ? WS_KB : WS_KA) + (size_t)kvh * T * D * 2;
    r.V = (const char*)ws + (mixb ? WS_VB : WS_VA) + (size_t)kvh * T * D * 2;
    r.O = (char*)ws + (mixb ? WS_OUTB : WS_OUTA) + ((size_t)(b * T + qb * QB) * 1024 + h * D) * 2;
    r.P0 = qb * QB;
    r.NBQ = nullptr;
    r.MK = (const char*)ws + WS_MASK + (size_t)(b * T + qb * QB) * 64 * 8;
    const int NTall = r.P0 / KVBLK + 4;
    r.part = part; r.j0 = 0; r.nt = NTall;
    r.PART = (char*)ws + WS_PART + (size_t)(bh * 8 + (qb & 7)) * 135168; r.flag = (unsigned*)(ws + WS_CTL) + CW_SPLIT + (bh * 8 + (qb & 7));
    if (part != 0) { const int hs = HSPLIT[bh & 7][qb - 8]; if (part == 1) r.nt = hs; else { r.j0 = hs; r.nt = NTall - hs; } }
    if (mixb) {
        const unsigned* nrm = (const unsigned*)(ws + WS_NORM);
        float q2 = 0.f, k2 = 0.f;
#pragma unroll
        for (int w_ = 0; w_ < 4; ++w_) { q2 += __uint_as_float(nrm[(bh * 16 + qb) * 4 + w_]); k2 += __uint_as_float(nrm[1024 + bh * 4 + w_]); }
        const float qk = 2.02f * __builtin_sqrtf(q2 * k2) * SCALE;
        r.j0 = __float_as_int(qk);
        r.NBQ = (const char*)ws + WS_LOGF + (size_t)bh * T * 4;
    }
    return r;
}
__device__ __forceinline__ void run_list(int cu, unsigned char* ws, char* lds, int wv, const float* b_f) {
    Seam S;
    int code = SCHED[cu][0];
    if (code < 0) return;
    BlockRef cur = make_ref(code, ws, b_f);
    prime(cur, lds, S, wv);
#pragma unroll 1
    for (int k = 0; k < SCHED_MAXI; ++k) {
        if ((code & 15) == 2) break;
        const int ncode = (k + 1 < SCHED_MAXI) ? SCHED[cu][k + 1] : -1;
        const BlockRef nxt = ncode >= 0 ? make_ref(ncode, ws, b_f) : cur;
        if ((code >> 12) != 0) block<true, 0>(cur, nxt, lds, S, wv); else block<false, 0>(cur, nxt, lds, S, wv);
        if (ncode < 0) return;
        cur = nxt; code = ncode;
    }
    block<false, 2>(cur, cur, lds, S, wv);
}
}


#define XB_TMO      128
#define XB_XCNT(j)  (256  + 64 * (j))
#define XB_XSUB(j)  (1280 + 64 * (j))
#define XB_XGEN(j)  (2304 + 64 * (j))
#define XB_TOP      3328
#define XB_TOPGEN   3392
#define XCD_BAR_WORDS 3456
#define XB_SPIN_CAP (1u << 24)
__device__ __forceinline__ unsigned xb_ld(unsigned* p)              { return __hip_atomic_load(p, __ATOMIC_RELAXED, __HIP_MEMORY_SCOPE_AGENT); }
__device__ __forceinline__ unsigned xb_add(unsigned* p, unsigned v) { return __hip_atomic_fetch_add(p, v, __ATOMIC_RELAXED, __HIP_MEMORY_SCOPE_AGENT); }
__device__ __forceinline__ unsigned xb_xcc_id() { return (unsigned)__builtin_amdgcn_s_getreg((3 << 11) | 20) & 0xFu; }
#define XB_SPIN(cond, bar) do { unsigned _sp = 0; while (cond) { __builtin_amdgcn_s_sleep(1); \
    if ((++_sp & 255u) == 0u) { if (xb_ld(&(bar)[XB_TMO])) break; if (_sp > XB_SPIN_CAP) { atomicAdd(&(bar)[XB_TMO], 1u); break; } } } } while (0)
struct XcdBarrier { unsigned* bar; unsigned x; volatile LAS unsigned* st; };
__device__ __forceinline__ XcdBarrier xcd_barrier_post(unsigned* bar, volatile LAS unsigned* st, int wv) {
    XcdBarrier b; b.bar = bar; b.x = xb_xcc_id(); b.st = st;
    if (wv == 0 && lane_id() == 0) (void)xb_add(&bar[XB_XCNT(b.x)], 1u);
    return b;
}
__device__ __forceinline__ void xcd_barrier_complete(unsigned* bar, unsigned x, unsigned& nloc, unsigned& nx) {
    const unsigned G = gridDim.x * gridDim.y * gridDim.z;
    unsigned sum, cnt, mine, sp = 0u;
    for (;;) {
        sum = 0u; cnt = 0u; mine = 0u;
#pragma unroll
        for (unsigned j = 0; j < 16; ++j) { const unsigned c = xb_ld(&bar[XB_XCNT(j)]); sum += c; cnt += (c > 0u) ? 1u : 0u; mine = (j == x) ? c : mine; }
        if (sum == G) break;
        __builtin_amdgcn_s_sleep(1);
        if ((++sp & 255u) == 0u) { if (xb_ld(&bar[XB_TMO])) break; if (sp > XB_SPIN_CAP) { atomicAdd(&bar[XB_TMO], 1u); break; } }
    }
    nloc = mine > 0u ? mine : 1u; nx = cnt > 0u ? cnt : 1u;
}
__device__ __forceinline__ void xcd_barrier(const XcdBarrier& b, int wv) {
    asm volatile("s_waitcnt vmcnt(0)" ::: "memory");
    __syncthreads();
    if (wv == 0 && lane_id() == 0) {
        unsigned* bar = b.bar;
        __builtin_amdgcn_s_waitcnt(0);
        unsigned nloc = b.st[0], nx = b.st[1];
        if (nloc == 0u) { xcd_barrier_complete(bar, b.x, nloc, nx); b.st[0] = nloc; b.st[1] = nx; }
        const unsigned old = xb_add(&bar[XB_XSUB(b.x)], 1u);
        const unsigned gen = old / nloc;
        if (old + 1u == (gen + 1u) * nloc) {
            __builtin_amdgcn_fence(__ATOMIC_RELEASE, "agent");
            asm volatile("s_waitcnt vmcnt(0)" ::: "memory");
            const unsigned og = xb_add(&bar[XB_TOP], 1u);
            const unsigned tg = og / nx;
            if (og + 1u == (tg + 1u) * nx) xb_add(&bar[XB_TOPGEN], 1u);
            else XB_SPIN(xb_ld(&bar[XB_TOPGEN]) == tg, bar);
            __builtin_amdgcn_fence(__ATOMIC_ACQUIRE, "agent");
            xb_add(&bar[XB_XGEN(b.x)], 1u);
            asm volatile("s_waitcnt vmcnt(0)" ::: "memory");
        } else {
            XB_SPIN(xb_ld(&bar[XB_XGEN(b.x)]) == gen, bar);
            __builtin_amdgcn_fence(__ATOMIC_ACQUIRE, "agent");
            asm volatile("s_waitcnt vmcnt(0)" ::: "memory");
        }
    }
    __syncthreads();
}

namespace cg = cooperative_groups;
constexpr int LDS_BYTES = pg8::STAGE_BYTES + 256;
struct Params { const float* in[17]; float* out; unsigned char* ws; };
template <class Epi>
__device__ __forceinline__ void run_gemm(LAS unsigned char* lds, const h16* A, const h16* Bt, int M, int N, int K, const Epi& e, int wv) {
    pg8::Gemm g{A, Bt, M, N, K, nullptr, nullptr}; pg8::StaticOrder S; S.init(M, N, (int)gridDim.x, (int)blockIdx.x);
    pg8::gemm_phase<Epi>(lds, g, S, e, wv);
}
template <class Epi>
__device__ __forceinline__ void run_gemm2(LAS unsigned char* lds, const h16* A, const h16* Bt, const h16* A2, const h16* Bt2, int M, int N, int K, const Epi& e, int wv) {
    pg8::Gemm g{A, Bt, M, N, K, A2, Bt2}; pg8::StaticOrder S; S.init(M, N, (int)gridDim.x, (int)blockIdx.x, 2);
    pg8::gemm_phase<Epi>(lds, g, S, e, wv);
}
__global__ void __launch_bounds__(512, 2) mega_fwd(Params P) {
    extern __shared__ __attribute__((aligned(16))) unsigned char lds_raw[];
    LAS unsigned char* lds = (LAS unsigned char*)lds_raw;
    const int wv = __builtin_amdgcn_readfirstlane(threadIdx.x >> 6);
    volatile LAS unsigned* bst = (volatile LAS unsigned*)(lds + pg8::STAGE_BYTES);
    if (wv == 0 && lane_id() < 2) bst[lane_id()] = 0u;
    __syncthreads();
    const XcdBarrier xbar = xcd_barrier_post((unsigned*)(P.ws + WS_CTL) + CW_BAR, bst, wv);
#define GRID_BAR() xcd_barrier(xbar, wv)
#define IDS() int lane = lane_id(); asm volatile("" : "+v"(lane)); const int wave = wv, tid = wave * 64 + lane, gw = blockIdx.x * 8 + wave, NGW = gridDim.x * 8; (void)tid; (void)gw; (void)NGW
    const float* x = P.in[0]; const float* p = P.in[1]; const int* pos = (const int*)P.in[2];
    const float* g_mix = P.in[3]; const float* w_in = P.in[4]; const float* b_f = P.in[5];
    const float* w_o_a = P.in[6]; const float* w_o_b = P.in[7]; const float* w_out = P.in[8];
    const float* g_ffn = P.in[9]; const float* w_g = P.in[10]; const float* w_u = P.in[11]; const float* w_d = P.in[12];
    const float* g_ple = P.in[13]; const float* w_pg = P.in[14]; const float* w_pp = P.in[15]; const float* g_final = P.in[16];
    unsigned char* ws = P.ws; float* out = P.out;
    float* RS = (float*)(ws + WS_RS); float* ROPE = (float*)(ws + WS_ROPE); float* LOGF = (float*)(ws + WS_LOGF); u64* MASK = (u64*)(ws + WS_MASK);
    h16* WIN = (h16*)(ws + WS_WIN); h16* WOA = (h16*)(ws + WS_WOA); h16* WOB = (h16*)(ws + WS_WOB); h16* WOUT = (h16*)(ws + WS_WOUT);
    h16* WGU = (h16*)(ws + WS_WGU); h16* WDN = (h16*)(ws + WS_WDN); h16* WPG = (h16*)(ws + WS_WPG); h16* WPP = (h16*)(ws + WS_WPP);
    h16* QI = (h16*)(ws + WS_QI); h16* KI = (h16*)(ws + WS_KI); float* WI = (float*)(ws + WS_WI);
    h16* SIGA = (h16*)(ws + WS_SIGA); h16* SIGB = (h16*)(ws + WS_SIGB);
    h16* OUTA = (h16*)(ws + WS_OUTA); h16* OUTB = (h16*)(ws + WS_OUTB); h16* P16 = (h16*)(ws + WS_P16);
    h16* X3H = (h16*)(ws + WS_SIGA);
    h16* MIXED = (h16*)(ws + WS_MIXED); h16* H2 = (h16*)(ws + WS_H2); h16* ACT = (h16*)(ws + WS_ACT); h16* PP = (h16*)(ws + WS_PP);
    h16* H1 = (h16*)P.out;

    { IDS(); LAS float* scr = (LAS float*)(lds + wave * 8448);
      ph_transpose<2>(w_g, w_u, g_ffn, DM, DFF, WGU, 2 * DFF, scr, gw, NGW, lane);
      ph_transpose<1>(w_in, nullptr, nullptr, DM, N_IN, WIN, N_INP, scr, gw, NGW, lane);
      ph_rope(pos, ROPE, blockIdx.x * 512 + tid, gridDim.x * 512);
      for (int i = blockIdx.x * 512 + tid; i < 3 * MTOK; i += gridDim.x * 512) RS[i] = 0.f;
      for (int i = blockIdx.x * 512 + tid; i < 1088; i += gridDim.x * 512) ((unsigned*)(ws + WS_NORM))[i] = 0u;
      ph_rmsnorm<false>(x, g_mix, H1, nullptr, gw, NGW, lane);
    }
    GRID_BAR();
    { EpiInProj e{ws, b_f}; run_gemm(lds, H1, WIN, MTOK, N_INP, DM, e, wv); }
    { const int fi = ((MTOK / 256) * (N_INP / 256)) % (int)gridDim.x;
    if ((int)blockIdx.x >= fi) { IDS(); (void)tid; (void)gw; (void)NGW; LAS float* scr = (LAS float*)(lds + wave * 8448); const int qw = ((int)blockIdx.x - fi) * 8 + wave, nq = ((int)gridDim.x - fi) * 8;
      ph_transpose<0>(w_o_a, nullptr, nullptr, 1024, DM, WOA, DM, scr, qw, nq, lane);
      ph_transpose<0>(w_o_b, nullptr, nullptr, 1024, DM, WOB, DM, scr, qw, nq, lane);
      ph_transpose<0>(w_out, nullptr, nullptr, DM, DM, WOUT, DM, scr, qw, nq, lane); } }
    GRID_BAR();
    { IDS();
      for (int it = blockIdx.x; it < 256; it += gridDim.x) { const int bb = it & 1, gi = it >> 1;
#pragma unroll 1
          for (int pass = 0; pass < 2; ++pass) idx::run_group(ws, (char*)lds_raw, (unsigned*)out + (size_t)blockIdx.x * 16 * T, bb, pass ? 255 - gi : gi, wv); }
      for (int i = blockIdx.x * 512 + tid; i < MTOK * DPLE / 4; i += gridDim.x * 512) st4h(P16 + 4 * (size_t)i, *((const f32x4*)p + i));
    }
    GRID_BAR();
    for (int cu = blockIdx.x; cu < 256; cu += gridDim.x) att::run_list(cu, ws, (char*)lds_raw, wv, b_f);
    GRID_BAR();
    { EpiGate2 e{SIGA, SIGB, MIXED}; run_gemm2(lds, OUTA, WOA, OUTB, WOB, MTOK, DM, 1024, e, wv); }
    GRID_BAR();
    { EpiResidNorm<true> e{x, H2, RS}; run_gemm(lds, MIXED, WOUT, MTOK, DM, DM, e, wv); }
    GRID_BAR();
    { EpiSwiGLU e{ACT, RS}; run_gemm(lds, H2, WGU, MTOK, 2 * DFF, DM, e, wv); }
    { const int fi = ((MTOK / 256) * (2 * DFF / 256)) % (int)gridDim.x;
    if ((int)blockIdx.x >= fi) { IDS(); (void)tid; (void)gw; (void)NGW; LAS float* scr = (LAS float*)(lds + wave * 8448); const int qw = ((int)blockIdx.x - fi) * 8 + wave, nq = ((int)gridDim.x - fi) * 8;
      ph_transpose<0>(w_d, nullptr, nullptr, DFF, DM, WDN, DM, scr, qw, nq, lane);
      ph_transpose<0>(w_pg, nullptr, g_ple, DM, DM, WPG, DM, scr, qw, nq, lane);
      ph_transpose<0>(w_pp, nullptr, nullptr, DPLE, DM, WPP, DM, scr, qw, nq, lane); } }
    GRID_BAR();
    { EpiResidNorm<false> e{nullptr, H2, RS + MTOK}; run_gemm(lds, ACT, WDN, MTOK, DM, DFF, e, wv); }
    GRID_BAR();
    { EpiStoreH e{PP, DM}; run_gemm(lds, P16, WPP, MTOK, DM, DPLE, e, wv); }
    if (gridDim.x == (MTOK / 256) * (DM / 256)) {
        EpiPLEFinal e{PP, H2, out, RS + MTOK, RS + 2 * MTOK, g_final, (unsigned*)(ws + WS_CTL) + CW_PANEL}; run_gemm(lds, H2, WPG, MTOK, DM, DM, e, wv);
    } else {
        { EpiPLE e{PP, H2, X3H, RS + MTOK, RS + 2 * MTOK}; run_gemm(lds, H2, WPG, MTOK, DM, DM, e, wv); }
        GRID_BAR();
        { IDS(); ph_final(X3H, out, g_final, RS + 2 * MTOK, gw, NGW, lane); }
    }
#undef IDS
#undef GRID_BAR
}

extern "C" void kernel_launch(void* const* d_in, const int* in_sizes, int n_in, void* d_out, int out_size, void* d_ws, size_t ws_size, hipStream_t stream) {
    if (n_in != 17 || out_size != MTOK * DM || ws_size < WS_END) { fprintf(stderr, "kernel_launch: unexpected shapes / workspace (%d inputs, out %d, ws %zu)\n", n_in, out_size, ws_size); return; }
    static int grid_blocks = 0;
    if (!grid_blocks) {
        int dev = 0, cus = 0, per_cu = 0;
        (void)hipGetDevice(&dev);
        (void)hipDeviceGetAttribute(&cus, hipDeviceAttributeMultiprocessorCount, dev);
        (void)hipFuncSetAttribute((const void*)mega_fwd, hipFuncAttributeMaxDynamicSharedMemorySize, LDS_BYTES);
        (void)hipOccupancyMaxActiveBlocksPerMultiprocessor(&per_cu, (const void*)mega_fwd, 512, LDS_BYTES);
        if (per_cu < 1) { fprintf(stderr, "kernel_launch: occupancy query says %d blocks per CU\n", per_cu); per_cu = 1; }
        if (per_cu > 1) per_cu = 1;
        grid_blocks = cus * per_cu;
    }
    (void)hipMemsetAsync((char*)d_ws + WS_CTL, 0, 64 * 1024, stream);
    Params prm{};
    for (int i = 0; i < 17; ++i) prm.in[i] = (const float*)d_in[i];
    prm.out = (float*)d_out; prm.ws = (unsigned char*)d_ws;
    void* args[] = {&prm};
    hipError_t e = hipLaunchCooperativeKernel((const void*)mega_fwd, dim3(grid_blocks), dim3(512), args, LDS_BYTES, stream);
    if (e != hipSuccess) fprintf(stderr, "cooperative launch failed: %s (grid %d)\n", hipGetErrorString(e), grid_blocks);
}
```
